# Optimizing an MI355X kernel written in HIP

```python
import jax
import jax.numpy as jnp
from jax import lax
import numpy as np

D_MODEL = 1024
BATCH = 16
SEQ = 4096
DEPTH = 2

POOL_WIDTH = D_MODEL // 4
POOL_GROUPS = 4
POOL_GROUP_WIDTH = POOL_WIDTH // POOL_GROUPS
POOL_WINDOWS = (2, 4, 8, 16)
LRU_WIDTH = D_MODEL // 4
LRU_BLOCKS = 4
LRU_BLOCK_WIDTH = LRU_WIDTH // LRU_BLOCKS
CONV_WIDTH = 4
LRU_C = 8.0
HEAD_DIM = 64
ATTN_WIDTH = D_MODEL - POOL_WIDTH - LRU_WIDTH
N_ATTN_HEADS = ATTN_WIDTH // HEAD_DIM
DILATED_PATTERNS = ((128, 1), (512, 4), (2048, 16))
ATTN_BLOCK = 128
ROPE_THETA = 10000.0
IN_WIDTH = POOL_WIDTH + 2 * LRU_WIDTH + 3 * ATTN_WIDTH
N_EXPERTS = 32
TOP_K = 4
EXPERT_FF = D_MODEL // 4
MOE_BLOCK = 512
SWIGLU_LIMIT = 7.0
SWIGLU_ALPHA = 1.702
NORM_EPS = 1e-6
NEG_INF = -1e30

kernel_name = 'hybrid_pool_rglru_dilated_attn_moe'


def _rms_norm(x, g):
    x32 = x.astype(jnp.float32)
    y = x32 * lax.rsqrt(jnp.mean(x32 * x32, axis=-1, keepdims=True) + NORM_EPS)
    return (y * g.astype(jnp.float32)).astype(x.dtype)


def _rope_tables(seq_len):
    pos = jnp.arange(seq_len, dtype=jnp.float32)
    inv_freq = ROPE_THETA ** (-jnp.arange(0, HEAD_DIM, 2, dtype=jnp.float32) / HEAD_DIM)
    ang = pos[:, None] * inv_freq[None, :]
    return jnp.cos(ang)[None, :, None, :], jnp.sin(ang)[None, :, None, :]


def _rope(x, cos, sin):
    half = HEAD_DIM // 2
    x1, x2 = x[..., :half], x[..., half:]
    return jnp.concatenate([x1 * cos - x2 * sin, x2 * cos + x1 * sin], axis=-1)


def _pool_mixer(u, pool_w, pool_scale):
    b, s, _ = u.shape
    u32 = u.astype(jnp.float32).reshape(b, s, POOL_GROUPS, POOL_GROUP_WIDTH)
    csum = lax.cumsum(u32, axis=1)
    count = jnp.arange(1, s + 1, dtype=jnp.float32)[None, :, None]
    means = []
    for g, w in enumerate(POOL_WINDOWS):
        cg = csum[:, :, g]
        lagged = jnp.pad(cg, ((0, 0), (w, 0), (0, 0)))[:, :s]
        means.append((cg - lagged) / jnp.minimum(count, float(w)))
    pooled = jnp.stack(means, axis=2) - u32
    y = jnp.einsum('bsgc,gce->bsge', pooled, pool_w.astype(jnp.float32)).reshape(b, s, POOL_WIDTH)
    return y * pool_scale.astype(jnp.float32)


def _lru_combine(left, right):
    a1, b1 = left
    a2, b2 = right
    return a1 * a2, a2 * b1 + b2


def _rglru_mixer(u, gate_in, conv_w, conv_b, wa, ba, wx, bx, lam):
    b, s, _ = u.shape
    up = jnp.pad(u, ((0, 0), (CONV_WIDTH - 1, 0), (0, 0)))
    xc = conv_b.astype(jnp.float32)
    for j in range(CONV_WIDTH):
        xc = xc + conv_w[j].astype(jnp.float32) * up[:, j:j + s].astype(jnp.float32)
    xblk = xc.reshape(b, s, LRU_BLOCKS, LRU_BLOCK_WIDTH)
    r = jax.nn.sigmoid(jnp.einsum('bsnc,nce->bsne', xblk, wa.astype(jnp.float32)).reshape(b, s, LRU_WIDTH) + ba)
    i = jax.nn.sigmoid(jnp.einsum('bsnc,nce->bsne', xblk, wx.astype(jnp.float32)).reshape(b, s, LRU_WIDTH) + bx)
    log_a = -LRU_C * r * jax.nn.softplus(-lam.astype(jnp.float32))
    a = jnp.exp(log_a)
    mult = jnp.sqrt(-jnp.expm1(2.0 * log_a))
    mult = mult.at[:, 0].set(1.0)
    _, h = lax.associative_scan(_lru_combine, (a, mult * (i * xc)), axis=1)
    return h * jax.nn.gelu(gate_in.astype(jnp.float32))


def _dilated_branch(q, k, v, window, dilation):
    b, s, h, dh = q.shape
    span = window // dilation
    sub = s // dilation
    n_blk = -(-sub // ATTN_BLOCK)
    pad = n_blk * ATTN_BLOCK - sub

    def to_blocks(t):
        t = t.reshape(b, sub, dilation, h, dh)
        t = jnp.pad(t, ((0, 0), (0, pad), (0, 0), (0, 0), (0, 0)))
        return t.reshape(b, n_blk, ATTN_BLOCK, dilation, h, dh)

    def with_previous(t):
        prev = jnp.pad(t, ((0, 0), (1, 0), (0, 0), (0, 0), (0, 0), (0, 0)))[:, :n_blk]
        return jnp.concatenate([prev, t], axis=2)

    qb = to_blocks(q)
    kb = with_previous(to_blocks(k))
    vb = with_previous(to_blocks(v))
    scores = jnp.einsum('bnqrhd,bnkrhd->bnrhqk', qb, kb) * (HEAD_DIM ** -0.5)
    qi = jnp.arange(ATTN_BLOCK)[:, None]
    kj = jnp.arange(2 * ATTN_BLOCK)[None, :]
    dist = qi + ATTN_BLOCK - kj
    band = (dist >= 0) & (dist <= span)
    valid = band[None] & ((jnp.arange(n_blk)[:, None, None] > 0) | (kj[None] >= ATTN_BLOCK))
    scores = jnp.where(valid[None, :, None, None], scores, NEG_INF)
    row_max = jnp.max(scores, axis=-1)
    p = jnp.exp(scores - row_max[..., None])
    den = jnp.sum(p, axis=-1)
    num = jnp.einsum('bnrhqk,bnkrhd->bnqrhd', p, vb)

    def from_blocks(t):
        t1 = t.reshape((b, n_blk * ATTN_BLOCK) + t.shape[3:])[:, :sub]
        return t1.reshape((b, s) + t1.shape[3:])

    return (from_blocks(num),
            from_blocks(den.transpose(0, 1, 4, 2, 3)),
            from_blocks(row_max.transpose(0, 1, 4, 2, 3)))


def _attention_mixer(q, k, v, q_norm_g, k_norm_g, cos, sin):
    b, s, _ = q.shape
    q = _rope(_rms_norm(q.reshape(b, s, N_ATTN_HEADS, HEAD_DIM), q_norm_g).astype(jnp.float32), cos, sin)
    k = _rope(_rms_norm(k.reshape(b, s, N_ATTN_HEADS, HEAD_DIM), k_norm_g).astype(jnp.float32), cos, sin)
    v = v.reshape(b, s, N_ATTN_HEADS, HEAD_DIM).astype(jnp.float32)
    branches = [_dilated_branch(q, k, v, w, d) for (w, d) in DILATED_PATTERNS]
    m_ref = branches[0][2]
    for br in branches[1:]:
        m_ref = jnp.maximum(m_ref, br[2])
    num = jnp.zeros_like(q)
    den = jnp.zeros_like(m_ref)
    for n_g, d_g, m_g in branches:
        wgt = jnp.exp(m_g - m_ref)
        num = num + wgt[..., None] * n_g
        den = den + wgt * d_g
    return (num / den[..., None]).reshape(b, s, ATTN_WIDTH)


def _moe(h, router_w, router_b, w_gate_up, b_gate_up, w_down, b_down):
    b, s, d = h.shape
    n_tok = b * s
    n_assign = n_tok * TOP_K
    n_blocks = -(-n_assign // MOE_BLOCK) + N_EXPERTS
    t = h.reshape(n_tok, d)
    logits = t.astype(jnp.float32) @ router_w.astype(jnp.float32) + router_b.astype(jnp.float32)
    top_val, top_idx = lax.top_k(logits, TOP_K)
    gates = jax.nn.softmax(top_val, axis=-1)
    flat_e = top_idx.reshape(-1).astype(jnp.int32)
    order = jnp.argsort(flat_e)
    e_sorted = flat_e[order]
    sizes = jnp.bincount(flat_e, length=N_EXPERTS).astype(jnp.int32)
    start = jnp.cumsum(sizes) - sizes
    pad_sizes = (sizes + MOE_BLOCK - 1) // MOE_BLOCK * MOE_BLOCK
    pad_end = jnp.cumsum(pad_sizes)
    pad_start = pad_end - pad_sizes
    dest_sorted = pad_start[e_sorted] + jnp.arange(n_assign, dtype=jnp.int32) - start[e_sorted]
    dest = jnp.zeros((n_assign,), jnp.int32).at[order].set(dest_sorted.astype(jnp.int32))
    row_tok = jnp.zeros((n_blocks * MOE_BLOCK,), jnp.int32).at[dest].set(
        jnp.arange(n_assign, dtype=jnp.int32) // TOP_K)
    block_e = jnp.minimum(jnp.searchsorted(pad_end, jnp.arange(n_blocks, dtype=jnp.int32) * MOE_BLOCK,
                                           side='right'), N_EXPERTS - 1)
    xb = t[row_tok].reshape(n_blocks, MOE_BLOCK, d)
    gu = jnp.einsum('nrd,ndf->nrf', xb, w_gate_up[block_e]) + b_gate_up[block_e][:, None, :]
    gate = jnp.minimum(gu[..., :EXPERT_FF], SWIGLU_LIMIT)
    up = jnp.clip(gu[..., EXPERT_FF:], -SWIGLU_LIMIT, SWIGLU_LIMIT)
    act = (up + 1.0) * gate * jax.nn.sigmoid(SWIGLU_ALPHA * gate)
    y = jnp.einsum('nrf,nfd->nrd', act, w_down[block_e]) + b_down[block_e][:, None, :]
    y_assign = y.reshape(n_blocks * MOE_BLOCK, d)[dest].reshape(n_tok, TOP_K, d)
    out = jnp.einsum('tkd,tk->td', y_assign, gates.astype(y.dtype))
    return out.reshape(b, s, d)


def setup_inputs(seed: int = 0) -> dict:
    key = jax.random.key(seed)
    ks = jax.random.split(key, 24)
    f32 = jnp.float32

    def nrm(k, shape, scale):
        return jax.random.normal(k, shape, f32) * scale

    lam_u = jax.random.uniform(ks[11], (DEPTH, LRU_WIDTH), f32, 0.9, 0.999)
    lam_s = lam_u ** (1.0 / LRU_C)
    return {
        'x': nrm(ks[0], (BATCH, SEQ, D_MODEL), 1.0),
        'norm1_g': 1.0 + nrm(ks[1], (DEPTH, D_MODEL), 0.02),
        'w_in': nrm(ks[2], (DEPTH, D_MODEL, IN_WIDTH), D_MODEL ** -0.5),
        'pool_w': nrm(ks[3], (DEPTH, POOL_GROUPS, POOL_GROUP_WIDTH, POOL_GROUP_WIDTH), POOL_GROUP_WIDTH ** -0.5),
        'pool_scale': 1.0 + nrm(ks[4], (DEPTH, POOL_WIDTH), 0.02),
        'conv_w': nrm(ks[5], (DEPTH, CONV_WIDTH, LRU_WIDTH), CONV_WIDTH ** -0.5),
        'conv_b': nrm(ks[6], (DEPTH, LRU_WIDTH), 0.01),
        'lru_wa': nrm(ks[7], (DEPTH, LRU_BLOCKS, LRU_BLOCK_WIDTH, LRU_BLOCK_WIDTH), LRU_BLOCK_WIDTH ** -0.5),
        'lru_ba': nrm(ks[8], (DEPTH, LRU_WIDTH), 0.01),
        'lru_wx': nrm(ks[9], (DEPTH, LRU_BLOCKS, LRU_BLOCK_WIDTH, LRU_BLOCK_WIDTH), LRU_BLOCK_WIDTH ** -0.5),
        'lru_bx': nrm(ks[10], (DEPTH, LRU_WIDTH), 0.01),
        'lru_lambda': jnp.log(lam_s) - jnp.log1p(-lam_s),
        'q_norm_g': 1.0 + nrm(ks[12], (DEPTH, HEAD_DIM), 0.02),
        'k_norm_g': 1.0 + nrm(ks[13], (DEPTH, HEAD_DIM), 0.02),
        'out_norm_g': 1.0 + nrm(ks[14], (DEPTH, D_MODEL), 0.02),
        'w_out': nrm(ks[15], (DEPTH, D_MODEL, D_MODEL), D_MODEL ** -0.5),
        'norm2_g': 1.0 + nrm(ks[16], (DEPTH, D_MODEL), 0.02),
        'router_w': nrm(ks[17], (DEPTH, D_MODEL, N_EXPERTS), D_MODEL ** -0.5),
        'router_b': nrm(ks[18], (DEPTH, N_EXPERTS), 0.01),
        'w_gate_up': nrm(ks[19], (DEPTH, N_EXPERTS, D_MODEL, 2 * EXPERT_FF), D_MODEL ** -0.5),
        'b_gate_up': nrm(ks[20], (DEPTH, N_EXPERTS, 2 * EXPERT_FF), 0.01),
        'w_down': nrm(ks[21], (DEPTH, N_EXPERTS, EXPERT_FF, D_MODEL), EXPERT_FF ** -0.5),
        'b_down': nrm(ks[22], (DEPTH, N_EXPERTS, D_MODEL), 0.01),
    }


def reference(x, norm1_g, w_in, pool_w, pool_scale, conv_w, conv_b, lru_wa, lru_ba, lru_wx, lru_bx,
              lru_lambda, q_norm_g, k_norm_g, out_norm_g, w_out, norm2_g, router_w, router_b,
              w_gate_up, b_gate_up, w_down, b_down):
    cos, sin = _rope_tables(x.shape[1])
    c0 = POOL_WIDTH
    c1 = c0 + LRU_WIDTH
    c2 = c1 + LRU_WIDTH
    c3 = c2 + ATTN_WIDTH
    c4 = c3 + ATTN_WIDTH
    a_end = POOL_WIDTH
    b_end = POOL_WIDTH + LRU_WIDTH
    for l in range(DEPTH):
        h = _rms_norm(x, norm1_g[l])
        proj = h @ w_in[l]
        y_pool = _pool_mixer(proj[..., :c0], pool_w[l], pool_scale[l])
        y_lru = _rglru_mixer(proj[..., c0:c1], proj[..., c1:c2], conv_w[l], conv_b[l],
                             lru_wa[l], lru_ba[l], lru_wx[l], lru_bx[l], lru_lambda[l])
        y_attn = _attention_mixer(proj[..., c2:c3], proj[..., c3:c4], proj[..., c4:],
                                  q_norm_g[l], k_norm_g[l], cos, sin)
        og = out_norm_g[l]
        mix = jnp.concatenate([_rms_norm(y_pool, og[:a_end]),
                               _rms_norm(y_lru, og[a_end:b_end]),
                               _rms_norm(y_attn, og[b_end:])], axis=-1).astype(x.dtype)
        x = x + mix @ w_out[l]
        x = x + _moe(_rms_norm(x, norm2_g[l]), router_w[l], router_b[l],
                     w_gate_up[l], b_gate_up[l], w_down[l], b_down[l])
    return x
```

```cpp
#include <hip/hip_runtime.h>
#include <cstdio>
#include <cstdint>

#define LAS __attribute__((address_space(3)))
#define GAS __attribute__((address_space(1)))
typedef unsigned short bf16;
typedef short bf16x8 __attribute__((ext_vector_type(8)));
typedef float f32x4 __attribute__((ext_vector_type(4)));
typedef float f32x2 __attribute__((ext_vector_type(2)));
typedef unsigned u32x4 __attribute__((ext_vector_type(4)));
typedef unsigned u32x2 __attribute__((ext_vector_type(2)));

constexpr int NB = 16, SEQ = 4096, DM = 1024, NT = NB * SEQ;
constexpr int NIN = 2304;
constexpr int C_POOL = 0, C_LRU = 256, C_GATE = 512, C_Q = 768, C_K = 1280, C_V = 1792;
constexpr int NEXP = 32, TOPK = 4, EFF = 256;
constexpr int NASSIGN = NT * TOPK;
constexpr int ACT_ROWS = NASSIGN + NEXP * 256;
constexpr float EPS = 1e-6f;
constexpr int NWAVES = 8, NTHR = 512;
constexpr int LRU_CH = 32, LRU_NCH = SEQ / LRU_CH;

constexpr size_t MiB = 1u << 20;
constexpr size_t WS_CTL = 0, CTL_ZERO_BYTES = 1 * MiB;
constexpr size_t WS_ROPE = 1 * MiB;
constexpr size_t WS_SMALL = 2 * MiB;
constexpr size_t WS_WIN = 4 * MiB;
constexpr size_t WS_WOUT = 13 * MiB;
constexpr size_t WS_WGU = 17 * MiB;
constexpr size_t WS_WD = 81 * MiB;
constexpr size_t WS_SSQ = 113 * MiB;
constexpr size_t WS_SSQP = 114 * MiB;
constexpr size_t WS_LIST = 118 * MiB;
constexpr size_t WS_XB = 128 * MiB;
constexpr size_t WS_R = 256 * MiB;
constexpr size_t WS_PROJ = WS_R;
constexpr size_t WS_MIX = WS_R + 288 * MiB;
constexpr size_t WS_PNUM = WS_R + 416 * MiB;
constexpr size_t WS_PDEN = WS_R + 608 * MiB;
constexpr size_t WS_PMAX = WS_R + 614 * MiB;
constexpr size_t WS_HL = WS_R + 620 * MiB;
constexpr size_t WS_PL = WS_R + 652 * MiB;
constexpr size_t WS_AGGH = WS_R + 684 * MiB;
constexpr size_t WS_AGGP = WS_R + 686 * MiB;
constexpr size_t WS_CARRY = WS_R + 688 * MiB;
constexpr size_t WS_ACT = WS_R;
constexpr size_t WS_Y = WS_R + 132 * MiB;
constexpr size_t WS_LRSTD = WS_R + 644 * MiB;
constexpr size_t WS_LGATE2 = WS_R + 652 * MiB;
constexpr size_t WS_END = 1024 * MiB;
static_assert(WS_CARRY + 2 * MiB <= WS_END && WS_LGATE2 + 8 * MiB <= WS_END, "d_ws map");
constexpr size_t SM_POOLW = 0;
constexpr size_t SM_WA = 32768;
constexpr size_t SM_WX = 65536;
constexpr size_t SM_WR = 98304;
constexpr int CW_BAR = 4096;
constexpr int CW_CNT = 1024;

constexpr int RING_BYTES = 131072;
constexpr int LDSCTL_OFF = RING_BYTES;
constexpr int MISC_OFF = LDSCTL_OFF + 320;
constexpr int TAB_OFF = LDSCTL_OFF + 1024;
constexpr int LDS_BYTES = 147456;

typedef GAS unsigned gu32;
#define RLX_AGENT __ATOMIC_RELAXED, __HIP_MEMORY_SCOPE_AGENT
#define LDS_WAIT() asm volatile("s_waitcnt lgkmcnt(0)" ::: "memory")
#define VM_WAIT() asm volatile("s_waitcnt vmcnt(0)" ::: "memory")
typedef __bf16 bf16x2_t __attribute__((ext_vector_type(2)));
__device__ __forceinline__ unsigned cvt_pk_bf16(float lo, float hi) { const f32x2 v = {lo, hi}; const bf16x2_t b = __builtin_convertvector(v, bf16x2_t); return __builtin_bit_cast(unsigned, b); }
__device__ __forceinline__ float bflo(unsigned w) { return __uint_as_float(w << 16); }
__device__ __forceinline__ float bfhi(unsigned w) { return __uint_as_float(w & 0xffff0000u); }
__device__ __forceinline__ float bf2f(bf16 h) { return __uint_as_float((unsigned)h << 16); }
__device__ __forceinline__ bf16 f2bf(float f) { return (bf16)(cvt_pk_bf16(f, 0.f) & 0xffffu); }
__device__ __forceinline__ float wave_sum(float v) {
#pragma unroll
    for (int o = 1; o < 64; o <<= 1) v += __shfl_xor(v, o);
    return v;
}
__device__ __forceinline__ float fast_sigmoid(float x) { return __builtin_amdgcn_rcpf(1.0f + __builtin_amdgcn_exp2f(-1.4426950408889634f * x)); }
__device__ __forceinline__ float fast_exp(float x) { return __builtin_amdgcn_exp2f(1.4426950408889634f * x); }
__device__ __forceinline__ float gelu_tanh(float x) {
    const float u = 0.7978845608028654f * (x + 0.044715f * x * x * x);
    return x * fast_sigmoid(2.0f * u);
}
namespace pg8 {
constexpr int BM = 256, BK = 64, HALF = 128, HTB = HALF * BK * 2  , STAGE_BYTES = 8 * HTB, NXCD = 8, WGM = 8;

__host__ __device__ __forceinline__ int lds_byte(int r, int c) { const int st = (r >> 4) * 2 + (c >> 5), rr = r & 15, cc = c & 31, ob = rr * 64 + cc * 2; return st * 1024 + (ob ^ (((ob >> 9) & 1) << 5)); }
__host__ __device__ __forceinline__ void stage_rc(int b, int& R, int& C) { const int st = b / 1024, sb = b % 1024, swz = sb ^ (((sb >> 9) & 1) << 5); R = (st >> 1) * 16 + swz / 64; C = (st & 1) * 32 + (swz % 64) / 2; }
__host__ __device__ __forceinline__ int perm32(int rho) { const int n = rho >> 4, i = rho & 15; return 8 * (i >> 2) + 4 * n + (i & 3); }

struct Unit { int pm, pn, e, aux; };

template <class Epi, class Sched, bool ALIGN_EPI>
__device__ __forceinline__ void gemm_phase(LAS unsigned char* lds, const bf16* Abase, const bf16* Bbase, const int K, const Sched& S, const Epi& E) {
    int tid_ = threadIdx.x; asm volatile("" : "+v"(tid_)); const int tid = tid_, wid = __builtin_amdgcn_readfirstlane(tid >> 6), lane = tid & 63, wr = wid >> 2, wc = wid & 3, fr = lane & 15, fq = lane >> 4;
    const int nt = K / BK;
    unsigned voffB[2];
#pragma unroll
    for (int i = 0; i < 2; ++i) { int R, C; stage_rc(tid * 16 + i * 8192, R, C); const int Rb = Epi::PERM ? ((R & ~31) + perm32(R & 31)) : R;
        voffB[i] = (unsigned)(Rb * K + C) * 2u; }
#define PG8_AVOFF(u, h, i) ([&]() { int R_, C_; stage_rc(tid * 16 + (i) * 8192, R_, C_); return S.a_voff((u), (h) * HALF + R_, C_); }())
    const unsigned kstep = (unsigned)(BK * 2);
    const unsigned hstep = (unsigned)(HALF * K * 2);
    const unsigned ldsw = (unsigned)wid * 1024u;
    const int aoff = lds_byte(wr * 64 + fr, fq * 8), boff = lds_byte(wc * 32 + fr, fq * 8);
    const __amdgpu_buffer_rsrc_t rsA = __builtin_amdgcn_make_buffer_rsrc((void*)Abase, 0, 0x7fffffff, 0x00020000);
    const __amdgpu_buffer_rsrc_t rsB = __builtin_amdgcn_make_buffer_rsrc((void*)Bbase, 0, 0x7fffffff, 0x00020000);
#define PG8_SA(b, h) (((b) * 2 + (h)) * HTB)
#define PG8_SB(b, h) ((4 + (b) * 2 + (h)) * HTB)
#define PG8_STAGE_B(bufoff, soff) do { const int so_ = __builtin_amdgcn_readfirstlane((int)(soff)); _Pragma("unroll") for (int _i = 0; _i < 2; ++_i) \
        __builtin_amdgcn_raw_ptr_buffer_load_lds(rsB, (LAS void*)(lds + (bufoff) + ldsw + _i * 8192), 16, voffB[_i], so_, 0, 0); } while (0)
#define PG8_STAGE_A(bufoff, kbytes, v0, v1) do { const int so_ = __builtin_amdgcn_readfirstlane((int)(kbytes)); \
        __builtin_amdgcn_raw_ptr_buffer_load_lds(rsA, (LAS void*)(lds + (bufoff) + ldsw), 16, (v0), so_, 0, 0); \
        __builtin_amdgcn_raw_ptr_buffer_load_lds(rsA, (LAS void*)(lds + (bufoff) + ldsw + 8192), 16, (v1), so_, 0, 0); } while (0)
#define PG8_LDA(dst, b, h) do { _Pragma("unroll") for (int m = 0; m < 4; ++m) _Pragma("unroll") for (int k = 0; k < 2; ++k) dst[m][k] = *(const LAS bf16x8*)(lds + PG8_SA(b, h) + aoff + m * 2048 + k * 1024); } while (0)
#define PG8_LDB(dst, b, h) do { _Pragma("unroll") for (int n = 0; n < 2; ++n) _Pragma("unroll") for (int k = 0; k < 2; ++k) dst[n][k] = *(const LAS bf16x8*)(lds + PG8_SB(b, h) + boff + n * 2048 + k * 1024); } while (0)
#define PG8_MMA(ai, bj, At, Bt) do { __builtin_amdgcn_s_setprio(1); _Pragma("unroll") for (int m = 0; m < 4; ++m) _Pragma("unroll") for (int n = 0; n < 2; ++n) _Pragma("unroll") for (int k = 0; k < 2; ++k) \
        acc[ai][bj][m][n] = __builtin_amdgcn_mfma_f32_16x16x32_bf16(Bt[n][k], At[m][k], acc[ai][bj][m][n], 0, 0, 0); __builtin_amdgcn_s_setprio(0); } while (0)
#define PG8_WAIT_V(n) asm volatile("s_waitcnt vmcnt(" #n ")" ::: "memory")
#define PG8_WAIT_L(n) asm volatile("s_waitcnt lgkmcnt(" #n ")" ::: "memory")
#define PG8_BAR __builtin_amdgcn_s_barrier()
#define PG8_SCHED __builtin_amdgcn_sched_barrier(0)
    Unit cur, nxt; int ui = 0;
    if (!S.next(0, cur)) return;
    f32x4 acc[2][2][4][2];
#pragma unroll
    for (int a = 0; a < 2; ++a)
#pragma unroll
        for (int b = 0; b < 2; ++b)
#pragma unroll
            for (int m = 0; m < 4; ++m)
#pragma unroll
                for (int n = 0; n < 2; ++n) acc[a][b][m][n] = (f32x4){0.f, 0.f, 0.f, 0.f};
    bf16x8 At[4][2], B0[2][2], B1[2][2];
    unsigned vc0, vc1, vc2, vc3, vn0, vn1, vn2, vn3;
    vc0 = PG8_AVOFF(cur, 0, 0); vc1 = PG8_AVOFF(cur, 0, 1); vc2 = PG8_AVOFF(cur, 1, 0); vc3 = PG8_AVOFF(cur, 1, 1);
    unsigned cB = (unsigned)S.b_off(cur);
    PG8_STAGE_B(PG8_SB(0, 0), cB); PG8_STAGE_B(PG8_SB(0, 1), cB + hstep); PG8_STAGE_A(PG8_SA(0, 0), 0, vc0, vc1); PG8_STAGE_A(PG8_SA(0, 1), 0, vc2, vc3);
    if (wr == 1) PG8_BAR;
    PG8_WAIT_V(2); PG8_BAR;
    PG8_STAGE_B(PG8_SB(1, 0), cB + kstep); PG8_STAGE_A(PG8_SA(1, 0), kstep, vc0, vc1); PG8_STAGE_B(PG8_SB(1, 1), cB + hstep + kstep);
    PG8_WAIT_V(6); PG8_BAR;
    for (;;) {
#define PG8_TRIP(a1k, a2k, a3k, b2, b3, w0, w1, w2, w3) do { \
              \
            PG8_LDB(B0, 0, 0); PG8_LDB(B1, 0, 1); PG8_SCHED; PG8_LDA(At, 0, 0); PG8_STAGE_A(PG8_SA(1, 1), a1k, vc2, vc3); \
            PG8_WAIT_V(8); PG8_WAIT_L(0); PG8_BAR; PG8_MMA(0, 0, At, B0); PG8_MMA(0, 1, At, B1); PG8_BAR; PG8_SCHED; \
              \
            PG8_LDA(At, 0, 1); PG8_STAGE_B(PG8_SB(0, 0), b2); PG8_STAGE_B(PG8_SB(0, 1), (b2) + hstep); PG8_STAGE_A(PG8_SA(0, 0), a2k, w0, w1); \
            PG8_WAIT_V(8); PG8_WAIT_L(0); PG8_BAR; PG8_MMA(1, 0, At, B0); PG8_MMA(1, 1, At, B1); PG8_BAR; PG8_SCHED; \
              \
            PG8_LDB(B0, 1, 0); PG8_LDB(B1, 1, 1); PG8_SCHED; PG8_LDA(At, 1, 0); PG8_STAGE_A(PG8_SA(0, 1), a2k, w2, w3); \
            PG8_WAIT_V(8); PG8_WAIT_L(0); PG8_BAR; PG8_MMA(0, 0, At, B0); PG8_MMA(0, 1, At, B1); PG8_BAR; PG8_SCHED; \
              \
            PG8_LDA(At, 1, 1); PG8_STAGE_B(PG8_SB(1, 0), b3); PG8_STAGE_B(PG8_SB(1, 1), (b3) + hstep); PG8_STAGE_A(PG8_SA(1, 0), a3k, w0, w1); \
            PG8_WAIT_V(8); PG8_WAIT_L(0); PG8_BAR; PG8_MMA(1, 0, At, B0); PG8_MMA(1, 1, At, B1); PG8_BAR; PG8_SCHED; } while (0)
        for (int t = 0; t < nt - 2; t += 2) {
            const unsigned a1k = (unsigned)(t + 1) * kstep, a2k = (unsigned)(t + 2) * kstep, a3k = a2k + kstep, b2 = cB + a2k, b3 = b2 + kstep;
            PG8_TRIP(a1k, a2k, a3k, b2, b3, vc0, vc1, vc2, vc3);
        }
        const bool has_next = S.next(ui + 1, nxt);
        unsigned nB;
        if (has_next) { vn0 = PG8_AVOFF(nxt, 0, 0); vn1 = PG8_AVOFF(nxt, 0, 1); vn2 = PG8_AVOFF(nxt, 1, 0); vn3 = PG8_AVOFF(nxt, 1, 1); nB = (unsigned)S.b_off(nxt); }
        else { vn0 = vc0; vn1 = vc1; vn2 = vc2; vn3 = vc3; nB = cB; }
        { const unsigned a1k = (unsigned)(nt - 1) * kstep;
          PG8_TRIP(a1k, 0u, kstep, nB, nB + kstep, vn0, vn1, vn2, vn3); }
#undef PG8_TRIP
        if constexpr (ALIGN_EPI) { if (wr == 0) PG8_BAR; }
        E(acc, cur, wr, wc, fr, fq);
        if (!has_next) break;
#pragma unroll
        for (int a = 0; a < 2; ++a)
#pragma unroll
            for (int b = 0; b < 2; ++b)
#pragma unroll
                for (int m = 0; m < 4; ++m)
#pragma unroll
                    for (int n = 0; n < 2; ++n) acc[a][b][m][n] = (f32x4){0.f, 0.f, 0.f, 0.f};
        cur = nxt; cB = nB; vc0 = vn0; vc1 = vn1; vc2 = vn2; vc3 = vn3; ++ui;
        if constexpr (ALIGN_EPI) { if (wr == 1) PG8_BAR; }
    }
    PG8_WAIT_V(0);
    if constexpr (!ALIGN_EPI) { if (wr == 0) PG8_BAR; }
    PG8_BAR;
#undef PG8_SA
#undef PG8_AVOFF
#undef PG8_SB
#undef PG8_STAGE_A
#undef PG8_STAGE_B
#undef PG8_LDA
#undef PG8_LDB
#undef PG8_MMA
#undef PG8_WAIT_V
#undef PG8_WAIT_L
#undef PG8_BAR
#undef PG8_SCHED
}

struct StaticOrder {
    int nM, nN, nwg, G, c, lda;
    __device__ __forceinline__ void init(int M, int N, int lda_, int G_, int c_) { nM = M / BM; nN = N / BM; nwg = nM * nN; G = G_; c = c_; lda = lda_; }
    __device__ __forceinline__ bool next(int i, Unit& u) const {
        const long L = (long)i * G + c; if (L >= nwg) return false;
        int wgid = (int)L; { const int q = nwg / NXCD, r = nwg % NXCD, xcd = wgid % NXCD, off = wgid / NXCD; wgid = (xcd < r ? xcd * (q + 1) : r * (q + 1) + (xcd - r) * q) + off; }
        const int nig = WGM * nN, gid = wgid / nig, fm = gid * WGM, gsz = (nM - fm) < WGM ? (nM - fm) : WGM;
        u.pm = fm + ((wgid % nig) % gsz); u.pn = (wgid % nig) / gsz; u.e = 0; u.aux = 0; return true;
    }
    __device__ __forceinline__ unsigned a_voff(const Unit& u, int R, int C) const { return (unsigned)((u.pm * BM + R) * lda + C) * 2u; }
    __device__ __forceinline__ size_t b_off(const Unit& u) const { return (size_t)u.pn * BM * lda * 2; }
};
}

#define XB_TMO      128
#define XB_XCNT(j)  (256  + 64 * (j))
#define XB_XSUB(j)  (1280 + 64 * (j))
#define XB_XGEN(j)  (2304 + 64 * (j))
#define XB_TOP      3328
#define XB_TOPGEN   3392
#define XCD_BAR_WORDS 3456
#define XB_SPIN_CAP (1u << 18)

__device__ __forceinline__ unsigned xb_ld(unsigned* p)              { return __hip_atomic_load(p, __ATOMIC_RELAXED, __HIP_MEMORY_SCOPE_AGENT); }
__device__ __forceinline__ unsigned xb_add(unsigned* p, unsigned v) { return __hip_atomic_fetch_add(p, v, __ATOMIC_RELAXED, __HIP_MEMORY_SCOPE_AGENT); }
__device__ __forceinline__ unsigned xb_xcc_id() { return (unsigned)__builtin_amdgcn_s_getreg((3 << 11) | 20) & 0xFu; }
#define XB_SPIN(cond, bar) do { unsigned _sp = 0; while (cond) { __builtin_amdgcn_s_sleep(1); \
    if ((++_sp & 255u) == 0u) { if (xb_ld(&(bar)[XB_TMO])) break; if (_sp > XB_SPIN_CAP) { atomicAdd(&(bar)[XB_TMO], 1u); break; } } } } while (0)

struct XcdBarrier {
    unsigned* bar; unsigned x;
    volatile LAS unsigned* st;
};

__device__ __forceinline__ XcdBarrier xcd_barrier_post(unsigned* bar, volatile LAS unsigned* st) {
    XcdBarrier b; b.bar = bar; b.x = xb_xcc_id(); b.st = st;
    if (threadIdx.x == 0) (void)xb_add(&bar[XB_XCNT(b.x)], 1u);
    return b;
}
__device__ __forceinline__ void xcd_barrier_complete(unsigned* bar, unsigned x, unsigned& nloc, unsigned& nx) {
    const unsigned G = gridDim.x * gridDim.y * gridDim.z;
    unsigned sum, cnt, mine, sp = 0u;
    for (;;) {
        sum = 0u; cnt = 0u; mine = 0u;
#pragma unroll
        for (unsigned j = 0; j < 16; ++j) { const unsigned c = xb_ld(&bar[XB_XCNT(j)]); sum += c; cnt += (c > 0u) ? 1u : 0u; mine = (j == x) ? c : mine; }
        if (sum == G) break;
        __builtin_amdgcn_s_sleep(1);
        if ((++sp & 255u) == 0u) { if (xb_ld(&bar[XB_TMO])) break; if (sp > XB_SPIN_CAP) { atomicAdd(&bar[XB_TMO], 1u); break; } }
    }
    nloc = mine > 0u ? mine : 1u; nx = cnt > 0u ? cnt : 1u;
}

__device__ __forceinline__ void xcd_barrier(const XcdBarrier& b) {
    asm volatile("s_waitcnt vmcnt(0)" ::: "memory");
    __syncthreads();
    if (threadIdx.x == 0) {
        unsigned* bar = b.bar;
        __builtin_amdgcn_s_waitcnt(0);
        unsigned nloc = b.st[0], nx = b.st[1];
        if (nloc == 0u) { xcd_barrier_complete(bar, b.x, nloc, nx); b.st[0] = nloc; b.st[1] = nx; }
        const unsigned old = xb_add(&bar[XB_XSUB(b.x)], 1u);
        const unsigned gen = old / nloc;
        if (old + 1u == (gen + 1u) * nloc) {
            __builtin_amdgcn_fence(__ATOMIC_RELEASE, "agent");
            asm volatile("s_waitcnt vmcnt(0)" ::: "memory");
            const unsigned og = xb_add(&bar[XB_TOP], 1u);
            const unsigned tg = og / nx;
            if (og + 1u == (tg + 1u) * nx) xb_add(&bar[XB_TOPGEN], 1u);
            else XB_SPIN(xb_ld(&bar[XB_TOPGEN]) == tg, bar);
            __builtin_amdgcn_fence(__ATOMIC_ACQUIRE, "agent");
            xb_add(&bar[XB_XGEN(b.x)], 1u);
            asm volatile("s_waitcnt vmcnt(0)" ::: "memory");
        } else {
            XB_SPIN(xb_ld(&bar[XB_XGEN(b.x)]) == gen, bar);
            __builtin_amdgcn_fence(__ATOMIC_ACQUIRE, "agent");
            asm volatile("s_waitcnt vmcnt(0)" ::: "memory");
        }
    }
    __syncthreads();
}

struct Args { const float* in[23]; float* out; unsigned char* ws; int ph_lo, ph_hi, li, pad; };
#define CAS __attribute__((address_space(4)))
typedef const CAS Args& ArgsRef;
enum { I_X = 0, I_NORM1G, I_WIN, I_POOLW, I_POOLSC, I_CONVW, I_CONVB, I_WA, I_BA, I_WX, I_BX, I_LAM, I_QG, I_KG, I_OG, I_WOUT, I_NORM2G, I_WR, I_BR, I_WGU, I_BGU, I_WD, I_BD };

__device__ __forceinline__ void tr_item(const float* W, int K, int N, bf16* WT, const float* gk, int mode, LAS float* scr, int item, int lane) {
    const int nblk = N / 32, kb = item / nblk, nb = item % nblk, k0 = 64 * kb, n0 = 32 * nb;
#pragma unroll 8
    for (int i = 0; i < 32; ++i) { const int kk = 2 * i + (lane >> 5); float v = W[(size_t)(k0 + kk) * N + n0 + (lane & 31)]; if (gk) v *= gk[k0 + kk]; scr[kk * 33 + (lane & 31)] = v; }
    LDS_WAIT(); asm volatile("" ::: "memory");
    const int c = lane & 7;
#pragma unroll
    for (int j = 0; j < 4; ++j) { const int n = (lane >> 3) + 8 * j; const LAS float* s = scr + (8 * c) * 33 + n;
        u32x4 o; o.x = cvt_pk_bf16(s[0 * 33], s[1 * 33]); o.y = cvt_pk_bf16(s[2 * 33], s[3 * 33]); o.z = cvt_pk_bf16(s[4 * 33], s[5 * 33]); o.w = cvt_pk_bf16(s[6 * 33], s[7 * 33]);
        int dn = n0 + n;
        if (mode == 1) { const int jj = dn & 255; dn = (jj >> 7) * 256 + (dn >> 8) * 128 + (jj & 127); }
        *(u32x4*)(WT + (size_t)dn * K + k0 + 8 * c) = o; }
    LDS_WAIT(); asm volatile("" ::: "memory");
}
__device__ __forceinline__ void cvt_row(const float* xrow, bf16* orow, float* ssq, int lane) {
    const f32x4* xr = (const f32x4*)xrow + lane;
    f32x4 v[4]; float s = 0.f;
#pragma unroll
    for (int j = 0; j < 4; ++j) { v[j] = xr[64 * j]; s += (v[j].x * v[j].x + v[j].y * v[j].y) + (v[j].z * v[j].z + v[j].w * v[j].w); }
    s = wave_sum(s);
    u32x2* o8 = (u32x2*)orow + lane;
#pragma unroll
    for (int j = 0; j < 4; ++j) { u32x2 w; w.x = cvt_pk_bf16(v[j].x, v[j].y); w.y = cvt_pk_bf16(v[j].z, v[j].w); o8[64 * j] = w; }
    if (lane == 0) *ssq = s;
}
__device__ __forceinline__ void phase_prologue(ArgsRef a, LAS unsigned char* lds) {
    int tid_ = threadIdx.x; asm volatile("" : "+v"(tid_)); const int tid = tid_, lane = tid & 63, wave = tid >> 6;
    LAS float* scr = (LAS float*)(lds + wave * 16384);
    const int gw = blockIdx.x * NWAVES + wave, NGW = gridDim.x * NWAVES;
    unsigned char* ws = a.ws;
    constexpr int I_IN = 16 * 72, I_OUT = 16 * 32, I_R = 16, I_GU = 16 * 16, I_D = 4 * 32, I_S = 2;
    constexpr int PER_LAYER = I_IN + I_OUT + I_R + NEXP * I_GU + NEXP * I_D + 12 * I_S;
    for (int it = gw; it < 2 * PER_LAYER; it += NGW) {
        const int l = it / PER_LAYER; int r = it % PER_LAYER;
        if (r < I_IN) { tr_item(a.in[I_WIN] + (size_t)l * DM * NIN, DM, NIN, (bf16*)(ws + WS_WIN) + (size_t)l * NIN * DM, a.in[I_NORM1G] + l * DM, 0, scr, r, lane); continue; } r -= I_IN;
        if (r < I_OUT) { tr_item(a.in[I_WOUT] + (size_t)l * DM * DM, DM, DM, (bf16*)(ws + WS_WOUT) + (size_t)l * DM * DM, a.in[I_OG] + l * DM, 0, scr, r, lane); continue; } r -= I_OUT;
        if (r < I_R) { tr_item(a.in[I_WR] + (size_t)l * DM * NEXP, DM, NEXP, (bf16*)(ws + WS_SMALL) + SM_WR + (size_t)l * NEXP * DM, a.in[I_NORM2G] + l * DM, 0, scr, r, lane); continue; } r -= I_R;
        if (r < NEXP * I_GU) { const int e = r / I_GU; tr_item(a.in[I_WGU] + (size_t)(l * NEXP + e) * DM * 512, DM, 512, (bf16*)(ws + WS_WGU) + (size_t)(l * NEXP + e) * 512 * DM, a.in[I_NORM2G] + l * DM, 1, scr, r % I_GU, lane); continue; } r -= NEXP * I_GU;
        if (r < NEXP * I_D) { const int e = r / I_D; tr_item(a.in[I_WD] + (size_t)(l * NEXP + e) * EFF * DM, EFF, DM, (bf16*)(ws + WS_WD) + (size_t)(l * NEXP + e) * DM * EFF, nullptr, 0, scr, r % I_D, lane); continue; } r -= NEXP * I_D;
        { const int which = r / (4 * I_S), g = (r / I_S) % 4, sub = r % I_S;
          const float* src = a.in[which == 0 ? I_POOLW : (which == 1 ? I_WA : I_WX)] + (size_t)(l * 4 + g) * 4096;
          bf16* dst = (bf16*)(ws + WS_SMALL) + (which == 0 ? SM_POOLW : (which == 1 ? SM_WA : SM_WX)) + (size_t)(l * 4 + g) * 4096;
          tr_item(src, 64, 64, dst, nullptr, 0, scr, sub, lane); }
    }
    { float* ct = (float*)(ws + WS_ROPE); float* st = ct + SEQ * 32;
      for (int idx = blockIdx.x * NTHR + tid; idx < SEQ * 32; idx += gridDim.x * NTHR) {
          const int pos = idx >> 5, i = idx & 31;
          const float inv = __builtin_amdgcn_exp2f(-(float)i * 0.41524101186092029f);
          const float ang = (float)pos * inv;
          const double rev = (double)ang * 0.15915494309189535; const double fr = rev - __builtin_rint(rev);
          const float f = (float)fr;
          ct[idx] = __builtin_amdgcn_cosf(f); st[idx] = __builtin_amdgcn_sinf(f); } }
    for (int m = gw; m < NT; m += NGW) cvt_row(a.in[I_X] + (size_t)m * DM, (bf16*)(ws + WS_XB) + (size_t)m * DM, (float*)(ws + WS_SSQ) + m, lane);
}

struct EpiIn {
    static constexpr bool PERM = true;
    bf16* O; const float* ssq;
    __device__ __forceinline__ void operator()(const f32x4 (&acc)[2][2][4][2], const pg8::Unit& u, int wr, int wc, int fr, int fq) const {
        const int row0 = u.pm * 256 + wr * 64 + fr, col0 = u.pn * 256 + wc * 32 + 8 * fq;
#pragma unroll
        for (int ai = 0; ai < 2; ++ai)
#pragma unroll
            for (int m = 0; m < 4; ++m) { const int row = row0 + ai * 128 + m * 16; const float rs = __builtin_amdgcn_rsqf(ssq[row] * (1.0f / DM) + EPS);
                bf16* rowp = O + (size_t)row * NIN + col0;
#pragma unroll
                for (int bj = 0; bj < 2; ++bj) { const f32x4 v0 = acc[ai][bj][m][0] * rs, v1 = acc[ai][bj][m][1] * rs;
                    u32x4 w; w.x = cvt_pk_bf16(v0[0], v0[1]); w.y = cvt_pk_bf16(v0[2], v0[3]); w.z = cvt_pk_bf16(v1[0], v1[1]); w.w = cvt_pk_bf16(v1[2], v1[3]);
                    *(u32x4*)(rowp + bj * 128) = w; } }
    }
};
struct EpiOut {
    static constexpr bool PERM = false;
    const float* xin; float* out; bf16* xb; float* ssqp;
    __device__ __forceinline__ void operator()(const f32x4 (&acc)[2][2][4][2], const pg8::Unit& u, int wr, int wc, int fr, int fq) const {
        const int row0 = u.pm * 256 + wr * 64 + fr, col0 = u.pn * 256 + wc * 32 + 4 * fq;
#pragma unroll
        for (int ai = 0; ai < 2; ++ai)
#pragma unroll
            for (int m = 0; m < 4; ++m) { const int row = row0 + ai * 128 + m * 16; const size_t off = (size_t)row * DM + col0; float s = 0.f;
#pragma unroll
                for (int bj = 0; bj < 2; ++bj)
#pragma unroll
                    for (int n = 0; n < 2; ++n) { const f32x4 o = *(const f32x4*)(xin + off + bj * 128 + n * 16) + acc[ai][bj][m][n];
                        *(f32x4*)(out + off + bj * 128 + n * 16) = o; s += (o[0] * o[0] + o[1] * o[1]) + (o[2] * o[2] + o[3] * o[3]);
                        u32x2 w; w.x = cvt_pk_bf16(o[0], o[1]); w.y = cvt_pk_bf16(o[2], o[3]); *(u32x2*)(xb + off + bj * 128 + n * 16) = w; }
                s += __shfl_xor(s, 16); s += __shfl_xor(s, 32);
                if (fq == 0) ssqp[(size_t)row * 16 + u.pn * 4 + wc] = s; }
    }
};

struct MoeOrder {
    const LAS int* tab; int npn, G, c; const int* list; int mode;
    __device__ __forceinline__ bool next(int i, pg8::Unit& u) const {
        const int L = i * G + c; const int total = __builtin_amdgcn_readfirstlane(tab[64]) * npn; if (L >= total) return false;
        const int gb = L / npn; u.pn = L % npn; int e = 0;
        for (int k = 1; k < NEXP; ++k) { if (__builtin_amdgcn_readfirstlane(tab[32 + k]) <= gb) e = k; }
        u.e = e; u.pm = gb; u.aux = gb - __builtin_amdgcn_readfirstlane(tab[32 + e]); return true;
    }
    __device__ __forceinline__ unsigned a_voff(const pg8::Unit& u, int R, int C) const {
        if (mode == 0) { const int pos = u.aux * 256 + R; const int ne = tab[u.e]; int tok = 0; if (pos < ne) tok = list[u.e * NT + pos] >> 2; return (unsigned)(tok * DM + C) * 2u; }
        return (unsigned)((u.pm * 256 + R) * EFF + C) * 2u;
    }
    __device__ __forceinline__ size_t b_off(const pg8::Unit& u) const {
        if (mode == 0) return ((size_t)u.e * 512 + (size_t)u.pn * 256) * DM * 2;
        return ((size_t)u.e * DM + (size_t)u.pn * 256) * EFF * 2;
    }
};
struct EpiGU {
    static constexpr bool PERM = true;
    bf16* act; const float* lrstd; const float* bgu;
    __device__ __forceinline__ void operator()(const f32x4 (&acc)[2][2][4][2], const pg8::Unit& u, int wr, int wc, int fr, int fq) const {
        const int r0 = wr * 64 + fr, cl0 = wc * 32 + 8 * fq;
        const float* bg = bgu + u.e * 512 + u.pn * 128 + cl0;
        const f32x4 bg0 = *(const f32x4*)(bg), bg1 = *(const f32x4*)(bg + 4), bu0 = *(const f32x4*)(bg + 256), bu1 = *(const f32x4*)(bg + 260);
#pragma unroll
        for (int ai = 0; ai < 2; ++ai)
#pragma unroll
            for (int m = 0; m < 4; ++m) { const int r = r0 + ai * 128 + m * 16; const float rs = lrstd[(size_t)u.e * NT + u.aux * 256 + r];
                f32x4 g0 = acc[ai][0][m][0] * rs + bg0, g1 = acc[ai][0][m][1] * rs + bg1, u0 = acc[ai][1][m][0] * rs + bu0, u1 = acc[ai][1][m][1] * rs + bu1;
                float o[8];
#pragma unroll
                for (int j = 0; j < 4; ++j) { const float ga = fminf(g0[j], 7.0f), ua = fminf(fmaxf(u0[j], -7.0f), 7.0f); o[j] = (ua + 1.0f) * ga * fast_sigmoid(1.702f * ga);
                                              const float gb = fminf(g1[j], 7.0f), ub = fminf(fmaxf(u1[j], -7.0f), 7.0f); o[4 + j] = (ub + 1.0f) * gb * fast_sigmoid(1.702f * gb); }
                u32x4 w; w.x = cvt_pk_bf16(o[0], o[1]); w.y = cvt_pk_bf16(o[2], o[3]); w.z = cvt_pk_bf16(o[4], o[5]); w.w = cvt_pk_bf16(o[6], o[7]);
                *(u32x4*)(act + (size_t)(u.pm * 256 + r) * EFF + u.pn * 128 + cl0) = w; }
    }
};
struct EpiDown {
    static constexpr bool PERM = true;
    bf16* y; const int* list; const float* lgate; const float* bd; const LAS int* tab;
    __device__ __forceinline__ void operator()(const f32x4 (&acc)[2][2][4][2], const pg8::Unit& u, int wr, int wc, int fr, int fq) const {
        const int r0 = wr * 64 + fr, col0 = u.pn * 256 + wc * 32 + 8 * fq; const int ne = tab[u.e];
        const float* bp = bd + u.e * DM + col0;
#pragma unroll
        for (int ai = 0; ai < 2; ++ai)
#pragma unroll
            for (int m = 0; m < 4; ++m) { const int pos = u.aux * 256 + r0 + ai * 128 + m * 16;
                asm volatile("" ::: "memory");
                if (pos < ne) { const int asg = list[(size_t)u.e * NT + pos]; const float gt = lgate[(size_t)u.e * NT + pos]; bf16* rowp = y + (size_t)asg * DM + col0;
#pragma unroll
                    for (int bj = 0; bj < 2; ++bj) { const f32x4 b0 = *(const f32x4*)(bp + bj * 128), b1 = *(const f32x4*)(bp + bj * 128 + 4);
                        const f32x4 v0 = (acc[ai][bj][m][0] + b0) * gt, v1 = (acc[ai][bj][m][1] + b1) * gt;
                        u32x4 w; w.x = cvt_pk_bf16(v0[0], v0[1]); w.y = cvt_pk_bf16(v0[2], v0[3]); w.z = cvt_pk_bf16(v1[0], v1[1]); w.w = cvt_pk_bf16(v1[2], v1[3]);
                        *(u32x4*)(rowp + bj * 128) = w; } } }
    }
};
__device__ __forceinline__ void moe_tables(LAS int* tab, const unsigned* cnt) {
    __syncthreads();
    int tid_ = threadIdx.x; asm volatile("" : "+v"(tid_));
    if (tid_ == 0) { int pre = 0;
        for (int e = 0; e < NEXP; ++e) { const int n = (int)__hip_atomic_load(cnt + e, RLX_AGENT); tab[e] = n; tab[32 + e] = pre; pre += (n + 255) >> 8; }
        tab[64] = pre; }
    __syncthreads();
}

__device__ __forceinline__ void phase_qkprep(ArgsRef a, int layer) {
    int tid_ = threadIdx.x; asm volatile("" : "+v"(tid_)); const int tid = tid_, lane = tid & 63, wave = tid >> 6;
    const int gw = blockIdx.x * NWAVES + wave, NGW = gridDim.x * NWAVES;
    bf16* proj = (bf16*)(a.ws + WS_PROJ);
    const float* ct = (const float*)(a.ws + WS_ROPE); const float* st = ct + SEQ * 32;
    const int d0 = (lane & 7) * 8, p0 = d0 & 31;
    float gq[8], gk[8];
#pragma unroll
    for (int j = 0; j < 8; ++j) { gq[j] = a.in[I_QG][layer * 64 + d0 + j] * (0.125f * 1.4426950408889634f); gk[j] = a.in[I_KG][layer * 64 + d0 + j]; }
    const bool second = (lane & 4) != 0;
    for (int t = gw; t < NT; t += NGW) {
        const int pos = t & (SEQ - 1);
        float c[8], s[8];
        { const f32x4 c0 = *(const f32x4*)(ct + pos * 32 + p0), c1 = *(const f32x4*)(ct + pos * 32 + p0 + 4), s0 = *(const f32x4*)(st + pos * 32 + p0), s1 = *(const f32x4*)(st + pos * 32 + p0 + 4);
#pragma unroll
          for (int j = 0; j < 4; ++j) { c[j] = c0[j]; c[4 + j] = c1[j]; s[j] = s0[j]; s[4 + j] = s1[j]; } }
#pragma unroll
        for (int i = 0; i < 2; ++i) {
            bf16* p = proj + (size_t)t * NIN + C_Q + i * 512 + lane * 8;
            const u32x4 w = *(const u32x4*)p;
            float x[8]; x[0] = bflo(w.x); x[1] = bfhi(w.x); x[2] = bflo(w.y); x[3] = bfhi(w.y); x[4] = bflo(w.z); x[5] = bfhi(w.z); x[6] = bflo(w.w); x[7] = bfhi(w.w);
            float ss = 0.f;
#pragma unroll
            for (int j = 0; j < 8; ++j) ss += x[j] * x[j];
            ss += __shfl_xor(ss, 1); ss += __shfl_xor(ss, 2); ss += __shfl_xor(ss, 4);
            const float rs = __builtin_amdgcn_rsqf(ss * (1.0f / 64.0f) + EPS);
            float o[8];
#pragma unroll
            for (int j = 0; j < 8; ++j) { const float yv = x[j] * rs * (i == 0 ? gq[j] : gk[j]); const float pv = __shfl_xor(yv, 4);
                o[j] = second ? (yv * c[j] + pv * s[j]) : (yv * c[j] - pv * s[j]); }
            u32x4 r; r.x = cvt_pk_bf16(o[0], o[1]); r.y = cvt_pk_bf16(o[2], o[3]); r.z = cvt_pk_bf16(o[4], o[5]); r.w = cvt_pk_bf16(o[6], o[7]);
            *(u32x4*)p = r;
        }
    }
}

__device__ __forceinline__ void phase_pool(ArgsRef a, LAS unsigned char* lds, int layer) {
    int tid_ = threadIdx.x; asm volatile("" : "+v"(tid_)); const int tid = tid_, lane = tid & 63, wave = __builtin_amdgcn_readfirstlane(tid >> 6);
    const bf16* proj = (const bf16*)(a.ws + WS_PROJ); bf16* mix = (bf16*)(a.ws + WS_MIX);
    const bf16* pw = (const bf16*)(a.ws + WS_SMALL) + SM_POOLW + (size_t)layer * 4 * 4096;
    const float* psc = a.in[I_POOLSC] + layer * 256;
    LAS float* U = (LAS float*)lds;
    LAS bf16* PA = (LAS bf16*)(lds + 81920);
    LAS float* SS = (LAS float*)(lds + 116736);
    constexpr int PAS = 264;
    for (int unit = blockIdx.x; unit < NT / 64; unit += gridDim.x) {
        const int t0 = unit * 64, s0 = t0 & (SEQ - 1);
        __syncthreads();
        for (int ch = tid; ch < 79 * 32; ch += NTHR) { const int r = ch >> 5, c8 = (ch & 31) * 8; const int srow = s0 - 15 + r;
            f32x4 lo = {0.f, 0.f, 0.f, 0.f}, hi = {0.f, 0.f, 0.f, 0.f};
            if (srow >= 0) { const u32x4 w = *(const u32x4*)(proj + (size_t)(t0 - 15 + r) * NIN + C_POOL + c8); lo = (f32x4){bflo(w.x), bfhi(w.x), bflo(w.y), bfhi(w.y)}; hi = (f32x4){bflo(w.z), bfhi(w.z), bflo(w.w), bfhi(w.w)}; }
            *(LAS f32x4*)(U + r * 256 + c8) = lo; *(LAS f32x4*)(U + r * 256 + c8 + 4) = hi; }
        __syncthreads();
        { const int c = tid & 255, tl0 = (tid >> 8) * 32, w = 2 << (c >> 6);
          float sum = 0.f;
          for (int j = 1; j < w; ++j) sum += U[(15 + tl0 - j) * 256 + c];
          for (int tl = tl0; tl < tl0 + 32; ++tl) { const float cur = U[(15 + tl) * 256 + c]; sum += cur;
              const int cnt = min(w, s0 + tl + 1); const float pooled = sum / (float)cnt - cur;
              PA[tl * PAS + c] = f2bf(pooled); sum -= U[(15 + tl - w + 1) * 256 + c]; } }
        __syncthreads();
        const int g = wave & 3, th = wave >> 2, lr = lane & 15, lq = lane >> 4;
        f32x4 acc[2][4];
#pragma unroll
        for (int rt = 0; rt < 2; ++rt)
#pragma unroll
            for (int et = 0; et < 4; ++et) acc[rt][et] = (f32x4){0.f, 0.f, 0.f, 0.f};
#pragma unroll
        for (int ks = 0; ks < 2; ++ks) { bf16x8 af[2], bfr[4];
#pragma unroll
            for (int rt = 0; rt < 2; ++rt) af[rt] = *(const LAS bf16x8*)(PA + (th * 32 + rt * 16 + lr) * PAS + g * 64 + ks * 32 + lq * 8);
#pragma unroll
            for (int et = 0; et < 4; ++et) bfr[et] = *(const bf16x8*)(pw + (size_t)g * 4096 + (et * 16 + lr) * 64 + ks * 32 + lq * 8);
#pragma unroll
            for (int rt = 0; rt < 2; ++rt)
#pragma unroll
                for (int et = 0; et < 4; ++et) acc[rt][et] = __builtin_amdgcn_mfma_f32_16x16x32_bf16(af[rt], bfr[et], acc[rt][et], 0, 0, 0); }
#pragma unroll
        for (int et = 0; et < 4; ++et) { const float sc = psc[g * 64 + et * 16 + lr];
#pragma unroll
            for (int rt = 0; rt < 2; ++rt) acc[rt][et] = acc[rt][et] * sc; }
#pragma unroll
        for (int rt = 0; rt < 2; ++rt)
#pragma unroll
            for (int reg = 0; reg < 4; ++reg) { float s = 0.f;
#pragma unroll
                for (int et = 0; et < 4; ++et) s += acc[rt][et][reg] * acc[rt][et][reg];
                s += __shfl_xor(s, 1); s += __shfl_xor(s, 2); s += __shfl_xor(s, 4); s += __shfl_xor(s, 8);
                if (lr == 0) SS[(th * 32 + rt * 16 + lq * 4 + reg) * 4 + g] = s; }
        __syncthreads();
#pragma unroll
        for (int rt = 0; rt < 2; ++rt)
#pragma unroll
            for (int reg = 0; reg < 4; ++reg) { const int tl = th * 32 + rt * 16 + lq * 4 + reg; const LAS float* sp = SS + tl * 4;
                const float rs = __builtin_amdgcn_rsqf(((sp[0] + sp[1]) + (sp[2] + sp[3])) * (1.0f / 256.0f) + EPS);
#pragma unroll
                for (int et = 0; et < 4; ++et) mix[(size_t)(t0 + tl) * DM + g * 64 + et * 16 + lr] = f2bf(acc[rt][et][reg] * rs); }
    }
}

__device__ __forceinline__ void phase_lru_a(ArgsRef a, LAS unsigned char* lds, int layer) {
    int tid_ = threadIdx.x; asm volatile("" : "+v"(tid_)); const int tid = tid_, lane = tid & 63, wave = __builtin_amdgcn_readfirstlane(tid >> 6);
    const bf16* proj = (const bf16*)(a.ws + WS_PROJ);
    const bf16* wa = (const bf16*)(a.ws + WS_SMALL) + SM_WA + (size_t)layer * 4 * 4096;
    const bf16* wx = (const bf16*)(a.ws + WS_SMALL) + SM_WX + (size_t)layer * 4 * 4096;
    bf16* HL = (bf16*)(a.ws + WS_HL); bf16* PL = (bf16*)(a.ws + WS_PL);
    float* AGGH = (float*)(a.ws + WS_AGGH); float* AGGP = (float*)(a.ws + WS_AGGP);
    LAS float* U = (LAS float*)lds;
    LAS bf16* XC = (LAS bf16*)(lds + 36864);
    LAS float* XF = (LAS float*)(lds + 54272);
    LAS float* AA = (LAS float*)(lds + 87040);
    constexpr int XS = 264;
    const int c = tid & 255;
    const float cw0 = a.in[I_CONVW][(layer * 4 + 0) * 256 + c], cw1 = a.in[I_CONVW][(layer * 4 + 1) * 256 + c], cw2 = a.in[I_CONVW][(layer * 4 + 2) * 256 + c], cw3 = a.in[I_CONVW][(layer * 4 + 3) * 256 + c];
    const float cb = a.in[I_CONVB][layer * 256 + c];
    for (int unit = blockIdx.x; unit < NT / LRU_CH; unit += gridDim.x) {
        const int t0 = unit * LRU_CH, s0 = t0 & (SEQ - 1);
        __syncthreads();
        for (int ch = tid; ch < 35 * 32; ch += NTHR) { const int r = ch >> 5, c8 = (ch & 31) * 8; const int srow = s0 - 3 + r;
            f32x4 lo = {0.f, 0.f, 0.f, 0.f}, hi = {0.f, 0.f, 0.f, 0.f};
            if (srow >= 0) { const u32x4 w = *(const u32x4*)(proj + (size_t)(t0 - 3 + r) * NIN + C_LRU + c8); lo = (f32x4){bflo(w.x), bfhi(w.x), bflo(w.y), bfhi(w.y)}; hi = (f32x4){bflo(w.z), bfhi(w.z), bflo(w.w), bfhi(w.w)}; }
            *(LAS f32x4*)(U + r * 256 + c8) = lo; *(LAS f32x4*)(U + r * 256 + c8 + 4) = hi; }
        __syncthreads();
        { const int tl0 = (tid >> 8) * 16;
          for (int tl = tl0; tl < tl0 + 16; ++tl) { const float xc = cb + cw0 * U[(tl + 0) * 256 + c] + cw1 * U[(tl + 1) * 256 + c] + cw2 * U[(tl + 2) * 256 + c] + cw3 * U[(tl + 3) * 256 + c];
              XF[tl * 256 + c] = xc; XC[tl * XS + c] = f2bf(xc); } }
        __syncthreads();
        { const int n = wave & 3, eh = wave >> 2, lr = lane & 15, lq = lane >> 4;
          f32x4 ca[2][2], cx[2][2];
#pragma unroll
          for (int rt = 0; rt < 2; ++rt)
#pragma unroll
              for (int et = 0; et < 2; ++et) { ca[rt][et] = (f32x4){0.f, 0.f, 0.f, 0.f}; cx[rt][et] = (f32x4){0.f, 0.f, 0.f, 0.f}; }
#pragma unroll
          for (int ks = 0; ks < 2; ++ks) { bf16x8 af[2], ba[2], bx[2];
#pragma unroll
              for (int rt = 0; rt < 2; ++rt) af[rt] = *(const LAS bf16x8*)(XC + (rt * 16 + lr) * XS + n * 64 + ks * 32 + lq * 8);
#pragma unroll
              for (int et = 0; et < 2; ++et) { const size_t wo = (size_t)n * 4096 + (eh * 32 + et * 16 + lr) * 64 + ks * 32 + lq * 8; ba[et] = *(const bf16x8*)(wa + wo); bx[et] = *(const bf16x8*)(wx + wo); }
#pragma unroll
              for (int rt = 0; rt < 2; ++rt)
#pragma unroll
                  for (int et = 0; et < 2; ++et) { ca[rt][et] = __builtin_amdgcn_mfma_f32_16x16x32_bf16(af[rt], ba[et], ca[rt][et], 0, 0, 0);
                                                   cx[rt][et] = __builtin_amdgcn_mfma_f32_16x16x32_bf16(af[rt], bx[et], cx[rt][et], 0, 0, 0); } }
#pragma unroll
          for (int et = 0; et < 2; ++et) { const int chn = n * 64 + eh * 32 + et * 16 + lr;
              const float bav = a.in[I_BA][layer * 256 + chn], bxv = a.in[I_BX][layer * 256 + chn], lam = a.in[I_LAM][layer * 256 + chn];
              const float sp = log1pf(expf(-lam));
#pragma unroll
              for (int rt = 0; rt < 2; ++rt)
#pragma unroll
                  for (int reg = 0; reg < 4; ++reg) { const int tl = rt * 16 + lq * 4 + reg;
                      const float r = fast_sigmoid(ca[rt][et][reg] + bav), ig = fast_sigmoid(cx[rt][et][reg] + bxv);
                      const float log_a = -8.0f * r * sp; const float av = fast_exp(log_a);
                      float mult = sqrtf(fmaxf(1.0f - fast_exp(2.0f * log_a), 0.f)); if (s0 + tl == 0) mult = 1.0f;
                      const float xc = XF[tl * 256 + chn];
                      AA[tl * 256 + chn] = av; XF[tl * 256 + chn] = mult * ig * xc; } } }
        __syncthreads();
        if (tid < 256) { float h = 0.f, P = 1.f;
            for (int tl = 0; tl < LRU_CH; ++tl) { const float av = AA[tl * 256 + c], bv = XF[tl * 256 + c]; h = av * h + bv; P *= av;
                HL[(size_t)(t0 + tl) * 256 + c] = f2bf(h); PL[(size_t)(t0 + tl) * 256 + c] = f2bf(P); }
            AGGH[(size_t)unit * 256 + c] = h; AGGP[(size_t)unit * 256 + c] = P; }
    }
}
__device__ __forceinline__ void phase_lru_b(ArgsRef a) {
    const float* AGGH = (const float*)(a.ws + WS_AGGH); const float* AGGP = (const float*)(a.ws + WS_AGGP); float* CARRY = (float*)(a.ws + WS_CARRY);
    int tid_ = threadIdx.x; asm volatile("" : "+v"(tid_));
    for (int idx = blockIdx.x * NTHR + tid_; idx < NB * 256; idx += gridDim.x * NTHR) { const int b = idx >> 8, c = idx & 255; float carry = 0.f;
        for (int k = 0; k < LRU_NCH; ++k) { const size_t o = (size_t)(b * LRU_NCH + k) * 256 + c; CARRY[o] = carry; carry = AGGP[o] * carry + AGGH[o]; } }
}
__device__ __forceinline__ void phase_lru_c(ArgsRef a) {
    int tid_ = threadIdx.x; asm volatile("" : "+v"(tid_)); const int tid = tid_, lane = tid & 63, wave = tid >> 6;
    const int gw = blockIdx.x * NWAVES + wave, NGW = gridDim.x * NWAVES;
    const bf16* proj = (const bf16*)(a.ws + WS_PROJ); bf16* mix = (bf16*)(a.ws + WS_MIX);
    const bf16* HL = (const bf16*)(a.ws + WS_HL); const bf16* PL = (const bf16*)(a.ws + WS_PL); const float* CARRY = (const float*)(a.ws + WS_CARRY);
    for (int t = gw; t < NT; t += NGW) {
        const u32x2 hw = *(const u32x2*)(HL + (size_t)t * 256 + lane * 4), pw = *(const u32x2*)(PL + (size_t)t * 256 + lane * 4), gwd = *(const u32x2*)(proj + (size_t)t * NIN + C_GATE + lane * 4);
        const f32x4 cr = *(const f32x4*)(CARRY + (size_t)(t / LRU_CH) * 256 + lane * 4);
        float h[4] = {bflo(hw.x) + bflo(pw.x) * cr[0], bfhi(hw.x) + bfhi(pw.x) * cr[1], bflo(hw.y) + bflo(pw.y) * cr[2], bfhi(hw.y) + bfhi(pw.y) * cr[3]};
        const float gt[4] = {bflo(gwd.x), bfhi(gwd.x), bflo(gwd.y), bfhi(gwd.y)};
        float s = 0.f;
#pragma unroll
        for (int j = 0; j < 4; ++j) { h[j] *= gelu_tanh(gt[j]); s += h[j] * h[j]; }
        s = wave_sum(s); const float rs = __builtin_amdgcn_rsqf(s * (1.0f / 256.0f) + EPS);
        u32x2 o; o.x = cvt_pk_bf16(h[0] * rs, h[1] * rs); o.y = cvt_pk_bf16(h[2] * rs, h[3] * rs);
        *(u32x2*)(mix + (size_t)t * DM + 256 + lane * 4) = o;
    }
}

__device__ __forceinline__ void phase_attn(ArgsRef a, LAS unsigned char* lds) {
    int tid_ = threadIdx.x; asm volatile("" : "+v"(tid_)); const int tid = tid_, lane = tid & 63, wave = __builtin_amdgcn_readfirstlane(tid >> 6);
    const bf16* proj = (const bf16*)(a.ws + WS_PROJ);
    bf16* PNUM = (bf16*)(a.ws + WS_PNUM); float* PDEN = (float*)(a.ws + WS_PDEN); float* PMAX = (float*)(a.ws + WS_PMAX);
    constexpr int KS = 72, VS = 280, PS = 168;
    LAS bf16* Ks = (LAS bf16*)lds;
    LAS bf16* Vt = (LAS bf16*)(lds + 36864);
    LAS bf16* Pw = (LAS bf16*)(lds + 73728) + wave * 16 * PS;
    const int lr = lane & 15, lq = lane >> 4;
    constexpr int NUNITS = NB * 8 * 3 * 32;
    for (int unit = blockIdx.x; unit < NUNITS; unit += gridDim.x) {
        const int blk = unit & 31, g = (unit >> 5) % 3, h = (unit / 96) & 7, b = unit / 768;
        const int dl = (g == 0) ? 1 : (g == 1 ? 4 : 16), nb = 32 / dl;
        const int n = blk % nb, r = blk / nb;
        const size_t rowb = (size_t)b * SEQ;
        __syncthreads();
        for (int ch = tid; ch < 256 * 8; ch += NTHR) { const int j = ch >> 3, d8 = (ch & 7) * 8; const int l = 128 * (n - 1) + j;
            u32x4 kw = {0u, 0u, 0u, 0u}, vw = {0u, 0u, 0u, 0u};
            if (l >= 0) { const size_t row = rowb + (size_t)l * dl + r; kw = *(const u32x4*)(proj + row * NIN + C_K + h * 64 + d8); vw = *(const u32x4*)(proj + row * NIN + C_V + h * 64 + d8); }
            *(LAS u32x2*)(Ks + j * KS + d8) = (u32x2){kw.x, kw.y}; *(LAS u32x2*)(Ks + j * KS + d8 + 4) = (u32x2){kw.z, kw.w};
            Vt[(d8 + 0) * VS + j] = (bf16)(vw.x & 0xffffu); Vt[(d8 + 1) * VS + j] = (bf16)(vw.x >> 16); Vt[(d8 + 2) * VS + j] = (bf16)(vw.y & 0xffffu); Vt[(d8 + 3) * VS + j] = (bf16)(vw.y >> 16);
            Vt[(d8 + 4) * VS + j] = (bf16)(vw.z & 0xffffu); Vt[(d8 + 5) * VS + j] = (bf16)(vw.z >> 16); Vt[(d8 + 6) * VS + j] = (bf16)(vw.w & 0xffffu); Vt[(d8 + 7) * VS + j] = (bf16)(vw.w >> 16); }
        for (int ch = tid; ch < 64 * 24; ch += NTHR) { const int d = ch / 24, j = 256 + ch % 24; Vt[d * VS + j] = 0; }
        __syncthreads();
        const int qi0 = 16 * wave;
        bf16x8 qf[2];
        { const size_t qrow = rowb + (size_t)(128 * n + qi0 + lr) * dl + r;
#pragma unroll
          for (int ks = 0; ks < 2; ++ks) qf[ks] = *(const bf16x8*)(proj + qrow * NIN + C_Q + h * 64 + ks * 32 + lq * 8); }
        f32x4 sc[9];
#pragma unroll
        for (int kt = 0; kt < 9; ++kt) { sc[kt] = (f32x4){0.f, 0.f, 0.f, 0.f};
#pragma unroll
            for (int ks = 0; ks < 2; ++ks) { const bf16x8 kf = *(const LAS bf16x8*)(Ks + (qi0 + kt * 16 + lr) * KS + ks * 32 + lq * 8);
                sc[kt] = __builtin_amdgcn_mfma_f32_16x16x32_bf16(qf[ks], kf, sc[kt], 0, 0, 0); } }
        float mx[4] = {-1e30f, -1e30f, -1e30f, -1e30f};
#pragma unroll
        for (int kt = 0; kt < 9; ++kt)
#pragma unroll
            for (int reg = 0; reg < 4; ++reg) { const int dist = 128 + lq * 4 + reg - kt * 16 - lr; const int kj = qi0 + kt * 16 + lr;
                const bool ok = (dist >= 0) && (dist <= 128) && (n > 0 || kj >= 128);
                const float v = ok ? sc[kt][reg] : -1e30f; sc[kt][reg] = v; mx[reg] = fmaxf(mx[reg], v); }
#pragma unroll
        for (int reg = 0; reg < 4; ++reg) { float m = mx[reg]; m = fmaxf(m, __shfl_xor(m, 1)); m = fmaxf(m, __shfl_xor(m, 2)); m = fmaxf(m, __shfl_xor(m, 4)); m = fmaxf(m, __shfl_xor(m, 8)); mx[reg] = m; }
        float sm[4] = {0.f, 0.f, 0.f, 0.f};
#pragma unroll
        for (int kt = 0; kt < 9; ++kt)
#pragma unroll
            for (int reg = 0; reg < 4; ++reg) { const float v = sc[kt][reg]; const float p = (v > -1e29f) ? __builtin_amdgcn_exp2f(v - mx[reg]) : 0.f; sm[reg] += p;
                Pw[(lq * 4 + reg) * PS + kt * 16 + lr] = f2bf(p); }
#pragma unroll
        for (int reg = 0; reg < 4; ++reg) { Pw[(lq * 4 + reg) * PS + 144 + lr] = 0;
            float s = sm[reg]; s += __shfl_xor(s, 1); s += __shfl_xor(s, 2); s += __shfl_xor(s, 4); s += __shfl_xor(s, 8); sm[reg] = s; }
        LDS_WAIT(); asm volatile("" ::: "memory");
        f32x4 oc[4];
#pragma unroll
        for (int dt = 0; dt < 4; ++dt) oc[dt] = (f32x4){0.f, 0.f, 0.f, 0.f};
#pragma unroll
        for (int ks = 0; ks < 5; ++ks) { const bf16x8 pf = *(const LAS bf16x8*)(Pw + lr * PS + ks * 32 + lq * 8);
#pragma unroll
            for (int dt = 0; dt < 4; ++dt) { const bf16x8 vf = *(const LAS bf16x8*)(Vt + (dt * 16 + lr) * VS + qi0 + ks * 32 + lq * 8);
                oc[dt] = __builtin_amdgcn_mfma_f32_16x16x32_bf16(pf, vf, oc[dt], 0, 0, 0); } }
#pragma unroll
        for (int reg = 0; reg < 4; ++reg) { const size_t tok = rowb + (size_t)(128 * n + qi0 + lq * 4 + reg) * dl + r;
#pragma unroll
            for (int dt = 0; dt < 4; ++dt) PNUM[((size_t)g * NT + tok) * 512 + h * 64 + dt * 16 + lr] = f2bf(oc[dt][reg]);
            if (lr == 0) { PDEN[((size_t)g * NT + tok) * 8 + h] = sm[reg]; PMAX[((size_t)g * NT + tok) * 8 + h] = mx[reg]; } }
    }
}
__device__ __forceinline__ void phase_merge(ArgsRef a) {
    int tid_ = threadIdx.x; asm volatile("" : "+v"(tid_)); const int tid = tid_, lane = tid & 63, wave = tid >> 6;
    const int gw = blockIdx.x * NWAVES + wave, NGW = gridDim.x * NWAVES;
    const bf16* PNUM = (const bf16*)(a.ws + WS_PNUM); const float* PDEN = (const float*)(a.ws + WS_PDEN); const float* PMAX = (const float*)(a.ws + WS_PMAX);
    bf16* mix = (bf16*)(a.ws + WS_MIX);
    const int hd = lane >> 3;
    for (int t = gw; t < NT; t += NGW) {
        float m[3], dn[3]; u32x4 nw[3];
#pragma unroll
        for (int g = 0; g < 3; ++g) { m[g] = PMAX[((size_t)g * NT + t) * 8 + hd]; dn[g] = PDEN[((size_t)g * NT + t) * 8 + hd]; nw[g] = *(const u32x4*)(PNUM + ((size_t)g * NT + t) * 512 + lane * 8); }
        const float mr = fmaxf(fmaxf(m[0], m[1]), m[2]);
        float o[8] = {0.f, 0.f, 0.f, 0.f, 0.f, 0.f, 0.f, 0.f}; float den = 0.f;
#pragma unroll
        for (int g = 0; g < 3; ++g) { const float w = __builtin_amdgcn_exp2f(m[g] - mr); den += w * dn[g];
            o[0] += w * bflo(nw[g].x); o[1] += w * bfhi(nw[g].x); o[2] += w * bflo(nw[g].y); o[3] += w * bfhi(nw[g].y); o[4] += w * bflo(nw[g].z); o[5] += w * bfhi(nw[g].z); o[6] += w * bflo(nw[g].w); o[7] += w * bfhi(nw[g].w); }
        const float inv = 1.0f / den; float s = 0.f;
#pragma unroll
        for (int j = 0; j < 8; ++j) { o[j] *= inv; s += o[j] * o[j]; }
        s = wave_sum(s); const float rs = __builtin_amdgcn_rsqf(s * (1.0f / 512.0f) + EPS);
        u32x4 w; w.x = cvt_pk_bf16(o[0] * rs, o[1] * rs); w.y = cvt_pk_bf16(o[2] * rs, o[3] * rs); w.z = cvt_pk_bf16(o[4] * rs, o[5] * rs); w.w = cvt_pk_bf16(o[6] * rs, o[7] * rs);
        *(u32x4*)(mix + (size_t)t * DM + 512 + lane * 8) = w;
    }
}

__device__ __forceinline__ void phase_router(ArgsRef a, LAS unsigned char* lds, int layer) {
    int tid_ = threadIdx.x; asm volatile("" : "+v"(tid_)); const int tid = tid_, lane = tid & 63, wave = __builtin_amdgcn_readfirstlane(tid >> 6);
    const bf16* xb = (const bf16*)(a.ws + WS_XB); const bf16* wr = (const bf16*)(a.ws + WS_SMALL) + SM_WR + (size_t)layer * NEXP * DM;
    const float* ssqp = (const float*)(a.ws + WS_SSQP); const float* rbias = a.in[I_BR] + layer * NEXP;
    int* LIST = (int*)(a.ws + WS_LIST); float* LRSTD = (float*)(a.ws + WS_LRSTD); float* LGATE = (float*)(a.ws + WS_LGATE2);
    unsigned* cnt = (unsigned*)(a.ws + WS_CTL) + CW_CNT + layer * NEXP;
    LAS float* LG = (LAS float*)lds + wave * 32 * 33;
    LAS int* hist = (LAS int*)(lds + 65536);
    LAS int* base = (LAS int*)(lds + 65536 + 128);
    const int lr = lane & 15, lq = lane >> 4;
    for (int unit = blockIdx.x; unit < NT / 256; unit += gridDim.x) {
        const int tok0 = unit * 256 + wave * 32;
        __syncthreads();
        if (tid < 32) hist[tid] = 0;
        f32x4 acc[2][2];
#pragma unroll
        for (int rt = 0; rt < 2; ++rt)
#pragma unroll
            for (int et = 0; et < 2; ++et) acc[rt][et] = (f32x4){0.f, 0.f, 0.f, 0.f};
#pragma unroll 4
        for (int ks = 0; ks < 32; ++ks) { bf16x8 af[2], bfr[2];
#pragma unroll
            for (int rt = 0; rt < 2; ++rt) af[rt] = *(const bf16x8*)(xb + (size_t)(tok0 + rt * 16 + lr) * DM + ks * 32 + lq * 8);
#pragma unroll
            for (int et = 0; et < 2; ++et) bfr[et] = *(const bf16x8*)(wr + (size_t)(et * 16 + lr) * DM + ks * 32 + lq * 8);
#pragma unroll
            for (int rt = 0; rt < 2; ++rt)
#pragma unroll
                for (int et = 0; et < 2; ++et) acc[rt][et] = __builtin_amdgcn_mfma_f32_16x16x32_bf16(af[rt], bfr[et], acc[rt][et], 0, 0, 0); }
#pragma unroll
        for (int rt = 0; rt < 2; ++rt)
#pragma unroll
            for (int et = 0; et < 2; ++et)
#pragma unroll
                for (int reg = 0; reg < 4; ++reg) LG[(rt * 16 + lq * 4 + reg) * 33 + et * 16 + lr] = acc[rt][et][reg];
        __syncthreads();
        int te[4] = {0, 0, 0, 0}; float tg[4] = {0.f, 0.f, 0.f, 0.f}; int rk[4] = {0, 0, 0, 0}; float rstd = 0.f; const int tok = tok0 + lane;
        if (lane < 32) {
            const float* sp = ssqp + (size_t)tok * 16; float ss = 0.f;
#pragma unroll
            for (int j = 0; j < 16; ++j) ss += sp[j];
            rstd = __builtin_amdgcn_rsqf(ss * (1.0f / DM) + EPS);
            float tv[4] = {-3e38f, -3e38f, -3e38f, -3e38f};
            for (int e = 0; e < NEXP; ++e) { float v = LG[lane * 33 + e] * rstd + rbias[e]; int ve = e;
#pragma unroll
                for (int k = 0; k < 4; ++k) { if (v > tv[k]) { const float tvv = tv[k]; const int tee = te[k]; tv[k] = v; te[k] = ve; v = tvv; ve = tee; } } }
            float z = 0.f;
#pragma unroll
            for (int k = 0; k < 4; ++k) { tg[k] = fast_exp(tv[k] - tv[0]); z += tg[k]; }
            const float iz = 1.0f / z;
#pragma unroll
            for (int k = 0; k < 4; ++k) { tg[k] *= iz; rk[k] = __hip_atomic_fetch_add(&hist[te[k]], 1, __ATOMIC_RELAXED, __HIP_MEMORY_SCOPE_WORKGROUP); }
        }
        __syncthreads();
        if (tid < 32) base[tid] = (int)__hip_atomic_fetch_add(cnt + tid, (unsigned)hist[tid], RLX_AGENT);
        __syncthreads();
        if (lane < 32) {
#pragma unroll
            for (int k = 0; k < 4; ++k) { const size_t p = (size_t)te[k] * NT + base[te[k]] + rk[k]; LIST[p] = tok * 4 + k; LRSTD[p] = rstd; LGATE[p] = tg[k]; }
        }
    }
}

__device__ __forceinline__ void phase_combine(ArgsRef a, bool last_layer) {
    int tid_ = threadIdx.x; asm volatile("" : "+v"(tid_)); const int tid = tid_, lane = tid & 63, wave = tid >> 6;
    const int gw = blockIdx.x * NWAVES + wave, NGW = gridDim.x * NWAVES;
    const bf16* Y = (const bf16*)(a.ws + WS_Y); float* out = a.out; bf16* xb = (bf16*)(a.ws + WS_XB); float* ssq = (float*)(a.ws + WS_SSQ);
    for (int t = gw; t < NT; t += NGW) {
        f32x4 v[4]; float s = 0.f;
#pragma unroll
        for (int j = 0; j < 4; ++j) { v[j] = *((const f32x4*)(out + (size_t)t * DM) + lane + 64 * j);
#pragma unroll
            for (int k = 0; k < 4; ++k) { const u32x2 w = *((const u32x2*)(Y + ((size_t)t * 4 + k) * DM) + lane + 64 * j); v[j].x += bflo(w.x); v[j].y += bfhi(w.x); v[j].z += bflo(w.y); v[j].w += bfhi(w.y); }
            s += (v[j].x * v[j].x + v[j].y * v[j].y) + (v[j].z * v[j].z + v[j].w * v[j].w);
            *((f32x4*)(out + (size_t)t * DM) + lane + 64 * j) = v[j]; }
        if (!last_layer) { s = wave_sum(s);
#pragma unroll
            for (int j = 0; j < 4; ++j) { u32x2 w; w.x = cvt_pk_bf16(v[j].x, v[j].y); w.y = cvt_pk_bf16(v[j].z, v[j].w); *((u32x2*)(xb + (size_t)t * DM) + lane + 64 * j) = w; }
            if (lane == 0) ssq[t] = s; }
    }
}

constexpr int NPH_LAYER = 13, NPH = 1 + 2 * NPH_LAYER;
enum { PH_GEMM_IN = 0, PH_QKPREP, PH_POOL, PH_LRU_A, PH_LRU_B, PH_ATTN, PH_LRU_C, PH_MERGE, PH_GEMM_OUT, PH_ROUTER, PH_MOE_GU, PH_MOE_DOWN, PH_COMBINE };
#ifndef MK_STOP
#define MK_STOP NPH
#endif
#ifndef MK_SPLIT
#define MK_SPLIT 1
#endif

template <int PHMASK>
__global__ void __launch_bounds__(NTHR, 2) mega_fwd(Args args_by_value) {
    extern __shared__ __attribute__((aligned(16))) unsigned char lds_raw[];
    LAS unsigned char* lds = (LAS unsigned char*)lds_raw;
    const int tid = threadIdx.x;
    for (int u = tid; u < (LDS_BYTES - LDSCTL_OFF) / 4; u += NTHR) ((LAS unsigned*)(lds + LDSCTL_OFF))[u] = 0u;
    __syncthreads();
#define ARGS_HERE() const CAS Args* ap_ = (const CAS Args*)__builtin_amdgcn_kernarg_segment_ptr(); asm volatile("" : "+s"(ap_)); ArgsRef args = *ap_; unsigned char* const ws = args.ws; unsigned* const ctl = (unsigned*)(ws + WS_CTL); (void)ctl
    int lo, hi;
    { ARGS_HERE(); lo = args.ph_lo; hi = args.ph_hi; xcd_barrier_post(ctl + CW_BAR + args.li * XCD_BAR_WORDS, (volatile LAS unsigned*)(lds + MISC_OFF) + 8); }
#define EN(p) (((PHMASK) >> (p)) & 1)
#define IN(k) (lo <= (k) && (k) < hi)
#define SEAM(k) do { if (IN(k) && IN((k) + 1)) { ARGS_HERE(); XcdBarrier bar_; bar_.bar = ctl + CW_BAR + args.li * XCD_BAR_WORDS; bar_.x = xb_xcc_id(); bar_.st = (volatile LAS unsigned*)(lds + MISC_OFF) + 8; xcd_barrier(bar_); } } while (0)

    if (EN(13) && IN(0)) { ARGS_HERE(); phase_prologue(args, lds); }
    SEAM(0);
    for (int l = 0; l < 2; ++l) {
        const int pb = 1 + NPH_LAYER * l;
        if (EN(PH_GEMM_IN) && IN(pb + PH_GEMM_IN)) { ARGS_HERE();
            pg8::StaticOrder S; S.init(NT, NIN, DM, gridDim.x, blockIdx.x);
            EpiIn E{(bf16*)(ws + WS_PROJ), (const float*)(ws + WS_SSQ)};
            pg8::gemm_phase<EpiIn, pg8::StaticOrder, true>(lds, (const bf16*)(ws + WS_XB), (const bf16*)(ws + WS_WIN) + (size_t)l * NIN * DM, DM, S, E);
        }
        SEAM(pb + PH_GEMM_IN);
        if (EN(PH_QKPREP) && IN(pb + PH_QKPREP)) { ARGS_HERE(); phase_qkprep(args, l); }
        if (EN(PH_POOL) && IN(pb + PH_POOL)) { ARGS_HERE(); phase_pool(args, lds, l); }
        if (EN(PH_LRU_A) && IN(pb + PH_LRU_A)) { ARGS_HERE(); phase_lru_a(args, lds, l); }
        SEAM(pb + PH_LRU_A);
        if (EN(PH_LRU_B) && IN(pb + PH_LRU_B)) { ARGS_HERE(); phase_lru_b(args); }
        if (EN(PH_ATTN) && IN(pb + PH_ATTN)) { ARGS_HERE(); phase_attn(args, lds); }
        SEAM(pb + PH_ATTN);
        if (EN(PH_LRU_C) && IN(pb + PH_LRU_C)) { ARGS_HERE(); phase_lru_c(args); }
        if (EN(PH_MERGE) && IN(pb + PH_MERGE)) { ARGS_HERE(); phase_merge(args); }
        SEAM(pb + PH_MERGE);
        if (EN(PH_GEMM_OUT) && IN(pb + PH_GEMM_OUT)) { ARGS_HERE();
            __syncthreads();
            pg8::StaticOrder S; S.init(NT, DM, DM, gridDim.x, blockIdx.x);
            EpiOut E{l == 0 ? args.in[I_X] : (const float*)args.out, args.out, (bf16*)(ws + WS_XB), (float*)(ws + WS_SSQP)};
            pg8::gemm_phase<EpiOut, pg8::StaticOrder, true>(lds, (const bf16*)(ws + WS_MIX), (const bf16*)(ws + WS_WOUT) + (size_t)l * DM * DM, DM, S, E);
        }
        SEAM(pb + PH_GEMM_OUT);
        if (EN(PH_ROUTER) && IN(pb + PH_ROUTER)) { ARGS_HERE(); phase_router(args, lds, l); }
        SEAM(pb + PH_ROUTER);
        if (EN(PH_MOE_GU) && IN(pb + PH_MOE_GU)) { ARGS_HERE();
            LAS int* tab = (LAS int*)(lds + TAB_OFF);
            moe_tables(tab, ctl + CW_CNT + l * NEXP);
            MoeOrder S{tab, 2, (int)gridDim.x, (int)blockIdx.x, (const int*)(ws + WS_LIST), 0};
            EpiGU E{(bf16*)(ws + WS_ACT), (const float*)(ws + WS_LRSTD), args.in[I_BGU] + (size_t)l * NEXP * 512};
            pg8::gemm_phase<EpiGU, MoeOrder, true>(lds, (const bf16*)(ws + WS_XB), (const bf16*)(ws + WS_WGU) + (size_t)l * NEXP * 512 * DM, DM, S, E);
        }
        SEAM(pb + PH_MOE_GU);
        if (EN(PH_MOE_DOWN) && IN(pb + PH_MOE_DOWN)) { ARGS_HERE();
            LAS int* tab = (LAS int*)(lds + TAB_OFF);
            moe_tables(tab, ctl + CW_CNT + l * NEXP);
            MoeOrder S{tab, 4, (int)gridDim.x, (int)blockIdx.x, (const int*)(ws + WS_LIST), 1};
            EpiDown E{(bf16*)(ws + WS_Y), (const int*)(ws + WS_LIST), (const float*)(ws + WS_LGATE2), args.in[I_BD] + (size_t)l * NEXP * DM, tab};
            pg8::gemm_phase<EpiDown, MoeOrder, true>(lds, (const bf16*)(ws + WS_ACT), (const bf16*)(ws + WS_WD) + (size_t)l * NEXP * DM * EFF, EFF, S, E);
        }
        SEAM(pb + PH_MOE_DOWN);
        if (EN(PH_COMBINE) && IN(pb + PH_COMBINE)) { ARGS_HERE(); phase_combine(args, l == 1); }
        SEAM(pb + PH_COMBINE);
    }
#undef IN
#undef SEAM
}

typedef void (*kern_t)(Args);
template <int M> static kern_t kern_of() { return (kern_t)mega_fwd<M>; }
static kern_t phase_kernel(int p) {
    switch (p) { case 0: return kern_of<1 << 0>(); case 1: return kern_of<1 << 1>(); case 2: return kern_of<1 << 2>(); case 3: return kern_of<1 << 3>(); case 4: return kern_of<1 << 4>();
                 case 5: return kern_of<1 << 5>(); case 6: return kern_of<1 << 6>(); case 7: return kern_of<1 << 7>(); case 8: return kern_of<1 << 8>(); case 9: return kern_of<1 << 9>();
                 case 10: return kern_of<1 << 10>(); case 11: return kern_of<1 << 11>(); case 12: return kern_of<1 << 12>(); default: return kern_of<1 << 13>(); }
}
extern "C" void kernel_launch(void* const* d_in, const int* in_sizes, int n_in, void* d_out, int out_size, void* d_ws, size_t ws_size, hipStream_t stream) {
    static int grid = 0;
    if (grid == 0) {
        if (n_in != 23 || in_sizes[0] != NT * DM || out_size != NT * DM || ws_size < WS_END) {
            fprintf(stderr, "kernel_launch: built for 23 inputs, x/out of %d floats, >= %zu bytes of workspace; got n_in %d, in0 %d, out %d, ws %zu; nothing launched\n", NT * DM, (size_t)WS_END, n_in, n_in > 0 ? in_sizes[0] : -1, out_size, ws_size);
            grid = -1; return; }
        int dev = 0, cus = 0;
        if (hipGetDevice(&dev) != hipSuccess || hipDeviceGetAttribute(&cus, hipDeviceAttributeMultiprocessorCount, dev) != hipSuccess) { fprintf(stderr, "kernel_launch: device query failed\n"); grid = -1; return; }
#if MK_SPLIT
        for (int p = 0; p < 14; ++p) if (hipFuncSetAttribute((const void*)phase_kernel(p), hipFuncAttributeMaxDynamicSharedMemorySize, LDS_BYTES) != hipSuccess) { fprintf(stderr, "kernel_launch: hipFuncSetAttribute failed\n"); grid = -1; return; }
#else
        if (hipFuncSetAttribute((const void*)kern_of<0x3fff>(), hipFuncAttributeMaxDynamicSharedMemorySize, LDS_BYTES) != hipSuccess) { fprintf(stderr, "kernel_launch: hipFuncSetAttribute failed\n"); grid = -1; return; }
        int per_cu = 0;
        if (hipOccupancyMaxActiveBlocksPerMultiprocessor(&per_cu, (const void*)kern_of<0x3fff>(), NTHR, LDS_BYTES) != hipSuccess || per_cu < 1)
            fprintf(stderr, "kernel_launch: note: occupancy query reports %d workgroups per CU\n", per_cu);
#endif
        (void)hipGetLastError();
        grid = cus;
    }
    if (grid < 0) return;
    if (hipMemsetAsync((char*)d_ws + WS_CTL, 0, CTL_ZERO_BYTES, stream) != hipSuccess) { fprintf(stderr, "kernel_launch: hipMemsetAsync failed\n"); return; }
    Args a{};
    for (int i = 0; i < 23; ++i) a.in[i] = (const float*)d_in[i];
    a.out = (float*)d_out; a.ws = (unsigned char*)d_ws; a.pad = 0;
#if MK_SPLIT
#ifdef MK_SKIP
    (void)hipMemsetAsync((char*)d_ws + WS_MIX, 0, (size_t)NT * DM * 2, stream);
#endif
    for (int p = 0; p < MK_STOP; ++p) { a.ph_lo = p; a.ph_hi = p + 1; a.li = p;
#ifdef MK_SKIP
        if (p >= 1 && (((MK_SKIP) >> ((p - 1) % NPH_LAYER)) & 1)) continue;
#endif
        hipLaunchKernelGGL(phase_kernel(p == 0 ? 13 : (p - 1) % NPH_LAYER), dim3(grid), dim3(NTHR), LDS_BYTES, stream, a); }
#else
    a.ph_lo = 0; a.ph_hi = NPH; a.li = 0;
    hipLaunchKernelGGL(kern_of<0x3fff>(), dim3(grid), dim3(NTHR), LDS_BYTES, stream, a);
#endif
    const hipError_t le = hipPeekAtLastError();
    if (le != hipSuccess) fprintf(stderr, "kernel_launch: launch failed: %s\n", hipGetErrorName(le));
}
```

```cpp
#include <hip/hip_runtime.h>
#include <cstdio>
#include <cstdint>

#define LAS __attribute__((address_space(3)))
#define GAS __attribute__((address_space(1)))
typedef unsigned short bf16;
typedef short bf16x8 __attribute__((ext_vector_type(8)));
typedef float f32x4 __attribute__((ext_vector_type(4)));
typedef float f32x2 __attribute__((ext_vector_type(2)));
typedef unsigned u32x4 __attribute__((ext_vector_type(4)));
typedef unsigned u32x2 __attribute__((ext_vector_type(2)));

constexpr int NB = 16, SEQ = 4096, DM = 1024, NT = NB * SEQ;
constexpr int NIN = 2304;
constexpr int C_POOL = 0, C_LRU = 256, C_GATE = 512, C_Q = 768, C_K = 1280, C_V = 1792;
constexpr int NEXP = 32, TOPK = 4, EFF = 256;
constexpr int NASSIGN = NT * TOPK;
constexpr int ACT_ROWS = NASSIGN + NEXP * 256;
constexpr float EPS = 1e-6f;
constexpr int NWAVES = 8, NTHR = 512;
constexpr int LRU_CH = 32, LRU_NCH = SEQ / LRU_CH;

constexpr size_t MiB = 1u << 20;
constexpr size_t WS_CTL = 0, CTL_ZERO_BYTES = 1 * MiB;
constexpr size_t WS_ROPE = 1 * MiB;
constexpr size_t WS_SMALL = 2 * MiB;
constexpr size_t WS_WIN = 4 * MiB;
constexpr size_t WS_WOUT = 13 * MiB;
constexpr size_t WS_WGU = 17 * MiB;
constexpr size_t WS_WD = 81 * MiB;
constexpr size_t WS_SSQ = 113 * MiB;
constexpr size_t WS_SSQP = 114 * MiB;
constexpr size_t WS_LIST = 118 * MiB;
constexpr size_t WS_XB = 128 * MiB;
constexpr size_t WS_R = 256 * MiB;
constexpr size_t WS_PROJ = WS_R;
constexpr size_t WS_MIX = WS_R + 288 * MiB;
constexpr size_t WS_PNUM = WS_R + 416 * MiB;
constexpr size_t WS_PDEN = WS_R + 608 * MiB;
constexpr size_t WS_PMAX = WS_R + 614 * MiB;
constexpr size_t WS_HL = WS_R + 620 * MiB;
constexpr size_t WS_PL = WS_R + 652 * MiB;
constexpr size_t WS_AGGH = WS_R + 684 * MiB;
constexpr size_t WS_AGGP = WS_R + 686 * MiB;
constexpr size_t WS_CARRY = WS_R + 688 * MiB;
constexpr size_t WS_ACT = WS_R;
constexpr size_t WS_Y = WS_R + 132 * MiB;
constexpr size_t WS_LRSTD = WS_R + 644 * MiB;
constexpr size_t WS_LGATE2 = WS_R + 652 * MiB;
constexpr size_t WS_END = 1024 * MiB;
static_assert(WS_CARRY + 2 * MiB <= WS_END && WS_LGATE2 + 8 * MiB <= WS_END, "d_ws map");
constexpr size_t SM_POOLW = 0;
constexpr size_t SM_WA = 32768;
constexpr size_t SM_WX = 65536;
constexpr size_t SM_WR = 98304;
constexpr int CW_BAR = 4096;
constexpr int CW_CNT = 1024;

constexpr int RING_BYTES = 131072;
constexpr int LDSCTL_OFF = RING_BYTES;
constexpr int MISC_OFF = LDSCTL_OFF + 320;
constexpr int TAB_OFF = LDSCTL_OFF + 1024;
constexpr int LDS_BYTES = 147456;

typedef GAS unsigned gu32;
#define RLX_AGENT __ATOMIC_RELAXED, __HIP_MEMORY_SCOPE_AGENT
#define LDS_WAIT() asm volatile("s_waitcnt lgkmcnt(0)" ::: "memory")
#define VM_WAIT() asm volatile("s_waitcnt vmcnt(0)" ::: "memory")
typedef __bf16 bf16x2_t __attribute__((ext_vector_type(2)));
__device__ __forceinline__ unsigned cvt_pk_bf16(float lo, float hi) { const f32x2 v = {lo, hi}; const bf16x2_t b = __builtin_convertvector(v, bf16x2_t); return __builtin_bit_cast(unsigned, b); }
__device__ __forceinline__ float bflo(unsigned w) { return __uint_as_float(w << 16); }
__device__ __forceinline__ float bfhi(unsigned w) { return __uint_as_float(w & 0xffff0000u); }
__device__ __forceinline__ float bf2f(bf16 h) { return __uint_as_float((unsigned)h << 16); }
__device__ __forceinline__ bf16 f2bf(float f) { return (bf16)(cvt_pk_bf16(f, 0.f) & 0xffffu); }
__device__ __forceinline__ float wave_sum(float v) {
#pragma unroll
    for (int o = 1; o < 64; o <<= 1) v += __shfl_xor(v, o);
    return v;
}
__device__ __forceinline__ float fast_sigmoid(float x) { return __builtin_amdgcn_rcpf(1.0f + __builtin_amdgcn_exp2f(-1.4426950408889634f * x)); }
__device__ __forceinline__ float fast_exp(float x) { return __builtin_amdgcn_exp2f(1.4426950408889634f * x); }
__device__ __forceinline__ float gelu_tanh(float x) {
    const float u = 0.7978845608028654f * (x + 0.044715f * x * x * x);
    return x * fast_sigmoid(2.0f * u);
}
__device__ __forceinline__ int tid_from(int wv) { int ln; asm volatile("v_mbcnt_lo_u32_b32 %0, -1, 0\n\tv_mbcnt_hi_u32_b32 %0, -1, %0" : "=v"(ln)); return wv * 64 + ln; }
namespace pg8 {
constexpr int BM = 256, BK = 64, HALF = 128, HTB = HALF * BK * 2  , STAGE_BYTES = 8 * HTB, NXCD = 8, WGM = 8;

__host__ __device__ __forceinline__ int lds_byte(int r, int c) { const int st = (r >> 4) * 2 + (c >> 5), rr = r & 15, cc = c & 31, ob = rr * 64 + cc * 2; return st * 1024 + (ob ^ (((ob >> 9) & 1) << 5)); }
__host__ __device__ __forceinline__ void stage_rc(int b, int& R, int& C) { const int st = b / 1024, sb = b % 1024, swz = sb ^ (((sb >> 9) & 1) << 5); R = (st >> 1) * 16 + swz / 64; C = (st & 1) * 32 + (swz % 64) / 2; }
__host__ __device__ __forceinline__ int perm32(int rho) { const int n = rho >> 4, i = rho & 15; return 8 * (i >> 2) + 4 * n + (i & 3); }

struct Unit { int pm, pn, e, aux; };

template <class Epi, class Sched, bool ALIGN_EPI>
__device__ __forceinline__ void gemm_phase(LAS unsigned char* lds, const bf16* Abase, const bf16* Bbase, const int K, const Sched& S, const Epi& E, const int wv) {
    const int tid = tid_from(wv), wid = __builtin_amdgcn_readfirstlane(tid >> 6), lane = tid & 63, wr = wid >> 2, wc = wid & 3, fr = lane & 15, fq = lane >> 4;
    const int nt = K / BK;
    unsigned voffB[2];
#pragma unroll
    for (int i = 0; i < 2; ++i) { int R, C; stage_rc(tid * 16 + i * 8192, R, C); const int Rb = Epi::PERM ? ((R & ~31) + perm32(R & 31)) : R;
        voffB[i] = (unsigned)(Rb * K + C) * 2u; }
#define PG8_AVOFF(u, h, i) ([&]() { int R_, C_; stage_rc(tid * 16 + (i) * 8192, R_, C_); return S.a_voff((u), (h) * HALF + R_, C_); }())
    const unsigned kstep = (unsigned)(BK * 2);
    const unsigned hstep = (unsigned)(HALF * K * 2);
    const unsigned ldsw = (unsigned)wid * 1024u;
    const int aoff = lds_byte(wr * 64 + fr, fq * 8), boff = lds_byte(wc * 32 + fr, fq * 8);
    const __amdgpu_buffer_rsrc_t rsA = __builtin_amdgcn_make_buffer_rsrc((void*)Abase, 0, 0x7fffffff, 0x00020000);
    const __amdgpu_buffer_rsrc_t rsB = __builtin_amdgcn_make_buffer_rsrc((void*)Bbase, 0, 0x7fffffff, 0x00020000);
#define PG8_SA(b, h) (((b) * 2 + (h)) * HTB)
#define PG8_SB(b, h) ((4 + (b) * 2 + (h)) * HTB)
#define PG8_STAGE_B(bufoff, soff) do { const int so_ = __builtin_amdgcn_readfirstlane((int)(soff)); _Pragma("unroll") for (int _i = 0; _i < 2; ++_i) \
        __builtin_amdgcn_raw_ptr_buffer_load_lds(rsB, (LAS void*)(lds + (bufoff) + ldsw + _i * 8192), 16, voffB[_i], so_, 0, 0); } while (0)
#define PG8_STAGE_A(bufoff, kbytes, v0, v1) do { const int so_ = __builtin_amdgcn_readfirstlane((int)(kbytes)); \
        __builtin_amdgcn_raw_ptr_buffer_load_lds(rsA, (LAS void*)(lds + (bufoff) + ldsw), 16, (v0), so_, 0, 0); \
        __builtin_amdgcn_raw_ptr_buffer_load_lds(rsA, (LAS void*)(lds + (bufoff) + ldsw + 8192), 16, (v1), so_, 0, 0); } while (0)
#define PG8_LDA(dst, b, h) do { _Pragma("unroll") for (int m = 0; m < 4; ++m) _Pragma("unroll") for (int k = 0; k < 2; ++k) dst[m][k] = *(const LAS bf16x8*)(lds + PG8_SA(b, h) + aoff + m * 2048 + k * 1024); } while (0)
#define PG8_LDB(dst, b, h) do { _Pragma("unroll") for (int n = 0; n < 2; ++n) _Pragma("unroll") for (int k = 0; k < 2; ++k) dst[n][k] = *(const LAS bf16x8*)(lds + PG8_SB(b, h) + boff + n * 2048 + k * 1024); } while (0)
#define PG8_MMA(ai, bj, At, Bt) do { __builtin_amdgcn_s_setprio(1); _Pragma("unroll") for (int m = 0; m < 4; ++m) _Pragma("unroll") for (int n = 0; n < 2; ++n) _Pragma("unroll") for (int k = 0; k < 2; ++k) \
        acc[ai][bj][m][n] = __builtin_amdgcn_mfma_f32_16x16x32_bf16(Bt[n][k], At[m][k], acc[ai][bj][m][n], 0, 0, 0); __builtin_amdgcn_s_setprio(0); } while (0)
#define PG8_WAIT_V(n) asm volatile("s_waitcnt vmcnt(" #n ")" ::: "memory")
#define PG8_WAIT_L(n) asm volatile("s_waitcnt lgkmcnt(" #n ")" ::: "memory")
#define PG8_BAR __builtin_amdgcn_s_barrier()
#define PG8_SCHED __builtin_amdgcn_sched_barrier(0)
    Unit cur, nxt; int ui = 0;
    if (!S.next(0, cur)) return;
    f32x4 acc[2][2][4][2];
#pragma unroll
    for (int a = 0; a < 2; ++a)
#pragma unroll
        for (int b = 0; b < 2; ++b)
#pragma unroll
            for (int m = 0; m < 4; ++m)
#pragma unroll
                for (int n = 0; n < 2; ++n) acc[a][b][m][n] = (f32x4){0.f, 0.f, 0.f, 0.f};
    bf16x8 At[4][2], B0[2][2], B1[2][2];
    unsigned vc0, vc1, vc2, vc3, vn0, vn1, vn2, vn3;
    unsigned cA0, cA1, nA0, nA1;
    vc0 = PG8_AVOFF(cur, 0, 0); vc1 = PG8_AVOFF(cur, 0, 1);
    if constexpr (Sched::GATHER) { vc2 = PG8_AVOFF(cur, 1, 0); vc3 = PG8_AVOFF(cur, 1, 1); } else { vc2 = vc0; vc3 = vc1; }
    cA0 = S.a_soff(cur, 0); cA1 = S.a_soff(cur, 1);
    unsigned cB = (unsigned)S.b_off(cur);
    PG8_STAGE_B(PG8_SB(0, 0), cB); PG8_STAGE_B(PG8_SB(0, 1), cB + hstep); PG8_STAGE_A(PG8_SA(0, 0), cA0, vc0, vc1); PG8_STAGE_A(PG8_SA(0, 1), cA1, vc2, vc3);
    if (wr == 1) PG8_BAR;
    PG8_WAIT_V(2); PG8_BAR;
    PG8_STAGE_B(PG8_SB(1, 0), cB + kstep); PG8_STAGE_A(PG8_SA(1, 0), cA0 + kstep, vc0, vc1); PG8_STAGE_B(PG8_SB(1, 1), cB + hstep + kstep);
    PG8_WAIT_V(6); PG8_BAR;
    for (;;) {
#define PG8_TRIP(a1k, a2k0, a2k1, a3k0, b2, b3, w0, w1, w2, w3) do { \
              \
            PG8_LDB(B0, 0, 0); PG8_LDB(B1, 0, 1); PG8_SCHED; PG8_LDA(At, 0, 0); PG8_STAGE_A(PG8_SA(1, 1), a1k, vc2, vc3); \
            PG8_WAIT_V(8); PG8_WAIT_L(0); PG8_BAR; PG8_MMA(0, 0, At, B0); PG8_MMA(0, 1, At, B1); PG8_BAR; PG8_SCHED; \
              \
            PG8_LDA(At, 0, 1); PG8_STAGE_B(PG8_SB(0, 0), b2); PG8_STAGE_B(PG8_SB(0, 1), (b2) + hstep); PG8_STAGE_A(PG8_SA(0, 0), a2k0, w0, w1); \
            PG8_WAIT_V(8); PG8_WAIT_L(0); PG8_BAR; PG8_MMA(1, 0, At, B0); PG8_MMA(1, 1, At, B1); PG8_BAR; PG8_SCHED; \
              \
            PG8_LDB(B0, 1, 0); PG8_LDB(B1, 1, 1); PG8_SCHED; PG8_LDA(At, 1, 0); PG8_STAGE_A(PG8_SA(0, 1), a2k1, w2, w3); \
            PG8_WAIT_V(8); PG8_WAIT_L(0); PG8_BAR; PG8_MMA(0, 0, At, B0); PG8_MMA(0, 1, At, B1); PG8_BAR; PG8_SCHED; \
              \
            PG8_LDA(At, 1, 1); PG8_STAGE_B(PG8_SB(1, 0), b3); PG8_STAGE_B(PG8_SB(1, 1), (b3) + hstep); PG8_STAGE_A(PG8_SA(1, 0), a3k0, w0, w1); \
            PG8_WAIT_V(8); PG8_WAIT_L(0); PG8_BAR; PG8_MMA(1, 0, At, B0); PG8_MMA(1, 1, At, B1); PG8_BAR; PG8_SCHED; } while (0)
        for (int t = 0; t < nt - 2; t += 2) {
            const unsigned k1 = (unsigned)(t + 1) * kstep, k2 = (unsigned)(t + 2) * kstep, b2 = cB + k2, b3 = b2 + kstep;
            PG8_TRIP(cA1 + k1, cA0 + k2, cA1 + k2, cA0 + k2 + kstep, b2, b3, vc0, vc1, vc2, vc3);
        }
        const bool has_next = S.next(ui + 1, nxt);
        unsigned nB;
        if (has_next) { if constexpr (Sched::GATHER) { vn0 = PG8_AVOFF(nxt, 0, 0); vn1 = PG8_AVOFF(nxt, 0, 1); vn2 = PG8_AVOFF(nxt, 1, 0); vn3 = PG8_AVOFF(nxt, 1, 1); } else { vn0 = vc0; vn1 = vc1; vn2 = vc0; vn3 = vc1; }
                        nA0 = S.a_soff(nxt, 0); nA1 = S.a_soff(nxt, 1); nB = (unsigned)S.b_off(nxt); }
        else { vn0 = vc0; vn1 = vc1; vn2 = vc2; vn3 = vc3; nA0 = cA0; nA1 = cA1; nB = cB; }
        { const unsigned k1 = (unsigned)(nt - 1) * kstep;
          PG8_TRIP(cA1 + k1, nA0, nA1, nA0 + kstep, nB, nB + kstep, vn0, vn1, vn2, vn3); }
#undef PG8_TRIP
        if constexpr (ALIGN_EPI) { if (wr == 0) PG8_BAR; }
        E(acc, cur, wr, wc, fr, fq);
        if (!has_next) break;
#pragma unroll
        for (int a = 0; a < 2; ++a)
#pragma unroll
            for (int b = 0; b < 2; ++b)
#pragma unroll
                for (int m = 0; m < 4; ++m)
#pragma unroll
                    for (int n = 0; n < 2; ++n) acc[a][b][m][n] = (f32x4){0.f, 0.f, 0.f, 0.f};
        cur = nxt; cB = nB; cA0 = nA0; cA1 = nA1; vc0 = vn0; vc1 = vn1; vc2 = vn2; vc3 = vn3; ++ui;
        if constexpr (ALIGN_EPI) { if (wr == 1) PG8_BAR; }
    }
    PG8_WAIT_V(0);
    if constexpr (!ALIGN_EPI) { if (wr == 0) PG8_BAR; }
    PG8_BAR;
#undef PG8_SA
#undef PG8_AVOFF
#undef PG8_SB
#undef PG8_STAGE_A
#undef PG8_STAGE_B
#undef PG8_LDA
#undef PG8_LDB
#undef PG8_MMA
#undef PG8_WAIT_V
#undef PG8_WAIT_L
#undef PG8_BAR
#undef PG8_SCHED
}

struct StaticOrder {
    int nM, nN, nwg, G, c, lda;
    __device__ __forceinline__ void init(int M, int N, int lda_, int G_, int c_) { nM = M / BM; nN = N / BM; nwg = nM * nN; G = G_; c = c_; lda = lda_; }
    __device__ __forceinline__ bool next(int i, Unit& u) const {
        const long L = (long)i * G + c; if (L >= nwg) return false;
        int wgid = (int)L; { const int q = nwg / NXCD, r = nwg % NXCD, xcd = wgid % NXCD, off = wgid / NXCD; wgid = (xcd < r ? xcd * (q + 1) : r * (q + 1) + (xcd - r) * q) + off; }
        const int nig = WGM * nN, gid = wgid / nig, fm = gid * WGM, gsz = (nM - fm) < WGM ? (nM - fm) : WGM;
        u.pm = fm + ((wgid % nig) % gsz); u.pn = (wgid % nig) / gsz; u.e = 0; u.aux = 0; return true;
    }
    static constexpr bool GATHER = false;
    __device__ __forceinline__ unsigned a_voff(const Unit&, int R, int C) const { return (unsigned)((R & (HALF - 1)) * lda + C) * 2u; }
    __device__ __forceinline__ unsigned a_soff(const Unit& u, int h) const { return (unsigned)((u.pm * BM + h * HALF) * lda) * 2u; }
    __device__ __forceinline__ size_t b_off(const Unit& u) const { return (size_t)u.pn * BM * lda * 2; }
};
}

#define XB_TMO      128
#define XB_XCNT(j)  (256  + 64 * (j))
#define XB_XSUB(j)  (1280 + 64 * (j))
#define XB_XGEN(j)  (2304 + 64 * (j))
#define XB_TOP      3328
#define XB_TOPGEN   3392
#define XCD_BAR_WORDS 3456
#define XB_SPIN_CAP (1u << 18)

__device__ __forceinline__ unsigned xb_ld(unsigned* p)              { return __hip_atomic_load(p, __ATOMIC_RELAXED, __HIP_MEMORY_SCOPE_AGENT); }
__device__ __forceinline__ unsigned xb_add(unsigned* p, unsigned v) { return __hip_atomic_fetch_add(p, v, __ATOMIC_RELAXED, __HIP_MEMORY_SCOPE_AGENT); }
__device__ __forceinline__ unsigned xb_xcc_id() { return (unsigned)__builtin_amdgcn_s_getreg((3 << 11) | 20) & 0xFu; }
#define XB_SPIN(cond, bar) do { unsigned _sp = 0; while (cond) { __builtin_amdgcn_s_sleep(1); \
    if ((++_sp & 255u) == 0u) { if (xb_ld(&(bar)[XB_TMO])) break; if (_sp > XB_SPIN_CAP) { atomicAdd(&(bar)[XB_TMO], 1u); break; } } } } while (0)

struct XcdBarrier {
    unsigned* bar; unsigned x;
    volatile LAS unsigned* st;
};

__device__ __forceinline__ XcdBarrier xcd_barrier_post(unsigned* bar, volatile LAS unsigned* st) {
    XcdBarrier b; b.bar = bar; b.x = xb_xcc_id(); b.st = st;
    if (threadIdx.x == 0) (void)xb_add(&bar[XB_XCNT(b.x)], 1u);
    return b;
}
__device__ __forceinline__ void xcd_barrier_complete(unsigned* bar, unsigned x, unsigned& nloc, unsigned& nx) {
    const unsigned G = gridDim.x * gridDim.y * gridDim.z;
    unsigned sum, cnt, mine, sp = 0u;
    for (;;) {
        sum = 0u; cnt = 0u; mine = 0u;
#pragma unroll
        for (unsigned j = 0; j < 16; ++j) { const unsigned c = xb_ld(&bar[XB_XCNT(j)]); sum += c; cnt += (c > 0u) ? 1u : 0u; mine = (j == x) ? c : mine; }
        if (sum == G) break;
        __builtin_amdgcn_s_sleep(1);
        if ((++sp & 255u) == 0u) { if (xb_ld(&bar[XB_TMO])) break; if (sp > XB_SPIN_CAP) { atomicAdd(&bar[XB_TMO], 1u); break; } }
    }
    nloc = mine > 0u ? mine : 1u; nx = cnt > 0u ? cnt : 1u;
}

__device__ __forceinline__ void xcd_barrier(const XcdBarrier& b) {
    asm volatile("s_waitcnt vmcnt(0)" ::: "memory");
    __syncthreads();
    if (threadIdx.x == 0) {
        unsigned* bar = b.bar;
        __builtin_amdgcn_s_waitcnt(0);
        unsigned nloc = b.st[0], nx = b.st[1];
        if (nloc == 0u) { xcd_barrier_complete(bar, b.x, nloc, nx); b.st[0] = nloc; b.st[1] = nx; }
        const unsigned old = xb_add(&bar[XB_XSUB(b.x)], 1u);
        const unsigned gen = old / nloc;
        if (old + 1u == (gen + 1u) * nloc) {
            __builtin_amdgcn_fence(__ATOMIC_RELEASE, "agent");
            asm volatile("s_waitcnt vmcnt(0)" ::: "memory");
            const unsigned og = xb_add(&bar[XB_TOP], 1u);
            const unsigned tg = og / nx;
            if (og + 1u == (tg + 1u) * nx) xb_add(&bar[XB_TOPGEN], 1u);
            else XB_SPIN(xb_ld(&bar[XB_TOPGEN]) == tg, bar);
            __builtin_amdgcn_fence(__ATOMIC_ACQUIRE, "agent");
            xb_add(&bar[XB_XGEN(b.x)], 1u);
            asm volatile("s_waitcnt vmcnt(0)" ::: "memory");
        } else {
            XB_SPIN(xb_ld(&bar[XB_XGEN(b.x)]) == gen, bar);
            __builtin_amdgcn_fence(__ATOMIC_ACQUIRE, "agent");
            asm volatile("s_waitcnt vmcnt(0)" ::: "memory");
        }
    }
    __syncthreads();
}

struct Args { const float* in[23]; float* out; unsigned char* ws; int ph_lo, ph_hi, li, pad; };
#define CAS __attribute__((address_space(4)))
typedef const CAS Args& ArgsRef;
enum { I_X = 0, I_NORM1G, I_WIN, I_POOLW, I_POOLSC, I_CONVW, I_CONVB, I_WA, I_BA, I_WX, I_BX, I_LAM, I_QG, I_KG, I_OG, I_WOUT, I_NORM2G, I_WR, I_BR, I_WGU, I_BGU, I_WD, I_BD };

__device__ __forceinline__ void tr_item(const float* W, int K, int N, bf16* WT, const float* gk, int mode, LAS float* scr, int item, int lane) {
    const int nblk = N / 32, kb = item / nblk, nb = item % nblk, k0 = 64 * kb, n0 = 32 * nb;
#pragma unroll 8
    for (int i = 0; i < 32; ++i) { const int kk = 2 * i + (lane >> 5); float v = W[(size_t)(k0 + kk) * N + n0 + (lane & 31)]; if (gk) v *= gk[k0 + kk]; scr[kk * 33 + (lane & 31)] = v; }
    LDS_WAIT(); asm volatile("" ::: "memory");
    const int c = lane & 7;
#pragma unroll
    for (int j = 0; j < 4; ++j) { const int n = (lane >> 3) + 8 * j; const LAS float* s = scr + (8 * c) * 33 + n;
        u32x4 o; o.x = cvt_pk_bf16(s[0 * 33], s[1 * 33]); o.y = cvt_pk_bf16(s[2 * 33], s[3 * 33]); o.z = cvt_pk_bf16(s[4 * 33], s[5 * 33]); o.w = cvt_pk_bf16(s[6 * 33], s[7 * 33]);
        int dn = n0 + n;
        if (mode == 1) { const int jj = dn & 255; dn = (jj >> 7) * 256 + (dn >> 8) * 128 + (jj & 127); }
        *(u32x4*)(WT + (size_t)dn * K + k0 + 8 * c) = o; }
    LDS_WAIT(); asm volatile("" ::: "memory");
}
__device__ __forceinline__ void cvt_row(const float* xrow, bf16* orow, float* ssq, int lane) {
    const f32x4* xr = (const f32x4*)xrow + lane;
    f32x4 v[4]; float s = 0.f;
#pragma unroll
    for (int j = 0; j < 4; ++j) { v[j] = xr[64 * j]; s += (v[j].x * v[j].x + v[j].y * v[j].y) + (v[j].z * v[j].z + v[j].w * v[j].w); }
    s = wave_sum(s);
    u32x2* o8 = (u32x2*)orow + lane;
#pragma unroll
    for (int j = 0; j < 4; ++j) { u32x2 w; w.x = cvt_pk_bf16(v[j].x, v[j].y); w.y = cvt_pk_bf16(v[j].z, v[j].w); o8[64 * j] = w; }
    if (lane == 0) *ssq = s;
}
__device__ __forceinline__ void phase_prologue(ArgsRef a, LAS unsigned char* lds, int wv) {
    const int tid = tid_from(wv), lane = tid & 63, wave = tid >> 6;
    LAS float* scr = (LAS float*)(lds + wave * 16384);
    const int gw = blockIdx.x * NWAVES + wave, NGW = gridDim.x * NWAVES;
    unsigned char* ws = a.ws;
    constexpr int I_IN = 16 * 72, I_OUT = 16 * 32, I_R = 16, I_GU = 16 * 16, I_D = 4 * 32, I_S = 2;
    constexpr int PER_LAYER = I_IN + I_OUT + I_R + NEXP * I_GU + NEXP * I_D + 12 * I_S;
    for (int it = gw; it < 2 * PER_LAYER; it += NGW) {
        const int l = it / PER_LAYER; int r = it % PER_LAYER;
        if (r < I_IN) { tr_item(a.in[I_WIN] + (size_t)l * DM * NIN, DM, NIN, (bf16*)(ws + WS_WIN) + (size_t)l * NIN * DM, a.in[I_NORM1G] + l * DM, 0, scr, r, lane); continue; } r -= I_IN;
        if (r < I_OUT) { tr_item(a.in[I_WOUT] + (size_t)l * DM * DM, DM, DM, (bf16*)(ws + WS_WOUT) + (size_t)l * DM * DM, a.in[I_OG] + l * DM, 0, scr, r, lane); continue; } r -= I_OUT;
        if (r < I_R) { tr_item(a.in[I_WR] + (size_t)l * DM * NEXP, DM, NEXP, (bf16*)(ws + WS_SMALL) + SM_WR + (size_t)l * NEXP * DM, a.in[I_NORM2G] + l * DM, 0, scr, r, lane); continue; } r -= I_R;
        if (r < NEXP * I_GU) { const int e = r / I_GU; tr_item(a.in[I_WGU] + (size_t)(l * NEXP + e) * DM * 512, DM, 512, (bf16*)(ws + WS_WGU) + (size_t)(l * NEXP + e) * 512 * DM, a.in[I_NORM2G] + l * DM, 1, scr, r % I_GU, lane); continue; } r -= NEXP * I_GU;
        if (r < NEXP * I_D) { const int e = r / I_D; tr_item(a.in[I_WD] + (size_t)(l * NEXP + e) * EFF * DM, EFF, DM, (bf16*)(ws + WS_WD) + (size_t)(l * NEXP + e) * DM * EFF, nullptr, 0, scr, r % I_D, lane); continue; } r -= NEXP * I_D;
        { const int which = r / (4 * I_S), g = (r / I_S) % 4, sub = r % I_S;
          const float* src = a.in[which == 0 ? I_POOLW : (which == 1 ? I_WA : I_WX)] + (size_t)(l * 4 + g) * 4096;
          bf16* dst = (bf16*)(ws + WS_SMALL) + (which == 0 ? SM_POOLW : (which == 1 ? SM_WA : SM_WX)) + (size_t)(l * 4 + g) * 4096;
          tr_item(src, 64, 64, dst, nullptr, 0, scr, sub, lane); }
    }
    { float* ct = (float*)(ws + WS_ROPE); float* st = ct + SEQ * 32;
      for (int idx = blockIdx.x * NTHR + tid; idx < SEQ * 32; idx += gridDim.x * NTHR) {
          const int pos = idx >> 5, i = idx & 31;
          const float inv = __builtin_amdgcn_exp2f(-(float)i * 0.41524101186092029f);
          const float ang = (float)pos * inv;
          const double rev = (double)ang * 0.15915494309189535; const double fr = rev - __builtin_rint(rev);
          const float f = (float)fr;
          ct[idx] = __builtin_amdgcn_cosf(f); st[idx] = __builtin_amdgcn_sinf(f); } }
    for (int m = gw; m < NT; m += NGW) cvt_row(a.in[I_X] + (size_t)m * DM, (bf16*)(ws + WS_XB) + (size_t)m * DM, (float*)(ws + WS_SSQ) + m, lane);
}

struct EpiIn {
    static constexpr bool PERM = true;
    bf16* O; const float* ssq;
    __device__ __forceinline__ void operator()(const f32x4 (&acc)[2][2][4][2], const pg8::Unit& u, int wr, int wc, int fr, int fq) const {
        const int row0 = u.pm * 256 + wr * 64 + fr, col0 = u.pn * 256 + wc * 32 + 8 * fq;
#pragma unroll
        for (int ai = 0; ai < 2; ++ai)
#pragma unroll
            for (int m = 0; m < 4; ++m) { const int row = row0 + ai * 128 + m * 16; const float rs = __builtin_amdgcn_rsqf(ssq[row] * (1.0f / DM) + EPS);
                bf16* rowp = O + (size_t)row * NIN + col0;
#pragma unroll
                for (int bj = 0; bj < 2; ++bj) { const f32x4 v0 = acc[ai][bj][m][0] * rs, v1 = acc[ai][bj][m][1] * rs;
                    u32x4 w; w.x = cvt_pk_bf16(v0[0], v0[1]); w.y = cvt_pk_bf16(v0[2], v0[3]); w.z = cvt_pk_bf16(v1[0], v1[1]); w.w = cvt_pk_bf16(v1[2], v1[3]);
                    *(u32x4*)(rowp + bj * 128) = w; } }
    }
};
struct EpiOut {
    static constexpr bool PERM = false;
    const float* xin; float* out; bf16* xb; float* ssqp;
    __device__ __forceinline__ void operator()(const f32x4 (&acc)[2][2][4][2], const pg8::Unit& u, int wr, int wc, int fr, int fq) const {
        const int row0 = u.pm * 256 + wr * 64 + fr, col0 = u.pn * 256 + wc * 32 + 4 * fq;
#pragma unroll
        for (int ai = 0; ai < 2; ++ai)
#pragma unroll
            for (int m = 0; m < 4; ++m) { const int row = row0 + ai * 128 + m * 16; const size_t off = (size_t)row * DM + col0; float s = 0.f;
#pragma unroll
                for (int bj = 0; bj < 2; ++bj)
#pragma unroll
                    for (int n = 0; n < 2; ++n) { const f32x4 o = *(const f32x4*)(xin + off + bj * 128 + n * 16) + acc[ai][bj][m][n];
                        *(f32x4*)(out + off + bj * 128 + n * 16) = o; s += (o[0] * o[0] + o[1] * o[1]) + (o[2] * o[2] + o[3] * o[3]);
                        u32x2 w; w.x = cvt_pk_bf16(o[0], o[1]); w.y = cvt_pk_bf16(o[2], o[3]); *(u32x2*)(xb + off + bj * 128 + n * 16) = w; }
                s += __shfl_xor(s, 16); s += __shfl_xor(s, 32);
                if (fq == 0) ssqp[(size_t)row * 16 + u.pn * 4 + wc] = s; }
    }
};

template <int MODE> struct MoeOrder {
    static constexpr bool GATHER = (MODE == 0);
    const LAS int* tab; int npn, G, c; const int* list;
    __device__ __forceinline__ bool next(int i, pg8::Unit& u) const {
        const int L = i * G + c; const int total = __builtin_amdgcn_readfirstlane(tab[64]) * npn; if (L >= total) return false;
        const int gb = L / npn; u.pn = L % npn; int e = 0;
        for (int k = 1; k < NEXP; ++k) { if (__builtin_amdgcn_readfirstlane(tab[32 + k]) <= gb) e = k; }
        u.e = e; u.pm = gb; u.aux = gb - __builtin_amdgcn_readfirstlane(tab[32 + e]); return true;
    }
    __device__ __forceinline__ unsigned a_voff(const pg8::Unit& u, int R, int C) const {
        if constexpr (MODE == 0) { const int pos = u.aux * 256 + R; const int ne = tab[u.e]; int tok = 0; if (pos < ne) tok = list[u.e * NT + pos] >> 2; return (unsigned)(tok * DM + C) * 2u; }
        else return (unsigned)((R & 127) * EFF + C) * 2u;
    }
    __device__ __forceinline__ unsigned a_soff(const pg8::Unit& u, int h) const { if constexpr (MODE == 0) return 0u; else return (unsigned)((u.pm * 256 + h * 128) * EFF) * 2u; }
    __device__ __forceinline__ size_t b_off(const pg8::Unit& u) const {
        if constexpr (MODE == 0) return ((size_t)u.e * 512 + (size_t)u.pn * 256) * DM * 2;
        else return ((size_t)u.e * DM + (size_t)u.pn * 256) * EFF * 2;
    }
};
struct EpiGU {
    static constexpr bool PERM = true;
    bf16* act; const float* lrstd; const float* bgu;
    __device__ __forceinline__ void operator()(const f32x4 (&acc)[2][2][4][2], const pg8::Unit& u, int wr, int wc, int fr, int fq) const {
        const int r0 = wr * 64 + fr, cl0 = wc * 32 + 8 * fq;
        const float* bg = bgu + u.e * 512 + u.pn * 128 + cl0;
        const f32x4 bg0 = *(const f32x4*)(bg), bg1 = *(const f32x4*)(bg + 4), bu0 = *(const f32x4*)(bg + 256), bu1 = *(const f32x4*)(bg + 260);
#pragma unroll
        for (int ai = 0; ai < 2; ++ai)
#pragma unroll
            for (int m = 0; m < 4; ++m) { const int r = r0 + ai * 128 + m * 16; const float rs = lrstd[(size_t)u.e * NT + u.aux * 256 + r];
                f32x4 g0 = acc[ai][0][m][0] * rs + bg0, g1 = acc[ai][0][m][1] * rs + bg1, u0 = acc[ai][1][m][0] * rs + bu0, u1 = acc[ai][1][m][1] * rs + bu1;
                float o[8];
#pragma unroll
                for (int j = 0; j < 4; ++j) { const float ga = fminf(g0[j], 7.0f), ua = fminf(fmaxf(u0[j], -7.0f), 7.0f); o[j] = (ua + 1.0f) * ga * fast_sigmoid(1.702f * ga);
                                              const float gb = fminf(g1[j], 7.0f), ub = fminf(fmaxf(u1[j], -7.0f), 7.0f); o[4 + j] = (ub + 1.0f) * gb * fast_sigmoid(1.702f * gb); }
                u32x4 w; w.x = cvt_pk_bf16(o[0], o[1]); w.y = cvt_pk_bf16(o[2], o[3]); w.z = cvt_pk_bf16(o[4], o[5]); w.w = cvt_pk_bf16(o[6], o[7]);
                *(u32x4*)(act + (size_t)(u.pm * 256 + r) * EFF + u.pn * 128 + cl0) = w; }
    }
};
struct EpiDown {
    static constexpr bool PERM = true;
    bf16* y; const int* list; const float* lgate; const float* bd; const LAS int* tab;
    __device__ __forceinline__ void operator()(const f32x4 (&acc)[2][2][4][2], const pg8::Unit& u, int wr, int wc, int fr, int fq) const {
        const int r0 = wr * 64 + fr, col0 = u.pn * 256 + wc * 32 + 8 * fq; const int ne = tab[u.e];
        const float* bp = bd + u.e * DM + col0;
#pragma unroll
        for (int ai = 0; ai < 2; ++ai)
#pragma unroll
            for (int m = 0; m < 4; ++m) { const int pos = u.aux * 256 + r0 + ai * 128 + m * 16;
                asm volatile("" ::: "memory");
                if (pos < ne) { const int asg = list[(size_t)u.e * NT + pos]; const float gt = lgate[(size_t)u.e * NT + pos]; bf16* rowp = y + (size_t)asg * DM + col0;
#pragma unroll
                    for (int bj = 0; bj < 2; ++bj) { const f32x4 b0 = *(const f32x4*)(bp + bj * 128), b1 = *(const f32x4*)(bp + bj * 128 + 4);
                        const f32x4 v0 = (acc[ai][bj][m][0] + b0) * gt, v1 = (acc[ai][bj][m][1] + b1) * gt;
                        u32x4 w; w.x = cvt_pk_bf16(v0[0], v0[1]); w.y = cvt_pk_bf16(v0[2], v0[3]); w.z = cvt_pk_bf16(v1[0], v1[1]); w.w = cvt_pk_bf16(v1[2], v1[3]);
                        *(u32x4*)(rowp + bj * 128) = w; } } }
    }
};
__device__ __forceinline__ void moe_tables(LAS int* tab, const unsigned* cnt, int wv) {
    __syncthreads();
    const int tid_ = tid_from(wv);
    if (tid_ == 0) { int pre = 0;
        for (int e = 0; e < NEXP; ++e) { const int n = (int)__hip_atomic_load(cnt + e, RLX_AGENT); tab[e] = n; tab[32 + e] = pre; pre += (n + 255) >> 8; }
        tab[64] = pre; }
    __syncthreads();
}

__device__ __forceinline__ void phase_qkprep(ArgsRef a, int layer, int wv) {
    const int tid = tid_from(wv), lane = tid & 63, wave = tid >> 6;
    const int gw = blockIdx.x * NWAVES + wave, NGW = gridDim.x * NWAVES;
    bf16* proj = (bf16*)(a.ws + WS_PROJ);
    const float* ct = (const float*)(a.ws + WS_ROPE); const float* st = ct + SEQ * 32;
    const int d0 = (lane & 7) * 8, p0 = d0 & 31;
    float gq[8], gk[8];
#pragma unroll
    for (int j = 0; j < 8; ++j) { gq[j] = a.in[I_QG][layer * 64 + d0 + j] * (0.125f * 1.4426950408889634f); gk[j] = a.in[I_KG][layer * 64 + d0 + j]; }
    const bool second = (lane & 4) != 0;
    for (int t = gw; t < NT; t += NGW) {
        const int pos = t & (SEQ - 1);
        float c[8], s[8];
        { const f32x4 c0 = *(const f32x4*)(ct + pos * 32 + p0), c1 = *(const f32x4*)(ct + pos * 32 + p0 + 4), s0 = *(const f32x4*)(st + pos * 32 + p0), s1 = *(const f32x4*)(st + pos * 32 + p0 + 4);
#pragma unroll
          for (int j = 0; j < 4; ++j) { c[j] = c0[j]; c[4 + j] = c1[j]; s[j] = s0[j]; s[4 + j] = s1[j]; } }
#pragma unroll
        for (int i = 0; i < 2; ++i) {
            bf16* p = proj + (size_t)t * NIN + C_Q + i * 512 + lane * 8;
            const u32x4 w = *(const u32x4*)p;
            float x[8]; x[0] = bflo(w.x); x[1] = bfhi(w.x); x[2] = bflo(w.y); x[3] = bfhi(w.y); x[4] = bflo(w.z); x[5] = bfhi(w.z); x[6] = bflo(w.w); x[7] = bfhi(w.w);
            float ss = 0.f;
#pragma unroll
            for (int j = 0; j < 8; ++j) ss += x[j] * x[j];
            ss += __shfl_xor(ss, 1); ss += __shfl_xor(ss, 2); ss += __shfl_xor(ss, 4);
            const float rs = __builtin_amdgcn_rsqf(ss * (1.0f / 64.0f) + EPS);
            float o[8];
#pragma unroll
            for (int j = 0; j < 8; ++j) { const float yv = x[j] * rs * (i == 0 ? gq[j] : gk[j]); const float pv = __shfl_xor(yv, 4);
                o[j] = second ? (yv * c[j] + pv * s[j]) : (yv * c[j] - pv * s[j]); }
            u32x4 r; r.x = cvt_pk_bf16(o[0], o[1]); r.y = cvt_pk_bf16(o[2], o[3]); r.z = cvt_pk_bf16(o[4], o[5]); r.w = cvt_pk_bf16(o[6], o[7]);
            *(u32x4*)p = r;
        }
    }
}

__device__ __forceinline__ void phase_pool(ArgsRef a, LAS unsigned char* lds, int layer, int wv) {
    const int tid = tid_from(wv), lane = tid & 63, wave = __builtin_amdgcn_readfirstlane(tid >> 6);
    const bf16* proj = (const bf16*)(a.ws + WS_PROJ); bf16* mix = (bf16*)(a.ws + WS_MIX);
    const bf16* pw = (const bf16*)(a.ws + WS_SMALL) + SM_POOLW + (size_t)layer * 4 * 4096;
    const float* psc = a.in[I_POOLSC] + layer * 256;
    LAS float* U = (LAS float*)lds;
    LAS bf16* PA = (LAS bf16*)(lds + 81920);
    LAS float* SS = (LAS float*)(lds + 116736);
    constexpr int PAS = 264;
    for (int unit = blockIdx.x; unit < NT / 64; unit += gridDim.x) {
        const int t0 = unit * 64, s0 = t0 & (SEQ - 1);
        __syncthreads();
        for (int ch = tid; ch < 79 * 32; ch += NTHR) { const int r = ch >> 5, c8 = (ch & 31) * 8; const int srow = s0 - 15 + r;
            f32x4 lo = {0.f, 0.f, 0.f, 0.f}, hi = {0.f, 0.f, 0.f, 0.f};
            if (srow >= 0) { const u32x4 w = *(const u32x4*)(proj + (size_t)(t0 - 15 + r) * NIN + C_POOL + c8); lo = (f32x4){bflo(w.x), bfhi(w.x), bflo(w.y), bfhi(w.y)}; hi = (f32x4){bflo(w.z), bfhi(w.z), bflo(w.w), bfhi(w.w)}; }
            *(LAS f32x4*)(U + r * 256 + c8) = lo; *(LAS f32x4*)(U + r * 256 + c8 + 4) = hi; }
        __syncthreads();
        { const int c = tid & 255, tl0 = (tid >> 8) * 32, w = 2 << (c >> 6);
          float sum = 0.f;
          for (int j = 1; j < w; ++j) sum += U[(15 + tl0 - j) * 256 + c];
          for (int tl = tl0; tl < tl0 + 32; ++tl) { const float cur = U[(15 + tl) * 256 + c]; sum += cur;
              const int cnt = min(w, s0 + tl + 1); const float pooled = sum / (float)cnt - cur;
              PA[tl * PAS + c] = f2bf(pooled); sum -= U[(15 + tl - w + 1) * 256 + c]; } }
        __syncthreads();
        const int g = wave & 3, th = wave >> 2, lr = lane & 15, lq = lane >> 4;
        f32x4 acc[2][4];
#pragma unroll
        for (int rt = 0; rt < 2; ++rt)
#pragma unroll
            for (int et = 0; et < 4; ++et) acc[rt][et] = (f32x4){0.f, 0.f, 0.f, 0.f};
#pragma unroll
        for (int ks = 0; ks < 2; ++ks) { bf16x8 af[2], bfr[4];
#pragma unroll
            for (int rt = 0; rt < 2; ++rt) af[rt] = *(const LAS bf16x8*)(PA + (th * 32 + rt * 16 + lr) * PAS + g * 64 + ks * 32 + lq * 8);
#pragma unroll
            for (int et = 0; et < 4; ++et) bfr[et] = *(const bf16x8*)(pw + (size_t)g * 4096 + (et * 16 + lr) * 64 + ks * 32 + lq * 8);
#pragma unroll
            for (int rt = 0; rt < 2; ++rt)
#pragma unroll
                for (int et = 0; et < 4; ++et) acc[rt][et] = __builtin_amdgcn_mfma_f32_16x16x32_bf16(af[rt], bfr[et], acc[rt][et], 0, 0, 0); }
#pragma unroll
        for (int et = 0; et < 4; ++et) { const float sc = psc[g * 64 + et * 16 + lr];
#pragma unroll
            for (int rt = 0; rt < 2; ++rt) acc[rt][et] = acc[rt][et] * sc; }
#pragma unroll
        for (int rt = 0; rt < 2; ++rt)
#pragma unroll
            for (int reg = 0; reg < 4; ++reg) { float s = 0.f;
#pragma unroll
                for (int et = 0; et < 4; ++et) s += acc[rt][et][reg] * acc[rt][et][reg];
                s += __shfl_xor(s, 1); s += __shfl_xor(s, 2); s += __shfl_xor(s, 4); s += __shfl_xor(s, 8);
                if (lr == 0) SS[(th * 32 + rt * 16 + lq * 4 + reg) * 4 + g] = s; }
        __syncthreads();
#pragma unroll
        for (int rt = 0; rt < 2; ++rt)
#pragma unroll
            for (int reg = 0; reg < 4; ++reg) { const int tl = th * 32 + rt * 16 + lq * 4 + reg; const LAS float* sp = SS + tl * 4;
                const float rs = __builtin_amdgcn_rsqf(((sp[0] + sp[1]) + (sp[2] + sp[3])) * (1.0f / 256.0f) + EPS);
#pragma unroll
                for (int et = 0; et < 4; ++et) mix[(size_t)(t0 + tl) * DM + g * 64 + et * 16 + lr] = f2bf(acc[rt][et][reg] * rs); }
    }
}

__device__ __forceinline__ void phase_lru_a(ArgsRef a, LAS unsigned char* lds, int layer, int wv) {
    const int tid = tid_from(wv), lane = tid & 63, wave = __builtin_amdgcn_readfirstlane(tid >> 6);
    const bf16* proj = (const bf16*)(a.ws + WS_PROJ);
    const bf16* wa = (const bf16*)(a.ws + WS_SMALL) + SM_WA + (size_t)layer * 4 * 4096;
    const bf16* wx = (const bf16*)(a.ws + WS_SMALL) + SM_WX + (size_t)layer * 4 * 4096;
    bf16* HL = (bf16*)(a.ws + WS_HL); bf16* PL = (bf16*)(a.ws + WS_PL);
    float* AGGH = (float*)(a.ws + WS_AGGH); float* AGGP = (float*)(a.ws + WS_AGGP);
    LAS float* U = (LAS float*)lds;
    LAS bf16* XC = (LAS bf16*)(lds + 36864);
    LAS float* XF = (LAS float*)(lds + 54272);
    LAS float* AA = (LAS float*)(lds + 87040);
    constexpr int XS = 264;
    const int c = tid & 255;
    const float cw0 = a.in[I_CONVW][(layer * 4 + 0) * 256 + c], cw1 = a.in[I_CONVW][(layer * 4 + 1) * 256 + c], cw2 = a.in[I_CONVW][(layer * 4 + 2) * 256 + c], cw3 = a.in[I_CONVW][(layer * 4 + 3) * 256 + c];
    const float cb = a.in[I_CONVB][layer * 256 + c];
    for (int unit = blockIdx.x; unit < NT / LRU_CH; unit += gridDim.x) {
        const int t0 = unit * LRU_CH, s0 = t0 & (SEQ - 1);
        __syncthreads();
        for (int ch = tid; ch < 35 * 32; ch += NTHR) { const int r = ch >> 5, c8 = (ch & 31) * 8; const int srow = s0 - 3 + r;
            f32x4 lo = {0.f, 0.f, 0.f, 0.f}, hi = {0.f, 0.f, 0.f, 0.f};
            if (srow >= 0) { const u32x4 w = *(const u32x4*)(proj + (size_t)(t0 - 3 + r) * NIN + C_LRU + c8); lo = (f32x4){bflo(w.x), bfhi(w.x), bflo(w.y), bfhi(w.y)}; hi = (f32x4){bflo(w.z), bfhi(w.z), bflo(w.w), bfhi(w.w)}; }
            *(LAS f32x4*)(U + r * 256 + c8) = lo; *(LAS f32x4*)(U + r * 256 + c8 + 4) = hi; }
        __syncthreads();
        { const int tl0 = (tid >> 8) * 16;
          for (int tl = tl0; tl < tl0 + 16; ++tl) { const float xc = cb + cw0 * U[(tl + 0) * 256 + c] + cw1 * U[(tl + 1) * 256 + c] + cw2 * U[(tl + 2) * 256 + c] + cw3 * U[(tl + 3) * 256 + c];
              XF[tl * 256 + c] = xc; XC[tl * XS + c] = f2bf(xc); } }
        __syncthreads();
        { const int n = wave & 3, eh = wave >> 2, lr = lane & 15, lq = lane >> 4;
          f32x4 ca[2][2], cx[2][2];
#pragma unroll
          for (int rt = 0; rt < 2; ++rt)
#pragma unroll
              for (int et = 0; et < 2; ++et) { ca[rt][et] = (f32x4){0.f, 0.f, 0.f, 0.f}; cx[rt][et] = (f32x4){0.f, 0.f, 0.f, 0.f}; }
#pragma unroll
          for (int ks = 0; ks < 2; ++ks) { bf16x8 af[2], ba[2], bx[2];
#pragma unroll
              for (int rt = 0; rt < 2; ++rt) af[rt] = *(const LAS bf16x8*)(XC + (rt * 16 + lr) * XS + n * 64 + ks * 32 + lq * 8);
#pragma unroll
              for (int et = 0; et < 2; ++et) { const size_t wo = (size_t)n * 4096 + (eh * 32 + et * 16 + lr) * 64 + ks * 32 + lq * 8; ba[et] = *(const bf16x8*)(wa + wo); bx[et] = *(const bf16x8*)(wx + wo); }
#pragma unroll
              for (int rt = 0; rt < 2; ++rt)
#pragma unroll
                  for (int et = 0; et < 2; ++et) { ca[rt][et] = __builtin_amdgcn_mfma_f32_16x16x32_bf16(af[rt], ba[et], ca[rt][et], 0, 0, 0);
                                                   cx[rt][et] = __builtin_amdgcn_mfma_f32_16x16x32_bf16(af[rt], bx[et], cx[rt][et], 0, 0, 0); } }
#pragma unroll
          for (int et = 0; et < 2; ++et) { const int chn = n * 64 + eh * 32 + et * 16 + lr;
              const float bav = a.in[I_BA][layer * 256 + chn], bxv = a.in[I_BX][layer * 256 + chn], lam = a.in[I_LAM][layer * 256 + chn];
              const float sp = log1pf(expf(-lam));
#pragma unroll
              for (int rt = 0; rt < 2; ++rt)
#pragma unroll
                  for (int reg = 0; reg < 4; ++reg) { const int tl = rt * 16 + lq * 4 + reg;
                      const float r = fast_sigmoid(ca[rt][et][reg] + bav), ig = fast_sigmoid(cx[rt][et][reg] + bxv);
                      const float log_a = -8.0f * r * sp; const float av = fast_exp(log_a);
                      float mult = sqrtf(fmaxf(1.0f - fast_exp(2.0f * log_a), 0.f)); if (s0 + tl == 0) mult = 1.0f;
                      const float xc = XF[tl * 256 + chn];
                      AA[tl * 256 + chn] = av; XF[tl * 256 + chn] = mult * ig * xc; } } }
        __syncthreads();
        if (tid < 256) { float h = 0.f, P = 1.f;
            for (int tl = 0; tl < LRU_CH; ++tl) { const float av = AA[tl * 256 + c], bv = XF[tl * 256 + c]; h = av * h + bv; P *= av;
                HL[(size_t)(t0 + tl) * 256 + c] = f2bf(h); PL[(size_t)(t0 + tl) * 256 + c] = f2bf(P); }
            AGGH[(size_t)unit * 256 + c] = h; AGGP[(size_t)unit * 256 + c] = P; }
    }
}
__device__ __forceinline__ void phase_lru_b(ArgsRef a, int wv) {
    const float* AGGH = (const float*)(a.ws + WS_AGGH); const float* AGGP = (const float*)(a.ws + WS_AGGP); float* CARRY = (float*)(a.ws + WS_CARRY);
    const int tid_ = tid_from(wv);
    for (int idx = blockIdx.x * NTHR + tid_; idx < NB * 256; idx += gridDim.x * NTHR) { const int b = idx >> 8, c = idx & 255; float carry = 0.f;
        for (int k = 0; k < LRU_NCH; ++k) { const size_t o = (size_t)(b * LRU_NCH + k) * 256 + c; CARRY[o] = carry; carry = AGGP[o] * carry + AGGH[o]; } }
}
__device__ __forceinline__ void phase_lru_c(ArgsRef a, int wv) {
    const int tid = tid_from(wv), lane = tid & 63, wave = tid >> 6;
    const int gw = blockIdx.x * NWAVES + wave, NGW = gridDim.x * NWAVES;
    const bf16* proj = (const bf16*)(a.ws + WS_PROJ); bf16* mix = (bf16*)(a.ws + WS_MIX);
    const bf16* HL = (const bf16*)(a.ws + WS_HL); const bf16* PL = (const bf16*)(a.ws + WS_PL); const float* CARRY = (const float*)(a.ws + WS_CARRY);
    for (int t = gw; t < NT; t += NGW) {
        const u32x2 hw = *(const u32x2*)(HL + (size_t)t * 256 + lane * 4), pw = *(const u32x2*)(PL + (size_t)t * 256 + lane * 4), gwd = *(const u32x2*)(proj + (size_t)t * NIN + C_GATE + lane * 4);
        const f32x4 cr = *(const f32x4*)(CARRY + (size_t)(t / LRU_CH) * 256 + lane * 4);
        float h[4] = {bflo(hw.x) + bflo(pw.x) * cr[0], bfhi(hw.x) + bfhi(pw.x) * cr[1], bflo(hw.y) + bflo(pw.y) * cr[2], bfhi(hw.y) + bfhi(pw.y) * cr[3]};
        const float gt[4] = {bflo(gwd.x), bfhi(gwd.x), bflo(gwd.y), bfhi(gwd.y)};
        float s = 0.f;
#pragma unroll
        for (int j = 0; j < 4; ++j) { h[j] *= gelu_tanh(gt[j]); s += h[j] * h[j]; }
        s = wave_sum(s); const float rs = __builtin_amdgcn_rsqf(s * (1.0f / 256.0f) + EPS);
        u32x2 o; o.x = cvt_pk_bf16(h[0] * rs, h[1] * rs); o.y = cvt_pk_bf16(h[2] * rs, h[3] * rs);
        *(u32x2*)(mix + (size_t)t * DM + 256 + lane * 4) = o;
    }
}

__device__ __forceinline__ void phase_attn(ArgsRef a, LAS unsigned char* lds, int wv) {
    const int tid = tid_from(wv), lane = tid & 63, wave = __builtin_amdgcn_readfirstlane(tid >> 6);
    const bf16* proj = (const bf16*)(a.ws + WS_PROJ);
    bf16* PNUM = (bf16*)(a.ws + WS_PNUM); float* PDEN = (float*)(a.ws + WS_PDEN); float* PMAX = (float*)(a.ws + WS_PMAX);
    constexpr int KS = 72, VS = 280, PS = 168;
    LAS bf16* Ks = (LAS bf16*)lds;
    LAS bf16* Vt = (LAS bf16*)(lds + 36864);
    LAS bf16* Pw = (LAS bf16*)(lds + 73728) + wave * 16 * PS;
    const int lr = lane & 15, lq = lane >> 4;
    constexpr int NUNITS = NB * 8 * 3 * 32;
    for (int unit = blockIdx.x; unit < NUNITS; unit += gridDim.x) {
        const int blk = unit & 31, g = (unit >> 5) % 3, h = (unit / 96) & 7, b = unit / 768;
        const int dl = (g == 0) ? 1 : (g == 1 ? 4 : 16), nb = 32 / dl;
        const int n = blk % nb, r = blk / nb;
        const size_t rowb = (size_t)b * SEQ;
        __syncthreads();
        for (int ch = tid; ch < 256 * 8; ch += NTHR) { const int j = ch >> 3, d8 = (ch & 7) * 8; const int l = 128 * (n - 1) + j;
            u32x4 kw = {0u, 0u, 0u, 0u}, vw = {0u, 0u, 0u, 0u};
            if (l >= 0) { const size_t row = rowb + (size_t)l * dl + r; kw = *(const u32x4*)(proj + row * NIN + C_K + h * 64 + d8); vw = *(const u32x4*)(proj + row * NIN + C_V + h * 64 + d8); }
            *(LAS u32x2*)(Ks + j * KS + d8) = (u32x2){kw.x, kw.y}; *(LAS u32x2*)(Ks + j * KS + d8 + 4) = (u32x2){kw.z, kw.w};
            Vt[(d8 + 0) * VS + j] = (bf16)(vw.x & 0xffffu); Vt[(d8 + 1) * VS + j] = (bf16)(vw.x >> 16); Vt[(d8 + 2) * VS + j] = (bf16)(vw.y & 0xffffu); Vt[(d8 + 3) * VS + j] = (bf16)(vw.y >> 16);
            Vt[(d8 + 4) * VS + j] = (bf16)(vw.z & 0xffffu); Vt[(d8 + 5) * VS + j] = (bf16)(vw.z >> 16); Vt[(d8 + 6) * VS + j] = (bf16)(vw.w & 0xffffu); Vt[(d8 + 7) * VS + j] = (bf16)(vw.w >> 16); }
        for (int ch = tid; ch < 64 * 24; ch += NTHR) { const int d = ch / 24, j = 256 + ch % 24; Vt[d * VS + j] = 0; }
        __syncthreads();
        const int qi0 = 16 * wave;
        bf16x8 qf[2];
        { const size_t qrow = rowb + (size_t)(128 * n + qi0 + lr) * dl + r;
#pragma unroll
          for (int ks = 0; ks < 2; ++ks) qf[ks] = *(const bf16x8*)(proj + qrow * NIN + C_Q + h * 64 + ks * 32 + lq * 8); }
        f32x4 sc[9];
#pragma unroll
        for (int kt = 0; kt < 9; ++kt) { sc[kt] = (f32x4){0.f, 0.f, 0.f, 0.f};
#pragma unroll
            for (int ks = 0; ks < 2; ++ks) { const bf16x8 kf = *(const LAS bf16x8*)(Ks + (qi0 + kt * 16 + lr) * KS + ks * 32 + lq * 8);
                sc[kt] = __builtin_amdgcn_mfma_f32_16x16x32_bf16(qf[ks], kf, sc[kt], 0, 0, 0); } }
        float mx[4] = {-1e30f, -1e30f, -1e30f, -1e30f};
#pragma unroll
        for (int kt = 0; kt < 9; ++kt)
#pragma unroll
            for (int reg = 0; reg < 4; ++reg) { const int dist = 128 + lq * 4 + reg - kt * 16 - lr; const int kj = qi0 + kt * 16 + lr;
                const bool ok = (dist >= 0) && (dist <= 128) && (n > 0 || kj >= 128);
                const float v = ok ? sc[kt][reg] : -1e30f; sc[kt][reg] = v; mx[reg] = fmaxf(mx[reg], v); }
#pragma unroll
        for (int reg = 0; reg < 4; ++reg) { float m = mx[reg]; m = fmaxf(m, __shfl_xor(m, 1)); m = fmaxf(m, __shfl_xor(m, 2)); m = fmaxf(m, __shfl_xor(m, 4)); m = fmaxf(m, __shfl_xor(m, 8)); mx[reg] = m; }
        float sm[4] = {0.f, 0.f, 0.f, 0.f};
#pragma unroll
        for (int kt = 0; kt < 9; ++kt)
#pragma unroll
            for (int reg = 0; reg < 4; ++reg) { const float v = sc[kt][reg]; const float p = (v > -1e29f) ? __builtin_amdgcn_exp2f(v - mx[reg]) : 0.f; sm[reg] += p;
                Pw[(lq * 4 + reg) * PS + kt * 16 + lr] = f2bf(p); }
#pragma unroll
        for (int reg = 0; reg < 4; ++reg) { Pw[(lq * 4 + reg) * PS + 144 + lr] = 0;
            float s = sm[reg]; s += __shfl_xor(s, 1); s += __shfl_xor(s, 2); s += __shfl_xor(s, 4); s += __shfl_xor(s, 8); sm[reg] = s; }
        LDS_WAIT(); asm volatile("" ::: "memory");
        f32x4 oc[4];
#pragma unroll
        for (int dt = 0; dt < 4; ++dt) oc[dt] = (f32x4){0.f, 0.f, 0.f, 0.f};
#pragma unroll
        for (int ks = 0; ks < 5; ++ks) { const bf16x8 pf = *(const LAS bf16x8*)(Pw + lr * PS + ks * 32 + lq * 8);
#pragma unroll
            for (int dt = 0; dt < 4; ++dt) { const bf16x8 vf = *(const LAS bf16x8*)(Vt + (dt * 16 + lr) * VS + qi0 + ks * 32 + lq * 8);
                oc[dt] = __builtin_amdgcn_mfma_f32_16x16x32_bf16(pf, vf, oc[dt], 0, 0, 0); } }
#pragma unroll
        for (int reg = 0; reg < 4; ++reg) { const size_t tok = rowb + (size_t)(128 * n + qi0 + lq * 4 + reg) * dl + r;
#pragma unroll
            for (int dt = 0; dt < 4; ++dt) PNUM[((size_t)g * NT + tok) * 512 + h * 64 + dt * 16 + lr] = f2bf(oc[dt][reg]);
            if (lr == 0) { PDEN[((size_t)g * NT + tok) * 8 + h] = sm[reg]; PMAX[((size_t)g * NT + tok) * 8 + h] = mx[reg]; } }
    }
}
__device__ __forceinline__ void phase_merge(ArgsRef a, int wv) {
    const int tid = tid_from(wv), lane = tid & 63, wave = tid >> 6;
    const int gw = blockIdx.x * NWAVES + wave, NGW = gridDim.x * NWAVES;
    const bf16* PNUM = (const bf16*)(a.ws + WS_PNUM); const float* PDEN = (const float*)(a.ws + WS_PDEN); const float* PMAX = (const float*)(a.ws + WS_PMAX);
    bf16* mix = (bf16*)(a.ws + WS_MIX);
    const int hd = lane >> 3;
    for (int t = gw; t < NT; t += NGW) {
        float m[3], dn[3]; u32x4 nw[3];
#pragma unroll
        for (int g = 0; g < 3; ++g) { m[g] = PMAX[((size_t)g * NT + t) * 8 + hd]; dn[g] = PDEN[((size_t)g * NT + t) * 8 + hd]; nw[g] = *(const u32x4*)(PNUM + ((size_t)g * NT + t) * 512 + lane * 8); }
        const float mr = fmaxf(fmaxf(m[0], m[1]), m[2]);
        float o[8] = {0.f, 0.f, 0.f, 0.f, 0.f, 0.f, 0.f, 0.f}; float den = 0.f;
#pragma unroll
        for (int g = 0; g < 3; ++g) { const float w = __builtin_amdgcn_exp2f(m[g] - mr); den += w * dn[g];
            o[0] += w * bflo(nw[g].x); o[1] += w * bfhi(nw[g].x); o[2] += w * bflo(nw[g].y); o[3] += w * bfhi(nw[g].y); o[4] += w * bflo(nw[g].z); o[5] += w * bfhi(nw[g].z); o[6] += w * bflo(nw[g].w); o[7] += w * bfhi(nw[g].w); }
        const float inv = 1.0f / den; float s = 0.f;
#pragma unroll
        for (int j = 0; j < 8; ++j) { o[j] *= inv; s += o[j] * o[j]; }
        s = wave_sum(s); const float rs = __builtin_amdgcn_rsqf(s * (1.0f / 512.0f) + EPS);
        u32x4 w; w.x = cvt_pk_bf16(o[0] * rs, o[1] * rs); w.y = cvt_pk_bf16(o[2] * rs, o[3] * rs); w.z = cvt_pk_bf16(o[4] * rs, o[5] * rs); w.w = cvt_pk_bf16(o[6] * rs, o[7] * rs);
        *(u32x4*)(mix + (size_t)t * DM + 512 + lane * 8) = w;
    }
}

__device__ __forceinline__ void phase_router(ArgsRef a, LAS unsigned char* lds, int layer, int wv) {
    const int tid = tid_from(wv), lane = tid & 63, wave = __builtin_amdgcn_readfirstlane(tid >> 6);
    const bf16* xb = (const bf16*)(a.ws + WS_XB); const bf16* wr = (const bf16*)(a.ws + WS_SMALL) + SM_WR + (size_t)layer * NEXP * DM;
    const float* ssqp = (const float*)(a.ws + WS_SSQP); const float* rbias = a.in[I_BR] + layer * NEXP;
    int* LIST = (int*)(a.ws + WS_LIST); float* LRSTD = (float*)(a.ws + WS_LRSTD); float* LGATE = (float*)(a.ws + WS_LGATE2);
    unsigned* cnt = (unsigned*)(a.ws + WS_CTL) + CW_CNT + layer * NEXP;
    LAS float* LG = (LAS float*)lds + wave * 32 * 33;
    LAS int* hist = (LAS int*)(lds + 65536);
    LAS int* base = (LAS int*)(lds + 65536 + 128);
    const int lr = lane & 15, lq = lane >> 4;
    for (int unit = blockIdx.x; unit < NT / 256; unit += gridDim.x) {
        const int tok0 = unit * 256 + wave * 32;
        __syncthreads();
        if (tid < 32) hist[tid] = 0;
        f32x4 acc[2][2];
#pragma unroll
        for (int rt = 0; rt < 2; ++rt)
#pragma unroll
            for (int et = 0; et < 2; ++et) acc[rt][et] = (f32x4){0.f, 0.f, 0.f, 0.f};
#pragma unroll 4
        for (int ks = 0; ks < 32; ++ks) { bf16x8 af[2], bfr[2];
#pragma unroll
            for (int rt = 0; rt < 2; ++rt) af[rt] = *(const bf16x8*)(xb + (size_t)(tok0 + rt * 16 + lr) * DM + ks * 32 + lq * 8);
#pragma unroll
            for (int et = 0; et < 2; ++et) bfr[et] = *(const bf16x8*)(wr + (size_t)(et * 16 + lr) * DM + ks * 32 + lq * 8);
#pragma unroll
            for (int rt = 0; rt < 2; ++rt)
#pragma unroll
                for (int et = 0; et < 2; ++et) acc[rt][et] = __builtin_amdgcn_mfma_f32_16x16x32_bf16(af[rt], bfr[et], acc[rt][et], 0, 0, 0); }
#pragma unroll
        for (int rt = 0; rt < 2; ++rt)
#pragma unroll
            for (int et = 0; et < 2; ++et)
#pragma unroll
                for (int reg = 0; reg < 4; ++reg) LG[(rt * 16 + lq * 4 + reg) * 33 + et * 16 + lr] = acc[rt][et][reg];
        __syncthreads();
        int te[4] = {0, 0, 0, 0}; float tg[4] = {0.f, 0.f, 0.f, 0.f}; int rk[4] = {0, 0, 0, 0}; float rstd = 0.f; const int tok = tok0 + lane;
        if (lane < 32) {
            const float* sp = ssqp + (size_t)tok * 16; float ss = 0.f;
#pragma unroll
            for (int j = 0; j < 16; ++j) ss += sp[j];
            rstd = __builtin_amdgcn_rsqf(ss * (1.0f / DM) + EPS);
            float tv[4] = {-3e38f, -3e38f, -3e38f, -3e38f};
            for (int e = 0; e < NEXP; ++e) { float v = LG[lane * 33 + e] * rstd + rbias[e]; int ve = e;
#pragma unroll
                for (int k = 0; k < 4; ++k) { if (v > tv[k]) { const float tvv = tv[k]; const int tee = te[k]; tv[k] = v; te[k] = ve; v = tvv; ve = tee; } } }
            float z = 0.f;
#pragma unroll
            for (int k = 0; k < 4; ++k) { tg[k] = fast_exp(tv[k] - tv[0]); z += tg[k]; }
            const float iz = 1.0f / z;
#pragma unroll
            for (int k = 0; k < 4; ++k) { tg[k] *= iz; rk[k] = __hip_atomic_fetch_add(&hist[te[k]], 1, __ATOMIC_RELAXED, __HIP_MEMORY_SCOPE_WORKGROUP); }
        }
        __syncthreads();
        if (tid < 32) base[tid] = (int)__hip_atomic_fetch_add(cnt + tid, (unsigned)hist[tid], RLX_AGENT);
        __syncthreads();
        if (lane < 32) {
#pragma unroll
            for (int k = 0; k < 4; ++k) { const size_t p = (size_t)te[k] * NT + base[te[k]] + rk[k]; LIST[p] = tok * 4 + k; LRSTD[p] = rstd; LGATE[p] = tg[k]; }
        }
    }
}

__device__ __forceinline__ void phase_combine(ArgsRef a, bool last_layer, int wv) {
    const int tid = tid_from(wv), lane = tid & 63, wave = tid >> 6;
    const int gw = blockIdx.x * NWAVES + wave, NGW = gridDim.x * NWAVES;
    const bf16* Y = (const bf16*)(a.ws + WS_Y); float* out = a.out; bf16* xb = (bf16*)(a.ws + WS_XB); float* ssq = (float*)(a.ws + WS_SSQ);
    for (int t = gw; t < NT; t += NGW) {
        f32x4 v[4]; float s = 0.f;
#pragma unroll
        for (int j = 0; j < 4; ++j) { v[j] = *((const f32x4*)(out + (size_t)t * DM) + lane + 64 * j);
#pragma unroll
            for (int k = 0; k < 4; ++k) { const u32x2 w = *((const u32x2*)(Y + ((size_t)t * 4 + k) * DM) + lane + 64 * j); v[j].x += bflo(w.x); v[j].y += bfhi(w.x); v[j].z += bflo(w.y); v[j].w += bfhi(w.y); }
            s += (v[j].x * v[j].x + v[j].y * v[j].y) + (v[j].z * v[j].z + v[j].w * v[j].w);
            *((f32x4*)(out + (size_t)t * DM) + lane + 64 * j) = v[j]; }
        if (!last_layer) { s = wave_sum(s);
#pragma unroll
            for (int j = 0; j < 4; ++j) { u32x2 w; w.x = cvt_pk_bf16(v[j].x, v[j].y); w.y = cvt_pk_bf16(v[j].z, v[j].w); *((u32x2*)(xb + (size_t)t * DM) + lane + 64 * j) = w; }
            if (lane == 0) ssq[t] = s; }
    }
}

constexpr int NPH_LAYER = 13, NPH = 1 + 2 * NPH_LAYER;
enum { PH_GEMM_IN = 0, PH_QKPREP, PH_POOL, PH_LRU_A, PH_LRU_B, PH_ATTN, PH_LRU_C, PH_MERGE, PH_GEMM_OUT, PH_ROUTER, PH_MOE_GU, PH_MOE_DOWN, PH_COMBINE };
#ifndef MK_STOP
#define MK_STOP NPH
#endif
#ifndef MK_SPLIT
#define MK_SPLIT 0
#endif

template <int PHMASK>
__global__ void __launch_bounds__(NTHR, 2) mega_fwd(Args args_by_value) {
    extern __shared__ __attribute__((aligned(16))) unsigned char lds_raw[];
    LAS unsigned char* lds = (LAS unsigned char*)lds_raw;
    const int tid = threadIdx.x;
    int wv = __builtin_amdgcn_readfirstlane(tid >> 6); asm volatile("" : "+s"(wv));
    for (int u = tid; u < (LDS_BYTES - LDSCTL_OFF) / 4; u += NTHR) ((LAS unsigned*)(lds + LDSCTL_OFF))[u] = 0u;
    __syncthreads();
#define ARGS_HERE() const CAS Args* ap_ = (const CAS Args*)__builtin_amdgcn_kernarg_segment_ptr(); asm volatile("" : "+s"(ap_)); ArgsRef args = *ap_; unsigned char* const ws = args.ws; unsigned* const ctl = (unsigned*)(ws + WS_CTL); (void)ctl
    int lo, hi;
    { ARGS_HERE(); lo = args.ph_lo; hi = args.ph_hi; xcd_barrier_post(ctl + CW_BAR + args.li * XCD_BAR_WORDS, (volatile LAS unsigned*)(lds + MISC_OFF) + 8); }
#define EN(p) (((PHMASK) >> (p)) & 1)
#define IN(k) (lo <= (k) && (k) < hi)
#define SEAM(k) do { if (IN(k) && IN((k) + 1)) { ARGS_HERE(); XcdBarrier bar_; bar_.bar = ctl + CW_BAR + args.li * XCD_BAR_WORDS; bar_.x = xb_xcc_id(); bar_.st = (volatile LAS unsigned*)(lds + MISC_OFF) + 8; xcd_barrier(bar_); } } while (0)

    if (EN(13) && IN(0)) { ARGS_HERE(); phase_prologue(args, lds, wv); }
    SEAM(0);
    for (int l = 0; l < 2; ++l) {
        const int pb = 1 + NPH_LAYER * l;
        if (EN(PH_GEMM_IN) && IN(pb + PH_GEMM_IN)) { ARGS_HERE();
            pg8::StaticOrder S; S.init(NT, NIN, DM, gridDim.x, blockIdx.x);
            EpiIn E{(bf16*)(ws + WS_PROJ), (const float*)(ws + WS_SSQ)};
            pg8::gemm_phase<EpiIn, pg8::StaticOrder, true>(lds, (const bf16*)(ws + WS_XB), (const bf16*)(ws + WS_WIN) + (size_t)l * NIN * DM, DM, S, E, wv);
        }
        SEAM(pb + PH_GEMM_IN);
        if (EN(PH_QKPREP) && IN(pb + PH_QKPREP)) { ARGS_HERE(); phase_qkprep(args, l, wv); }
        if (EN(PH_POOL) && IN(pb + PH_POOL)) { ARGS_HERE(); phase_pool(args, lds, l, wv); }
        if (EN(PH_LRU_A) && IN(pb + PH_LRU_A)) { ARGS_HERE(); phase_lru_a(args, lds, l, wv); }
        SEAM(pb + PH_LRU_A);
        if (EN(PH_LRU_B) && IN(pb + PH_LRU_B)) { ARGS_HERE(); phase_lru_b(args, wv); }
        if (EN(PH_ATTN) && IN(pb + PH_ATTN)) { ARGS_HERE(); phase_attn(args, lds, wv); }
        SEAM(pb + PH_ATTN);
        if (EN(PH_LRU_C) && IN(pb + PH_LRU_C)) { ARGS_HERE(); phase_lru_c(args, wv); }
        if (EN(PH_MERGE) && IN(pb + PH_MERGE)) { ARGS_HERE(); phase_merge(args, wv); }
        SEAM(pb + PH_MERGE);
        if (EN(PH_GEMM_OUT) && IN(pb + PH_GEMM_OUT)) { ARGS_HERE();
            __syncthreads();
            pg8::StaticOrder S; S.init(NT, DM, DM, gridDim.x, blockIdx.x);
            EpiOut E{l == 0 ? args.in[I_X] : (const float*)args.out, args.out, (bf16*)(ws + WS_XB), (float*)(ws + WS_SSQP)};
            pg8::gemm_phase<EpiOut, pg8::StaticOrder, true>(lds, (const bf16*)(ws + WS_MIX), (const bf16*)(ws + WS_WOUT) + (size_t)l * DM * DM, DM, S, E, wv);
        }
        SEAM(pb + PH_GEMM_OUT);
        if (EN(PH_ROUTER) && IN(pb + PH_ROUTER)) { ARGS_HERE(); phase_router(args, lds, l, wv); }
        SEAM(pb + PH_ROUTER);
        if (EN(PH_MOE_GU) && IN(pb + PH_MOE_GU)) { ARGS_HERE();
            LAS int* tab = (LAS int*)(lds + TAB_OFF);
            moe_tables(tab, ctl + CW_CNT + l * NEXP, wv);
            MoeOrder<0> S{tab, 2, (int)gridDim.x, (int)blockIdx.x, (const int*)(ws + WS_LIST)};
            EpiGU E{(bf16*)(ws + WS_ACT), (const float*)(ws + WS_LRSTD), args.in[I_BGU] + (size_t)l * NEXP * 512};
            pg8::gemm_phase<EpiGU, MoeOrder<0>, true>(lds, (const bf16*)(ws + WS_XB), (const bf16*)(ws + WS_WGU) + (size_t)l * NEXP * 512 * DM, DM, S, E, wv);
        }
        SEAM(pb + PH_MOE_GU);
        if (EN(PH_MOE_DOWN) && IN(pb + PH_MOE_DOWN)) { ARGS_HERE();
            LAS int* tab = (LAS int*)(lds + TAB_OFF);
            moe_tables(tab, ctl + CW_CNT + l * NEXP, wv);
            MoeOrder<1> S{tab, 4, (int)gridDim.x, (int)blockIdx.x, (const int*)(ws + WS_LIST)};
            EpiDown E{(bf16*)(ws + WS_Y), (const int*)(ws + WS_LIST), (const float*)(ws + WS_LGATE2), args.in[I_BD] + (size_t)l * NEXP * DM, tab};
            pg8::gemm_phase<EpiDown, MoeOrder<1>, true>(lds, (const bf16*)(ws + WS_ACT), (const bf16*)(ws + WS_WD) + (size_t)l * NEXP * DM * EFF, EFF, S, E, wv);
        }
        SEAM(pb + PH_MOE_DOWN);
        if (EN(PH_COMBINE) && IN(pb + PH_COMBINE)) { ARGS_HERE(); phase_combine(args, l == 1, wv); }
        SEAM(pb + PH_COMBINE);
    }
#undef IN
#undef SEAM
}

typedef void (*kern_t)(Args);
template <int M> static kern_t kern_of() { return (kern_t)mega_fwd<M>; }
static kern_t phase_kernel(int p) {
    switch (p) { case 0: return kern_of<1 << 0>(); case 1: return kern_of<1 << 1>(); case 2: return kern_of<1 << 2>(); case 3: return kern_of<1 << 3>(); case 4: return kern_of<1 << 4>();
                 case 5: return kern_of<1 << 5>(); case 6: return kern_of<1 << 6>(); case 7: return kern_of<1 << 7>(); case 8: return kern_of<1 << 8>(); case 9: return kern_of<1 << 9>();
                 case 10: return kern_of<1 << 10>(); case 11: return kern_of<1 << 11>(); case 12: return kern_of<1 << 12>(); default: return kern_of<1 << 13>(); }
}
extern "C" void kernel_launch(void* const* d_in, const int* in_sizes, int n_in, void* d_out, int out_size, void* d_ws, size_t ws_size, hipStream_t stream) {
    static int grid = 0;
    if (grid == 0) {
        if (n_in != 23 || in_sizes[0] != NT * DM || out_size != NT * DM || ws_size < WS_END) {
            fprintf(stderr, "kernel_launch: built for 23 inputs, x/out of %d floats, >= %zu bytes of workspace; got n_in %d, in0 %d, out %d, ws %zu; nothing launched\n", NT * DM, (size_t)WS_END, n_in, n_in > 0 ? in_sizes[0] : -1, out_size, ws_size);
            grid = -1; return; }
        int dev = 0, cus = 0;
        if (hipGetDevice(&dev) != hipSuccess || hipDeviceGetAttribute(&cus, hipDeviceAttributeMultiprocessorCount, dev) != hipSuccess) { fprintf(stderr, "kernel_launch: device query failed\n"); grid = -1; return; }
#if MK_SPLIT
        for (int p = 0; p < 14; ++p) if (hipFuncSetAttribute((const void*)phase_kernel(p), hipFuncAttributeMaxDynamicSharedMemorySize, LDS_BYTES) != hipSuccess) { fprintf(stderr, "kernel_launch: hipFuncSetAttribute failed\n"); grid = -1; return; }
#else
        if (hipFuncSetAttribute((const void*)kern_of<0x3fff>(), hipFuncAttributeMaxDynamicSharedMemorySize, LDS_BYTES) != hipSuccess) { fprintf(stderr, "kernel_launch: hipFuncSetAttribute failed\n"); grid = -1; return; }
        int per_cu = 0;
        if (hipOccupancyMaxActiveBlocksPerMultiprocessor(&per_cu, (const void*)kern_of<0x3fff>(), NTHR, LDS_BYTES) != hipSuccess || per_cu < 1)
            fprintf(stderr, "kernel_launch: note: occupancy query reports %d workgroups per CU\n", per_cu);
#endif
        (void)hipGetLastError();
        grid = cus;
    }
    if (grid < 0) return;
    if (hipMemsetAsync((char*)d_ws + WS_CTL, 0, CTL_ZERO_BYTES, stream) != hipSuccess) { fprintf(stderr, "kernel_launch: hipMemsetAsync failed\n"); return; }
    Args a{};
    for (int i = 0; i < 23; ++i) a.in[i] = (const float*)d_in[i];
    a.out = (float*)d_out; a.ws = (unsigned char*)d_ws; a.pad = 0;
#if MK_SPLIT
#ifdef MK_SKIP
    (void)hipMemsetAsync((char*)d_ws + WS_MIX, 0, (size_t)NT * DM * 2, stream);
#endif
    for (int p = 0; p < MK_STOP; ++p) { a.ph_lo = p; a.ph_hi = p + 1; a.li = p;
#ifdef MK_SKIP
        if (p >= 1 && (((MK_SKIP) >> ((p - 1) % NPH_LAYER)) & 1)) continue;
#endif
        hipLaunchKernelGGL(phase_kernel(p == 0 ? 13 : (p - 1) % NPH_LAYER), dim3(grid), dim3(NTHR), LDS_BYTES, stream, a); }
#else
    a.ph_lo = 0; a.ph_hi = NPH; a.li = 0;
    hipLaunchKernelGGL(kern_of<0x3fff>(), dim3(grid), dim3(NTHR), LDS_BYTES, stream, a);
#endif
    const hipError_t le = hipPeekAtLastError();
    if (le != hipSuccess) fprintf(stderr, "kernel_launch: launch failed: %s\n", hipGetErrorName(le));
}
```

```cpp
#include <hip/hip_runtime.h>
#include <cstdio>
#include <cstdint>

#define LAS __attribute__((address_space(3)))
#define GAS __attribute__((address_space(1)))
typedef unsigned short bf16;
typedef short bf16x8 __attribute__((ext_vector_type(8)));
typedef float f32x4 __attribute__((ext_vector_type(4)));
typedef float f32x2 __attribute__((ext_vector_type(2)));
typedef unsigned u32x4 __attribute__((ext_vector_type(4)));
typedef unsigned u32x2 __attribute__((ext_vector_type(2)));

constexpr int NB = 16, SEQ = 4096, DM = 1024, NT = NB * SEQ;
constexpr int NIN = 2304;
constexpr int C_POOL = 0, C_LRU = 256, C_GATE = 512, C_Q = 768, C_K = 1280, C_V = 1792;
constexpr int NEXP = 32, TOPK = 4, EFF = 256;
constexpr int NASSIGN = NT * TOPK;
constexpr int ACT_ROWS = NASSIGN + NEXP * 256;
constexpr float EPS = 1e-6f;
constexpr int NWAVES = 8, NTHR = 512;
constexpr int LRU_CH = 32, LRU_NCH = SEQ / LRU_CH;

constexpr size_t MiB = 1u << 20;
constexpr size_t WS_CTL = 0, CTL_ZERO_BYTES = 1 * MiB;
constexpr size_t WS_ROPE = 1 * MiB;
constexpr size_t WS_SMALL = 2 * MiB;
constexpr size_t WS_WIN = 4 * MiB;
constexpr size_t WS_WOUT = 13 * MiB;
constexpr size_t WS_WGU = 17 * MiB;
constexpr size_t WS_WD = 81 * MiB;
constexpr size_t WS_SSQ = 113 * MiB;
constexpr size_t WS_SSQP = 114 * MiB;
constexpr size_t WS_LIST = 118 * MiB;
constexpr size_t WS_XB = 128 * MiB;
constexpr size_t WS_R = 256 * MiB;
constexpr size_t WS_PROJ = WS_R;
constexpr size_t WS_MIX = WS_R + 288 * MiB;
constexpr size_t WS_PNUM = WS_R + 416 * MiB;
constexpr size_t WS_PDEN = WS_R + 608 * MiB;
constexpr size_t WS_PMAX = WS_R + 614 * MiB;
constexpr size_t WS_HL = WS_R + 620 * MiB;
constexpr size_t WS_PL = WS_R + 652 * MiB;
constexpr size_t WS_AGGH = WS_R + 684 * MiB;
constexpr size_t WS_AGGP = WS_R + 686 * MiB;
constexpr size_t WS_CARRY = WS_R + 688 * MiB;
constexpr size_t WS_ACT = WS_R;
constexpr size_t WS_Y = WS_R + 132 * MiB;
constexpr size_t WS_LRSTD = WS_R + 644 * MiB;
constexpr size_t WS_LGATE2 = WS_R + 652 * MiB;
constexpr size_t WS_END = 1024 * MiB;
static_assert(WS_CARRY + 2 * MiB <= WS_END && WS_LGATE2 + 8 * MiB <= WS_END, "d_ws map");
constexpr size_t SM_POOLW = 0;
constexpr size_t SM_WA = 32768;
constexpr size_t SM_WX = 65536;
constexpr size_t SM_WR = 98304;
constexpr int CW_BAR = 4096;
constexpr int CW_CNT = 1024;

constexpr int RING_BYTES = 131072;
constexpr int LDSCTL_OFF = RING_BYTES;
constexpr int MISC_OFF = LDSCTL_OFF + 320;
constexpr int TAB_OFF = LDSCTL_OFF + 1024;
constexpr int LDS_BYTES = 147456;

typedef GAS unsigned gu32;
#define RLX_AGENT __ATOMIC_RELAXED, __HIP_MEMORY_SCOPE_AGENT
#define LDS_WAIT() asm volatile("s_waitcnt lgkmcnt(0)" ::: "memory")
#define VM_WAIT() asm volatile("s_waitcnt vmcnt(0)" ::: "memory")
typedef __bf16 bf16x2_t __attribute__((ext_vector_type(2)));
__device__ __forceinline__ unsigned cvt_pk_bf16(float lo, float hi) { const f32x2 v = {lo, hi}; const bf16x2_t b = __builtin_convertvector(v, bf16x2_t); return __builtin_bit_cast(unsigned, b); }
__device__ __forceinline__ float bflo(unsigned w) { return __uint_as_float(w << 16); }
__device__ __forceinline__ float bfhi(unsigned w) { return __uint_as_float(w & 0xffff0000u); }
__device__ __forceinline__ float bf2f(bf16 h) { return __uint_as_float((unsigned)h << 16); }
__device__ __forceinline__ bf16 f2bf(float f) { return (bf16)(cvt_pk_bf16(f, 0.f) & 0xffffu); }
__device__ __forceinline__ float wave_sum(float v) {
#pragma unroll
    for (int o = 1; o < 64; o <<= 1) v += __shfl_xor(v, o);
    return v;
}
__device__ __forceinline__ float fast_sigmoid(float x) { return __builtin_amdgcn_rcpf(1.0f + __builtin_amdgcn_exp2f(-1.4426950408889634f * x)); }
__device__ __forceinline__ float fast_exp(float x) { return __builtin_amdgcn_exp2f(1.4426950408889634f * x); }
__device__ __forceinline__ float gelu_tanh(float x) {
    const float u = 0.7978845608028654f * (x + 0.044715f * x * x * x);
    return x * fast_sigmoid(2.0f * u);
}
__device__ __forceinline__ int tid_from(int wv) { int ln; asm volatile("v_mbcnt_lo_u32_b32 %0, -1, 0\n\tv_mbcnt_hi_u32_b32 %0, -1, %0" : "=v"(ln)); return wv * 64 + ln; }
namespace pg8 {
constexpr int BM = 256, BK = 64, HALF = 128, HTB = HALF * BK * 2  , STAGE_BYTES = 8 * HTB, NXCD = 8, WGM = 8;

__host__ __device__ __forceinline__ int lds_byte(int r, int c) { const int st = (r >> 4) * 2 + (c >> 5), rr = r & 15, cc = c & 31, ob = rr * 64 + cc * 2; return st * 1024 + (ob ^ (((ob >> 9) & 1) << 5)); }
__host__ __device__ __forceinline__ void stage_rc(int b, int& R, int& C) { const int st = b / 1024, sb = b % 1024, swz = sb ^ (((sb >> 9) & 1) << 5); R = (st >> 1) * 16 + swz / 64; C = (st & 1) * 32 + (swz % 64) / 2; }
__host__ __device__ __forceinline__ int perm32(int rho) { const int n = rho >> 4, i = rho & 15; return 8 * (i >> 2) + 4 * n + (i & 3); }

struct Unit { int pm, pn, e, aux; };

template <class Epi, class Sched, bool ALIGN_EPI>
__device__ __forceinline__ void gemm_phase(LAS unsigned char* lds, const bf16* Abase, const bf16* Bbase, const int K, const Sched& S, const Epi& E, const int wv) {
    const int tid = tid_from(wv), wid = __builtin_amdgcn_readfirstlane(tid >> 6), lane = tid & 63, wr = wid >> 2, wc = wid & 3, fr = lane & 15, fq = lane >> 4;
    const int nt = K / BK;
    unsigned voffB[2];
#pragma unroll
    for (int i = 0; i < 2; ++i) { int R, C; stage_rc(tid * 16 + i * 8192, R, C); const int Rb = Epi::PERM ? ((R & ~31) + perm32(R & 31)) : R;
        voffB[i] = (unsigned)(Rb * K + C) * 2u; }
#define PG8_AVOFF(u, h, i) ([&]() { int R_, C_; stage_rc(tid * 16 + (i) * 8192, R_, C_); return S.a_voff((u), (h) * HALF + R_, C_); }())
    const unsigned kstep = (unsigned)(BK * 2);
    const unsigned hstep = (unsigned)(HALF * K * 2);
    const unsigned ldsw = (unsigned)wid * 1024u;
    const int aoff = lds_byte(wr * 64 + fr, fq * 8), boff = lds_byte(wc * 32 + fr, fq * 8);
    const __amdgpu_buffer_rsrc_t rsA = __builtin_amdgcn_make_buffer_rsrc((void*)Abase, 0, 0x7fffffff, 0x00020000);
    const __amdgpu_buffer_rsrc_t rsB = __builtin_amdgcn_make_buffer_rsrc((void*)Bbase, 0, 0x7fffffff, 0x00020000);
#define PG8_SA(b, h) (((b) * 2 + (h)) * HTB)
#define PG8_SB(b, h) ((4 + (b) * 2 + (h)) * HTB)
#define PG8_STAGE_B(bufoff, soff) do { const int so_ = __builtin_amdgcn_readfirstlane((int)(soff)); _Pragma("unroll") for (int _i = 0; _i < 2; ++_i) \
        __builtin_amdgcn_raw_ptr_buffer_load_lds(rsB, (LAS void*)(lds + (bufoff) + ldsw + _i * 8192), 16, voffB[_i], so_, 0, 0); } while (0)
#define PG8_STAGE_A(bufoff, kbytes, v0, v1) do { const int so_ = __builtin_amdgcn_readfirstlane((int)(kbytes)); \
        __builtin_amdgcn_raw_ptr_buffer_load_lds(rsA, (LAS void*)(lds + (bufoff) + ldsw), 16, (v0), so_, 0, 0); \
        __builtin_amdgcn_raw_ptr_buffer_load_lds(rsA, (LAS void*)(lds + (bufoff) + ldsw + 8192), 16, (v1), so_, 0, 0); } while (0)
#define PG8_LDA(dst, b, h) do { _Pragma("unroll") for (int m = 0; m < 4; ++m) _Pragma("unroll") for (int k = 0; k < 2; ++k) dst[m][k] = *(const LAS bf16x8*)(lds + PG8_SA(b, h) + aoff + m * 2048 + k * 1024); } while (0)
#define PG8_LDB(dst, b, h) do { _Pragma("unroll") for (int n = 0; n < 2; ++n) _Pragma("unroll") for (int k = 0; k < 2; ++k) dst[n][k] = *(const LAS bf16x8*)(lds + PG8_SB(b, h) + boff + n * 2048 + k * 1024); } while (0)
#define PG8_MMA(ai, bj, At, Bt) do { __builtin_amdgcn_s_setprio(1); _Pragma("unroll") for (int m = 0; m < 4; ++m) _Pragma("unroll") for (int n = 0; n < 2; ++n) _Pragma("unroll") for (int k = 0; k < 2; ++k) \
        acc[ai][bj][m][n] = __builtin_amdgcn_mfma_f32_16x16x32_bf16(Bt[n][k], At[m][k], acc[ai][bj][m][n], 0, 0, 0); __builtin_amdgcn_s_setprio(0); } while (0)
#define PG8_WAIT_V(n) asm volatile("s_waitcnt vmcnt(" #n ")" ::: "memory")
#define PG8_WAIT_L(n) asm volatile("s_waitcnt lgkmcnt(" #n ")" ::: "memory")
#define PG8_BAR __builtin_amdgcn_s_barrier()
#define PG8_SCHED __builtin_amdgcn_sched_barrier(0)
    Unit cur, nxt; int ui = 0;
    if (!S.next(0, cur)) return;
    f32x4 acc[2][2][4][2];
#pragma unroll
    for (int a = 0; a < 2; ++a)
#pragma unroll
        for (int b = 0; b < 2; ++b)
#pragma unroll
            for (int m = 0; m < 4; ++m)
#pragma unroll
                for (int n = 0; n < 2; ++n) acc[a][b][m][n] = (f32x4){0.f, 0.f, 0.f, 0.f};
    bf16x8 At[4][2], B0[2][2], B1[2][2];
    unsigned vc0, vc1, vc2, vc3, vn0, vn1, vn2, vn3;
    unsigned cA0, cA1, nA0, nA1;
    vc0 = PG8_AVOFF(cur, 0, 0); vc1 = PG8_AVOFF(cur, 0, 1);
    if constexpr (Sched::GATHER) { vc2 = PG8_AVOFF(cur, 1, 0); vc3 = PG8_AVOFF(cur, 1, 1); } else { vc2 = vc0; vc3 = vc1; }
    cA0 = S.a_soff(cur, 0); cA1 = S.a_soff(cur, 1);
    unsigned cB = (unsigned)S.b_off(cur);
    PG8_STAGE_B(PG8_SB(0, 0), cB); PG8_STAGE_B(PG8_SB(0, 1), cB + hstep); PG8_STAGE_A(PG8_SA(0, 0), cA0, vc0, vc1); PG8_STAGE_A(PG8_SA(0, 1), cA1, vc2, vc3);
    if (wr == 1) PG8_BAR;
    PG8_WAIT_V(2); PG8_BAR;
    PG8_STAGE_B(PG8_SB(1, 0), cB + kstep); PG8_STAGE_A(PG8_SA(1, 0), cA0 + kstep, vc0, vc1); PG8_STAGE_B(PG8_SB(1, 1), cB + hstep + kstep);
    PG8_WAIT_V(6); PG8_BAR;
    for (;;) {
#define PG8_TRIP(a1k, a2k0, a2k1, a3k0, b2, b3, w0, w1, w2, w3) do { \
              \
            PG8_LDB(B0, 0, 0); PG8_LDB(B1, 0, 1); PG8_SCHED; PG8_LDA(At, 0, 0); PG8_STAGE_A(PG8_SA(1, 1), a1k, vc2, vc3); \
            PG8_WAIT_V(8); PG8_WAIT_L(0); PG8_BAR; PG8_MMA(0, 0, At, B0); PG8_MMA(0, 1, At, B1); PG8_BAR; PG8_SCHED; \
              \
            PG8_LDA(At, 0, 1); PG8_STAGE_B(PG8_SB(0, 0), b2); PG8_STAGE_B(PG8_SB(0, 1), (b2) + hstep); PG8_STAGE_A(PG8_SA(0, 0), a2k0, w0, w1); \
            PG8_WAIT_V(8); PG8_WAIT_L(0); PG8_BAR; PG8_MMA(1, 0, At, B0); PG8_MMA(1, 1, At, B1); PG8_BAR; PG8_SCHED; \
              \
            PG8_LDB(B0, 1, 0); PG8_LDB(B1, 1, 1); PG8_SCHED; PG8_LDA(At, 1, 0); PG8_STAGE_A(PG8_SA(0, 1), a2k1, w2, w3); \
            PG8_WAIT_V(8); PG8_WAIT_L(0); PG8_BAR; PG8_MMA(0, 0, At, B0); PG8_MMA(0, 1, At, B1); PG8_BAR; PG8_SCHED; \
              \
            PG8_LDA(At, 1, 1); PG8_STAGE_B(PG8_SB(1, 0), b3); PG8_STAGE_B(PG8_SB(1, 1), (b3) + hstep); PG8_STAGE_A(PG8_SA(1, 0), a3k0, w0, w1); \
            PG8_WAIT_V(8); PG8_WAIT_L(0); PG8_BAR; PG8_MMA(1, 0, At, B0); PG8_MMA(1, 1, At, B1); PG8_BAR; PG8_SCHED; } while (0)
        for (int t = 0; t < nt - 2; t += 2) {
            const unsigned k1 = (unsigned)(t + 1) * kstep, k2 = (unsigned)(t + 2) * kstep, b2 = cB + k2, b3 = b2 + kstep;
            PG8_TRIP(cA1 + k1, cA0 + k2, cA1 + k2, cA0 + k2 + kstep, b2, b3, vc0, vc1, vc2, vc3);
        }
        const bool has_next = S.next(ui + 1, nxt);
        unsigned nB;
        if (has_next) { if constexpr (Sched::GATHER) { vn0 = PG8_AVOFF(nxt, 0, 0); vn1 = PG8_AVOFF(nxt, 0, 1); vn2 = PG8_AVOFF(nxt, 1, 0); vn3 = PG8_AVOFF(nxt, 1, 1); } else { vn0 = vc0; vn1 = vc1; vn2 = vc0; vn3 = vc1; }
                        nA0 = S.a_soff(nxt, 0); nA1 = S.a_soff(nxt, 1); nB = (unsigned)S.b_off(nxt); }
        else { vn0 = vc0; vn1 = vc1; vn2 = vc2; vn3 = vc3; nA0 = cA0; nA1 = cA1; nB = cB; }
        { const unsigned k1 = (unsigned)(nt - 1) * kstep;
          PG8_TRIP(cA1 + k1, nA0, nA1, nA0 + kstep, nB, nB + kstep, vn0, vn1, vn2, vn3); }
#undef PG8_TRIP
        if constexpr (ALIGN_EPI) { if (wr == 0) PG8_BAR; }
        E(acc, cur, wr, wc, fr, fq);
        if (!has_next) break;
#pragma unroll
        for (int a = 0; a < 2; ++a)
#pragma unroll
            for (int b = 0; b < 2; ++b)
#pragma unroll
                for (int m = 0; m < 4; ++m)
#pragma unroll
                    for (int n = 0; n < 2; ++n) acc[a][b][m][n] = (f32x4){0.f, 0.f, 0.f, 0.f};
        cur = nxt; cB = nB; cA0 = nA0; cA1 = nA1; vc0 = vn0; vc1 = vn1; vc2 = vn2; vc3 = vn3; ++ui;
        if constexpr (ALIGN_EPI) { if (wr == 1) PG8_BAR; }
    }
    PG8_WAIT_V(0);
    if constexpr (!ALIGN_EPI) { if (wr == 0) PG8_BAR; }
    PG8_BAR;
#undef PG8_SA
#undef PG8_AVOFF
#undef PG8_SB
#undef PG8_STAGE_A
#undef PG8_STAGE_B
#undef PG8_LDA
#undef PG8_LDB
#undef PG8_MMA
#undef PG8_WAIT_V
#undef PG8_WAIT_L
#undef PG8_BAR
#undef PG8_SCHED
}

struct StaticOrder {
    int nM, nN, nwg, G, c, lda, dup;
    __device__ __forceinline__ void init(int M, int N, int lda_, int G_, int c_) { nM = M / BM; nN = N / BM; nwg = nM * nN; G = G_; c = c_; lda = lda_; dup = 0; }
    __device__ __forceinline__ bool next(int i, Unit& u) const {
        const long L = (long)(i >> dup) * G + c; if (L >= nwg) return false;
        int wgid = (int)L; { const int q = nwg / NXCD, r = nwg % NXCD, xcd = wgid % NXCD, off = wgid / NXCD; wgid = (xcd < r ? xcd * (q + 1) : r * (q + 1) + (xcd - r) * q) + off; }
        const int nig = WGM * nN, gid = wgid / nig, fm = gid * WGM, gsz = (nM - fm) < WGM ? (nM - fm) : WGM;
        u.pm = fm + ((wgid % nig) % gsz); u.pn = (wgid % nig) / gsz; u.e = 0; u.aux = 0; return true;
    }
    static constexpr bool GATHER = false;
    __device__ __forceinline__ unsigned a_voff(const Unit&, int R, int C) const { return (unsigned)((R & (HALF - 1)) * lda + C) * 2u; }
    __device__ __forceinline__ unsigned a_soff(const Unit& u, int h) const { return (unsigned)((u.pm * BM + h * HALF) * lda) * 2u; }
    __device__ __forceinline__ size_t b_off(const Unit& u) const { return (size_t)u.pn * BM * lda * 2; }
};
}

#define XB_TMO      128
#define XB_XCNT(j)  (256  + 64 * (j))
#define XB_XSUB(j)  (1280 + 64 * (j))
#define XB_XGEN(j)  (2304 + 64 * (j))
#define XB_TOP      3328
#define XB_TOPGEN   3392
#define XCD_BAR_WORDS 3456
#define XB_SPIN_CAP (1u << 18)

__device__ __forceinline__ unsigned xb_ld(unsigned* p)              { return __hip_atomic_load(p, __ATOMIC_RELAXED, __HIP_MEMORY_SCOPE_AGENT); }
__device__ __forceinline__ unsigned xb_add(unsigned* p, unsigned v) { return __hip_atomic_fetch_add(p, v, __ATOMIC_RELAXED, __HIP_MEMORY_SCOPE_AGENT); }
__device__ __forceinline__ unsigned xb_xcc_id() { return (unsigned)__builtin_amdgcn_s_getreg((3 << 11) | 20) & 0xFu; }
#define XB_SPIN(cond, bar) do { unsigned _sp = 0; while (cond) { __builtin_amdgcn_s_sleep(1); \
    if ((++_sp & 255u) == 0u) { if (xb_ld(&(bar)[XB_TMO])) break; if (_sp > XB_SPIN_CAP) { atomicAdd(&(bar)[XB_TMO], 1u); break; } } } } while (0)

struct XcdBarrier {
    unsigned* bar; unsigned x;
    volatile LAS unsigned* st;
};

__device__ __forceinline__ XcdBarrier xcd_barrier_post(unsigned* bar, volatile LAS unsigned* st) {
    XcdBarrier b; b.bar = bar; b.x = xb_xcc_id(); b.st = st;
    if (threadIdx.x == 0) (void)xb_add(&bar[XB_XCNT(b.x)], 1u);
    return b;
}
__device__ __forceinline__ void xcd_barrier_complete(unsigned* bar, unsigned x, unsigned& nloc, unsigned& nx) {
    const unsigned G = gridDim.x * gridDim.y * gridDim.z;
    unsigned sum, cnt, mine, sp = 0u;
    for (;;) {
        sum = 0u; cnt = 0u; mine = 0u;
#pragma unroll
        for (unsigned j = 0; j < 16; ++j) { const unsigned c = xb_ld(&bar[XB_XCNT(j)]); sum += c; cnt += (c > 0u) ? 1u : 0u; mine = (j == x) ? c : mine; }
        if (sum == G) break;
        __builtin_amdgcn_s_sleep(1);
        if ((++sp & 255u) == 0u) { if (xb_ld(&bar[XB_TMO])) break; if (sp > XB_SPIN_CAP) { atomicAdd(&bar[XB_TMO], 1u); break; } }
    }
    nloc = mine > 0u ? mine : 1u; nx = cnt > 0u ? cnt : 1u;
}

__device__ __forceinline__ void xcd_barrier(const XcdBarrier& b) {
    asm volatile("s_waitcnt vmcnt(0)" ::: "memory");
    __syncthreads();
    if (threadIdx.x == 0) {
        unsigned* bar = b.bar;
        __builtin_amdgcn_s_waitcnt(0);
        unsigned nloc = b.st[0], nx = b.st[1];
        if (nloc == 0u) { xcd_barrier_complete(bar, b.x, nloc, nx); b.st[0] = nloc; b.st[1] = nx; }
        const unsigned old = xb_add(&bar[XB_XSUB(b.x)], 1u);
        const unsigned gen = old / nloc;
        if (old + 1u == (gen + 1u) * nloc) {
            __builtin_amdgcn_fence(__ATOMIC_RELEASE, "agent");
            asm volatile("s_waitcnt vmcnt(0)" ::: "memory");
            const unsigned og = xb_add(&bar[XB_TOP], 1u);
            const unsigned tg = og / nx;
            if (og + 1u == (tg + 1u) * nx) xb_add(&bar[XB_TOPGEN], 1u);
            else XB_SPIN(xb_ld(&bar[XB_TOPGEN]) == tg, bar);
            __builtin_amdgcn_fence(__ATOMIC_ACQUIRE, "agent");
            xb_add(&bar[XB_XGEN(b.x)], 1u);
            asm volatile("s_waitcnt vmcnt(0)" ::: "memory");
        } else {
            XB_SPIN(xb_ld(&bar[XB_XGEN(b.x)]) == gen, bar);
            __builtin_amdgcn_fence(__ATOMIC_ACQUIRE, "agent");
            asm volatile("s_waitcnt vmcnt(0)" ::: "memory");
        }
    }
    __syncthreads();
}

struct Args { const float* in[23]; float* out; unsigned char* ws; int ph_lo, ph_hi, li, pad; };
#define CAS __attribute__((address_space(4)))
typedef const CAS Args& ArgsRef;
enum { I_X = 0, I_NORM1G, I_WIN, I_POOLW, I_POOLSC, I_CONVW, I_CONVB, I_WA, I_BA, I_WX, I_BX, I_LAM, I_QG, I_KG, I_OG, I_WOUT, I_NORM2G, I_WR, I_BR, I_WGU, I_BGU, I_WD, I_BD };

__device__ __forceinline__ void tr_item(const float* W, int K, int N, bf16* WT, const float* gk, int mode, LAS float* scr, int item, int lane) {
    const int nblk = N / 32, kb = item / nblk, nb = item % nblk, k0 = 64 * kb, n0 = 32 * nb;
#pragma unroll 8
    for (int i = 0; i < 32; ++i) { const int kk = 2 * i + (lane >> 5); float v = W[(size_t)(k0 + kk) * N + n0 + (lane & 31)]; if (gk) v *= gk[k0 + kk]; scr[kk * 33 + (lane & 31)] = v; }
    LDS_WAIT(); asm volatile("" ::: "memory");
    const int c = lane & 7;
#pragma unroll
    for (int j = 0; j < 4; ++j) { const int n = (lane >> 3) + 8 * j; const LAS float* s = scr + (8 * c) * 33 + n;
        u32x4 o; o.x = cvt_pk_bf16(s[0 * 33], s[1 * 33]); o.y = cvt_pk_bf16(s[2 * 33], s[3 * 33]); o.z = cvt_pk_bf16(s[4 * 33], s[5 * 33]); o.w = cvt_pk_bf16(s[6 * 33], s[7 * 33]);
        int dn = n0 + n;
        if (mode == 1) { const int jj = dn & 255; dn = (jj >> 7) * 256 + (dn >> 8) * 128 + (jj & 127); }
        *(u32x4*)(WT + (size_t)dn * K + k0 + 8 * c) = o; }
    LDS_WAIT(); asm volatile("" ::: "memory");
}
__device__ __forceinline__ void cvt_row(const float* xrow, bf16* orow, float* ssq, int lane) {
    const f32x4* xr = (const f32x4*)xrow + lane;
    f32x4 v[4]; float s = 0.f;
#pragma unroll
    for (int j = 0; j < 4; ++j) { v[j] = xr[64 * j]; s += (v[j].x * v[j].x + v[j].y * v[j].y) + (v[j].z * v[j].z + v[j].w * v[j].w); }
    s = wave_sum(s);
    u32x2* o8 = (u32x2*)orow + lane;
#pragma unroll
    for (int j = 0; j < 4; ++j) { u32x2 w; w.x = cvt_pk_bf16(v[j].x, v[j].y); w.y = cvt_pk_bf16(v[j].z, v[j].w); o8[64 * j] = w; }
    if (lane == 0) *ssq = s;
}
__device__ __forceinline__ void phase_prologue(ArgsRef a, LAS unsigned char* lds, int wv) {
    const int tid = tid_from(wv), lane = tid & 63, wave = tid >> 6;
    LAS float* scr = (LAS float*)(lds + wave * 16384);
    const int gw = blockIdx.x * NWAVES + wave, NGW = gridDim.x * NWAVES;
    unsigned char* ws = a.ws;
    constexpr int I_IN = 16 * 72, I_OUT = 16 * 32, I_R = 16, I_GU = 16 * 16, I_D = 4 * 32, I_S = 2;
    constexpr int PER_LAYER = I_IN + I_OUT + I_R + NEXP * I_GU + NEXP * I_D + 12 * I_S;
    for (int it = gw; it < 2 * PER_LAYER; it += NGW) {
        const int l = it / PER_LAYER; int r = it % PER_LAYER;
        if (r < I_IN) { tr_item(a.in[I_WIN] + (size_t)l * DM * NIN, DM, NIN, (bf16*)(ws + WS_WIN) + (size_t)l * NIN * DM, a.in[I_NORM1G] + l * DM, 0, scr, r, lane); continue; } r -= I_IN;
        if (r < I_OUT) { tr_item(a.in[I_WOUT] + (size_t)l * DM * DM, DM, DM, (bf16*)(ws + WS_WOUT) + (size_t)l * DM * DM, a.in[I_OG] + l * DM, 0, scr, r, lane); continue; } r -= I_OUT;
        if (r < I_R) { tr_item(a.in[I_WR] + (size_t)l * DM * NEXP, DM, NEXP, (bf16*)(ws + WS_SMALL) + SM_WR + (size_t)l * NEXP * DM, a.in[I_NORM2G] + l * DM, 0, scr, r, lane); continue; } r -= I_R;
        if (r < NEXP * I_GU) { const int e = r / I_GU; tr_item(a.in[I_WGU] + (size_t)(l * NEXP + e) * DM * 512, DM, 512, (bf16*)(ws + WS_WGU) + (size_t)(l * NEXP + e) * 512 * DM, a.in[I_NORM2G] + l * DM, 1, scr, r % I_GU, lane); continue; } r -= NEXP * I_GU;
        if (r < NEXP * I_D) { const int e = r / I_D; tr_item(a.in[I_WD] + (size_t)(l * NEXP + e) * EFF * DM, EFF, DM, (bf16*)(ws + WS_WD) + (size_t)(l * NEXP + e) * DM * EFF, nullptr, 0, scr, r % I_D, lane); continue; } r -= NEXP * I_D;
        { const int which = r / (4 * I_S), g = (r / I_S) % 4, sub = r % I_S;
          const float* src = a.in[which == 0 ? I_POOLW : (which == 1 ? I_WA : I_WX)] + (size_t)(l * 4 + g) * 4096;
          bf16* dst = (bf16*)(ws + WS_SMALL) + (which == 0 ? SM_POOLW : (which == 1 ? SM_WA : SM_WX)) + (size_t)(l * 4 + g) * 4096;
          tr_item(src, 64, 64, dst, nullptr, 0, scr, sub, lane); }
    }
    { float* ct = (float*)(ws + WS_ROPE); float* st = ct + SEQ * 32;
      for (int idx = blockIdx.x * NTHR + tid; idx < SEQ * 32; idx += gridDim.x * NTHR) {
          const int pos = idx >> 5, i = idx & 31;
          const float inv = __builtin_amdgcn_exp2f(-(float)i * 0.41524101186092029f);
          const float ang = (float)pos * inv;
          const double rev = (double)ang * 0.15915494309189535; const double fr = rev - __builtin_rint(rev);
          const float f = (float)fr;
          ct[idx] = __builtin_amdgcn_cosf(f); st[idx] = __builtin_amdgcn_sinf(f); } }
    for (int m = gw; m < NT; m += NGW) cvt_row(a.in[I_X] + (size_t)m * DM, (bf16*)(ws + WS_XB) + (size_t)m * DM, (float*)(ws + WS_SSQ) + m, lane);
}

struct EpiIn {
    static constexpr bool PERM = true;
    bf16* O; const float* ssq;
    __device__ __forceinline__ void operator()(const f32x4 (&acc)[2][2][4][2], const pg8::Unit& u, int wr, int wc, int fr, int fq) const {
        const int row0 = u.pm * 256 + wr * 64 + fr, col0 = u.pn * 256 + wc * 32 + 8 * fq;
#pragma unroll
        for (int ai = 0; ai < 2; ++ai)
#pragma unroll
            for (int m = 0; m < 4; ++m) { const int row = row0 + ai * 128 + m * 16; const float rs = __builtin_amdgcn_rsqf(ssq[row] * (1.0f / DM) + EPS);
                bf16* rowp = O + (size_t)row * NIN + col0;
#pragma unroll
                for (int bj = 0; bj < 2; ++bj) { const f32x4 v0 = acc[ai][bj][m][0] * rs, v1 = acc[ai][bj][m][1] * rs;
                    u32x4 w; w.x = cvt_pk_bf16(v0[0], v0[1]); w.y = cvt_pk_bf16(v0[2], v0[3]); w.z = cvt_pk_bf16(v1[0], v1[1]); w.w = cvt_pk_bf16(v1[2], v1[3]);
                    *(u32x4*)(rowp + bj * 128) = w; } }
    }
};
struct EpiOut {
    static constexpr bool PERM = false;
    const float* xin; float* out; bf16* xb; float* ssqp;
    __device__ __forceinline__ void operator()(const f32x4 (&acc)[2][2][4][2], const pg8::Unit& u, int wr, int wc, int fr, int fq) const {
        const int row0 = u.pm * 256 + wr * 64 + fr, col0 = u.pn * 256 + wc * 32 + 4 * fq;
#pragma unroll
        for (int ai = 0; ai < 2; ++ai)
#pragma unroll
            for (int m = 0; m < 4; ++m) { const int row = row0 + ai * 128 + m * 16; const size_t off = (size_t)row * DM + col0; float s = 0.f;
#pragma unroll
                for (int bj = 0; bj < 2; ++bj)
#pragma unroll
                    for (int n = 0; n < 2; ++n) { const f32x4 o = *(const f32x4*)(xin + off + bj * 128 + n * 16) + acc[ai][bj][m][n];
                        *(f32x4*)(out + off + bj * 128 + n * 16) = o; s += (o[0] * o[0] + o[1] * o[1]) + (o[2] * o[2] + o[3] * o[3]);
                        u32x2 w; w.x = cvt_pk_bf16(o[0], o[1]); w.y = cvt_pk_bf16(o[2], o[3]); *(u32x2*)(xb + off + bj * 128 + n * 16) = w; }
                s += __shfl_xor(s, 16); s += __shfl_xor(s, 32);
                if (fq == 0) ssqp[(size_t)row * 16 + u.pn * 4 + wc] = s; }
    }
};

template <int MODE> struct MoeOrder {
    static constexpr bool GATHER = (MODE == 0);
    const LAS int* tab; int npn, G, c; const int* list; int dup;
    __device__ __forceinline__ bool next(int i, pg8::Unit& u) const {
        const int L = (i >> dup) * G + c; const int total = __builtin_amdgcn_readfirstlane(tab[64]) * npn; if (L >= total) return false;
        const int gb = L / npn; u.pn = L % npn; int e = 0;
        for (int k = 1; k < NEXP; ++k) { if (__builtin_amdgcn_readfirstlane(tab[32 + k]) <= gb) e = k; }
        u.e = e; u.pm = gb; u.aux = gb - __builtin_amdgcn_readfirstlane(tab[32 + e]); return true;
    }
    __device__ __forceinline__ unsigned a_voff(const pg8::Unit& u, int R, int C) const {
        if constexpr (MODE == 0) { const int pos = u.aux * 256 + R; const int ne = tab[u.e]; int tok = 0; if (pos < ne) tok = list[u.e * NT + pos] >> 2; return (unsigned)(tok * DM + C) * 2u; }
        else return (unsigned)((R & 127) * EFF + C) * 2u;
    }
    __device__ __forceinline__ unsigned a_soff(const pg8::Unit& u, int h) const { if constexpr (MODE == 0) return 0u; else return (unsigned)((u.pm * 256 + h * 128) * EFF) * 2u; }
    __device__ __forceinline__ size_t b_off(const pg8::Unit& u) const {
        if constexpr (MODE == 0) return ((size_t)u.e * 512 + (size_t)u.pn * 256) * DM * 2;
        else return ((size_t)u.e * DM + (size_t)u.pn * 256) * EFF * 2;
    }
};
struct EpiGU {
    static constexpr bool PERM = true;
    bf16* act; const float* lrstd; const float* bgu;
    __device__ __forceinline__ void operator()(const f32x4 (&acc)[2][2][4][2], const pg8::Unit& u, int wr, int wc, int fr, int fq) const {
        const int r0 = wr * 64 + fr, cl0 = wc * 32 + 8 * fq;
        const float* bg = bgu + u.e * 512 + u.pn * 128 + cl0;
        const f32x4 bg0 = *(const f32x4*)(bg), bg1 = *(const f32x4*)(bg + 4), bu0 = *(const f32x4*)(bg + 256), bu1 = *(const f32x4*)(bg + 260);
#pragma unroll
        for (int ai = 0; ai < 2; ++ai)
#pragma unroll
            for (int m = 0; m < 4; ++m) { const int r = r0 + ai * 128 + m * 16; const float rs = lrstd[(size_t)u.e * NT + u.aux * 256 + r];
                f32x4 g0 = acc[ai][0][m][0] * rs + bg0, g1 = acc[ai][0][m][1] * rs + bg1, u0 = acc[ai][1][m][0] * rs + bu0, u1 = acc[ai][1][m][1] * rs + bu1;
                float o[8];
#pragma unroll
                for (int j = 0; j < 4; ++j) { const float ga = fminf(g0[j], 7.0f), ua = fminf(fmaxf(u0[j], -7.0f), 7.0f); o[j] = (ua + 1.0f) * ga * fast_sigmoid(1.702f * ga);
                                              const float gb = fminf(g1[j], 7.0f), ub = fminf(fmaxf(u1[j], -7.0f), 7.0f); o[4 + j] = (ub + 1.0f) * gb * fast_sigmoid(1.702f * gb); }
                u32x4 w; w.x = cvt_pk_bf16(o[0], o[1]); w.y = cvt_pk_bf16(o[2], o[3]); w.z = cvt_pk_bf16(o[4], o[5]); w.w = cvt_pk_bf16(o[6], o[7]);
                *(u32x4*)(act + (size_t)(u.pm * 256 + r) * EFF + u.pn * 128 + cl0) = w; }
    }
};
struct EpiDown {
    static constexpr bool PERM = true;
    bf16* y; const int* list; const float* lgate; const float* bd; const LAS int* tab;
    __device__ __forceinline__ void operator()(const f32x4 (&acc)[2][2][4][2], const pg8::Unit& u, int wr, int wc, int fr, int fq) const {
        const int r0 = wr * 64 + fr, col0 = u.pn * 256 + wc * 32 + 8 * fq; const int ne = tab[u.e];
        const float* bp = bd + u.e * DM + col0;
#pragma unroll
        for (int ai = 0; ai < 2; ++ai)
#pragma unroll
            for (int m = 0; m < 4; ++m) { const int pos = u.aux * 256 + r0 + ai * 128 + m * 16;
                asm volatile("" ::: "memory");
                if (pos < ne) { const int asg = list[(size_t)u.e * NT + pos]; const float gt = lgate[(size_t)u.e * NT + pos]; bf16* rowp = y + (size_t)asg * DM + col0;
#pragma unroll
                    for (int bj = 0; bj < 2; ++bj) { const f32x4 b0 = *(const f32x4*)(bp + bj * 128), b1 = *(const f32x4*)(bp + bj * 128 + 4);
                        const f32x4 v0 = (acc[ai][bj][m][0] + b0) * gt, v1 = (acc[ai][bj][m][1] + b1) * gt;
                        u32x4 w; w.x = cvt_pk_bf16(v0[0], v0[1]); w.y = cvt_pk_bf16(v0[2], v0[3]); w.z = cvt_pk_bf16(v1[0], v1[1]); w.w = cvt_pk_bf16(v1[2], v1[3]);
                        *(u32x4*)(rowp + bj * 128) = w; } } }
    }
};
__device__ __forceinline__ void moe_tables(LAS int* tab, const unsigned* cnt, int wv) {
    __syncthreads();
    const int tid_ = tid_from(wv);
    if (tid_ == 0) { int pre = 0;
        for (int e = 0; e < NEXP; ++e) { const int n = (int)__hip_atomic_load(cnt + e, RLX_AGENT); tab[e] = n; tab[32 + e] = pre; pre += (n + 255) >> 8; }
        tab[64] = pre; }
    __syncthreads();
}

__device__ __forceinline__ void phase_qkprep(ArgsRef a, int layer, int wv, bool dry) {
    const int tid = tid_from(wv), lane = tid & 63, wave = tid >> 6;
    const int gw = blockIdx.x * NWAVES + wave, NGW = gridDim.x * NWAVES;
    bf16* proj = (bf16*)(a.ws + WS_PROJ);
    const float* __restrict__ ct = (const float*)(a.ws + WS_ROPE); const float* __restrict__ st = ct + SEQ * 32;
    const int d0 = (lane & 7) * 8, p0 = d0 & 31;
    float gq[8], gk[8];
#pragma unroll
    for (int j = 0; j < 8; ++j) { gq[j] = a.in[I_QG][layer * 64 + d0 + j] * (0.125f * 1.4426950408889634f); gk[j] = a.in[I_KG][layer * 64 + d0 + j]; }
    const bool second = (lane & 4) != 0;
    constexpr int TB = 4;
    for (int t0 = gw * TB; t0 < NT; t0 += NGW * TB) {
        u32x4 w[TB][2]; f32x4 cs[TB][4];
#pragma unroll
        for (int u = 0; u < TB; ++u) { const int t = t0 + u, pos = t & (SEQ - 1);
            w[u][0] = *(const u32x4*)(proj + (size_t)t * NIN + C_Q + lane * 8); w[u][1] = *(const u32x4*)(proj + (size_t)t * NIN + C_Q + 512 + lane * 8);
            cs[u][0] = *(const f32x4*)(ct + pos * 32 + p0); cs[u][1] = *(const f32x4*)(ct + pos * 32 + p0 + 4); cs[u][2] = *(const f32x4*)(st + pos * 32 + p0); cs[u][3] = *(const f32x4*)(st + pos * 32 + p0 + 4); }
#pragma unroll
        for (int u = 0; u < TB; ++u) { const int t = t0 + u;
            float c[8], s[8];
#pragma unroll
            for (int j = 0; j < 4; ++j) { c[j] = cs[u][0][j]; c[4 + j] = cs[u][1][j]; s[j] = cs[u][2][j]; s[4 + j] = cs[u][3][j]; }
#pragma unroll
            for (int i = 0; i < 2; ++i) {
                const u32x4 ww = w[u][i];
                float x[8]; x[0] = bflo(ww.x); x[1] = bfhi(ww.x); x[2] = bflo(ww.y); x[3] = bfhi(ww.y); x[4] = bflo(ww.z); x[5] = bfhi(ww.z); x[6] = bflo(ww.w); x[7] = bfhi(ww.w);
                float ss = 0.f;
#pragma unroll
                for (int j = 0; j < 8; ++j) ss += x[j] * x[j];
                ss += __shfl_xor(ss, 1); ss += __shfl_xor(ss, 2); ss += __shfl_xor(ss, 4);
                const float rs = __builtin_amdgcn_rsqf(ss * (1.0f / 64.0f) + EPS);
                float o[8];
#pragma unroll
                for (int j = 0; j < 8; ++j) { const float yv = x[j] * rs * (i == 0 ? gq[j] : gk[j]); const float pv = __shfl_xor(yv, 4);
                    o[j] = second ? (yv * c[j] + pv * s[j]) : (yv * c[j] - pv * s[j]); }
                u32x4 r; r.x = cvt_pk_bf16(o[0], o[1]); r.y = cvt_pk_bf16(o[2], o[3]); r.z = cvt_pk_bf16(o[4], o[5]); r.w = cvt_pk_bf16(o[6], o[7]);
                if (!dry || o[0] == 12345.678f) *(u32x4*)(proj + (size_t)t * NIN + C_Q + i * 512 + lane * 8) = r;
            } }
    }
}

__device__ __forceinline__ void phase_pool(ArgsRef a, LAS unsigned char* lds, int layer, int wv) {
    const int tid = tid_from(wv), lane = tid & 63, wave = __builtin_amdgcn_readfirstlane(tid >> 6);
    const bf16* proj = (const bf16*)(a.ws + WS_PROJ); bf16* mix = (bf16*)(a.ws + WS_MIX);
    const bf16* pw = (const bf16*)(a.ws + WS_SMALL) + SM_POOLW + (size_t)layer * 4 * 4096;
    const float* psc = a.in[I_POOLSC] + layer * 256;
    LAS float* U = (LAS float*)lds;
    LAS bf16* PA = (LAS bf16*)(lds + 81920);
    LAS float* SS = (LAS float*)(lds + 116736);
    constexpr int PAS = 264;
    for (int unit = blockIdx.x; unit < NT / 64; unit += gridDim.x) {
        const int t0 = unit * 64, s0 = t0 & (SEQ - 1);
        __syncthreads();
        for (int ch = tid; ch < 79 * 32; ch += NTHR) { const int r = ch >> 5, c8 = (ch & 31) * 8; const int srow = s0 - 15 + r;
            f32x4 lo = {0.f, 0.f, 0.f, 0.f}, hi = {0.f, 0.f, 0.f, 0.f};
            if (srow >= 0) { const u32x4 w = *(const u32x4*)(proj + (size_t)(t0 - 15 + r) * NIN + C_POOL + c8); lo = (f32x4){bflo(w.x), bfhi(w.x), bflo(w.y), bfhi(w.y)}; hi = (f32x4){bflo(w.z), bfhi(w.z), bflo(w.w), bfhi(w.w)}; }
            *(LAS f32x4*)(U + r * 256 + c8) = lo; *(LAS f32x4*)(U + r * 256 + c8 + 4) = hi; }
        __syncthreads();
        { const int c = tid & 255, tl0 = (tid >> 8) * 32, w = 2 << (c >> 6);
          float sum = 0.f;
          for (int j = 1; j < w; ++j) sum += U[(15 + tl0 - j) * 256 + c];
          for (int tl = tl0; tl < tl0 + 32; ++tl) { const float cur = U[(15 + tl) * 256 + c]; sum += cur;
              const int cnt = min(w, s0 + tl + 1); const float pooled = sum / (float)cnt - cur;
              PA[tl * PAS + c] = f2bf(pooled); sum -= U[(15 + tl - w + 1) * 256 + c]; } }
        __syncthreads();
        const int g = wave & 3, th = wave >> 2, lr = lane & 15, lq = lane >> 4;
        f32x4 acc[2][4];
#pragma unroll
        for (int rt = 0; rt < 2; ++rt)
#pragma unroll
            for (int et = 0; et < 4; ++et) acc[rt][et] = (f32x4){0.f, 0.f, 0.f, 0.f};
#pragma unroll
        for (int ks = 0; ks < 2; ++ks) { bf16x8 af[2], bfr[4];
#pragma unroll
            for (int rt = 0; rt < 2; ++rt) af[rt] = *(const LAS bf16x8*)(PA + (th * 32 + rt * 16 + lr) * PAS + g * 64 + ks * 32 + lq * 8);
#pragma unroll
            for (int et = 0; et < 4; ++et) bfr[et] = *(const bf16x8*)(pw + (size_t)g * 4096 + (et * 16 + lr) * 64 + ks * 32 + lq * 8);
#pragma unroll
            for (int rt = 0; rt < 2; ++rt)
#pragma unroll
                for (int et = 0; et < 4; ++et) acc[rt][et] = __builtin_amdgcn_mfma_f32_16x16x32_bf16(af[rt], bfr[et], acc[rt][et], 0, 0, 0); }
#pragma unroll
        for (int et = 0; et < 4; ++et) { const float sc = psc[g * 64 + et * 16 + lr];
#pragma unroll
            for (int rt = 0; rt < 2; ++rt) acc[rt][et] = acc[rt][et] * sc; }
#pragma unroll
        for (int rt = 0; rt < 2; ++rt)
#pragma unroll
            for (int reg = 0; reg < 4; ++reg) { float s = 0.f;
#pragma unroll
                for (int et = 0; et < 4; ++et) s += acc[rt][et][reg] * acc[rt][et][reg];
                s += __shfl_xor(s, 1); s += __shfl_xor(s, 2); s += __shfl_xor(s, 4); s += __shfl_xor(s, 8);
                if (lr == 0) SS[(th * 32 + rt * 16 + lq * 4 + reg) * 4 + g] = s; }
        __syncthreads();
#pragma unroll
        for (int rt = 0; rt < 2; ++rt)
#pragma unroll
            for (int reg = 0; reg < 4; ++reg) { const int tl = th * 32 + rt * 16 + lq * 4 + reg; const LAS float* sp = SS + tl * 4;
                const float rs = __builtin_amdgcn_rsqf(((sp[0] + sp[1]) + (sp[2] + sp[3])) * (1.0f / 256.0f) + EPS);
#pragma unroll
                for (int et = 0; et < 4; ++et) mix[(size_t)(t0 + tl) * DM + g * 64 + et * 16 + lr] = f2bf(acc[rt][et][reg] * rs); }
    }
}

__device__ __forceinline__ void phase_lru_a(ArgsRef a, LAS unsigned char* lds, int layer, int wv) {
    const int tid = tid_from(wv), lane = tid & 63, wave = __builtin_amdgcn_readfirstlane(tid >> 6);
    const bf16* proj = (const bf16*)(a.ws + WS_PROJ);
    const bf16* wa = (const bf16*)(a.ws + WS_SMALL) + SM_WA + (size_t)layer * 4 * 4096;
    const bf16* wx = (const bf16*)(a.ws + WS_SMALL) + SM_WX + (size_t)layer * 4 * 4096;
    bf16* HL = (bf16*)(a.ws + WS_HL); bf16* PL = (bf16*)(a.ws + WS_PL);
    float* AGGH = (float*)(a.ws + WS_AGGH); float* AGGP = (float*)(a.ws + WS_AGGP);
    LAS float* U = (LAS float*)lds;
    LAS bf16* XC = (LAS bf16*)(lds + 36864);
    LAS float* XF = (LAS float*)(lds + 54272);
    LAS float* AA = (LAS float*)(lds + 87040);
    constexpr int XS = 264;
    const int c = tid & 255;
    const float cw0 = a.in[I_CONVW][(layer * 4 + 0) * 256 + c], cw1 = a.in[I_CONVW][(layer * 4 + 1) * 256 + c], cw2 = a.in[I_CONVW][(layer * 4 + 2) * 256 + c], cw3 = a.in[I_CONVW][(layer * 4 + 3) * 256 + c];
    const float cb = a.in[I_CONVB][layer * 256 + c];
    for (int unit = blockIdx.x; unit < NT / LRU_CH; unit += gridDim.x) {
        const int t0 = unit * LRU_CH, s0 = t0 & (SEQ - 1);
        __syncthreads();
        for (int ch = tid; ch < 35 * 32; ch += NTHR) { const int r = ch >> 5, c8 = (ch & 31) * 8; const int srow = s0 - 3 + r;
            f32x4 lo = {0.f, 0.f, 0.f, 0.f}, hi = {0.f, 0.f, 0.f, 0.f};
            if (srow >= 0) { const u32x4 w = *(const u32x4*)(proj + (size_t)(t0 - 3 + r) * NIN + C_LRU + c8); lo = (f32x4){bflo(w.x), bfhi(w.x), bflo(w.y), bfhi(w.y)}; hi = (f32x4){bflo(w.z), bfhi(w.z), bflo(w.w), bfhi(w.w)}; }
            *(LAS f32x4*)(U + r * 256 + c8) = lo; *(LAS f32x4*)(U + r * 256 + c8 + 4) = hi; }
        __syncthreads();
        { const int tl0 = (tid >> 8) * 16;
          for (int tl = tl0; tl < tl0 + 16; ++tl) { const float xc = cb + cw0 * U[(tl + 0) * 256 + c] + cw1 * U[(tl + 1) * 256 + c] + cw2 * U[(tl + 2) * 256 + c] + cw3 * U[(tl + 3) * 256 + c];
              XF[tl * 256 + c] = xc; XC[tl * XS + c] = f2bf(xc); } }
        __syncthreads();
        { const int n = wave & 3, eh = wave >> 2, lr = lane & 15, lq = lane >> 4;
          f32x4 ca[2][2], cx[2][2];
#pragma unroll
          for (int rt = 0; rt < 2; ++rt)
#pragma unroll
              for (int et = 0; et < 2; ++et) { ca[rt][et] = (f32x4){0.f, 0.f, 0.f, 0.f}; cx[rt][et] = (f32x4){0.f, 0.f, 0.f, 0.f}; }
#pragma unroll
          for (int ks = 0; ks < 2; ++ks) { bf16x8 af[2], ba[2], bx[2];
#pragma unroll
              for (int rt = 0; rt < 2; ++rt) af[rt] = *(const LAS bf16x8*)(XC + (rt * 16 + lr) * XS + n * 64 + ks * 32 + lq * 8);
#pragma unroll
              for (int et = 0; et < 2; ++et) { const size_t wo = (size_t)n * 4096 + (eh * 32 + et * 16 + lr) * 64 + ks * 32 + lq * 8; ba[et] = *(const bf16x8*)(wa + wo); bx[et] = *(const bf16x8*)(wx + wo); }
#pragma unroll
              for (int rt = 0; rt < 2; ++rt)
#pragma unroll
                  for (int et = 0; et < 2; ++et) { ca[rt][et] = __builtin_amdgcn_mfma_f32_16x16x32_bf16(af[rt], ba[et], ca[rt][et], 0, 0, 0);
                                                   cx[rt][et] = __builtin_amdgcn_mfma_f32_16x16x32_bf16(af[rt], bx[et], cx[rt][et], 0, 0, 0); } }
#pragma unroll
          for (int et = 0; et < 2; ++et) { const int chn = n * 64 + eh * 32 + et * 16 + lr;
              const float bav = a.in[I_BA][layer * 256 + chn], bxv = a.in[I_BX][layer * 256 + chn], lam = a.in[I_LAM][layer * 256 + chn];
              const float sp = log1pf(expf(-lam));
#pragma unroll
              for (int rt = 0; rt < 2; ++rt)
#pragma unroll
                  for (int reg = 0; reg < 4; ++reg) { const int tl = rt * 16 + lq * 4 + reg;
                      const float r = fast_sigmoid(ca[rt][et][reg] + bav), ig = fast_sigmoid(cx[rt][et][reg] + bxv);
                      const float log_a = -8.0f * r * sp; const float av = fast_exp(log_a);
                      float mult = sqrtf(fmaxf(1.0f - fast_exp(2.0f * log_a), 0.f)); if (s0 + tl == 0) mult = 1.0f;
                      const float xc = XF[tl * 256 + chn];
                      AA[tl * 256 + chn] = av; XF[tl * 256 + chn] = mult * ig * xc; } } }
        __syncthreads();
        if (tid < 256) { float h = 0.f, P = 1.f;
            for (int tl = 0; tl < LRU_CH; ++tl) { const float av = AA[tl * 256 + c], bv = XF[tl * 256 + c]; h = av * h + bv; P *= av;
                HL[(size_t)(t0 + tl) * 256 + c] = f2bf(h); PL[(size_t)(t0 + tl) * 256 + c] = f2bf(P); }
            AGGH[(size_t)unit * 256 + c] = h; AGGP[(size_t)unit * 256 + c] = P; }
    }
}
__device__ __forceinline__ void phase_lru_b(ArgsRef a, int wv) {
    const float* AGGH = (const float*)(a.ws + WS_AGGH); const float* AGGP = (const float*)(a.ws + WS_AGGP); float* CARRY = (float*)(a.ws + WS_CARRY);
    const int tid_ = tid_from(wv);
    for (int idx = blockIdx.x * NTHR + tid_; idx < NB * 256; idx += gridDim.x * NTHR) { const int b = idx >> 8, c = idx & 255; float carry = 0.f;
        for (int k = 0; k < LRU_NCH; ++k) { const size_t o = (size_t)(b * LRU_NCH + k) * 256 + c; CARRY[o] = carry; carry = AGGP[o] * carry + AGGH[o]; } }
}
__device__ __forceinline__ void phase_lru_c(ArgsRef a, int wv) {
    const int tid = tid_from(wv), lane = tid & 63, wave = tid >> 6;
    const int gw = blockIdx.x * NWAVES + wave, NGW = gridDim.x * NWAVES;
    const bf16* proj = (const bf16*)(a.ws + WS_PROJ); bf16* mix = (bf16*)(a.ws + WS_MIX);
    const bf16* HL = (const bf16*)(a.ws + WS_HL); const bf16* PL = (const bf16*)(a.ws + WS_PL); const float* CARRY = (const float*)(a.ws + WS_CARRY);
    for (int t = gw; t < NT; t += NGW) {
        const u32x2 hw = *(const u32x2*)(HL + (size_t)t * 256 + lane * 4), pw = *(const u32x2*)(PL + (size_t)t * 256 + lane * 4), gwd = *(const u32x2*)(proj + (size_t)t * NIN + C_GATE + lane * 4);
        const f32x4 cr = *(const f32x4*)(CARRY + (size_t)(t / LRU_CH) * 256 + lane * 4);
        float h[4] = {bflo(hw.x) + bflo(pw.x) * cr[0], bfhi(hw.x) + bfhi(pw.x) * cr[1], bflo(hw.y) + bflo(pw.y) * cr[2], bfhi(hw.y) + bfhi(pw.y) * cr[3]};
        const float gt[4] = {bflo(gwd.x), bfhi(gwd.x), bflo(gwd.y), bfhi(gwd.y)};
        float s = 0.f;
#pragma unroll
        for (int j = 0; j < 4; ++j) { h[j] *= gelu_tanh(gt[j]); s += h[j] * h[j]; }
        s = wave_sum(s); const float rs = __builtin_amdgcn_rsqf(s * (1.0f / 256.0f) + EPS);
        u32x2 o; o.x = cvt_pk_bf16(h[0] * rs, h[1] * rs); o.y = cvt_pk_bf16(h[2] * rs, h[3] * rs);
        *(u32x2*)(mix + (size_t)t * DM + 256 + lane * 4) = o;
    }
}

typedef short v4i16_t __attribute__((ext_vector_type(4)));
struct AttnUnit { int h, n, r, dl; size_t rowb; int g; };
__device__ __forceinline__ AttnUnit attn_decode(int unit) {
    AttnUnit u; const int blk = unit & 31; u.g = (unit >> 5) % 3; u.h = (unit / 96) & 7; const int b = unit / 768;
    u.dl = (u.g == 0) ? 1 : (u.g == 1 ? 4 : 16); const int nb = 32 / u.dl; u.n = blk % nb; u.r = blk / nb; u.rowb = (size_t)b * SEQ; return u;
}
__device__ __forceinline__ void attn_dma(const __amdgpu_buffer_rsrc_t rs, LAS unsigned char* lds, const AttnUnit& u, int buf, int wave, int lane) {
    const int kr0 = 8 * wave + (lane >> 3), cs = ((lane & 7) ^ ((lane >> 3) & 7)) * 16;
#pragma unroll
    for (int q = 0; q < 4; ++q) { const int keyrow = kr0 + 64 * q; int l = 128 * (u.n - 1) + keyrow; l = l < 0 ? 0 : l;
        const unsigned src = (unsigned)(((u.rowb + (size_t)l * u.dl + u.r) * NIN + C_K + u.h * 64) * 2 + cs);
        LAS unsigned char* dst = lds + buf * 65536 + (wave + 8 * q) * 1024;
        __builtin_amdgcn_raw_ptr_buffer_load_lds(rs, (LAS void*)dst, 16, src, 0, 0, 0);
        __builtin_amdgcn_raw_ptr_buffer_load_lds(rs, (LAS void*)(dst + 32768), 16, src + (unsigned)((C_V - C_K) * 2), 0, 0, 0); }
}
__device__ __forceinline__ void phase_attn(ArgsRef a, LAS unsigned char* lds, int wv) {
    const int tid = tid_from(wv), lane = tid & 63, wave = __builtin_amdgcn_readfirstlane(tid >> 6);
    const bf16* proj = (const bf16*)(a.ws + WS_PROJ);
    bf16* PNUM = (bf16*)(a.ws + WS_PNUM); float* PDEN = (float*)(a.ws + WS_PDEN); float* PMAX = (float*)(a.ws + WS_PMAX);
    const __amdgpu_buffer_rsrc_t rs = __builtin_amdgcn_make_buffer_rsrc((void*)proj, 0, 0x7fffffff, 0x00020000);
    const int lr = lane & 15, lq = lane >> 4, qi0 = 16 * wave, G = gridDim.x;
    constexpr int NUNITS = NB * 8 * 3 * 32;
    const int kro = (qi0 + lr) * 128, kc0 = ((0 + lq) ^ (lr & 7)) * 16, kc1 = ((4 + lq) ^ (lr & 7)) * 16;
    const int q4 = (lane & 15) >> 2, p4 = lane & 3, vrow = qi0 + 4 * lq + q4, vsw = (4 * lq + q4) & 7;
    __syncthreads();
    int unit = blockIdx.x;
    AttnUnit cu = attn_decode(unit < NUNITS ? unit : 0);
    bf16x8 qf0, qf1;
    if (unit < NUNITS) { attn_dma(rs, lds, cu, 0, wave, lane);
        const size_t qrow = cu.rowb + (size_t)(128 * cu.n + qi0 + lr) * cu.dl + cu.r;
        qf0 = *(const bf16x8*)(proj + qrow * NIN + C_Q + cu.h * 64 + lq * 8); qf1 = *(const bf16x8*)(proj + qrow * NIN + C_Q + cu.h * 64 + 32 + lq * 8); }
    int buf = 0;
    asm volatile("s_waitcnt vmcnt(0)" ::: "memory");
    for (; unit < NUNITS; unit += G) {
        asm volatile("s_waitcnt vmcnt(16)" ::: "memory"); __builtin_amdgcn_s_barrier(); asm volatile("" ::: "memory");
        const int nunit = unit + G; AttnUnit nu = attn_decode(nunit < NUNITS ? nunit : 0); bf16x8 nq0 = qf0, nq1 = qf1;
        if (nunit < NUNITS) { attn_dma(rs, lds, nu, buf ^ 1, wave, lane);
            const size_t qrow = nu.rowb + (size_t)(128 * nu.n + qi0 + lr) * nu.dl + nu.r;
            nq0 = *(const bf16x8*)(proj + qrow * NIN + C_Q + nu.h * 64 + lq * 8); nq1 = *(const bf16x8*)(proj + qrow * NIN + C_Q + nu.h * 64 + 32 + lq * 8); }
        const LAS unsigned char* Kb = lds + buf * 65536; const LAS unsigned char* Vb = Kb + 32768;
        f32x4 sc[9];
#pragma unroll
        for (int t = 0; t < 9; ++t) { const bf16x8 k0 = *(const LAS bf16x8*)(Kb + kro + t * 2048 + kc0), k1 = *(const LAS bf16x8*)(Kb + kro + t * 2048 + kc1);
            sc[t] = __builtin_amdgcn_mfma_f32_16x16x32_bf16(k0, qf0, (f32x4){0.f, 0.f, 0.f, 0.f}, 0, 0, 0);
            sc[t] = __builtin_amdgcn_mfma_f32_16x16x32_bf16(k1, qf1, sc[t], 0, 0, 0); }
        float mx = -1e30f;
#pragma unroll
        for (int t = 0; t < 9; ++t)
#pragma unroll
            for (int reg = 0; reg < 4; ++reg) { const int dist = 128 + lr - 16 * t - 4 * lq - reg; const int kj = qi0 + 16 * t + 4 * lq + reg;
                const bool ok = (dist >= 0) && (dist <= 128) && (cu.n > 0 || kj >= 128);
                const float v = ok ? sc[t][reg] : -1e30f; sc[t][reg] = v; mx = fmaxf(mx, v); }
        mx = fmaxf(mx, __shfl_xor(mx, 16)); mx = fmaxf(mx, __shfl_xor(mx, 32));
        float sm = 0.f;
#pragma unroll
        for (int t = 0; t < 9; ++t)
#pragma unroll
            for (int reg = 0; reg < 4; ++reg) { const float v = sc[t][reg]; const float pe = (v > -1e29f) ? __builtin_amdgcn_exp2f(v - mx) : 0.f; sm += pe; sc[t][reg] = pe; }
        sm += __shfl_xor(sm, 16); sm += __shfl_xor(sm, 32);
        f32x4 oc[4];
#pragma unroll
        for (int dt = 0; dt < 4; ++dt) oc[dt] = (f32x4){0.f, 0.f, 0.f, 0.f};
#pragma unroll
        for (int pi = 0; pi < 5; ++pi) { const int t0 = 2 * pi, t1 = (2 * pi + 1 < 9) ? 2 * pi + 1 : 8;
            u32x4 pw; pw.x = cvt_pk_bf16(sc[t0][0], sc[t0][1]); pw.y = cvt_pk_bf16(sc[t0][2], sc[t0][3]);
            if (2 * pi + 1 < 9) { pw.z = cvt_pk_bf16(sc[t1][0], sc[t1][1]); pw.w = cvt_pk_bf16(sc[t1][2], sc[t1][3]); } else { pw.z = 0u; pw.w = 0u; }
            const bf16x8 pf = __builtin_bit_cast(bf16x8, pw);
#pragma unroll
            for (int dt = 0; dt < 4; ++dt) { const int ch = ((2 * dt + (p4 >> 1)) ^ vsw) * 16 + (p4 & 1) * 8;
                const v4i16_t v0 = __builtin_amdgcn_ds_read_tr16_b64_v4i16((LAS v4i16_t*)(Vb + (vrow + 16 * t0) * 128 + ch));
                const v4i16_t v1 = __builtin_amdgcn_ds_read_tr16_b64_v4i16((LAS v4i16_t*)(Vb + (vrow + 16 * t1) * 128 + ch));
                const bf16x8 vf = (bf16x8){v0[0], v0[1], v0[2], v0[3], v1[0], v1[1], v1[2], v1[3]};
                oc[dt] = __builtin_amdgcn_mfma_f32_16x16x32_bf16(pf, vf, oc[dt], 0, 0, 0); } }
#pragma unroll
        for (int reg = 0; reg < 4; ++reg) { const size_t tok = cu.rowb + (size_t)(128 * cu.n + qi0 + lq * 4 + reg) * cu.dl + cu.r;
#pragma unroll
            for (int dt = 0; dt < 4; ++dt) PNUM[((size_t)cu.g * NT + tok) * 512 + cu.h * 64 + dt * 16 + lr] = f2bf(oc[dt][reg]); }
        if (lq == 0) { const size_t tok = cu.rowb + (size_t)(128 * cu.n + qi0 + lr) * cu.dl + cu.r; PDEN[((size_t)cu.g * NT + tok) * 8 + cu.h] = sm; PMAX[((size_t)cu.g * NT + tok) * 8 + cu.h] = mx; }
        cu = nu; qf0 = nq0; qf1 = nq1; buf ^= 1;
    }
}
__device__ __forceinline__ void phase_merge(ArgsRef a, int wv) {
    const int tid = tid_from(wv), lane = tid & 63, wave = tid >> 6;
    const int gw = blockIdx.x * NWAVES + wave, NGW = gridDim.x * NWAVES;
    const bf16* PNUM = (const bf16*)(a.ws + WS_PNUM); const float* PDEN = (const float*)(a.ws + WS_PDEN); const float* PMAX = (const float*)(a.ws + WS_PMAX);
    bf16* mix = (bf16*)(a.ws + WS_MIX);
    const int hd = lane >> 3;
    for (int t = gw; t < NT; t += NGW) {
        float m[3], dn[3]; u32x4 nw[3];
#pragma unroll
        for (int g = 0; g < 3; ++g) { m[g] = PMAX[((size_t)g * NT + t) * 8 + hd]; dn[g] = PDEN[((size_t)g * NT + t) * 8 + hd]; nw[g] = *(const u32x4*)(PNUM + ((size_t)g * NT + t) * 512 + lane * 8); }
        const float mr = fmaxf(fmaxf(m[0], m[1]), m[2]);
        float o[8] = {0.f, 0.f, 0.f, 0.f, 0.f, 0.f, 0.f, 0.f}; float den = 0.f;
#pragma unroll
        for (int g = 0; g < 3; ++g) { const float w = __builtin_amdgcn_exp2f(m[g] - mr); den += w * dn[g];
            o[0] += w * bflo(nw[g].x); o[1] += w * bfhi(nw[g].x); o[2] += w * bflo(nw[g].y); o[3] += w * bfhi(nw[g].y); o[4] += w * bflo(nw[g].z); o[5] += w * bfhi(nw[g].z); o[6] += w * bflo(nw[g].w); o[7] += w * bfhi(nw[g].w); }
        const float inv = 1.0f / den; float s = 0.f;
#pragma unroll
        for (int j = 0; j < 8; ++j) { o[j] *= inv; s += o[j] * o[j]; }
        s = wave_sum(s); const float rs = __builtin_amdgcn_rsqf(s * (1.0f / 512.0f) + EPS);
        u32x4 w; w.x = cvt_pk_bf16(o[0] * rs, o[1] * rs); w.y = cvt_pk_bf16(o[2] * rs, o[3] * rs); w.z = cvt_pk_bf16(o[4] * rs, o[5] * rs); w.w = cvt_pk_bf16(o[6] * rs, o[7] * rs);
        *(u32x4*)(mix + (size_t)t * DM + 512 + lane * 8) = w;
    }
}

__device__ __forceinline__ void phase_router(ArgsRef a, LAS unsigned char* lds, int layer, int wv, bool alloc) {
    const int tid = tid_from(wv), lane = tid & 63, wave = __builtin_amdgcn_readfirstlane(tid >> 6);
    const bf16* xb = (const bf16*)(a.ws + WS_XB); const bf16* wr = (const bf16*)(a.ws + WS_SMALL) + SM_WR + (size_t)layer * NEXP * DM;
    const float* ssqp = (const float*)(a.ws + WS_SSQP); const float* rbias = a.in[I_BR] + layer * NEXP;
    int* LIST = (int*)(a.ws + WS_LIST); float* LRSTD = (float*)(a.ws + WS_LRSTD); float* LGATE = (float*)(a.ws + WS_LGATE2);
    unsigned* cnt = (unsigned*)(a.ws + WS_CTL) + CW_CNT + layer * NEXP;
    LAS float* LG = (LAS float*)lds + wave * 32 * 33;
    LAS int* hist = (LAS int*)(lds + 65536);
    LAS int* base = (LAS int*)(lds + 65536 + 128);
    const int lr = lane & 15, lq = lane >> 4;
    for (int unit = blockIdx.x; unit < NT / 256; unit += gridDim.x) {
        const int tok0 = unit * 256 + wave * 32;
        __syncthreads();
        if (tid < 32) hist[tid] = 0;
        f32x4 acc[2][2];
#pragma unroll
        for (int rt = 0; rt < 2; ++rt)
#pragma unroll
            for (int et = 0; et < 2; ++et) acc[rt][et] = (f32x4){0.f, 0.f, 0.f, 0.f};
#pragma unroll 4
        for (int ks = 0; ks < 32; ++ks) { bf16x8 af[2], bfr[2];
#pragma unroll
            for (int rt = 0; rt < 2; ++rt) af[rt] = *(const bf16x8*)(xb + (size_t)(tok0 + rt * 16 + lr) * DM + ks * 32 + lq * 8);
#pragma unroll
            for (int et = 0; et < 2; ++et) bfr[et] = *(const bf16x8*)(wr + (size_t)(et * 16 + lr) * DM + ks * 32 + lq * 8);
#pragma unroll
            for (int rt = 0; rt < 2; ++rt)
#pragma unroll
                for (int et = 0; et < 2; ++et) acc[rt][et] = __builtin_amdgcn_mfma_f32_16x16x32_bf16(af[rt], bfr[et], acc[rt][et], 0, 0, 0); }
#pragma unroll
        for (int rt = 0; rt < 2; ++rt)
#pragma unroll
            for (int et = 0; et < 2; ++et)
#pragma unroll
                for (int reg = 0; reg < 4; ++reg) LG[(rt * 16 + lq * 4 + reg) * 33 + et * 16 + lr] = acc[rt][et][reg];
        __syncthreads();
        int te[4] = {0, 0, 0, 0}; float tg[4] = {0.f, 0.f, 0.f, 0.f}; int rk[4] = {0, 0, 0, 0}; float rstd = 0.f; const int tok = tok0 + lane;
        if (lane < 32) {
            const float* sp = ssqp + (size_t)tok * 16; float ss = 0.f;
#pragma unroll
            for (int j = 0; j < 16; ++j) ss += sp[j];
            rstd = __builtin_amdgcn_rsqf(ss * (1.0f / DM) + EPS);
            float tv[4] = {-3e38f, -3e38f, -3e38f, -3e38f};
            for (int e = 0; e < NEXP; ++e) { float v = LG[lane * 33 + e] * rstd + rbias[e]; int ve = e;
#pragma unroll
                for (int k = 0; k < 4; ++k) { if (v > tv[k]) { const float tvv = tv[k]; const int tee = te[k]; tv[k] = v; te[k] = ve; v = tvv; ve = tee; } } }
            float z = 0.f;
#pragma unroll
            for (int k = 0; k < 4; ++k) { tg[k] = fast_exp(tv[k] - tv[0]); z += tg[k]; }
            const float iz = 1.0f / z;
#pragma unroll
            for (int k = 0; k < 4; ++k) { tg[k] *= iz; rk[k] = __hip_atomic_fetch_add(&hist[te[k]], 1, __ATOMIC_RELAXED, __HIP_MEMORY_SCOPE_WORKGROUP); }
        }
        __syncthreads();
        if (tid < 32) base[tid] = alloc ? (int)__hip_atomic_fetch_add(cnt + tid, (unsigned)hist[tid], RLX_AGENT) : 0;
        __syncthreads();
        if (lane < 32 && alloc) {
#pragma unroll
            for (int k = 0; k < 4; ++k) { const size_t p = (size_t)te[k] * NT + base[te[k]] + rk[k]; LIST[p] = tok * 4 + k; LRSTD[p] = rstd; LGATE[p] = tg[k]; }
        }
    }
}

__device__ __forceinline__ void phase_combine(ArgsRef a, bool last_layer, int wv, bool dry) {
    const int tid = tid_from(wv), lane = tid & 63, wave = tid >> 6;
    const int gw = blockIdx.x * NWAVES + wave, NGW = gridDim.x * NWAVES;
    const bf16* __restrict__ Y = (const bf16*)(a.ws + WS_Y); float* out = a.out; bf16* __restrict__ xb = (bf16*)(a.ws + WS_XB); float* __restrict__ ssq = (float*)(a.ws + WS_SSQ);
    for (int t = gw; t < NT; t += NGW) {
        f32x4 v[4]; u32x2 y[4][4];
        const f32x4* op = (const f32x4*)(out + (size_t)t * DM) + lane;
#pragma unroll
        for (int j = 0; j < 4; ++j) { v[j] = op[64 * j];
#pragma unroll
            for (int k = 0; k < 4; ++k) y[k][j] = *((const u32x2*)(Y + ((size_t)t * 4 + k) * DM) + lane + 64 * j); }
        float s = 0.f;
#pragma unroll
        for (int j = 0; j < 4; ++j) {
#pragma unroll
            for (int k = 0; k < 4; ++k) { v[j].x += bflo(y[k][j].x); v[j].y += bfhi(y[k][j].x); v[j].z += bflo(y[k][j].y); v[j].w += bfhi(y[k][j].y); }
            s += (v[j].x * v[j].x + v[j].y * v[j].y) + (v[j].z * v[j].z + v[j].w * v[j].w); }
        if (dry && s != 12345.678f) continue;
#pragma unroll
        for (int j = 0; j < 4; ++j) *((f32x4*)(out + (size_t)t * DM) + lane + 64 * j) = v[j];
        if (!last_layer) { s = wave_sum(s);
#pragma unroll
            for (int j = 0; j < 4; ++j) { u32x2 w; w.x = cvt_pk_bf16(v[j].x, v[j].y); w.y = cvt_pk_bf16(v[j].z, v[j].w); *((u32x2*)(xb + (size_t)t * DM) + lane + 64 * j) = w; }
            if (lane == 0) ssq[t] = s; }
    }
}

constexpr int NPH_LAYER = 13, NPH = 1 + 2 * NPH_LAYER;
enum { PH_GEMM_IN = 0, PH_QKPREP, PH_POOL, PH_LRU_A, PH_LRU_B, PH_ATTN, PH_LRU_C, PH_MERGE, PH_GEMM_OUT, PH_ROUTER, PH_MOE_GU, PH_MOE_DOWN, PH_COMBINE };
#ifndef MK_STOP
#define MK_STOP NPH
#endif
#ifndef MK_SPLIT
#define MK_SPLIT 0
#endif

template <int PHMASK>
__global__ void __launch_bounds__(NTHR, 2) mega_fwd(Args args_by_value) {
    extern __shared__ __attribute__((aligned(16))) unsigned char lds_raw[];
    LAS unsigned char* lds = (LAS unsigned char*)lds_raw;
    const int tid = threadIdx.x;
    int wv = __builtin_amdgcn_readfirstlane(tid >> 6); asm volatile("" : "+s"(wv));
    for (int u = tid; u < (LDS_BYTES - LDSCTL_OFF) / 4; u += NTHR) ((LAS unsigned*)(lds + LDSCTL_OFF))[u] = 0u;
    __syncthreads();
#define ARGS_HERE() const CAS Args* ap_ = (const CAS Args*)__builtin_amdgcn_kernarg_segment_ptr(); asm volatile("" : "+s"(ap_)); ArgsRef args = *ap_; unsigned char* const ws = args.ws; unsigned* const ctl = (unsigned*)(ws + WS_CTL); (void)ctl
    int lo, hi;
    { ARGS_HERE(); lo = args.ph_lo; hi = args.ph_hi; xcd_barrier_post(ctl + CW_BAR + args.li * XCD_BAR_WORDS, (volatile LAS unsigned*)(lds + MISC_OFF) + 8); }
#define EN(p) (((PHMASK) >> (p)) & 1)
#ifndef MK_DUP
#define MK_DUP 0
#endif
#define NREP(p) ((((MK_DUP) >> (p)) & 1) ? 2 : 1)
#define IN(k) (lo <= (k) && (k) < hi)
#define SEAM(k) do { if (IN(k) && IN((k) + 1)) { ARGS_HERE(); XcdBarrier bar_; bar_.bar = ctl + CW_BAR + args.li * XCD_BAR_WORDS; bar_.x = xb_xcc_id(); bar_.st = (volatile LAS unsigned*)(lds + MISC_OFF) + 8; xcd_barrier(bar_); } } while (0)

    if (EN(13) && IN(0)) { ARGS_HERE(); for (int rep_ = 0; rep_ < NREP(13); ++rep_) { phase_prologue(args, lds, wv); } }
    SEAM(0);
    for (int l = 0; l < 2; ++l) {
        const int pb = 1 + NPH_LAYER * l;
        if (EN(PH_GEMM_IN) && IN(pb + PH_GEMM_IN)) { ARGS_HERE();
            pg8::StaticOrder S; S.init(NT, NIN, DM, gridDim.x, blockIdx.x); S.dup = NREP(PH_GEMM_IN) - 1;
            EpiIn E{(bf16*)(ws + WS_PROJ), (const float*)(ws + WS_SSQ)};
            pg8::gemm_phase<EpiIn, pg8::StaticOrder, true>(lds, (const bf16*)(ws + WS_XB), (const bf16*)(ws + WS_WIN) + (size_t)l * NIN * DM, DM, S, E, wv);
        }
        SEAM(pb + PH_GEMM_IN);
        if (EN(PH_QKPREP) && IN(pb + PH_QKPREP)) { ARGS_HERE(); for (int rep_ = 0; rep_ < NREP(PH_QKPREP); ++rep_) { phase_qkprep(args, l, wv, rep_ < NREP(PH_QKPREP) - 1); } }
        if (EN(PH_POOL) && IN(pb + PH_POOL)) { ARGS_HERE(); for (int rep_ = 0; rep_ < NREP(PH_POOL); ++rep_) { phase_pool(args, lds, l, wv); } }
        if (EN(PH_LRU_A) && IN(pb + PH_LRU_A)) { ARGS_HERE(); for (int rep_ = 0; rep_ < NREP(PH_LRU_A); ++rep_) { phase_lru_a(args, lds, l, wv); } }
        SEAM(pb + PH_LRU_A);
        if (EN(PH_LRU_B) && IN(pb + PH_LRU_B)) { ARGS_HERE(); for (int rep_ = 0; rep_ < NREP(PH_LRU_B); ++rep_) { phase_lru_b(args, wv); } }
        if (EN(PH_ATTN) && IN(pb + PH_ATTN)) { ARGS_HERE(); for (int rep_ = 0; rep_ < NREP(PH_ATTN); ++rep_) { phase_attn(args, lds, wv); } }
        SEAM(pb + PH_ATTN);
        if (EN(PH_LRU_C) && IN(pb + PH_LRU_C)) { ARGS_HERE(); for (int rep_ = 0; rep_ < NREP(PH_LRU_C); ++rep_) { phase_lru_c(args, wv); } }
        if (EN(PH_MERGE) && IN(pb + PH_MERGE)) { ARGS_HERE(); for (int rep_ = 0; rep_ < NREP(PH_MERGE); ++rep_) { phase_merge(args, wv); } }
        SEAM(pb + PH_MERGE);
        if (EN(PH_GEMM_OUT) && IN(pb + PH_GEMM_OUT)) { ARGS_HERE();
            __syncthreads();
            pg8::StaticOrder S; S.init(NT, DM, DM, gridDim.x, blockIdx.x); S.dup = (l == 0) ? NREP(PH_GEMM_OUT) - 1 : 0;
            EpiOut E{l == 0 ? args.in[I_X] : (const float*)args.out, args.out, (bf16*)(ws + WS_XB), (float*)(ws + WS_SSQP)};
            pg8::gemm_phase<EpiOut, pg8::StaticOrder, true>(lds, (const bf16*)(ws + WS_MIX), (const bf16*)(ws + WS_WOUT) + (size_t)l * DM * DM, DM, S, E, wv);
        }
        SEAM(pb + PH_GEMM_OUT);
        if (EN(PH_ROUTER) && IN(pb + PH_ROUTER)) { ARGS_HERE(); for (int rep_ = 0; rep_ < NREP(PH_ROUTER); ++rep_) { phase_router(args, lds, l, wv, rep_ == NREP(PH_ROUTER) - 1); } }
        SEAM(pb + PH_ROUTER);
        if (EN(PH_MOE_GU) && IN(pb + PH_MOE_GU)) { ARGS_HERE();
            LAS int* tab = (LAS int*)(lds + TAB_OFF);
            moe_tables(tab, ctl + CW_CNT + l * NEXP, wv);
            MoeOrder<0> S{tab, 2, (int)gridDim.x, (int)blockIdx.x, (const int*)(ws + WS_LIST), NREP(PH_MOE_GU) - 1};
            EpiGU E{(bf16*)(ws + WS_ACT), (const float*)(ws + WS_LRSTD), args.in[I_BGU] + (size_t)l * NEXP * 512};
            pg8::gemm_phase<EpiGU, MoeOrder<0>, true>(lds, (const bf16*)(ws + WS_XB), (const bf16*)(ws + WS_WGU) + (size_t)l * NEXP * 512 * DM, DM, S, E, wv);
        }
        SEAM(pb + PH_MOE_GU);
        if (EN(PH_MOE_DOWN) && IN(pb + PH_MOE_DOWN)) { ARGS_HERE();
            LAS int* tab = (LAS int*)(lds + TAB_OFF);
            moe_tables(tab, ctl + CW_CNT + l * NEXP, wv);
            MoeOrder<1> S{tab, 4, (int)gridDim.x, (int)blockIdx.x, (const int*)(ws + WS_LIST), NREP(PH_MOE_DOWN) - 1};
            EpiDown E{(bf16*)(ws + WS_Y), (const int*)(ws + WS_LIST), (const float*)(ws + WS_LGATE2), args.in[I_BD] + (size_t)l * NEXP * DM, tab};
            pg8::gemm_phase<EpiDown, MoeOrder<1>, true>(lds, (const bf16*)(ws + WS_ACT), (const bf16*)(ws + WS_WD) + (size_t)l * NEXP * DM * EFF, EFF, S, E, wv);
        }
        SEAM(pb + PH_MOE_DOWN);
        if (EN(PH_COMBINE) && IN(pb + PH_COMBINE)) { ARGS_HERE(); for (int rep_ = 0; rep_ < NREP(PH_COMBINE); ++rep_) { phase_combine(args, l == 1, wv, rep_ < NREP(PH_COMBINE) - 1); } }
        SEAM(pb + PH_COMBINE);
    }
#undef IN
#undef SEAM
}

typedef void (*kern_t)(Args);
template <int M> static kern_t kern_of() { return (kern_t)mega_fwd<M>; }
static kern_t phase_kernel(int p) {
    switch (p) { case 0: return kern_of<1 << 0>(); case 1: return kern_of<1 << 1>(); case 2: return kern_of<1 << 2>(); case 3: return kern_of<1 << 3>(); case 4: return kern_of<1 << 4>();
                 case 5: return kern_of<1 << 5>(); case 6: return kern_of<1 << 6>(); case 7: return kern_of<1 << 7>(); case 8: return kern_of<1 << 8>(); case 9: return kern_of<1 << 9>();
                 case 10: return kern_of<1 << 10>(); case 11: return kern_of<1 << 11>(); case 12: return kern_of<1 << 12>(); default: return kern_of<1 << 13>(); }
}
extern "C" void kernel_launch(void* const* d_in, const int* in_sizes, int n_in, void* d_out, int out_size, void* d_ws, size_t ws_size, hipStream_t stream) {
    static int grid = 0;
    if (grid == 0) {
        if (n_in != 23 || in_sizes[0] != NT * DM || out_size != NT * DM || ws_size < WS_END) {
            fprintf(stderr, "kernel_launch: built for 23 inputs, x/out of %d floats, >= %zu bytes of workspace; got n_in %d, in0 %d, out %d, ws %zu; nothing launched\n", NT * DM, (size_t)WS_END, n_in, n_in > 0 ? in_sizes[0] : -1, out_size, ws_size);
            grid = -1; return; }
        int dev = 0, cus = 0;
        if (hipGetDevice(&dev) != hipSuccess || hipDeviceGetAttribute(&cus, hipDeviceAttributeMultiprocessorCount, dev) != hipSuccess) { fprintf(stderr, "kernel_launch: device query failed\n"); grid = -1; return; }
#if MK_SPLIT
        for (int p = 0; p < 14; ++p) if (hipFuncSetAttribute((const void*)phase_kernel(p), hipFuncAttributeMaxDynamicSharedMemorySize, LDS_BYTES) != hipSuccess) { fprintf(stderr, "kernel_launch: hipFuncSetAttribute failed\n"); grid = -1; return; }
#else
        if (hipFuncSetAttribute((const void*)kern_of<0x3fff>(), hipFuncAttributeMaxDynamicSharedMemorySize, LDS_BYTES) != hipSuccess) { fprintf(stderr, "kernel_launch: hipFuncSetAttribute failed\n"); grid = -1; return; }
        int per_cu = 0;
        if (hipOccupancyMaxActiveBlocksPerMultiprocessor(&per_cu, (const void*)kern_of<0x3fff>(), NTHR, LDS_BYTES) != hipSuccess || per_cu < 1)
            fprintf(stderr, "kernel_launch: note: occupancy query reports %d workgroups per CU\n", per_cu);
#endif
        (void)hipGetLastError();
        grid = cus;
    }
    if (grid < 0) return;
    if (hipMemsetAsync((char*)d_ws + WS_CTL, 0, CTL_ZERO_BYTES, stream) != hipSuccess) { fprintf(stderr, "kernel_launch: hipMemsetAsync failed\n"); return; }
    Args a{};
    for (int i = 0; i < 23; ++i) a.in[i] = (const float*)d_in[i];
    a.out = (float*)d_out; a.ws = (unsigned char*)d_ws; a.pad = 0;
#if MK_SPLIT
#ifdef MK_SKIP
    (void)hipMemsetAsync((char*)d_ws + WS_MIX, 0, (size_t)NT * DM * 2, stream);
#endif
    for (int p = 0; p < MK_STOP; ++p) { a.ph_lo = p; a.ph_hi = p + 1; a.li = p;
#ifdef MK_SKIP
        if (p >= 1 && (((MK_SKIP) >> ((p - 1) % NPH_LAYER)) & 1)) continue;
#endif
        hipLaunchKernelGGL(phase_kernel(p == 0 ? 13 : (p - 1) % NPH_LAYER), dim3(grid), dim3(NTHR), LDS_BYTES, stream, a); }
#else
    a.ph_lo = 0; a.ph_hi = NPH; a.li = 0;
    hipLaunchKernelGGL(kern_of<0x3fff>(), dim3(grid), dim3(NTHR), LDS_BYTES, stream, a);
#endif
    const hipError_t le = hipPeekAtLastError();
    if (le != hipSuccess) fprintf(stderr, "kernel_launch: launch failed: %s\n", hipGetErrorName(le));
}
```

```cpp
#include <hip/hip_runtime.h>
#include <cstdio>
#include <cstdint>

#define LAS __attribute__((address_space(3)))
#define GAS __attribute__((address_space(1)))
typedef unsigned short bf16;
typedef short bf16x8 __attribute__((ext_vector_type(8)));
typedef float f32x4 __attribute__((ext_vector_type(4)));
typedef float f32x2 __attribute__((ext_vector_type(2)));
typedef unsigned u32x4 __attribute__((ext_vector_type(4)));
typedef unsigned u32x2 __attribute__((ext_vector_type(2)));

constexpr int NB = 16, SEQ = 4096, DM = 1024, NT = NB * SEQ;
constexpr int NIN = 2304;
constexpr int C_POOL = 0, C_LRU = 256, C_GATE = 512, C_Q = 768, C_K = 1280, C_V = 1792;
constexpr int NEXP = 32, TOPK = 4, EFF = 256;
constexpr int NASSIGN = NT * TOPK;
constexpr int ACT_ROWS = NASSIGN + NEXP * 256;
constexpr float EPS = 1e-6f;
constexpr int NWAVES = 8, NTHR = 512;
constexpr int LRU_CH = 32, LRU_NCH = SEQ / LRU_CH;

constexpr size_t MiB = 1u << 20;
constexpr size_t WS_CTL = 0, CTL_ZERO_BYTES = 1 * MiB;
constexpr size_t WS_ROPE = 1 * MiB;
constexpr size_t WS_SMALL = 2 * MiB;
constexpr size_t WS_WIN = 4 * MiB;
constexpr size_t WS_WOUT = 13 * MiB;
constexpr size_t WS_WGU = 17 * MiB;
constexpr size_t WS_WD = 81 * MiB;
constexpr size_t WS_SSQ = 113 * MiB;
constexpr size_t WS_SSQP = 114 * MiB;
constexpr size_t WS_LIST = 118 * MiB;
constexpr size_t WS_XB = 128 * MiB;
constexpr size_t WS_R = 256 * MiB;
constexpr size_t WS_PROJ = WS_R;
constexpr size_t WS_MIX = WS_R + 288 * MiB;
constexpr size_t WS_PNUM = WS_R + 416 * MiB;
constexpr size_t WS_PDEN = WS_R + 608 * MiB;
constexpr size_t WS_PMAX = WS_R + 614 * MiB;
constexpr size_t WS_HL = WS_R + 620 * MiB;
constexpr size_t WS_PL = WS_R + 652 * MiB;
constexpr size_t WS_AGGH = WS_R + 684 * MiB;
constexpr size_t WS_AGGP = WS_R + 686 * MiB;
constexpr size_t WS_CARRY = WS_R + 688 * MiB;
constexpr size_t WS_ACT = WS_R;
constexpr size_t WS_Y = WS_R + 132 * MiB;
constexpr size_t WS_LRSTD = WS_R + 644 * MiB;
constexpr size_t WS_LGATE2 = WS_R + 652 * MiB;
constexpr size_t WS_END = 1024 * MiB;
static_assert(WS_CARRY + 2 * MiB <= WS_END && WS_LGATE2 + 8 * MiB <= WS_END, "d_ws map");
constexpr size_t SM_POOLW = 0;
constexpr size_t SM_WA = 32768;
constexpr size_t SM_WX = 65536;
constexpr size_t SM_WR = 98304;
constexpr int CW_BAR = 4096;
constexpr int CW_CNT = 1024;

constexpr int RING_BYTES = 131072;
constexpr int LDSCTL_OFF = RING_BYTES;
constexpr int MISC_OFF = LDSCTL_OFF + 320;
constexpr int TAB_OFF = LDSCTL_OFF + 1024;
constexpr int OST_OFF = RING_BYTES + 8192;
constexpr int LDS_BYTES = 163840;

typedef GAS unsigned gu32;
#define RLX_AGENT __ATOMIC_RELAXED, __HIP_MEMORY_SCOPE_AGENT
#define LDS_WAIT() asm volatile("s_waitcnt lgkmcnt(0)" ::: "memory")
#define VM_WAIT() asm volatile("s_waitcnt vmcnt(0)" ::: "memory")
typedef __bf16 bf16x2_t __attribute__((ext_vector_type(2)));
__device__ __forceinline__ unsigned cvt_pk_bf16(float lo, float hi) { const f32x2 v = {lo, hi}; const bf16x2_t b = __builtin_convertvector(v, bf16x2_t); return __builtin_bit_cast(unsigned, b); }
__device__ __forceinline__ float bflo(unsigned w) { return __uint_as_float(w << 16); }
__device__ __forceinline__ float bfhi(unsigned w) { return __uint_as_float(w & 0xffff0000u); }
__device__ __forceinline__ float bf2f(bf16 h) { return __uint_as_float((unsigned)h << 16); }
__device__ __forceinline__ bf16 f2bf(float f) { return (bf16)(cvt_pk_bf16(f, 0.f) & 0xffffu); }
__device__ __forceinline__ float wave_sum(float v) {
#pragma unroll
    for (int o = 1; o < 64; o <<= 1) v += __shfl_xor(v, o);
    return v;
}
__device__ __forceinline__ float fast_sigmoid(float x) { return __builtin_amdgcn_rcpf(1.0f + __builtin_amdgcn_exp2f(-1.4426950408889634f * x)); }
__device__ __forceinline__ float fast_exp(float x) { return __builtin_amdgcn_exp2f(1.4426950408889634f * x); }
__device__ __forceinline__ float gelu_tanh(float x) {
    const float u = 0.7978845608028654f * (x + 0.044715f * x * x * x);
    return x * fast_sigmoid(2.0f * u);
}
__device__ __forceinline__ int tid_from(int wv) { int ln; asm volatile("v_mbcnt_lo_u32_b32 %0, -1, 0\n\tv_mbcnt_hi_u32_b32 %0, -1, %0" : "=v"(ln)); return wv * 64 + ln; }
namespace pg8 {
constexpr int BM = 256, BK = 64, HALF = 128, HTB = HALF * BK * 2  , STAGE_BYTES = 8 * HTB, NXCD = 8, WGM = 8;

__host__ __device__ __forceinline__ int lds_byte(int r, int c) { const int st = (r >> 4) * 2 + (c >> 5), rr = r & 15, cc = c & 31, ob = rr * 64 + cc * 2; return st * 1024 + (ob ^ (((ob >> 9) & 1) << 5)); }
__host__ __device__ __forceinline__ void stage_rc(int b, int& R, int& C) { const int st = b / 1024, sb = b % 1024, swz = sb ^ (((sb >> 9) & 1) << 5); R = (st >> 1) * 16 + swz / 64; C = (st & 1) * 32 + (swz % 64) / 2; }
__host__ __device__ __forceinline__ int perm32(int rho) { const int n = rho >> 4, i = rho & 15; return 8 * (i >> 2) + 4 * n + (i & 3); }

struct Unit { int pm, pn, e, aux; };

template <class Epi, class Sched, bool ALIGN_EPI>
__device__ __forceinline__ void gemm_phase(LAS unsigned char* lds, const bf16* Abase, const bf16* Bbase, const int K, const Sched& S, const Epi& E, const int wv) {
    const int tid = tid_from(wv), wid = __builtin_amdgcn_readfirstlane(tid >> 6), lane = tid & 63, wr = wid >> 2, wc = wid & 3, fr = lane & 15, fq = lane >> 4;
    const int nt = K / BK;
    unsigned voffB[2];
#pragma unroll
    for (int i = 0; i < 2; ++i) { int R, C; stage_rc(tid * 16 + i * 8192, R, C); const int Rb = Epi::PERM ? ((R & ~31) + perm32(R & 31)) : R;
        voffB[i] = (unsigned)(Rb * K + C) * 2u; }
#define PG8_AVOFF(u, h, i) ([&]() { int R_, C_; stage_rc(tid * 16 + (i) * 8192, R_, C_); return S.a_voff((u), (h) * HALF + R_, C_); }())
    const unsigned kstep = (unsigned)(BK * 2);
    const unsigned hstep = (unsigned)(HALF * K * 2);
    const unsigned ldsw = (unsigned)wid * 1024u;
    const int aoff = lds_byte(wr * 64 + fr, fq * 8), boff = lds_byte(wc * 32 + fr, fq * 8);
    const __amdgpu_buffer_rsrc_t rsA = __builtin_amdgcn_make_buffer_rsrc((void*)Abase, 0, 0x7fffffff, 0x00020000);
    const __amdgpu_buffer_rsrc_t rsB = __builtin_amdgcn_make_buffer_rsrc((void*)Bbase, 0, 0x7fffffff, 0x00020000);
#define PG8_SA(b, h) (((b) * 2 + (h)) * HTB)
#define PG8_SB(b, h) ((4 + (b) * 2 + (h)) * HTB)
#define PG8_STAGE_B(bufoff, soff) do { const int so_ = __builtin_amdgcn_readfirstlane((int)(soff)); _Pragma("unroll") for (int _i = 0; _i < 2; ++_i) \
        __builtin_amdgcn_raw_ptr_buffer_load_lds(rsB, (LAS void*)(lds + (bufoff) + ldsw + _i * 8192), 16, voffB[_i], so_, 0, 0); } while (0)
#define PG8_STAGE_A(bufoff, kbytes, v0, v1) do { const int so_ = __builtin_amdgcn_readfirstlane((int)(kbytes)); \
        __builtin_amdgcn_raw_ptr_buffer_load_lds(rsA, (LAS void*)(lds + (bufoff) + ldsw), 16, (v0), so_, 0, 0); \
        __builtin_amdgcn_raw_ptr_buffer_load_lds(rsA, (LAS void*)(lds + (bufoff) + ldsw + 8192), 16, (v1), so_, 0, 0); } while (0)
#define PG8_LDA(dst, b, h) do { _Pragma("unroll") for (int m = 0; m < 4; ++m) _Pragma("unroll") for (int k = 0; k < 2; ++k) dst[m][k] = *(const LAS bf16x8*)(lds + PG8_SA(b, h) + aoff + m * 2048 + k * 1024); } while (0)
#define PG8_LDB(dst, b, h) do { _Pragma("unroll") for (int n = 0; n < 2; ++n) _Pragma("unroll") for (int k = 0; k < 2; ++k) dst[n][k] = *(const LAS bf16x8*)(lds + PG8_SB(b, h) + boff + n * 2048 + k * 1024); } while (0)
#define PG8_MMA(ai, bj, At, Bt) do { __builtin_amdgcn_s_setprio(1); _Pragma("unroll") for (int m = 0; m < 4; ++m) _Pragma("unroll") for (int n = 0; n < 2; ++n) _Pragma("unroll") for (int k = 0; k < 2; ++k) \
        acc[ai][bj][m][n] = __builtin_amdgcn_mfma_f32_16x16x32_bf16(Bt[n][k], At[m][k], acc[ai][bj][m][n], 0, 0, 0); __builtin_amdgcn_s_setprio(0); } while (0)
#define PG8_WAIT_V(n) asm volatile("s_waitcnt vmcnt(" #n ")" ::: "memory")
#define PG8_WAIT_L(n) asm volatile("s_waitcnt lgkmcnt(" #n ")" ::: "memory")
#define PG8_BAR __builtin_amdgcn_s_barrier()
#define PG8_SCHED __builtin_amdgcn_sched_barrier(0)
    Unit cur, nxt; int ui = 0;
    if (!S.next(0, cur)) return;
    f32x4 acc[2][2][4][2];
#pragma unroll
    for (int a = 0; a < 2; ++a)
#pragma unroll
        for (int b = 0; b < 2; ++b)
#pragma unroll
            for (int m = 0; m < 4; ++m)
#pragma unroll
                for (int n = 0; n < 2; ++n) acc[a][b][m][n] = (f32x4){0.f, 0.f, 0.f, 0.f};
    bf16x8 At[4][2], B0[2][2], B1[2][2];
    unsigned vc0, vc1, vc2, vc3, vn0, vn1, vn2, vn3;
    unsigned cA0, cA1, nA0, nA1;
    vc0 = PG8_AVOFF(cur, 0, 0); vc1 = PG8_AVOFF(cur, 0, 1);
    if constexpr (Sched::GATHER) { vc2 = PG8_AVOFF(cur, 1, 0); vc3 = PG8_AVOFF(cur, 1, 1); } else { vc2 = vc0; vc3 = vc1; }
    cA0 = S.a_soff(cur, 0); cA1 = S.a_soff(cur, 1);
    unsigned cB = (unsigned)S.b_off(cur);
    PG8_STAGE_B(PG8_SB(0, 0), cB); PG8_STAGE_B(PG8_SB(0, 1), cB + hstep); PG8_STAGE_A(PG8_SA(0, 0), cA0, vc0, vc1); PG8_STAGE_A(PG8_SA(0, 1), cA1, vc2, vc3);
    if (wr == 1) PG8_BAR;
    PG8_WAIT_V(2); PG8_BAR;
    PG8_STAGE_B(PG8_SB(1, 0), cB + kstep); PG8_STAGE_A(PG8_SA(1, 0), cA0 + kstep, vc0, vc1); PG8_STAGE_B(PG8_SB(1, 1), cB + hstep + kstep);
    PG8_WAIT_V(6); PG8_BAR;
    for (;;) {
#define PG8_TRIP(a1k, a2k0, a2k1, a3k0, b2, b3, w0, w1, w2, w3) do { \
              \
            PG8_LDB(B0, 0, 0); PG8_LDB(B1, 0, 1); PG8_SCHED; PG8_LDA(At, 0, 0); PG8_STAGE_A(PG8_SA(1, 1), a1k, vc2, vc3); \
            PG8_WAIT_V(8); PG8_WAIT_L(0); PG8_BAR; PG8_MMA(0, 0, At, B0); PG8_MMA(0, 1, At, B1); PG8_BAR; PG8_SCHED; \
              \
            PG8_LDA(At, 0, 1); PG8_STAGE_B(PG8_SB(0, 0), b2); PG8_STAGE_B(PG8_SB(0, 1), (b2) + hstep); PG8_STAGE_A(PG8_SA(0, 0), a2k0, w0, w1); \
            PG8_WAIT_V(8); PG8_WAIT_L(0); PG8_BAR; PG8_MMA(1, 0, At, B0); PG8_MMA(1, 1, At, B1); PG8_BAR; PG8_SCHED; \
              \
            PG8_LDB(B0, 1, 0); PG8_LDB(B1, 1, 1); PG8_SCHED; PG8_LDA(At, 1, 0); PG8_STAGE_A(PG8_SA(0, 1), a2k1, w2, w3); \
            PG8_WAIT_V(8); PG8_WAIT_L(0); PG8_BAR; PG8_MMA(0, 0, At, B0); PG8_MMA(0, 1, At, B1); PG8_BAR; PG8_SCHED; \
              \
            PG8_LDA(At, 1, 1); PG8_STAGE_B(PG8_SB(1, 0), b3); PG8_STAGE_B(PG8_SB(1, 1), (b3) + hstep); PG8_STAGE_A(PG8_SA(1, 0), a3k0, w0, w1); \
            PG8_WAIT_V(8); PG8_WAIT_L(0); PG8_BAR; PG8_MMA(1, 0, At, B0); PG8_MMA(1, 1, At, B1); PG8_BAR; PG8_SCHED; } while (0)
        for (int t = 0; t < nt - 2; t += 2) {
            const unsigned k1 = (unsigned)(t + 1) * kstep, k2 = (unsigned)(t + 2) * kstep, b2 = cB + k2, b3 = b2 + kstep;
            PG8_TRIP(cA1 + k1, cA0 + k2, cA1 + k2, cA0 + k2 + kstep, b2, b3, vc0, vc1, vc2, vc3);
        }
        const bool has_next = S.next(ui + 1, nxt);
        unsigned nB;
        if (has_next) { if constexpr (Sched::GATHER) { vn0 = PG8_AVOFF(nxt, 0, 0); vn1 = PG8_AVOFF(nxt, 0, 1); vn2 = PG8_AVOFF(nxt, 1, 0); vn3 = PG8_AVOFF(nxt, 1, 1); } else { vn0 = vc0; vn1 = vc1; vn2 = vc0; vn3 = vc1; }
                        nA0 = S.a_soff(nxt, 0); nA1 = S.a_soff(nxt, 1); nB = (unsigned)S.b_off(nxt); }
        else { vn0 = vc0; vn1 = vc1; vn2 = vc2; vn3 = vc3; nA0 = cA0; nA1 = cA1; nB = cB; }
        { const unsigned k1 = (unsigned)(nt - 1) * kstep;
          PG8_TRIP(cA1 + k1, nA0, nA1, nA0 + kstep, nB, nB + kstep, vn0, vn1, vn2, vn3); }
#undef PG8_TRIP
        if constexpr (ALIGN_EPI) { if (wr == 0) PG8_BAR; }
        E(acc, cur, wr, wc, fr, fq);
        if (!has_next) break;
#pragma unroll
        for (int a = 0; a < 2; ++a)
#pragma unroll
            for (int b = 0; b < 2; ++b)
#pragma unroll
                for (int m = 0; m < 4; ++m)
#pragma unroll
                    for (int n = 0; n < 2; ++n) acc[a][b][m][n] = (f32x4){0.f, 0.f, 0.f, 0.f};
        cur = nxt; cB = nB; cA0 = nA0; cA1 = nA1; vc0 = vn0; vc1 = vn1; vc2 = vn2; vc3 = vn3; ++ui;
        if constexpr (ALIGN_EPI) { if (wr == 1) PG8_BAR; }
    }
    PG8_WAIT_V(0);
    if constexpr (!ALIGN_EPI) { if (wr == 0) PG8_BAR; }
    PG8_BAR;
#undef PG8_SA
#undef PG8_AVOFF
#undef PG8_SB
#undef PG8_STAGE_A
#undef PG8_STAGE_B
#undef PG8_LDA
#undef PG8_LDB
#undef PG8_MMA
#undef PG8_WAIT_V
#undef PG8_WAIT_L
#undef PG8_BAR
#undef PG8_SCHED
}

struct StaticOrder {
    int nM, nN, nwg, G, c, lda, dup;
    __device__ __forceinline__ void init(int M, int N, int lda_, int G_, int c_) { nM = M / BM; nN = N / BM; nwg = nM * nN; G = G_; c = c_; lda = lda_; dup = 0; }
    __device__ __forceinline__ bool next(int i, Unit& u) const {
        const long L = (long)(i >> dup) * G + c; if (L >= nwg) return false;
        int wgid = (int)L; { const int q = nwg / NXCD, r = nwg % NXCD, xcd = wgid % NXCD, off = wgid / NXCD; wgid = (xcd < r ? xcd * (q + 1) : r * (q + 1) + (xcd - r) * q) + off; }
        const int nig = WGM * nN, gid = wgid / nig, fm = gid * WGM, gsz = (nM - fm) < WGM ? (nM - fm) : WGM;
        u.pm = fm + ((wgid % nig) % gsz); u.pn = (wgid % nig) / gsz; u.e = 0; u.aux = 0; return true;
    }
    static constexpr bool GATHER = false;
    __device__ __forceinline__ unsigned a_voff(const Unit&, int R, int C) const { return (unsigned)((R & (HALF - 1)) * lda + C) * 2u; }
    __device__ __forceinline__ unsigned a_soff(const Unit& u, int h) const { return (unsigned)((u.pm * BM + h * HALF) * lda) * 2u; }
    __device__ __forceinline__ size_t b_off(const Unit& u) const { return (size_t)u.pn * BM * lda * 2; }
};
}

#define XB_TMO      128
#define XB_XCNT(j)  (256  + 64 * (j))
#define XB_XSUB(j)  (1280 + 64 * (j))
#define XB_XGEN(j)  (2304 + 64 * (j))
#define XB_TOP      3328
#define XB_TOPGEN   3392
#define XCD_BAR_WORDS 3456
#define XB_SPIN_CAP (1u << 18)

__device__ __forceinline__ unsigned xb_ld(unsigned* p)              { return __hip_atomic_load(p, __ATOMIC_RELAXED, __HIP_MEMORY_SCOPE_AGENT); }
__device__ __forceinline__ unsigned xb_add(unsigned* p, unsigned v) { return __hip_atomic_fetch_add(p, v, __ATOMIC_RELAXED, __HIP_MEMORY_SCOPE_AGENT); }
__device__ __forceinline__ unsigned xb_xcc_id() { return (unsigned)__builtin_amdgcn_s_getreg((3 << 11) | 20) & 0xFu; }
#define XB_SPIN(cond, bar) do { unsigned _sp = 0; while (cond) { __builtin_amdgcn_s_sleep(1); \
    if ((++_sp & 255u) == 0u) { if (xb_ld(&(bar)[XB_TMO])) break; if (_sp > XB_SPIN_CAP) { atomicAdd(&(bar)[XB_TMO], 1u); break; } } } } while (0)

struct XcdBarrier {
    unsigned* bar; unsigned x;
    volatile LAS unsigned* st;
};

__device__ __forceinline__ XcdBarrier xcd_barrier_post(unsigned* bar, volatile LAS unsigned* st) {
    XcdBarrier b; b.bar = bar; b.x = xb_xcc_id(); b.st = st;
    if (threadIdx.x == 0) (void)xb_add(&bar[XB_XCNT(b.x)], 1u);
    return b;
}
__device__ __forceinline__ void xcd_barrier_complete(unsigned* bar, unsigned x, unsigned& nloc, unsigned& nx) {
    const unsigned G = gridDim.x * gridDim.y * gridDim.z;
    unsigned sum, cnt, mine, sp = 0u;
    for (;;) {
        sum = 0u; cnt = 0u; mine = 0u;
#pragma unroll
        for (unsigned j = 0; j < 16; ++j) { const unsigned c = xb_ld(&bar[XB_XCNT(j)]); sum += c; cnt += (c > 0u) ? 1u : 0u; mine = (j == x) ? c : mine; }
        if (sum == G) break;
        __builtin_amdgcn_s_sleep(1);
        if ((++sp & 255u) == 0u) { if (xb_ld(&bar[XB_TMO])) break; if (sp > XB_SPIN_CAP) { atomicAdd(&bar[XB_TMO], 1u); break; } }
    }
    nloc = mine > 0u ? mine : 1u; nx = cnt > 0u ? cnt : 1u;
}

__device__ __forceinline__ void xcd_barrier(const XcdBarrier& b) {
    asm volatile("s_waitcnt vmcnt(0)" ::: "memory");
    __syncthreads();
    if (threadIdx.x == 0) {
        unsigned* bar = b.bar;
        __builtin_amdgcn_s_waitcnt(0);
        unsigned nloc = b.st[0], nx = b.st[1];
        if (nloc == 0u) { xcd_barrier_complete(bar, b.x, nloc, nx); b.st[0] = nloc; b.st[1] = nx; }
        const unsigned old = xb_add(&bar[XB_XSUB(b.x)], 1u);
        const unsigned gen = old / nloc;
        if (old + 1u == (gen + 1u) * nloc) {
            __builtin_amdgcn_fence(__ATOMIC_RELEASE, "agent");
            asm volatile("s_waitcnt vmcnt(0)" ::: "memory");
            const unsigned og = xb_add(&bar[XB_TOP], 1u);
            const unsigned tg = og / nx;
            if (og + 1u == (tg + 1u) * nx) xb_add(&bar[XB_TOPGEN], 1u);
            else XB_SPIN(xb_ld(&bar[XB_TOPGEN]) == tg, bar);
            __builtin_amdgcn_fence(__ATOMIC_ACQUIRE, "agent");
            xb_add(&bar[XB_XGEN(b.x)], 1u);
            asm volatile("s_waitcnt vmcnt(0)" ::: "memory");
        } else {
            XB_SPIN(xb_ld(&bar[XB_XGEN(b.x)]) == gen, bar);
            __builtin_amdgcn_fence(__ATOMIC_ACQUIRE, "agent");
            asm volatile("s_waitcnt vmcnt(0)" ::: "memory");
        }
    }
    __syncthreads();
}

struct Args { const float* in[23]; float* out; unsigned char* ws; int ph_lo, ph_hi, li, pad; };
#define CAS __attribute__((address_space(4)))
typedef const CAS Args& ArgsRef;
enum { I_X = 0, I_NORM1G, I_WIN, I_POOLW, I_POOLSC, I_CONVW, I_CONVB, I_WA, I_BA, I_WX, I_BX, I_LAM, I_QG, I_KG, I_OG, I_WOUT, I_NORM2G, I_WR, I_BR, I_WGU, I_BGU, I_WD, I_BD };

__device__ __forceinline__ void tr_item(const float* W, int K, int N, bf16* WT, const float* gk, int mode, LAS float* scr, int item, int lane) {
    const int nblk = N / 32, kb = item / nblk, nb = item % nblk, k0 = 64 * kb, n0 = 32 * nb;
#pragma unroll 8
    for (int i = 0; i < 32; ++i) { const int kk = 2 * i + (lane >> 5); float v = W[(size_t)(k0 + kk) * N + n0 + (lane & 31)]; if (gk) v *= gk[k0 + kk]; scr[kk * 33 + (lane & 31)] = v; }
    LDS_WAIT(); asm volatile("" ::: "memory");
    const int c = lane & 7;
#pragma unroll
    for (int j = 0; j < 4; ++j) { const int n = (lane >> 3) + 8 * j; const LAS float* s = scr + (8 * c) * 33 + n;
        u32x4 o; o.x = cvt_pk_bf16(s[0 * 33], s[1 * 33]); o.y = cvt_pk_bf16(s[2 * 33], s[3 * 33]); o.z = cvt_pk_bf16(s[4 * 33], s[5 * 33]); o.w = cvt_pk_bf16(s[6 * 33], s[7 * 33]);
        int dn = n0 + n;
        if (mode == 1) { const int jj = dn & 255; dn = (jj >> 7) * 256 + (dn >> 8) * 128 + (jj & 127); }
        *(u32x4*)(WT + (size_t)dn * K + k0 + 8 * c) = o; }
    LDS_WAIT(); asm volatile("" ::: "memory");
}
__device__ __forceinline__ void cvt_row(const float* xrow, bf16* orow, float* ssq, int lane) {
    const f32x4* xr = (const f32x4*)xrow + lane;
    f32x4 v[4]; float s = 0.f;
#pragma unroll
    for (int j = 0; j < 4; ++j) { v[j] = xr[64 * j]; s += (v[j].x * v[j].x + v[j].y * v[j].y) + (v[j].z * v[j].z + v[j].w * v[j].w); }
    s = wave_sum(s);
    u32x2* o8 = (u32x2*)orow + lane;
#pragma unroll
    for (int j = 0; j < 4; ++j) { u32x2 w; w.x = cvt_pk_bf16(v[j].x, v[j].y); w.y = cvt_pk_bf16(v[j].z, v[j].w); o8[64 * j] = w; }
    if (lane == 0) *ssq = s;
}
__device__ __forceinline__ void phase_prologue(ArgsRef a, LAS unsigned char* lds, int wv) {
    const int tid = tid_from(wv), lane = tid & 63, wave = tid >> 6;
    LAS float* scr = (LAS float*)(lds + wave * 16384);
    const int gw = blockIdx.x * NWAVES + wave, NGW = gridDim.x * NWAVES;
    unsigned char* ws = a.ws;
    constexpr int I_IN = 16 * 72, I_OUT = 16 * 32, I_R = 16, I_GU = 16 * 16, I_D = 4 * 32, I_S = 2;
    constexpr int PER_LAYER = I_IN + I_OUT + I_R + NEXP * I_GU + NEXP * I_D + 12 * I_S;
    for (int it = gw; it < 2 * PER_LAYER; it += NGW) {
        const int l = it / PER_LAYER; int r = it % PER_LAYER;
        if (r < I_IN) { tr_item(a.in[I_WIN] + (size_t)l * DM * NIN, DM, NIN, (bf16*)(ws + WS_WIN) + (size_t)l * NIN * DM, a.in[I_NORM1G] + l * DM, 0, scr, r, lane); continue; } r -= I_IN;
        if (r < I_OUT) { tr_item(a.in[I_WOUT] + (size_t)l * DM * DM, DM, DM, (bf16*)(ws + WS_WOUT) + (size_t)l * DM * DM, a.in[I_OG] + l * DM, 0, scr, r, lane); continue; } r -= I_OUT;
        if (r < I_R) { tr_item(a.in[I_WR] + (size_t)l * DM * NEXP, DM, NEXP, (bf16*)(ws + WS_SMALL) + SM_WR + (size_t)l * NEXP * DM, a.in[I_NORM2G] + l * DM, 0, scr, r, lane); continue; } r -= I_R;
        if (r < NEXP * I_GU) { const int e = r / I_GU; tr_item(a.in[I_WGU] + (size_t)(l * NEXP + e) * DM * 512, DM, 512, (bf16*)(ws + WS_WGU) + (size_t)(l * NEXP + e) * 512 * DM, a.in[I_NORM2G] + l * DM, 1, scr, r % I_GU, lane); continue; } r -= NEXP * I_GU;
        if (r < NEXP * I_D) { const int e = r / I_D; tr_item(a.in[I_WD] + (size_t)(l * NEXP + e) * EFF * DM, EFF, DM, (bf16*)(ws + WS_WD) + (size_t)(l * NEXP + e) * DM * EFF, nullptr, 0, scr, r % I_D, lane); continue; } r -= NEXP * I_D;
        { const int which = r / (4 * I_S), g = (r / I_S) % 4, sub = r % I_S;
          const float* src = a.in[which == 0 ? I_POOLW : (which == 1 ? I_WA : I_WX)] + (size_t)(l * 4 + g) * 4096;
          bf16* dst = (bf16*)(ws + WS_SMALL) + (which == 0 ? SM_POOLW : (which == 1 ? SM_WA : SM_WX)) + (size_t)(l * 4 + g) * 4096;
          tr_item(src, 64, 64, dst, nullptr, 0, scr, sub, lane); }
    }
    { float* ct = (float*)(ws + WS_ROPE); float* st = ct + SEQ * 32;
      for (int idx = blockIdx.x * NTHR + tid; idx < SEQ * 32; idx += gridDim.x * NTHR) {
          const int pos = idx >> 5, i = idx & 31;
          const float inv = __builtin_amdgcn_exp2f(-(float)i * 0.41524101186092029f);
          const float ang = (float)pos * inv;
          const double rev = (double)ang * 0.15915494309189535; const double fr = rev - __builtin_rint(rev);
          const float f = (float)fr;
          ct[idx] = __builtin_amdgcn_cosf(f); st[idx] = __builtin_amdgcn_sinf(f); } }
    for (int m = gw; m < NT; m += NGW) cvt_row(a.in[I_X] + (size_t)m * DM, (bf16*)(ws + WS_XB) + (size_t)m * DM, (float*)(ws + WS_SSQ) + m, lane);
}

struct EpiIn {
    static constexpr bool PERM = true;
    bf16* O; const float* ssq;
    __device__ __forceinline__ void operator()(const f32x4 (&acc)[2][2][4][2], const pg8::Unit& u, int wr, int wc, int fr, int fq) const {
        const int row0 = u.pm * 256 + wr * 64 + fr, col0 = u.pn * 256 + wc * 32 + 8 * fq;
#pragma unroll
        for (int ai = 0; ai < 2; ++ai)
#pragma unroll
            for (int m = 0; m < 4; ++m) { const int row = row0 + ai * 128 + m * 16; const float rs = __builtin_amdgcn_rsqf(ssq[row] * (1.0f / DM) + EPS);
                bf16* rowp = O + (size_t)row * NIN + col0;
#pragma unroll
                for (int bj = 0; bj < 2; ++bj) { const f32x4 v0 = acc[ai][bj][m][0] * rs, v1 = acc[ai][bj][m][1] * rs;
                    u32x4 w; w.x = cvt_pk_bf16(v0[0], v0[1]); w.y = cvt_pk_bf16(v0[2], v0[3]); w.z = cvt_pk_bf16(v1[0], v1[1]); w.w = cvt_pk_bf16(v1[2], v1[3]);
                    *(u32x4*)(rowp + bj * 128) = w; } }
    }
};
struct EpiOut {
    static constexpr bool PERM = false;
    bf16* xb; float* ssqp;
    __device__ __forceinline__ void operator()(const f32x4 (&acc)[2][2][4][2], const pg8::Unit& u, int wr, int wc, int fr, int fq) const {
        const int row0 = u.pm * 256 + wr * 64 + fr, col0 = u.pn * 256 + wc * 32 + 4 * fq;
#pragma unroll
        for (int ai = 0; ai < 2; ++ai)
#pragma unroll
            for (int m = 0; m < 4; ++m) { const int row = row0 + ai * 128 + m * 16; const size_t off = (size_t)row * DM + col0; float s = 0.f;
                u32x2 xi[2][2];
#pragma unroll
                for (int bj = 0; bj < 2; ++bj)
#pragma unroll
                    for (int n = 0; n < 2; ++n) xi[bj][n] = *(const u32x2*)(xb + off + bj * 128 + n * 16);
#pragma unroll
                for (int bj = 0; bj < 2; ++bj)
#pragma unroll
                    for (int n = 0; n < 2; ++n) { const f32x4 o = (f32x4){bflo(xi[bj][n].x), bfhi(xi[bj][n].x), bflo(xi[bj][n].y), bfhi(xi[bj][n].y)} + acc[ai][bj][m][n];
                        s += (o[0] * o[0] + o[1] * o[1]) + (o[2] * o[2] + o[3] * o[3]);
                        u32x2 w; w.x = cvt_pk_bf16(o[0], o[1]); w.y = cvt_pk_bf16(o[2], o[3]); *(u32x2*)(xb + off + bj * 128 + n * 16) = w; }
                s += __shfl_xor(s, 16); s += __shfl_xor(s, 32);
                if (fq == 0) ssqp[(size_t)row * 16 + u.pn * 4 + wc] = s; }
    }
};

template <int MODE> struct MoeOrder {
    static constexpr bool GATHER = (MODE == 0);
    const LAS int* tab; int npn, G, c; const int* list; int dup;
    __device__ __forceinline__ bool next(int i, pg8::Unit& u) const {
        const int L = (i >> dup) * G + c; const int total = __builtin_amdgcn_readfirstlane(tab[64]) * npn; if (L >= total) return false;
        const int gb = L / npn; u.pn = L % npn; int e = 0;
        for (int k = 1; k < NEXP; ++k) { if (__builtin_amdgcn_readfirstlane(tab[32 + k]) <= gb) e = k; }
        u.e = e; u.pm = gb; u.aux = gb - __builtin_amdgcn_readfirstlane(tab[32 + e]); return true;
    }
    __device__ __forceinline__ unsigned a_voff(const pg8::Unit& u, int R, int C) const {
        if constexpr (MODE == 0) { const int pos = u.aux * 256 + R; const int ne = tab[u.e]; int tok = 0; if (pos < ne) tok = list[u.e * NT + pos] >> 2; return (unsigned)(tok * DM + C) * 2u; }
        else return (unsigned)((R & 127) * EFF + C) * 2u;
    }
    __device__ __forceinline__ unsigned a_soff(const pg8::Unit& u, int h) const { if constexpr (MODE == 0) return 0u; else return (unsigned)((u.pm * 256 + h * 128) * EFF) * 2u; }
    __device__ __forceinline__ size_t b_off(const pg8::Unit& u) const {
        if constexpr (MODE == 0) return ((size_t)u.e * 512 + (size_t)u.pn * 256) * DM * 2;
        else return ((size_t)u.e * DM + (size_t)u.pn * 256) * EFF * 2;
    }
};
struct EpiGU {
    static constexpr bool PERM = true;
    bf16* act; const float* lrstd; const float* bgu;
    __device__ __forceinline__ void operator()(const f32x4 (&acc)[2][2][4][2], const pg8::Unit& u, int wr, int wc, int fr, int fq) const {
        const int r0 = wr * 64 + fr, cl0 = wc * 32 + 8 * fq;
        const float* bg = bgu + u.e * 512 + u.pn * 128 + cl0;
        const f32x4 bg0 = *(const f32x4*)(bg), bg1 = *(const f32x4*)(bg + 4), bu0 = *(const f32x4*)(bg + 256), bu1 = *(const f32x4*)(bg + 260);
#pragma unroll
        for (int ai = 0; ai < 2; ++ai)
#pragma unroll
            for (int m = 0; m < 4; ++m) { const int r = r0 + ai * 128 + m * 16; const float rs = lrstd[(size_t)u.e * NT + u.aux * 256 + r];
                f32x4 g0 = acc[ai][0][m][0] * rs + bg0, g1 = acc[ai][0][m][1] * rs + bg1, u0 = acc[ai][1][m][0] * rs + bu0, u1 = acc[ai][1][m][1] * rs + bu1;
                float o[8];
#pragma unroll
                for (int j = 0; j < 4; ++j) { const float ga = fminf(g0[j], 7.0f), ua = fminf(fmaxf(u0[j], -7.0f), 7.0f); o[j] = (ua + 1.0f) * ga * fast_sigmoid(1.702f * ga);
                                              const float gb = fminf(g1[j], 7.0f), ub = fminf(fmaxf(u1[j], -7.0f), 7.0f); o[4 + j] = (ub + 1.0f) * gb * fast_sigmoid(1.702f * gb); }
                u32x4 w; w.x = cvt_pk_bf16(o[0], o[1]); w.y = cvt_pk_bf16(o[2], o[3]); w.z = cvt_pk_bf16(o[4], o[5]); w.w = cvt_pk_bf16(o[6], o[7]);
                *(u32x4*)(act + (size_t)(u.pm * 256 + r) * EFF + u.pn * 128 + cl0) = w; }
    }
};
struct EpiDown {
    static constexpr bool PERM = true;
    bf16* y; const int* list; const float* lgate; const float* bd; const LAS int* tab;
    __device__ __forceinline__ void operator()(const f32x4 (&acc)[2][2][4][2], const pg8::Unit& u, int wr, int wc, int fr, int fq) const {
        const int r0 = wr * 64 + fr, col0 = u.pn * 256 + wc * 32 + 8 * fq; const int ne = tab[u.e];
        const float* bp = bd + u.e * DM + col0;
#pragma unroll
        for (int ai = 0; ai < 2; ++ai)
#pragma unroll
            for (int m = 0; m < 4; ++m) { const int pos = u.aux * 256 + r0 + ai * 128 + m * 16;
                asm volatile("" ::: "memory");
                if (pos < ne) { const int asg = list[(size_t)u.e * NT + pos]; const float gt = lgate[(size_t)u.e * NT + pos]; bf16* rowp = y + (size_t)asg * DM + col0;
#pragma unroll
                    for (int bj = 0; bj < 2; ++bj) { const f32x4 b0 = *(const f32x4*)(bp + bj * 128), b1 = *(const f32x4*)(bp + bj * 128 + 4);
                        const f32x4 v0 = (acc[ai][bj][m][0] + b0) * gt, v1 = (acc[ai][bj][m][1] + b1) * gt;
                        u32x4 w; w.x = cvt_pk_bf16(v0[0], v0[1]); w.y = cvt_pk_bf16(v0[2], v0[3]); w.z = cvt_pk_bf16(v1[0], v1[1]); w.w = cvt_pk_bf16(v1[2], v1[3]);
                        *(u32x4*)(rowp + bj * 128) = w; } } }
    }
};
__device__ __forceinline__ void moe_tables(LAS int* tab, const unsigned* cnt, int wv) {
    __syncthreads();
    const int tid_ = tid_from(wv);
    if (tid_ == 0) { int pre = 0;
        for (int e = 0; e < NEXP; ++e) { const int n = (int)__hip_atomic_load(cnt + e, RLX_AGENT); tab[e] = n; tab[32 + e] = pre; pre += (n + 255) >> 8; }
        tab[64] = pre; }
    __syncthreads();
}

__device__ __forceinline__ void phase_qkprep(ArgsRef a, int layer, int wv, bool dry) {
    const int tid = tid_from(wv), lane = tid & 63, wave = tid >> 6;
    const int gw = blockIdx.x * NWAVES + wave, NGW = gridDim.x * NWAVES;
    bf16* proj = (bf16*)(a.ws + WS_PROJ);
    const float* __restrict__ ct = (const float*)(a.ws + WS_ROPE); const float* __restrict__ st = ct + SEQ * 32;
    const int d0 = (lane & 7) * 8, p0 = d0 & 31;
    float gq[8], gk[8];
#pragma unroll
    for (int j = 0; j < 8; ++j) { gq[j] = a.in[I_QG][layer * 64 + d0 + j] * (0.125f * 1.4426950408889634f); gk[j] = a.in[I_KG][layer * 64 + d0 + j]; }
    const bool second = (lane & 4) != 0;
    constexpr int TB = 4;
    for (int t0 = gw * TB; t0 < NT; t0 += NGW * TB) {
        u32x4 w[TB][2]; f32x4 cs[TB][4];
#pragma unroll
        for (int u = 0; u < TB; ++u) { const int t = t0 + u, pos = t & (SEQ - 1);
            w[u][0] = *(const u32x4*)(proj + (size_t)t * NIN + C_Q + lane * 8); w[u][1] = *(const u32x4*)(proj + (size_t)t * NIN + C_Q + 512 + lane * 8);
            cs[u][0] = *(const f32x4*)(ct + pos * 32 + p0); cs[u][1] = *(const f32x4*)(ct + pos * 32 + p0 + 4); cs[u][2] = *(const f32x4*)(st + pos * 32 + p0); cs[u][3] = *(const f32x4*)(st + pos * 32 + p0 + 4); }
#pragma unroll
        for (int u = 0; u < TB; ++u) { const int t = t0 + u;
            float c[8], s[8];
#pragma unroll
            for (int j = 0; j < 4; ++j) { c[j] = cs[u][0][j]; c[4 + j] = cs[u][1][j]; s[j] = cs[u][2][j]; s[4 + j] = cs[u][3][j]; }
#pragma unroll
            for (int i = 0; i < 2; ++i) {
                const u32x4 ww = w[u][i];
                float x[8]; x[0] = bflo(ww.x); x[1] = bfhi(ww.x); x[2] = bflo(ww.y); x[3] = bfhi(ww.y); x[4] = bflo(ww.z); x[5] = bfhi(ww.z); x[6] = bflo(ww.w); x[7] = bfhi(ww.w);
                float ss = 0.f;
#pragma unroll
                for (int j = 0; j < 8; ++j) ss += x[j] * x[j];
                ss += __shfl_xor(ss, 1); ss += __shfl_xor(ss, 2); ss += __shfl_xor(ss, 4);
                const float rs = __builtin_amdgcn_rsqf(ss * (1.0f / 64.0f) + EPS);
                float o[8];
#pragma unroll
                for (int j = 0; j < 8; ++j) { const float yv = x[j] * rs * (i == 0 ? gq[j] : gk[j]); const float pv = __shfl_xor(yv, 4);
                    o[j] = second ? (yv * c[j] + pv * s[j]) : (yv * c[j] - pv * s[j]); }
                u32x4 r; r.x = cvt_pk_bf16(o[0], o[1]); r.y = cvt_pk_bf16(o[2], o[3]); r.z = cvt_pk_bf16(o[4], o[5]); r.w = cvt_pk_bf16(o[6], o[7]);
                if (!dry || o[0] == 12345.678f) *(u32x4*)(proj + (size_t)t * NIN + C_Q + i * 512 + lane * 8) = r;
            } }
    }
}

__device__ __forceinline__ void phase_pool(ArgsRef a, LAS unsigned char* lds, int layer, int wv) {
    const int tid = tid_from(wv), lane = tid & 63, wave = __builtin_amdgcn_readfirstlane(tid >> 6);
    const bf16* proj = (const bf16*)(a.ws + WS_PROJ); bf16* mix = (bf16*)(a.ws + WS_MIX);
    const bf16* pw = (const bf16*)(a.ws + WS_SMALL) + SM_POOLW + (size_t)layer * 4 * 4096;
    const float* psc = a.in[I_POOLSC] + layer * 256;
    LAS float* U = (LAS float*)lds;
    LAS bf16* PA = (LAS bf16*)(lds + 81920);
    LAS float* SS = (LAS float*)(lds + 116736);
    constexpr int PAS = 264;
    for (int unit = blockIdx.x; unit < NT / 64; unit += gridDim.x) {
        const int t0 = unit * 64, s0 = t0 & (SEQ - 1);
        __syncthreads();
        for (int ch = tid; ch < 79 * 32; ch += NTHR) { const int r = ch >> 5, c8 = (ch & 31) * 8; const int srow = s0 - 15 + r;
            f32x4 lo = {0.f, 0.f, 0.f, 0.f}, hi = {0.f, 0.f, 0.f, 0.f};
            if (srow >= 0) { const u32x4 w = *(const u32x4*)(proj + (size_t)(t0 - 15 + r) * NIN + C_POOL + c8); lo = (f32x4){bflo(w.x), bfhi(w.x), bflo(w.y), bfhi(w.y)}; hi = (f32x4){bflo(w.z), bfhi(w.z), bflo(w.w), bfhi(w.w)}; }
            *(LAS f32x4*)(U + r * 256 + c8) = lo; *(LAS f32x4*)(U + r * 256 + c8 + 4) = hi; }
        __syncthreads();
        { const int c = tid & 255, tl0 = (tid >> 8) * 32, w = 2 << (c >> 6);
          float sum = 0.f;
          for (int j = 1; j < w; ++j) sum += U[(15 + tl0 - j) * 256 + c];
          for (int tl = tl0; tl < tl0 + 32; ++tl) { const float cur = U[(15 + tl) * 256 + c]; sum += cur;
              const int cnt = min(w, s0 + tl + 1); const float pooled = sum / (float)cnt - cur;
              PA[tl * PAS + c] = f2bf(pooled); sum -= U[(15 + tl - w + 1) * 256 + c]; } }
        __syncthreads();
        const int g = wave & 3, th = wave >> 2, lr = lane & 15, lq = lane >> 4;
        f32x4 acc[2][4];
#pragma unroll
        for (int rt = 0; rt < 2; ++rt)
#pragma unroll
            for (int et = 0; et < 4; ++et) acc[rt][et] = (f32x4){0.f, 0.f, 0.f, 0.f};
#pragma unroll
        for (int ks = 0; ks < 2; ++ks) { bf16x8 af[2], bfr[4];
#pragma unroll
            for (int rt = 0; rt < 2; ++rt) af[rt] = *(const LAS bf16x8*)(PA + (th * 32 + rt * 16 + lr) * PAS + g * 64 + ks * 32 + lq * 8);
#pragma unroll
            for (int et = 0; et < 4; ++et) bfr[et] = *(const bf16x8*)(pw + (size_t)g * 4096 + (et * 16 + lr) * 64 + ks * 32 + lq * 8);
#pragma unroll
            for (int rt = 0; rt < 2; ++rt)
#pragma unroll
                for (int et = 0; et < 4; ++et) acc[rt][et] = __builtin_amdgcn_mfma_f32_16x16x32_bf16(af[rt], bfr[et], acc[rt][et], 0, 0, 0); }
#pragma unroll
        for (int et = 0; et < 4; ++et) { const float sc = psc[g * 64 + et * 16 + lr];
#pragma unroll
            for (int rt = 0; rt < 2; ++rt) acc[rt][et] = acc[rt][et] * sc; }
#pragma unroll
        for (int rt = 0; rt < 2; ++rt)
#pragma unroll
            for (int reg = 0; reg < 4; ++reg) { float s = 0.f;
#pragma unroll
                for (int et = 0; et < 4; ++et) s += acc[rt][et][reg] * acc[rt][et][reg];
                s += __shfl_xor(s, 1); s += __shfl_xor(s, 2); s += __shfl_xor(s, 4); s += __shfl_xor(s, 8);
                if (lr == 0) SS[(th * 32 + rt * 16 + lq * 4 + reg) * 4 + g] = s; }
        __syncthreads();
#pragma unroll
        for (int rt = 0; rt < 2; ++rt)
#pragma unroll
            for (int reg = 0; reg < 4; ++reg) { const int tl = th * 32 + rt * 16 + lq * 4 + reg; const LAS float* sp = SS + tl * 4;
                const float rs = __builtin_amdgcn_rsqf(((sp[0] + sp[1]) + (sp[2] + sp[3])) * (1.0f / 256.0f) + EPS);
#pragma unroll
                for (int et = 0; et < 4; ++et) mix[(size_t)(t0 + tl) * DM + g * 64 + et * 16 + lr] = f2bf(acc[rt][et][reg] * rs); }
    }
}

__device__ __forceinline__ void phase_lru_a(ArgsRef a, LAS unsigned char* lds, int layer, int wv) {
    const int tid = tid_from(wv), lane = tid & 63, wave = __builtin_amdgcn_readfirstlane(tid >> 6);
    const bf16* proj = (const bf16*)(a.ws + WS_PROJ);
    const bf16* wa = (const bf16*)(a.ws + WS_SMALL) + SM_WA + (size_t)layer * 4 * 4096;
    const bf16* wx = (const bf16*)(a.ws + WS_SMALL) + SM_WX + (size_t)layer * 4 * 4096;
    bf16* HL = (bf16*)(a.ws + WS_HL); bf16* PL = (bf16*)(a.ws + WS_PL);
    float* AGGH = (float*)(a.ws + WS_AGGH); float* AGGP = (float*)(a.ws + WS_AGGP);
    LAS float* U = (LAS float*)lds;
    LAS bf16* XC = (LAS bf16*)(lds + 36864);
    LAS float* XF = (LAS float*)(lds + 54272);
    LAS float* AA = (LAS float*)(lds + 87040);
    constexpr int XS = 264;
    const int c = tid & 255;
    const float cw0 = a.in[I_CONVW][(layer * 4 + 0) * 256 + c], cw1 = a.in[I_CONVW][(layer * 4 + 1) * 256 + c], cw2 = a.in[I_CONVW][(layer * 4 + 2) * 256 + c], cw3 = a.in[I_CONVW][(layer * 4 + 3) * 256 + c];
    const float cb = a.in[I_CONVB][layer * 256 + c];
    for (int unit = blockIdx.x; unit < NT / LRU_CH; unit += gridDim.x) {
        const int t0 = unit * LRU_CH, s0 = t0 & (SEQ - 1);
        __syncthreads();
        for (int ch = tid; ch < 35 * 32; ch += NTHR) { const int r = ch >> 5, c8 = (ch & 31) * 8; const int srow = s0 - 3 + r;
            f32x4 lo = {0.f, 0.f, 0.f, 0.f}, hi = {0.f, 0.f, 0.f, 0.f};
            if (srow >= 0) { const u32x4 w = *(const u32x4*)(proj + (size_t)(t0 - 3 + r) * NIN + C_LRU + c8); lo = (f32x4){bflo(w.x), bfhi(w.x), bflo(w.y), bfhi(w.y)}; hi = (f32x4){bflo(w.z), bfhi(w.z), bflo(w.w), bfhi(w.w)}; }
            *(LAS f32x4*)(U + r * 256 + c8) = lo; *(LAS f32x4*)(U + r * 256 + c8 + 4) = hi; }
        __syncthreads();
        { const int tl0 = (tid >> 8) * 16;
          for (int tl = tl0; tl < tl0 + 16; ++tl) { const float xc = cb + cw0 * U[(tl + 0) * 256 + c] + cw1 * U[(tl + 1) * 256 + c] + cw2 * U[(tl + 2) * 256 + c] + cw3 * U[(tl + 3) * 256 + c];
              XF[tl * 256 + c] = xc; XC[tl * XS + c] = f2bf(xc); } }
        __syncthreads();
        { const int n = wave & 3, eh = wave >> 2, lr = lane & 15, lq = lane >> 4;
          f32x4 ca[2][2], cx[2][2];
#pragma unroll
          for (int rt = 0; rt < 2; ++rt)
#pragma unroll
              for (int et = 0; et < 2; ++et) { ca[rt][et] = (f32x4){0.f, 0.f, 0.f, 0.f}; cx[rt][et] = (f32x4){0.f, 0.f, 0.f, 0.f}; }
#pragma unroll
          for (int ks = 0; ks < 2; ++ks) { bf16x8 af[2], ba[2], bx[2];
#pragma unroll
              for (int rt = 0; rt < 2; ++rt) af[rt] = *(const LAS bf16x8*)(XC + (rt * 16 + lr) * XS + n * 64 + ks * 32 + lq * 8);
#pragma unroll
              for (int et = 0; et < 2; ++et) { const size_t wo = (size_t)n * 4096 + (eh * 32 + et * 16 + lr) * 64 + ks * 32 + lq * 8; ba[et] = *(const bf16x8*)(wa + wo); bx[et] = *(const bf16x8*)(wx + wo); }
#pragma unroll
              for (int rt = 0; rt < 2; ++rt)
#pragma unroll
                  for (int et = 0; et < 2; ++et) { ca[rt][et] = __builtin_amdgcn_mfma_f32_16x16x32_bf16(af[rt], ba[et], ca[rt][et], 0, 0, 0);
                                                   cx[rt][et] = __builtin_amdgcn_mfma_f32_16x16x32_bf16(af[rt], bx[et], cx[rt][et], 0, 0, 0); } }
#pragma unroll
          for (int et = 0; et < 2; ++et) { const int chn = n * 64 + eh * 32 + et * 16 + lr;
              const float bav = a.in[I_BA][layer * 256 + chn], bxv = a.in[I_BX][layer * 256 + chn], lam = a.in[I_LAM][layer * 256 + chn];
              const float sp = log1pf(expf(-lam));
#pragma unroll
              for (int rt = 0; rt < 2; ++rt)
#pragma unroll
                  for (int reg = 0; reg < 4; ++reg) { const int tl = rt * 16 + lq * 4 + reg;
                      const float r = fast_sigmoid(ca[rt][et][reg] + bav), ig = fast_sigmoid(cx[rt][et][reg] + bxv);
                      const float log_a = -8.0f * r * sp; const float av = fast_exp(log_a);
                      float mult = sqrtf(fmaxf(1.0f - fast_exp(2.0f * log_a), 0.f)); if (s0 + tl == 0) mult = 1.0f;
                      const float xc = XF[tl * 256 + chn];
                      AA[tl * 256 + chn] = av; XF[tl * 256 + chn] = mult * ig * xc; } } }
        __syncthreads();
        if (tid < 256) { float h = 0.f, P = 1.f;
            for (int tl = 0; tl < LRU_CH; ++tl) { const float av = AA[tl * 256 + c], bv = XF[tl * 256 + c]; h = av * h + bv; P *= av;
                HL[(size_t)(t0 + tl) * 256 + c] = f2bf(h); PL[(size_t)(t0 + tl) * 256 + c] = f2bf(P); }
            AGGH[(size_t)unit * 256 + c] = h; AGGP[(size_t)unit * 256 + c] = P; }
    }
}
__device__ __forceinline__ void phase_lru_b(ArgsRef a, int wv) {
    const float* AGGH = (const float*)(a.ws + WS_AGGH); const float* AGGP = (const float*)(a.ws + WS_AGGP); float* CARRY = (float*)(a.ws + WS_CARRY);
    const int tid_ = tid_from(wv);
    for (int idx = blockIdx.x * NTHR + tid_; idx < NB * 256; idx += gridDim.x * NTHR) { const int b = idx >> 8, c = idx & 255; float carry = 0.f;
        for (int k = 0; k < LRU_NCH; ++k) { const size_t o = (size_t)(b * LRU_NCH + k) * 256 + c; CARRY[o] = carry; carry = AGGP[o] * carry + AGGH[o]; } }
}
__device__ __forceinline__ void phase_lru_c(ArgsRef a, int wv) {
    const int tid = tid_from(wv), lane = tid & 63, wave = tid >> 6;
    const int gw = blockIdx.x * NWAVES + wave, NGW = gridDim.x * NWAVES;
    const bf16* proj = (const bf16*)(a.ws + WS_PROJ); bf16* mix = (bf16*)(a.ws + WS_MIX);
    const bf16* HL = (const bf16*)(a.ws + WS_HL); const bf16* PL = (const bf16*)(a.ws + WS_PL); const float* CARRY = (const float*)(a.ws + WS_CARRY);
    for (int t = gw; t < NT; t += NGW) {
        const u32x2 hw = *(const u32x2*)(HL + (size_t)t * 256 + lane * 4), pw = *(const u32x2*)(PL + (size_t)t * 256 + lane * 4), gwd = *(const u32x2*)(proj + (size_t)t * NIN + C_GATE + lane * 4);
        const f32x4 cr = *(const f32x4*)(CARRY + (size_t)(t / LRU_CH) * 256 + lane * 4);
        float h[4] = {bflo(hw.x) + bflo(pw.x) * cr[0], bfhi(hw.x) + bfhi(pw.x) * cr[1], bflo(hw.y) + bflo(pw.y) * cr[2], bfhi(hw.y) + bfhi(pw.y) * cr[3]};
        const float gt[4] = {bflo(gwd.x), bfhi(gwd.x), bflo(gwd.y), bfhi(gwd.y)};
        float s = 0.f;
#pragma unroll
        for (int j = 0; j < 4; ++j) { h[j] *= gelu_tanh(gt[j]); s += h[j] * h[j]; }
        s = wave_sum(s); const float rs = __builtin_amdgcn_rsqf(s * (1.0f / 256.0f) + EPS);
        u32x2 o; o.x = cvt_pk_bf16(h[0] * rs, h[1] * rs); o.y = cvt_pk_bf16(h[2] * rs, h[3] * rs);
        *(u32x2*)(mix + (size_t)t * DM + 256 + lane * 4) = o;
    }
}

typedef short v4i16_t __attribute__((ext_vector_type(4)));
struct AttnUnit { int h, n, r, dl; size_t rowb; int g; };
__device__ __forceinline__ AttnUnit attn_decode(int unit) {
    AttnUnit u; const int blk = unit & 31; u.g = (unit >> 5) % 3; u.h = (unit / 96) & 7; const int b = unit / 768;
    u.dl = (u.g == 0) ? 1 : (u.g == 1 ? 4 : 16); const int nb = 32 / u.dl; u.n = blk % nb; u.r = blk / nb; u.rowb = (size_t)b * SEQ; return u;
}
__device__ __forceinline__ void attn_dma(const __amdgpu_buffer_rsrc_t rs, LAS unsigned char* lds, const AttnUnit& u, int buf, int wave, int lane) {
    const int kr0 = 8 * wave + (lane >> 3), cs = ((lane & 7) ^ ((lane >> 3) & 7)) * 16;
#pragma unroll
    for (int q = 0; q < 4; ++q) { const int keyrow = kr0 + 64 * q; int l = 128 * (u.n - 1) + keyrow; l = l < 0 ? 0 : l;
        const unsigned src = (unsigned)(((u.rowb + (size_t)l * u.dl + u.r) * NIN + C_K + u.h * 64) * 2 + cs);
        LAS unsigned char* dst = lds + buf * 65536 + (wave + 8 * q) * 1024;
        __builtin_amdgcn_raw_ptr_buffer_load_lds(rs, (LAS void*)dst, 16, src, 0, 0, 0);
        __builtin_amdgcn_raw_ptr_buffer_load_lds(rs, (LAS void*)(dst + 32768), 16, src + (unsigned)((C_V - C_K) * 2), 0, 0, 0); }
}
__device__ __forceinline__ void phase_attn(ArgsRef a, LAS unsigned char* lds, int wv) {
    const int tid = tid_from(wv), lane = tid & 63, wave = __builtin_amdgcn_readfirstlane(tid >> 6);
    const bf16* proj = (const bf16*)(a.ws + WS_PROJ);
    bf16* PNUM = (bf16*)(a.ws + WS_PNUM); float* PDEN = (float*)(a.ws + WS_PDEN); float* PMAX = (float*)(a.ws + WS_PMAX);
    const __amdgpu_buffer_rsrc_t rs = __builtin_amdgcn_make_buffer_rsrc((void*)proj, 0, 0x7fffffff, 0x00020000);
    const int lr = lane & 15, lq = lane >> 4, qi0 = 16 * wave, G = gridDim.x;
    constexpr int NUNITS = NB * 8 * 3 * 32;
    const int kro = (qi0 + lr) * 128, kc0 = ((0 + lq) ^ (lr & 7)) * 16, kc1 = ((4 + lq) ^ (lr & 7)) * 16;
    const int q4 = (lane & 15) >> 2, p4 = lane & 3, vrow = qi0 + 4 * lq + q4, vsw = (4 * lq + q4) & 7;
    __syncthreads();
    const bool xo = (G == 256); const int xcd = blockIdx.x & 7, jx = blockIdx.x >> 3;
#define ATT_UNIT(i) (xo ? ((xcd * 16 + (i) / 3) * 96 + ((i) % 3) * 32 + jx) : ((int)blockIdx.x + (i) * G))
    int it = 0; int unit = ATT_UNIT(0);
    AttnUnit cu = attn_decode(unit < NUNITS ? unit : 0);
    bf16x8 qf0, qf1;
    if (unit < NUNITS) { attn_dma(rs, lds, cu, 0, wave, lane);
        const size_t qrow = cu.rowb + (size_t)(128 * cu.n + qi0 + lr) * cu.dl + cu.r;
        qf0 = *(const bf16x8*)(proj + qrow * NIN + C_Q + cu.h * 64 + lq * 8); qf1 = *(const bf16x8*)(proj + qrow * NIN + C_Q + cu.h * 64 + 32 + lq * 8); }
    int buf = 0;
    asm volatile("s_waitcnt vmcnt(0)" ::: "memory");
    while (unit < NUNITS) {
        asm volatile("s_waitcnt vmcnt(4)" ::: "memory"); __builtin_amdgcn_s_barrier(); asm volatile("" ::: "memory");
        ++it; const int nunit = (xo && it >= 48) ? NUNITS : ATT_UNIT(it); AttnUnit nu = attn_decode(nunit < NUNITS ? nunit : 0); bf16x8 nq0 = qf0, nq1 = qf1;
        if (nunit < NUNITS) { attn_dma(rs, lds, nu, buf ^ 1, wave, lane);
            const size_t qrow = nu.rowb + (size_t)(128 * nu.n + qi0 + lr) * nu.dl + nu.r;
            nq0 = *(const bf16x8*)(proj + qrow * NIN + C_Q + nu.h * 64 + lq * 8); nq1 = *(const bf16x8*)(proj + qrow * NIN + C_Q + nu.h * 64 + 32 + lq * 8); }
        const LAS unsigned char* Kb = lds + buf * 65536; const LAS unsigned char* Vb = Kb + 32768;
        f32x4 sc[9];
#pragma unroll
        for (int t = 0; t < 9; ++t) { const bf16x8 k0 = *(const LAS bf16x8*)(Kb + kro + t * 2048 + kc0), k1 = *(const LAS bf16x8*)(Kb + kro + t * 2048 + kc1);
            sc[t] = __builtin_amdgcn_mfma_f32_16x16x32_bf16(k0, qf0, (f32x4){0.f, 0.f, 0.f, 0.f}, 0, 0, 0);
            sc[t] = __builtin_amdgcn_mfma_f32_16x16x32_bf16(k1, qf1, sc[t], 0, 0, 0); }
#pragma unroll
        for (int reg = 0; reg < 4; ++reg) { if (4 * lq + reg < lr) sc[0][reg] = -1e30f; if (4 * lq + reg > lr) sc[8][reg] = -1e30f; }
        if (cu.n == 0) {
#pragma unroll
            for (int t = 0; t < 8; ++t)
#pragma unroll
                for (int reg = 0; reg < 4; ++reg) { if (qi0 + 16 * t + 4 * lq + reg < 128) sc[t][reg] = -1e30f; } }
        float mx = -1e30f;
#pragma unroll
        for (int t = 0; t < 9; ++t)
#pragma unroll
            for (int reg = 0; reg < 4; ++reg) mx = fmaxf(mx, sc[t][reg]);
        mx = fmaxf(mx, __shfl_xor(mx, 16)); mx = fmaxf(mx, __shfl_xor(mx, 32));
        float sm = 0.f;
#pragma unroll
        for (int t = 0; t < 9; ++t)
#pragma unroll
            for (int reg = 0; reg < 4; ++reg) { const float pe = __builtin_amdgcn_exp2f(sc[t][reg] - mx); sm += pe; sc[t][reg] = pe; }
        sm += __shfl_xor(sm, 16); sm += __shfl_xor(sm, 32);
        f32x4 oc[4];
#pragma unroll
        for (int dt = 0; dt < 4; ++dt) oc[dt] = (f32x4){0.f, 0.f, 0.f, 0.f};
#pragma unroll
        for (int pi = 0; pi < 5; ++pi) { const int t0 = 2 * pi, t1 = (2 * pi + 1 < 9) ? 2 * pi + 1 : 8;
            u32x4 pw; pw.x = cvt_pk_bf16(sc[t0][0], sc[t0][1]); pw.y = cvt_pk_bf16(sc[t0][2], sc[t0][3]);
            if (2 * pi + 1 < 9) { pw.z = cvt_pk_bf16(sc[t1][0], sc[t1][1]); pw.w = cvt_pk_bf16(sc[t1][2], sc[t1][3]); } else { pw.z = 0u; pw.w = 0u; }
            const bf16x8 pf = __builtin_bit_cast(bf16x8, pw);
#pragma unroll
            for (int dt = 0; dt < 4; ++dt) { const int ch = ((2 * dt + (p4 >> 1)) ^ vsw) * 16 + (p4 & 1) * 8;
                const v4i16_t v0 = __builtin_amdgcn_ds_read_tr16_b64_v4i16((LAS v4i16_t*)(Vb + (vrow + 16 * t0) * 128 + ch));
                const v4i16_t v1 = __builtin_amdgcn_ds_read_tr16_b64_v4i16((LAS v4i16_t*)(Vb + (vrow + 16 * t1) * 128 + ch));
                const bf16x8 vf = (bf16x8){v0[0], v0[1], v0[2], v0[3], v1[0], v1[1], v1[2], v1[3]};
                oc[dt] = __builtin_amdgcn_mfma_f32_16x16x32_bf16(pf, vf, oc[dt], 0, 0, 0); } }
        { LAS bf16* stg = (LAS bf16*)(lds + OST_OFF + wave * 2048);
#pragma unroll
          for (int reg = 0; reg < 4; ++reg)
#pragma unroll
              for (int dt = 0; dt < 4; ++dt) stg[(4 * lq + reg) * 64 + dt * 16 + lr] = f2bf(oc[dt][reg]);
          LDS_WAIT(); asm volatile("" ::: "memory");
#pragma unroll
          for (int i = 0; i < 2; ++i) { const int qq = i * 8 + (lane >> 3), c8 = (lane & 7) * 8; const u32x4 w = *(const LAS u32x4*)(stg + qq * 64 + c8);
              const size_t tok = cu.rowb + (size_t)(128 * cu.n + qi0 + qq) * cu.dl + cu.r;
              *(u32x4*)(PNUM + ((size_t)cu.g * NT + tok) * 512 + cu.h * 64 + c8) = w; }
          LDS_WAIT(); asm volatile("" ::: "memory"); }
        if (lq == 0) { const size_t tok = cu.rowb + (size_t)(128 * cu.n + qi0 + lr) * cu.dl + cu.r; PDEN[((size_t)cu.g * NT + tok) * 8 + cu.h] = sm; PMAX[((size_t)cu.g * NT + tok) * 8 + cu.h] = mx; }
        cu = nu; qf0 = nq0; qf1 = nq1; buf ^= 1; unit = nunit;
    }
#undef ATT_UNIT
}
__device__ __forceinline__ void phase_merge(ArgsRef a, int wv) {
    const int tid = tid_from(wv), lane = tid & 63, wave = tid >> 6;
    const int gw = blockIdx.x * NWAVES + wave, NGW = gridDim.x * NWAVES;
    const bf16* PNUM = (const bf16*)(a.ws + WS_PNUM); const float* PDEN = (const float*)(a.ws + WS_PDEN); const float* PMAX = (const float*)(a.ws + WS_PMAX);
    bf16* mix = (bf16*)(a.ws + WS_MIX);
    const int hd = lane >> 3;
    for (int t = gw; t < NT; t += NGW) {
        float m[3], dn[3]; u32x4 nw[3];
#pragma unroll
        for (int g = 0; g < 3; ++g) { m[g] = PMAX[((size_t)g * NT + t) * 8 + hd]; dn[g] = PDEN[((size_t)g * NT + t) * 8 + hd]; nw[g] = *(const u32x4*)(PNUM + ((size_t)g * NT + t) * 512 + lane * 8); }
        const float mr = fmaxf(fmaxf(m[0], m[1]), m[2]);
        float o[8] = {0.f, 0.f, 0.f, 0.f, 0.f, 0.f, 0.f, 0.f}; float den = 0.f;
#pragma unroll
        for (int g = 0; g < 3; ++g) { const float w = __builtin_amdgcn_exp2f(m[g] - mr); den += w * dn[g];
            o[0] += w * bflo(nw[g].x); o[1] += w * bfhi(nw[g].x); o[2] += w * bflo(nw[g].y); o[3] += w * bfhi(nw[g].y); o[4] += w * bflo(nw[g].z); o[5] += w * bfhi(nw[g].z); o[6] += w * bflo(nw[g].w); o[7] += w * bfhi(nw[g].w); }
        const float inv = 1.0f / den; float s = 0.f;
#pragma unroll
        for (int j = 0; j < 8; ++j) { o[j] *= inv; s += o[j] * o[j]; }
        s = wave_sum(s); const float rs = __builtin_amdgcn_rsqf(s * (1.0f / 512.0f) + EPS);
        u32x4 w; w.x = cvt_pk_bf16(o[0] * rs, o[1] * rs); w.y = cvt_pk_bf16(o[2] * rs, o[3] * rs); w.z = cvt_pk_bf16(o[4] * rs, o[5] * rs); w.w = cvt_pk_bf16(o[6] * rs, o[7] * rs);
        *(u32x4*)(mix + (size_t)t * DM + 512 + lane * 8) = w;
    }
}

__device__ __forceinline__ void phase_router(ArgsRef a, LAS unsigned char* lds, int layer, int wv, bool alloc) {
    const int tid = tid_from(wv), lane = tid & 63, wave = __builtin_amdgcn_readfirstlane(tid >> 6);
    const bf16* xb = (const bf16*)(a.ws + WS_XB); const bf16* wr = (const bf16*)(a.ws + WS_SMALL) + SM_WR + (size_t)layer * NEXP * DM;
    const float* ssqp = (const float*)(a.ws + WS_SSQP); const float* rbias = a.in[I_BR] + layer * NEXP;
    int* LIST = (int*)(a.ws + WS_LIST); float* LRSTD = (float*)(a.ws + WS_LRSTD); float* LGATE = (float*)(a.ws + WS_LGATE2);
    unsigned* cnt = (unsigned*)(a.ws + WS_CTL) + CW_CNT + layer * NEXP;
    LAS float* LG = (LAS float*)lds + wave * 32 * 33;
    LAS int* hist = (LAS int*)(lds + 65536);
    LAS int* base = (LAS int*)(lds + 65536 + 128);
    const int lr = lane & 15, lq = lane >> 4;
    for (int unit = blockIdx.x; unit < NT / 256; unit += gridDim.x) {
        const int tok0 = unit * 256 + wave * 32;
        __syncthreads();
        if (tid < 32) hist[tid] = 0;
        f32x4 acc[2][2];
#pragma unroll
        for (int rt = 0; rt < 2; ++rt)
#pragma unroll
            for (int et = 0; et < 2; ++et) acc[rt][et] = (f32x4){0.f, 0.f, 0.f, 0.f};
#pragma unroll 4
        for (int ks = 0; ks < 32; ++ks) { bf16x8 af[2], bfr[2];
#pragma unroll
            for (int rt = 0; rt < 2; ++rt) af[rt] = *(const bf16x8*)(xb + (size_t)(tok0 + rt * 16 + lr) * DM + ks * 32 + lq * 8);
#pragma unroll
            for (int et = 0; et < 2; ++et) bfr[et] = *(const bf16x8*)(wr + (size_t)(et * 16 + lr) * DM + ks * 32 + lq * 8);
#pragma unroll
            for (int rt = 0; rt < 2; ++rt)
#pragma unroll
                for (int et = 0; et < 2; ++et) acc[rt][et] = __builtin_amdgcn_mfma_f32_16x16x32_bf16(af[rt], bfr[et], acc[rt][et], 0, 0, 0); }
#pragma unroll
        for (int rt = 0; rt < 2; ++rt)
#pragma unroll
            for (int et = 0; et < 2; ++et)
#pragma unroll
                for (int reg = 0; reg < 4; ++reg) LG[(rt * 16 + lq * 4 + reg) * 33 + et * 16 + lr] = acc[rt][et][reg];
        __syncthreads();
        int te[4] = {0, 0, 0, 0}; float tg[4] = {0.f, 0.f, 0.f, 0.f}; int rk[4] = {0, 0, 0, 0}; float rstd = 0.f; const int tok = tok0 + lane;
        if (lane < 32) {
            const float* sp = ssqp + (size_t)tok * 16; float ss = 0.f;
#pragma unroll
            for (int j = 0; j < 16; ++j) ss += sp[j];
            rstd = __builtin_amdgcn_rsqf(ss * (1.0f / DM) + EPS);
            float tv[4] = {-3e38f, -3e38f, -3e38f, -3e38f};
            for (int e = 0; e < NEXP; ++e) { float v = LG[lane * 33 + e] * rstd + rbias[e]; int ve = e;
#pragma unroll
                for (int k = 0; k < 4; ++k) { if (v > tv[k]) { const float tvv = tv[k]; const int tee = te[k]; tv[k] = v; te[k] = ve; v = tvv; ve = tee; } } }
            float z = 0.f;
#pragma unroll
            for (int k = 0; k < 4; ++k) { tg[k] = fast_exp(tv[k] - tv[0]); z += tg[k]; }
            const float iz = 1.0f / z;
#pragma unroll
            for (int k = 0; k < 4; ++k) { tg[k] *= iz; rk[k] = __hip_atomic_fetch_add(&hist[te[k]], 1, __ATOMIC_RELAXED, __HIP_MEMORY_SCOPE_WORKGROUP); }
        }
        __syncthreads();
        if (tid < 32) base[tid] = alloc ? (int)__hip_atomic_fetch_add(cnt + tid, (unsigned)hist[tid], RLX_AGENT) : 0;
        __syncthreads();
        if (lane < 32 && alloc) {
#pragma unroll
            for (int k = 0; k < 4; ++k) { const size_t p = (size_t)te[k] * NT + base[te[k]] + rk[k]; LIST[p] = tok * 4 + k; LRSTD[p] = rstd; LGATE[p] = tg[k]; }
        }
    }
}

__device__ __forceinline__ void phase_combine(ArgsRef a, bool last_layer, int wv, bool dry) {
    const int tid = tid_from(wv), lane = tid & 63, wave = tid >> 6;
    const int gw = blockIdx.x * NWAVES + wave, NGW = gridDim.x * NWAVES;
    const bf16* __restrict__ Y = (const bf16*)(a.ws + WS_Y); float* __restrict__ out = a.out; bf16* xb = (bf16*)(a.ws + WS_XB); float* __restrict__ ssq = (float*)(a.ws + WS_SSQ);
    for (int t = gw; t < NT; t += NGW) {
        u32x2 xv[4]; u32x2 y[4][4];
#pragma unroll
        for (int j = 0; j < 4; ++j) { xv[j] = *((const u32x2*)(xb + (size_t)t * DM) + lane + 64 * j);
#pragma unroll
            for (int k = 0; k < 4; ++k) y[k][j] = *((const u32x2*)(Y + ((size_t)t * 4 + k) * DM) + lane + 64 * j); }
        f32x4 v[4]; float s = 0.f;
#pragma unroll
        for (int j = 0; j < 4; ++j) { v[j] = (f32x4){bflo(xv[j].x), bfhi(xv[j].x), bflo(xv[j].y), bfhi(xv[j].y)};
#pragma unroll
            for (int k = 0; k < 4; ++k) { v[j].x += bflo(y[k][j].x); v[j].y += bfhi(y[k][j].x); v[j].z += bflo(y[k][j].y); v[j].w += bfhi(y[k][j].y); }
            s += (v[j].x * v[j].x + v[j].y * v[j].y) + (v[j].z * v[j].z + v[j].w * v[j].w); }
        if (dry && s != 12345.678f) continue;
        if (last_layer) {
#pragma unroll
            for (int j = 0; j < 4; ++j) *((f32x4*)(out + (size_t)t * DM) + lane + 64 * j) = v[j];
        } else { s = wave_sum(s);
#pragma unroll
            for (int j = 0; j < 4; ++j) { u32x2 w; w.x = cvt_pk_bf16(v[j].x, v[j].y); w.y = cvt_pk_bf16(v[j].z, v[j].w); *((u32x2*)(xb + (size_t)t * DM) + lane + 64 * j) = w; }
            if (lane == 0) ssq[t] = s; }
    }
}

constexpr int NPH_LAYER = 13, NPH = 1 + 2 * NPH_LAYER;
enum { PH_GEMM_IN = 0, PH_QKPREP, PH_POOL, PH_LRU_A, PH_LRU_B, PH_ATTN, PH_LRU_C, PH_MERGE, PH_GEMM_OUT, PH_ROUTER, PH_MOE_GU, PH_MOE_DOWN, PH_COMBINE };
#ifndef MK_STOP
#define MK_STOP NPH
#endif
#ifndef MK_SPLIT
#define MK_SPLIT 0
#endif

template <int PHMASK>
__global__ void __launch_bounds__(NTHR, 2) mega_fwd(Args args_by_value) {
    extern __shared__ __attribute__((aligned(16))) unsigned char lds_raw[];
    LAS unsigned char* lds = (LAS unsigned char*)lds_raw;
    const int tid = threadIdx.x;
    int wv = __builtin_amdgcn_readfirstlane(tid >> 6); asm volatile("" : "+s"(wv));
    for (int u = tid; u < (LDS_BYTES - LDSCTL_OFF) / 4; u += NTHR) ((LAS unsigned*)(lds + LDSCTL_OFF))[u] = 0u;
    __syncthreads();
#define ARGS_HERE() const CAS Args* ap_ = (const CAS Args*)__builtin_amdgcn_kernarg_segment_ptr(); asm volatile("" : "+s"(ap_)); ArgsRef args = *ap_; unsigned char* const ws = args.ws; unsigned* const ctl = (unsigned*)(ws + WS_CTL); (void)ctl
    int lo, hi;
    { ARGS_HERE(); lo = args.ph_lo; hi = args.ph_hi; xcd_barrier_post(ctl + CW_BAR + args.li * XCD_BAR_WORDS, (volatile LAS unsigned*)(lds + MISC_OFF) + 8); }
#define EN(p) (((PHMASK) >> (p)) & 1)
#ifndef MK_DUP
#define MK_DUP 0
#endif
#define NREP(p) ((((MK_DUP) >> (p)) & 1) ? 2 : 1)
#define IN(k) (lo <= (k) && (k) < hi)
#define SEAM(k) do { if (IN(k) && IN((k) + 1)) { ARGS_HERE(); XcdBarrier bar_; bar_.bar = ctl + CW_BAR + args.li * XCD_BAR_WORDS; bar_.x = xb_xcc_id(); bar_.st = (volatile LAS unsigned*)(lds + MISC_OFF) + 8; xcd_barrier(bar_); } } while (0)

    if (EN(13) && IN(0)) { ARGS_HERE(); for (int rep_ = 0; rep_ < NREP(13); ++rep_) { phase_prologue(args, lds, wv); } }
    SEAM(0);
    for (int l = 0; l < 2; ++l) {
        const int pb = 1 + NPH_LAYER * l;
        if (EN(PH_GEMM_IN) && IN(pb + PH_GEMM_IN)) { ARGS_HERE();
            pg8::StaticOrder S; S.init(NT, NIN, DM, gridDim.x, blockIdx.x); S.dup = NREP(PH_GEMM_IN) - 1;
            EpiIn E{(bf16*)(ws + WS_PROJ), (const float*)(ws + WS_SSQ)};
            pg8::gemm_phase<EpiIn, pg8::StaticOrder, true>(lds, (const bf16*)(ws + WS_XB), (const bf16*)(ws + WS_WIN) + (size_t)l * NIN * DM, DM, S, E, wv);
        }
        SEAM(pb + PH_GEMM_IN);
        if (EN(PH_QKPREP) && IN(pb + PH_QKPREP)) { ARGS_HERE(); for (int rep_ = 0; rep_ < NREP(PH_QKPREP); ++rep_) { phase_qkprep(args, l, wv, rep_ < NREP(PH_QKPREP) - 1); } }
        if (EN(PH_POOL) && IN(pb + PH_POOL)) { ARGS_HERE(); for (int rep_ = 0; rep_ < NREP(PH_POOL); ++rep_) { phase_pool(args, lds, l, wv); } }
        if (EN(PH_LRU_A) && IN(pb + PH_LRU_A)) { ARGS_HERE(); for (int rep_ = 0; rep_ < NREP(PH_LRU_A); ++rep_) { phase_lru_a(args, lds, l, wv); } }
        SEAM(pb + PH_LRU_A);
        if (EN(PH_LRU_B) && IN(pb + PH_LRU_B)) { ARGS_HERE(); for (int rep_ = 0; rep_ < NREP(PH_LRU_B); ++rep_) { phase_lru_b(args, wv); } }
        if (EN(PH_ATTN) && IN(pb + PH_ATTN)) { ARGS_HERE(); for (int rep_ = 0; rep_ < NREP(PH_ATTN); ++rep_) { phase_attn(args, lds, wv); } }
        SEAM(pb + PH_ATTN);
        if (EN(PH_LRU_C) && IN(pb + PH_LRU_C)) { ARGS_HERE(); for (int rep_ = 0; rep_ < NREP(PH_LRU_C); ++rep_) { phase_lru_c(args, wv); } }
        if (EN(PH_MERGE) && IN(pb + PH_MERGE)) { ARGS_HERE(); for (int rep_ = 0; rep_ < NREP(PH_MERGE); ++rep_) { phase_merge(args, wv); } }
        SEAM(pb + PH_MERGE);
        if (EN(PH_GEMM_OUT) && IN(pb + PH_GEMM_OUT)) { ARGS_HERE();
            __syncthreads();
            pg8::StaticOrder S; S.init(NT, DM, DM, gridDim.x, blockIdx.x); S.dup = (l == 0) ? NREP(PH_GEMM_OUT) - 1 : 0;
            EpiOut E{(bf16*)(ws + WS_XB), (float*)(ws + WS_SSQP)};
            pg8::gemm_phase<EpiOut, pg8::StaticOrder, true>(lds, (const bf16*)(ws + WS_MIX), (const bf16*)(ws + WS_WOUT) + (size_t)l * DM * DM, DM, S, E, wv);
        }
        SEAM(pb + PH_GEMM_OUT);
        if (EN(PH_ROUTER) && IN(pb + PH_ROUTER)) { ARGS_HERE(); for (int rep_ = 0; rep_ < NREP(PH_ROUTER); ++rep_) { phase_router(args, lds, l, wv, rep_ == NREP(PH_ROUTER) - 1); } }
        SEAM(pb + PH_ROUTER);
        if (EN(PH_MOE_GU) && IN(pb + PH_MOE_GU)) { ARGS_HERE();
            LAS int* tab = (LAS int*)(lds + TAB_OFF);
            moe_tables(tab, ctl + CW_CNT + l * NEXP, wv);
            MoeOrder<0> S{tab, 2, (int)gridDim.x, (int)blockIdx.x, (const int*)(ws + WS_LIST), NREP(PH_MOE_GU) - 1};
            EpiGU E{(bf16*)(ws + WS_ACT), (const float*)(ws + WS_LRSTD), args.in[I_BGU] + (size_t)l * NEXP * 512};
            pg8::gemm_phase<EpiGU, MoeOrder<0>, true>(lds, (const bf16*)(ws + WS_XB), (const bf16*)(ws + WS_WGU) + (size_t)l * NEXP * 512 * DM, DM, S, E, wv);
        }
        SEAM(pb + PH_MOE_GU);
        if (EN(PH_MOE_DOWN) && IN(pb + PH_MOE_DOWN)) { ARGS_HERE();
            LAS int* tab = (LAS int*)(lds + TAB_OFF);
            moe_tables(tab, ctl + CW_CNT + l * NEXP, wv);
            MoeOrder<1> S{tab, 4, (int)gridDim.x, (int)blockIdx.x, (const int*)(ws + WS_LIST), NREP(PH_MOE_DOWN) - 1};
            EpiDown E{(bf16*)(ws + WS_Y), (const int*)(ws + WS_LIST), (const float*)(ws + WS_LGATE2), args.in[I_BD] + (size_t)l * NEXP * DM, tab};
            pg8::gemm_phase<EpiDown, MoeOrder<1>, true>(lds, (const bf16*)(ws + WS_ACT), (const bf16*)(ws + WS_WD) + (size_t)l * NEXP * DM * EFF, EFF, S, E, wv);
        }
        SEAM(pb + PH_MOE_DOWN);
        if (EN(PH_COMBINE) && IN(pb + PH_COMBINE)) { ARGS_HERE(); for (int rep_ = 0; rep_ < NREP(PH_COMBINE); ++rep_) { phase_combine(args, l == 1, wv, rep_ < NREP(PH_COMBINE) - 1); } }
        SEAM(pb + PH_COMBINE);
    }
#undef IN
#undef SEAM
}

typedef void (*kern_t)(Args);
template <int M> static kern_t kern_of() { return (kern_t)mega_fwd<M>; }
static kern_t phase_kernel(int p) {
    switch (p) { case 0: return kern_of<1 << 0>(); case 1: return kern_of<1 << 1>(); case 2: return kern_of<1 << 2>(); case 3: return kern_of<1 << 3>(); case 4: return kern_of<1 << 4>();
                 case 5: return kern_of<1 << 5>(); case 6: return kern_of<1 << 6>(); case 7: return kern_of<1 << 7>(); case 8: return kern_of<1 << 8>(); case 9: return kern_of<1 << 9>();
                 case 10: return kern_of<1 << 10>(); case 11: return kern_of<1 << 11>(); case 12: return kern_of<1 << 12>(); default: return kern_of<1 << 13>(); }
}
extern "C" void kernel_launch(void* const* d_in, const int* in_sizes, int n_in, void* d_out, int out_size, void* d_ws, size_t ws_size, hipStream_t stream) {
    static int grid = 0;
    if (grid == 0) {
        if (n_in != 23 || in_sizes[0] != NT * DM || out_size != NT * DM || ws_size < WS_END) {
            fprintf(stderr, "kernel_launch: built for 23 inputs, x/out of %d floats, >= %zu bytes of workspace; got n_in %d, in0 %d, out %d, ws %zu; nothing launched\n", NT * DM, (size_t)WS_END, n_in, n_in > 0 ? in_sizes[0] : -1, out_size, ws_size);
            grid = -1; return; }
        int dev = 0, cus = 0;
        if (hipGetDevice(&dev) != hipSuccess || hipDeviceGetAttribute(&cus, hipDeviceAttributeMultiprocessorCount, dev) != hipSuccess) { fprintf(stderr, "kernel_launch: device query failed\n"); grid = -1; return; }
#if MK_SPLIT
        for (int p = 0; p < 14; ++p) if (hipFuncSetAttribute((const void*)phase_kernel(p), hipFuncAttributeMaxDynamicSharedMemorySize, LDS_BYTES) != hipSuccess) { fprintf(stderr, "kernel_launch: hipFuncSetAttribute failed\n"); grid = -1; return; }
#else
        if (hipFuncSetAttribute((const void*)kern_of<0x3fff>(), hipFuncAttributeMaxDynamicSharedMemorySize, LDS_BYTES) != hipSuccess) { fprintf(stderr, "kernel_launch: hipFuncSetAttribute failed\n"); grid = -1; return; }
        int per_cu = 0;
        if (hipOccupancyMaxActiveBlocksPerMultiprocessor(&per_cu, (const void*)kern_of<0x3fff>(), NTHR, LDS_BYTES) != hipSuccess || per_cu < 1)
            fprintf(stderr, "kernel_launch: note: occupancy query reports %d workgroups per CU\n", per_cu);
#endif
        (void)hipGetLastError();
        grid = cus;
    }
    if (grid < 0) return;
    if (hipMemsetAsync((char*)d_ws + WS_CTL, 0, CTL_ZERO_BYTES, stream) != hipSuccess) { fprintf(stderr, "kernel_launch: hipMemsetAsync failed\n"); return; }
    Args a{};
    for (int i = 0; i < 23; ++i) a.in[i] = (const float*)d_in[i];
    a.out = (float*)d_out; a.ws = (unsigned char*)d_ws; a.pad = 0;
#if MK_SPLIT
#ifdef MK_SKIP
    (void)hipMemsetAsync((char*)d_ws + WS_MIX, 0, (size_t)NT * DM * 2, stream);
#endif
    for (int p = 0; p < MK_STOP; ++p) { a.ph_lo = p; a.ph_hi = p + 1; a.li = p;
#ifdef MK_SKIP
        if (p >= 1 && (((MK_SKIP) >> ((p - 1) % NPH_LAYER)) & 1)) continue;
#endif
        hipLaunchKernelGGL(phase_kernel(p == 0 ? 13 : (p - 1) % NPH_LAYER), dim3(grid), dim3(NTHR), LDS_BYTES, stream, a); }
#else
    a.ph_lo = 0; a.ph_hi = NPH; a.li = 0;
    hipLaunchKernelGGL(kern_of<0x3fff>(), dim3(grid), dim3(NTHR), LDS_BYTES, stream, a);
#endif
    const hipError_t le = hipPeekAtLastError();
    if (le != hipSuccess) fprintf(stderr, "kernel_launch: launch failed: %s\n", hipGetErrorName(le));
}
```

```cpp
#include <hip/hip_runtime.h>
#include <cstdio>
#include <cstdint>

#define LAS __attribute__((address_space(3)))
#define GAS __attribute__((address_space(1)))
typedef unsigned short bf16;
typedef short bf16x8 __attribute__((ext_vector_type(8)));
typedef float f32x4 __attribute__((ext_vector_type(4)));
typedef float f32x2 __attribute__((ext_vector_type(2)));
typedef unsigned u32x4 __attribute__((ext_vector_type(4)));
typedef unsigned u32x2 __attribute__((ext_vector_type(2)));

#ifndef MK_VAR
#define MK_VAR 0
#endif
constexpr int NB = 16, SEQ = 4096, DM = 1024, NT = NB * SEQ;
constexpr int NIN = 2304;
constexpr int C_POOL = 0, C_LRU = 256, C_GATE = 512, C_Q = 768, C_K = 1280, C_V = 1792;
constexpr int NEXP = 32, TOPK = 4, EFF = 256;
constexpr int NASSIGN = NT * TOPK;
constexpr int ACT_ROWS = NASSIGN + NEXP * 256;
constexpr float EPS = 1e-6f;
constexpr int NWAVES = 8, NTHR = 512;
constexpr int LRU_CH = 32, LRU_NCH = SEQ / LRU_CH;

constexpr size_t MiB = 1u << 20;
constexpr size_t WS_CTL = 0, CTL_ZERO_BYTES = 1 * MiB;
constexpr size_t WS_ROPE = 1 * MiB;
constexpr size_t WS_SMALL = 2 * MiB;
constexpr size_t WS_WIN = 4 * MiB;
constexpr size_t WS_WOUT = 13 * MiB;
constexpr size_t WS_WGU = 17 * MiB;
constexpr size_t WS_WD = 81 * MiB;
constexpr size_t WS_SSQ = 113 * MiB;
constexpr size_t WS_SSQP = 114 * MiB;
constexpr size_t WS_LIST = 118 * MiB;
constexpr size_t WS_XB = 128 * MiB;
constexpr size_t WS_R = 256 * MiB;
constexpr size_t WS_PROJ = WS_R;
constexpr size_t WS_MIX = WS_R + 288 * MiB;
constexpr size_t WS_PNUM = WS_R + 416 * MiB;
constexpr size_t WS_PDEN = WS_R + 608 * MiB;
constexpr size_t WS_PMAX = WS_R + 614 * MiB;
constexpr size_t WS_HL = WS_R + 620 * MiB;
constexpr size_t WS_PL = WS_R + 652 * MiB;
constexpr size_t WS_AGGH = WS_R + 684 * MiB;
constexpr size_t WS_AGGP = WS_R + 686 * MiB;
constexpr size_t WS_CARRY = WS_R + 688 * MiB;
constexpr size_t WS_ACT = WS_R;
constexpr size_t WS_Y = WS_R + 132 * MiB;
constexpr size_t WS_LRSTD = WS_R + 644 * MiB;
constexpr size_t WS_LGATE2 = WS_R + 652 * MiB;
constexpr size_t WS_END = 1024 * MiB;
static_assert(WS_CARRY + 2 * MiB <= WS_END && WS_LGATE2 + 8 * MiB <= WS_END, "d_ws map");
constexpr size_t SM_POOLW = 0;
constexpr size_t SM_WA = 32768;
constexpr size_t SM_WX = 65536;
constexpr size_t SM_WR = 98304;
constexpr int CW_BAR = 4096;
constexpr int CW_CNT = 1024;

constexpr int RING_BYTES = 131072;
constexpr int LDSCTL_OFF = RING_BYTES;
constexpr int MISC_OFF = LDSCTL_OFF + 320;
constexpr int TAB_OFF = LDSCTL_OFF + 1024;
constexpr int OST_OFF = RING_BYTES + 8192;
constexpr int LDS_BYTES = 163840;

typedef GAS unsigned gu32;
#define RLX_AGENT __ATOMIC_RELAXED, __HIP_MEMORY_SCOPE_AGENT
#define LDS_WAIT() asm volatile("s_waitcnt lgkmcnt(0)" ::: "memory")
#define VM_WAIT() asm volatile("s_waitcnt vmcnt(0)" ::: "memory")
typedef __bf16 bf16x2_t __attribute__((ext_vector_type(2)));
__device__ __forceinline__ unsigned cvt_pk_bf16(float lo, float hi) { const f32x2 v = {lo, hi}; const bf16x2_t b = __builtin_convertvector(v, bf16x2_t); return __builtin_bit_cast(unsigned, b); }
__device__ __forceinline__ float bflo(unsigned w) { return __uint_as_float(w << 16); }
__device__ __forceinline__ float bfhi(unsigned w) { return __uint_as_float(w & 0xffff0000u); }
__device__ __forceinline__ float bf2f(bf16 h) { return __uint_as_float((unsigned)h << 16); }
__device__ __forceinline__ bf16 f2bf(float f) { return (bf16)(cvt_pk_bf16(f, 0.f) & 0xffffu); }
__device__ __forceinline__ float wave_sum(float v) {
#pragma unroll
    for (int o = 1; o < 64; o <<= 1) v += __shfl_xor(v, o);
    return v;
}
__device__ __forceinline__ float fast_sigmoid(float x) { return __builtin_amdgcn_rcpf(1.0f + __builtin_amdgcn_exp2f(-1.4426950408889634f * x)); }
__device__ __forceinline__ float fast_exp(float x) { return __builtin_amdgcn_exp2f(1.4426950408889634f * x); }
__device__ __forceinline__ float gelu_tanh(float x) {
    const float u = 0.7978845608028654f * (x + 0.044715f * x * x * x);
    return x * fast_sigmoid(2.0f * u);
}
__device__ __forceinline__ int tid_from(int wv) { int ln; asm volatile("v_mbcnt_lo_u32_b32 %0, -1, 0\n\tv_mbcnt_hi_u32_b32 %0, -1, %0" : "=v"(ln)); return wv * 64 + ln; }
namespace pg8 {
constexpr int BM = 256, BK = 64, HALF = 128, HTB = HALF * BK * 2  , STAGE_BYTES = 8 * HTB, NXCD = 8, WGM = 8;

__host__ __device__ __forceinline__ int lds_byte(int r, int c) { const int st = (r >> 4) * 2 + (c >> 5), rr = r & 15, cc = c & 31, ob = rr * 64 + cc * 2; return st * 1024 + (ob ^ (((ob >> 9) & 1) << 5)); }
__host__ __device__ __forceinline__ void stage_rc(int b, int& R, int& C) { const int st = b / 1024, sb = b % 1024, swz = sb ^ (((sb >> 9) & 1) << 5); R = (st >> 1) * 16 + swz / 64; C = (st & 1) * 32 + (swz % 64) / 2; }
__host__ __device__ __forceinline__ int perm32(int rho) { const int n = rho >> 4, i = rho & 15; return 8 * (i >> 2) + 4 * n + (i & 3); }

struct Unit { int pm, pn, e, aux; };

template <class Epi, class Sched, bool ALIGN_EPI>
__device__ __forceinline__ void gemm_phase(LAS unsigned char* lds, const bf16* Abase, const bf16* Bbase, const int K, const Sched& S, const Epi& E, const int wv) {
    const int tid = tid_from(wv), wid = __builtin_amdgcn_readfirstlane(tid >> 6), lane = tid & 63, wr = wid >> 2, wc = wid & 3, fr = lane & 15, fq = lane >> 4;
    const int nt = K / BK;
    unsigned voffB[2];
#pragma unroll
    for (int i = 0; i < 2; ++i) { int R, C; stage_rc(tid * 16 + i * 8192, R, C); const int Rb = Epi::PERM ? ((R & ~31) + perm32(R & 31)) : R;
        voffB[i] = (unsigned)(Rb * K + C) * 2u; }
#define PG8_AVOFF(u, h, i) ([&]() { int R_, C_; stage_rc(tid * 16 + (i) * 8192, R_, C_); return S.a_voff((u), (h) * HALF + R_, C_); }())
    const unsigned kstep = (unsigned)(BK * 2);
    const unsigned hstep = (unsigned)(HALF * K * 2);
    const unsigned ldsw = (unsigned)wid * 1024u;
    const int aoff = lds_byte(wr * 64 + fr, fq * 8), boff = lds_byte(wc * 32 + fr, fq * 8);
    const __amdgpu_buffer_rsrc_t rsA = __builtin_amdgcn_make_buffer_rsrc((void*)Abase, 0, 0x7fffffff, 0x00020000);
    const __amdgpu_buffer_rsrc_t rsB = __builtin_amdgcn_make_buffer_rsrc((void*)Bbase, 0, 0x7fffffff, 0x00020000);
#define PG8_SA(b, h) (((b) * 2 + (h)) * HTB)
#define PG8_SB(b, h) ((4 + (b) * 2 + (h)) * HTB)
#define PG8_STAGE_B(bufoff, soff) do { const int so_ = __builtin_amdgcn_readfirstlane((int)(soff)); _Pragma("unroll") for (int _i = 0; _i < 2; ++_i) \
        __builtin_amdgcn_raw_ptr_buffer_load_lds(rsB, (LAS void*)(lds + (bufoff) + ldsw + _i * 8192), 16, voffB[_i], so_, 0, 0); } while (0)
#define PG8_STAGE_A(bufoff, kbytes, v0, v1) do { const int so_ = __builtin_amdgcn_readfirstlane((int)(kbytes)); \
        __builtin_amdgcn_raw_ptr_buffer_load_lds(rsA, (LAS void*)(lds + (bufoff) + ldsw), 16, (v0), so_, 0, 0); \
        __builtin_amdgcn_raw_ptr_buffer_load_lds(rsA, (LAS void*)(lds + (bufoff) + ldsw + 8192), 16, (v1), so_, 0, 0); } while (0)
#define PG8_LDA(dst, b, h) do { _Pragma("unroll") for (int m = 0; m < 4; ++m) _Pragma("unroll") for (int k = 0; k < 2; ++k) dst[m][k] = *(const LAS bf16x8*)(lds + PG8_SA(b, h) + aoff + m * 2048 + k * 1024); } while (0)
#define PG8_LDB(dst, b, h) do { _Pragma("unroll") for (int n = 0; n < 2; ++n) _Pragma("unroll") for (int k = 0; k < 2; ++k) dst[n][k] = *(const LAS bf16x8*)(lds + PG8_SB(b, h) + boff + n * 2048 + k * 1024); } while (0)
#define PG8_MMA(ai, bj, At, Bt) do { __builtin_amdgcn_s_setprio(1); _Pragma("unroll") for (int m = 0; m < 4; ++m) _Pragma("unroll") for (int n = 0; n < 2; ++n) _Pragma("unroll") for (int k = 0; k < 2; ++k) \
        acc[ai][bj][m][n] = __builtin_amdgcn_mfma_f32_16x16x32_bf16(Bt[n][k], At[m][k], acc[ai][bj][m][n], 0, 0, 0); __builtin_amdgcn_s_setprio(0); } while (0)
#define PG8_WAIT_V(n) asm volatile("s_waitcnt vmcnt(" #n ")" ::: "memory")
#define PG8_WAIT_L(n) asm volatile("s_waitcnt lgkmcnt(" #n ")" ::: "memory")
#define PG8_BAR __builtin_amdgcn_s_barrier()
#define PG8_SCHED __builtin_amdgcn_sched_barrier(0)
    Unit cur, nxt; int ui = 0;
    if (!S.next(0, cur)) return;
    f32x4 acc[2][2][4][2];
#pragma unroll
    for (int a = 0; a < 2; ++a)
#pragma unroll
        for (int b = 0; b < 2; ++b)
#pragma unroll
            for (int m = 0; m < 4; ++m)
#pragma unroll
                for (int n = 0; n < 2; ++n) acc[a][b][m][n] = (f32x4){0.f, 0.f, 0.f, 0.f};
    bf16x8 At[4][2], B0[2][2], B1[2][2];
    unsigned vc0, vc1, vc2, vc3, vn0, vn1, vn2, vn3;
    unsigned cA0, cA1, nA0, nA1;
    vc0 = PG8_AVOFF(cur, 0, 0); vc1 = PG8_AVOFF(cur, 0, 1);
    if constexpr (Sched::GATHER) { vc2 = PG8_AVOFF(cur, 1, 0); vc3 = PG8_AVOFF(cur, 1, 1); } else { vc2 = vc0; vc3 = vc1; }
    cA0 = S.a_soff(cur, 0); cA1 = S.a_soff(cur, 1);
    unsigned cB = (unsigned)S.b_off(cur);
    PG8_STAGE_B(PG8_SB(0, 0), cB); PG8_STAGE_B(PG8_SB(0, 1), cB + hstep); PG8_STAGE_A(PG8_SA(0, 0), cA0, vc0, vc1); PG8_STAGE_A(PG8_SA(0, 1), cA1, vc2, vc3);
    if (wr == 1) PG8_BAR;
    PG8_WAIT_V(2); PG8_BAR;
    PG8_STAGE_B(PG8_SB(1, 0), cB + kstep); PG8_STAGE_A(PG8_SA(1, 0), cA0 + kstep, vc0, vc1); PG8_STAGE_B(PG8_SB(1, 1), cB + hstep + kstep);
    PG8_WAIT_V(6); PG8_BAR;
    for (;;) {
#define PG8_TRIP(a1k, a2k0, a2k1, a3k0, b2, b3, w0, w1, w2, w3) do { \
              \
            PG8_LDB(B0, 0, 0); PG8_LDB(B1, 0, 1); PG8_SCHED; PG8_LDA(At, 0, 0); PG8_STAGE_A(PG8_SA(1, 1), a1k, vc2, vc3); \
            PG8_WAIT_V(8); PG8_WAIT_L(0); PG8_BAR; PG8_MMA(0, 0, At, B0); PG8_MMA(0, 1, At, B1); PG8_BAR; PG8_SCHED; \
              \
            PG8_LDA(At, 0, 1); PG8_STAGE_B(PG8_SB(0, 0), b2); PG8_STAGE_B(PG8_SB(0, 1), (b2) + hstep); PG8_STAGE_A(PG8_SA(0, 0), a2k0, w0, w1); \
            PG8_WAIT_V(8); PG8_WAIT_L(0); PG8_BAR; PG8_MMA(1, 0, At, B0); PG8_MMA(1, 1, At, B1); PG8_BAR; PG8_SCHED; \
              \
            PG8_LDB(B0, 1, 0); PG8_LDB(B1, 1, 1); PG8_SCHED; PG8_LDA(At, 1, 0); PG8_STAGE_A(PG8_SA(0, 1), a2k1, w2, w3); \
            PG8_WAIT_V(8); PG8_WAIT_L(0); PG8_BAR; PG8_MMA(0, 0, At, B0); PG8_MMA(0, 1, At, B1); PG8_BAR; PG8_SCHED; \
              \
            PG8_LDA(At, 1, 1); PG8_STAGE_B(PG8_SB(1, 0), b3); PG8_STAGE_B(PG8_SB(1, 1), (b3) + hstep); PG8_STAGE_A(PG8_SA(1, 0), a3k0, w0, w1); \
            PG8_WAIT_V(8); PG8_WAIT_L(0); PG8_BAR; PG8_MMA(1, 0, At, B0); PG8_MMA(1, 1, At, B1); PG8_BAR; PG8_SCHED; } while (0)
        for (int t = 0; t < nt - 2; t += 2) {
            const unsigned k1 = (unsigned)(t + 1) * kstep, k2 = (unsigned)(t + 2) * kstep, b2 = cB + k2, b3 = b2 + kstep;
            PG8_TRIP(cA1 + k1, cA0 + k2, cA1 + k2, cA0 + k2 + kstep, b2, b3, vc0, vc1, vc2, vc3);
        }
        const bool has_next = S.next(ui + 1, nxt);
        unsigned nB;
        if (has_next) { if constexpr (Sched::GATHER) { vn0 = PG8_AVOFF(nxt, 0, 0); vn1 = PG8_AVOFF(nxt, 0, 1); vn2 = PG8_AVOFF(nxt, 1, 0); vn3 = PG8_AVOFF(nxt, 1, 1); } else { vn0 = vc0; vn1 = vc1; vn2 = vc0; vn3 = vc1; }
                        nA0 = S.a_soff(nxt, 0); nA1 = S.a_soff(nxt, 1); nB = (unsigned)S.b_off(nxt); }
        else { vn0 = vc0; vn1 = vc1; vn2 = vc2; vn3 = vc3; nA0 = cA0; nA1 = cA1; nB = cB; }
        { const unsigned k1 = (unsigned)(nt - 1) * kstep;
          PG8_TRIP(cA1 + k1, nA0, nA1, nA0 + kstep, nB, nB + kstep, vn0, vn1, vn2, vn3); }
#undef PG8_TRIP
        if constexpr (ALIGN_EPI) { if (wr == 0) PG8_BAR; }
        E(acc, cur, wr, wc, fr, fq);
        if (!has_next) break;
#pragma unroll
        for (int a = 0; a < 2; ++a)
#pragma unroll
            for (int b = 0; b < 2; ++b)
#pragma unroll
                for (int m = 0; m < 4; ++m)
#pragma unroll
                    for (int n = 0; n < 2; ++n) acc[a][b][m][n] = (f32x4){0.f, 0.f, 0.f, 0.f};
        cur = nxt; cB = nB; cA0 = nA0; cA1 = nA1; vc0 = vn0; vc1 = vn1; vc2 = vn2; vc3 = vn3; ++ui;
        if constexpr (ALIGN_EPI) { if (wr == 1) PG8_BAR; }
    }
    PG8_WAIT_V(0);
    if constexpr (!ALIGN_EPI) { if (wr == 0) PG8_BAR; }
    PG8_BAR;
#undef PG8_SA
#undef PG8_AVOFF
#undef PG8_SB
#undef PG8_STAGE_A
#undef PG8_STAGE_B
#undef PG8_LDA
#undef PG8_LDB
#undef PG8_MMA
#undef PG8_WAIT_V
#undef PG8_WAIT_L
#undef PG8_BAR
#undef PG8_SCHED
}

struct StaticOrder {
    int nM, nN, nwg, G, c, lda, dup;
    __device__ __forceinline__ void init(int M, int N, int lda_, int G_, int c_) { nM = M / BM; nN = N / BM; nwg = nM * nN; G = G_; c = c_; lda = lda_; dup = 0; }
    __device__ __forceinline__ bool next(int i, Unit& u) const {
        const long L = (long)(i >> dup) * G + c; if (L >= nwg) return false;
        int wgid = (int)L; { const int q = nwg / NXCD, r = nwg % NXCD, xcd = wgid % NXCD, off = wgid / NXCD; wgid = (xcd < r ? xcd * (q + 1) : r * (q + 1) + (xcd - r) * q) + off; }
        const int nig = WGM * nN, gid = wgid / nig, fm = gid * WGM, gsz = (nM - fm) < WGM ? (nM - fm) : WGM;
        u.pm = fm + ((wgid % nig) % gsz); u.pn = (wgid % nig) / gsz; u.e = 0; u.aux = 0; return true;
    }
    static constexpr bool GATHER = false;
    __device__ __forceinline__ unsigned a_voff(const Unit&, int R, int C) const { return (unsigned)((R & (HALF - 1)) * lda + C) * 2u; }
    __device__ __forceinline__ unsigned a_soff(const Unit& u, int h) const { return (unsigned)((u.pm * BM + h * HALF) * lda) * 2u; }
    __device__ __forceinline__ size_t b_off(const Unit& u) const { return (size_t)u.pn * BM * lda * 2; }
};
}

#define XB_TMO      128
#define XB_XCNT(j)  (256  + 64 * (j))
#define XB_XSUB(j)  (1280 + 64 * (j))
#define XB_XGEN(j)  (2304 + 64 * (j))
#define XB_TOP      3328
#define XB_TOPGEN   3392
#define XCD_BAR_WORDS 3456
#define XB_SPIN_CAP (1u << 18)

__device__ __forceinline__ unsigned xb_ld(unsigned* p)              { return __hip_atomic_load(p, __ATOMIC_RELAXED, __HIP_MEMORY_SCOPE_AGENT); }
__device__ __forceinline__ unsigned xb_add(unsigned* p, unsigned v) { return __hip_atomic_fetch_add(p, v, __ATOMIC_RELAXED, __HIP_MEMORY_SCOPE_AGENT); }
__device__ __forceinline__ unsigned xb_xcc_id() { return (unsigned)__builtin_amdgcn_s_getreg((3 << 11) | 20) & 0xFu; }
#define XB_SPIN(cond, bar) do { unsigned _sp = 0; while (cond) { __builtin_amdgcn_s_sleep(1); \
    if ((++_sp & 255u) == 0u) { if (xb_ld(&(bar)[XB_TMO])) break; if (_sp > XB_SPIN_CAP) { atomicAdd(&(bar)[XB_TMO], 1u); break; } } } } while (0)

struct XcdBarrier {
    unsigned* bar; unsigned x;
    volatile LAS unsigned* st;
};

__device__ __forceinline__ XcdBarrier xcd_barrier_post(unsigned* bar, volatile LAS unsigned* st) {
    XcdBarrier b; b.bar = bar; b.x = xb_xcc_id(); b.st = st;
    if (threadIdx.x == 0) (void)xb_add(&bar[XB_XCNT(b.x)], 1u);
    return b;
}
__device__ __forceinline__ void xcd_barrier_complete(unsigned* bar, unsigned x, unsigned& nloc, unsigned& nx) {
    const unsigned G = gridDim.x * gridDim.y * gridDim.z;
    unsigned sum, cnt, mine, sp = 0u;
    for (;;) {
        sum = 0u; cnt = 0u; mine = 0u;
#pragma unroll
        for (unsigned j = 0; j < 16; ++j) { const unsigned c = xb_ld(&bar[XB_XCNT(j)]); sum += c; cnt += (c > 0u) ? 1u : 0u; mine = (j == x) ? c : mine; }
        if (sum == G) break;
        __builtin_amdgcn_s_sleep(1);
        if ((++sp & 255u) == 0u) { if (xb_ld(&bar[XB_TMO])) break; if (sp > XB_SPIN_CAP) { atomicAdd(&bar[XB_TMO], 1u); break; } }
    }
    nloc = mine > 0u ? mine : 1u; nx = cnt > 0u ? cnt : 1u;
}

__device__ __forceinline__ void xcd_barrier(const XcdBarrier& b) {
    asm volatile("s_waitcnt vmcnt(0)" ::: "memory");
    __syncthreads();
    if (threadIdx.x == 0) {
        unsigned* bar = b.bar;
        __builtin_amdgcn_s_waitcnt(0);
        unsigned nloc = b.st[0], nx = b.st[1];
        if (nloc == 0u) { xcd_barrier_complete(bar, b.x, nloc, nx); b.st[0] = nloc; b.st[1] = nx; }
        const unsigned old = xb_add(&bar[XB_XSUB(b.x)], 1u);
        const unsigned gen = old / nloc;
        if (old + 1u == (gen + 1u) * nloc) {
            __builtin_amdgcn_fence(__ATOMIC_RELEASE, "agent");
            asm volatile("s_waitcnt vmcnt(0)" ::: "memory");
            const unsigned og = xb_add(&bar[XB_TOP], 1u);
            const unsigned tg = og / nx;
            if (og + 1u == (tg + 1u) * nx) xb_add(&bar[XB_TOPGEN], 1u);
            else XB_SPIN(xb_ld(&bar[XB_TOPGEN]) == tg, bar);
            __builtin_amdgcn_fence(__ATOMIC_ACQUIRE, "agent");
            xb_add(&bar[XB_XGEN(b.x)], 1u);
            asm volatile("s_waitcnt vmcnt(0)" ::: "memory");
        } else {
            XB_SPIN(xb_ld(&bar[XB_XGEN(b.x)]) == gen, bar);
            __builtin_amdgcn_fence(__ATOMIC_ACQUIRE, "agent");
            asm volatile("s_waitcnt vmcnt(0)" ::: "memory");
        }
    }
    __syncthreads();
}

struct Args { const float* in[23]; float* out; unsigned char* ws; int ph_lo, ph_hi, li, pad; };
#define CAS __attribute__((address_space(4)))
typedef const CAS Args& ArgsRef;
enum { I_X = 0, I_NORM1G, I_WIN, I_POOLW, I_POOLSC, I_CONVW, I_CONVB, I_WA, I_BA, I_WX, I_BX, I_LAM, I_QG, I_KG, I_OG, I_WOUT, I_NORM2G, I_WR, I_BR, I_WGU, I_BGU, I_WD, I_BD };

__device__ __forceinline__ void tr_item(const float* W, int K, int N, bf16* WT, const float* gk, int mode, LAS float* scr, int item, int lane) {
    const int nblk = N / 32, kb = item / nblk, nb = item % nblk, k0 = 64 * kb, n0 = 32 * nb;
#pragma unroll 8
    for (int i = 0; i < 32; ++i) { const int kk = 2 * i + (lane >> 5); float v = W[(size_t)(k0 + kk) * N + n0 + (lane & 31)]; if (gk) v *= gk[k0 + kk]; scr[kk * 33 + (lane & 31)] = v; }
    LDS_WAIT(); asm volatile("" ::: "memory");
    const int c = lane & 7;
#pragma unroll
    for (int j = 0; j < 4; ++j) { const int n = (lane >> 3) + 8 * j; const LAS float* s = scr + (8 * c) * 33 + n;
        u32x4 o; o.x = cvt_pk_bf16(s[0 * 33], s[1 * 33]); o.y = cvt_pk_bf16(s[2 * 33], s[3 * 33]); o.z = cvt_pk_bf16(s[4 * 33], s[5 * 33]); o.w = cvt_pk_bf16(s[6 * 33], s[7 * 33]);
        int dn = n0 + n;
        if (mode == 1) { const int jj = dn & 255; dn = (jj >> 7) * 256 + (dn >> 8) * 128 + (jj & 127); }
        if (mode == 2 && dn >= C_Q && dn < C_V) {
            const int rem = (dn - C_Q) & 511, sec = (dn - C_Q) >> 9, head = rem >> 6, d = rem & 63;
            dn = C_Q + sec * 512 + (head >> 2) * 256 + (d >> 5) * 128 + (head & 3) * 32 + (d & 31); }
        *(u32x4*)(WT + (size_t)dn * K + k0 + 8 * c) = o; }
    LDS_WAIT(); asm volatile("" ::: "memory");
}
__device__ __forceinline__ void cvt_row(const float* xrow, bf16* orow, float* ssq, int lane) {
    const f32x4* xr = (const f32x4*)xrow + lane;
    f32x4 v[4]; float s = 0.f;
#pragma unroll
    for (int j = 0; j < 4; ++j) { v[j] = xr[64 * j]; s += (v[j].x * v[j].x + v[j].y * v[j].y) + (v[j].z * v[j].z + v[j].w * v[j].w); }
    s = wave_sum(s);
    u32x2* o8 = (u32x2*)orow + lane;
#pragma unroll
    for (int j = 0; j < 4; ++j) { u32x2 w; w.x = cvt_pk_bf16(v[j].x, v[j].y); w.y = cvt_pk_bf16(v[j].z, v[j].w); o8[64 * j] = w; }
    if (lane == 0) *ssq = s;
}
__device__ __forceinline__ void phase_prologue(ArgsRef a, LAS unsigned char* lds, int wv) {
    const int tid = tid_from(wv), lane = tid & 63, wave = tid >> 6;
    LAS float* scr = (LAS float*)(lds + wave * 16384);
    const int gw = blockIdx.x * NWAVES + wave, NGW = gridDim.x * NWAVES;
    unsigned char* ws = a.ws;
    constexpr int I_IN = 16 * 72, I_OUT = 16 * 32, I_R = 16, I_GU = 16 * 16, I_D = 4 * 32, I_S = 2;
    constexpr int PER_LAYER = I_IN + I_OUT + I_R + NEXP * I_GU + NEXP * I_D + 12 * I_S;
    for (int it = gw; it < 2 * PER_LAYER; it += NGW) {
        const int l = it / PER_LAYER; int r = it % PER_LAYER;
        if (r < I_IN) { tr_item(a.in[I_WIN] + (size_t)l * DM * NIN, DM, NIN, (bf16*)(ws + WS_WIN) + (size_t)l * NIN * DM, a.in[I_NORM1G] + l * DM, 2, scr, r, lane); continue; } r -= I_IN;
        if (r < I_OUT) { tr_item(a.in[I_WOUT] + (size_t)l * DM * DM, DM, DM, (bf16*)(ws + WS_WOUT) + (size_t)l * DM * DM, a.in[I_OG] + l * DM, 0, scr, r, lane); continue; } r -= I_OUT;
        if (r < I_R) { tr_item(a.in[I_WR] + (size_t)l * DM * NEXP, DM, NEXP, (bf16*)(ws + WS_SMALL) + SM_WR + (size_t)l * NEXP * DM, a.in[I_NORM2G] + l * DM, 0, scr, r, lane); continue; } r -= I_R;
        if (r < NEXP * I_GU) { const int e = r / I_GU; tr_item(a.in[I_WGU] + (size_t)(l * NEXP + e) * DM * 512, DM, 512, (bf16*)(ws + WS_WGU) + (size_t)(l * NEXP + e) * 512 * DM, a.in[I_NORM2G] + l * DM, 1, scr, r % I_GU, lane); continue; } r -= NEXP * I_GU;
        if (r < NEXP * I_D) { const int e = r / I_D; tr_item(a.in[I_WD] + (size_t)(l * NEXP + e) * EFF * DM, EFF, DM, (bf16*)(ws + WS_WD) + (size_t)(l * NEXP + e) * DM * EFF, nullptr, 0, scr, r % I_D, lane); continue; } r -= NEXP * I_D;
        { const int which = r / (4 * I_S), g = (r / I_S) % 4, sub = r % I_S;
          const float* src = a.in[which == 0 ? I_POOLW : (which == 1 ? I_WA : I_WX)] + (size_t)(l * 4 + g) * 4096;
          bf16* dst = (bf16*)(ws + WS_SMALL) + (which == 0 ? SM_POOLW : (which == 1 ? SM_WA : SM_WX)) + (size_t)(l * 4 + g) * 4096;
          tr_item(src, 64, 64, dst, nullptr, 0, scr, sub, lane); }
    }
    { float* ct = (float*)(ws + WS_ROPE); float* st = ct + SEQ * 32;
      for (int idx = blockIdx.x * NTHR + tid; idx < SEQ * 32; idx += gridDim.x * NTHR) {
          const int pos = idx >> 5, i = idx & 31;
          const float inv = __builtin_amdgcn_exp2f(-(float)i * 0.41524101186092029f);
          const float ang = (float)pos * inv;
          const double rev = (double)ang * 0.15915494309189535; const double fr = rev - __builtin_rint(rev);
          const float f = (float)fr;
          ct[idx] = __builtin_amdgcn_cosf(f); st[idx] = __builtin_amdgcn_sinf(f); } }
    for (int m = gw; m < NT; m += NGW) cvt_row(a.in[I_X] + (size_t)m * DM, (bf16*)(ws + WS_XB) + (size_t)m * DM, (float*)(ws + WS_SSQ) + m, lane);
}

struct EpiIn {
    static constexpr bool PERM = true;
    bf16* O; const float* ssq; const float* qg; const float* kg; const float* ct; const float* st;
    __device__ __forceinline__ void operator()(const f32x4 (&acc)[2][2][4][2], const pg8::Unit& u, int wr, int wc, int fr, int fq) const {
        const int row0 = u.pm * 256 + wr * 64 + fr, col0 = u.pn * 256 + wc * 32 + 8 * fq;
        if (u.pn >= 3 && u.pn < 7) {
            const bool isq = u.pn < 5; const float* gp = (isq ? qg : kg) + 8 * fq; const float gs = isq ? (0.125f * 1.4426950408889634f) : 1.0f;
            f32x4 g[2][2];
#pragma unroll
            for (int bj = 0; bj < 2; ++bj)
#pragma unroll
                for (int n = 0; n < 2; ++n) g[bj][n] = *(const f32x4*)(gp + 32 * bj + 4 * n) * gs;
#pragma unroll
            for (int ai = 0; ai < 2; ++ai)
#pragma unroll
                for (int m = 0; m < 4; ++m) { const int row = row0 + ai * 128 + m * 16; const float rs = __builtin_amdgcn_rsqf(ssq[row] * (1.0f / DM) + EPS);
                    const int pos = row & (SEQ - 1);
                    const f32x4 c0 = *(const f32x4*)(ct + pos * 32 + 8 * fq), c1 = *(const f32x4*)(ct + pos * 32 + 8 * fq + 4), s0 = *(const f32x4*)(st + pos * 32 + 8 * fq), s1 = *(const f32x4*)(st + pos * 32 + 8 * fq + 4);
                    f32x4 v[2][2]; float ss = 0.f;
#pragma unroll
                    for (int bj = 0; bj < 2; ++bj)
#pragma unroll
                        for (int n = 0; n < 2; ++n) { v[bj][n] = acc[ai][bj][m][n] * rs; ss += (v[bj][n][0] * v[bj][n][0] + v[bj][n][1] * v[bj][n][1]) + (v[bj][n][2] * v[bj][n][2] + v[bj][n][3] * v[bj][n][3]); }
                    ss += __shfl_xor(ss, 16); ss += __shfl_xor(ss, 32);
                    const float rr = __builtin_amdgcn_rsqf(ss * (1.0f / 64.0f) + EPS);
#pragma unroll
                    for (int bj = 0; bj < 2; ++bj)
#pragma unroll
                        for (int n = 0; n < 2; ++n) v[bj][n] = v[bj][n] * rr * g[bj][n];
                    const f32x4 o00 = v[0][0] * c0 - v[1][0] * s0, o01 = v[0][1] * c1 - v[1][1] * s1, o10 = v[1][0] * c0 + v[0][0] * s0, o11 = v[1][1] * c1 + v[0][1] * s1;
                    bf16* rowp = O + (size_t)row * NIN + col0;
                    u32x4 w; w.x = cvt_pk_bf16(o00[0], o00[1]); w.y = cvt_pk_bf16(o00[2], o00[3]); w.z = cvt_pk_bf16(o01[0], o01[1]); w.w = cvt_pk_bf16(o01[2], o01[3]);
                    *(u32x4*)(rowp) = w;
                    w.x = cvt_pk_bf16(o10[0], o10[1]); w.y = cvt_pk_bf16(o10[2], o10[3]); w.z = cvt_pk_bf16(o11[0], o11[1]); w.w = cvt_pk_bf16(o11[2], o11[3]);
                    *(u32x4*)(rowp + 128) = w; }
            return;
        }
#pragma unroll
        for (int ai = 0; ai < 2; ++ai)
#pragma unroll
            for (int m = 0; m < 4; ++m) { const int row = row0 + ai * 128 + m * 16; const float rs = __builtin_amdgcn_rsqf(ssq[row] * (1.0f / DM) + EPS);
                bf16* rowp = O + (size_t)row * NIN + col0;
#pragma unroll
                for (int bj = 0; bj < 2; ++bj) { const f32x4 v0 = acc[ai][bj][m][0] * rs, v1 = acc[ai][bj][m][1] * rs;
                    u32x4 w; w.x = cvt_pk_bf16(v0[0], v0[1]); w.y = cvt_pk_bf16(v0[2], v0[3]); w.z = cvt_pk_bf16(v1[0], v1[1]); w.w = cvt_pk_bf16(v1[2], v1[3]);
                    *(u32x4*)(rowp + bj * 128) = w; } }
    }
};
struct EpiOut {
    static constexpr bool PERM = false;
    bf16* xb; float* ssqp;
    __device__ __forceinline__ void operator()(const f32x4 (&acc)[2][2][4][2], const pg8::Unit& u, int wr, int wc, int fr, int fq) const {
        const int row0 = u.pm * 256 + wr * 64 + fr, col0 = u.pn * 256 + wc * 32 + 4 * fq;
#pragma unroll
        for (int ai = 0; ai < 2; ++ai)
#pragma unroll
            for (int m = 0; m < 4; ++m) { const int row = row0 + ai * 128 + m * 16; const size_t off = (size_t)row * DM + col0; float s = 0.f;
                u32x2 xi[2][2];
#pragma unroll
                for (int bj = 0; bj < 2; ++bj)
#pragma unroll
                    for (int n = 0; n < 2; ++n) xi[bj][n] = *(const u32x2*)(xb + off + bj * 128 + n * 16);
#pragma unroll
                for (int bj = 0; bj < 2; ++bj)
#pragma unroll
                    for (int n = 0; n < 2; ++n) { const f32x4 o = (f32x4){bflo(xi[bj][n].x), bfhi(xi[bj][n].x), bflo(xi[bj][n].y), bfhi(xi[bj][n].y)} + acc[ai][bj][m][n];
                        s += (o[0] * o[0] + o[1] * o[1]) + (o[2] * o[2] + o[3] * o[3]);
                        u32x2 w; w.x = cvt_pk_bf16(o[0], o[1]); w.y = cvt_pk_bf16(o[2], o[3]); *(u32x2*)(xb + off + bj * 128 + n * 16) = w; }
                s += __shfl_xor(s, 16); s += __shfl_xor(s, 32);
                if (fq == 0) ssqp[(size_t)row * 16 + u.pn * 4 + wc] = s; }
    }
};

template <int MODE> struct MoeOrder {
    static constexpr bool GATHER = (MODE == 0);
    const LAS int* tab; int npn, G, c; const int* list; int dup;
    __device__ __forceinline__ bool next(int i, pg8::Unit& u) const {
        const int ii = i >> dup; const int total = __builtin_amdgcn_readfirstlane(tab[64]); const int nfr = total / G, nfu = nfr * npn;
        int gb;
        if (ii < nfu) { gb = (ii / npn) * G + c; u.pn = ii % npn; }
        else { const int L = (ii - nfu) * G + c; gb = nfr * G + L / npn; u.pn = L % npn; if (gb >= total) return false; }
        const int e = __builtin_amdgcn_readfirstlane((int)((const LAS unsigned char*)(tab + 80))[gb]);
        u.e = e; u.pm = gb; u.aux = gb - __builtin_amdgcn_readfirstlane(tab[32 + e]); return true;
    }
    __device__ __forceinline__ unsigned a_voff(const pg8::Unit& u, int R, int C) const {
        if constexpr (MODE == 0) { const int pos = u.aux * 256 + R; const int ne = tab[u.e]; int tok = 0; if (pos < ne) tok = list[u.e * NT + pos] >> 2; return (unsigned)(tok * DM + C) * 2u; }
        else return (unsigned)((R & 127) * EFF + C) * 2u;
    }
    __device__ __forceinline__ unsigned a_soff(const pg8::Unit& u, int h) const { if constexpr (MODE == 0) return 0u; else return (unsigned)((u.pm * 256 + h * 128) * EFF) * 2u; }
    __device__ __forceinline__ size_t b_off(const pg8::Unit& u) const {
        if constexpr (MODE == 0) return ((size_t)u.e * 512 + (size_t)u.pn * 256) * DM * 2;
        else return ((size_t)u.e * DM + (size_t)u.pn * 256) * EFF * 2;
    }
};
struct EpiGU {
    static constexpr bool PERM = true;
    bf16* act; const float* lrstd; const float* bgu;
    __device__ __forceinline__ void operator()(const f32x4 (&acc)[2][2][4][2], const pg8::Unit& u, int wr, int wc, int fr, int fq) const {
        const int r0 = wr * 64 + fr, cl0 = wc * 32 + 8 * fq;
        const float* bg = bgu + u.e * 512 + u.pn * 128 + cl0;
        const f32x4 bg0 = *(const f32x4*)(bg), bg1 = *(const f32x4*)(bg + 4), bu0 = *(const f32x4*)(bg + 256), bu1 = *(const f32x4*)(bg + 260);
#pragma unroll
        for (int ai = 0; ai < 2; ++ai)
#pragma unroll
            for (int m = 0; m < 4; ++m) { const int r = r0 + ai * 128 + m * 16; const float rs = lrstd[(size_t)u.e * NT + u.aux * 256 + r];
                f32x4 g0 = acc[ai][0][m][0] * rs + bg0, g1 = acc[ai][0][m][1] * rs + bg1, u0 = acc[ai][1][m][0] * rs + bu0, u1 = acc[ai][1][m][1] * rs + bu1;
                float o[8];
#pragma unroll
                for (int j = 0; j < 4; ++j) { const float ga = fminf(g0[j], 7.0f), ua = fminf(fmaxf(u0[j], -7.0f), 7.0f); o[j] = (ua + 1.0f) * ga * fast_sigmoid(1.702f * ga);
                                              const float gb = fminf(g1[j], 7.0f), ub = fminf(fmaxf(u1[j], -7.0f), 7.0f); o[4 + j] = (ub + 1.0f) * gb * fast_sigmoid(1.702f * gb); }
                u32x4 w; w.x = cvt_pk_bf16(o[0], o[1]); w.y = cvt_pk_bf16(o[2], o[3]); w.z = cvt_pk_bf16(o[4], o[5]); w.w = cvt_pk_bf16(o[6], o[7]);
                *(u32x4*)(act + (size_t)(u.pm * 256 + r) * EFF + u.pn * 128 + cl0) = w; }
    }
};
constexpr float Y8_SCALE = 32.0f;
struct EpiDown {
    static constexpr bool PERM = true;
    unsigned char* y; const int* list; const float* lgate; const float* bd; const LAS int* tab;
    __device__ __forceinline__ void operator()(const f32x4 (&acc)[2][2][4][2], const pg8::Unit& u, int wr, int wc, int fr, int fq) const {
        const int r0 = wr * 64 + fr, col0 = u.pn * 256 + wc * 32 + 8 * fq; const int ne = tab[u.e];
        const float* bp = bd + u.e * DM + col0;
#pragma unroll
        for (int ai = 0; ai < 2; ++ai) { int asg[4]; float gt[4];
#pragma unroll
            for (int m = 0; m < 4; ++m) { const int pos = u.aux * 256 + r0 + ai * 128 + m * 16; const bool ok = pos < ne;
                asg[m] = ok ? list[(size_t)u.e * NT + pos] : -1; gt[m] = ok ? lgate[(size_t)u.e * NT + pos] * Y8_SCALE : 0.f; }
            asm volatile("" ::: "memory");
#pragma unroll
            for (int m = 0; m < 4; ++m) {
                if (asg[m] >= 0) { unsigned char* rowp = y + (size_t)asg[m] * DM + col0; const float g = gt[m];
#pragma unroll
                    for (int bj = 0; bj < 2; ++bj) { const f32x4 b0 = *(const f32x4*)(bp + bj * 128), b1 = *(const f32x4*)(bp + bj * 128 + 4);
                        const f32x4 v0 = (acc[ai][bj][m][0] + b0) * g, v1 = (acc[ai][bj][m][1] + b1) * g;
                        int w0 = __builtin_amdgcn_cvt_pk_fp8_f32(v0[0], v0[1], 0, false); w0 = __builtin_amdgcn_cvt_pk_fp8_f32(v0[2], v0[3], w0, true);
                        int w1 = __builtin_amdgcn_cvt_pk_fp8_f32(v1[0], v1[1], 0, false); w1 = __builtin_amdgcn_cvt_pk_fp8_f32(v1[2], v1[3], w1, true);
                        *(u32x2*)(rowp + bj * 128) = (u32x2){(unsigned)w0, (unsigned)w1}; } }
                asm volatile("" ::: "memory"); } }
    }
};
__device__ __forceinline__ void moe_tables(LAS int* tab, const unsigned* cnt, int wv) {
    __syncthreads();
    const int tid_ = tid_from(wv);
    if (tid_ == 0) { int pre = 0;
        for (int e = 0; e < NEXP; ++e) { const int n = (int)__hip_atomic_load(cnt + e, RLX_AGENT); tab[e] = n; tab[32 + e] = pre; pre += (n + 255) >> 8; }
        tab[64] = pre; }
    __syncthreads();
    { LAS unsigned char* eb = (LAS unsigned char*)(tab + 80); const int total = tab[64];
      for (int gb = tid_; gb < total; gb += NTHR) { int e = 0;
          for (int k = 1; k < NEXP; ++k) { if (tab[32 + k] <= gb) e = k; }
          eb[gb] = (unsigned char)e; } }
    __syncthreads();
}

__device__ __forceinline__ void phase_qkprep(ArgsRef a, int layer, int wv, bool dry) {
    const int tid = tid_from(wv), lane = tid & 63, wave = tid >> 6;
    const int gw = blockIdx.x * NWAVES + wave, NGW = gridDim.x * NWAVES;
    bf16* proj = (bf16*)(a.ws + WS_PROJ);
    const float* __restrict__ ct = (const float*)(a.ws + WS_ROPE); const float* __restrict__ st = ct + SEQ * 32;
    const int d0 = (lane & 7) * 8, p0 = d0 & 31;
    float gq[8], gk[8];
#pragma unroll
    for (int j = 0; j < 8; ++j) { gq[j] = a.in[I_QG][layer * 64 + d0 + j] * (0.125f * 1.4426950408889634f); gk[j] = a.in[I_KG][layer * 64 + d0 + j]; }
    const bool second = (lane & 4) != 0;
    constexpr int TB = 4;
    for (int t0 = gw * TB; t0 < NT; t0 += NGW * TB) {
        u32x4 w[TB][2]; f32x4 cs[TB][4];
#pragma unroll
        for (int u = 0; u < TB; ++u) { const int t = t0 + u, pos = t & (SEQ - 1);
            w[u][0] = *(const u32x4*)(proj + (size_t)t * NIN + C_Q + lane * 8); w[u][1] = *(const u32x4*)(proj + (size_t)t * NIN + C_Q + 512 + lane * 8);
            cs[u][0] = *(const f32x4*)(ct + pos * 32 + p0); cs[u][1] = *(const f32x4*)(ct + pos * 32 + p0 + 4); cs[u][2] = *(const f32x4*)(st + pos * 32 + p0); cs[u][3] = *(const f32x4*)(st + pos * 32 + p0 + 4); }
#pragma unroll
        for (int u = 0; u < TB; ++u) { const int t = t0 + u;
            float c[8], s[8];
#pragma unroll
            for (int j = 0; j < 4; ++j) { c[j] = cs[u][0][j]; c[4 + j] = cs[u][1][j]; s[j] = cs[u][2][j]; s[4 + j] = cs[u][3][j]; }
#pragma unroll
            for (int i = 0; i < 2; ++i) {
                const u32x4 ww = w[u][i];
                float x[8]; x[0] = bflo(ww.x); x[1] = bfhi(ww.x); x[2] = bflo(ww.y); x[3] = bfhi(ww.y); x[4] = bflo(ww.z); x[5] = bfhi(ww.z); x[6] = bflo(ww.w); x[7] = bfhi(ww.w);
                float ss = 0.f;
#pragma unroll
                for (int j = 0; j < 8; ++j) ss += x[j] * x[j];
                ss += __shfl_xor(ss, 1); ss += __shfl_xor(ss, 2); ss += __shfl_xor(ss, 4);
                const float rs = __builtin_amdgcn_rsqf(ss * (1.0f / 64.0f) + EPS);
                float o[8];
#pragma unroll
                for (int j = 0; j < 8; ++j) { const float yv = x[j] * rs * (i == 0 ? gq[j] : gk[j]); const float pv = __shfl_xor(yv, 4);
                    o[j] = second ? (yv * c[j] + pv * s[j]) : (yv * c[j] - pv * s[j]); }
                u32x4 r; r.x = cvt_pk_bf16(o[0], o[1]); r.y = cvt_pk_bf16(o[2], o[3]); r.z = cvt_pk_bf16(o[4], o[5]); r.w = cvt_pk_bf16(o[6], o[7]);
                if (!dry || o[0] == 12345.678f) *(u32x4*)(proj + (size_t)t * NIN + C_Q + i * 512 + lane * 8) = r;
            } }
    }
}

__device__ __forceinline__ void phase_pool(ArgsRef a, LAS unsigned char* lds, int layer, int wv) {
    const int tid = tid_from(wv), lane = tid & 63, wave = __builtin_amdgcn_readfirstlane(tid >> 6);
    const bf16* proj = (const bf16*)(a.ws + WS_PROJ); bf16* mix = (bf16*)(a.ws + WS_MIX);
    const bf16* pw = (const bf16*)(a.ws + WS_SMALL) + SM_POOLW + (size_t)layer * 4 * 4096;
    const float* psc = a.in[I_POOLSC] + layer * 256;
    LAS float* U = (LAS float*)lds;
    LAS bf16* PA = (LAS bf16*)(lds + 81920);
    LAS float* SS = (LAS float*)(lds + 116736);
    constexpr int PAS = 264;
    for (int unit = blockIdx.x; unit < NT / 64; unit += gridDim.x) {
        const int t0 = unit * 64, s0 = t0 & (SEQ - 1);
        __syncthreads();
        for (int ch = tid; ch < 79 * 32; ch += NTHR) { const int r = ch >> 5, c8 = (ch & 31) * 8; const int srow = s0 - 15 + r;
            f32x4 lo = {0.f, 0.f, 0.f, 0.f}, hi = {0.f, 0.f, 0.f, 0.f};
            if (srow >= 0) { const u32x4 w = *(const u32x4*)(proj + (size_t)(t0 - 15 + r) * NIN + C_POOL + c8); lo = (f32x4){bflo(w.x), bfhi(w.x), bflo(w.y), bfhi(w.y)}; hi = (f32x4){bflo(w.z), bfhi(w.z), bflo(w.w), bfhi(w.w)}; }
            *(LAS f32x4*)(U + r * 256 + c8) = lo; *(LAS f32x4*)(U + r * 256 + c8 + 4) = hi; }
        __syncthreads();
        { const int c = tid & 255, tl0 = (tid >> 8) * 32, w = 2 << (c >> 6);
          float sum = 0.f;
          for (int j = 1; j < w; ++j) sum += U[(15 + tl0 - j) * 256 + c];
          for (int tl = tl0; tl < tl0 + 32; ++tl) { const float cur = U[(15 + tl) * 256 + c]; sum += cur;
              const int cnt = min(w, s0 + tl + 1); const float pooled = sum / (float)cnt - cur;
              PA[tl * PAS + c] = f2bf(pooled); sum -= U[(15 + tl - w + 1) * 256 + c]; } }
        __syncthreads();
        const int g = wave & 3, th = wave >> 2, lr = lane & 15, lq = lane >> 4;
        f32x4 acc[2][4];
#pragma unroll
        for (int rt = 0; rt < 2; ++rt)
#pragma unroll
            for (int et = 0; et < 4; ++et) acc[rt][et] = (f32x4){0.f, 0.f, 0.f, 0.f};
#pragma unroll
        for (int ks = 0; ks < 2; ++ks) { bf16x8 af[2], bfr[4];
#pragma unroll
            for (int rt = 0; rt < 2; ++rt) af[rt] = *(const LAS bf16x8*)(PA + (th * 32 + rt * 16 + lr) * PAS + g * 64 + ks * 32 + lq * 8);
#pragma unroll
            for (int et = 0; et < 4; ++et) bfr[et] = *(const bf16x8*)(pw + (size_t)g * 4096 + (et * 16 + lr) * 64 + ks * 32 + lq * 8);
#pragma unroll
            for (int rt = 0; rt < 2; ++rt)
#pragma unroll
                for (int et = 0; et < 4; ++et) acc[rt][et] = __builtin_amdgcn_mfma_f32_16x16x32_bf16(af[rt], bfr[et], acc[rt][et], 0, 0, 0); }
#pragma unroll
        for (int et = 0; et < 4; ++et) { const float sc = psc[g * 64 + et * 16 + lr];
#pragma unroll
            for (int rt = 0; rt < 2; ++rt) acc[rt][et] = acc[rt][et] * sc; }
#pragma unroll
        for (int rt = 0; rt < 2; ++rt)
#pragma unroll
            for (int reg = 0; reg < 4; ++reg) { float s = 0.f;
#pragma unroll
                for (int et = 0; et < 4; ++et) s += acc[rt][et][reg] * acc[rt][et][reg];
                s += __shfl_xor(s, 1); s += __shfl_xor(s, 2); s += __shfl_xor(s, 4); s += __shfl_xor(s, 8);
                if (lr == 0) SS[(th * 32 + rt * 16 + lq * 4 + reg) * 4 + g] = s; }
        __syncthreads();
#pragma unroll
        for (int rt = 0; rt < 2; ++rt)
#pragma unroll
            for (int reg = 0; reg < 4; ++reg) { const int tl = th * 32 + rt * 16 + lq * 4 + reg; const LAS float* sp = SS + tl * 4;
                const float rs = __builtin_amdgcn_rsqf(((sp[0] + sp[1]) + (sp[2] + sp[3])) * (1.0f / 256.0f) + EPS);
#pragma unroll
                for (int et = 0; et < 4; ++et) mix[(size_t)(t0 + tl) * DM + g * 64 + et * 16 + lr] = f2bf(acc[rt][et][reg] * rs); }
    }
}

__device__ __forceinline__ void phase_lru_a(ArgsRef a, LAS unsigned char* lds, int layer, int wv) {
    const int tid = tid_from(wv), lane = tid & 63, wave = __builtin_amdgcn_readfirstlane(tid >> 6);
    const bf16* proj = (const bf16*)(a.ws + WS_PROJ);
    const bf16* wa = (const bf16*)(a.ws + WS_SMALL) + SM_WA + (size_t)layer * 4 * 4096;
    const bf16* wx = (const bf16*)(a.ws + WS_SMALL) + SM_WX + (size_t)layer * 4 * 4096;
    bf16* HL = (bf16*)(a.ws + WS_HL); bf16* PL = (bf16*)(a.ws + WS_PL);
    float* AGGH = (float*)(a.ws + WS_AGGH); float* AGGP = (float*)(a.ws + WS_AGGP);
    LAS float* U = (LAS float*)lds;
    LAS bf16* XC = (LAS bf16*)(lds + 36864);
    LAS float* XF = (LAS float*)(lds + 54272);
    LAS float* AA = (LAS float*)(lds + 87040);
    constexpr int XS = 264;
    const int c = tid & 255;
    const float cw0 = a.in[I_CONVW][(layer * 4 + 0) * 256 + c], cw1 = a.in[I_CONVW][(layer * 4 + 1) * 256 + c], cw2 = a.in[I_CONVW][(layer * 4 + 2) * 256 + c], cw3 = a.in[I_CONVW][(layer * 4 + 3) * 256 + c];
    const float cb = a.in[I_CONVB][layer * 256 + c];
    for (int unit = blockIdx.x; unit < NT / LRU_CH; unit += gridDim.x) {
        const int t0 = unit * LRU_CH, s0 = t0 & (SEQ - 1);
        __syncthreads();
        for (int ch = tid; ch < 35 * 32; ch += NTHR) { const int r = ch >> 5, c8 = (ch & 31) * 8; const int srow = s0 - 3 + r;
            f32x4 lo = {0.f, 0.f, 0.f, 0.f}, hi = {0.f, 0.f, 0.f, 0.f};
            if (srow >= 0) { const u32x4 w = *(const u32x4*)(proj + (size_t)(t0 - 3 + r) * NIN + C_LRU + c8); lo = (f32x4){bflo(w.x), bfhi(w.x), bflo(w.y), bfhi(w.y)}; hi = (f32x4){bflo(w.z), bfhi(w.z), bflo(w.w), bfhi(w.w)}; }
            *(LAS f32x4*)(U + r * 256 + c8) = lo; *(LAS f32x4*)(U + r * 256 + c8 + 4) = hi; }
        __syncthreads();
        { const int tl0 = (tid >> 8) * 16;
          for (int tl = tl0; tl < tl0 + 16; ++tl) { const float xc = cb + cw0 * U[(tl + 0) * 256 + c] + cw1 * U[(tl + 1) * 256 + c] + cw2 * U[(tl + 2) * 256 + c] + cw3 * U[(tl + 3) * 256 + c];
              XF[tl * 256 + c] = xc; XC[tl * XS + c] = f2bf(xc); } }
        __syncthreads();
        { const int n = wave & 3, eh = wave >> 2, lr = lane & 15, lq = lane >> 4;
          f32x4 ca[2][2], cx[2][2];
#pragma unroll
          for (int rt = 0; rt < 2; ++rt)
#pragma unroll
              for (int et = 0; et < 2; ++et) { ca[rt][et] = (f32x4){0.f, 0.f, 0.f, 0.f}; cx[rt][et] = (f32x4){0.f, 0.f, 0.f, 0.f}; }
#pragma unroll
          for (int ks = 0; ks < 2; ++ks) { bf16x8 af[2], ba[2], bx[2];
#pragma unroll
              for (int rt = 0; rt < 2; ++rt) af[rt] = *(const LAS bf16x8*)(XC + (rt * 16 + lr) * XS + n * 64 + ks * 32 + lq * 8);
#pragma unroll
              for (int et = 0; et < 2; ++et) { const size_t wo = (size_t)n * 4096 + (eh * 32 + et * 16 + lr) * 64 + ks * 32 + lq * 8; ba[et] = *(const bf16x8*)(wa + wo); bx[et] = *(const bf16x8*)(wx + wo); }
#pragma unroll
              for (int rt = 0; rt < 2; ++rt)
#pragma unroll
                  for (int et = 0; et < 2; ++et) { ca[rt][et] = __builtin_amdgcn_mfma_f32_16x16x32_bf16(af[rt], ba[et], ca[rt][et], 0, 0, 0);
                                                   cx[rt][et] = __builtin_amdgcn_mfma_f32_16x16x32_bf16(af[rt], bx[et], cx[rt][et], 0, 0, 0); } }
#pragma unroll
          for (int et = 0; et < 2; ++et) { const int chn = n * 64 + eh * 32 + et * 16 + lr;
              const float bav = a.in[I_BA][layer * 256 + chn], bxv = a.in[I_BX][layer * 256 + chn], lam = a.in[I_LAM][layer * 256 + chn];
              const float sp = log1pf(expf(-lam));
#pragma unroll
              for (int rt = 0; rt < 2; ++rt)
#pragma unroll
                  for (int reg = 0; reg < 4; ++reg) { const int tl = rt * 16 + lq * 4 + reg;
                      const float r = fast_sigmoid(ca[rt][et][reg] + bav), ig = fast_sigmoid(cx[rt][et][reg] + bxv);
                      const float log_a = -8.0f * r * sp; const float av = fast_exp(log_a);
                      float mult = sqrtf(fmaxf(1.0f - fast_exp(2.0f * log_a), 0.f)); if (s0 + tl == 0) mult = 1.0f;
                      const float xc = XF[tl * 256 + chn];
                      AA[tl * 256 + chn] = av; XF[tl * 256 + chn] = mult * ig * xc; } } }
        __syncthreads();
        if (tid < 256) { float h = 0.f, P = 1.f;
            for (int tl = 0; tl < LRU_CH; ++tl) { const float av = AA[tl * 256 + c], bv = XF[tl * 256 + c]; h = av * h + bv; P *= av;
                HL[(size_t)(t0 + tl) * 256 + c] = f2bf(h); PL[(size_t)(t0 + tl) * 256 + c] = f2bf(P); }
            AGGH[(size_t)unit * 256 + c] = h; AGGP[(size_t)unit * 256 + c] = P; }
    }
}
__device__ __forceinline__ void phase_lru_b(ArgsRef a, int wv) {
    const float* __restrict__ AGGH = (const float*)(a.ws + WS_AGGH); const float* __restrict__ AGGP = (const float*)(a.ws + WS_AGGP); float* __restrict__ CARRY = (float*)(a.ws + WS_CARRY);
    const int tid_ = tid_from(wv);
    for (int idx = blockIdx.x * NTHR + tid_; idx < NB * 256; idx += gridDim.x * NTHR) { const int b = idx >> 8, c = idx & 255; float carry = 0.f;
        for (int k0 = 0; k0 < LRU_NCH; k0 += 16) { float pp[16], hh[16];
#pragma unroll
            for (int k = 0; k < 16; ++k) { const size_t o = (size_t)(b * LRU_NCH + k0 + k) * 256 + c; pp[k] = AGGP[o]; hh[k] = AGGH[o]; }
#pragma unroll
            for (int k = 0; k < 16; ++k) { const size_t o = (size_t)(b * LRU_NCH + k0 + k) * 256 + c; CARRY[o] = carry; carry = pp[k] * carry + hh[k]; } } }
}
__device__ __forceinline__ void phase_lru_c(ArgsRef a, int wv) {
    const int tid = tid_from(wv), lane = tid & 63, wave = tid >> 6;
    const int gw = blockIdx.x * NWAVES + wave, NGW = gridDim.x * NWAVES;
    const bf16* proj = (const bf16*)(a.ws + WS_PROJ); bf16* mix = (bf16*)(a.ws + WS_MIX);
    const bf16* HL = (const bf16*)(a.ws + WS_HL); const bf16* PL = (const bf16*)(a.ws + WS_PL); const float* CARRY = (const float*)(a.ws + WS_CARRY);
    for (int t = gw; t < NT; t += NGW) {
        const u32x2 hw = *(const u32x2*)(HL + (size_t)t * 256 + lane * 4), pw = *(const u32x2*)(PL + (size_t)t * 256 + lane * 4), gwd = *(const u32x2*)(proj + (size_t)t * NIN + C_GATE + lane * 4);
        const f32x4 cr = *(const f32x4*)(CARRY + (size_t)(t / LRU_CH) * 256 + lane * 4);
        float h[4] = {bflo(hw.x) + bflo(pw.x) * cr[0], bfhi(hw.x) + bfhi(pw.x) * cr[1], bflo(hw.y) + bflo(pw.y) * cr[2], bfhi(hw.y) + bfhi(pw.y) * cr[3]};
        const float gt[4] = {bflo(gwd.x), bfhi(gwd.x), bflo(gwd.y), bfhi(gwd.y)};
        float s = 0.f;
#pragma unroll
        for (int j = 0; j < 4; ++j) { h[j] *= gelu_tanh(gt[j]); s += h[j] * h[j]; }
        s = wave_sum(s); const float rs = __builtin_amdgcn_rsqf(s * (1.0f / 256.0f) + EPS);
        u32x2 o; o.x = cvt_pk_bf16(h[0] * rs, h[1] * rs); o.y = cvt_pk_bf16(h[2] * rs, h[3] * rs);
        *(u32x2*)(mix + (size_t)t * DM + 256 + lane * 4) = o;
    }
}

typedef short v4i16_t __attribute__((ext_vector_type(4)));
struct AttnUnit { int h, n, r, dl; size_t rowb; int g; };
__device__ __forceinline__ AttnUnit attn_decode(int unit) {
    AttnUnit u; const int blk = unit & 31; u.g = (unit >> 5) % 3; u.h = (unit / 96) & 7; const int b = unit / 768;
    u.dl = (u.g == 0) ? 1 : (u.g == 1 ? 4 : 16); const int nb = 32 / u.dl; u.n = blk % nb; u.r = blk / nb; u.rowb = (size_t)b * SEQ; return u;
}
__device__ __forceinline__ void attn_dma(const __amdgpu_buffer_rsrc_t rs, LAS unsigned char* lds, const AttnUnit& u, int buf, int wave, int lane) {
    const int kr0 = 8 * wave + (lane >> 3), csc = (lane & 7) ^ ((lane >> 3) & 7);
#pragma unroll
    for (int q = 0; q < 4; ++q) { const int keyrow = kr0 + 64 * q; int l = 128 * (u.n - 1) + keyrow; l = l < 0 ? 0 : l;
        const unsigned rowoff = (unsigned)((u.rowb + (size_t)l * u.dl + u.r) * NIN * 2);
        const unsigned srcK = rowoff + (unsigned)((C_K + (u.h >> 2) * 256 + (u.h & 3) * 32) * 2) + (unsigned)((csc >> 2) * 256 + (csc & 3) * 16);
        const unsigned srcV = rowoff + (unsigned)((C_V + u.h * 64) * 2) + (unsigned)(csc * 16);
        LAS unsigned char* dst = lds + buf * 65536 + (wave + 8 * q) * 1024;
        __builtin_amdgcn_raw_ptr_buffer_load_lds(rs, (LAS void*)dst, 16, srcK, 0, 0, 0);
        __builtin_amdgcn_raw_ptr_buffer_load_lds(rs, (LAS void*)(dst + 32768), 16, srcV, 0, 0, 0); }
}
__device__ __forceinline__ void phase_attn(ArgsRef a, LAS unsigned char* lds, int wv) {
    const int tid = tid_from(wv), lane = tid & 63, wave = __builtin_amdgcn_readfirstlane(tid >> 6);
    const bf16* proj = (const bf16*)(a.ws + WS_PROJ);
    bf16* PNUM = (bf16*)(a.ws + WS_PNUM); float* PDEN = (float*)(a.ws + WS_PDEN); float* PMAX = (float*)(a.ws + WS_PMAX);
    const __amdgpu_buffer_rsrc_t rs = __builtin_amdgcn_make_buffer_rsrc((void*)proj, 0, 0x7fffffff, 0x00020000);
    const int lr = lane & 15, lq = lane >> 4, qi0 = 16 * wave, G = gridDim.x;
    constexpr int NUNITS = NB * 8 * 3 * 32;
    const int kro = (qi0 + lr) * 128, kc0 = ((0 + lq) ^ (lr & 7)) * 16, kc1 = ((4 + lq) ^ (lr & 7)) * 16;
    const int q4 = (lane & 15) >> 2, p4 = lane & 3, vrow = qi0 + 4 * lq + q4, vsw = (4 * lq + q4) & 7;
    __syncthreads();
    const bool xo = (G == 256); const int xcd = blockIdx.x & 7, jx = blockIdx.x >> 3;
#define ATT_UNIT(i) (xo ? ((xcd * 16 + (i) / 3) * 96 + ((i) % 3) * 32 + jx) : ((int)blockIdx.x + (i) * G))
    int it = 0; int unit = ATT_UNIT(0);
    AttnUnit cu = attn_decode(unit < NUNITS ? unit : 0);
    bf16x8 qf0, qf1;
    if (unit < NUNITS) { attn_dma(rs, lds, cu, 0, wave, lane);
        const size_t qrow = cu.rowb + (size_t)(128 * cu.n + qi0 + lr) * cu.dl + cu.r;
        const int qc = C_Q + (cu.h >> 2) * 256 + (cu.h & 3) * 32 + lq * 8; qf0 = *(const bf16x8*)(proj + qrow * NIN + qc); qf1 = *(const bf16x8*)(proj + qrow * NIN + qc + 128); }
    int buf = 0;
    asm volatile("s_waitcnt vmcnt(0)" ::: "memory");
    while (unit < NUNITS) {
        asm volatile("s_waitcnt vmcnt(4)" ::: "memory"); __builtin_amdgcn_s_barrier(); asm volatile("" ::: "memory");
        ++it; const int nunit = (xo && it >= 48) ? NUNITS : ATT_UNIT(it); AttnUnit nu = attn_decode(nunit < NUNITS ? nunit : 0); bf16x8 nq0 = qf0, nq1 = qf1;
        if (nunit < NUNITS) { attn_dma(rs, lds, nu, buf ^ 1, wave, lane);
            const size_t qrow = nu.rowb + (size_t)(128 * nu.n + qi0 + lr) * nu.dl + nu.r;
            const int qc = C_Q + (nu.h >> 2) * 256 + (nu.h & 3) * 32 + lq * 8; nq0 = *(const bf16x8*)(proj + qrow * NIN + qc); nq1 = *(const bf16x8*)(proj + qrow * NIN + qc + 128); }
        const LAS unsigned char* Kb = lds + buf * 65536; const LAS unsigned char* Vb = Kb + 32768;
        f32x4 sc[9];
#pragma unroll
        for (int t = 0; t < 9; ++t) { const bf16x8 k0 = *(const LAS bf16x8*)(Kb + kro + t * 2048 + kc0), k1 = *(const LAS bf16x8*)(Kb + kro + t * 2048 + kc1);
            sc[t] = __builtin_amdgcn_mfma_f32_16x16x32_bf16(k0, qf0, (f32x4){0.f, 0.f, 0.f, 0.f}, 0, 0, 0);
            sc[t] = __builtin_amdgcn_mfma_f32_16x16x32_bf16(k1, qf1, sc[t], 0, 0, 0); }
#pragma unroll
        for (int reg = 0; reg < 4; ++reg) { if (4 * lq + reg < lr) sc[0][reg] = -1e30f; if (4 * lq + reg > lr) sc[8][reg] = -1e30f; }
        if (cu.n == 0) {
#pragma unroll
            for (int t = 0; t < 8; ++t)
#pragma unroll
                for (int reg = 0; reg < 4; ++reg) { if (qi0 + 16 * t + 4 * lq + reg < 128) sc[t][reg] = -1e30f; } }
        float mx = -1e30f;
#pragma unroll
        for (int t = 0; t < 9; ++t)
#pragma unroll
            for (int reg = 0; reg < 4; ++reg) mx = fmaxf(mx, sc[t][reg]);
        mx = fmaxf(mx, __shfl_xor(mx, 16)); mx = fmaxf(mx, __shfl_xor(mx, 32));
        float sm = 0.f;
#pragma unroll
        for (int t = 0; t < 9; ++t)
#pragma unroll
            for (int reg = 0; reg < 4; ++reg) { const float pe = __builtin_amdgcn_exp2f(sc[t][reg] - mx); sm += pe; sc[t][reg] = pe; }
        sm += __shfl_xor(sm, 16); sm += __shfl_xor(sm, 32);
        f32x4 oc[4];
#pragma unroll
        for (int dt = 0; dt < 4; ++dt) oc[dt] = (f32x4){0.f, 0.f, 0.f, 0.f};
#pragma unroll
        for (int pi = 0; pi < 5; ++pi) { const int t0 = 2 * pi, t1 = (2 * pi + 1 < 9) ? 2 * pi + 1 : 8;
            u32x4 pw; pw.x = cvt_pk_bf16(sc[t0][0], sc[t0][1]); pw.y = cvt_pk_bf16(sc[t0][2], sc[t0][3]);
            if (2 * pi + 1 < 9) { pw.z = cvt_pk_bf16(sc[t1][0], sc[t1][1]); pw.w = cvt_pk_bf16(sc[t1][2], sc[t1][3]); } else { pw.z = 0u; pw.w = 0u; }
            const bf16x8 pf = __builtin_bit_cast(bf16x8, pw);
#pragma unroll
            for (int dt = 0; dt < 4; ++dt) { const int ch = ((2 * dt + (p4 >> 1)) ^ vsw) * 16 + (p4 & 1) * 8;
                const v4i16_t v0 = __builtin_amdgcn_ds_read_tr16_b64_v4i16((LAS v4i16_t*)(Vb + (vrow + 16 * t0) * 128 + ch));
                const v4i16_t v1 = __builtin_amdgcn_ds_read_tr16_b64_v4i16((LAS v4i16_t*)(Vb + (vrow + 16 * t1) * 128 + ch));
                const bf16x8 vf = (bf16x8){v0[0], v0[1], v0[2], v0[3], v1[0], v1[1], v1[2], v1[3]};
                oc[dt] = __builtin_amdgcn_mfma_f32_16x16x32_bf16(pf, vf, oc[dt], 0, 0, 0); } }
        { LAS bf16* stg = (LAS bf16*)(lds + OST_OFF + wave * 2048);
#pragma unroll
          for (int reg = 0; reg < 4; ++reg)
#pragma unroll
              for (int dt = 0; dt < 4; ++dt) stg[(4 * lq + reg) * 64 + dt * 16 + lr] = f2bf(oc[dt][reg]);
          LDS_WAIT(); asm volatile("" ::: "memory");
#pragma unroll
          for (int i = 0; i < 2; ++i) { const int qq = i * 8 + (lane >> 3), c8 = (lane & 7) * 8; const u32x4 w = *(const LAS u32x4*)(stg + qq * 64 + c8);
              const size_t tok = cu.rowb + (size_t)(128 * cu.n + qi0 + qq) * cu.dl + cu.r;
              *(u32x4*)(PNUM + ((size_t)cu.g * NT + tok) * 512 + cu.h * 64 + c8) = w; }
          LDS_WAIT(); asm volatile("" ::: "memory"); }
        if (lq == 0) { const size_t tok = cu.rowb + (size_t)(128 * cu.n + qi0 + lr) * cu.dl + cu.r; PDEN[((size_t)cu.g * NT + tok) * 8 + cu.h] = sm; PMAX[((size_t)cu.g * NT + tok) * 8 + cu.h] = mx; }
        cu = nu; qf0 = nq0; qf1 = nq1; buf ^= 1; unit = nunit;
    }
#undef ATT_UNIT
}
__device__ __forceinline__ void phase_merge(ArgsRef a, int wv) {
    const int tid = tid_from(wv), lane = tid & 63, wave = tid >> 6;
    const int gw = blockIdx.x * NWAVES + wave, NGW = gridDim.x * NWAVES;
    const bf16* PNUM = (const bf16*)(a.ws + WS_PNUM); const float* PDEN = (const float*)(a.ws + WS_PDEN); const float* PMAX = (const float*)(a.ws + WS_PMAX);
    bf16* mix = (bf16*)(a.ws + WS_MIX);
    const int hd = lane >> 3;
    for (int t = gw; t < NT; t += NGW) {
        float m[3], dn[3]; u32x4 nw[3];
#pragma unroll
        for (int g = 0; g < 3; ++g) { m[g] = PMAX[((size_t)g * NT + t) * 8 + hd]; dn[g] = PDEN[((size_t)g * NT + t) * 8 + hd]; nw[g] = *(const u32x4*)(PNUM + ((size_t)g * NT + t) * 512 + lane * 8); }
        const float mr = fmaxf(fmaxf(m[0], m[1]), m[2]);
        float o[8] = {0.f, 0.f, 0.f, 0.f, 0.f, 0.f, 0.f, 0.f}; float den = 0.f;
#pragma unroll
        for (int g = 0; g < 3; ++g) { const float w = __builtin_amdgcn_exp2f(m[g] - mr); den += w * dn[g];
            o[0] += w * bflo(nw[g].x); o[1] += w * bfhi(nw[g].x); o[2] += w * bflo(nw[g].y); o[3] += w * bfhi(nw[g].y); o[4] += w * bflo(nw[g].z); o[5] += w * bfhi(nw[g].z); o[6] += w * bflo(nw[g].w); o[7] += w * bfhi(nw[g].w); }
        const float inv = 1.0f / den; float s = 0.f;
#pragma unroll
        for (int j = 0; j < 8; ++j) { o[j] *= inv; s += o[j] * o[j]; }
        s = wave_sum(s); const float rs = __builtin_amdgcn_rsqf(s * (1.0f / 512.0f) + EPS);
        u32x4 w; w.x = cvt_pk_bf16(o[0] * rs, o[1] * rs); w.y = cvt_pk_bf16(o[2] * rs, o[3] * rs); w.z = cvt_pk_bf16(o[4] * rs, o[5] * rs); w.w = cvt_pk_bf16(o[6] * rs, o[7] * rs);
        *(u32x4*)(mix + (size_t)t * DM + 512 + lane * 8) = w;
    }
}

__device__ __forceinline__ void phase_router(ArgsRef a, LAS unsigned char* lds, int layer, int wv, bool alloc) {
    const int tid = tid_from(wv), lane = tid & 63, wave = __builtin_amdgcn_readfirstlane(tid >> 6);
    const bf16* xb = (const bf16*)(a.ws + WS_XB); const bf16* wr = (const bf16*)(a.ws + WS_SMALL) + SM_WR + (size_t)layer * NEXP * DM;
    const float* ssqp = (const float*)(a.ws + WS_SSQP); const float* rbias = a.in[I_BR] + layer * NEXP;
    int* LIST = (int*)(a.ws + WS_LIST); float* LRSTD = (float*)(a.ws + WS_LRSTD); float* LGATE = (float*)(a.ws + WS_LGATE2);
    unsigned* cnt = (unsigned*)(a.ws + WS_CTL) + CW_CNT + layer * NEXP;
    LAS float* LG = (LAS float*)lds + wave * 32 * 33;
    LAS int* hist = (LAS int*)(lds + 65536);
    LAS int* base = (LAS int*)(lds + 65536 + 128);
    const int lr = lane & 15, lq = lane >> 4;
    for (int unit = blockIdx.x; unit < NT / 256; unit += gridDim.x) {
        const int tok0 = unit * 256 + wave * 32;
        __syncthreads();
        if (tid < 32) hist[tid] = 0;
        f32x4 acc[2][2];
#pragma unroll
        for (int rt = 0; rt < 2; ++rt)
#pragma unroll
            for (int et = 0; et < 2; ++et) acc[rt][et] = (f32x4){0.f, 0.f, 0.f, 0.f};
#pragma unroll 4
        for (int ks = 0; ks < 32; ++ks) { bf16x8 af[2], bfr[2];
#pragma unroll
            for (int rt = 0; rt < 2; ++rt) af[rt] = *(const bf16x8*)(xb + (size_t)(tok0 + rt * 16 + lr) * DM + ks * 32 + lq * 8);
#pragma unroll
            for (int et = 0; et < 2; ++et) bfr[et] = *(const bf16x8*)(wr + (size_t)(et * 16 + lr) * DM + ks * 32 + lq * 8);
#pragma unroll
            for (int rt = 0; rt < 2; ++rt)
#pragma unroll
                for (int et = 0; et < 2; ++et) acc[rt][et] = __builtin_amdgcn_mfma_f32_16x16x32_bf16(af[rt], bfr[et], acc[rt][et], 0, 0, 0); }
#pragma unroll
        for (int rt = 0; rt < 2; ++rt)
#pragma unroll
            for (int et = 0; et < 2; ++et)
#pragma unroll
                for (int reg = 0; reg < 4; ++reg) LG[(rt * 16 + lq * 4 + reg) * 33 + et * 16 + lr] = acc[rt][et][reg];
        __syncthreads();
        int te[4] = {0, 0, 0, 0}; float tg[4] = {0.f, 0.f, 0.f, 0.f}; int rk[4] = {0, 0, 0, 0}; float rstd = 0.f; const int tok = tok0 + lane;
        if (lane < 32) {
            const float* sp = ssqp + (size_t)tok * 16; float ss = 0.f;
#pragma unroll
            for (int j = 0; j < 16; ++j) ss += sp[j];
            rstd = __builtin_amdgcn_rsqf(ss * (1.0f / DM) + EPS);
            float tv[4] = {-3e38f, -3e38f, -3e38f, -3e38f};
            for (int e = 0; e < NEXP; ++e) { float v = LG[lane * 33 + e] * rstd + rbias[e]; int ve = e;
#pragma unroll
                for (int k = 0; k < 4; ++k) { if (v > tv[k]) { const float tvv = tv[k]; const int tee = te[k]; tv[k] = v; te[k] = ve; v = tvv; ve = tee; } } }
            float z = 0.f;
#pragma unroll
            for (int k = 0; k < 4; ++k) { tg[k] = fast_exp(tv[k] - tv[0]); z += tg[k]; }
            const float iz = 1.0f / z;
#pragma unroll
            for (int k = 0; k < 4; ++k) { tg[k] *= iz; rk[k] = __hip_atomic_fetch_add(&hist[te[k]], 1, __ATOMIC_RELAXED, __HIP_MEMORY_SCOPE_WORKGROUP); }
        }
        __syncthreads();
        if (tid < 32) base[tid] = alloc ? (int)__hip_atomic_fetch_add(cnt + tid, (unsigned)hist[tid], RLX_AGENT) : 0;
        __syncthreads();
        if (lane < 32 && alloc) {
#pragma unroll
            for (int k = 0; k < 4; ++k) { const size_t p = (size_t)te[k] * NT + base[te[k]] + rk[k]; LIST[p] = tok * 4 + k; LRSTD[p] = rstd; LGATE[p] = tg[k]; }
        }
    }
}

__device__ __forceinline__ void phase_combine(ArgsRef a, bool last_layer, int wv, bool dry) {
    const int tid = tid_from(wv), lane = tid & 63, wave = tid >> 6;
    const int gw = blockIdx.x * NWAVES + wave, NGW = gridDim.x * NWAVES;
    const unsigned char* __restrict__ Y = (const unsigned char*)(a.ws + WS_Y); float* __restrict__ out = a.out; bf16* xb = (bf16*)(a.ws + WS_XB); float* __restrict__ ssq = (float*)(a.ws + WS_SSQ);
    typedef float f2v __attribute__((ext_vector_type(2)));
    for (int t = gw; t < NT; t += NGW) {
        const u32x4 x0 = *((const u32x4*)(xb + (size_t)t * DM) + 2 * lane), x1 = *((const u32x4*)(xb + (size_t)t * DM) + 2 * lane + 1);
        u32x4 y[4];
#pragma unroll
        for (int k = 0; k < 4; ++k) y[k] = *((const u32x4*)(Y + ((size_t)t * 4 + k) * DM) + lane);
        float v[16];
        v[0] = bflo(x0.x); v[1] = bfhi(x0.x); v[2] = bflo(x0.y); v[3] = bfhi(x0.y); v[4] = bflo(x0.z); v[5] = bfhi(x0.z); v[6] = bflo(x0.w); v[7] = bfhi(x0.w);
        v[8] = bflo(x1.x); v[9] = bfhi(x1.x); v[10] = bflo(x1.y); v[11] = bfhi(x1.y); v[12] = bflo(x1.z); v[13] = bfhi(x1.z); v[14] = bflo(x1.w); v[15] = bfhi(x1.w);
#pragma unroll
        for (int k = 0; k < 4; ++k)
#pragma unroll
            for (int d = 0; d < 4; ++d) { const int w = (int)y[k][d]; const f2v lo = __builtin_amdgcn_cvt_pk_f32_fp8(w, false), hi = __builtin_amdgcn_cvt_pk_f32_fp8(w, true);
                v[4 * d + 0] += lo.x * (1.0f / Y8_SCALE); v[4 * d + 1] += lo.y * (1.0f / Y8_SCALE); v[4 * d + 2] += hi.x * (1.0f / Y8_SCALE); v[4 * d + 3] += hi.y * (1.0f / Y8_SCALE); }
        float s = 0.f;
#pragma unroll
        for (int j = 0; j < 16; ++j) s += v[j] * v[j];
        if (dry && s != 12345.678f) continue;
        if (last_layer) {
#pragma unroll
            for (int j = 0; j < 4; ++j) *((f32x4*)(out + (size_t)t * DM) + 4 * lane + j) = (f32x4){v[4 * j], v[4 * j + 1], v[4 * j + 2], v[4 * j + 3]};
        } else { s = wave_sum(s);
            u32x4 w0, w1; w0.x = cvt_pk_bf16(v[0], v[1]); w0.y = cvt_pk_bf16(v[2], v[3]); w0.z = cvt_pk_bf16(v[4], v[5]); w0.w = cvt_pk_bf16(v[6], v[7]);
            w1.x = cvt_pk_bf16(v[8], v[9]); w1.y = cvt_pk_bf16(v[10], v[11]); w1.z = cvt_pk_bf16(v[12], v[13]); w1.w = cvt_pk_bf16(v[14], v[15]);
            *((u32x4*)(xb + (size_t)t * DM) + 2 * lane) = w0; *((u32x4*)(xb + (size_t)t * DM) + 2 * lane + 1) = w1;
            if (lane == 0) ssq[t] = s; }
    }
}

constexpr int NPH_LAYER = 13, NPH = 1 + 2 * NPH_LAYER;
enum { PH_GEMM_IN = 0, PH_QKPREP, PH_POOL, PH_LRU_A, PH_LRU_B, PH_ATTN, PH_LRU_C, PH_MERGE, PH_GEMM_OUT, PH_ROUTER, PH_MOE_GU, PH_MOE_DOWN, PH_COMBINE };
#ifndef MK_STOP
#define MK_STOP NPH
#endif
#ifndef MK_SPLIT
#define MK_SPLIT 0
#endif

template <int PHMASK>
__global__ void __launch_bounds__(NTHR, 2) mega_fwd(Args args_by_value) {
    extern __shared__ __attribute__((aligned(16))) unsigned char lds_raw[];
    LAS unsigned char* lds = (LAS unsigned char*)lds_raw;
    const int tid = threadIdx.x;
    int wv = __builtin_amdgcn_readfirstlane(tid >> 6); asm volatile("" : "+s"(wv));
    for (int u = tid; u < (LDS_BYTES - LDSCTL_OFF) / 4; u += NTHR) ((LAS unsigned*)(lds + LDSCTL_OFF))[u] = 0u;
    __syncthreads();
#define ARGS_HERE() const CAS Args* ap_ = (const CAS Args*)__builtin_amdgcn_kernarg_segment_ptr(); asm volatile("" : "+s"(ap_)); ArgsRef args = *ap_; unsigned char* const ws = args.ws; unsigned* const ctl = (unsigned*)(ws + WS_CTL); (void)ctl
    int lo, hi;
    { ARGS_HERE(); lo = args.ph_lo; hi = args.ph_hi; xcd_barrier_post(ctl + CW_BAR + args.li * XCD_BAR_WORDS, (volatile LAS unsigned*)(lds + MISC_OFF) + 8); }
#define EN(p) (((PHMASK) >> (p)) & 1)
#ifndef MK_DUP
#define MK_DUP 0
#endif
#define NREP(p) ((((MK_DUP) >> (p)) & 1) ? 2 : 1)
#define IN(k) (lo <= (k) && (k) < hi)
#define SEAM(k) do { if (IN(k) && IN((k) + 1)) { ARGS_HERE(); XcdBarrier bar_; bar_.bar = ctl + CW_BAR + args.li * XCD_BAR_WORDS; bar_.x = xb_xcc_id(); bar_.st = (volatile LAS unsigned*)(lds + MISC_OFF) + 8; xcd_barrier(bar_); } } while (0)

    if (EN(13) && IN(0)) { ARGS_HERE(); for (int rep_ = 0; rep_ < NREP(13); ++rep_) { phase_prologue(args, lds, wv); } }
    SEAM(0);
    for (int l = 0; l < 2; ++l) {
        const int pb = 1 + NPH_LAYER * l;
        if (EN(PH_GEMM_IN) && IN(pb + PH_GEMM_IN)) { ARGS_HERE();
            pg8::StaticOrder S; S.init(NT, NIN, DM, gridDim.x, blockIdx.x); S.dup = NREP(PH_GEMM_IN) - 1;
            EpiIn E{(bf16*)(ws + WS_PROJ), (const float*)(ws + WS_SSQ), args.in[I_QG] + l * 64, args.in[I_KG] + l * 64, (const float*)(ws + WS_ROPE), (const float*)(ws + WS_ROPE) + SEQ * 32};
            pg8::gemm_phase<EpiIn, pg8::StaticOrder, true>(lds, (const bf16*)(ws + WS_XB), (const bf16*)(ws + WS_WIN) + (size_t)l * NIN * DM, DM, S, E, wv);
        }
        SEAM(pb + PH_GEMM_IN);
        if (EN(PH_POOL) && IN(pb + PH_POOL)) { ARGS_HERE(); for (int rep_ = 0; rep_ < NREP(PH_POOL); ++rep_) { phase_pool(args, lds, l, wv); } }
        if (EN(PH_LRU_A) && IN(pb + PH_LRU_A)) { ARGS_HERE(); for (int rep_ = 0; rep_ < NREP(PH_LRU_A); ++rep_) { phase_lru_a(args, lds, l, wv); } }
        SEAM(pb + PH_LRU_A);
        if (EN(PH_LRU_B) && IN(pb + PH_LRU_B)) { ARGS_HERE(); for (int rep_ = 0; rep_ < NREP(PH_LRU_B); ++rep_) { phase_lru_b(args, wv); } }
        if (EN(PH_ATTN) && IN(pb + PH_ATTN)) { ARGS_HERE(); for (int rep_ = 0; rep_ < NREP(PH_ATTN); ++rep_) { phase_attn(args, lds, wv); } }
        SEAM(pb + PH_ATTN);
        if (EN(PH_LRU_C) && IN(pb + PH_LRU_C)) { ARGS_HERE(); for (int rep_ = 0; rep_ < NREP(PH_LRU_C); ++rep_) { phase_lru_c(args, wv); } }
        if (EN(PH_MERGE) && IN(pb + PH_MERGE)) { ARGS_HERE(); for (int rep_ = 0; rep_ < NREP(PH_MERGE); ++rep_) { phase_merge(args, wv); } }
        SEAM(pb + PH_MERGE);
        if (EN(PH_GEMM_OUT) && IN(pb + PH_GEMM_OUT)) { ARGS_HERE();
            __syncthreads();
            pg8::StaticOrder S; S.init(NT, DM, DM, gridDim.x, blockIdx.x); S.dup = (l == 0) ? NREP(PH_GEMM_OUT) - 1 : 0;
            EpiOut E{(bf16*)(ws + WS_XB), (float*)(ws + WS_SSQP)};
            pg8::gemm_phase<EpiOut, pg8::StaticOrder, true>(lds, (const bf16*)(ws + WS_MIX), (const bf16*)(ws + WS_WOUT) + (size_t)l * DM * DM, DM, S, E, wv);
        }
        SEAM(pb + PH_GEMM_OUT);
        if (EN(PH_ROUTER) && IN(pb + PH_ROUTER)) { ARGS_HERE(); for (int rep_ = 0; rep_ < NREP(PH_ROUTER); ++rep_) { phase_router(args, lds, l, wv, rep_ == NREP(PH_ROUTER) - 1); } }
        SEAM(pb + PH_ROUTER);
        if (EN(PH_MOE_GU) && IN(pb + PH_MOE_GU)) { ARGS_HERE();
            LAS int* tab = (LAS int*)(lds + TAB_OFF);
            moe_tables(tab, ctl + CW_CNT + l * NEXP, wv);
            MoeOrder<0> S{tab, 2, (int)gridDim.x, (int)blockIdx.x, (const int*)(ws + WS_LIST), NREP(PH_MOE_GU) - 1};
            EpiGU E{(bf16*)(ws + WS_ACT), (const float*)(ws + WS_LRSTD), args.in[I_BGU] + (size_t)l * NEXP * 512};
            pg8::gemm_phase<EpiGU, MoeOrder<0>, true>(lds, (const bf16*)(ws + WS_XB), (const bf16*)(ws + WS_WGU) + (size_t)l * NEXP * 512 * DM, DM, S, E, wv);
        }
        SEAM(pb + PH_MOE_GU);
        if (EN(PH_MOE_DOWN) && IN(pb + PH_MOE_DOWN)) { ARGS_HERE();
            LAS int* tab = (LAS int*)(lds + TAB_OFF);
            moe_tables(tab, ctl + CW_CNT + l * NEXP, wv);
            MoeOrder<1> S{tab, 4, (int)gridDim.x, (int)blockIdx.x, (const int*)(ws + WS_LIST), NREP(PH_MOE_DOWN) - 1};
            EpiDown E{(unsigned char*)(ws + WS_Y), (const int*)(ws + WS_LIST), (const float*)(ws + WS_LGATE2), args.in[I_BD] + (size_t)l * NEXP * DM, tab};
            pg8::gemm_phase<EpiDown, MoeOrder<1>, true>(lds, (const bf16*)(ws + WS_ACT), (const bf16*)(ws + WS_WD) + (size_t)l * NEXP * DM * EFF, EFF, S, E, wv);
        }
        SEAM(pb + PH_MOE_DOWN);
        if (EN(PH_COMBINE) && IN(pb + PH_COMBINE)) { ARGS_HERE(); for (int rep_ = 0; rep_ < NREP(PH_COMBINE); ++rep_) { phase_combine(args, l == 1, wv, rep_ < NREP(PH_COMBINE) - 1); } }
        SEAM(pb + PH_COMBINE);
    }
#undef IN
#undef SEAM
}

typedef void (*kern_t)(Args);
template <int M> static kern_t kern_of() { return (kern_t)mega_fwd<M>; }
static kern_t phase_kernel(int p) {
    switch (p) { case 0: return kern_of<1 << 0>(); case 1: return kern_of<1 << 1>(); case 2: return kern_of<1 << 2>(); case 3: return kern_of<1 << 3>(); case 4: return kern_of<1 << 4>();
                 case 5: return kern_of<1 << 5>(); case 6: return kern_of<1 << 6>(); case 7: return kern_of<1 << 7>(); case 8: return kern_of<1 << 8>(); case 9: return kern_of<1 << 9>();
                 case 10: return kern_of<1 << 10>(); case 11: return kern_of<1 << 11>(); case 12: return kern_of<1 << 12>(); default: return kern_of<1 << 13>(); }
}
extern "C" void kernel_launch(void* const* d_in, const int* in_sizes, int n_in, void* d_out, int out_size, void* d_ws, size_t ws_size, hipStream_t stream) {
    static int grid = 0;
    if (grid == 0) {
        if (n_in != 23 || in_sizes[0] != NT * DM || out_size != NT * DM || ws_size < WS_END) {
            fprintf(stderr, "kernel_launch: built for 23 inputs, x/out of %d floats, >= %zu bytes of workspace; got n_in %d, in0 %d, out %d, ws %zu; nothing launched\n", NT * DM, (size_t)WS_END, n_in, n_in > 0 ? in_sizes[0] : -1, out_size, ws_size);
            grid = -1; return; }
        int dev = 0, cus = 0;
        if (hipGetDevice(&dev) != hipSuccess || hipDeviceGetAttribute(&cus, hipDeviceAttributeMultiprocessorCount, dev) != hipSuccess) { fprintf(stderr, "kernel_launch: device query failed\n"); grid = -1; return; }
#if MK_SPLIT
        for (int p = 0; p < 14; ++p) if (hipFuncSetAttribute((const void*)phase_kernel(p), hipFuncAttributeMaxDynamicSharedMemorySize, LDS_BYTES) != hipSuccess) { fprintf(stderr, "kernel_launch: hipFuncSetAttribute failed\n"); grid = -1; return; }
#else
        if (hipFuncSetAttribute((const void*)kern_of<0x3fff>(), hipFuncAttributeMaxDynamicSharedMemorySize, LDS_BYTES) != hipSuccess) { fprintf(stderr, "kernel_launch: hipFuncSetAttribute failed\n"); grid = -1; return; }
        int per_cu = 0;
        if (hipOccupancyMaxActiveBlocksPerMultiprocessor(&per_cu, (const void*)kern_of<0x3fff>(), NTHR, LDS_BYTES) != hipSuccess || per_cu < 1)
            fprintf(stderr, "kernel_launch: note: occupancy query reports %d workgroups per CU\n", per_cu);
#endif
        (void)hipGetLastError();
        grid = cus;
    }
    if (grid < 0) return;
    if (hipMemsetAsync((char*)d_ws + WS_CTL, 0, CTL_ZERO_BYTES, stream) != hipSuccess) { fprintf(stderr, "kernel_launch: hipMemsetAsync failed\n"); return; }
    Args a{};
    for (int i = 0; i < 23; ++i) a.in[i] = (const float*)d_in[i];
    a.out = (float*)d_out; a.ws = (unsigned char*)d_ws; a.pad = 0;
#if MK_SPLIT
#ifdef MK_SKIP
    (void)hipMemsetAsync((char*)d_ws + WS_MIX, 0, (size_t)NT * DM * 2, stream);
#endif
    for (int p = 0; p < MK_STOP; ++p) { a.ph_lo = p; a.ph_hi = p + 1; a.li = p;
#ifdef MK_SKIP
        if (p >= 1 && (((MK_SKIP) >> ((p - 1) % NPH_LAYER)) & 1)) continue;
#endif
        hipLaunchKernelGGL(phase_kernel(p == 0 ? 13 : (p - 1) % NPH_LAYER), dim3(grid), dim3(NTHR), LDS_BYTES, stream, a); }
#else
    a.ph_lo = 0; a.ph_hi = NPH; a.li = 0;
    hipLaunchKernelGGL(kern_of<0x3fff>(), dim3(grid), dim3(NTHR), LDS_BYTES, stream, a);
#endif
    const hipError_t le = hipPeekAtLastError();
    if (le != hipSuccess) fprintf(stderr, "kernel_launch: launch failed: %s\n", hipGetErrorName(le));
}
```

```cpp
#include <hip/hip_runtime.h>
#include <cstdio>
#include <cstdint>

#define LAS __attribute__((address_space(3)))
#define GAS __attribute__((address_space(1)))
typedef unsigned short bf16;
typedef short bf16x8 __attribute__((ext_vector_type(8)));
typedef float f32x4 __attribute__((ext_vector_type(4)));
typedef float f32x2 __attribute__((ext_vector_type(2)));
typedef unsigned u32x4 __attribute__((ext_vector_type(4)));
typedef unsigned u32x2 __attribute__((ext_vector_type(2)));

#ifndef MK_VAR
#define MK_VAR 0
#endif
constexpr int NB = 16, SEQ = 4096, DM = 1024, NT = NB * SEQ;
constexpr int NIN = 2304;
constexpr int C_POOL = 0, C_LRU = 256, C_GATE = 512, C_Q = 768, C_K = 1280, C_V = 1792;
constexpr int NEXP = 32, TOPK = 4, EFF = 256;
constexpr int NASSIGN = NT * TOPK;
constexpr int ACT_ROWS = NASSIGN + NEXP * 256;
constexpr float EPS = 1e-6f;
constexpr int NWAVES = 8, NTHR = 512;
constexpr int LRU_CH = 32, LRU_NCH = SEQ / LRU_CH;

constexpr size_t MiB = 1u << 20;
constexpr size_t WS_CTL = 0, CTL_ZERO_BYTES = 1 * MiB;
constexpr size_t WS_ROPE = 1 * MiB;
constexpr size_t WS_SMALL = 2 * MiB;
constexpr size_t WS_WIN = 4 * MiB;
constexpr size_t WS_WOUT = 13 * MiB;
constexpr size_t WS_WGU = 17 * MiB;
constexpr size_t WS_WD = 81 * MiB;
constexpr size_t WS_SSQ = 113 * MiB;
constexpr size_t WS_SSQP = 114 * MiB;
constexpr size_t WS_LIST = 118 * MiB;
constexpr size_t WS_XB = 128 * MiB;
constexpr size_t WS_R = 256 * MiB;
constexpr size_t WS_PROJ = WS_R;
constexpr size_t WS_MIX = WS_R + 288 * MiB;
constexpr size_t WS_PNUM = WS_R + 416 * MiB;
constexpr size_t WS_PDEN = WS_R + 608 * MiB;
constexpr size_t WS_PMAX = WS_R + 614 * MiB;
constexpr size_t WS_HL = WS_R + 620 * MiB;
constexpr size_t WS_PL = WS_R + 652 * MiB;
constexpr size_t WS_AGGH = WS_R + 684 * MiB;
constexpr size_t WS_AGGP = WS_R + 686 * MiB;
constexpr size_t WS_CARRY = WS_R + 688 * MiB;
constexpr size_t WS_ACT = WS_R;
constexpr size_t WS_Y = WS_R + 132 * MiB;
constexpr size_t WS_LRSTD = WS_R + 644 * MiB;
constexpr size_t WS_LGATE2 = WS_R + 652 * MiB;
constexpr size_t WS_END = 1024 * MiB;
static_assert(WS_CARRY + 2 * MiB <= WS_END && WS_LGATE2 + 8 * MiB <= WS_END, "d_ws map");
constexpr size_t SM_POOLW = 0;
constexpr size_t SM_WA = 32768;
constexpr size_t SM_WX = 65536;
constexpr size_t SM_WR = 98304;
constexpr int CW_BAR = 4096;
constexpr int CW_CNT = 1024;

constexpr int RING_BYTES = 131072;
constexpr int LDSCTL_OFF = RING_BYTES;
constexpr int MISC_OFF = LDSCTL_OFF + 320;
constexpr int TAB_OFF = LDSCTL_OFF + 1024;
constexpr int OST_OFF = RING_BYTES + 8192;
constexpr int LDS_BYTES = 163840;

typedef GAS unsigned gu32;
#define RLX_AGENT __ATOMIC_RELAXED, __HIP_MEMORY_SCOPE_AGENT
#define LDS_WAIT() asm volatile("s_waitcnt lgkmcnt(0)" ::: "memory")
#define VM_WAIT() asm volatile("s_waitcnt vmcnt(0)" ::: "memory")
typedef __bf16 bf16x2_t __attribute__((ext_vector_type(2)));
__device__ __forceinline__ unsigned cvt_pk_bf16(float lo, float hi) { const f32x2 v = {lo, hi}; const bf16x2_t b = __builtin_convertvector(v, bf16x2_t); return __builtin_bit_cast(unsigned, b); }
__device__ __forceinline__ float bflo(unsigned w) { return __uint_as_float(w << 16); }
__device__ __forceinline__ float bfhi(unsigned w) { return __uint_as_float(w & 0xffff0000u); }
__device__ __forceinline__ float bf2f(bf16 h) { return __uint_as_float((unsigned)h << 16); }
__device__ __forceinline__ bf16 f2bf(float f) { return (bf16)(cvt_pk_bf16(f, 0.f) & 0xffffu); }
__device__ __forceinline__ float wave_sum(float v) {
#pragma unroll
    for (int o = 1; o < 64; o <<= 1) v += __shfl_xor(v, o);
    return v;
}
__device__ __forceinline__ float fast_sigmoid(float x) { return __builtin_amdgcn_rcpf(1.0f + __builtin_amdgcn_exp2f(-1.4426950408889634f * x)); }
__device__ __forceinline__ float fast_exp(float x) { return __builtin_amdgcn_exp2f(1.4426950408889634f * x); }
__device__ __forceinline__ float gelu_tanh(float x) {
    const float u = 0.7978845608028654f * (x + 0.044715f * x * x * x);
    return x * fast_sigmoid(2.0f * u);
}
__device__ __forceinline__ int tid_from(int wv) { int ln; asm volatile("v_mbcnt_lo_u32_b32 %0, -1, 0\n\tv_mbcnt_hi_u32_b32 %0, -1, %0" : "=v"(ln)); return wv * 64 + ln; }
namespace pg8 {
constexpr int BM = 256, BK = 64, HALF = 128, HTB = HALF * BK * 2  , STAGE_BYTES = 8 * HTB, NXCD = 8, WGM = 8;

__host__ __device__ __forceinline__ int lds_byte(int r, int c) { const int st = (r >> 4) * 2 + (c >> 5), rr = r & 15, cc = c & 31, ob = rr * 64 + cc * 2; return st * 1024 + (ob ^ (((ob >> 9) & 1) << 5)); }
__host__ __device__ __forceinline__ void stage_rc(int b, int& R, int& C) { const int st = b / 1024, sb = b % 1024, swz = sb ^ (((sb >> 9) & 1) << 5); R = (st >> 1) * 16 + swz / 64; C = (st & 1) * 32 + (swz % 64) / 2; }
__host__ __device__ __forceinline__ int perm32(int rho) { const int n = rho >> 4, i = rho & 15; return 8 * (i >> 2) + 4 * n + (i & 3); }

struct Unit { int pm, pn, e, aux; };

template <class Epi, class Sched, bool ALIGN_EPI>
__device__ __forceinline__ void gemm_phase(LAS unsigned char* lds, const bf16* Abase, const bf16* Bbase, const int K, const Sched& S, const Epi& E, const int wv) {
    const int tid = tid_from(wv), wid = __builtin_amdgcn_readfirstlane(tid >> 6), lane = tid & 63, wr = wid >> 2, wc = wid & 3, fr = lane & 15, fq = lane >> 4;
    const int nt = K / BK;
    unsigned voffB[2];
#pragma unroll
    for (int i = 0; i < 2; ++i) { int R, C; stage_rc(tid * 16 + i * 8192, R, C); const int Rb = Epi::PERM ? ((R & ~31) + perm32(R & 31)) : R;
        voffB[i] = (unsigned)(Rb * K + C) * 2u; }
#define PG8_AVOFF(u, h, i) ([&]() { int R_, C_; stage_rc(tid * 16 + (i) * 8192, R_, C_); return S.a_voff((u), (h) * HALF + R_, C_); }())
    const unsigned kstep = (unsigned)(BK * 2);
    const unsigned hstep = (unsigned)(HALF * K * 2);
    const unsigned ldsw = (unsigned)wid * 1024u;
    const int aoff = lds_byte(wr * 64 + fr, fq * 8), boff = lds_byte(wc * 32 + fr, fq * 8);
    const __amdgpu_buffer_rsrc_t rsA = __builtin_amdgcn_make_buffer_rsrc((void*)Abase, 0, 0x7fffffff, 0x00020000);
    const __amdgpu_buffer_rsrc_t rsB = __builtin_amdgcn_make_buffer_rsrc((void*)Bbase, 0, 0x7fffffff, 0x00020000);
#define PG8_SA(b, h) (((b) * 2 + (h)) * HTB)
#define PG8_SB(b, h) ((4 + (b) * 2 + (h)) * HTB)
#define PG8_STAGE_B(bufoff, soff) do { const int so_ = __builtin_amdgcn_readfirstlane((int)(soff)); _Pragma("unroll") for (int _i = 0; _i < 2; ++_i) \
        __builtin_amdgcn_raw_ptr_buffer_load_lds(rsB, (LAS void*)(lds + (bufoff) + ldsw + _i * 8192), 16, voffB[_i], so_, 0, 0); } while (0)
#define PG8_STAGE_A(bufoff, kbytes, v0, v1) do { const int so_ = __builtin_amdgcn_readfirstlane((int)(kbytes)); \
        __builtin_amdgcn_raw_ptr_buffer_load_lds(rsA, (LAS void*)(lds + (bufoff) + ldsw), 16, (v0), so_, 0, 0); \
        __builtin_amdgcn_raw_ptr_buffer_load_lds(rsA, (LAS void*)(lds + (bufoff) + ldsw + 8192), 16, (v1), so_, 0, 0); } while (0)
#define PG8_LDA(dst, b, h) do { _Pragma("unroll") for (int m = 0; m < 4; ++m) _Pragma("unroll") for (int k = 0; k < 2; ++k) dst[m][k] = *(const LAS bf16x8*)(lds + PG8_SA(b, h) + aoff + m * 2048 + k * 1024); } while (0)
#define PG8_LDB(dst, b, h) do { _Pragma("unroll") for (int n = 0; n < 2; ++n) _Pragma("unroll") for (int k = 0; k < 2; ++k) dst[n][k] = *(const LAS bf16x8*)(lds + PG8_SB(b, h) + boff + n * 2048 + k * 1024); } while (0)
#define PG8_MMA(ai, bj, At, Bt) do { __builtin_amdgcn_s_setprio(1); _Pragma("unroll") for (int m = 0; m < 4; ++m) _Pragma("unroll") for (int n = 0; n < 2; ++n) _Pragma("unroll") for (int k = 0; k < 2; ++k) \
        acc[ai][bj][m][n] = __builtin_amdgcn_mfma_f32_16x16x32_bf16(Bt[n][k], At[m][k], acc[ai][bj][m][n], 0, 0, 0); __builtin_amdgcn_s_setprio(0); } while (0)
#define PG8_WAIT_V(n) asm volatile("s_waitcnt vmcnt(" #n ")" ::: "memory")
#define PG8_WAIT_L(n) asm volatile("s_waitcnt lgkmcnt(" #n ")" ::: "memory")
#define PG8_BAR __builtin_amdgcn_s_barrier()
#define PG8_SCHED __builtin_amdgcn_sched_barrier(0)
    Unit cur, nxt; int ui = 0;
    if (!S.next(0, cur)) return;
    f32x4 acc[2][2][4][2];
#pragma unroll
    for (int a = 0; a < 2; ++a)
#pragma unroll
        for (int b = 0; b < 2; ++b)
#pragma unroll
            for (int m = 0; m < 4; ++m)
#pragma unroll
                for (int n = 0; n < 2; ++n) acc[a][b][m][n] = (f32x4){0.f, 0.f, 0.f, 0.f};
    bf16x8 At[4][2], B0[2][2], B1[2][2];
    unsigned vc0, vc1, vc2, vc3, vn0, vn1, vn2, vn3;
    unsigned cA0, cA1, nA0, nA1;
    vc0 = PG8_AVOFF(cur, 0, 0); vc1 = PG8_AVOFF(cur, 0, 1);
    if constexpr (Sched::GATHER) { vc2 = PG8_AVOFF(cur, 1, 0); vc3 = PG8_AVOFF(cur, 1, 1); } else { vc2 = vc0; vc3 = vc1; }
    cA0 = S.a_soff(cur, 0); cA1 = S.a_soff(cur, 1);
    unsigned cB = (unsigned)S.b_off(cur);
    PG8_STAGE_B(PG8_SB(0, 0), cB); PG8_STAGE_B(PG8_SB(0, 1), cB + hstep); PG8_STAGE_A(PG8_SA(0, 0), cA0, vc0, vc1); PG8_STAGE_A(PG8_SA(0, 1), cA1, vc2, vc3);
    if (wr == 1) PG8_BAR;
    PG8_WAIT_V(2); PG8_BAR;
    PG8_STAGE_B(PG8_SB(1, 0), cB + kstep); PG8_STAGE_A(PG8_SA(1, 0), cA0 + kstep, vc0, vc1); PG8_STAGE_B(PG8_SB(1, 1), cB + hstep + kstep);
    PG8_WAIT_V(6); PG8_BAR;
    for (;;) {
#define PG8_TRIP(a1k, a2k0, a2k1, a3k0, b2, b3, w0, w1, w2, w3) do { \
              \
            PG8_LDB(B0, 0, 0); PG8_LDB(B1, 0, 1); PG8_SCHED; PG8_LDA(At, 0, 0); PG8_STAGE_A(PG8_SA(1, 1), a1k, vc2, vc3); \
            PG8_WAIT_V(8); PG8_WAIT_L(0); PG8_BAR; PG8_MMA(0, 0, At, B0); PG8_MMA(0, 1, At, B1); PG8_BAR; PG8_SCHED; \
              \
            PG8_LDA(At, 0, 1); PG8_STAGE_B(PG8_SB(0, 0), b2); PG8_STAGE_B(PG8_SB(0, 1), (b2) + hstep); PG8_STAGE_A(PG8_SA(0, 0), a2k0, w0, w1); \
            PG8_WAIT_V(8); PG8_WAIT_L(0); PG8_BAR; PG8_MMA(1, 0, At, B0); PG8_MMA(1, 1, At, B1); PG8_BAR; PG8_SCHED; \
              \
            PG8_LDB(B0, 1, 0); PG8_LDB(B1, 1, 1); PG8_SCHED; PG8_LDA(At, 1, 0); PG8_STAGE_A(PG8_SA(0, 1), a2k1, w2, w3); \
            PG8_WAIT_V(8); PG8_WAIT_L(0); PG8_BAR; PG8_MMA(0, 0, At, B0); PG8_MMA(0, 1, At, B1); PG8_BAR; PG8_SCHED; \
              \
            PG8_LDA(At, 1, 1); PG8_STAGE_B(PG8_SB(1, 0), b3); PG8_STAGE_B(PG8_SB(1, 1), (b3) + hstep); PG8_STAGE_A(PG8_SA(1, 0), a3k0, w0, w1); \
            PG8_WAIT_V(8); PG8_WAIT_L(0); PG8_BAR; PG8_MMA(1, 0, At, B0); PG8_MMA(1, 1, At, B1); PG8_BAR; PG8_SCHED; } while (0)
        for (int t = 0; t < nt - 2; t += 2) {
            const unsigned k1 = (unsigned)(t + 1) * kstep, k2 = (unsigned)(t + 2) * kstep, b2 = cB + k2, b3 = b2 + kstep;
            PG8_TRIP(cA1 + k1, cA0 + k2, cA1 + k2, cA0 + k2 + kstep, b2, b3, vc0, vc1, vc2, vc3);
        }
        const bool has_next = S.next(ui + 1, nxt);
        unsigned nB;
        if (has_next) { if constexpr (Sched::GATHER) { vn0 = PG8_AVOFF(nxt, 0, 0); vn1 = PG8_AVOFF(nxt, 0, 1); vn2 = PG8_AVOFF(nxt, 1, 0); vn3 = PG8_AVOFF(nxt, 1, 1); } else { vn0 = vc0; vn1 = vc1; vn2 = vc0; vn3 = vc1; }
                        nA0 = S.a_soff(nxt, 0); nA1 = S.a_soff(nxt, 1); nB = (unsigned)S.b_off(nxt); }
        else { vn0 = vc0; vn1 = vc1; vn2 = vc2; vn3 = vc3; nA0 = cA0; nA1 = cA1; nB = cB; }
        { const unsigned k1 = (unsigned)(nt - 1) * kstep;
          PG8_TRIP(cA1 + k1, nA0, nA1, nA0 + kstep, nB, nB + kstep, vn0, vn1, vn2, vn3); }
#undef PG8_TRIP
        if constexpr (ALIGN_EPI) { if (wr == 0) PG8_BAR; }
        E(acc, cur, wr, wc, fr, fq);
        if (!has_next) break;
#pragma unroll
        for (int a = 0; a < 2; ++a)
#pragma unroll
            for (int b = 0; b < 2; ++b)
#pragma unroll
                for (int m = 0; m < 4; ++m)
#pragma unroll
                    for (int n = 0; n < 2; ++n) acc[a][b][m][n] = (f32x4){0.f, 0.f, 0.f, 0.f};
        cur = nxt; cB = nB; cA0 = nA0; cA1 = nA1; vc0 = vn0; vc1 = vn1; vc2 = vn2; vc3 = vn3; ++ui;
        if constexpr (ALIGN_EPI) { if (wr == 1) PG8_BAR; }
    }
    PG8_WAIT_V(0);
    if constexpr (!ALIGN_EPI) { if (wr == 0) PG8_BAR; }
    PG8_BAR;
#undef PG8_SA
#undef PG8_AVOFF
#undef PG8_SB
#undef PG8_STAGE_A
#undef PG8_STAGE_B
#undef PG8_LDA
#undef PG8_LDB
#undef PG8_MMA
#undef PG8_WAIT_V
#undef PG8_WAIT_L
#undef PG8_BAR
#undef PG8_SCHED
}

struct StaticOrder {
    int nM, nN, nwg, G, c, lda, dup;
    __device__ __forceinline__ void init(int M, int N, int lda_, int G_, int c_) { nM = M / BM; nN = N / BM; nwg = nM * nN; G = G_; c = c_; lda = lda_; dup = 0; }
    __device__ __forceinline__ bool next(int i, Unit& u) const {
        const long L = (long)(i >> dup) * G + c; if (L >= nwg) return false;
        int wgid = (int)L; { const int q = nwg / NXCD, r = nwg % NXCD, xcd = wgid % NXCD, off = wgid / NXCD; wgid = (xcd < r ? xcd * (q + 1) : r * (q + 1) + (xcd - r) * q) + off; }
        const int nig = WGM * nN, gid = wgid / nig, fm = gid * WGM, gsz = (nM - fm) < WGM ? (nM - fm) : WGM;
        u.pm = fm + ((wgid % nig) % gsz); u.pn = (wgid % nig) / gsz; u.e = 0; u.aux = 0; return true;
    }
    static constexpr bool GATHER = false;
    __device__ __forceinline__ unsigned a_voff(const Unit&, int R, int C) const { return (unsigned)((R & (HALF - 1)) * lda + C) * 2u; }
    __device__ __forceinline__ unsigned a_soff(const Unit& u, int h) const { return (unsigned)((u.pm * BM + h * HALF) * lda) * 2u; }
    __device__ __forceinline__ size_t b_off(const Unit& u) const { return (size_t)u.pn * BM * lda * 2; }
};
}

#define XB_TMO      128
#define XB_XCNT(j)  (256  + 64 * (j))
#define XB_XSUB(j)  (1280 + 64 * (j))
#define XB_XGEN(j)  (2304 + 64 * (j))
#define XB_TOP      3328
#define XB_TOPGEN   3392
#define XCD_BAR_WORDS 3456
#define XB_SPIN_CAP (1u << 18)

__device__ __forceinline__ unsigned xb_ld(unsigned* p)              { return __hip_atomic_load(p, __ATOMIC_RELAXED, __HIP_MEMORY_SCOPE_AGENT); }
__device__ __forceinline__ unsigned xb_add(unsigned* p, unsigned v) { return __hip_atomic_fetch_add(p, v, __ATOMIC_RELAXED, __HIP_MEMORY_SCOPE_AGENT); }
__device__ __forceinline__ unsigned xb_xcc_id() { return (unsigned)__builtin_amdgcn_s_getreg((3 << 11) | 20) & 0xFu; }
#define XB_SPIN(cond, bar) do { unsigned _sp = 0; while (cond) { __builtin_amdgcn_s_sleep(1); \
    if ((++_sp & 255u) == 0u) { if (xb_ld(&(bar)[XB_TMO])) break; if (_sp > XB_SPIN_CAP) { atomicAdd(&(bar)[XB_TMO], 1u); break; } } } } while (0)

struct XcdBarrier {
    unsigned* bar; unsigned x;
    volatile LAS unsigned* st;
};

__device__ __forceinline__ XcdBarrier xcd_barrier_post(unsigned* bar, volatile LAS unsigned* st) {
    XcdBarrier b; b.bar = bar; b.x = xb_xcc_id(); b.st = st;
    if (threadIdx.x == 0) (void)xb_add(&bar[XB_XCNT(b.x)], 1u);
    return b;
}
__device__ __forceinline__ void xcd_barrier_complete(unsigned* bar, unsigned x, unsigned& nloc, unsigned& nx) {
    const unsigned G = gridDim.x * gridDim.y * gridDim.z;
    unsigned sum, cnt, mine, sp = 0u;
    for (;;) {
        sum = 0u; cnt = 0u; mine = 0u;
#pragma unroll
        for (unsigned j = 0; j < 16; ++j) { const unsigned c = xb_ld(&bar[XB_XCNT(j)]); sum += c; cnt += (c > 0u) ? 1u : 0u; mine = (j == x) ? c : mine; }
        if (sum == G) break;
        __builtin_amdgcn_s_sleep(1);
        if ((++sp & 255u) == 0u) { if (xb_ld(&bar[XB_TMO])) break; if (sp > XB_SPIN_CAP) { atomicAdd(&bar[XB_TMO], 1u); break; } }
    }
    nloc = mine > 0u ? mine : 1u; nx = cnt > 0u ? cnt : 1u;
}

__device__ __forceinline__ void xcd_barrier(const XcdBarrier& b) {
    asm volatile("s_waitcnt vmcnt(0)" ::: "memory");
    __syncthreads();
    if (threadIdx.x == 0) {
        unsigned* bar = b.bar;
        __builtin_amdgcn_s_waitcnt(0);
        unsigned nloc = b.st[0], nx = b.st[1];
        if (nloc == 0u) { xcd_barrier_complete(bar, b.x, nloc, nx); b.st[0] = nloc; b.st[1] = nx; }
        const unsigned old = xb_add(&bar[XB_XSUB(b.x)], 1u);
        const unsigned gen = old / nloc;
        if (old + 1u == (gen + 1u) * nloc) {
            __builtin_amdgcn_fence(__ATOMIC_RELEASE, "agent");
            asm volatile("s_waitcnt vmcnt(0)" ::: "memory");
            const unsigned og = xb_add(&bar[XB_TOP], 1u);
            const unsigned tg = og / nx;
            if (og + 1u == (tg + 1u) * nx) xb_add(&bar[XB_TOPGEN], 1u);
            else XB_SPIN(xb_ld(&bar[XB_TOPGEN]) == tg, bar);
            __builtin_amdgcn_fence(__ATOMIC_ACQUIRE, "agent");
            xb_add(&bar[XB_XGEN(b.x)], 1u);
            asm volatile("s_waitcnt vmcnt(0)" ::: "memory");
        } else {
            XB_SPIN(xb_ld(&bar[XB_XGEN(b.x)]) == gen, bar);
            __builtin_amdgcn_fence(__ATOMIC_ACQUIRE, "agent");
            asm volatile("s_waitcnt vmcnt(0)" ::: "memory");
        }
    }
    __syncthreads();
}

struct Args { const float* in[23]; float* out; unsigned char* ws; int ph_lo, ph_hi, li, pad; };
#define CAS __attribute__((address_space(4)))
typedef const CAS Args& ArgsRef;
enum { I_X = 0, I_NORM1G, I_WIN, I_POOLW, I_POOLSC, I_CONVW, I_CONVB, I_WA, I_BA, I_WX, I_BX, I_LAM, I_QG, I_KG, I_OG, I_WOUT, I_NORM2G, I_WR, I_BR, I_WGU, I_BGU, I_WD, I_BD };

struct TrDesc { const float* W; int K, N; bf16* WT; const float* gk; int mode, item; };
__device__ __forceinline__ void tr_load(const TrDesc& d, float (&v)[32], int lane) {
    const int nblk = d.N / 32, kb = d.item / nblk, nb = d.item % nblk, k0 = 64 * kb, n0 = 32 * nb;
#pragma unroll
    for (int i = 0; i < 32; ++i) { const int kk = 2 * i + (lane >> 5); v[i] = d.W[(size_t)(k0 + kk) * d.N + n0 + (lane & 31)]; }
}
__device__ __forceinline__ void tr_finish(const TrDesc& d, float (&v)[32], LAS float* scr, int lane) {
    const int nblk = d.N / 32, kb = d.item / nblk, nb = d.item % nblk, k0 = 64 * kb, n0 = 32 * nb; const int K = d.K;
#pragma unroll
    for (int i = 0; i < 32; ++i) { const int kk = 2 * i + (lane >> 5); float x = v[i]; if (d.gk) x *= d.gk[k0 + kk]; scr[kk * 33 + (lane & 31)] = x; }
    LDS_WAIT(); asm volatile("" ::: "memory");
    const int c = lane & 7;
#pragma unroll
    for (int j = 0; j < 4; ++j) { const int n = (lane >> 3) + 8 * j; const LAS float* s = scr + (8 * c) * 33 + n;
        u32x4 o; o.x = cvt_pk_bf16(s[0 * 33], s[1 * 33]); o.y = cvt_pk_bf16(s[2 * 33], s[3 * 33]); o.z = cvt_pk_bf16(s[4 * 33], s[5 * 33]); o.w = cvt_pk_bf16(s[6 * 33], s[7 * 33]);
        int dn = n0 + n; const int mode = d.mode;
        if (mode == 1) { const int jj = dn & 255; dn = (jj >> 7) * 256 + (dn >> 8) * 128 + (jj & 127); }
        if (mode == 3 || (mode == 2 && (dn < C_Q || dn >= C_V))) {
            const int L = dn & 255; dn = (dn & ~255) + 128 * ((L >> 3) & 1) + 32 * (L >> 6) + 8 * ((L >> 4) & 3) + (L & 7); }
        else if (mode == 2) {
            const int rem = (dn - C_Q) & 511, sec = (dn - C_Q) >> 9, head = rem >> 6, d2 = rem & 63;
            dn = C_Q + sec * 512 + (head >> 2) * 256 + (d2 >> 5) * 128 + (head & 3) * 32 + (d2 & 31); }
        *(u32x4*)(d.WT + (size_t)dn * K + k0 + 8 * c) = o; }
    LDS_WAIT(); asm volatile("" ::: "memory");
}
__device__ __forceinline__ void cvt_row(const float* xrow, bf16* orow, float* ssq, int lane) {
    const f32x4* xr = (const f32x4*)xrow + lane;
    f32x4 v[4]; float s = 0.f;
#pragma unroll
    for (int j = 0; j < 4; ++j) { v[j] = xr[64 * j]; s += (v[j].x * v[j].x + v[j].y * v[j].y) + (v[j].z * v[j].z + v[j].w * v[j].w); }
    s = wave_sum(s);
    u32x2* o8 = (u32x2*)orow + lane;
#pragma unroll
    for (int j = 0; j < 4; ++j) { u32x2 w; w.x = cvt_pk_bf16(v[j].x, v[j].y); w.y = cvt_pk_bf16(v[j].z, v[j].w); o8[64 * j] = w; }
    if (lane == 0) *ssq = s;
}
__device__ __forceinline__ TrDesc tr_desc(ArgsRef a, int it) {
    unsigned char* ws = a.ws;
    constexpr int I_IN = 16 * 72, I_OUT = 16 * 32, I_R = 16, I_GU = 16 * 16, I_D = 4 * 32, I_S = 2;
    constexpr int PER_LAYER = I_IN + I_OUT + I_R + NEXP * I_GU + NEXP * I_D + 12 * I_S;
    const int l = it / PER_LAYER; int r = it % PER_LAYER; TrDesc d;
    if (r < I_IN) { d = TrDesc{a.in[I_WIN] + (size_t)l * DM * NIN, DM, NIN, (bf16*)(ws + WS_WIN) + (size_t)l * NIN * DM, a.in[I_NORM1G] + l * DM, 2, r}; return d; } r -= I_IN;
    if (r < I_OUT) { d = TrDesc{a.in[I_WOUT] + (size_t)l * DM * DM, DM, DM, (bf16*)(ws + WS_WOUT) + (size_t)l * DM * DM, a.in[I_OG] + l * DM, 3, r}; return d; } r -= I_OUT;
    if (r < I_R) { d = TrDesc{a.in[I_WR] + (size_t)l * DM * NEXP, DM, NEXP, (bf16*)(ws + WS_SMALL) + SM_WR + (size_t)l * NEXP * DM, a.in[I_NORM2G] + l * DM, 0, r}; return d; } r -= I_R;
    if (r < NEXP * I_GU) { const int e = r / I_GU; d = TrDesc{a.in[I_WGU] + (size_t)(l * NEXP + e) * DM * 512, DM, 512, (bf16*)(ws + WS_WGU) + (size_t)(l * NEXP + e) * 512 * DM, a.in[I_NORM2G] + l * DM, 1, r % I_GU}; return d; } r -= NEXP * I_GU;
    if (r < NEXP * I_D) { const int e = r / I_D; d = TrDesc{a.in[I_WD] + (size_t)(l * NEXP + e) * EFF * DM, EFF, DM, (bf16*)(ws + WS_WD) + (size_t)(l * NEXP + e) * DM * EFF, nullptr, 3, r % I_D}; return d; } r -= NEXP * I_D;
    { const int which = r / (4 * I_S), g = (r / I_S) % 4, sub = r % I_S;
      const float* src = a.in[which == 0 ? I_POOLW : (which == 1 ? I_WA : I_WX)] + (size_t)(l * 4 + g) * 4096;
      bf16* dst = (bf16*)(ws + WS_SMALL) + (which == 0 ? SM_POOLW : (which == 1 ? SM_WA : SM_WX)) + (size_t)(l * 4 + g) * 4096;
      d = TrDesc{src, 64, 64, dst, nullptr, 0, sub}; return d; }
}
__device__ __forceinline__ void phase_prologue(ArgsRef a, LAS unsigned char* lds, int wv) {
    const int tid = tid_from(wv), lane = tid & 63, wave = tid >> 6;
    LAS float* scr = (LAS float*)(lds + wave * 16384);
    const int gw = blockIdx.x * NWAVES + wave, NGW = gridDim.x * NWAVES;
    unsigned char* ws = a.ws;
    constexpr int PER_LAYER = 16 * 72 + 16 * 32 + 16 + NEXP * 16 * 16 + NEXP * 4 * 32 + 12 * 2;
    { int it = gw; float cur[32], nxt[32];
      TrDesc dc = tr_desc(a, it < 2 * PER_LAYER ? it : 0), dn = dc;
      if (it < 2 * PER_LAYER) tr_load(dc, cur, lane);
      while (it < 2 * PER_LAYER) { const int itn = it + NGW;
          if (itn < 2 * PER_LAYER) { dn = tr_desc(a, itn); tr_load(dn, nxt, lane); }
          tr_finish(dc, cur, scr, lane);
#pragma unroll
          for (int i = 0; i < 32; ++i) cur[i] = nxt[i];
          dc = dn; it = itn; } }
    { float* ct = (float*)(ws + WS_ROPE); float* st = ct + SEQ * 32;
      for (int idx = blockIdx.x * NTHR + tid; idx < SEQ * 32; idx += gridDim.x * NTHR) {
          const int pos = idx >> 5, i = idx & 31;
          const float inv = __builtin_amdgcn_exp2f(-(float)i * 0.41524101186092029f);
          const float ang = (float)pos * inv;
          const double rev = (double)ang * 0.15915494309189535; const double fr = rev - __builtin_rint(rev);
          const float f = (float)fr;
          ct[idx] = __builtin_amdgcn_cosf(f); st[idx] = __builtin_amdgcn_sinf(f); } }
    { const float* __restrict__ X = a.in[I_X]; bf16* __restrict__ xb = (bf16*)(ws + WS_XB); float* __restrict__ ssq = (float*)(ws + WS_SSQ);
      for (int m0 = gw * 4; m0 < NT; m0 += NGW * 4) { f32x4 v[4][4];
#pragma unroll
          for (int u = 0; u < 4; ++u)
#pragma unroll
              for (int j = 0; j < 4; ++j) v[u][j] = *((const f32x4*)(X + (size_t)(m0 + u) * DM) + lane + 64 * j);
#pragma unroll
          for (int u = 0; u < 4; ++u) { float s = 0.f;
#pragma unroll
              for (int j = 0; j < 4; ++j) s += (v[u][j].x * v[u][j].x + v[u][j].y * v[u][j].y) + (v[u][j].z * v[u][j].z + v[u][j].w * v[u][j].w);
              s = wave_sum(s);
#pragma unroll
              for (int j = 0; j < 4; ++j) { u32x2 w; w.x = cvt_pk_bf16(v[u][j].x, v[u][j].y); w.y = cvt_pk_bf16(v[u][j].z, v[u][j].w); *((u32x2*)(xb + (size_t)(m0 + u) * DM) + lane + 64 * j) = w; }
              if (lane == 0) ssq[m0 + u] = s; } } }
}

struct EpiIn {
    static constexpr bool PERM = true;
    bf16* O; const float* ssq; const float* qg; const float* kg; const float* ct; const float* st;
    __device__ __forceinline__ void operator()(const f32x4 (&acc)[2][2][4][2], const pg8::Unit& u, int wr, int wc, int fr, int fq) const {
        const int row0 = u.pm * 256 + wr * 64 + fr, col0 = u.pn * 256 + wc * 32 + 8 * fq;
        if (u.pn >= 3 && u.pn < 7) {
            const bool isq = u.pn < 5; const float* gp = (isq ? qg : kg) + 8 * fq; const float gs = isq ? (0.125f * 1.4426950408889634f) : 1.0f;
            f32x4 g[2][2];
#pragma unroll
            for (int bj = 0; bj < 2; ++bj)
#pragma unroll
                for (int n = 0; n < 2; ++n) g[bj][n] = *(const f32x4*)(gp + 32 * bj + 4 * n) * gs;
#pragma unroll
            for (int ai = 0; ai < 2; ++ai)
#pragma unroll
                for (int m = 0; m < 4; ++m) { const int row = row0 + ai * 128 + m * 16; const float rs = __builtin_amdgcn_rsqf(ssq[row] * (1.0f / DM) + EPS);
                    const int pos = row & (SEQ - 1);
                    const f32x4 c0 = *(const f32x4*)(ct + pos * 32 + 8 * fq), c1 = *(const f32x4*)(ct + pos * 32 + 8 * fq + 4), s0 = *(const f32x4*)(st + pos * 32 + 8 * fq), s1 = *(const f32x4*)(st + pos * 32 + 8 * fq + 4);
                    f32x4 v[2][2]; float ss = 0.f;
#pragma unroll
                    for (int bj = 0; bj < 2; ++bj)
#pragma unroll
                        for (int n = 0; n < 2; ++n) { v[bj][n] = acc[ai][bj][m][n] * rs; ss += (v[bj][n][0] * v[bj][n][0] + v[bj][n][1] * v[bj][n][1]) + (v[bj][n][2] * v[bj][n][2] + v[bj][n][3] * v[bj][n][3]); }
                    ss += __shfl_xor(ss, 16); ss += __shfl_xor(ss, 32);
                    const float rr = __builtin_amdgcn_rsqf(ss * (1.0f / 64.0f) + EPS);
#pragma unroll
                    for (int bj = 0; bj < 2; ++bj)
#pragma unroll
                        for (int n = 0; n < 2; ++n) v[bj][n] = v[bj][n] * rr * g[bj][n];
                    const f32x4 o00 = v[0][0] * c0 - v[1][0] * s0, o01 = v[0][1] * c1 - v[1][1] * s1, o10 = v[1][0] * c0 + v[0][0] * s0, o11 = v[1][1] * c1 + v[0][1] * s1;
                    bf16* rowp = O + (size_t)row * NIN + col0;
                    u32x4 w; w.x = cvt_pk_bf16(o00[0], o00[1]); w.y = cvt_pk_bf16(o00[2], o00[3]); w.z = cvt_pk_bf16(o01[0], o01[1]); w.w = cvt_pk_bf16(o01[2], o01[3]);
                    *(u32x4*)(rowp) = w;
                    w.x = cvt_pk_bf16(o10[0], o10[1]); w.y = cvt_pk_bf16(o10[2], o10[3]); w.z = cvt_pk_bf16(o11[0], o11[1]); w.w = cvt_pk_bf16(o11[2], o11[3]);
                    *(u32x4*)(rowp + 128) = w; }
            return;
        }
#pragma unroll
        for (int ai = 0; ai < 2; ++ai)
#pragma unroll
            for (int m = 0; m < 4; ++m) { const int row = row0 + ai * 128 + m * 16; const float rs = __builtin_amdgcn_rsqf(ssq[row] * (1.0f / DM) + EPS);
                bf16* rowp = O + (size_t)row * NIN + u.pn * 256 + wc * 64 + fq * 16;
#pragma unroll
                for (int bj = 0; bj < 2; ++bj) { const f32x4 v0 = acc[ai][bj][m][0] * rs, v1 = acc[ai][bj][m][1] * rs;
                    u32x4 w; w.x = cvt_pk_bf16(v0[0], v0[1]); w.y = cvt_pk_bf16(v0[2], v0[3]); w.z = cvt_pk_bf16(v1[0], v1[1]); w.w = cvt_pk_bf16(v1[2], v1[3]);
                    *(u32x4*)(rowp + bj * 8) = w; } }
    }
};
struct EpiOut {
    static constexpr bool PERM = true;
    bf16* xb; float* ssqp;
    __device__ __forceinline__ void operator()(const f32x4 (&acc)[2][2][4][2], const pg8::Unit& u, int wr, int wc, int fr, int fq) const {
        const int row0 = u.pm * 256 + wr * 64 + fr, col0 = u.pn * 256 + wc * 64 + fq * 16;
#pragma unroll
        for (int am = 0; am < 4; ++am) { u32x4 xi[2][2];
#pragma unroll
            for (int mm = 0; mm < 2; ++mm) { const int ai = am >> 1, m = (am & 1) * 2 + mm; const size_t off = (size_t)(row0 + ai * 128 + m * 16) * DM + col0; xi[mm][0] = *(const u32x4*)(xb + off); xi[mm][1] = *(const u32x4*)(xb + off + 8); }
            asm volatile("" ::: "memory");
#pragma unroll
            for (int mm = 0; mm < 2; ++mm) { const int ai = am >> 1, m = (am & 1) * 2 + mm; const int row = row0 + ai * 128 + m * 16; const size_t off = (size_t)row * DM + col0; float s = 0.f;
#pragma unroll
                for (int bj = 0; bj < 2; ++bj) { const u32x4 x = xi[mm][bj];
                    const f32x4 o0 = (f32x4){bflo(x.x), bfhi(x.x), bflo(x.y), bfhi(x.y)} + acc[ai][bj][m][0], o1 = (f32x4){bflo(x.z), bfhi(x.z), bflo(x.w), bfhi(x.w)} + acc[ai][bj][m][1];
                    s += ((o0[0] * o0[0] + o0[1] * o0[1]) + (o0[2] * o0[2] + o0[3] * o0[3])) + ((o1[0] * o1[0] + o1[1] * o1[1]) + (o1[2] * o1[2] + o1[3] * o1[3]));
                    u32x4 w; w.x = cvt_pk_bf16(o0[0], o0[1]); w.y = cvt_pk_bf16(o0[2], o0[3]); w.z = cvt_pk_bf16(o1[0], o1[1]); w.w = cvt_pk_bf16(o1[2], o1[3]);
                    *(u32x4*)(xb + off + bj * 8) = w; }
                s += __shfl_xor(s, 16); s += __shfl_xor(s, 32);
                if (fq == 0) ssqp[(size_t)row * 16 + u.pn * 4 + wc] = s; }
            asm volatile("" ::: "memory"); }
    }
};

template <int MODE> struct MoeOrder {
    static constexpr bool GATHER = (MODE == 0);
    const LAS int* tab; int npn, G, c; const int* list; int dup;
    __device__ __forceinline__ bool next(int i, pg8::Unit& u) const {
        const int ii = i >> dup; const int total = __builtin_amdgcn_readfirstlane(tab[64]); const int nfr = total / G, nfu = nfr * npn;
        int gb;
        if (ii < nfu) { gb = (ii / npn) * G + c; u.pn = ii % npn; }
        else { const int L = (ii - nfu) * G + c; gb = nfr * G + L / npn; u.pn = L % npn; if (gb >= total) return false; }
        const int e = __builtin_amdgcn_readfirstlane((int)((const LAS unsigned char*)(tab + 80))[gb]);
        u.e = e; u.pm = gb; u.aux = gb - __builtin_amdgcn_readfirstlane(tab[32 + e]); return true;
    }
    __device__ __forceinline__ unsigned a_voff(const pg8::Unit& u, int R, int C) const {
        if constexpr (MODE == 0) { const int pos = u.aux * 256 + R; const int ne = tab[u.e]; int tok = 0; if (pos < ne) tok = list[u.e * NT + pos] >> 2; return (unsigned)(tok * DM + C) * 2u; }
        else return (unsigned)((R & 127) * EFF + C) * 2u;
    }
    __device__ __forceinline__ unsigned a_soff(const pg8::Unit& u, int h) const { if constexpr (MODE == 0) return 0u; else return (unsigned)((u.pm * 256 + h * 128) * EFF) * 2u; }
    __device__ __forceinline__ size_t b_off(const pg8::Unit& u) const {
        if constexpr (MODE == 0) return ((size_t)u.e * 512 + (size_t)u.pn * 256) * DM * 2;
        else return ((size_t)u.e * DM + (size_t)u.pn * 256) * EFF * 2;
    }
};
struct EpiGU {
    static constexpr bool PERM = true;
    bf16* act; const float* lrstd; const float* bgu;
    __device__ __forceinline__ void operator()(const f32x4 (&acc)[2][2][4][2], const pg8::Unit& u, int wr, int wc, int fr, int fq) const {
        const int r0 = wr * 64 + fr, cl0 = wc * 32 + 8 * fq;
        const float* bg = bgu + u.e * 512 + u.pn * 128 + cl0;
        const f32x4 bg0 = *(const f32x4*)(bg), bg1 = *(const f32x4*)(bg + 4), bu0 = *(const f32x4*)(bg + 256), bu1 = *(const f32x4*)(bg + 260);
#pragma unroll
        for (int ai = 0; ai < 2; ++ai)
#pragma unroll
            for (int m = 0; m < 4; ++m) { const int r = r0 + ai * 128 + m * 16; const float rs = lrstd[(size_t)u.e * NT + u.aux * 256 + r];
                f32x4 g0 = acc[ai][0][m][0] * rs + bg0, g1 = acc[ai][0][m][1] * rs + bg1, u0 = acc[ai][1][m][0] * rs + bu0, u1 = acc[ai][1][m][1] * rs + bu1;
                float o[8];
#pragma unroll
                for (int j = 0; j < 4; ++j) { const float ga = fminf(g0[j], 7.0f), ua = fminf(fmaxf(u0[j], -7.0f), 7.0f); o[j] = (ua + 1.0f) * ga * fast_sigmoid(1.702f * ga);
                                              const float gb = fminf(g1[j], 7.0f), ub = fminf(fmaxf(u1[j], -7.0f), 7.0f); o[4 + j] = (ub + 1.0f) * gb * fast_sigmoid(1.702f * gb); }
                u32x4 w; w.x = cvt_pk_bf16(o[0], o[1]); w.y = cvt_pk_bf16(o[2], o[3]); w.z = cvt_pk_bf16(o[4], o[5]); w.w = cvt_pk_bf16(o[6], o[7]);
                *(u32x4*)(act + (size_t)(u.pm * 256 + r) * EFF + u.pn * 128 + cl0) = w; }
    }
};
constexpr float Y8_SCALE = 32.0f;
struct EpiDown {
    static constexpr bool PERM = true;
    unsigned char* y; const int* list; const float* lgate; const float* bd; const LAS int* tab;
    __device__ __forceinline__ void operator()(const f32x4 (&acc)[2][2][4][2], const pg8::Unit& u, int wr, int wc, int fr, int fq) const {
        const int r0 = wr * 64 + fr, col0 = u.pn * 256 + wc * 64 + fq * 16; const int ne = tab[u.e];
        const float* bp = bd + u.e * DM + col0;
#pragma unroll
        for (int ai = 0; ai < 2; ++ai) { int asg[4]; float gt[4];
#pragma unroll
            for (int m = 0; m < 4; ++m) { const int pos = u.aux * 256 + r0 + ai * 128 + m * 16; const bool ok = pos < ne;
                asg[m] = ok ? list[(size_t)u.e * NT + pos] : -1; gt[m] = ok ? lgate[(size_t)u.e * NT + pos] * Y8_SCALE : 0.f; }
            asm volatile("" ::: "memory");
#pragma unroll
            for (int m = 0; m < 4; ++m) {
                if (asg[m] >= 0) { unsigned char* rowp = y + (size_t)asg[m] * DM + col0; const float g = gt[m]; u32x4 wv4;
#pragma unroll
                    for (int bj = 0; bj < 2; ++bj) { const f32x4 b0 = *(const f32x4*)(bp + bj * 8), b1 = *(const f32x4*)(bp + bj * 8 + 4);
                        const f32x4 v0 = (acc[ai][bj][m][0] + b0) * g, v1 = (acc[ai][bj][m][1] + b1) * g;
                        int w0 = __builtin_amdgcn_cvt_pk_fp8_f32(v0[0], v0[1], 0, false); w0 = __builtin_amdgcn_cvt_pk_fp8_f32(v0[2], v0[3], w0, true);
                        int w1 = __builtin_amdgcn_cvt_pk_fp8_f32(v1[0], v1[1], 0, false); w1 = __builtin_amdgcn_cvt_pk_fp8_f32(v1[2], v1[3], w1, true);
                        if (bj == 0) { wv4.x = (unsigned)w0; wv4.y = (unsigned)w1; } else { wv4.z = (unsigned)w0; wv4.w = (unsigned)w1; } }
                    *(u32x4*)rowp = wv4; }
                asm volatile("" ::: "memory"); } }
    }
};
__device__ __forceinline__ void moe_tables(LAS int* tab, const unsigned* cnt, int wv) {
    __syncthreads();
    const int tid_ = tid_from(wv);
    if (tid_ == 0) { int pre = 0;
        for (int e = 0; e < NEXP; ++e) { const int n = (int)__hip_atomic_load(cnt + e, RLX_AGENT); tab[e] = n; tab[32 + e] = pre; pre += (n + 255) >> 8; }
        tab[64] = pre; }
    __syncthreads();
    { LAS unsigned char* eb = (LAS unsigned char*)(tab + 80); const int total = tab[64];
      for (int gb = tid_; gb < total; gb += NTHR) { int e = 0;
          for (int k = 1; k < NEXP; ++k) { if (tab[32 + k] <= gb) e = k; }
          eb[gb] = (unsigned char)e; } }
    __syncthreads();
}

__device__ __forceinline__ void phase_qkprep(ArgsRef a, int layer, int wv, bool dry) {
    const int tid = tid_from(wv), lane = tid & 63, wave = tid >> 6;
    const int gw = blockIdx.x * NWAVES + wave, NGW = gridDim.x * NWAVES;
    bf16* proj = (bf16*)(a.ws + WS_PROJ);
    const float* __restrict__ ct = (const float*)(a.ws + WS_ROPE); const float* __restrict__ st = ct + SEQ * 32;
    const int d0 = (lane & 7) * 8, p0 = d0 & 31;
    float gq[8], gk[8];
#pragma unroll
    for (int j = 0; j < 8; ++j) { gq[j] = a.in[I_QG][layer * 64 + d0 + j] * (0.125f * 1.4426950408889634f); gk[j] = a.in[I_KG][layer * 64 + d0 + j]; }
    const bool second = (lane & 4) != 0;
    constexpr int TB = 4;
    for (int t0 = gw * TB; t0 < NT; t0 += NGW * TB) {
        u32x4 w[TB][2]; f32x4 cs[TB][4];
#pragma unroll
        for (int u = 0; u < TB; ++u) { const int t = t0 + u, pos = t & (SEQ - 1);
            w[u][0] = *(const u32x4*)(proj + (size_t)t * NIN + C_Q + lane * 8); w[u][1] = *(const u32x4*)(proj + (size_t)t * NIN + C_Q + 512 + lane * 8);
            cs[u][0] = *(const f32x4*)(ct + pos * 32 + p0); cs[u][1] = *(const f32x4*)(ct + pos * 32 + p0 + 4); cs[u][2] = *(const f32x4*)(st + pos * 32 + p0); cs[u][3] = *(const f32x4*)(st + pos * 32 + p0 + 4); }
#pragma unroll
        for (int u = 0; u < TB; ++u) { const int t = t0 + u;
            float c[8], s[8];
#pragma unroll
            for (int j = 0; j < 4; ++j) { c[j] = cs[u][0][j]; c[4 + j] = cs[u][1][j]; s[j] = cs[u][2][j]; s[4 + j] = cs[u][3][j]; }
#pragma unroll
            for (int i = 0; i < 2; ++i) {
                const u32x4 ww = w[u][i];
                float x[8]; x[0] = bflo(ww.x); x[1] = bfhi(ww.x); x[2] = bflo(ww.y); x[3] = bfhi(ww.y); x[4] = bflo(ww.z); x[5] = bfhi(ww.z); x[6] = bflo(ww.w); x[7] = bfhi(ww.w);
                float ss = 0.f;
#pragma unroll
                for (int j = 0; j < 8; ++j) ss += x[j] * x[j];
                ss += __shfl_xor(ss, 1); ss += __shfl_xor(ss, 2); ss += __shfl_xor(ss, 4);
                const float rs = __builtin_amdgcn_rsqf(ss * (1.0f / 64.0f) + EPS);
                float o[8];
#pragma unroll
                for (int j = 0; j < 8; ++j) { const float yv = x[j] * rs * (i == 0 ? gq[j] : gk[j]); const float pv = __shfl_xor(yv, 4);
                    o[j] = second ? (yv * c[j] + pv * s[j]) : (yv * c[j] - pv * s[j]); }
                u32x4 r; r.x = cvt_pk_bf16(o[0], o[1]); r.y = cvt_pk_bf16(o[2], o[3]); r.z = cvt_pk_bf16(o[4], o[5]); r.w = cvt_pk_bf16(o[6], o[7]);
                if (!dry || o[0] == 12345.678f) *(u32x4*)(proj + (size_t)t * NIN + C_Q + i * 512 + lane * 8) = r;
            } }
    }
}

__device__ __forceinline__ void phase_pool(ArgsRef a, LAS unsigned char* lds, int layer, int wv) {
    const int tid = tid_from(wv), lane = tid & 63, wave = __builtin_amdgcn_readfirstlane(tid >> 6);
    const bf16* proj = (const bf16*)(a.ws + WS_PROJ); bf16* mix = (bf16*)(a.ws + WS_MIX);
    const bf16* pw = (const bf16*)(a.ws + WS_SMALL) + SM_POOLW + (size_t)layer * 4 * 4096;
    const float* psc = a.in[I_POOLSC] + layer * 256;
    LAS float* U = (LAS float*)lds;
    LAS bf16* PA = (LAS bf16*)(lds + 81920);
    LAS float* SS = (LAS float*)(lds + 116736);
    constexpr int PAS = 264;
    for (int unit = blockIdx.x; unit < NT / 64; unit += gridDim.x) {
        const int t0 = unit * 64, s0 = t0 & (SEQ - 1);
        __syncthreads();
        for (int ch = tid; ch < 79 * 32; ch += NTHR) { const int r = ch >> 5, c8 = (ch & 31) * 8; const int srow = s0 - 15 + r;
            f32x4 lo = {0.f, 0.f, 0.f, 0.f}, hi = {0.f, 0.f, 0.f, 0.f};
            if (srow >= 0) { const u32x4 w = *(const u32x4*)(proj + (size_t)(t0 - 15 + r) * NIN + C_POOL + c8); lo = (f32x4){bflo(w.x), bfhi(w.x), bflo(w.y), bfhi(w.y)}; hi = (f32x4){bflo(w.z), bfhi(w.z), bflo(w.w), bfhi(w.w)}; }
            *(LAS f32x4*)(U + r * 256 + c8) = lo; *(LAS f32x4*)(U + r * 256 + c8 + 4) = hi; }
        __syncthreads();
        { const int c = tid & 255, tl0 = (tid >> 8) * 32, w = 2 << (c >> 6);
          float sum = 0.f;
          for (int j = 1; j < w; ++j) sum += U[(15 + tl0 - j) * 256 + c];
          for (int tl = tl0; tl < tl0 + 32; ++tl) { const float cur = U[(15 + tl) * 256 + c]; sum += cur;
              const int cnt = min(w, s0 + tl + 1); const float pooled = sum / (float)cnt - cur;
              PA[tl * PAS + c] = f2bf(pooled); sum -= U[(15 + tl - w + 1) * 256 + c]; } }
        __syncthreads();
        const int g = wave & 3, th = wave >> 2, lr = lane & 15, lq = lane >> 4;
        f32x4 acc[2][4];
#pragma unroll
        for (int rt = 0; rt < 2; ++rt)
#pragma unroll
            for (int et = 0; et < 4; ++et) acc[rt][et] = (f32x4){0.f, 0.f, 0.f, 0.f};
#pragma unroll
        for (int ks = 0; ks < 2; ++ks) { bf16x8 af[2], bfr[4];
#pragma unroll
            for (int rt = 0; rt < 2; ++rt) af[rt] = *(const LAS bf16x8*)(PA + (th * 32 + rt * 16 + lr) * PAS + g * 64 + ks * 32 + lq * 8);
#pragma unroll
            for (int et = 0; et < 4; ++et) bfr[et] = *(const bf16x8*)(pw + (size_t)g * 4096 + (et * 16 + lr) * 64 + ks * 32 + lq * 8);
#pragma unroll
            for (int rt = 0; rt < 2; ++rt)
#pragma unroll
                for (int et = 0; et < 4; ++et) acc[rt][et] = __builtin_amdgcn_mfma_f32_16x16x32_bf16(af[rt], bfr[et], acc[rt][et], 0, 0, 0); }
#pragma unroll
        for (int et = 0; et < 4; ++et) { const float sc = psc[g * 64 + et * 16 + lr];
#pragma unroll
            for (int rt = 0; rt < 2; ++rt) acc[rt][et] = acc[rt][et] * sc; }
#pragma unroll
        for (int rt = 0; rt < 2; ++rt)
#pragma unroll
            for (int reg = 0; reg < 4; ++reg) { float s = 0.f;
#pragma unroll
                for (int et = 0; et < 4; ++et) s += acc[rt][et][reg] * acc[rt][et][reg];
                s += __shfl_xor(s, 1); s += __shfl_xor(s, 2); s += __shfl_xor(s, 4); s += __shfl_xor(s, 8);
                if (lr == 0) SS[(th * 32 + rt * 16 + lq * 4 + reg) * 4 + g] = s; }
        __syncthreads();
#pragma unroll
        for (int rt = 0; rt < 2; ++rt)
#pragma unroll
            for (int reg = 0; reg < 4; ++reg) { const int tl = th * 32 + rt * 16 + lq * 4 + reg; const LAS float* sp = SS + tl * 4;
                const float rs = __builtin_amdgcn_rsqf(((sp[0] + sp[1]) + (sp[2] + sp[3])) * (1.0f / 256.0f) + EPS);
#pragma unroll
                for (int et = 0; et < 4; ++et) mix[(size_t)(t0 + tl) * DM + g * 64 + et * 16 + lr] = f2bf(acc[rt][et][reg] * rs); }
    }
}

__device__ __forceinline__ void phase_lru_a(ArgsRef a, LAS unsigned char* lds, int layer, int wv) {
    const int tid = tid_from(wv), lane = tid & 63, wave = __builtin_amdgcn_readfirstlane(tid >> 6);
    const bf16* proj = (const bf16*)(a.ws + WS_PROJ);
    const bf16* wa = (const bf16*)(a.ws + WS_SMALL) + SM_WA + (size_t)layer * 4 * 4096;
    const bf16* wx = (const bf16*)(a.ws + WS_SMALL) + SM_WX + (size_t)layer * 4 * 4096;
    bf16* HL = (bf16*)(a.ws + WS_HL); bf16* PL = (bf16*)(a.ws + WS_PL);
    float* AGGH = (float*)(a.ws + WS_AGGH); float* AGGP = (float*)(a.ws + WS_AGGP);
    LAS float* U = (LAS float*)lds;
    LAS bf16* XC = (LAS bf16*)(lds + 36864);
    LAS float* XF = (LAS float*)(lds + 54272);
    LAS float* AA = (LAS float*)(lds + 87040);
    constexpr int XS = 264;
    const int c = tid & 255;
    const float cw0 = a.in[I_CONVW][(layer * 4 + 0) * 256 + c], cw1 = a.in[I_CONVW][(layer * 4 + 1) * 256 + c], cw2 = a.in[I_CONVW][(layer * 4 + 2) * 256 + c], cw3 = a.in[I_CONVW][(layer * 4 + 3) * 256 + c];
    const float cb = a.in[I_CONVB][layer * 256 + c];
    for (int unit = blockIdx.x; unit < NT / LRU_CH; unit += gridDim.x) {
        const int t0 = unit * LRU_CH, s0 = t0 & (SEQ - 1);
        __syncthreads();
        for (int ch = tid; ch < 35 * 32; ch += NTHR) { const int r = ch >> 5, c8 = (ch & 31) * 8; const int srow = s0 - 3 + r;
            f32x4 lo = {0.f, 0.f, 0.f, 0.f}, hi = {0.f, 0.f, 0.f, 0.f};
            if (srow >= 0) { const u32x4 w = *(const u32x4*)(proj + (size_t)(t0 - 3 + r) * NIN + C_LRU + c8); lo = (f32x4){bflo(w.x), bfhi(w.x), bflo(w.y), bfhi(w.y)}; hi = (f32x4){bflo(w.z), bfhi(w.z), bflo(w.w), bfhi(w.w)}; }
            *(LAS f32x4*)(U + r * 256 + c8) = lo; *(LAS f32x4*)(U + r * 256 + c8 + 4) = hi; }
        __syncthreads();
        { const int tl0 = (tid >> 8) * 16;
          for (int tl = tl0; tl < tl0 + 16; ++tl) { const float xc = cb + cw0 * U[(tl + 0) * 256 + c] + cw1 * U[(tl + 1) * 256 + c] + cw2 * U[(tl + 2) * 256 + c] + cw3 * U[(tl + 3) * 256 + c];
              XF[tl * 256 + c] = xc; XC[tl * XS + c] = f2bf(xc); } }
        __syncthreads();
        { const int n = wave & 3, eh = wave >> 2, lr = lane & 15, lq = lane >> 4;
          f32x4 ca[2][2], cx[2][2];
#pragma unroll
          for (int rt = 0; rt < 2; ++rt)
#pragma unroll
              for (int et = 0; et < 2; ++et) { ca[rt][et] = (f32x4){0.f, 0.f, 0.f, 0.f}; cx[rt][et] = (f32x4){0.f, 0.f, 0.f, 0.f}; }
#pragma unroll
          for (int ks = 0; ks < 2; ++ks) { bf16x8 af[2], ba[2], bx[2];
#pragma unroll
              for (int rt = 0; rt < 2; ++rt) af[rt] = *(const LAS bf16x8*)(XC + (rt * 16 + lr) * XS + n * 64 + ks * 32 + lq * 8);
#pragma unroll
              for (int et = 0; et < 2; ++et) { const size_t wo = (size_t)n * 4096 + (eh * 32 + et * 16 + lr) * 64 + ks * 32 + lq * 8; ba[et] = *(const bf16x8*)(wa + wo); bx[et] = *(const bf16x8*)(wx + wo); }
#pragma unroll
              for (int rt = 0; rt < 2; ++rt)
#pragma unroll
                  for (int et = 0; et < 2; ++et) { ca[rt][et] = __builtin_amdgcn_mfma_f32_16x16x32_bf16(af[rt], ba[et], ca[rt][et], 0, 0, 0);
                                                   cx[rt][et] = __builtin_amdgcn_mfma_f32_16x16x32_bf16(af[rt], bx[et], cx[rt][et], 0, 0, 0); } }
#pragma unroll
          for (int et = 0; et < 2; ++et) { const int chn = n * 64 + eh * 32 + et * 16 + lr;
              const float bav = a.in[I_BA][layer * 256 + chn], bxv = a.in[I_BX][layer * 256 + chn], lam = a.in[I_LAM][layer * 256 + chn];
              const float sp = log1pf(expf(-lam));
#pragma unroll
              for (int rt = 0; rt < 2; ++rt)
#pragma unroll
                  for (int reg = 0; reg < 4; ++reg) { const int tl = rt * 16 + lq * 4 + reg;
                      const float r = fast_sigmoid(ca[rt][et][reg] + bav), ig = fast_sigmoid(cx[rt][et][reg] + bxv);
                      const float log_a = -8.0f * r * sp; const float av = fast_exp(log_a);
                      float mult = sqrtf(fmaxf(1.0f - fast_exp(2.0f * log_a), 0.f)); if (s0 + tl == 0) mult = 1.0f;
                      const float xc = XF[tl * 256 + chn];
                      AA[tl * 256 + chn] = av; XF[tl * 256 + chn] = mult * ig * xc; } } }
        __syncthreads();
        if (tid < 256) { float h = 0.f, P = 1.f;
            for (int tl = 0; tl < LRU_CH; ++tl) { const float av = AA[tl * 256 + c], bv = XF[tl * 256 + c]; h = av * h + bv; P *= av;
                HL[(size_t)(t0 + tl) * 256 + c] = f2bf(h); PL[(size_t)(t0 + tl) * 256 + c] = f2bf(P); }
            AGGH[(size_t)unit * 256 + c] = h; AGGP[(size_t)unit * 256 + c] = P; }
    }
}
__device__ __forceinline__ void phase_lru_b(ArgsRef a, int wv) {
    const float* __restrict__ AGGH = (const float*)(a.ws + WS_AGGH); const float* __restrict__ AGGP = (const float*)(a.ws + WS_AGGP); float* __restrict__ CARRY = (float*)(a.ws + WS_CARRY);
    const int tid_ = tid_from(wv);
    for (int idx = blockIdx.x * NTHR + tid_; idx < NB * 256; idx += gridDim.x * NTHR) { const int b = idx >> 8, c = idx & 255; float carry = 0.f;
        for (int k0 = 0; k0 < LRU_NCH; k0 += 16) { float pp[16], hh[16];
#pragma unroll
            for (int k = 0; k < 16; ++k) { const size_t o = (size_t)(b * LRU_NCH + k0 + k) * 256 + c; pp[k] = AGGP[o]; hh[k] = AGGH[o]; }
#pragma unroll
            for (int k = 0; k < 16; ++k) { const size_t o = (size_t)(b * LRU_NCH + k0 + k) * 256 + c; CARRY[o] = carry; carry = pp[k] * carry + hh[k]; } } }
}
__device__ __forceinline__ void phase_lru_c(ArgsRef a, int wv) {
    const int tid = tid_from(wv), lane = tid & 63, wave = tid >> 6;
    const int gw = blockIdx.x * NWAVES + wave, NGW = gridDim.x * NWAVES;
    const bf16* proj = (const bf16*)(a.ws + WS_PROJ); bf16* mix = (bf16*)(a.ws + WS_MIX);
    const bf16* HL = (const bf16*)(a.ws + WS_HL); const bf16* PL = (const bf16*)(a.ws + WS_PL); const float* CARRY = (const float*)(a.ws + WS_CARRY);
    for (int t = gw; t < NT; t += NGW) {
        const u32x2 hw = *(const u32x2*)(HL + (size_t)t * 256 + lane * 4), pw = *(const u32x2*)(PL + (size_t)t * 256 + lane * 4), gwd = *(const u32x2*)(proj + (size_t)t * NIN + C_GATE + lane * 4);
        const f32x4 cr = *(const f32x4*)(CARRY + (size_t)(t / LRU_CH) * 256 + lane * 4);
        float h[4] = {bflo(hw.x) + bflo(pw.x) * cr[0], bfhi(hw.x) + bfhi(pw.x) * cr[1], bflo(hw.y) + bflo(pw.y) * cr[2], bfhi(hw.y) + bfhi(pw.y) * cr[3]};
        const float gt[4] = {bflo(gwd.x), bfhi(gwd.x), bflo(gwd.y), bfhi(gwd.y)};
        float s = 0.f;
#pragma unroll
        for (int j = 0; j < 4; ++j) { h[j] *= gelu_tanh(gt[j]); s += h[j] * h[j]; }
        s = wave_sum(s); const float rs = __builtin_amdgcn_rsqf(s * (1.0f / 256.0f) + EPS);
        u32x2 o; o.x = cvt_pk_bf16(h[0] * rs, h[1] * rs); o.y = cvt_pk_bf16(h[2] * rs, h[3] * rs);
        *(u32x2*)(mix + (size_t)t * DM + 256 + lane * 4) = o;
    }
}

typedef short v4i16_t __attribute__((ext_vector_type(4)));
struct AttnUnit { int h, n, r, dl; size_t rowb; int g; };
__device__ __forceinline__ AttnUnit attn_decode(int unit) {
    AttnUnit u; const int blk = unit & 31; u.g = (unit >> 5) % 3; u.h = (unit / 96) & 7; const int b = unit / 768;
    u.dl = (u.g == 0) ? 1 : (u.g == 1 ? 4 : 16); const int nb = 32 / u.dl; u.n = blk % nb; u.r = blk / nb; u.rowb = (size_t)b * SEQ; return u;
}
__device__ __forceinline__ void attn_dma(const __amdgpu_buffer_rsrc_t rs, LAS unsigned char* lds, const AttnUnit& u, int buf, int wave, int lane) {
    const int kr0 = 8 * wave + (lane >> 3), csc = (lane & 7) ^ ((lane >> 3) & 7);
#pragma unroll
    for (int q = 0; q < 4; ++q) { const int keyrow = kr0 + 64 * q; int l = 128 * (u.n - 1) + keyrow; l = l < 0 ? 0 : l;
        const unsigned rowoff = (unsigned)((u.rowb + (size_t)l * u.dl + u.r) * NIN * 2);
        const unsigned srcK = rowoff + (unsigned)((C_K + (u.h >> 2) * 256 + (u.h & 3) * 32) * 2) + (unsigned)((csc >> 2) * 256 + (csc & 3) * 16);
        const unsigned srcV = rowoff + (unsigned)((C_V + u.h * 64) * 2) + (unsigned)(csc * 16);
        LAS unsigned char* dst = lds + buf * 65536 + (wave + 8 * q) * 1024;
        __builtin_amdgcn_raw_ptr_buffer_load_lds(rs, (LAS void*)dst, 16, srcK, 0, 0, 0);
        __builtin_amdgcn_raw_ptr_buffer_load_lds(rs, (LAS void*)(dst + 32768), 16, srcV, 0, 0, 0); }
}
__device__ __forceinline__ void phase_attn(ArgsRef a, LAS unsigned char* lds, int wv) {
    const int tid = tid_from(wv), lane = tid & 63, wave = __builtin_amdgcn_readfirstlane(tid >> 6);
    const bf16* proj = (const bf16*)(a.ws + WS_PROJ);
    bf16* PNUM = (bf16*)(a.ws + WS_PNUM); float* PDEN = (float*)(a.ws + WS_PDEN); float* PMAX = (float*)(a.ws + WS_PMAX);
    const __amdgpu_buffer_rsrc_t rs = __builtin_amdgcn_make_buffer_rsrc((void*)proj, 0, 0x7fffffff, 0x00020000);
    const int lr = lane & 15, lq = lane >> 4, qi0 = 16 * wave, G = gridDim.x;
    constexpr int NUNITS = NB * 8 * 3 * 32;
    const int kro = (qi0 + lr) * 128, kc0 = ((0 + lq) ^ (lr & 7)) * 16, kc1 = ((4 + lq) ^ (lr & 7)) * 16;
    const int q4 = (lane & 15) >> 2, p4 = lane & 3, vrow = qi0 + 4 * lq + q4, vsw = (4 * lq + q4) & 7;
    __syncthreads();
    const bool xo = (G == 256); const int xcd = blockIdx.x & 7, jx = blockIdx.x >> 3;
#define ATT_UNIT(i) (xo ? ((xcd * 16 + (i) / 3) * 96 + ((i) % 3) * 32 + jx) : ((int)blockIdx.x + (i) * G))
    int it = 0; int unit = ATT_UNIT(0);
    AttnUnit cu = attn_decode(unit < NUNITS ? unit : 0);
    bf16x8 qf0, qf1;
    if (unit < NUNITS) { attn_dma(rs, lds, cu, 0, wave, lane);
        const size_t qrow = cu.rowb + (size_t)(128 * cu.n + qi0 + lr) * cu.dl + cu.r;
        const int qc = C_Q + (cu.h >> 2) * 256 + (cu.h & 3) * 32 + lq * 8; qf0 = *(const bf16x8*)(proj + qrow * NIN + qc); qf1 = *(const bf16x8*)(proj + qrow * NIN + qc + 128); }
    int buf = 0;
    asm volatile("s_waitcnt vmcnt(0)" ::: "memory");
    while (unit < NUNITS) {
        asm volatile("s_waitcnt vmcnt(4)" ::: "memory"); __builtin_amdgcn_s_barrier(); asm volatile("" ::: "memory");
        ++it; const int nunit = (xo && it >= 48) ? NUNITS : ATT_UNIT(it); AttnUnit nu = attn_decode(nunit < NUNITS ? nunit : 0); bf16x8 nq0 = qf0, nq1 = qf1;
        if (nunit < NUNITS) { attn_dma(rs, lds, nu, buf ^ 1, wave, lane);
            const size_t qrow = nu.rowb + (size_t)(128 * nu.n + qi0 + lr) * nu.dl + nu.r;
            const int qc = C_Q + (nu.h >> 2) * 256 + (nu.h & 3) * 32 + lq * 8; nq0 = *(const bf16x8*)(proj + qrow * NIN + qc); nq1 = *(const bf16x8*)(proj + qrow * NIN + qc + 128); }
        const LAS unsigned char* Kb = lds + buf * 65536; const LAS unsigned char* Vb = Kb + 32768;
        f32x4 sc[9];
#pragma unroll
        for (int t = 0; t < 9; ++t) { const bf16x8 k0 = *(const LAS bf16x8*)(Kb + kro + t * 2048 + kc0), k1 = *(const LAS bf16x8*)(Kb + kro + t * 2048 + kc1);
            sc[t] = __builtin_amdgcn_mfma_f32_16x16x32_bf16(k0, qf0, (f32x4){0.f, 0.f, 0.f, 0.f}, 0, 0, 0);
            sc[t] = __builtin_amdgcn_mfma_f32_16x16x32_bf16(k1, qf1, sc[t], 0, 0, 0); }
#pragma unroll
        for (int reg = 0; reg < 4; ++reg) { if (4 * lq + reg < lr) sc[0][reg] = -1e30f; if (4 * lq + reg > lr) sc[8][reg] = -1e30f; }
        if (cu.n == 0) {
#pragma unroll
            for (int t = 0; t < 8; ++t)
#pragma unroll
                for (int reg = 0; reg < 4; ++reg) { if (qi0 + 16 * t + 4 * lq + reg < 128) sc[t][reg] = -1e30f; } }
        float mx = -1e30f;
#pragma unroll
        for (int t = 0; t < 9; ++t)
#pragma unroll
            for (int reg = 0; reg < 4; ++reg) mx = fmaxf(mx, sc[t][reg]);
        mx = fmaxf(mx, __shfl_xor(mx, 16)); mx = fmaxf(mx, __shfl_xor(mx, 32));
        float sm = 0.f;
#pragma unroll
        for (int t = 0; t < 9; ++t)
#pragma unroll
            for (int reg = 0; reg < 4; ++reg) { const float pe = __builtin_amdgcn_exp2f(sc[t][reg] - mx); sm += pe; sc[t][reg] = pe; }
        sm += __shfl_xor(sm, 16); sm += __shfl_xor(sm, 32);
        f32x4 oc[4];
#pragma unroll
        for (int dt = 0; dt < 4; ++dt) oc[dt] = (f32x4){0.f, 0.f, 0.f, 0.f};
#pragma unroll
        for (int pi = 0; pi < 5; ++pi) { const int t0 = 2 * pi, t1 = (2 * pi + 1 < 9) ? 2 * pi + 1 : 8;
            u32x4 pw; pw.x = cvt_pk_bf16(sc[t0][0], sc[t0][1]); pw.y = cvt_pk_bf16(sc[t0][2], sc[t0][3]);
            if (2 * pi + 1 < 9) { pw.z = cvt_pk_bf16(sc[t1][0], sc[t1][1]); pw.w = cvt_pk_bf16(sc[t1][2], sc[t1][3]); } else { pw.z = 0u; pw.w = 0u; }
            const bf16x8 pf = __builtin_bit_cast(bf16x8, pw);
#pragma unroll
            for (int dt = 0; dt < 4; ++dt) { const int ch = ((2 * dt + (p4 >> 1)) ^ vsw) * 16 + (p4 & 1) * 8;
                const v4i16_t v0 = __builtin_amdgcn_ds_read_tr16_b64_v4i16((LAS v4i16_t*)(Vb + (vrow + 16 * t0) * 128 + ch));
                const v4i16_t v1 = __builtin_amdgcn_ds_read_tr16_b64_v4i16((LAS v4i16_t*)(Vb + (vrow + 16 * t1) * 128 + ch));
                const bf16x8 vf = (bf16x8){v0[0], v0[1], v0[2], v0[3], v1[0], v1[1], v1[2], v1[3]};
                oc[dt] = __builtin_amdgcn_mfma_f32_16x16x32_bf16(pf, vf, oc[dt], 0, 0, 0); } }
        { LAS bf16* stg = (LAS bf16*)(lds + OST_OFF + wave * 2048);
#pragma unroll
          for (int reg = 0; reg < 4; ++reg)
#pragma unroll
              for (int dt = 0; dt < 4; ++dt) stg[(4 * lq + reg) * 64 + dt * 16 + lr] = f2bf(oc[dt][reg]);
          LDS_WAIT(); asm volatile("" ::: "memory");
#pragma unroll
          for (int i = 0; i < 2; ++i) { const int qq = i * 8 + (lane >> 3), c8 = (lane & 7) * 8; const u32x4 w = *(const LAS u32x4*)(stg + qq * 64 + c8);
              const size_t tok = cu.rowb + (size_t)(128 * cu.n + qi0 + qq) * cu.dl + cu.r;
              *(u32x4*)(PNUM + ((size_t)cu.g * NT + tok) * 512 + cu.h * 64 + c8) = w; }
          LDS_WAIT(); asm volatile("" ::: "memory"); }
        if (lq == 0) { const size_t tok = cu.rowb + (size_t)(128 * cu.n + qi0 + lr) * cu.dl + cu.r; PDEN[((size_t)cu.g * NT + tok) * 8 + cu.h] = sm; PMAX[((size_t)cu.g * NT + tok) * 8 + cu.h] = mx; }
        cu = nu; qf0 = nq0; qf1 = nq1; buf ^= 1; unit = nunit;
    }
#undef ATT_UNIT
}
__device__ __forceinline__ void phase_merge(ArgsRef a, int wv) {
    const int tid = tid_from(wv), lane = tid & 63, wave = tid >> 6;
    const int gw = blockIdx.x * NWAVES + wave, NGW = gridDim.x * NWAVES;
    const bf16* PNUM = (const bf16*)(a.ws + WS_PNUM); const float* PDEN = (const float*)(a.ws + WS_PDEN); const float* PMAX = (const float*)(a.ws + WS_PMAX);
    bf16* mix = (bf16*)(a.ws + WS_MIX);
    const int hd = lane >> 3;
    for (int t = gw; t < NT; t += NGW) {
        float m[3], dn[3]; u32x4 nw[3];
#pragma unroll
        for (int g = 0; g < 3; ++g) { m[g] = PMAX[((size_t)g * NT + t) * 8 + hd]; dn[g] = PDEN[((size_t)g * NT + t) * 8 + hd]; nw[g] = *(const u32x4*)(PNUM + ((size_t)g * NT + t) * 512 + lane * 8); }
        const float mr = fmaxf(fmaxf(m[0], m[1]), m[2]);
        float o[8] = {0.f, 0.f, 0.f, 0.f, 0.f, 0.f, 0.f, 0.f}; float den = 0.f;
#pragma unroll
        for (int g = 0; g < 3; ++g) { const float w = __builtin_amdgcn_exp2f(m[g] - mr); den += w * dn[g];
            o[0] += w * bflo(nw[g].x); o[1] += w * bfhi(nw[g].x); o[2] += w * bflo(nw[g].y); o[3] += w * bfhi(nw[g].y); o[4] += w * bflo(nw[g].z); o[5] += w * bfhi(nw[g].z); o[6] += w * bflo(nw[g].w); o[7] += w * bfhi(nw[g].w); }
        const float inv = 1.0f / den; float s = 0.f;
#pragma unroll
        for (int j = 0; j < 8; ++j) { o[j] *= inv; s += o[j] * o[j]; }
        s = wave_sum(s); const float rs = __builtin_amdgcn_rsqf(s * (1.0f / 512.0f) + EPS);
        u32x4 w; w.x = cvt_pk_bf16(o[0] * rs, o[1] * rs); w.y = cvt_pk_bf16(o[2] * rs, o[3] * rs); w.z = cvt_pk_bf16(o[4] * rs, o[5] * rs); w.w = cvt_pk_bf16(o[6] * rs, o[7] * rs);
        *(u32x4*)(mix + (size_t)t * DM + 512 + lane * 8) = w;
    }
}

__device__ __forceinline__ void phase_router(ArgsRef a, LAS unsigned char* lds, int layer, int wv, bool alloc) {
    const int tid = tid_from(wv), lane = tid & 63, wave = __builtin_amdgcn_readfirstlane(tid >> 6);
    const bf16* xb = (const bf16*)(a.ws + WS_XB); const bf16* wr = (const bf16*)(a.ws + WS_SMALL) + SM_WR + (size_t)layer * NEXP * DM;
    const float* ssqp = (const float*)(a.ws + WS_SSQP); const float* rbias = a.in[I_BR] + layer * NEXP;
    int* LIST = (int*)(a.ws + WS_LIST); float* LRSTD = (float*)(a.ws + WS_LRSTD); float* LGATE = (float*)(a.ws + WS_LGATE2);
    unsigned* cnt = (unsigned*)(a.ws + WS_CTL) + CW_CNT + layer * NEXP;
    LAS float* LG = (LAS float*)lds + wave * 32 * 33;
    LAS int* hist = (LAS int*)(lds + 65536);
    LAS int* base = (LAS int*)(lds + 65536 + 128);
    const int lr = lane & 15, lq = lane >> 4;
    for (int unit = blockIdx.x; unit < NT / 256; unit += gridDim.x) {
        const int tok0 = unit * 256 + wave * 32;
        __syncthreads();
        if (tid < 32) hist[tid] = 0;
        f32x4 acc[2][2];
#pragma unroll
        for (int rt = 0; rt < 2; ++rt)
#pragma unroll
            for (int et = 0; et < 2; ++et) acc[rt][et] = (f32x4){0.f, 0.f, 0.f, 0.f};
#pragma unroll 4
        for (int ks = 0; ks < 32; ++ks) { bf16x8 af[2], bfr[2];
#pragma unroll
            for (int rt = 0; rt < 2; ++rt) af[rt] = *(const bf16x8*)(xb + (size_t)(tok0 + rt * 16 + lr) * DM + ks * 32 + lq * 8);
#pragma unroll
            for (int et = 0; et < 2; ++et) bfr[et] = *(const bf16x8*)(wr + (size_t)(et * 16 + lr) * DM + ks * 32 + lq * 8);
#pragma unroll
            for (int rt = 0; rt < 2; ++rt)
#pragma unroll
                for (int et = 0; et < 2; ++et) acc[rt][et] = __builtin_amdgcn_mfma_f32_16x16x32_bf16(af[rt], bfr[et], acc[rt][et], 0, 0, 0); }
#pragma unroll
        for (int rt = 0; rt < 2; ++rt)
#pragma unroll
            for (int et = 0; et < 2; ++et)
#pragma unroll
                for (int reg = 0; reg < 4; ++reg) LG[(rt * 16 + lq * 4 + reg) * 33 + et * 16 + lr] = acc[rt][et][reg];
        __syncthreads();
        int te[4] = {0, 0, 0, 0}; float tg[4] = {0.f, 0.f, 0.f, 0.f}; int rk[4] = {0, 0, 0, 0}; float rstd = 0.f; const int tok = tok0 + lane;
        if (lane < 32) {
            const float* sp = ssqp + (size_t)tok * 16; float ss = 0.f;
#pragma unroll
            for (int j = 0; j < 16; ++j) ss += sp[j];
            rstd = __builtin_amdgcn_rsqf(ss * (1.0f / DM) + EPS);
            float tv[4] = {-3e38f, -3e38f, -3e38f, -3e38f};
            for (int e = 0; e < NEXP; ++e) { float v = LG[lane * 33 + e] * rstd + rbias[e]; int ve = e;
#pragma unroll
                for (int k = 0; k < 4; ++k) { if (v > tv[k]) { const float tvv = tv[k]; const int tee = te[k]; tv[k] = v; te[k] = ve; v = tvv; ve = tee; } } }
            float z = 0.f;
#pragma unroll
            for (int k = 0; k < 4; ++k) { tg[k] = fast_exp(tv[k] - tv[0]); z += tg[k]; }
            const float iz = 1.0f / z;
#pragma unroll
            for (int k = 0; k < 4; ++k) { tg[k] *= iz; rk[k] = __hip_atomic_fetch_add(&hist[te[k]], 1, __ATOMIC_RELAXED, __HIP_MEMORY_SCOPE_WORKGROUP); }
        }
        __syncthreads();
        if (tid < 32) base[tid] = alloc ? (int)__hip_atomic_fetch_add(cnt + tid, (unsigned)hist[tid], RLX_AGENT) : 0;
        __syncthreads();
        if (lane < 32 && alloc) {
#pragma unroll
            for (int k = 0; k < 4; ++k) { const size_t p = (size_t)te[k] * NT + base[te[k]] + rk[k]; LIST[p] = tok * 4 + k; LRSTD[p] = rstd; LGATE[p] = tg[k]; }
        }
    }
}

__device__ __forceinline__ void phase_combine(ArgsRef a, bool last_layer, int wv, bool dry) {
    const int tid = tid_from(wv), lane = tid & 63, wave = tid >> 6;
    const int gw = blockIdx.x * NWAVES + wave, NGW = gridDim.x * NWAVES;
    const unsigned char* __restrict__ Y = (const unsigned char*)(a.ws + WS_Y); float* __restrict__ out = a.out; bf16* xb = (bf16*)(a.ws + WS_XB); float* __restrict__ ssq = (float*)(a.ws + WS_SSQ);
    typedef float f2v __attribute__((ext_vector_type(2)));
    for (int t = gw; t < NT; t += NGW) {
        const u32x4 x0 = *((const u32x4*)(xb + (size_t)t * DM) + 2 * lane), x1 = *((const u32x4*)(xb + (size_t)t * DM) + 2 * lane + 1);
        u32x4 y[4];
#pragma unroll
        for (int k = 0; k < 4; ++k) y[k] = *((const u32x4*)(Y + ((size_t)t * 4 + k) * DM) + lane);
        float v[16];
        v[0] = bflo(x0.x); v[1] = bfhi(x0.x); v[2] = bflo(x0.y); v[3] = bfhi(x0.y); v[4] = bflo(x0.z); v[5] = bfhi(x0.z); v[6] = bflo(x0.w); v[7] = bfhi(x0.w);
        v[8] = bflo(x1.x); v[9] = bfhi(x1.x); v[10] = bflo(x1.y); v[11] = bfhi(x1.y); v[12] = bflo(x1.z); v[13] = bfhi(x1.z); v[14] = bflo(x1.w); v[15] = bfhi(x1.w);
#pragma unroll
        for (int k = 0; k < 4; ++k)
#pragma unroll
            for (int d = 0; d < 4; ++d) { const int w = (int)y[k][d]; const f2v lo = __builtin_amdgcn_cvt_pk_f32_fp8(w, false), hi = __builtin_amdgcn_cvt_pk_f32_fp8(w, true);
                v[4 * d + 0] += lo.x * (1.0f / Y8_SCALE); v[4 * d + 1] += lo.y * (1.0f / Y8_SCALE); v[4 * d + 2] += hi.x * (1.0f / Y8_SCALE); v[4 * d + 3] += hi.y * (1.0f / Y8_SCALE); }
        float s = 0.f;
#pragma unroll
        for (int j = 0; j < 16; ++j) s += v[j] * v[j];
        if (dry && s != 12345.678f) continue;
        if (last_layer) {
#pragma unroll
            for (int j = 0; j < 4; ++j) *((f32x4*)(out + (size_t)t * DM) + 4 * lane + j) = (f32x4){v[4 * j], v[4 * j + 1], v[4 * j + 2], v[4 * j + 3]};
        } else { s = wave_sum(s);
            u32x4 w0, w1; w0.x = cvt_pk_bf16(v[0], v[1]); w0.y = cvt_pk_bf16(v[2], v[3]); w0.z = cvt_pk_bf16(v[4], v[5]); w0.w = cvt_pk_bf16(v[6], v[7]);
            w1.x = cvt_pk_bf16(v[8], v[9]); w1.y = cvt_pk_bf16(v[10], v[11]); w1.z = cvt_pk_bf16(v[12], v[13]); w1.w = cvt_pk_bf16(v[14], v[15]);
            *((u32x4*)(xb + (size_t)t * DM) + 2 * lane) = w0; *((u32x4*)(xb + (size_t)t * DM) + 2 * lane + 1) = w1;
            if (lane == 0) ssq[t] = s; }
    }
}

constexpr int NPH_LAYER = 13, NPH = 1 + 2 * NPH_LAYER;
enum { PH_GEMM_IN = 0, PH_QKPREP, PH_POOL, PH_LRU_A, PH_LRU_B, PH_ATTN, PH_LRU_C, PH_MERGE, PH_GEMM_OUT, PH_ROUTER, PH_MOE_GU, PH_MOE_DOWN, PH_COMBINE };
#ifndef MK_STOP
#define MK_STOP NPH
#endif
#ifndef MK_SPLIT
#define MK_SPLIT 0
#endif

template <int PHMASK>
__global__ void __launch_bounds__(NTHR, 2) mega_fwd(Args args_by_value) {
    extern __shared__ __attribute__((aligned(16))) unsigned char lds_raw[];
    LAS unsigned char* lds = (LAS unsigned char*)lds_raw;
    const int tid = threadIdx.x;
    int wv = __builtin_amdgcn_readfirstlane(tid >> 6); asm volatile("" : "+s"(wv));
    for (int u = tid; u < (LDS_BYTES - LDSCTL_OFF) / 4; u += NTHR) ((LAS unsigned*)(lds + LDSCTL_OFF))[u] = 0u;
    __syncthreads();
#define ARGS_HERE() const CAS Args* ap_ = (const CAS Args*)__builtin_amdgcn_kernarg_segment_ptr(); asm volatile("" : "+s"(ap_)); ArgsRef args = *ap_; unsigned char* const ws = args.ws; unsigned* const ctl = (unsigned*)(ws + WS_CTL); (void)ctl
    int lo, hi;
    { ARGS_HERE(); lo = args.ph_lo; hi = args.ph_hi; xcd_barrier_post(ctl + CW_BAR + args.li * XCD_BAR_WORDS, (volatile LAS unsigned*)(lds + MISC_OFF) + 8); }
#define EN(p) (((PHMASK) >> (p)) & 1)
#ifndef MK_DUP
#define MK_DUP 0
#endif
#define NREP(p) ((((MK_DUP) >> (p)) & 1) ? 2 : 1)
#define IN(k) (lo <= (k) && (k) < hi)
#define SEAM(k) do { if (IN(k) && IN((k) + 1)) { ARGS_HERE(); XcdBarrier bar_; bar_.bar = ctl + CW_BAR + args.li * XCD_BAR_WORDS; bar_.x = xb_xcc_id(); bar_.st = (volatile LAS unsigned*)(lds + MISC_OFF) + 8; xcd_barrier(bar_); } } while (0)

    if (EN(13) && IN(0)) { ARGS_HERE(); for (int rep_ = 0; rep_ < NREP(13); ++rep_) { phase_prologue(args, lds, wv); } }
    SEAM(0);
    for (int l = 0; l < 2; ++l) {
        const int pb = 1 + NPH_LAYER * l;
        if (EN(PH_GEMM_IN) && IN(pb + PH_GEMM_IN)) { ARGS_HERE();
            pg8::StaticOrder S; S.init(NT, NIN, DM, gridDim.x, blockIdx.x); S.dup = NREP(PH_GEMM_IN) - 1;
            EpiIn E{(bf16*)(ws + WS_PROJ), (const float*)(ws + WS_SSQ), args.in[I_QG] + l * 64, args.in[I_KG] + l * 64, (const float*)(ws + WS_ROPE), (const float*)(ws + WS_ROPE) + SEQ * 32};
            pg8::gemm_phase<EpiIn, pg8::StaticOrder, true>(lds, (const bf16*)(ws + WS_XB), (const bf16*)(ws + WS_WIN) + (size_t)l * NIN * DM, DM, S, E, wv);
        }
        SEAM(pb + PH_GEMM_IN);
        if (EN(PH_POOL) && IN(pb + PH_POOL)) { ARGS_HERE(); for (int rep_ = 0; rep_ < NREP(PH_POOL); ++rep_) { phase_pool(args, lds, l, wv); } }
        if (EN(PH_LRU_A) && IN(pb + PH_LRU_A)) { ARGS_HERE(); for (int rep_ = 0; rep_ < NREP(PH_LRU_A); ++rep_) { phase_lru_a(args, lds, l, wv); } }
        SEAM(pb + PH_LRU_A);
        if (EN(PH_LRU_B) && IN(pb + PH_LRU_B)) { ARGS_HERE(); for (int rep_ = 0; rep_ < NREP(PH_LRU_B); ++rep_) { phase_lru_b(args, wv); } }
        if (EN(PH_ATTN) && IN(pb + PH_ATTN)) { ARGS_HERE(); for (int rep_ = 0; rep_ < NREP(PH_ATTN); ++rep_) { phase_attn(args, lds, wv); } }
        SEAM(pb + PH_ATTN);
        if (EN(PH_LRU_C) && IN(pb + PH_LRU_C)) { ARGS_HERE(); for (int rep_ = 0; rep_ < NREP(PH_LRU_C); ++rep_) { phase_lru_c(args, wv); } }
        if (EN(PH_MERGE) && IN(pb + PH_MERGE)) { ARGS_HERE(); for (int rep_ = 0; rep_ < NREP(PH_MERGE); ++rep_) { phase_merge(args, wv); } }
        SEAM(pb + PH_MERGE);
        if (EN(PH_GEMM_OUT) && IN(pb + PH_GEMM_OUT)) { ARGS_HERE();
            __syncthreads();
            pg8::StaticOrder S; S.init(NT, DM, DM, gridDim.x, blockIdx.x); S.dup = (l == 0) ? NREP(PH_GEMM_OUT) - 1 : 0;
            EpiOut E{(bf16*)(ws + WS_XB), (float*)(ws + WS_SSQP)};
            pg8::gemm_phase<EpiOut, pg8::StaticOrder, true>(lds, (const bf16*)(ws + WS_MIX), (const bf16*)(ws + WS_WOUT) + (size_t)l * DM * DM, DM, S, E, wv);
        }
        SEAM(pb + PH_GEMM_OUT);
        if (EN(PH_ROUTER) && IN(pb + PH_ROUTER)) { ARGS_HERE(); for (int rep_ = 0; rep_ < NREP(PH_ROUTER); ++rep_) { phase_router(args, lds, l, wv, rep_ == NREP(PH_ROUTER) - 1); } }
        SEAM(pb + PH_ROUTER);
        if (EN(PH_MOE_GU) && IN(pb + PH_MOE_GU)) { ARGS_HERE();
            LAS int* tab = (LAS int*)(lds + TAB_OFF);
            moe_tables(tab, ctl + CW_CNT + l * NEXP, wv);
            MoeOrder<0> S{tab, 2, (int)gridDim.x, (int)blockIdx.x, (const int*)(ws + WS_LIST), NREP(PH_MOE_GU) - 1};
            EpiGU E{(bf16*)(ws + WS_ACT), (const float*)(ws + WS_LRSTD), args.in[I_BGU] + (size_t)l * NEXP * 512};
            pg8::gemm_phase<EpiGU, MoeOrder<0>, true>(lds, (const bf16*)(ws + WS_XB), (const bf16*)(ws + WS_WGU) + (size_t)l * NEXP * 512 * DM, DM, S, E, wv);
        }
        SEAM(pb + PH_MOE_GU);
        if (EN(PH_MOE_DOWN) && IN(pb + PH_MOE_DOWN)) { ARGS_HERE();
            LAS int* tab = (LAS int*)(lds + TAB_OFF);
            moe_tables(tab, ctl + CW_CNT + l * NEXP, wv);
            MoeOrder<1> S{tab, 4, (int)gridDim.x, (int)blockIdx.x, (const int*)(ws + WS_LIST), NREP(PH_MOE_DOWN) - 1};
            EpiDown E{(unsigned char*)(ws + WS_Y), (const int*)(ws + WS_LIST), (const float*)(ws + WS_LGATE2), args.in[I_BD] + (size_t)l * NEXP * DM, tab};
            pg8::gemm_phase<EpiDown, MoeOrder<1>, true>(lds, (const bf16*)(ws + WS_ACT), (const bf16*)(ws + WS_WD) + (size_t)l * NEXP * DM * EFF, EFF, S, E, wv);
        }
        SEAM(pb + PH_MOE_DOWN);
        if (EN(PH_COMBINE) && IN(pb + PH_COMBINE)) { ARGS_HERE(); for (int rep_ = 0; rep_ < NREP(PH_COMBINE); ++rep_) { phase_combine(args, l == 1, wv, rep_ < NREP(PH_COMBINE) - 1); } }
        SEAM(pb + PH_COMBINE);
    }
#undef IN
#undef SEAM
}

typedef void (*kern_t)(Args);
template <int M> static kern_t kern_of() { return (kern_t)mega_fwd<M>; }
static kern_t phase_kernel(int p) {
    switch (p) { case 0: return kern_of<1 << 0>(); case 1: return kern_of<1 << 1>(); case 2: return kern_of<1 << 2>(); case 3: return kern_of<1 << 3>(); case 4: return kern_of<1 << 4>();
                 case 5: return kern_of<1 << 5>(); case 6: return kern_of<1 << 6>(); case 7: return kern_of<1 << 7>(); case 8: return kern_of<1 << 8>(); case 9: return kern_of<1 << 9>();
                 case 10: return kern_of<1 << 10>(); case 11: return kern_of<1 << 11>(); case 12: return kern_of<1 << 12>(); default: return kern_of<1 << 13>(); }
}
extern "C" void kernel_launch(void* const* d_in, const int* in_sizes, int n_in, void* d_out, int out_size, void* d_ws, size_t ws_size, hipStream_t stream) {
    static int grid = 0;
    if (grid == 0) {
        if (n_in != 23 || in_sizes[0] != NT * DM || out_size != NT * DM || ws_size < WS_END) {
            fprintf(stderr, "kernel_launch: built for 23 inputs, x/out of %d floats, >= %zu bytes of workspace; got n_in %d, in0 %d, out %d, ws %zu; nothing launched\n", NT * DM, (size_t)WS_END, n_in, n_in > 0 ? in_sizes[0] : -1, out_size, ws_size);
            grid = -1; return; }
        int dev = 0, cus = 0;
        if (hipGetDevice(&dev) != hipSuccess || hipDeviceGetAttribute(&cus, hipDeviceAttributeMultiprocessorCount, dev) != hipSuccess) { fprintf(stderr, "kernel_launch: device query failed\n"); grid = -1; return; }
#if MK_SPLIT
        for (int p = 0; p < 14; ++p) if (hipFuncSetAttribute((const void*)phase_kernel(p), hipFuncAttributeMaxDynamicSharedMemorySize, LDS_BYTES) != hipSuccess) { fprintf(stderr, "kernel_launch: hipFuncSetAttribute failed\n"); grid = -1; return; }
#else
        if (hipFuncSetAttribute((const void*)kern_of<0x3fff>(), hipFuncAttributeMaxDynamicSharedMemorySize, LDS_BYTES) != hipSuccess) { fprintf(stderr, "kernel_launch: hipFuncSetAttribute failed\n"); grid = -1; return; }
        int per_cu = 0;
        if (hipOccupancyMaxActiveBlocksPerMultiprocessor(&per_cu, (const void*)kern_of<0x3fff>(), NTHR, LDS_BYTES) != hipSuccess || per_cu < 1)
            fprintf(stderr, "kernel_launch: note: occupancy query reports %d workgroups per CU\n", per_cu);
#endif
        (void)hipGetLastError();
        grid = cus;
    }
    if (grid < 0) return;
    if (hipMemsetAsync((char*)d_ws + WS_CTL, 0, CTL_ZERO_BYTES, stream) != hipSuccess) { fprintf(stderr, "kernel_launch: hipMemsetAsync failed\n"); return; }
    Args a{};
    for (int i = 0; i < 23; ++i) a.in[i] = (const float*)d_in[i];
    a.out = (float*)d_out; a.ws = (unsigned char*)d_ws; a.pad = 0;
#if MK_SPLIT
#ifdef MK_SKIP
    (void)hipMemsetAsync((char*)d_ws + WS_MIX, 0, (size_t)NT * DM * 2, stream);
#endif
    for (int p = 0; p < MK_STOP; ++p) { a.ph_lo = p; a.ph_hi = p + 1; a.li = p;
#ifdef MK_SKIP
        if (p >= 1 && (((MK_SKIP) >> ((p - 1) % NPH_LAYER)) & 1)) continue;
#endif
        hipLaunchKernelGGL(phase_kernel(p == 0 ? 13 : (p - 1) % NPH_LAYER), dim3(grid), dim3(NTHR), LDS_BYTES, stream, a); }
#else
    a.ph_lo = 0; a.ph_hi = NPH; a.li = 0;
    hipLaunchKernelGGL(kern_of<0x3fff>(), dim3(grid), dim3(NTHR), LDS_BYTES, stream, a);
#endif
    const hipError_t le = hipPeekAtLastError();
    if (le != hipSuccess) fprintf(stderr, "kernel_launch: launch failed: %s\n", hipGetErrorName(le));
}
```

```cpp
#include <hip/hip_runtime.h>
#include <cstdio>
#include <cstdint>

#define LAS __attribute__((address_space(3)))
#define GAS __attribute__((address_space(1)))
typedef unsigned short bf16;
typedef short bf16x8 __attribute__((ext_vector_type(8)));
typedef float f32x4 __attribute__((ext_vector_type(4)));
typedef float f32x2 __attribute__((ext_vector_type(2)));
typedef unsigned u32x4 __attribute__((ext_vector_type(4)));
typedef unsigned u32x2 __attribute__((ext_vector_type(2)));

#ifndef MK_VAR
#define MK_VAR 0
#endif
constexpr int NB = 16, SEQ = 4096, DM = 1024, NT = NB * SEQ;
constexpr int NIN = 2304;
constexpr int C_POOL = 0, C_LRU = 256, C_GATE = 512, C_Q = 768, C_K = 1280, C_V = 1792;
constexpr int NEXP = 32, TOPK = 4, EFF = 256;
constexpr int NASSIGN = NT * TOPK;
constexpr int ACT_ROWS = NASSIGN + NEXP * 256;
constexpr float EPS = 1e-6f;
constexpr int NWAVES = 8, NTHR = 512;
constexpr int LRU_CH = 32, LRU_NCH = SEQ / LRU_CH;

constexpr size_t MiB = 1u << 20;
constexpr size_t WS_CTL = 0, CTL_ZERO_BYTES = 1 * MiB;
constexpr size_t WS_ROPE = 1 * MiB;
constexpr size_t WS_SMALL = 2 * MiB;
constexpr size_t WS_WIN = 4 * MiB;
constexpr size_t WS_WOUT = 13 * MiB;
constexpr size_t WS_WGU = 17 * MiB;
constexpr size_t WS_WD = 81 * MiB;
constexpr size_t WS_SSQ = 113 * MiB;
constexpr size_t WS_SSQP = 114 * MiB;
constexpr size_t WS_LIST = 118 * MiB;
constexpr size_t WS_XB = 128 * MiB;
constexpr size_t WS_R = 256 * MiB;
constexpr size_t WS_PROJ = WS_R;
constexpr size_t WS_MIX = WS_R + 288 * MiB;
constexpr size_t WS_PNUM = WS_R + 416 * MiB;
constexpr size_t WS_PDEN = WS_R + 608 * MiB;
constexpr size_t WS_PMAX = WS_R + 614 * MiB;
constexpr size_t WS_HL = WS_R + 620 * MiB;
constexpr size_t WS_PL = WS_R + 652 * MiB;
constexpr size_t WS_AGGH = WS_R + 684 * MiB;
constexpr size_t WS_AGGP = WS_R + 686 * MiB;
constexpr size_t WS_CARRY = WS_R + 688 * MiB;
constexpr size_t WS_YP = WS_R + 690 * MiB;
constexpr size_t WS_SSQPOOL = WS_R + 722 * MiB;
constexpr size_t WS_ACT = WS_R;
constexpr size_t WS_Y = WS_R + 132 * MiB;
constexpr size_t WS_LRSTD = WS_R + 644 * MiB;
constexpr size_t WS_LGATE2 = WS_R + 652 * MiB;
constexpr size_t WS_END = 1024 * MiB;
static_assert(WS_CARRY + 2 * MiB <= WS_END && WS_LGATE2 + 8 * MiB <= WS_END, "d_ws map");
constexpr size_t SM_POOLW = 0;
constexpr size_t SM_WA = 32768;
constexpr size_t SM_WX = 65536;
constexpr size_t SM_WR = 98304;
constexpr int CW_BAR = 4096;
constexpr int CW_CNT = 1024;

constexpr int RING_BYTES = 131072;
constexpr int LDSCTL_OFF = RING_BYTES;
constexpr int MISC_OFF = LDSCTL_OFF + 320;
constexpr int TAB_OFF = LDSCTL_OFF + 1024;
constexpr int OST_OFF = RING_BYTES + 8192;
constexpr int LDS_BYTES = 163840;

typedef GAS unsigned gu32;
#define RLX_AGENT __ATOMIC_RELAXED, __HIP_MEMORY_SCOPE_AGENT
#define LDS_WAIT() asm volatile("s_waitcnt lgkmcnt(0)" ::: "memory")
#define VM_WAIT() asm volatile("s_waitcnt vmcnt(0)" ::: "memory")
typedef __bf16 bf16x2_t __attribute__((ext_vector_type(2)));
__device__ __forceinline__ unsigned cvt_pk_bf16(float lo, float hi) { const f32x2 v = {lo, hi}; const bf16x2_t b = __builtin_convertvector(v, bf16x2_t); return __builtin_bit_cast(unsigned, b); }
__device__ __forceinline__ float bflo(unsigned w) { return __uint_as_float(w << 16); }
__device__ __forceinline__ float bfhi(unsigned w) { return __uint_as_float(w & 0xffff0000u); }
__device__ __forceinline__ float bf2f(bf16 h) { return __uint_as_float((unsigned)h << 16); }
__device__ __forceinline__ bf16 f2bf(float f) { return (bf16)(cvt_pk_bf16(f, 0.f) & 0xffffu); }
__device__ __forceinline__ float wave_sum(float v) {
#pragma unroll
    for (int o = 1; o < 64; o <<= 1) v += __shfl_xor(v, o);
    return v;
}
__device__ __forceinline__ float fast_sigmoid(float x) { return __builtin_amdgcn_rcpf(1.0f + __builtin_amdgcn_exp2f(-1.4426950408889634f * x)); }
__device__ __forceinline__ float fast_exp(float x) { return __builtin_amdgcn_exp2f(1.4426950408889634f * x); }
__device__ __forceinline__ float gelu_tanh(float x) {
    const float u = 0.7978845608028654f * (x + 0.044715f * x * x * x);
    return x * fast_sigmoid(2.0f * u);
}
__device__ __forceinline__ int tid_from(int wv) { int ln; asm volatile("v_mbcnt_lo_u32_b32 %0, -1, 0\n\tv_mbcnt_hi_u32_b32 %0, -1, %0" : "=v"(ln)); return wv * 64 + ln; }
namespace pg8 {
constexpr int BM = 256, BK = 64, HALF = 128, HTB = HALF * BK * 2  , STAGE_BYTES = 8 * HTB, NXCD = 8, WGM = 8;

__host__ __device__ __forceinline__ int lds_byte(int r, int c) { const int st = (r >> 4) * 2 + (c >> 5), rr = r & 15, cc = c & 31, ob = rr * 64 + cc * 2; return st * 1024 + (ob ^ (((ob >> 9) & 1) << 5)); }
__host__ __device__ __forceinline__ void stage_rc(int b, int& R, int& C) { const int st = b / 1024, sb = b % 1024, swz = sb ^ (((sb >> 9) & 1) << 5); R = (st >> 1) * 16 + swz / 64; C = (st & 1) * 32 + (swz % 64) / 2; }
__host__ __device__ __forceinline__ int perm32(int rho) { const int n = rho >> 4, i = rho & 15; return 8 * (i >> 2) + 4 * n + (i & 3); }

struct Unit { int pm, pn, e, aux; };

template <class Epi, class Sched, bool ALIGN_EPI>
__device__ __forceinline__ void gemm_phase(LAS unsigned char* lds, const bf16* Abase, const bf16* Bbase, const int K, const Sched& S, const Epi& E, const int wv) {
    const int tid = tid_from(wv), wid = __builtin_amdgcn_readfirstlane(tid >> 6), lane = tid & 63, wr = wid >> 2, wc = wid & 3, fr = lane & 15, fq = lane >> 4;
    const int nt = K / BK;
    unsigned voffB[2];
#pragma unroll
    for (int i = 0; i < 2; ++i) { int R, C; stage_rc(tid * 16 + i * 8192, R, C); const int Rb = Epi::PERM ? ((R & ~31) + perm32(R & 31)) : R;
        voffB[i] = (unsigned)(Rb * K + C) * 2u; }
#define PG8_AVOFF(u, h, i) ([&]() { int R_, C_; stage_rc(tid * 16 + (i) * 8192, R_, C_); return S.a_voff((u), (h) * HALF + R_, C_); }())
    const unsigned kstep = (unsigned)(BK * 2);
    const unsigned hstep = (unsigned)(HALF * K * 2);
    const unsigned ldsw = (unsigned)wid * 1024u;
    const int aoff = lds_byte(wr * 64 + fr, fq * 8), boff = lds_byte(wc * 32 + fr, fq * 8);
    const __amdgpu_buffer_rsrc_t rsA = __builtin_amdgcn_make_buffer_rsrc((void*)Abase, 0, 0x7fffffff, 0x00020000);
    const __amdgpu_buffer_rsrc_t rsB = __builtin_amdgcn_make_buffer_rsrc((void*)Bbase, 0, 0x7fffffff, 0x00020000);
#define PG8_SA(b, h) (((b) * 2 + (h)) * HTB)
#define PG8_SB(b, h) ((4 + (b) * 2 + (h)) * HTB)
#define PG8_STAGE_B(bufoff, soff) do { const int so_ = __builtin_amdgcn_readfirstlane((int)(soff)); _Pragma("unroll") for (int _i = 0; _i < 2; ++_i) \
        __builtin_amdgcn_raw_ptr_buffer_load_lds(rsB, (LAS void*)(lds + (bufoff) + ldsw + _i * 8192), 16, voffB[_i], so_, 0, 0); } while (0)
#define PG8_STAGE_A(bufoff, kbytes, v0, v1) do { const int so_ = __builtin_amdgcn_readfirstlane((int)(kbytes)); \
        __builtin_amdgcn_raw_ptr_buffer_load_lds(rsA, (LAS void*)(lds + (bufoff) + ldsw), 16, (v0), so_, 0, 0); \
        __builtin_amdgcn_raw_ptr_buffer_load_lds(rsA, (LAS void*)(lds + (bufoff) + ldsw + 8192), 16, (v1), so_, 0, 0); } while (0)
#define PG8_LDA(dst, b, h) do { _Pragma("unroll") for (int m = 0; m < 4; ++m) _Pragma("unroll") for (int k = 0; k < 2; ++k) dst[m][k] = *(const LAS bf16x8*)(lds + PG8_SA(b, h) + aoff + m * 2048 + k * 1024); } while (0)
#define PG8_LDB(dst, b, h) do { _Pragma("unroll") for (int n = 0; n < 2; ++n) _Pragma("unroll") for (int k = 0; k < 2; ++k) dst[n][k] = *(const LAS bf16x8*)(lds + PG8_SB(b, h) + boff + n * 2048 + k * 1024); } while (0)
#define PG8_MMA(ai, bj, At, Bt) do { __builtin_amdgcn_s_setprio(1); _Pragma("unroll") for (int m = 0; m < 4; ++m) _Pragma("unroll") for (int n = 0; n < 2; ++n) _Pragma("unroll") for (int k = 0; k < 2; ++k) \
        acc[ai][bj][m][n] = __builtin_amdgcn_mfma_f32_16x16x32_bf16(Bt[n][k], At[m][k], acc[ai][bj][m][n], 0, 0, 0); __builtin_amdgcn_s_setprio(0); } while (0)
#define PG8_WAIT_V(n) asm volatile("s_waitcnt vmcnt(" #n ")" ::: "memory")
#define PG8_WAIT_L(n) asm volatile("s_waitcnt lgkmcnt(" #n ")" ::: "memory")
#define PG8_BAR __builtin_amdgcn_s_barrier()
#define PG8_SCHED __builtin_amdgcn_sched_barrier(0)
    Unit cur, nxt; int ui = 0;
    if (!S.next(0, cur)) return;
    f32x4 acc[2][2][4][2];
#pragma unroll
    for (int a = 0; a < 2; ++a)
#pragma unroll
        for (int b = 0; b < 2; ++b)
#pragma unroll
            for (int m = 0; m < 4; ++m)
#pragma unroll
                for (int n = 0; n < 2; ++n) acc[a][b][m][n] = (f32x4){0.f, 0.f, 0.f, 0.f};
    bf16x8 At[4][2], B0[2][2], B1[2][2];
    unsigned vc0, vc1, vc2, vc3, vn0, vn1, vn2, vn3;
    unsigned cA0, cA1, nA0, nA1;
    vc0 = PG8_AVOFF(cur, 0, 0); vc1 = PG8_AVOFF(cur, 0, 1);
    if constexpr (Sched::GATHER) { vc2 = PG8_AVOFF(cur, 1, 0); vc3 = PG8_AVOFF(cur, 1, 1); } else { vc2 = vc0; vc3 = vc1; }
    cA0 = S.a_soff(cur, 0); cA1 = S.a_soff(cur, 1);
    unsigned cB = (unsigned)S.b_off(cur);
    PG8_STAGE_B(PG8_SB(0, 0), cB); PG8_STAGE_B(PG8_SB(0, 1), cB + hstep); PG8_STAGE_A(PG8_SA(0, 0), cA0, vc0, vc1); PG8_STAGE_A(PG8_SA(0, 1), cA1, vc2, vc3);
    if (wr == 1) PG8_BAR;
    PG8_WAIT_V(2); PG8_BAR;
    PG8_STAGE_B(PG8_SB(1, 0), cB + kstep); PG8_STAGE_A(PG8_SA(1, 0), cA0 + kstep, vc0, vc1); PG8_STAGE_B(PG8_SB(1, 1), cB + hstep + kstep);
    PG8_WAIT_V(6); PG8_BAR;
    for (;;) {
#define PG8_TRIP(a1k, a2k0, a2k1, a3k0, b2, b3, w0, w1, w2, w3) do { \
              \
            PG8_LDB(B0, 0, 0); PG8_LDB(B1, 0, 1); PG8_SCHED; PG8_LDA(At, 0, 0); PG8_STAGE_A(PG8_SA(1, 1), a1k, vc2, vc3); \
            PG8_WAIT_V(8); PG8_WAIT_L(0); PG8_BAR; PG8_MMA(0, 0, At, B0); PG8_MMA(0, 1, At, B1); PG8_BAR; PG8_SCHED; \
              \
            PG8_LDA(At, 0, 1); PG8_STAGE_B(PG8_SB(0, 0), b2); PG8_STAGE_B(PG8_SB(0, 1), (b2) + hstep); PG8_STAGE_A(PG8_SA(0, 0), a2k0, w0, w1); \
            PG8_WAIT_V(8); PG8_WAIT_L(0); PG8_BAR; PG8_MMA(1, 0, At, B0); PG8_MMA(1, 1, At, B1); PG8_BAR; PG8_SCHED; \
              \
            PG8_LDB(B0, 1, 0); PG8_LDB(B1, 1, 1); PG8_SCHED; PG8_LDA(At, 1, 0); PG8_STAGE_A(PG8_SA(0, 1), a2k1, w2, w3); \
            PG8_WAIT_V(8); PG8_WAIT_L(0); PG8_BAR; PG8_MMA(0, 0, At, B0); PG8_MMA(0, 1, At, B1); PG8_BAR; PG8_SCHED; \
              \
            PG8_LDA(At, 1, 1); PG8_STAGE_B(PG8_SB(1, 0), b3); PG8_STAGE_B(PG8_SB(1, 1), (b3) + hstep); PG8_STAGE_A(PG8_SA(1, 0), a3k0, w0, w1); \
            PG8_WAIT_V(8); PG8_WAIT_L(0); PG8_BAR; PG8_MMA(1, 0, At, B0); PG8_MMA(1, 1, At, B1); PG8_BAR; PG8_SCHED; } while (0)
        for (int t = 0; t < nt - 2; t += 2) {
            const unsigned k1 = (unsigned)(t + 1) * kstep, k2 = (unsigned)(t + 2) * kstep, b2 = cB + k2, b3 = b2 + kstep;
            PG8_TRIP(cA1 + k1, cA0 + k2, cA1 + k2, cA0 + k2 + kstep, b2, b3, vc0, vc1, vc2, vc3);
        }
        const bool has_next = S.next(ui + 1, nxt);
        unsigned nB;
        if (has_next) { if constexpr (Sched::GATHER) { vn0 = PG8_AVOFF(nxt, 0, 0); vn1 = PG8_AVOFF(nxt, 0, 1); vn2 = PG8_AVOFF(nxt, 1, 0); vn3 = PG8_AVOFF(nxt, 1, 1); } else { vn0 = vc0; vn1 = vc1; vn2 = vc0; vn3 = vc1; }
                        nA0 = S.a_soff(nxt, 0); nA1 = S.a_soff(nxt, 1); nB = (unsigned)S.b_off(nxt); }
        else { vn0 = vc0; vn1 = vc1; vn2 = vc2; vn3 = vc3; nA0 = cA0; nA1 = cA1; nB = cB; }
        { const unsigned k1 = (unsigned)(nt - 1) * kstep;
          PG8_TRIP(cA1 + k1, nA0, nA1, nA0 + kstep, nB, nB + kstep, vn0, vn1, vn2, vn3); }
#undef PG8_TRIP
        if constexpr (ALIGN_EPI) { if (wr == 0) PG8_BAR; }
        E(acc, cur, wr, wc, fr, fq);
        if (!has_next) break;
#pragma unroll
        for (int a = 0; a < 2; ++a)
#pragma unroll
            for (int b = 0; b < 2; ++b)
#pragma unroll
                for (int m = 0; m < 4; ++m)
#pragma unroll
                    for (int n = 0; n < 2; ++n) acc[a][b][m][n] = (f32x4){0.f, 0.f, 0.f, 0.f};
        cur = nxt; cB = nB; cA0 = nA0; cA1 = nA1; vc0 = vn0; vc1 = vn1; vc2 = vn2; vc3 = vn3; ++ui;
        if constexpr (ALIGN_EPI) { if (wr == 1) PG8_BAR; }
    }
    PG8_WAIT_V(0);
    if constexpr (!ALIGN_EPI) { if (wr == 0) PG8_BAR; }
    PG8_BAR;
#undef PG8_SA
#undef PG8_AVOFF
#undef PG8_SB
#undef PG8_STAGE_A
#undef PG8_STAGE_B
#undef PG8_LDA
#undef PG8_LDB
#undef PG8_MMA
#undef PG8_WAIT_V
#undef PG8_WAIT_L
#undef PG8_BAR
#undef PG8_SCHED
}

struct StaticOrder {
    int nM, nN, nwg, G, c, lda, dup;
    __device__ __forceinline__ void init(int M, int N, int lda_, int G_, int c_) { nM = M / BM; nN = N / BM; nwg = nM * nN; G = G_; c = c_; lda = lda_; dup = 0; }
    __device__ __forceinline__ bool next(int i, Unit& u) const {
        const long L = (long)(i >> dup) * G + c; if (L >= nwg) return false;
        int wgid = (int)L; { const int q = nwg / NXCD, r = nwg % NXCD, xcd = wgid % NXCD, off = wgid / NXCD; wgid = (xcd < r ? xcd * (q + 1) : r * (q + 1) + (xcd - r) * q) + off; }
        const int nig = WGM * nN, gid = wgid / nig, fm = gid * WGM, gsz = (nM - fm) < WGM ? (nM - fm) : WGM;
        u.pm = fm + ((wgid % nig) % gsz); u.pn = (wgid % nig) / gsz; u.e = 0; u.aux = 0; return true;
    }
    static constexpr bool GATHER = false;
    __device__ __forceinline__ unsigned a_voff(const Unit&, int R, int C) const { return (unsigned)((R & (HALF - 1)) * lda + C) * 2u; }
    __device__ __forceinline__ unsigned a_soff(const Unit& u, int h) const { return (unsigned)((u.pm * BM + h * HALF) * lda) * 2u; }
    __device__ __forceinline__ size_t b_off(const Unit& u) const { return (size_t)u.pn * BM * lda * 2; }
};
}

#define XB_TMO      128
#define XB_XCNT(j)  (256  + 64 * (j))
#define XB_XSUB(j)  (1280 + 64 * (j))
#define XB_XGEN(j)  (2304 + 64 * (j))
#define XB_TOP      3328
#define XB_TOPGEN   3392
#define XCD_BAR_WORDS 3456
#define XB_SPIN_CAP (1u << 18)

__device__ __forceinline__ unsigned xb_ld(unsigned* p)              { return __hip_atomic_load(p, __ATOMIC_RELAXED, __HIP_MEMORY_SCOPE_AGENT); }
__device__ __forceinline__ unsigned xb_add(unsigned* p, unsigned v) { return __hip_atomic_fetch_add(p, v, __ATOMIC_RELAXED, __HIP_MEMORY_SCOPE_AGENT); }
__device__ __forceinline__ unsigned xb_xcc_id() { return (unsigned)__builtin_amdgcn_s_getreg((3 << 11) | 20) & 0xFu; }
#define XB_SPIN(cond, bar) do { unsigned _sp = 0; while (cond) { __builtin_amdgcn_s_sleep(1); \
    if ((++_sp & 255u) == 0u) { if (xb_ld(&(bar)[XB_TMO])) break; if (_sp > XB_SPIN_CAP) { atomicAdd(&(bar)[XB_TMO], 1u); break; } } } } while (0)

struct XcdBarrier {
    unsigned* bar; unsigned x;
    volatile LAS unsigned* st;
};

__device__ __forceinline__ XcdBarrier xcd_barrier_post(unsigned* bar, volatile LAS unsigned* st) {
    XcdBarrier b; b.bar = bar; b.x = xb_xcc_id(); b.st = st;
    if (threadIdx.x == 0) (void)xb_add(&bar[XB_XCNT(b.x)], 1u);
    return b;
}
__device__ __forceinline__ void xcd_barrier_complete(unsigned* bar, unsigned x, unsigned& nloc, unsigned& nx) {
    const unsigned G = gridDim.x * gridDim.y * gridDim.z;
    unsigned sum, cnt, mine, sp = 0u;
    for (;;) {
        sum = 0u; cnt = 0u; mine = 0u;
#pragma unroll
        for (unsigned j = 0; j < 16; ++j) { const unsigned c = xb_ld(&bar[XB_XCNT(j)]); sum += c; cnt += (c > 0u) ? 1u : 0u; mine = (j == x) ? c : mine; }
        if (sum == G) break;
        __builtin_amdgcn_s_sleep(1);
        if ((++sp & 255u) == 0u) { if (xb_ld(&bar[XB_TMO])) break; if (sp > XB_SPIN_CAP) { atomicAdd(&bar[XB_TMO], 1u); break; } }
    }
    nloc = mine > 0u ? mine : 1u; nx = cnt > 0u ? cnt : 1u;
}

__device__ __forceinline__ void xcd_barrier(const XcdBarrier& b) {
    asm volatile("s_waitcnt vmcnt(0)" ::: "memory");
    __syncthreads();
    if (threadIdx.x == 0) {
        unsigned* bar = b.bar;
        __builtin_amdgcn_s_waitcnt(0);
        unsigned nloc = b.st[0], nx = b.st[1];
        if (nloc == 0u) { xcd_barrier_complete(bar, b.x, nloc, nx); b.st[0] = nloc; b.st[1] = nx; }
        const unsigned old = xb_add(&bar[XB_XSUB(b.x)], 1u);
        const unsigned gen = old / nloc;
        if (old + 1u == (gen + 1u) * nloc) {
            __builtin_amdgcn_fence(__ATOMIC_RELEASE, "agent");
            asm volatile("s_waitcnt vmcnt(0)" ::: "memory");
            const unsigned og = xb_add(&bar[XB_TOP], 1u);
            const unsigned tg = og / nx;
            if (og + 1u == (tg + 1u) * nx) xb_add(&bar[XB_TOPGEN], 1u);
            else XB_SPIN(xb_ld(&bar[XB_TOPGEN]) == tg, bar);
            __builtin_amdgcn_fence(__ATOMIC_ACQUIRE, "agent");
            xb_add(&bar[XB_XGEN(b.x)], 1u);
            asm volatile("s_waitcnt vmcnt(0)" ::: "memory");
        } else {
            XB_SPIN(xb_ld(&bar[XB_XGEN(b.x)]) == gen, bar);
            __builtin_amdgcn_fence(__ATOMIC_ACQUIRE, "agent");
            asm volatile("s_waitcnt vmcnt(0)" ::: "memory");
        }
    }
    __syncthreads();
}

struct Args { const float* in[23]; float* out; unsigned char* ws; int ph_lo, ph_hi, li, pad; };
#define CAS __attribute__((address_space(4)))
typedef const CAS Args& ArgsRef;
enum { I_X = 0, I_NORM1G, I_WIN, I_POOLW, I_POOLSC, I_CONVW, I_CONVB, I_WA, I_BA, I_WX, I_BX, I_LAM, I_QG, I_KG, I_OG, I_WOUT, I_NORM2G, I_WR, I_BR, I_WGU, I_BGU, I_WD, I_BD };

struct TrDesc { const float* W; int K, N; bf16* WT; const float* gk; int mode, item; };
__device__ __forceinline__ void tr_load(const TrDesc& d, float (&v)[32], int lane) {
    const int nblk = d.N / 32, kb = d.item / nblk, nb = d.item % nblk, k0 = 64 * kb, n0 = 32 * nb;
#pragma unroll
    for (int i = 0; i < 32; ++i) { const int kk = 2 * i + (lane >> 5); v[i] = d.W[(size_t)(k0 + kk) * d.N + n0 + (lane & 31)]; }
}
__device__ __forceinline__ void tr_finish(const TrDesc& d, float (&v)[32], LAS float* scr, int lane) {
    const int nblk = d.N / 32, kb = d.item / nblk, nb = d.item % nblk, k0 = 64 * kb, n0 = 32 * nb; const int K = d.K;
#pragma unroll
    for (int i = 0; i < 32; ++i) { const int kk = 2 * i + (lane >> 5); float x = v[i]; if (d.gk) x *= d.gk[k0 + kk]; scr[kk * 33 + (lane & 31)] = x; }
    LDS_WAIT(); asm volatile("" ::: "memory");
    const int c = lane & 7;
#pragma unroll
    for (int j = 0; j < 4; ++j) { const int n = (lane >> 3) + 8 * j; const LAS float* s = scr + (8 * c) * 33 + n;
        u32x4 o; o.x = cvt_pk_bf16(s[0 * 33], s[1 * 33]); o.y = cvt_pk_bf16(s[2 * 33], s[3 * 33]); o.z = cvt_pk_bf16(s[4 * 33], s[5 * 33]); o.w = cvt_pk_bf16(s[6 * 33], s[7 * 33]);
        int dn = n0 + n; const int mode = d.mode;
        if (mode == 1) { const int jj = dn & 255; dn = (jj >> 7) * 256 + (dn >> 8) * 128 + (jj & 127); }
        if (mode == 3 || (mode == 2 && (dn < C_Q || dn >= C_V))) {
            const int L = dn & 255; dn = (dn & ~255) + 128 * ((L >> 3) & 1) + 32 * (L >> 6) + 8 * ((L >> 4) & 3) + (L & 7); }
        else if (mode == 2) {
            const int rem = (dn - C_Q) & 511, sec = (dn - C_Q) >> 9, head = rem >> 6, d2 = rem & 63;
            dn = C_Q + sec * 512 + (head >> 2) * 256 + (d2 >> 5) * 128 + (head & 3) * 32 + (d2 & 31); }
        *(u32x4*)(d.WT + (size_t)dn * K + k0 + 8 * c) = o; }
    LDS_WAIT(); asm volatile("" ::: "memory");
}
__device__ __forceinline__ void cvt_row(const float* xrow, bf16* orow, float* ssq, int lane) {
    const f32x4* xr = (const f32x4*)xrow + lane;
    f32x4 v[4]; float s = 0.f;
#pragma unroll
    for (int j = 0; j < 4; ++j) { v[j] = xr[64 * j]; s += (v[j].x * v[j].x + v[j].y * v[j].y) + (v[j].z * v[j].z + v[j].w * v[j].w); }
    s = wave_sum(s);
    u32x2* o8 = (u32x2*)orow + lane;
#pragma unroll
    for (int j = 0; j < 4; ++j) { u32x2 w; w.x = cvt_pk_bf16(v[j].x, v[j].y); w.y = cvt_pk_bf16(v[j].z, v[j].w); o8[64 * j] = w; }
    if (lane == 0) *ssq = s;
}
__device__ __forceinline__ TrDesc tr_desc(ArgsRef a, int it) {
    unsigned char* ws = a.ws;
    constexpr int I_IN = 16 * 72, I_OUT = 16 * 32, I_R = 16, I_GU = 16 * 16, I_D = 4 * 32, I_S = 2;
    constexpr int PER_LAYER = I_IN + I_OUT + I_R + NEXP * I_GU + NEXP * I_D + 12 * I_S;
    const int l = it / PER_LAYER; int r = it % PER_LAYER; TrDesc d;
    if (r < I_IN) { d = TrDesc{a.in[I_WIN] + (size_t)l * DM * NIN, DM, NIN, (bf16*)(ws + WS_WIN) + (size_t)l * NIN * DM, a.in[I_NORM1G] + l * DM, 2, r}; return d; } r -= I_IN;
    if (r < I_OUT) { d = TrDesc{a.in[I_WOUT] + (size_t)l * DM * DM, DM, DM, (bf16*)(ws + WS_WOUT) + (size_t)l * DM * DM, a.in[I_OG] + l * DM, 3, r}; return d; } r -= I_OUT;
    if (r < I_R) { d = TrDesc{a.in[I_WR] + (size_t)l * DM * NEXP, DM, NEXP, (bf16*)(ws + WS_SMALL) + SM_WR + (size_t)l * NEXP * DM, a.in[I_NORM2G] + l * DM, 0, r}; return d; } r -= I_R;
    if (r < NEXP * I_GU) { const int e = r / I_GU; d = TrDesc{a.in[I_WGU] + (size_t)(l * NEXP + e) * DM * 512, DM, 512, (bf16*)(ws + WS_WGU) + (size_t)(l * NEXP + e) * 512 * DM, a.in[I_NORM2G] + l * DM, 1, r % I_GU}; return d; } r -= NEXP * I_GU;
    if (r < NEXP * I_D) { const int e = r / I_D; d = TrDesc{a.in[I_WD] + (size_t)(l * NEXP + e) * EFF * DM, EFF, DM, (bf16*)(ws + WS_WD) + (size_t)(l * NEXP + e) * DM * EFF, nullptr, 3, r % I_D}; return d; } r -= NEXP * I_D;
    { const int which = r / (4 * I_S), g = (r / I_S) % 4, sub = r % I_S;
      const float* src = a.in[which == 0 ? I_POOLW : (which == 1 ? I_WA : I_WX)] + (size_t)(l * 4 + g) * 4096;
      bf16* dst = (bf16*)(ws + WS_SMALL) + (which == 0 ? SM_POOLW : (which == 1 ? SM_WA : SM_WX)) + (size_t)(l * 4 + g) * 4096;
      d = TrDesc{src, 64, 64, dst, nullptr, 0, sub}; return d; }
}
__device__ __forceinline__ void phase_prologue(ArgsRef a, LAS unsigned char* lds, int wv) {
    const int tid = tid_from(wv), lane = tid & 63, wave = tid >> 6;
    LAS float* scr = (LAS float*)(lds + wave * 16384);
    const int gw = blockIdx.x * NWAVES + wave, NGW = gridDim.x * NWAVES;
    unsigned char* ws = a.ws;
    constexpr int PER_LAYER = 16 * 72 + 16 * 32 + 16 + NEXP * 16 * 16 + NEXP * 4 * 32 + 12 * 2;
    { int it = gw; float cur[32], nxt[32];
      TrDesc dc = tr_desc(a, it < 2 * PER_LAYER ? it : 0), dn = dc;
      if (it < 2 * PER_LAYER) tr_load(dc, cur, lane);
      while (it < 2 * PER_LAYER) { const int itn = it + NGW;
          if (itn < 2 * PER_LAYER) { dn = tr_desc(a, itn); tr_load(dn, nxt, lane); }
          tr_finish(dc, cur, scr, lane);
#pragma unroll
          for (int i = 0; i < 32; ++i) cur[i] = nxt[i];
          dc = dn; it = itn; } }
    { float* ct = (float*)(ws + WS_ROPE); float* st = ct + SEQ * 32;
      for (int idx = blockIdx.x * NTHR + tid; idx < SEQ * 32; idx += gridDim.x * NTHR) {
          const int pos = idx >> 5, i = idx & 31;
          const float inv = __builtin_amdgcn_exp2f(-(float)i * 0.41524101186092029f);
          const float ang = (float)pos * inv;
          const double rev = (double)ang * 0.15915494309189535; const double fr = rev - __builtin_rint(rev);
          const float f = (float)fr;
          ct[idx] = __builtin_amdgcn_cosf(f); st[idx] = __builtin_amdgcn_sinf(f); } }
    { const float* __restrict__ X = a.in[I_X]; bf16* __restrict__ xb = (bf16*)(ws + WS_XB); float* __restrict__ ssq = (float*)(ws + WS_SSQ);
      for (int m0 = gw * 4; m0 < NT; m0 += NGW * 4) { f32x4 v[4][4];
#pragma unroll
          for (int u = 0; u < 4; ++u)
#pragma unroll
              for (int j = 0; j < 4; ++j) v[u][j] = *((const f32x4*)(X + (size_t)(m0 + u) * DM) + lane + 64 * j);
#pragma unroll
          for (int u = 0; u < 4; ++u) { float s = 0.f;
#pragma unroll
              for (int j = 0; j < 4; ++j) s += (v[u][j].x * v[u][j].x + v[u][j].y * v[u][j].y) + (v[u][j].z * v[u][j].z + v[u][j].w * v[u][j].w);
              s = wave_sum(s);
#pragma unroll
              for (int j = 0; j < 4; ++j) { u32x2 w; w.x = cvt_pk_bf16(v[u][j].x, v[u][j].y); w.y = cvt_pk_bf16(v[u][j].z, v[u][j].w); *((u32x2*)(xb + (size_t)(m0 + u) * DM) + lane + 64 * j) = w; }
              if (lane == 0) ssq[m0 + u] = s; } } }
}

struct EpiIn {
    static constexpr bool PERM = true;
    bf16* O; const float* ssq; const float* qg; const float* kg; const float* ct; const float* st;
    __device__ __forceinline__ void operator()(const f32x4 (&acc)[2][2][4][2], const pg8::Unit& u, int wr, int wc, int fr, int fq) const {
        const int row0 = u.pm * 256 + wr * 64 + fr, col0 = u.pn * 256 + wc * 32 + 8 * fq;
        if (u.pn >= 3 && u.pn < 7) {
            const bool isq = u.pn < 5; const float* gp = (isq ? qg : kg) + 8 * fq; const float gs = isq ? (0.125f * 1.4426950408889634f) : 1.0f;
            f32x4 g[2][2];
#pragma unroll
            for (int bj = 0; bj < 2; ++bj)
#pragma unroll
                for (int n = 0; n < 2; ++n) g[bj][n] = *(const f32x4*)(gp + 32 * bj + 4 * n) * gs;
#pragma unroll
            for (int ai = 0; ai < 2; ++ai)
#pragma unroll
                for (int m = 0; m < 4; ++m) { const int row = row0 + ai * 128 + m * 16; const float rs = __builtin_amdgcn_rsqf(ssq[row] * (1.0f / DM) + EPS);
                    const int pos = row & (SEQ - 1);
                    const f32x4 c0 = *(const f32x4*)(ct + pos * 32 + 8 * fq), c1 = *(const f32x4*)(ct + pos * 32 + 8 * fq + 4), s0 = *(const f32x4*)(st + pos * 32 + 8 * fq), s1 = *(const f32x4*)(st + pos * 32 + 8 * fq + 4);
                    f32x4 v[2][2]; float ss = 0.f;
#pragma unroll
                    for (int bj = 0; bj < 2; ++bj)
#pragma unroll
                        for (int n = 0; n < 2; ++n) { v[bj][n] = acc[ai][bj][m][n] * rs; ss += (v[bj][n][0] * v[bj][n][0] + v[bj][n][1] * v[bj][n][1]) + (v[bj][n][2] * v[bj][n][2] + v[bj][n][3] * v[bj][n][3]); }
                    ss += __shfl_xor(ss, 16); ss += __shfl_xor(ss, 32);
                    const float rr = __builtin_amdgcn_rsqf(ss * (1.0f / 64.0f) + EPS);
#pragma unroll
                    for (int bj = 0; bj < 2; ++bj)
#pragma unroll
                        for (int n = 0; n < 2; ++n) v[bj][n] = v[bj][n] * rr * g[bj][n];
                    const f32x4 o00 = v[0][0] * c0 - v[1][0] * s0, o01 = v[0][1] * c1 - v[1][1] * s1, o10 = v[1][0] * c0 + v[0][0] * s0, o11 = v[1][1] * c1 + v[0][1] * s1;
                    bf16* rowp = O + (size_t)row * NIN + col0;
                    u32x4 w; w.x = cvt_pk_bf16(o00[0], o00[1]); w.y = cvt_pk_bf16(o00[2], o00[3]); w.z = cvt_pk_bf16(o01[0], o01[1]); w.w = cvt_pk_bf16(o01[2], o01[3]);
                    *(u32x4*)(rowp) = w;
                    w.x = cvt_pk_bf16(o10[0], o10[1]); w.y = cvt_pk_bf16(o10[2], o10[3]); w.z = cvt_pk_bf16(o11[0], o11[1]); w.w = cvt_pk_bf16(o11[2], o11[3]);
                    *(u32x4*)(rowp + 128) = w; }
            return;
        }
#pragma unroll
        for (int ai = 0; ai < 2; ++ai)
#pragma unroll
            for (int m = 0; m < 4; ++m) { const int row = row0 + ai * 128 + m * 16; const float rs = __builtin_amdgcn_rsqf(ssq[row] * (1.0f / DM) + EPS);
                bf16* rowp = O + (size_t)row * NIN + u.pn * 256 + wc * 64 + fq * 16;
#pragma unroll
                for (int bj = 0; bj < 2; ++bj) { const f32x4 v0 = acc[ai][bj][m][0] * rs, v1 = acc[ai][bj][m][1] * rs;
                    u32x4 w; w.x = cvt_pk_bf16(v0[0], v0[1]); w.y = cvt_pk_bf16(v0[2], v0[3]); w.z = cvt_pk_bf16(v1[0], v1[1]); w.w = cvt_pk_bf16(v1[2], v1[3]);
                    *(u32x4*)(rowp + bj * 8) = w; } }
    }
};
struct EpiOut {
    static constexpr bool PERM = true;
    bf16* xb; float* ssqp;
    __device__ __forceinline__ void operator()(const f32x4 (&acc)[2][2][4][2], const pg8::Unit& u, int wr, int wc, int fr, int fq) const {
        const int row0 = u.pm * 256 + wr * 64 + fr, col0 = u.pn * 256 + wc * 64 + fq * 16;
#pragma unroll
        for (int am = 0; am < 4; ++am) { u32x4 xi[2][2];
#pragma unroll
            for (int mm = 0; mm < 2; ++mm) { const int ai = am >> 1, m = (am & 1) * 2 + mm; const size_t off = (size_t)(row0 + ai * 128 + m * 16) * DM + col0; xi[mm][0] = *(const u32x4*)(xb + off); xi[mm][1] = *(const u32x4*)(xb + off + 8); }
            asm volatile("" ::: "memory");
#pragma unroll
            for (int mm = 0; mm < 2; ++mm) { const int ai = am >> 1, m = (am & 1) * 2 + mm; const int row = row0 + ai * 128 + m * 16; const size_t off = (size_t)row * DM + col0; float s = 0.f;
#pragma unroll
                for (int bj = 0; bj < 2; ++bj) { const u32x4 x = xi[mm][bj];
                    const f32x4 o0 = (f32x4){bflo(x.x), bfhi(x.x), bflo(x.y), bfhi(x.y)} + acc[ai][bj][m][0], o1 = (f32x4){bflo(x.z), bfhi(x.z), bflo(x.w), bfhi(x.w)} + acc[ai][bj][m][1];
                    s += ((o0[0] * o0[0] + o0[1] * o0[1]) + (o0[2] * o0[2] + o0[3] * o0[3])) + ((o1[0] * o1[0] + o1[1] * o1[1]) + (o1[2] * o1[2] + o1[3] * o1[3]));
                    u32x4 w; w.x = cvt_pk_bf16(o0[0], o0[1]); w.y = cvt_pk_bf16(o0[2], o0[3]); w.z = cvt_pk_bf16(o1[0], o1[1]); w.w = cvt_pk_bf16(o1[2], o1[3]);
                    *(u32x4*)(xb + off + bj * 8) = w; }
                s += __shfl_xor(s, 16); s += __shfl_xor(s, 32);
                if (fq == 0) ssqp[(size_t)row * 16 + u.pn * 4 + wc] = s; }
            asm volatile("" ::: "memory"); }
    }
};

template <int MODE> struct MoeOrder {
    static constexpr bool GATHER = (MODE == 0);
    const LAS int* tab; int npn, G, c; const int* list; int dup;
    __device__ __forceinline__ bool next(int i, pg8::Unit& u) const {
        const int ii = i >> dup; const int total = __builtin_amdgcn_readfirstlane(tab[64]); const int nfr = total / G, nfu = nfr * npn;
        int gb;
        if (ii < nfu) { gb = (ii / npn) * G + c; u.pn = ii % npn; }
        else { const int L = (ii - nfu) * G + c; gb = nfr * G + L / npn; u.pn = L % npn; if (gb >= total) return false; }
        const int e = __builtin_amdgcn_readfirstlane((int)((const LAS unsigned char*)(tab + 80))[gb]);
        u.e = e; u.pm = gb; u.aux = gb - __builtin_amdgcn_readfirstlane(tab[32 + e]); return true;
    }
    __device__ __forceinline__ unsigned a_voff(const pg8::Unit& u, int R, int C) const {
        if constexpr (MODE == 0) { const int pos = u.aux * 256 + R; const int ne = tab[u.e]; int tok = 0; if (pos < ne) tok = list[u.e * NT + pos] >> 2; return (unsigned)(tok * DM + C) * 2u; }
        else return (unsigned)((R & 127) * EFF + C) * 2u;
    }
    __device__ __forceinline__ unsigned a_soff(const pg8::Unit& u, int h) const { if constexpr (MODE == 0) return 0u; else return (unsigned)((u.pm * 256 + h * 128) * EFF) * 2u; }
    __device__ __forceinline__ size_t b_off(const pg8::Unit& u) const {
        if constexpr (MODE == 0) return ((size_t)u.e * 512 + (size_t)u.pn * 256) * DM * 2;
        else return ((size_t)u.e * DM + (size_t)u.pn * 256) * EFF * 2;
    }
};
struct EpiGU {
    static constexpr bool PERM = true;
    bf16* act; const float* lrstd; const float* bgu;
    __device__ __forceinline__ void operator()(const f32x4 (&acc)[2][2][4][2], const pg8::Unit& u, int wr, int wc, int fr, int fq) const {
        const int r0 = wr * 64 + fr, cl0 = wc * 32 + 8 * fq;
        const float* bg = bgu + u.e * 512 + u.pn * 128 + cl0;
        const f32x4 bg0 = *(const f32x4*)(bg), bg1 = *(const f32x4*)(bg + 4), bu0 = *(const f32x4*)(bg + 256), bu1 = *(const f32x4*)(bg + 260);
#pragma unroll
        for (int ai = 0; ai < 2; ++ai)
#pragma unroll
            for (int m = 0; m < 4; ++m) { const int r = r0 + ai * 128 + m * 16; const float rs = lrstd[(size_t)u.e * NT + u.aux * 256 + r];
                f32x4 g0 = acc[ai][0][m][0] * rs + bg0, g1 = acc[ai][0][m][1] * rs + bg1, u0 = acc[ai][1][m][0] * rs + bu0, u1 = acc[ai][1][m][1] * rs + bu1;
                float o[8];
#pragma unroll
                for (int j = 0; j < 4; ++j) { const float ga = fminf(g0[j], 7.0f), ua = fminf(fmaxf(u0[j], -7.0f), 7.0f); o[j] = (ua + 1.0f) * ga * fast_sigmoid(1.702f * ga);
                                              const float gb = fminf(g1[j], 7.0f), ub = fminf(fmaxf(u1[j], -7.0f), 7.0f); o[4 + j] = (ub + 1.0f) * gb * fast_sigmoid(1.702f * gb); }
                u32x4 w; w.x = cvt_pk_bf16(o[0], o[1]); w.y = cvt_pk_bf16(o[2], o[3]); w.z = cvt_pk_bf16(o[4], o[5]); w.w = cvt_pk_bf16(o[6], o[7]);
                *(u32x4*)(act + (size_t)(u.pm * 256 + r) * EFF + u.pn * 128 + cl0) = w; }
    }
};
constexpr float Y8_SCALE = 32.0f;
struct EpiDown {
    static constexpr bool PERM = true;
    unsigned char* y; const int* list; const float* lgate; const float* bd; const LAS int* tab;
    __device__ __forceinline__ void operator()(const f32x4 (&acc)[2][2][4][2], const pg8::Unit& u, int wr, int wc, int fr, int fq) const {
        const int r0 = wr * 64 + fr, col0 = u.pn * 256 + wc * 64 + fq * 16; const int ne = tab[u.e];
        const float* bp = bd + u.e * DM + col0;
#pragma unroll
        for (int ai = 0; ai < 2; ++ai) { int asg[4]; float gt[4];
#pragma unroll
            for (int m = 0; m < 4; ++m) { const int pos = u.aux * 256 + r0 + ai * 128 + m * 16; const bool ok = pos < ne;
                asg[m] = ok ? list[(size_t)u.e * NT + pos] : -1; gt[m] = ok ? lgate[(size_t)u.e * NT + pos] * Y8_SCALE : 0.f; }
            asm volatile("" ::: "memory");
#pragma unroll
            for (int m = 0; m < 4; ++m) {
                if (asg[m] >= 0) { unsigned char* rowp = y + (size_t)asg[m] * DM + col0; const float g = gt[m]; u32x4 wv4;
#pragma unroll
                    for (int bj = 0; bj < 2; ++bj) { const f32x4 b0 = *(const f32x4*)(bp + bj * 8), b1 = *(const f32x4*)(bp + bj * 8 + 4);
                        const f32x4 v0 = (acc[ai][bj][m][0] + b0) * g, v1 = (acc[ai][bj][m][1] + b1) * g;
                        int w0 = __builtin_amdgcn_cvt_pk_fp8_f32(v0[0], v0[1], 0, false); w0 = __builtin_amdgcn_cvt_pk_fp8_f32(v0[2], v0[3], w0, true);
                        int w1 = __builtin_amdgcn_cvt_pk_fp8_f32(v1[0], v1[1], 0, false); w1 = __builtin_amdgcn_cvt_pk_fp8_f32(v1[2], v1[3], w1, true);
                        if (bj == 0) { wv4.x = (unsigned)w0; wv4.y = (unsigned)w1; } else { wv4.z = (unsigned)w0; wv4.w = (unsigned)w1; } }
                    *(u32x4*)rowp = wv4; }
                asm volatile("" ::: "memory"); } }
    }
};
__device__ __forceinline__ void moe_tables(LAS int* tab, const unsigned* cnt, int wv) {
    __syncthreads();
    const int tid_ = tid_from(wv);
    if (tid_ == 0) { int pre = 0;
        for (int e = 0; e < NEXP; ++e) { const int n = (int)__hip_atomic_load(cnt + e, RLX_AGENT); tab[e] = n; tab[32 + e] = pre; pre += (n + 255) >> 8; }
        tab[64] = pre; }
    __syncthreads();
    { LAS unsigned char* eb = (LAS unsigned char*)(tab + 80); const int total = tab[64];
      for (int gb = tid_; gb < total; gb += NTHR) { int e = 0;
          for (int k = 1; k < NEXP; ++k) { if (tab[32 + k] <= gb) e = k; }
          eb[gb] = (unsigned char)e; } }
    __syncthreads();
}

__device__ __forceinline__ void phase_qkprep(ArgsRef a, int layer, int wv, bool dry) {
    const int tid = tid_from(wv), lane = tid & 63, wave = tid >> 6;
    const int gw = blockIdx.x * NWAVES + wave, NGW = gridDim.x * NWAVES;
    bf16* proj = (bf16*)(a.ws + WS_PROJ);
    const float* __restrict__ ct = (const float*)(a.ws + WS_ROPE); const float* __restrict__ st = ct + SEQ * 32;
    const int d0 = (lane & 7) * 8, p0 = d0 & 31;
    float gq[8], gk[8];
#pragma unroll
    for (int j = 0; j < 8; ++j) { gq[j] = a.in[I_QG][layer * 64 + d0 + j] * (0.125f * 1.4426950408889634f); gk[j] = a.in[I_KG][layer * 64 + d0 + j]; }
    const bool second = (lane & 4) != 0;
    constexpr int TB = 4;
    for (int t0 = gw * TB; t0 < NT; t0 += NGW * TB) {
        u32x4 w[TB][2]; f32x4 cs[TB][4];
#pragma unroll
        for (int u = 0; u < TB; ++u) { const int t = t0 + u, pos = t & (SEQ - 1);
            w[u][0] = *(const u32x4*)(proj + (size_t)t * NIN + C_Q + lane * 8); w[u][1] = *(const u32x4*)(proj + (size_t)t * NIN + C_Q + 512 + lane * 8);
            cs[u][0] = *(const f32x4*)(ct + pos * 32 + p0); cs[u][1] = *(const f32x4*)(ct + pos * 32 + p0 + 4); cs[u][2] = *(const f32x4*)(st + pos * 32 + p0); cs[u][3] = *(const f32x4*)(st + pos * 32 + p0 + 4); }
#pragma unroll
        for (int u = 0; u < TB; ++u) { const int t = t0 + u;
            float c[8], s[8];
#pragma unroll
            for (int j = 0; j < 4; ++j) { c[j] = cs[u][0][j]; c[4 + j] = cs[u][1][j]; s[j] = cs[u][2][j]; s[4 + j] = cs[u][3][j]; }
#pragma unroll
            for (int i = 0; i < 2; ++i) {
                const u32x4 ww = w[u][i];
                float x[8]; x[0] = bflo(ww.x); x[1] = bfhi(ww.x); x[2] = bflo(ww.y); x[3] = bfhi(ww.y); x[4] = bflo(ww.z); x[5] = bfhi(ww.z); x[6] = bflo(ww.w); x[7] = bfhi(ww.w);
                float ss = 0.f;
#pragma unroll
                for (int j = 0; j < 8; ++j) ss += x[j] * x[j];
                ss += __shfl_xor(ss, 1); ss += __shfl_xor(ss, 2); ss += __shfl_xor(ss, 4);
                const float rs = __builtin_amdgcn_rsqf(ss * (1.0f / 64.0f) + EPS);
                float o[8];
#pragma unroll
                for (int j = 0; j < 8; ++j) { const float yv = x[j] * rs * (i == 0 ? gq[j] : gk[j]); const float pv = __shfl_xor(yv, 4);
                    o[j] = second ? (yv * c[j] + pv * s[j]) : (yv * c[j] - pv * s[j]); }
                u32x4 r; r.x = cvt_pk_bf16(o[0], o[1]); r.y = cvt_pk_bf16(o[2], o[3]); r.z = cvt_pk_bf16(o[4], o[5]); r.w = cvt_pk_bf16(o[6], o[7]);
                if (!dry || o[0] == 12345.678f) *(u32x4*)(proj + (size_t)t * NIN + C_Q + i * 512 + lane * 8) = r;
            } }
    }
}

__device__ __forceinline__ void phase_pool(ArgsRef a, LAS unsigned char* lds, int layer, int wv) {
    const int tid = tid_from(wv), lane = tid & 63, wave = __builtin_amdgcn_readfirstlane(tid >> 6);
    const bf16* proj = (const bf16*)(a.ws + WS_PROJ); bf16* YP = (bf16*)(a.ws + WS_YP); float* SSQPOOL = (float*)(a.ws + WS_SSQPOOL);
    const int g = wave & 3, w = 2 << g, lr = lane & 15, lq = lane >> 4;
    constexpr int US = 72;
    LAS bf16* Uw = (LAS bf16*)(lds + wave * 11520);
    LAS bf16* Xw = (LAS bf16*)(lds + wave * 11520 + 6784);
    const bf16* pw = (const bf16*)(a.ws + WS_SMALL) + SM_POOLW + (size_t)(layer * 4 + g) * 4096;
    bf16x8 bw[4][2]; float psc[4];
#pragma unroll
    for (int et = 0; et < 4; ++et) {
#pragma unroll
        for (int ks = 0; ks < 2; ++ks) bw[et][ks] = *(const bf16x8*)(pw + (et * 16 + lr) * 64 + ks * 32 + lq * 8);
        psc[et] = a.in[I_POOLSC][layer * 256 + g * 64 + et * 16 + lr]; }
    __syncthreads();
    const int nstreams = gridDim.x * 2;
    for (int tk = blockIdx.x * 2 + (wave >> 2); tk < NT / 32; tk += nstreams) {
        const int t0 = tk * 32, s0 = t0 & (SEQ - 1);
#pragma unroll
        for (int j = 0; j < 6; ++j) { const int id = lane + 64 * j;
            if (id < 47 * 8) { const int row = id >> 3, c8 = (id & 7) * 8; u32x4 v = {0u, 0u, 0u, 0u};
                if (s0 - 15 + row >= 0) v = *(const u32x4*)(proj + (size_t)(t0 - 15 + row) * NIN + C_POOL + g * 64 + c8);
                *(LAS u32x4*)(Uw + row * US + c8) = v; } }
        LDS_WAIT(); asm volatile("" ::: "memory");
        { float sum = 0.f;
          for (int j = 1; j < w; ++j) sum += bf2f(Uw[(15 - j) * US + lane]);
#pragma unroll 8
          for (int tl = 0; tl < 32; ++tl) { const float cur = bf2f(Uw[(15 + tl) * US + lane]); sum += cur;
              const int cnt = min(w, s0 + tl + 1); const float pooled = sum * __builtin_amdgcn_rcpf((float)cnt) - cur;
              Xw[tl * US + lane] = f2bf(pooled); sum -= bf2f(Uw[(15 + tl - w + 1) * US + lane]); } }
        LDS_WAIT(); asm volatile("" ::: "memory");
        f32x4 acc[2][4];
#pragma unroll
        for (int rt = 0; rt < 2; ++rt) { const bf16x8 a0 = *(const LAS bf16x8*)(Xw + (rt * 16 + lr) * US + lq * 8), a1 = *(const LAS bf16x8*)(Xw + (rt * 16 + lr) * US + 32 + lq * 8);
#pragma unroll
            for (int et = 0; et < 4; ++et) { acc[rt][et] = __builtin_amdgcn_mfma_f32_16x16x32_bf16(a0, bw[et][0], (f32x4){0.f, 0.f, 0.f, 0.f}, 0, 0, 0); acc[rt][et] = __builtin_amdgcn_mfma_f32_16x16x32_bf16(a1, bw[et][1], acc[rt][et], 0, 0, 0); } }
#pragma unroll
        for (int rt = 0; rt < 2; ++rt)
#pragma unroll
            for (int reg = 0; reg < 4; ++reg) { const int tl = rt * 16 + lq * 4 + reg; float s = 0.f;
#pragma unroll
                for (int et = 0; et < 4; ++et) { const float y = acc[rt][et][reg] * psc[et]; s += y * y; Uw[tl * 64 + et * 16 + lr] = f2bf(y); }
                s += __shfl_xor(s, 1); s += __shfl_xor(s, 2); s += __shfl_xor(s, 4); s += __shfl_xor(s, 8);
                if (lr == 0) SSQPOOL[(size_t)(t0 + tl) * 4 + g] = s; }
        LDS_WAIT(); asm volatile("" ::: "memory");
#pragma unroll
        for (int j = 0; j < 4; ++j) { const int id = lane + 64 * j, row = id >> 3, c8 = (id & 7) * 8;
            *(u32x4*)(YP + (size_t)(t0 + row) * 256 + g * 64 + c8) = *(const LAS u32x4*)(Uw + row * 64 + c8); }
        LDS_WAIT(); asm volatile("" ::: "memory");
    }
}

__device__ __forceinline__ void phase_lru_a(ArgsRef a, LAS unsigned char* lds, int layer, int wv) {
    const int tid = tid_from(wv), lane = tid & 63, wave = __builtin_amdgcn_readfirstlane(tid >> 6);
    const bf16* proj = (const bf16*)(a.ws + WS_PROJ);
    bf16* HL = (bf16*)(a.ws + WS_HL); bf16* PL = (bf16*)(a.ws + WS_PL);
    float* AGGH = (float*)(a.ws + WS_AGGH); float* AGGP = (float*)(a.ws + WS_AGGP);
    const int n = wave & 3, lr = lane & 15, lq = lane >> 4;
    constexpr int US = 72;
    LAS bf16* Uw = (LAS bf16*)(lds + wave * 13824);
    LAS bf16* Xw = (LAS bf16*)(lds + wave * 13824 + 5120);
    LAS bf16* Pw = (LAS bf16*)(lds + wave * 13824 + 9728);
    const int chl = n * 64 + lane;
    const float cw0 = a.in[I_CONVW][(layer * 4 + 0) * 256 + chl], cw1 = a.in[I_CONVW][(layer * 4 + 1) * 256 + chl], cw2 = a.in[I_CONVW][(layer * 4 + 2) * 256 + chl], cw3 = a.in[I_CONVW][(layer * 4 + 3) * 256 + chl];
    const float cb = a.in[I_CONVB][layer * 256 + chl];
    const bf16* wa = (const bf16*)(a.ws + WS_SMALL) + SM_WA + (size_t)(layer * 4 + n) * 4096;
    const bf16* wx = (const bf16*)(a.ws + WS_SMALL) + SM_WX + (size_t)(layer * 4 + n) * 4096;
    bf16x8 ba[4][2], bx[4][2]; float bav[4], bxv[4], sp[4];
#pragma unroll
    for (int et = 0; et < 4; ++et) {
#pragma unroll
        for (int ks = 0; ks < 2; ++ks) { const int wo = (et * 16 + lr) * 64 + ks * 32 + lq * 8; ba[et][ks] = *(const bf16x8*)(wa + wo); bx[et][ks] = *(const bf16x8*)(wx + wo); }
        const int chn = layer * 256 + n * 64 + et * 16 + lr; bav[et] = a.in[I_BA][chn]; bxv[et] = a.in[I_BX][chn]; sp[et] = log1pf(expf(-a.in[I_LAM][chn])); }
    __syncthreads();
    const int nstreams = gridDim.x * 2;
    for (int ck = blockIdx.x * 2 + (wave >> 2); ck < NT / LRU_CH; ck += nstreams) {
        const int t0 = ck * LRU_CH, s0 = t0 & (SEQ - 1);
#pragma unroll
        for (int j = 0; j < 5; ++j) { const int id = lane + 64 * j;
            if (id < 35 * 8) { const int row = id >> 3, c8 = (id & 7) * 8; u32x4 w = {0u, 0u, 0u, 0u};
                if (s0 - 3 + row >= 0) w = *(const u32x4*)(proj + (size_t)(t0 - 3 + row) * NIN + C_LRU + n * 64 + c8);
                *(LAS u32x4*)(Uw + row * US + c8) = w; } }
        LDS_WAIT(); asm volatile("" ::: "memory");
        { float u0 = bf2f(Uw[0 * US + lane]), u1 = bf2f(Uw[1 * US + lane]), u2 = bf2f(Uw[2 * US + lane]);
#pragma unroll 8
          for (int tl = 0; tl < LRU_CH; ++tl) { const float u3 = bf2f(Uw[(tl + 3) * US + lane]); const float xc = cb + cw0 * u0 + cw1 * u1 + cw2 * u2 + cw3 * u3;
              Xw[tl * US + lane] = f2bf(xc); u0 = u1; u1 = u2; u2 = u3; } }
        LDS_WAIT(); asm volatile("" ::: "memory");
        f32x4 ca[2][4], cx[2][4];
#pragma unroll
        for (int rt = 0; rt < 2; ++rt) { const bf16x8 a0 = *(const LAS bf16x8*)(Xw + (rt * 16 + lr) * US + lq * 8), a1 = *(const LAS bf16x8*)(Xw + (rt * 16 + lr) * US + 32 + lq * 8);
#pragma unroll
            for (int et = 0; et < 4; ++et) { ca[rt][et] = __builtin_amdgcn_mfma_f32_16x16x32_bf16(a0, ba[et][0], (f32x4){0.f, 0.f, 0.f, 0.f}, 0, 0, 0); ca[rt][et] = __builtin_amdgcn_mfma_f32_16x16x32_bf16(a1, ba[et][1], ca[rt][et], 0, 0, 0);
                                              cx[rt][et] = __builtin_amdgcn_mfma_f32_16x16x32_bf16(a0, bx[et][0], (f32x4){0.f, 0.f, 0.f, 0.f}, 0, 0, 0); cx[rt][et] = __builtin_amdgcn_mfma_f32_16x16x32_bf16(a1, bx[et][1], cx[rt][et], 0, 0, 0); } }
#pragma unroll
        for (int et = 0; et < 4; ++et) {
            float Pl[2][4], Hl[2][4], At[2], Ht[2];
#pragma unroll
            for (int rt = 0; rt < 2; ++rt) { float P = 1.f, H = 0.f;
#pragma unroll
                for (int reg = 0; reg < 4; ++reg) { const int tl = rt * 16 + lq * 4 + reg;
                    const float r = fast_sigmoid(ca[rt][et][reg] + bav[et]), ig = fast_sigmoid(cx[rt][et][reg] + bxv[et]);
                    const float log_a = -8.0f * r * sp[et]; const float av = fast_exp(log_a);
                    float mult = sqrtf(fmaxf(1.0f - fast_exp(2.0f * log_a), 0.f)); if (s0 + tl == 0) mult = 1.0f;
                    const float bv = mult * ig * bf2f(Xw[tl * US + et * 16 + lr]);
                    H = av * H + bv; P *= av; Pl[rt][reg] = P; Hl[rt][reg] = H; }
                At[rt] = P; Ht[rt] = H; }
            float Ai[2], Hi[2];
#pragma unroll
            for (int rt = 0; rt < 2; ++rt) { float A = At[rt], H = Ht[rt];
                { const float Ap = __shfl_up(A, 16), Hp = __shfl_up(H, 16); if (lq >= 1) { H = A * Hp + H; A = A * Ap; } }
                { const float Ap = __shfl_up(A, 32), Hp = __shfl_up(H, 32); if (lq >= 2) { H = A * Hp + H; A = A * Ap; } }
                Ai[rt] = A; Hi[rt] = H; }
            float Ac[2], Hc[2];
#pragma unroll
            for (int rt = 0; rt < 2; ++rt) { const float Ap = __shfl_up(Ai[rt], 16), Hp = __shfl_up(Hi[rt], 16); Ac[rt] = (lq >= 1) ? Ap : 1.f; Hc[rt] = (lq >= 1) ? Hp : 0.f; }
            const float A0t = __shfl(Ai[0], 48 + lr), H0t = __shfl(Hi[0], 48 + lr);
            Hc[1] = Ac[1] * H0t + Hc[1]; Ac[1] = Ac[1] * A0t;
#pragma unroll
            for (int rt = 0; rt < 2; ++rt)
#pragma unroll
                for (int reg = 0; reg < 4; ++reg) { const int tl = rt * 16 + lq * 4 + reg;
                    Uw[tl * 64 + et * 16 + lr] = f2bf(Hl[rt][reg] + Pl[rt][reg] * Hc[rt]); Pw[tl * 64 + et * 16 + lr] = f2bf(Pl[rt][reg] * Ac[rt]); }
            if (lq == 3) { const size_t o = (size_t)ck * 256 + n * 64 + et * 16 + lr;
                AGGP[o] = Ai[1] * A0t; AGGH[o] = Ai[1] * H0t + Hi[1]; }
        }
        LDS_WAIT(); asm volatile("" ::: "memory");
#pragma unroll
        for (int j = 0; j < 4; ++j) { const int id = lane + 64 * j, row = id >> 3, c8 = (id & 7) * 8;
            *(u32x4*)(HL + (size_t)(t0 + row) * 256 + n * 64 + c8) = *(const LAS u32x4*)(Uw + row * 64 + c8);
            *(u32x4*)(PL + (size_t)(t0 + row) * 256 + n * 64 + c8) = *(const LAS u32x4*)(Pw + row * 64 + c8); }
        LDS_WAIT(); asm volatile("" ::: "memory");
    }
}
__device__ __forceinline__ void phase_lru_b(ArgsRef a, int wv) {
    const float* __restrict__ AGGH = (const float*)(a.ws + WS_AGGH); const float* __restrict__ AGGP = (const float*)(a.ws + WS_AGGP); float* __restrict__ CARRY = (float*)(a.ws + WS_CARRY);
    const int tid_ = tid_from(wv);
    for (int idx = blockIdx.x * NTHR + tid_; idx < NB * 256; idx += gridDim.x * NTHR) { const int b = idx >> 8, c = idx & 255; float carry = 0.f;
        for (int k0 = 0; k0 < LRU_NCH; k0 += 16) { float pp[16], hh[16];
#pragma unroll
            for (int k = 0; k < 16; ++k) { const size_t o = (size_t)(b * LRU_NCH + k0 + k) * 256 + c; pp[k] = AGGP[o]; hh[k] = AGGH[o]; }
#pragma unroll
            for (int k = 0; k < 16; ++k) { const size_t o = (size_t)(b * LRU_NCH + k0 + k) * 256 + c; CARRY[o] = carry; carry = pp[k] * carry + hh[k]; } } }
}
typedef short v4i16_t __attribute__((ext_vector_type(4)));
struct AttnUnit { int h, n, r, dl; size_t rowb; int g; };
__device__ __forceinline__ AttnUnit attn_decode(int unit) {
    AttnUnit u; const int blk = unit & 31; u.g = (unit >> 5) % 3; u.h = (unit / 96) & 7; const int b = unit / 768;
    u.dl = (u.g == 0) ? 1 : (u.g == 1 ? 4 : 16); const int nb = 32 / u.dl; u.n = blk % nb; u.r = blk / nb; u.rowb = (size_t)b * SEQ; return u;
}
__device__ __forceinline__ void attn_dma(const __amdgpu_buffer_rsrc_t rs, LAS unsigned char* lds, const AttnUnit& u, int buf, int wave, int lane) {
    const int kr0 = 8 * wave + (lane >> 3), csc = (lane & 7) ^ ((lane >> 3) & 7);
#pragma unroll
    for (int q = 0; q < 4; ++q) { const int keyrow = kr0 + 64 * q; int l = 128 * (u.n - 1) + keyrow; l = l < 0 ? 0 : l;
        const unsigned rowoff = (unsigned)((u.rowb + (size_t)l * u.dl + u.r) * NIN * 2);
        const unsigned srcK = rowoff + (unsigned)((C_K + (u.h >> 2) * 256 + (u.h & 3) * 32) * 2) + (unsigned)((csc >> 2) * 256 + (csc & 3) * 16);
        const unsigned srcV = rowoff + (unsigned)((C_V + u.h * 64) * 2) + (unsigned)(csc * 16);
        LAS unsigned char* dst = lds + buf * 65536 + (wave + 8 * q) * 1024;
        __builtin_amdgcn_raw_ptr_buffer_load_lds(rs, (LAS void*)dst, 16, srcK, 0, 0, 0);
        __builtin_amdgcn_raw_ptr_buffer_load_lds(rs, (LAS void*)(dst + 32768), 16, srcV, 0, 0, 0); }
}
__device__ __forceinline__ void phase_attn(ArgsRef a, LAS unsigned char* lds, int wv) {
    const int tid = tid_from(wv), lane = tid & 63, wave = __builtin_amdgcn_readfirstlane(tid >> 6);
    const bf16* proj = (const bf16*)(a.ws + WS_PROJ);
    bf16* PNUM = (bf16*)(a.ws + WS_PNUM); float* PDEN = (float*)(a.ws + WS_PDEN); float* PMAX = (float*)(a.ws + WS_PMAX);
    const __amdgpu_buffer_rsrc_t rs = __builtin_amdgcn_make_buffer_rsrc((void*)proj, 0, 0x7fffffff, 0x00020000);
    const int lr = lane & 15, lq = lane >> 4, qi0 = 16 * wave, G = gridDim.x;
    constexpr int NUNITS = NB * 8 * 3 * 32;
    const int kro = (qi0 + lr) * 128, kc0 = ((0 + lq) ^ (lr & 7)) * 16, kc1 = ((4 + lq) ^ (lr & 7)) * 16;
    const int q4 = (lane & 15) >> 2, p4 = lane & 3, vrow = qi0 + 4 * lq + q4, vsw = (4 * lq + q4) & 7;
    __syncthreads();
    const bool xo = (G == 256); const int xcd = blockIdx.x & 7, jx = blockIdx.x >> 3;
#define ATT_UNIT(i) (xo ? ((xcd * 16 + (i) / 3) * 96 + ((i) % 3) * 32 + jx) : ((int)blockIdx.x + (i) * G))
    int it = 0; int unit = ATT_UNIT(0);
    AttnUnit cu = attn_decode(unit < NUNITS ? unit : 0);
    bf16x8 qf0, qf1;
    if (unit < NUNITS) { attn_dma(rs, lds, cu, 0, wave, lane);
        const size_t qrow = cu.rowb + (size_t)(128 * cu.n + qi0 + lr) * cu.dl + cu.r;
        const int qc = C_Q + (cu.h >> 2) * 256 + (cu.h & 3) * 32 + lq * 8; qf0 = *(const bf16x8*)(proj + qrow * NIN + qc); qf1 = *(const bf16x8*)(proj + qrow * NIN + qc + 128); }
    int buf = 0;
    asm volatile("s_waitcnt vmcnt(0)" ::: "memory");
    while (unit < NUNITS) {
        asm volatile("s_waitcnt vmcnt(4)" ::: "memory"); __builtin_amdgcn_s_barrier(); asm volatile("" ::: "memory");
        ++it; const int nunit = (xo && it >= 48) ? NUNITS : ATT_UNIT(it); AttnUnit nu = attn_decode(nunit < NUNITS ? nunit : 0); bf16x8 nq0 = qf0, nq1 = qf1;
        if (nunit < NUNITS) { attn_dma(rs, lds, nu, buf ^ 1, wave, lane);
            const size_t qrow = nu.rowb + (size_t)(128 * nu.n + qi0 + lr) * nu.dl + nu.r;
            const int qc = C_Q + (nu.h >> 2) * 256 + (nu.h & 3) * 32 + lq * 8; nq0 = *(const bf16x8*)(proj + qrow * NIN + qc); nq1 = *(const bf16x8*)(proj + qrow * NIN + qc + 128); }
        const LAS unsigned char* Kb = lds + buf * 65536; const LAS unsigned char* Vb = Kb + 32768;
        f32x4 sc[9];
#pragma unroll
        for (int t = 0; t < 9; ++t) { const bf16x8 k0 = *(const LAS bf16x8*)(Kb + kro + t * 2048 + kc0), k1 = *(const LAS bf16x8*)(Kb + kro + t * 2048 + kc1);
            sc[t] = __builtin_amdgcn_mfma_f32_16x16x32_bf16(k0, qf0, (f32x4){0.f, 0.f, 0.f, 0.f}, 0, 0, 0);
            sc[t] = __builtin_amdgcn_mfma_f32_16x16x32_bf16(k1, qf1, sc[t], 0, 0, 0); }
#pragma unroll
        for (int reg = 0; reg < 4; ++reg) { if (4 * lq + reg < lr) sc[0][reg] = -1e30f; if (4 * lq + reg > lr) sc[8][reg] = -1e30f; }
        if (cu.n == 0) {
#pragma unroll
            for (int t = 0; t < 8; ++t)
#pragma unroll
                for (int reg = 0; reg < 4; ++reg) { if (qi0 + 16 * t + 4 * lq + reg < 128) sc[t][reg] = -1e30f; } }
        float mx = -1e30f;
#pragma unroll
        for (int t = 0; t < 9; ++t)
#pragma unroll
            for (int reg = 0; reg < 4; ++reg) mx = fmaxf(mx, sc[t][reg]);
        mx = fmaxf(mx, __shfl_xor(mx, 16)); mx = fmaxf(mx, __shfl_xor(mx, 32));
        float sm = 0.f;
#pragma unroll
        for (int t = 0; t < 9; ++t)
#pragma unroll
            for (int reg = 0; reg < 4; ++reg) { const float pe = __builtin_amdgcn_exp2f(sc[t][reg] - mx); sm += pe; sc[t][reg] = pe; }
        sm += __shfl_xor(sm, 16); sm += __shfl_xor(sm, 32);
        f32x4 oc[4];
#pragma unroll
        for (int dt = 0; dt < 4; ++dt) oc[dt] = (f32x4){0.f, 0.f, 0.f, 0.f};
#pragma unroll
        for (int pi = 0; pi < 5; ++pi) { const int t0 = 2 * pi, t1 = (2 * pi + 1 < 9) ? 2 * pi + 1 : 8;
            u32x4 pw; pw.x = cvt_pk_bf16(sc[t0][0], sc[t0][1]); pw.y = cvt_pk_bf16(sc[t0][2], sc[t0][3]);
            if (2 * pi + 1 < 9) { pw.z = cvt_pk_bf16(sc[t1][0], sc[t1][1]); pw.w = cvt_pk_bf16(sc[t1][2], sc[t1][3]); } else { pw.z = 0u; pw.w = 0u; }
            const bf16x8 pf = __builtin_bit_cast(bf16x8, pw);
#pragma unroll
            for (int dt = 0; dt < 4; ++dt) { const int ch = ((2 * dt + (p4 >> 1)) ^ vsw) * 16 + (p4 & 1) * 8;
                const v4i16_t v0 = __builtin_amdgcn_ds_read_tr16_b64_v4i16((LAS v4i16_t*)(Vb + (vrow + 16 * t0) * 128 + ch));
                const v4i16_t v1 = __builtin_amdgcn_ds_read_tr16_b64_v4i16((LAS v4i16_t*)(Vb + (vrow + 16 * t1) * 128 + ch));
                const bf16x8 vf = (bf16x8){v0[0], v0[1], v0[2], v0[3], v1[0], v1[1], v1[2], v1[3]};
                oc[dt] = __builtin_amdgcn_mfma_f32_16x16x32_bf16(pf, vf, oc[dt], 0, 0, 0); } }
        { LAS bf16* stg = (LAS bf16*)(lds + OST_OFF + wave * 2048);
#pragma unroll
          for (int reg = 0; reg < 4; ++reg)
#pragma unroll
              for (int dt = 0; dt < 4; ++dt) stg[(4 * lq + reg) * 64 + dt * 16 + lr] = f2bf(oc[dt][reg]);
          LDS_WAIT(); asm volatile("" ::: "memory");
#pragma unroll
          for (int i = 0; i < 2; ++i) { const int qq = i * 8 + (lane >> 3), c8 = (lane & 7) * 8; const u32x4 w = *(const LAS u32x4*)(stg + qq * 64 + c8);
              const size_t tok = cu.rowb + (size_t)(128 * cu.n + qi0 + qq) * cu.dl + cu.r;
              *(u32x4*)(PNUM + ((size_t)cu.g * NT + tok) * 512 + cu.h * 64 + c8) = w; }
          LDS_WAIT(); asm volatile("" ::: "memory"); }
        if (lq == 0) { const size_t tok = cu.rowb + (size_t)(128 * cu.n + qi0 + lr) * cu.dl + cu.r; PDEN[((size_t)cu.g * NT + tok) * 8 + cu.h] = sm; PMAX[((size_t)cu.g * NT + tok) * 8 + cu.h] = mx; }
        cu = nu; qf0 = nq0; qf1 = nq1; buf ^= 1; unit = nunit;
    }
#undef ATT_UNIT
}
__device__ __forceinline__ void phase_finalize(ArgsRef a, int wv) {
    const int tid = tid_from(wv), lane = tid & 63, wave = tid >> 6;
    const int gw = blockIdx.x * NWAVES + wave, NGW = gridDim.x * NWAVES;
    const bf16* __restrict__ proj = (const bf16*)(a.ws + WS_PROJ); bf16* __restrict__ mix = (bf16*)(a.ws + WS_MIX);
    const bf16* __restrict__ YP = (const bf16*)(a.ws + WS_YP); const float* __restrict__ SSQPOOL = (const float*)(a.ws + WS_SSQPOOL);
    const bf16* __restrict__ HL = (const bf16*)(a.ws + WS_HL); const bf16* __restrict__ PL = (const bf16*)(a.ws + WS_PL); const float* __restrict__ CARRY = (const float*)(a.ws + WS_CARRY);
    const bf16* __restrict__ PNUM = (const bf16*)(a.ws + WS_PNUM); const float* __restrict__ PDEN = (const float*)(a.ws + WS_PDEN); const float* __restrict__ PMAX = (const float*)(a.ws + WS_PMAX);
    const int hd = lane >> 3;
    for (int t = gw; t < NT; t += NGW) {
        const u32x2 ypw = *(const u32x2*)(YP + (size_t)t * 256 + lane * 4); const f32x4 sq = *(const f32x4*)(SSQPOOL + (size_t)t * 4);
        const u32x2 hw = *(const u32x2*)(HL + (size_t)t * 256 + lane * 4), pw = *(const u32x2*)(PL + (size_t)t * 256 + lane * 4), gwd = *(const u32x2*)(proj + (size_t)t * NIN + C_GATE + lane * 4);
        const f32x4 cr = *(const f32x4*)(CARRY + (size_t)(t / LRU_CH) * 256 + lane * 4);
        float m[3], dn[3]; u32x4 nw[3];
#pragma unroll
        for (int g = 0; g < 3; ++g) { m[g] = PMAX[((size_t)g * NT + t) * 8 + hd]; dn[g] = PDEN[((size_t)g * NT + t) * 8 + hd]; nw[g] = *(const u32x4*)(PNUM + ((size_t)g * NT + t) * 512 + lane * 8); }
        { const float rs = __builtin_amdgcn_rsqf(((sq[0] + sq[1]) + (sq[2] + sq[3])) * (1.0f / 256.0f) + EPS);
          u32x2 o; o.x = cvt_pk_bf16(bflo(ypw.x) * rs, bfhi(ypw.x) * rs); o.y = cvt_pk_bf16(bflo(ypw.y) * rs, bfhi(ypw.y) * rs);
          *(u32x2*)(mix + (size_t)t * DM + lane * 4) = o; }
        { float h[4] = {bflo(hw.x) + bflo(pw.x) * cr[0], bfhi(hw.x) + bfhi(pw.x) * cr[1], bflo(hw.y) + bflo(pw.y) * cr[2], bfhi(hw.y) + bfhi(pw.y) * cr[3]};
          const float gt[4] = {bflo(gwd.x), bfhi(gwd.x), bflo(gwd.y), bfhi(gwd.y)};
          float s = 0.f;
#pragma unroll
          for (int j = 0; j < 4; ++j) { h[j] *= gelu_tanh(gt[j]); s += h[j] * h[j]; }
          s = wave_sum(s); const float rs = __builtin_amdgcn_rsqf(s * (1.0f / 256.0f) + EPS);
          u32x2 o; o.x = cvt_pk_bf16(h[0] * rs, h[1] * rs); o.y = cvt_pk_bf16(h[2] * rs, h[3] * rs);
          *(u32x2*)(mix + (size_t)t * DM + 256 + lane * 4) = o; }
        { const float mr = fmaxf(fmaxf(m[0], m[1]), m[2]);
          float o[8] = {0.f, 0.f, 0.f, 0.f, 0.f, 0.f, 0.f, 0.f}; float den = 0.f;
#pragma unroll
          for (int g = 0; g < 3; ++g) { const float wg = __builtin_amdgcn_exp2f(m[g] - mr); den += wg * dn[g];
              o[0] += wg * bflo(nw[g].x); o[1] += wg * bfhi(nw[g].x); o[2] += wg * bflo(nw[g].y); o[3] += wg * bfhi(nw[g].y); o[4] += wg * bflo(nw[g].z); o[5] += wg * bfhi(nw[g].z); o[6] += wg * bflo(nw[g].w); o[7] += wg * bfhi(nw[g].w); }
          const float inv = 1.0f / den; float s = 0.f;
#pragma unroll
          for (int j = 0; j < 8; ++j) { o[j] *= inv; s += o[j] * o[j]; }
          s = wave_sum(s); const float rs = __builtin_amdgcn_rsqf(s * (1.0f / 512.0f) + EPS);
          u32x4 wv4; wv4.x = cvt_pk_bf16(o[0] * rs, o[1] * rs); wv4.y = cvt_pk_bf16(o[2] * rs, o[3] * rs); wv4.z = cvt_pk_bf16(o[4] * rs, o[5] * rs); wv4.w = cvt_pk_bf16(o[6] * rs, o[7] * rs);
          *(u32x4*)(mix + (size_t)t * DM + 512 + lane * 8) = wv4; }
    }
}

__device__ __forceinline__ void phase_router(ArgsRef a, LAS unsigned char* lds, int layer, int wv, bool alloc) {
    const int tid = tid_from(wv), lane = tid & 63, wave = __builtin_amdgcn_readfirstlane(tid >> 6);
    const bf16* xb = (const bf16*)(a.ws + WS_XB); const bf16* wr = (const bf16*)(a.ws + WS_SMALL) + SM_WR + (size_t)layer * NEXP * DM;
    const float* ssqp = (const float*)(a.ws + WS_SSQP); const float* rbias = a.in[I_BR] + layer * NEXP;
    int* LIST = (int*)(a.ws + WS_LIST); float* LRSTD = (float*)(a.ws + WS_LRSTD); float* LGATE = (float*)(a.ws + WS_LGATE2);
    unsigned* cnt = (unsigned*)(a.ws + WS_CTL) + CW_CNT + layer * NEXP;
    LAS float* LG = (LAS float*)lds + wave * 32 * 33;
    LAS int* hist = (LAS int*)(lds + 65536);
    LAS int* base = (LAS int*)(lds + 65536 + 128);
    const int lr = lane & 15, lq = lane >> 4;
    for (int unit = blockIdx.x; unit < NT / 256; unit += gridDim.x) {
        const int tok0 = unit * 256 + wave * 32;
        __syncthreads();
        if (tid < 32) hist[tid] = 0;
        f32x4 acc[2][2];
#pragma unroll
        for (int rt = 0; rt < 2; ++rt)
#pragma unroll
            for (int et = 0; et < 2; ++et) acc[rt][et] = (f32x4){0.f, 0.f, 0.f, 0.f};
#pragma unroll 4
        for (int ks = 0; ks < 32; ++ks) { bf16x8 af[2], bfr[2];
#pragma unroll
            for (int rt = 0; rt < 2; ++rt) af[rt] = *(const bf16x8*)(xb + (size_t)(tok0 + rt * 16 + lr) * DM + ks * 32 + lq * 8);
#pragma unroll
            for (int et = 0; et < 2; ++et) bfr[et] = *(const bf16x8*)(wr + (size_t)(et * 16 + lr) * DM + ks * 32 + lq * 8);
#pragma unroll
            for (int rt = 0; rt < 2; ++rt)
#pragma unroll
                for (int et = 0; et < 2; ++et) acc[rt][et] = __builtin_amdgcn_mfma_f32_16x16x32_bf16(af[rt], bfr[et], acc[rt][et], 0, 0, 0); }
#pragma unroll
        for (int rt = 0; rt < 2; ++rt)
#pragma unroll
            for (int et = 0; et < 2; ++et)
#pragma unroll
                for (int reg = 0; reg < 4; ++reg) LG[(rt * 16 + lq * 4 + reg) * 33 + et * 16 + lr] = acc[rt][et][reg];
        __syncthreads();
        int te[4] = {0, 0, 0, 0}; float tg[4] = {0.f, 0.f, 0.f, 0.f}; int rk[4] = {0, 0, 0, 0}; float rstd = 0.f; const int tok = tok0 + lane;
        if (lane < 32) {
            const float* sp = ssqp + (size_t)tok * 16; float ss = 0.f;
#pragma unroll
            for (int j = 0; j < 16; ++j) ss += sp[j];
            rstd = __builtin_amdgcn_rsqf(ss * (1.0f / DM) + EPS);
            float tv[4] = {-3e38f, -3e38f, -3e38f, -3e38f};
            for (int e = 0; e < NEXP; ++e) { float v = LG[lane * 33 + e] * rstd + rbias[e]; int ve = e;
#pragma unroll
                for (int k = 0; k < 4; ++k) { if (v > tv[k]) { const float tvv = tv[k]; const int tee = te[k]; tv[k] = v; te[k] = ve; v = tvv; ve = tee; } } }
            float z = 0.f;
#pragma unroll
            for (int k = 0; k < 4; ++k) { tg[k] = fast_exp(tv[k] - tv[0]); z += tg[k]; }
            const float iz = 1.0f / z;
#pragma unroll
            for (int k = 0; k < 4; ++k) { tg[k] *= iz; rk[k] = __hip_atomic_fetch_add(&hist[te[k]], 1, __ATOMIC_RELAXED, __HIP_MEMORY_SCOPE_WORKGROUP); }
        }
        __syncthreads();
        if (tid < 32) base[tid] = alloc ? (int)__hip_atomic_fetch_add(cnt + tid, (unsigned)hist[tid], RLX_AGENT) : 0;
        __syncthreads();
        if (lane < 32 && alloc) {
#pragma unroll
            for (int k = 0; k < 4; ++k) { const size_t p = (size_t)te[k] * NT + base[te[k]] + rk[k]; LIST[p] = tok * 4 + k; LRSTD[p] = rstd; LGATE[p] = tg[k]; }
        }
    }
}

__device__ __forceinline__ void phase_combine(ArgsRef a, bool last_layer, int wv, bool dry) {
    const int tid = tid_from(wv), lane = tid & 63, wave = tid >> 6;
    const int gw = blockIdx.x * NWAVES + wave, NGW = gridDim.x * NWAVES;
    const unsigned char* __restrict__ Y = (const unsigned char*)(a.ws + WS_Y); float* __restrict__ out = a.out; bf16* xb = (bf16*)(a.ws + WS_XB); float* __restrict__ ssq = (float*)(a.ws + WS_SSQ);
    typedef float f2v __attribute__((ext_vector_type(2)));
    for (int t = gw; t < NT; t += NGW) {
        const u32x4 x0 = *((const u32x4*)(xb + (size_t)t * DM) + 2 * lane), x1 = *((const u32x4*)(xb + (size_t)t * DM) + 2 * lane + 1);
        u32x4 y[4];
#pragma unroll
        for (int k = 0; k < 4; ++k) y[k] = *((const u32x4*)(Y + ((size_t)t * 4 + k) * DM) + lane);
        float v[16];
        v[0] = bflo(x0.x); v[1] = bfhi(x0.x); v[2] = bflo(x0.y); v[3] = bfhi(x0.y); v[4] = bflo(x0.z); v[5] = bfhi(x0.z); v[6] = bflo(x0.w); v[7] = bfhi(x0.w);
        v[8] = bflo(x1.x); v[9] = bfhi(x1.x); v[10] = bflo(x1.y); v[11] = bfhi(x1.y); v[12] = bflo(x1.z); v[13] = bfhi(x1.z); v[14] = bflo(x1.w); v[15] = bfhi(x1.w);
#pragma unroll
        for (int k = 0; k < 4; ++k)
#pragma unroll
            for (int d = 0; d < 4; ++d) { const int w = (int)y[k][d]; const f2v lo = __builtin_amdgcn_cvt_pk_f32_fp8(w, false), hi = __builtin_amdgcn_cvt_pk_f32_fp8(w, true);
                v[4 * d + 0] += lo.x * (1.0f / Y8_SCALE); v[4 * d + 1] += lo.y * (1.0f / Y8_SCALE); v[4 * d + 2] += hi.x * (1.0f / Y8_SCALE); v[4 * d + 3] += hi.y * (1.0f / Y8_SCALE); }
        float s = 0.f;
#pragma unroll
        for (int j = 0; j < 16; ++j) s += v[j] * v[j];
        if (dry && s != 12345.678f) continue;
        if (last_layer) {
#pragma unroll
            for (int j = 0; j < 4; ++j) *((f32x4*)(out + (size_t)t * DM) + 4 * lane + j) = (f32x4){v[4 * j], v[4 * j + 1], v[4 * j + 2], v[4 * j + 3]};
        } else { s = wave_sum(s);
            u32x4 w0, w1; w0.x = cvt_pk_bf16(v[0], v[1]); w0.y = cvt_pk_bf16(v[2], v[3]); w0.z = cvt_pk_bf16(v[4], v[5]); w0.w = cvt_pk_bf16(v[6], v[7]);
            w1.x = cvt_pk_bf16(v[8], v[9]); w1.y = cvt_pk_bf16(v[10], v[11]); w1.z = cvt_pk_bf16(v[12], v[13]); w1.w = cvt_pk_bf16(v[14], v[15]);
            *((u32x4*)(xb + (size_t)t * DM) + 2 * lane) = w0; *((u32x4*)(xb + (size_t)t * DM) + 2 * lane + 1) = w1;
            if (lane == 0) ssq[t] = s; }
    }
}

constexpr int NPH_LAYER = 13, NPH = 1 + 2 * NPH_LAYER;
enum { PH_GEMM_IN = 0, PH_QKPREP, PH_POOL, PH_LRU_A, PH_LRU_B, PH_ATTN, PH_LRU_C, PH_MERGE, PH_GEMM_OUT, PH_ROUTER, PH_MOE_GU, PH_MOE_DOWN, PH_COMBINE };
#ifndef MK_STOP
#define MK_STOP NPH
#endif
#ifndef MK_SPLIT
#define MK_SPLIT 0
#endif

template <int PHMASK>
__global__ void __launch_bounds__(NTHR, 2) mega_fwd(Args args_by_value) {
    extern __shared__ __attribute__((aligned(16))) unsigned char lds_raw[];
    LAS unsigned char* lds = (LAS unsigned char*)lds_raw;
    const int tid = threadIdx.x;
    int wv = __builtin_amdgcn_readfirstlane(tid >> 6); asm volatile("" : "+s"(wv));
    for (int u = tid; u < (LDS_BYTES - LDSCTL_OFF) / 4; u += NTHR) ((LAS unsigned*)(lds + LDSCTL_OFF))[u] = 0u;
    __syncthreads();
#define ARGS_HERE() const CAS Args* ap_ = (const CAS Args*)__builtin_amdgcn_kernarg_segment_ptr(); asm volatile("" : "+s"(ap_)); ArgsRef args = *ap_; unsigned char* const ws = args.ws; unsigned* const ctl = (unsigned*)(ws + WS_CTL); (void)ctl
    int lo, hi;
    { ARGS_HERE(); lo = args.ph_lo; hi = args.ph_hi; xcd_barrier_post(ctl + CW_BAR + args.li * XCD_BAR_WORDS, (volatile LAS unsigned*)(lds + MISC_OFF) + 8); }
#define EN(p) (((PHMASK) >> (p)) & 1)
#ifndef MK_DUP
#define MK_DUP 0
#endif
#define NREP(p) ((((MK_DUP) >> (p)) & 1) ? 2 : 1)
#define IN(k) (lo <= (k) && (k) < hi)
#define SEAM(k) do { if (IN(k) && IN((k) + 1)) { ARGS_HERE(); XcdBarrier bar_; bar_.bar = ctl + CW_BAR + args.li * XCD_BAR_WORDS; bar_.x = xb_xcc_id(); bar_.st = (volatile LAS unsigned*)(lds + MISC_OFF) + 8; xcd_barrier(bar_); } } while (0)

    if (EN(13) && IN(0)) { ARGS_HERE(); for (int rep_ = 0; rep_ < NREP(13); ++rep_) { phase_prologue(args, lds, wv); } }
    SEAM(0);
    for (int l = 0; l < 2; ++l) {
        const int pb = 1 + NPH_LAYER * l;
        if (EN(PH_GEMM_IN) && IN(pb + PH_GEMM_IN)) { ARGS_HERE();
            pg8::StaticOrder S; S.init(NT, NIN, DM, gridDim.x, blockIdx.x); S.dup = NREP(PH_GEMM_IN) - 1;
            EpiIn E{(bf16*)(ws + WS_PROJ), (const float*)(ws + WS_SSQ), args.in[I_QG] + l * 64, args.in[I_KG] + l * 64, (const float*)(ws + WS_ROPE), (const float*)(ws + WS_ROPE) + SEQ * 32};
            pg8::gemm_phase<EpiIn, pg8::StaticOrder, true>(lds, (const bf16*)(ws + WS_XB), (const bf16*)(ws + WS_WIN) + (size_t)l * NIN * DM, DM, S, E, wv);
        }
        SEAM(pb + PH_GEMM_IN);
        if (EN(PH_POOL) && IN(pb + PH_POOL)) { ARGS_HERE(); for (int rep_ = 0; rep_ < NREP(PH_POOL); ++rep_) { phase_pool(args, lds, l, wv); } }
        if (EN(PH_LRU_A) && IN(pb + PH_LRU_A)) { ARGS_HERE(); for (int rep_ = 0; rep_ < NREP(PH_LRU_A); ++rep_) { phase_lru_a(args, lds, l, wv); } }
        SEAM(pb + PH_LRU_A);
        if (EN(PH_LRU_B) && IN(pb + PH_LRU_B)) { ARGS_HERE(); for (int rep_ = 0; rep_ < NREP(PH_LRU_B); ++rep_) { phase_lru_b(args, wv); } }
        if (EN(PH_ATTN) && IN(pb + PH_ATTN)) { ARGS_HERE(); for (int rep_ = 0; rep_ < NREP(PH_ATTN); ++rep_) { phase_attn(args, lds, wv); } }
        SEAM(pb + PH_ATTN);
        if (EN(PH_LRU_C) && IN(pb + PH_LRU_C)) { ARGS_HERE(); for (int rep_ = 0; rep_ < NREP(PH_LRU_C); ++rep_) { phase_finalize(args, wv); } }
        SEAM(pb + PH_MERGE);
        if (EN(PH_GEMM_OUT) && IN(pb + PH_GEMM_OUT)) { ARGS_HERE();
            __syncthreads();
            pg8::StaticOrder S; S.init(NT, DM, DM, gridDim.x, blockIdx.x); S.dup = (l == 0) ? NREP(PH_GEMM_OUT) - 1 : 0;
            EpiOut E{(bf16*)(ws + WS_XB), (float*)(ws + WS_SSQP)};
            pg8::gemm_phase<EpiOut, pg8::StaticOrder, true>(lds, (const bf16*)(ws + WS_MIX), (const bf16*)(ws + WS_WOUT) + (size_t)l * DM * DM, DM, S, E, wv);
        }
        SEAM(pb + PH_GEMM_OUT);
        if (EN(PH_ROUTER) && IN(pb + PH_ROUTER)) { ARGS_HERE(); for (int rep_ = 0; rep_ < NREP(PH_ROUTER); ++rep_) { phase_router(args, lds, l, wv, rep_ == NREP(PH_ROUTER) - 1); } }
        SEAM(pb + PH_ROUTER);
        if (EN(PH_MOE_GU) && IN(pb + PH_MOE_GU)) { ARGS_HERE();
            LAS int* tab = (LAS int*)(lds + TAB_OFF);
            moe_tables(tab, ctl + CW_CNT + l * NEXP, wv);
            MoeOrder<0> S{tab, 2, (int)gridDim.x, (int)blockIdx.x, (const int*)(ws + WS_LIST), NREP(PH_MOE_GU) - 1};
            EpiGU E{(bf16*)(ws + WS_ACT), (const float*)(ws + WS_LRSTD), args.in[I_BGU] + (size_t)l * NEXP * 512};
            pg8::gemm_phase<EpiGU, MoeOrder<0>, true>(lds, (const bf16*)(ws + WS_XB), (const bf16*)(ws + WS_WGU) + (size_t)l * NEXP * 512 * DM, DM, S, E, wv);
        }
        SEAM(pb + PH_MOE_GU);
        if (EN(PH_MOE_DOWN) && IN(pb + PH_MOE_DOWN)) { ARGS_HERE();
            LAS int* tab = (LAS int*)(lds + TAB_OFF);
            moe_tables(tab, ctl + CW_CNT + l * NEXP, wv);
            MoeOrder<1> S{tab, 4, (int)gridDim.x, (int)blockIdx.x, (const int*)(ws + WS_LIST), NREP(PH_MOE_DOWN) - 1};
            EpiDown E{(unsigned char*)(ws + WS_Y), (const int*)(ws + WS_LIST), (const float*)(ws + WS_LGATE2), args.in[I_BD] + (size_t)l * NEXP * DM, tab};
            pg8::gemm_phase<EpiDown, MoeOrder<1>, true>(lds, (const bf16*)(ws + WS_ACT), (const bf16*)(ws + WS_WD) + (size_t)l * NEXP * DM * EFF, EFF, S, E, wv);
        }
        SEAM(pb + PH_MOE_DOWN);
        if (EN(PH_COMBINE) && IN(pb + PH_COMBINE)) { ARGS_HERE(); for (int rep_ = 0; rep_ < NREP(PH_COMBINE); ++rep_) { phase_combine(args, l == 1, wv, rep_ < NREP(PH_COMBINE) - 1); } }
        SEAM(pb + PH_COMBINE);
    }
#undef IN
#undef SEAM
}

typedef void (*kern_t)(Args);
template <int M> static kern_t kern_of() { return (kern_t)mega_fwd<M>; }
static kern_t phase_kernel(int p) {
    switch (p) { case 0: return kern_of<1 << 0>(); case 1: return kern_of<1 << 1>(); case 2: return kern_of<1 << 2>(); case 3: return kern_of<1 << 3>(); case 4: return kern_of<1 << 4>();
                 case 5: return kern_of<1 << 5>(); case 6: return kern_of<1 << 6>(); case 7: return kern_of<1 << 7>(); case 8: return kern_of<1 << 8>(); case 9: return kern_of<1 << 9>();
                 case 10: return kern_of<1 << 10>(); case 11: return kern_of<1 << 11>(); case 12: return kern_of<1 << 12>(); default: return kern_of<1 << 13>(); }
}
extern "C" void kernel_launch(void* const* d_in, const int* in_sizes, int n_in, void* d_out, int out_size, void* d_ws, size_t ws_size, hipStream_t stream) {
    static int grid = 0;
    if (grid == 0) {
        if (n_in != 23 || in_sizes[0] != NT * DM || out_size != NT * DM || ws_size < WS_END) {
            fprintf(stderr, "kernel_launch: built for 23 inputs, x/out of %d floats, >= %zu bytes of workspace; got n_in %d, in0 %d, out %d, ws %zu; nothing launched\n", NT * DM, (size_t)WS_END, n_in, n_in > 0 ? in_sizes[0] : -1, out_size, ws_size);
            grid = -1; return; }
        int dev = 0, cus = 0;
        if (hipGetDevice(&dev) != hipSuccess || hipDeviceGetAttribute(&cus, hipDeviceAttributeMultiprocessorCount, dev) != hipSuccess) { fprintf(stderr, "kernel_launch: device query failed\n"); grid = -1; return; }
#if MK_SPLIT
        for (int p = 0; p < 14; ++p) if (hipFuncSetAttribute((const void*)phase_kernel(p), hipFuncAttributeMaxDynamicSharedMemorySize, LDS_BYTES) != hipSuccess) { fprintf(stderr, "kernel_launch: hipFuncSetAttribute failed\n"); grid = -1; return; }
#else
        if (hipFuncSetAttribute((const void*)kern_of<0x3fff>(), hipFuncAttributeMaxDynamicSharedMemorySize, LDS_BYTES) != hipSuccess) { fprintf(stderr, "kernel_launch: hipFuncSetAttribute failed\n"); grid = -1; return; }
        int per_cu = 0;
        if (hipOccupancyMaxActiveBlocksPerMultiprocessor(&per_cu, (const void*)kern_of<0x3fff>(), NTHR, LDS_BYTES) != hipSuccess || per_cu < 1)
            fprintf(stderr, "kernel_launch: note: occupancy query reports %d workgroups per CU\n", per_cu);
#endif
        (void)hipGetLastError();
        grid = cus;
    }
    if (grid < 0) return;
    if (hipMemsetAsync((char*)d_ws + WS_CTL, 0, CTL_ZERO_BYTES, stream) != hipSuccess) { fprintf(stderr, "kernel_launch: hipMemsetAsync failed\n"); return; }
    Args a{};
    for (int i = 0; i < 23; ++i) a.in[i] = (const float*)d_in[i];
    a.out = (float*)d_out; a.ws = (unsigned char*)d_ws; a.pad = 0;
#if MK_SPLIT
#ifdef MK_SKIP
    (void)hipMemsetAsync((char*)d_ws + WS_MIX, 0, (size_t)NT * DM * 2, stream);
#endif
    for (int p = 0; p < MK_STOP; ++p) { a.ph_lo = p; a.ph_hi = p + 1; a.li = p;
#ifdef MK_SKIP
        if (p >= 1 && (((MK_SKIP) >> ((p - 1) % NPH_LAYER)) & 1)) continue;
#endif
        hipLaunchKernelGGL(phase_kernel(p == 0 ? 13 : (p - 1) % NPH_LAYER), dim3(grid), dim3(NTHR), LDS_BYTES, stream, a); }
#else
    a.ph_lo = 0; a.ph_hi = NPH; a.li = 0;
    hipLaunchKernelGGL(kern_of<0x3fff>(), dim3(grid), dim3(NTHR), LDS_BYTES, stream, a);
#endif
    const hipError_t le = hipPeekAtLastError();
    if (le != hipSuccess) fprintf(stderr, "kernel_launch: launch failed: %s\n", hipGetErrorName(le));
}
```

```cpp
#include <hip/hip_runtime.h>
#include <cstdio>
#include <cstdint>

#define LAS __attribute__((address_space(3)))
#define GAS __attribute__((address_space(1)))
typedef unsigned short bf16;
typedef short bf16x8 __attribute__((ext_vector_type(8)));
typedef float f32x4 __attribute__((ext_vector_type(4)));
typedef float f32x2 __attribute__((ext_vector_type(2)));
typedef unsigned u32x4 __attribute__((ext_vector_type(4)));
typedef unsigned u32x2 __attribute__((ext_vector_type(2)));

#ifndef MK_VAR
#define MK_VAR 0
#endif
constexpr int NB = 16, SEQ = 4096, DM = 1024, NT = NB * SEQ;
constexpr int NIN = 2304;
constexpr int C_POOL = 0, C_LRU = 256, C_GATE = 512, C_Q = 768, C_K = 1280, C_V = 1792;
constexpr int NEXP = 32, TOPK = 4, EFF = 256;
constexpr int NASSIGN = NT * TOPK;
constexpr int ACT_ROWS = NASSIGN + NEXP * 256;
constexpr float EPS = 1e-6f;
constexpr int NWAVES = 8, NTHR = 512;
constexpr int LRU_CH = 32, LRU_NCH = SEQ / LRU_CH;

constexpr size_t MiB = 1u << 20;
constexpr size_t WS_CTL = 0, CTL_ZERO_BYTES = 1 * MiB;
constexpr size_t WS_ROPE = 1 * MiB;
constexpr size_t WS_SMALL = 2 * MiB;
constexpr size_t WS_WIN = 4 * MiB;
constexpr size_t WS_WOUT = 13 * MiB;
constexpr size_t WS_WGU = 17 * MiB;
constexpr size_t WS_WD = 81 * MiB;
constexpr size_t WS_SSQ = 113 * MiB;
constexpr size_t WS_SSQP = 114 * MiB;
constexpr size_t WS_LIST = 118 * MiB;
constexpr size_t WS_XB = 128 * MiB;
constexpr size_t WS_R = 256 * MiB;
constexpr size_t WS_PROJ = WS_R;
constexpr size_t WS_MIX = WS_R + 288 * MiB;
constexpr size_t WS_PNUM = WS_R + 416 * MiB;
constexpr size_t WS_PDEN = WS_R + 608 * MiB;
constexpr size_t WS_PMAX = WS_R + 614 * MiB;
constexpr size_t WS_HL = WS_R + 620 * MiB;
constexpr size_t WS_PL = WS_R + 652 * MiB;
constexpr size_t WS_AGGH = WS_R + 684 * MiB;
constexpr size_t WS_AGGP = WS_R + 686 * MiB;
constexpr size_t WS_CARRY = WS_R + 688 * MiB;
constexpr size_t WS_YP = WS_R + 690 * MiB;
constexpr size_t WS_SSQPOOL = WS_R + 722 * MiB;
constexpr size_t WS_ACT = WS_R;
constexpr size_t WS_Y = WS_R + 132 * MiB;
constexpr size_t WS_LRSTD = WS_R + 644 * MiB;
constexpr size_t WS_LGATE2 = WS_R + 652 * MiB;
constexpr size_t WS_END = 1024 * MiB;
static_assert(WS_CARRY + 2 * MiB <= WS_END && WS_LGATE2 + 8 * MiB <= WS_END, "d_ws map");
constexpr size_t SM_POOLW = 0;
constexpr size_t SM_WA = 32768;
constexpr size_t SM_WX = 65536;
constexpr size_t SM_WR = 98304;
constexpr int CW_BAR = 4096;
constexpr int CW_CNT = 1024;

constexpr int RING_BYTES = 131072;
constexpr int LDSCTL_OFF = RING_BYTES;
constexpr int MISC_OFF = LDSCTL_OFF + 320;
constexpr int TAB_OFF = LDSCTL_OFF + 1024;
constexpr int OST_OFF = RING_BYTES + 8192;
constexpr int LDS_BYTES = 163840;

typedef GAS unsigned gu32;
#define RLX_AGENT __ATOMIC_RELAXED, __HIP_MEMORY_SCOPE_AGENT
#define LDS_WAIT() asm volatile("s_waitcnt lgkmcnt(0)" ::: "memory")
#define VM_WAIT() asm volatile("s_waitcnt vmcnt(0)" ::: "memory")
typedef __bf16 bf16x2_t __attribute__((ext_vector_type(2)));
__device__ __forceinline__ unsigned cvt_pk_bf16(float lo, float hi) { const f32x2 v = {lo, hi}; const bf16x2_t b = __builtin_convertvector(v, bf16x2_t); return __builtin_bit_cast(unsigned, b); }
__device__ __forceinline__ float bflo(unsigned w) { return __uint_as_float(w << 16); }
__device__ __forceinline__ float bfhi(unsigned w) { return __uint_as_float(w & 0xffff0000u); }
__device__ __forceinline__ float bf2f(bf16 h) { return __uint_as_float((unsigned)h << 16); }
__device__ __forceinline__ bf16 f2bf(float f) { return (bf16)(cvt_pk_bf16(f, 0.f) & 0xffffu); }
__device__ __forceinline__ float wave_sum(float v) {
#pragma unroll
    for (int o = 1; o < 64; o <<= 1) v += __shfl_xor(v, o);
    return v;
}
__device__ __forceinline__ float fast_sigmoid(float x) { return __builtin_amdgcn_rcpf(1.0f + __builtin_amdgcn_exp2f(-1.4426950408889634f * x)); }
__device__ __forceinline__ float fast_exp(float x) { return __builtin_amdgcn_exp2f(1.4426950408889634f * x); }
__device__ __forceinline__ float gelu_tanh(float x) {
    const float u = 0.7978845608028654f * (x + 0.044715f * x * x * x);
    return x * fast_sigmoid(2.0f * u);
}
__device__ __forceinline__ int tid_from(int wv) { int ln; asm volatile("v_mbcnt_lo_u32_b32 %0, -1, 0\n\tv_mbcnt_hi_u32_b32 %0, -1, %0" : "=v"(ln)); return wv * 64 + ln; }
namespace pg8 {
constexpr int BM = 256, BK = 64, HALF = 128, HTB = HALF * BK * 2  , STAGE_BYTES = 8 * HTB, NXCD = 8, WGM = 8;

__host__ __device__ __forceinline__ int lds_byte(int r, int c) { const int st = (r >> 4) * 2 + (c >> 5), rr = r & 15, cc = c & 31, ob = rr * 64 + cc * 2; return st * 1024 + (ob ^ (((ob >> 9) & 1) << 5)); }
__host__ __device__ __forceinline__ void stage_rc(int b, int& R, int& C) { const int st = b / 1024, sb = b % 1024, swz = sb ^ (((sb >> 9) & 1) << 5); R = (st >> 1) * 16 + swz / 64; C = (st & 1) * 32 + (swz % 64) / 2; }
__host__ __device__ __forceinline__ int perm32(int rho) { const int n = rho >> 4, i = rho & 15; return 8 * (i >> 2) + 4 * n + (i & 3); }

struct Unit { int pm, pn, e, aux; };

template <class Epi, class Sched, bool ALIGN_EPI>
__device__ __forceinline__ void gemm_phase(LAS unsigned char* lds, const bf16* Abase, const bf16* Bbase, const int K, const Sched& S, const Epi& E, const int wv) {
    const int tid = tid_from(wv), wid = __builtin_amdgcn_readfirstlane(tid >> 6), lane = tid & 63, wr = wid >> 2, wc = wid & 3, fr = lane & 15, fq = lane >> 4;
    const int nt = K / BK;
    unsigned voffB[2];
#pragma unroll
    for (int i = 0; i < 2; ++i) { int R, C; stage_rc(tid * 16 + i * 8192, R, C); const int Rb = Epi::PERM ? ((R & ~31) + perm32(R & 31)) : R;
        voffB[i] = (unsigned)(Rb * K + C) * 2u; }
#define PG8_AVOFF(u, h, i) ([&]() { int R_, C_; stage_rc(tid * 16 + (i) * 8192, R_, C_); return S.a_voff((u), (h) * HALF + R_, C_); }())
    const unsigned kstep = (unsigned)(BK * 2);
    const unsigned hstep = (unsigned)(HALF * K * 2);
    const unsigned ldsw = (unsigned)wid * 1024u;
    const int aoff = lds_byte(wr * 64 + fr, fq * 8), boff = lds_byte(wc * 32 + fr, fq * 8);
    const __amdgpu_buffer_rsrc_t rsA = __builtin_amdgcn_make_buffer_rsrc((void*)Abase, 0, 0x7fffffff, 0x00020000);
    const __amdgpu_buffer_rsrc_t rsB = __builtin_amdgcn_make_buffer_rsrc((void*)Bbase, 0, 0x7fffffff, 0x00020000);
#define PG8_SA(b, h) (((b) * 2 + (h)) * HTB)
#define PG8_SB(b, h) ((4 + (b) * 2 + (h)) * HTB)
#define PG8_STAGE_B(bufoff, soff) do { const int so_ = __builtin_amdgcn_readfirstlane((int)(soff)); _Pragma("unroll") for (int _i = 0; _i < 2; ++_i) \
        __builtin_amdgcn_raw_ptr_buffer_load_lds(rsB, (LAS void*)(lds + (bufoff) + ldsw + _i * 8192), 16, voffB[_i], so_, 0, 0); } while (0)
#define PG8_STAGE_A(bufoff, kbytes, v0, v1) do { const int so_ = __builtin_amdgcn_readfirstlane((int)(kbytes)); \
        __builtin_amdgcn_raw_ptr_buffer_load_lds(rsA, (LAS void*)(lds + (bufoff) + ldsw), 16, (v0), so_, 0, 0); \
        __builtin_amdgcn_raw_ptr_buffer_load_lds(rsA, (LAS void*)(lds + (bufoff) + ldsw + 8192), 16, (v1), so_, 0, 0); } while (0)
#define PG8_LDA(dst, b, h) do { _Pragma("unroll") for (int m = 0; m < 4; ++m) _Pragma("unroll") for (int k = 0; k < 2; ++k) dst[m][k] = *(const LAS bf16x8*)(lds + PG8_SA(b, h) + aoff + m * 2048 + k * 1024); } while (0)
#define PG8_LDB(dst, b, h) do { _Pragma("unroll") for (int n = 0; n < 2; ++n) _Pragma("unroll") for (int k = 0; k < 2; ++k) dst[n][k] = *(const LAS bf16x8*)(lds + PG8_SB(b, h) + boff + n * 2048 + k * 1024); } while (0)
#define PG8_MMA(ai, bj, At, Bt) do { __builtin_amdgcn_s_setprio(1); _Pragma("unroll") for (int m = 0; m < 4; ++m) _Pragma("unroll") for (int n = 0; n < 2; ++n) _Pragma("unroll") for (int k = 0; k < 2; ++k) \
        acc[ai][bj][m][n] = __builtin_amdgcn_mfma_f32_16x16x32_bf16(Bt[n][k], At[m][k], acc[ai][bj][m][n], 0, 0, 0); __builtin_amdgcn_s_setprio(0); } while (0)
#define PG8_WAIT_V(n) asm volatile("s_waitcnt vmcnt(" #n ")" ::: "memory")
#define PG8_WAIT_L(n) asm volatile("s_waitcnt lgkmcnt(" #n ")" ::: "memory")
#define PG8_BAR __builtin_amdgcn_s_barrier()
#define PG8_SCHED __builtin_amdgcn_sched_barrier(0)
    Unit cur, nxt; int ui = 0;
    if (!S.next(0, cur)) return;
    f32x4 acc[2][2][4][2];
#pragma unroll
    for (int a = 0; a < 2; ++a)
#pragma unroll
        for (int b = 0; b < 2; ++b)
#pragma unroll
            for (int m = 0; m < 4; ++m)
#pragma unroll
                for (int n = 0; n < 2; ++n) acc[a][b][m][n] = (f32x4){0.f, 0.f, 0.f, 0.f};
    bf16x8 At[4][2], B0[2][2], B1[2][2];
    unsigned vc0, vc1, vc2, vc3, vn0, vn1, vn2, vn3;
    unsigned cA0, cA1, nA0, nA1;
    vc0 = PG8_AVOFF(cur, 0, 0); vc1 = PG8_AVOFF(cur, 0, 1);
    if constexpr (Sched::GATHER) { vc2 = PG8_AVOFF(cur, 1, 0); vc3 = PG8_AVOFF(cur, 1, 1); } else { vc2 = vc0; vc3 = vc1; }
    cA0 = S.a_soff(cur, 0); cA1 = S.a_soff(cur, 1);
    unsigned cB = (unsigned)S.b_off(cur);
    PG8_STAGE_B(PG8_SB(0, 0), cB); PG8_STAGE_B(PG8_SB(0, 1), cB + hstep); PG8_STAGE_A(PG8_SA(0, 0), cA0, vc0, vc1); PG8_STAGE_A(PG8_SA(0, 1), cA1, vc2, vc3);
    if (wr == 1) PG8_BAR;
    PG8_WAIT_V(2); PG8_BAR;
    PG8_STAGE_B(PG8_SB(1, 0), cB + kstep); PG8_STAGE_A(PG8_SA(1, 0), cA0 + kstep, vc0, vc1); PG8_STAGE_B(PG8_SB(1, 1), cB + hstep + kstep);
    PG8_WAIT_V(6); PG8_BAR;
    for (;;) {
#define PG8_TRIP(a1k, a2k0, a2k1, a3k0, b2, b3, w0, w1, w2, w3) do { \
              \
            PG8_LDB(B0, 0, 0); PG8_LDB(B1, 0, 1); PG8_SCHED; PG8_LDA(At, 0, 0); PG8_STAGE_A(PG8_SA(1, 1), a1k, vc2, vc3); \
            PG8_WAIT_V(8); PG8_WAIT_L(0); PG8_BAR; PG8_MMA(0, 0, At, B0); PG8_MMA(0, 1, At, B1); PG8_BAR; PG8_SCHED; \
              \
            PG8_LDA(At, 0, 1); PG8_STAGE_B(PG8_SB(0, 0), b2); PG8_STAGE_B(PG8_SB(0, 1), (b2) + hstep); PG8_STAGE_A(PG8_SA(0, 0), a2k0, w0, w1); \
            PG8_WAIT_V(8); PG8_WAIT_L(0); PG8_BAR; PG8_MMA(1, 0, At, B0); PG8_MMA(1, 1, At, B1); PG8_BAR; PG8_SCHED; \
              \
            PG8_LDB(B0, 1, 0); PG8_LDB(B1, 1, 1); PG8_SCHED; PG8_LDA(At, 1, 0); PG8_STAGE_A(PG8_SA(0, 1), a2k1, w2, w3); \
            PG8_WAIT_V(8); PG8_WAIT_L(0); PG8_BAR; PG8_MMA(0, 0, At, B0); PG8_MMA(0, 1, At, B1); PG8_BAR; PG8_SCHED; \
              \
            PG8_LDA(At, 1, 1); PG8_STAGE_B(PG8_SB(1, 0), b3); PG8_STAGE_B(PG8_SB(1, 1), (b3) + hstep); PG8_STAGE_A(PG8_SA(1, 0), a3k0, w0, w1); \
            PG8_WAIT_V(8); PG8_WAIT_L(0); PG8_BAR; PG8_MMA(1, 0, At, B0); PG8_MMA(1, 1, At, B1); PG8_BAR; PG8_SCHED; } while (0)
        for (int t = 0; t < nt - 2; t += 2) {
            const unsigned k1 = (unsigned)(t + 1) * kstep, k2 = (unsigned)(t + 2) * kstep, b2 = cB + k2, b3 = b2 + kstep;
            PG8_TRIP(cA1 + k1, cA0 + k2, cA1 + k2, cA0 + k2 + kstep, b2, b3, vc0, vc1, vc2, vc3);
        }
        const bool has_next = S.next(ui + 1, nxt);
        unsigned nB;
        if (has_next) { if constexpr (Sched::GATHER) { vn0 = PG8_AVOFF(nxt, 0, 0); vn1 = PG8_AVOFF(nxt, 0, 1); vn2 = PG8_AVOFF(nxt, 1, 0); vn3 = PG8_AVOFF(nxt, 1, 1); } else { vn0 = vc0; vn1 = vc1; vn2 = vc0; vn3 = vc1; }
                        nA0 = S.a_soff(nxt, 0); nA1 = S.a_soff(nxt, 1); nB = (unsigned)S.b_off(nxt); }
        else { vn0 = vc0; vn1 = vc1; vn2 = vc2; vn3 = vc3; nA0 = cA0; nA1 = cA1; nB = cB; }
        { const unsigned k1 = (unsigned)(nt - 1) * kstep;
          PG8_TRIP(cA1 + k1, nA0, nA1, nA0 + kstep, nB, nB + kstep, vn0, vn1, vn2, vn3); }
#undef PG8_TRIP
        if constexpr (ALIGN_EPI) { if (wr == 0) PG8_BAR; }
        E(acc, cur, wr, wc, fr, fq);
        if (!has_next) break;
#pragma unroll
        for (int a = 0; a < 2; ++a)
#pragma unroll
            for (int b = 0; b < 2; ++b)
#pragma unroll
                for (int m = 0; m < 4; ++m)
#pragma unroll
                    for (int n = 0; n < 2; ++n) acc[a][b][m][n] = (f32x4){0.f, 0.f, 0.f, 0.f};
        cur = nxt; cB = nB; cA0 = nA0; cA1 = nA1; vc0 = vn0; vc1 = vn1; vc2 = vn2; vc3 = vn3; ++ui;
        if constexpr (ALIGN_EPI) { if (wr == 1) PG8_BAR; }
    }
    PG8_WAIT_V(0);
    if constexpr (!ALIGN_EPI) { if (wr == 0) PG8_BAR; }
    PG8_BAR;
#undef PG8_SA
#undef PG8_AVOFF
#undef PG8_SB
#undef PG8_STAGE_A
#undef PG8_STAGE_B
#undef PG8_LDA
#undef PG8_LDB
#undef PG8_MMA
#undef PG8_WAIT_V
#undef PG8_WAIT_L
#undef PG8_BAR
#undef PG8_SCHED
}

struct StaticOrder {
    int nM, nN, nwg, G, c, lda, dup;
    __device__ __forceinline__ void init(int M, int N, int lda_, int G_, int c_) { nM = M / BM; nN = N / BM; nwg = nM * nN; G = G_; c = c_; lda = lda_; dup = 0; }
    __device__ __forceinline__ bool next(int i, Unit& u) const {
        const long L = (long)(i >> dup) * G + c; if (L >= nwg) return false;
        int wgid = (int)L; { const int q = nwg / NXCD, r = nwg % NXCD, xcd = wgid % NXCD, off = wgid / NXCD; wgid = (xcd < r ? xcd * (q + 1) : r * (q + 1) + (xcd - r) * q) + off; }
        const int nig = WGM * nN, gid = wgid / nig, fm = gid * WGM, gsz = (nM - fm) < WGM ? (nM - fm) : WGM;
        u.pm = fm + ((wgid % nig) % gsz); u.pn = (wgid % nig) / gsz; u.e = 0; u.aux = 0; return true;
    }
    static constexpr bool GATHER = false;
    __device__ __forceinline__ unsigned a_voff(const Unit&, int R, int C) const { return (unsigned)((R & (HALF - 1)) * lda + C) * 2u; }
    __device__ __forceinline__ unsigned a_soff(const Unit& u, int h) const { return (unsigned)((u.pm * BM + h * HALF) * lda) * 2u; }
    __device__ __forceinline__ size_t b_off(const Unit& u) const { return (size_t)u.pn * BM * lda * 2; }
};
}

#define XB_TMO      128
#define XB_XCNT(j)  (256  + 64 * (j))
#define XB_XSUB(j)  (1280 + 64 * (j))
#define XB_XGEN(j)  (2304 + 64 * (j))
#define XB_TOP      3328
#define XB_TOPGEN   3392
#define XCD_BAR_WORDS 3456
#define XB_SPIN_CAP (1u << 18)

__device__ __forceinline__ unsigned xb_ld(unsigned* p)              { return __hip_atomic_load(p, __ATOMIC_RELAXED, __HIP_MEMORY_SCOPE_AGENT); }
__device__ __forceinline__ unsigned xb_add(unsigned* p, unsigned v) { return __hip_atomic_fetch_add(p, v, __ATOMIC_RELAXED, __HIP_MEMORY_SCOPE_AGENT); }
__device__ __forceinline__ unsigned xb_xcc_id() { return (unsigned)__builtin_amdgcn_s_getreg((3 << 11) | 20) & 0xFu; }
#define XB_SPIN(cond, bar) do { unsigned _sp = 0; while (cond) { __builtin_amdgcn_s_sleep(1); \
    if ((++_sp & 255u) == 0u) { if (xb_ld(&(bar)[XB_TMO])) break; if (_sp > XB_SPIN_CAP) { atomicAdd(&(bar)[XB_TMO], 1u); break; } } } } while (0)

struct XcdBarrier {
    unsigned* bar; unsigned x;
    volatile LAS unsigned* st;
};

__device__ __forceinline__ XcdBarrier xcd_barrier_post(unsigned* bar, volatile LAS unsigned* st) {
    XcdBarrier b; b.bar = bar; b.x = xb_xcc_id(); b.st = st;
    if (threadIdx.x == 0) (void)xb_add(&bar[XB_XCNT(b.x)], 1u);
    return b;
}
__device__ __forceinline__ void xcd_barrier_complete(unsigned* bar, unsigned x, unsigned& nloc, unsigned& nx) {
    const unsigned G = gridDim.x * gridDim.y * gridDim.z;
    unsigned sum, cnt, mine, sp = 0u;
    for (;;) {
        sum = 0u; cnt = 0u; mine = 0u;
#pragma unroll
        for (unsigned j = 0; j < 16; ++j) { const unsigned c = xb_ld(&bar[XB_XCNT(j)]); sum += c; cnt += (c > 0u) ? 1u : 0u; mine = (j == x) ? c : mine; }
        if (sum == G) break;
        __builtin_amdgcn_s_sleep(1);
        if ((++sp & 255u) == 0u) { if (xb_ld(&bar[XB_TMO])) break; if (sp > XB_SPIN_CAP) { atomicAdd(&bar[XB_TMO], 1u); break; } }
    }
    nloc = mine > 0u ? mine : 1u; nx = cnt > 0u ? cnt : 1u;
}

__device__ __forceinline__ void xcd_barrier(const XcdBarrier& b) {
    asm volatile("s_waitcnt vmcnt(0)" ::: "memory");
    __syncthreads();
    if (threadIdx.x == 0) {
        unsigned* bar = b.bar;
        __builtin_amdgcn_s_waitcnt(0);
        unsigned nloc = b.st[0], nx = b.st[1];
        if (nloc == 0u) { xcd_barrier_complete(bar, b.x, nloc, nx); b.st[0] = nloc; b.st[1] = nx; }
        const unsigned old = xb_add(&bar[XB_XSUB(b.x)], 1u);
        const unsigned gen = old / nloc;
        if (old + 1u == (gen + 1u) * nloc) {
            __builtin_amdgcn_fence(__ATOMIC_RELEASE, "agent");
            asm volatile("s_waitcnt vmcnt(0)" ::: "memory");
            const unsigned og = xb_add(&bar[XB_TOP], 1u);
            const unsigned tg = og / nx;
            if (og + 1u == (tg + 1u) * nx) xb_add(&bar[XB_TOPGEN], 1u);
            else XB_SPIN(xb_ld(&bar[XB_TOPGEN]) == tg, bar);
            __builtin_amdgcn_fence(__ATOMIC_ACQUIRE, "agent");
            xb_add(&bar[XB_XGEN(b.x)], 1u);
            asm volatile("s_waitcnt vmcnt(0)" ::: "memory");
        } else {
            XB_SPIN(xb_ld(&bar[XB_XGEN(b.x)]) == gen, bar);
            __builtin_amdgcn_fence(__ATOMIC_ACQUIRE, "agent");
            asm volatile("s_waitcnt vmcnt(0)" ::: "memory");
        }
    }
    __syncthreads();
}

struct Args { const float* in[23]; float* out; unsigned char* ws; int ph_lo, ph_hi, li, pad; };
#define CAS __attribute__((address_space(4)))
typedef const CAS Args& ArgsRef;
enum { I_X = 0, I_NORM1G, I_WIN, I_POOLW, I_POOLSC, I_CONVW, I_CONVB, I_WA, I_BA, I_WX, I_BX, I_LAM, I_QG, I_KG, I_OG, I_WOUT, I_NORM2G, I_WR, I_BR, I_WGU, I_BGU, I_WD, I_BD };

struct TrDesc { const float* W; int K, N; bf16* WT; const float* gk; int mode, item; };
__device__ __forceinline__ void tr_load(const TrDesc& d, float (&v)[32], int lane) {
    const int nblk = d.N / 32, kb = d.item / nblk, nb = d.item % nblk, k0 = 64 * kb, n0 = 32 * nb;
#pragma unroll
    for (int i = 0; i < 32; ++i) { const int kk = 2 * i + (lane >> 5); v[i] = d.W[(size_t)(k0 + kk) * d.N + n0 + (lane & 31)]; }
}
__device__ __forceinline__ void tr_finish(const TrDesc& d, float (&v)[32], LAS float* scr, int lane) {
    const int nblk = d.N / 32, kb = d.item / nblk, nb = d.item % nblk, k0 = 64 * kb, n0 = 32 * nb; const int K = d.K;
#pragma unroll
    for (int i = 0; i < 32; ++i) { const int kk = 2 * i + (lane >> 5); float x = v[i]; if (d.gk) x *= d.gk[k0 + kk]; scr[kk * 33 + (lane & 31)] = x; }
    LDS_WAIT(); asm volatile("" ::: "memory");
    const int c = lane & 7;
#pragma unroll
    for (int j = 0; j < 4; ++j) { const int n = (lane >> 3) + 8 * j; const LAS float* s = scr + (8 * c) * 33 + n;
        u32x4 o; o.x = cvt_pk_bf16(s[0 * 33], s[1 * 33]); o.y = cvt_pk_bf16(s[2 * 33], s[3 * 33]); o.z = cvt_pk_bf16(s[4 * 33], s[5 * 33]); o.w = cvt_pk_bf16(s[6 * 33], s[7 * 33]);
        int dn = n0 + n; const int mode = d.mode;
        if (mode == 1) { const int jj = dn & 255; dn = (jj >> 7) * 256 + (dn >> 8) * 128 + (jj & 127); }
        if (mode == 3 || (mode == 2 && (dn < C_Q || dn >= C_V))) {
            const int L = dn & 255; dn = (dn & ~255) + 128 * ((L >> 3) & 1) + 32 * (L >> 6) + 8 * ((L >> 4) & 3) + (L & 7); }
        else if (mode == 2) {
            const int rem = (dn - C_Q) & 511, sec = (dn - C_Q) >> 9, head = rem >> 6, d2 = rem & 63;
            dn = C_Q + sec * 512 + (head >> 2) * 256 + (d2 >> 5) * 128 + (head & 3) * 32 + (d2 & 31); }
        *(u32x4*)(d.WT + (size_t)dn * K + k0 + 8 * c) = o; }
    LDS_WAIT(); asm volatile("" ::: "memory");
}
__device__ __forceinline__ void cvt_row(const float* xrow, bf16* orow, float* ssq, int lane) {
    const f32x4* xr = (const f32x4*)xrow + lane;
    f32x4 v[4]; float s = 0.f;
#pragma unroll
    for (int j = 0; j < 4; ++j) { v[j] = xr[64 * j]; s += (v[j].x * v[j].x + v[j].y * v[j].y) + (v[j].z * v[j].z + v[j].w * v[j].w); }
    s = wave_sum(s);
    u32x2* o8 = (u32x2*)orow + lane;
#pragma unroll
    for (int j = 0; j < 4; ++j) { u32x2 w; w.x = cvt_pk_bf16(v[j].x, v[j].y); w.y = cvt_pk_bf16(v[j].z, v[j].w); o8[64 * j] = w; }
    if (lane == 0) *ssq = s;
}
__device__ __forceinline__ TrDesc tr_desc(ArgsRef a, int it) {
    unsigned char* ws = a.ws;
    constexpr int I_IN = 16 * 72, I_OUT = 16 * 32, I_R = 16, I_GU = 16 * 16, I_D = 4 * 32, I_S = 2;
    constexpr int PER_LAYER = I_IN + I_OUT + I_R + NEXP * I_GU + NEXP * I_D + 12 * I_S;
    const int l = it / PER_LAYER; int r = it % PER_LAYER; TrDesc d;
    if (r < I_IN) { d = TrDesc{a.in[I_WIN] + (size_t)l * DM * NIN, DM, NIN, (bf16*)(ws + WS_WIN) + (size_t)l * NIN * DM, a.in[I_NORM1G] + l * DM, 2, r}; return d; } r -= I_IN;
    if (r < I_OUT) { d = TrDesc{a.in[I_WOUT] + (size_t)l * DM * DM, DM, DM, (bf16*)(ws + WS_WOUT) + (size_t)l * DM * DM, a.in[I_OG] + l * DM, 3, r}; return d; } r -= I_OUT;
    if (r < I_R) { d = TrDesc{a.in[I_WR] + (size_t)l * DM * NEXP, DM, NEXP, (bf16*)(ws + WS_SMALL) + SM_WR + (size_t)l * NEXP * DM, a.in[I_NORM2G] + l * DM, 0, r}; return d; } r -= I_R;
    if (r < NEXP * I_GU) { const int e = r / I_GU; d = TrDesc{a.in[I_WGU] + (size_t)(l * NEXP + e) * DM * 512, DM, 512, (bf16*)(ws + WS_WGU) + (size_t)(l * NEXP + e) * 512 * DM, a.in[I_NORM2G] + l * DM, 1, r % I_GU}; return d; } r -= NEXP * I_GU;
    if (r < NEXP * I_D) { const int e = r / I_D; d = TrDesc{a.in[I_WD] + (size_t)(l * NEXP + e) * EFF * DM, EFF, DM, (bf16*)(ws + WS_WD) + (size_t)(l * NEXP + e) * DM * EFF, nullptr, 3, r % I_D}; return d; } r -= NEXP * I_D;
    { const int which = r / (4 * I_S), g = (r / I_S) % 4, sub = r % I_S;
      const float* src = a.in[which == 0 ? I_POOLW : (which == 1 ? I_WA : I_WX)] + (size_t)(l * 4 + g) * 4096;
      bf16* dst = (bf16*)(ws + WS_SMALL) + (which == 0 ? SM_POOLW : (which == 1 ? SM_WA : SM_WX)) + (size_t)(l * 4 + g) * 4096;
      d = TrDesc{src, 64, 64, dst, nullptr, 0, sub}; return d; }
}
__device__ __forceinline__ void phase_prologue(ArgsRef a, LAS unsigned char* lds, int wv) {
    const int tid = tid_from(wv), lane = tid & 63, wave = tid >> 6;
    LAS float* scr = (LAS float*)(lds + wave * 16384);
    const int gw = blockIdx.x * NWAVES + wave, NGW = gridDim.x * NWAVES;
    unsigned char* ws = a.ws;
    constexpr int PER_LAYER = 16 * 72 + 16 * 32 + 16 + NEXP * 16 * 16 + NEXP * 4 * 32 + 12 * 2;
    { int it = gw; float cur[32], nxt[32];
      TrDesc dc = tr_desc(a, it < 2 * PER_LAYER ? it : 0), dn = dc;
      if (it < 2 * PER_LAYER) tr_load(dc, cur, lane);
      while (it < 2 * PER_LAYER) { const int itn = it + NGW;
          if (itn < 2 * PER_LAYER) { dn = tr_desc(a, itn); tr_load(dn, nxt, lane); }
          tr_finish(dc, cur, scr, lane);
#pragma unroll
          for (int i = 0; i < 32; ++i) cur[i] = nxt[i];
          dc = dn; it = itn; } }
    { float* ct = (float*)(ws + WS_ROPE); float* st = ct + SEQ * 32;
      for (int idx = blockIdx.x * NTHR + tid; idx < SEQ * 32; idx += gridDim.x * NTHR) {
          const int pos = idx >> 5, i = idx & 31;
          const float inv = __builtin_amdgcn_exp2f(-(float)i * 0.41524101186092029f);
          const float ang = (float)pos * inv;
          const double rev = (double)ang * 0.15915494309189535; const double fr = rev - __builtin_rint(rev);
          const float f = (float)fr;
          ct[idx] = __builtin_amdgcn_cosf(f); st[idx] = __builtin_amdgcn_sinf(f); } }
    { const float* __restrict__ X = a.in[I_X]; bf16* __restrict__ xb = (bf16*)(ws + WS_XB); float* __restrict__ ssq = (float*)(ws + WS_SSQ);
      for (int m0 = gw * 4; m0 < NT; m0 += NGW * 4) { f32x4 v[4][4];
#pragma unroll
          for (int u = 0; u < 4; ++u)
#pragma unroll
              for (int j = 0; j < 4; ++j) v[u][j] = *((const f32x4*)(X + (size_t)(m0 + u) * DM) + lane + 64 * j);
#pragma unroll
          for (int u = 0; u < 4; ++u) { float s = 0.f;
#pragma unroll
              for (int j = 0; j < 4; ++j) s += (v[u][j].x * v[u][j].x + v[u][j].y * v[u][j].y) + (v[u][j].z * v[u][j].z + v[u][j].w * v[u][j].w);
              s = wave_sum(s);
#pragma unroll
              for (int j = 0; j < 4; ++j) { u32x2 w; w.x = cvt_pk_bf16(v[u][j].x, v[u][j].y); w.y = cvt_pk_bf16(v[u][j].z, v[u][j].w); *((u32x2*)(xb + (size_t)(m0 + u) * DM) + lane + 64 * j) = w; }
              if (lane == 0) ssq[m0 + u] = s; } } }
}

struct EpiIn {
    static constexpr bool PERM = true;
    bf16* O; const float* ssq; const float* qg; const float* kg; const float* ct; const float* st;
    __device__ __forceinline__ void operator()(const f32x4 (&acc)[2][2][4][2], const pg8::Unit& u, int wr, int wc, int fr, int fq) const {
        const int row0 = u.pm * 256 + wr * 64 + fr, col0 = u.pn * 256 + wc * 32 + 8 * fq;
        if (u.pn >= 3 && u.pn < 7) {
            const bool isq = u.pn < 5; const float* gp = (isq ? qg : kg) + 8 * fq; const float gs = isq ? (0.125f * 1.4426950408889634f) : 1.0f;
            f32x4 g[2][2];
#pragma unroll
            for (int bj = 0; bj < 2; ++bj)
#pragma unroll
                for (int n = 0; n < 2; ++n) g[bj][n] = *(const f32x4*)(gp + 32 * bj + 4 * n) * gs;
#pragma unroll
            for (int ai = 0; ai < 2; ++ai)
#pragma unroll
                for (int m = 0; m < 4; ++m) { const int row = row0 + ai * 128 + m * 16; const float rs = __builtin_amdgcn_rsqf(ssq[row] * (1.0f / DM) + EPS);
                    const int pos = row & (SEQ - 1);
                    const f32x4 c0 = *(const f32x4*)(ct + pos * 32 + 8 * fq), c1 = *(const f32x4*)(ct + pos * 32 + 8 * fq + 4), s0 = *(const f32x4*)(st + pos * 32 + 8 * fq), s1 = *(const f32x4*)(st + pos * 32 + 8 * fq + 4);
                    f32x4 v[2][2]; float ss = 0.f;
#pragma unroll
                    for (int bj = 0; bj < 2; ++bj)
#pragma unroll
                        for (int n = 0; n < 2; ++n) { v[bj][n] = acc[ai][bj][m][n] * rs; ss += (v[bj][n][0] * v[bj][n][0] + v[bj][n][1] * v[bj][n][1]) + (v[bj][n][2] * v[bj][n][2] + v[bj][n][3] * v[bj][n][3]); }
                    ss += __shfl_xor(ss, 16); ss += __shfl_xor(ss, 32);
                    const float rr = __builtin_amdgcn_rsqf(ss * (1.0f / 64.0f) + EPS);
#pragma unroll
                    for (int bj = 0; bj < 2; ++bj)
#pragma unroll
                        for (int n = 0; n < 2; ++n) v[bj][n] = v[bj][n] * rr * g[bj][n];
                    const f32x4 o00 = v[0][0] * c0 - v[1][0] * s0, o01 = v[0][1] * c1 - v[1][1] * s1, o10 = v[1][0] * c0 + v[0][0] * s0, o11 = v[1][1] * c1 + v[0][1] * s1;
                    bf16* rowp = O + (size_t)row * NIN + col0;
                    u32x4 w; w.x = cvt_pk_bf16(o00[0], o00[1]); w.y = cvt_pk_bf16(o00[2], o00[3]); w.z = cvt_pk_bf16(o01[0], o01[1]); w.w = cvt_pk_bf16(o01[2], o01[3]);
                    *(u32x4*)(rowp) = w;
                    w.x = cvt_pk_bf16(o10[0], o10[1]); w.y = cvt_pk_bf16(o10[2], o10[3]); w.z = cvt_pk_bf16(o11[0], o11[1]); w.w = cvt_pk_bf16(o11[2], o11[3]);
                    *(u32x4*)(rowp + 128) = w; }
            return;
        }
#pragma unroll
        for (int ai = 0; ai < 2; ++ai)
#pragma unroll
            for (int m = 0; m < 4; ++m) { const int row = row0 + ai * 128 + m * 16; const float rs = __builtin_amdgcn_rsqf(ssq[row] * (1.0f / DM) + EPS);
                bf16* rowp = O + (size_t)row * NIN + u.pn * 256 + wc * 64 + fq * 16;
#pragma unroll
                for (int bj = 0; bj < 2; ++bj) { const f32x4 v0 = acc[ai][bj][m][0] * rs, v1 = acc[ai][bj][m][1] * rs;
                    u32x4 w; w.x = cvt_pk_bf16(v0[0], v0[1]); w.y = cvt_pk_bf16(v0[2], v0[3]); w.z = cvt_pk_bf16(v1[0], v1[1]); w.w = cvt_pk_bf16(v1[2], v1[3]);
                    *(u32x4*)(rowp + bj * 8) = w; } }
    }
};
struct EpiOut {
    static constexpr bool PERM = true;
    bf16* xb; float* ssqp;
    __device__ __forceinline__ void operator()(const f32x4 (&acc)[2][2][4][2], const pg8::Unit& u, int wr, int wc, int fr, int fq) const {
        const int row0 = u.pm * 256 + wr * 64 + fr, col0 = u.pn * 256 + wc * 64 + fq * 16;
#pragma unroll
        for (int am = 0; am < 4; ++am) { u32x4 xi[2][2];
#pragma unroll
            for (int mm = 0; mm < 2; ++mm) { const int ai = am >> 1, m = (am & 1) * 2 + mm; const size_t off = (size_t)(row0 + ai * 128 + m * 16) * DM + col0; xi[mm][0] = *(const u32x4*)(xb + off); xi[mm][1] = *(const u32x4*)(xb + off + 8); }
            asm volatile("" ::: "memory");
#pragma unroll
            for (int mm = 0; mm < 2; ++mm) { const int ai = am >> 1, m = (am & 1) * 2 + mm; const int row = row0 + ai * 128 + m * 16; const size_t off = (size_t)row * DM + col0; float s = 0.f;
#pragma unroll
                for (int bj = 0; bj < 2; ++bj) { const u32x4 x = xi[mm][bj];
                    const f32x4 o0 = (f32x4){bflo(x.x), bfhi(x.x), bflo(x.y), bfhi(x.y)} + acc[ai][bj][m][0], o1 = (f32x4){bflo(x.z), bfhi(x.z), bflo(x.w), bfhi(x.w)} + acc[ai][bj][m][1];
                    s += ((o0[0] * o0[0] + o0[1] * o0[1]) + (o0[2] * o0[2] + o0[3] * o0[3])) + ((o1[0] * o1[0] + o1[1] * o1[1]) + (o1[2] * o1[2] + o1[3] * o1[3]));
                    u32x4 w; w.x = cvt_pk_bf16(o0[0], o0[1]); w.y = cvt_pk_bf16(o0[2], o0[3]); w.z = cvt_pk_bf16(o1[0], o1[1]); w.w = cvt_pk_bf16(o1[2], o1[3]);
                    *(u32x4*)(xb + off + bj * 8) = w; }
                s += __shfl_xor(s, 16); s += __shfl_xor(s, 32);
                if (fq == 0) ssqp[(size_t)row * 16 + u.pn * 4 + wc] = s; }
            asm volatile("" ::: "memory"); }
    }
};

template <int MODE> struct MoeOrder {
    static constexpr bool GATHER = (MODE == 0);
    const LAS int* tab; int npn, G, c; const int* list; int dup;
    __device__ __forceinline__ bool next(int i, pg8::Unit& u) const {
        const int ii = i >> dup; const int total = __builtin_amdgcn_readfirstlane(tab[64]); const int nfr = total / G, nfu = nfr * npn;
        int gb;
        if (ii < nfu) { gb = (ii / npn) * G + c; u.pn = ii % npn; }
        else { const int L = (ii - nfu) * G + c; gb = nfr * G + L / npn; u.pn = L % npn; if (gb >= total) return false; }
        const int e = __builtin_amdgcn_readfirstlane((int)((const LAS unsigned char*)(tab + 80))[gb]);
        u.e = e; u.pm = gb; u.aux = gb - __builtin_amdgcn_readfirstlane(tab[32 + e]); return true;
    }
    __device__ __forceinline__ unsigned a_voff(const pg8::Unit& u, int R, int C) const {
        if constexpr (MODE == 0) { const int pos = u.aux * 256 + R; const int ne = tab[u.e]; int tok = 0; if (pos < ne) tok = list[u.e * NT + pos] >> 2; return (unsigned)(tok * DM + C) * 2u; }
        else return (unsigned)((R & 127) * EFF + C) * 2u;
    }
    __device__ __forceinline__ unsigned a_soff(const pg8::Unit& u, int h) const { if constexpr (MODE == 0) return 0u; else return (unsigned)((u.pm * 256 + h * 128) * EFF) * 2u; }
    __device__ __forceinline__ size_t b_off(const pg8::Unit& u) const {
        if constexpr (MODE == 0) return ((size_t)u.e * 512 + (size_t)u.pn * 256) * DM * 2;
        else return ((size_t)u.e * DM + (size_t)u.pn * 256) * EFF * 2;
    }
};
struct EpiGU {
    static constexpr bool PERM = true;
    bf16* act; const float* lrstd; const float* bgu;
    __device__ __forceinline__ void operator()(const f32x4 (&acc)[2][2][4][2], const pg8::Unit& u, int wr, int wc, int fr, int fq) const {
        const int r0 = wr * 64 + fr, cl0 = wc * 32 + 8 * fq;
        const float* bg = bgu + u.e * 512 + u.pn * 128 + cl0;
        const f32x4 bg0 = *(const f32x4*)(bg), bg1 = *(const f32x4*)(bg + 4), bu0 = *(const f32x4*)(bg + 256), bu1 = *(const f32x4*)(bg + 260);
#pragma unroll
        for (int ai = 0; ai < 2; ++ai)
#pragma unroll
            for (int m = 0; m < 4; ++m) { const int r = r0 + ai * 128 + m * 16; const float rs = lrstd[(size_t)u.e * NT + u.aux * 256 + r];
                f32x4 g0 = acc[ai][0][m][0] * rs + bg0, g1 = acc[ai][0][m][1] * rs + bg1, u0 = acc[ai][1][m][0] * rs + bu0, u1 = acc[ai][1][m][1] * rs + bu1;
                float o[8];
#pragma unroll
                for (int j = 0; j < 4; ++j) { const float ga = fminf(g0[j], 7.0f), ua = fminf(fmaxf(u0[j], -7.0f), 7.0f); o[j] = (ua + 1.0f) * ga * fast_sigmoid(1.702f * ga);
                                              const float gb = fminf(g1[j], 7.0f), ub = fminf(fmaxf(u1[j], -7.0f), 7.0f); o[4 + j] = (ub + 1.0f) * gb * fast_sigmoid(1.702f * gb); }
                u32x4 w; w.x = cvt_pk_bf16(o[0], o[1]); w.y = cvt_pk_bf16(o[2], o[3]); w.z = cvt_pk_bf16(o[4], o[5]); w.w = cvt_pk_bf16(o[6], o[7]);
                *(u32x4*)(act + (size_t)(u.pm * 256 + r) * EFF + u.pn * 128 + cl0) = w; }
    }
};
constexpr float Y8_SCALE = 32.0f;
struct EpiDown {
    static constexpr bool PERM = true;
    unsigned char* y; const int* list; const float* lgate; const float* bd; const LAS int* tab;
    __device__ __forceinline__ void operator()(const f32x4 (&acc)[2][2][4][2], const pg8::Unit& u, int wr, int wc, int fr, int fq) const {
        const int r0 = wr * 64 + fr, col0 = u.pn * 256 + wc * 64 + fq * 16; const int ne = tab[u.e];
        const float* bp = bd + u.e * DM + col0;
#pragma unroll
        for (int ai = 0; ai < 2; ++ai) { int asg[4]; float gt[4];
#pragma unroll
            for (int m = 0; m < 4; ++m) { const int pos = u.aux * 256 + r0 + ai * 128 + m * 16; const bool ok = pos < ne;
                asg[m] = ok ? list[(size_t)u.e * NT + pos] : -1; gt[m] = ok ? lgate[(size_t)u.e * NT + pos] * Y8_SCALE : 0.f; }
            asm volatile("" ::: "memory");
#pragma unroll
            for (int m = 0; m < 4; ++m) {
                if (asg[m] >= 0) { unsigned char* rowp = y + (size_t)asg[m] * DM + col0; const float g = gt[m]; u32x4 wv4;
#pragma unroll
                    for (int bj = 0; bj < 2; ++bj) { const f32x4 b0 = *(const f32x4*)(bp + bj * 8), b1 = *(const f32x4*)(bp + bj * 8 + 4);
                        const f32x4 v0 = (acc[ai][bj][m][0] + b0) * g, v1 = (acc[ai][bj][m][1] + b1) * g;
                        int w0 = __builtin_amdgcn_cvt_pk_fp8_f32(v0[0], v0[1], 0, false); w0 = __builtin_amdgcn_cvt_pk_fp8_f32(v0[2], v0[3], w0, true);
                        int w1 = __builtin_amdgcn_cvt_pk_fp8_f32(v1[0], v1[1], 0, false); w1 = __builtin_amdgcn_cvt_pk_fp8_f32(v1[2], v1[3], w1, true);
                        if (bj == 0) { wv4.x = (unsigned)w0; wv4.y = (unsigned)w1; } else { wv4.z = (unsigned)w0; wv4.w = (unsigned)w1; } }
                    *(u32x4*)rowp = wv4; }
                asm volatile("" ::: "memory"); } }
    }
};
__device__ __forceinline__ void moe_tables(LAS int* tab, const unsigned* cnt, int wv) {
    __syncthreads();
    const int tid_ = tid_from(wv);
    if (tid_ == 0) { int pre = 0;
        for (int e = 0; e < NEXP; ++e) { const int n = (int)__hip_atomic_load(cnt + e, RLX_AGENT); tab[e] = n; tab[32 + e] = pre; pre += (n + 255) >> 8; }
        tab[64] = pre; }
    __syncthreads();
    { LAS unsigned char* eb = (LAS unsigned char*)(tab + 80); const int total = tab[64];
      for (int gb = tid_; gb < total; gb += NTHR) { int e = 0;
          for (int k = 1; k < NEXP; ++k) { if (tab[32 + k] <= gb) e = k; }
          eb[gb] = (unsigned char)e; } }
    __syncthreads();
}

__device__ __forceinline__ void phase_qkprep(ArgsRef a, int layer, int wv, bool dry) {
    const int tid = tid_from(wv), lane = tid & 63, wave = tid >> 6;
    const int gw = blockIdx.x * NWAVES + wave, NGW = gridDim.x * NWAVES;
    bf16* proj = (bf16*)(a.ws + WS_PROJ);
    const float* __restrict__ ct = (const float*)(a.ws + WS_ROPE); const float* __restrict__ st = ct + SEQ * 32;
    const int d0 = (lane & 7) * 8, p0 = d0 & 31;
    float gq[8], gk[8];
#pragma unroll
    for (int j = 0; j < 8; ++j) { gq[j] = a.in[I_QG][layer * 64 + d0 + j] * (0.125f * 1.4426950408889634f); gk[j] = a.in[I_KG][layer * 64 + d0 + j]; }
    const bool second = (lane & 4) != 0;
    constexpr int TB = 4;
    for (int t0 = gw * TB; t0 < NT; t0 += NGW * TB) {
        u32x4 w[TB][2]; f32x4 cs[TB][4];
#pragma unroll
        for (int u = 0; u < TB; ++u) { const int t = t0 + u, pos = t & (SEQ - 1);
            w[u][0] = *(const u32x4*)(proj + (size_t)t * NIN + C_Q + lane * 8); w[u][1] = *(const u32x4*)(proj + (size_t)t * NIN + C_Q + 512 + lane * 8);
            cs[u][0] = *(const f32x4*)(ct + pos * 32 + p0); cs[u][1] = *(const f32x4*)(ct + pos * 32 + p0 + 4); cs[u][2] = *(const f32x4*)(st + pos * 32 + p0); cs[u][3] = *(const f32x4*)(st + pos * 32 + p0 + 4); }
#pragma unroll
        for (int u = 0; u < TB; ++u) { const int t = t0 + u;
            float c[8], s[8];
#pragma unroll
            for (int j = 0; j < 4; ++j) { c[j] = cs[u][0][j]; c[4 + j] = cs[u][1][j]; s[j] = cs[u][2][j]; s[4 + j] = cs[u][3][j]; }
#pragma unroll
            for (int i = 0; i < 2; ++i) {
                const u32x4 ww = w[u][i];
                float x[8]; x[0] = bflo(ww.x); x[1] = bfhi(ww.x); x[2] = bflo(ww.y); x[3] = bfhi(ww.y); x[4] = bflo(ww.z); x[5] = bfhi(ww.z); x[6] = bflo(ww.w); x[7] = bfhi(ww.w);
                float ss = 0.f;
#pragma unroll
                for (int j = 0; j < 8; ++j) ss += x[j] * x[j];
                ss += __shfl_xor(ss, 1); ss += __shfl_xor(ss, 2); ss += __shfl_xor(ss, 4);
                const float rs = __builtin_amdgcn_rsqf(ss * (1.0f / 64.0f) + EPS);
                float o[8];
#pragma unroll
                for (int j = 0; j < 8; ++j) { const float yv = x[j] * rs * (i == 0 ? gq[j] : gk[j]); const float pv = __shfl_xor(yv, 4);
                    o[j] = second ? (yv * c[j] + pv * s[j]) : (yv * c[j] - pv * s[j]); }
                u32x4 r; r.x = cvt_pk_bf16(o[0], o[1]); r.y = cvt_pk_bf16(o[2], o[3]); r.z = cvt_pk_bf16(o[4], o[5]); r.w = cvt_pk_bf16(o[6], o[7]);
                if (!dry || o[0] == 12345.678f) *(u32x4*)(proj + (size_t)t * NIN + C_Q + i * 512 + lane * 8) = r;
            } }
    }
}

__device__ __forceinline__ void phase_pool(ArgsRef a, LAS unsigned char* lds, int layer, int wv) {
    const int tid = tid_from(wv), lane = tid & 63, wave = __builtin_amdgcn_readfirstlane(tid >> 6);
    const bf16* proj = (const bf16*)(a.ws + WS_PROJ); bf16* YP = (bf16*)(a.ws + WS_YP); float* SSQPOOL = (float*)(a.ws + WS_SSQPOOL);
    const int g = wave & 3, w = 2 << g, lr = lane & 15, lq = lane >> 4;
    constexpr int US = 72;
    LAS bf16* Uw = (LAS bf16*)(lds + wave * 11520);
    LAS bf16* Xw = (LAS bf16*)(lds + wave * 11520 + 6784);
    const bf16* pw = (const bf16*)(a.ws + WS_SMALL) + SM_POOLW + (size_t)(layer * 4 + g) * 4096;
    bf16x8 bw[4][2]; float psc[4];
#pragma unroll
    for (int et = 0; et < 4; ++et) {
#pragma unroll
        for (int ks = 0; ks < 2; ++ks) bw[et][ks] = *(const bf16x8*)(pw + (et * 16 + lr) * 64 + ks * 32 + lq * 8);
        psc[et] = a.in[I_POOLSC][layer * 256 + g * 64 + et * 16 + lr]; }
    __syncthreads();
    const int nstreams = gridDim.x * 2;
    for (int tk = blockIdx.x * 2 + (wave >> 2); tk < NT / 32; tk += nstreams) {
        const int t0 = tk * 32, s0 = t0 & (SEQ - 1);
#pragma unroll
        for (int j = 0; j < 6; ++j) { const int id = lane + 64 * j;
            if (id < 47 * 8) { const int row = id >> 3, c8 = (id & 7) * 8; u32x4 v = {0u, 0u, 0u, 0u};
                if (s0 - 15 + row >= 0) v = *(const u32x4*)(proj + (size_t)(t0 - 15 + row) * NIN + C_POOL + g * 64 + c8);
                *(LAS u32x4*)(Uw + row * US + c8) = v; } }
        LDS_WAIT(); asm volatile("" ::: "memory");
        { float sum = 0.f;
          for (int j = 1; j < w; ++j) sum += bf2f(Uw[(15 - j) * US + lane]);
#pragma unroll 8
          for (int tl = 0; tl < 32; ++tl) { const float cur = bf2f(Uw[(15 + tl) * US + lane]); sum += cur;
              const int cnt = min(w, s0 + tl + 1); const float pooled = sum * __builtin_amdgcn_rcpf((float)cnt) - cur;
              Xw[tl * US + lane] = f2bf(pooled); sum -= bf2f(Uw[(15 + tl - w + 1) * US + lane]); } }
        LDS_WAIT(); asm volatile("" ::: "memory");
        f32x4 acc[2][4];
#pragma unroll
        for (int rt = 0; rt < 2; ++rt) { const bf16x8 a0 = *(const LAS bf16x8*)(Xw + (rt * 16 + lr) * US + lq * 8), a1 = *(const LAS bf16x8*)(Xw + (rt * 16 + lr) * US + 32 + lq * 8);
#pragma unroll
            for (int et = 0; et < 4; ++et) { acc[rt][et] = __builtin_amdgcn_mfma_f32_16x16x32_bf16(a0, bw[et][0], (f32x4){0.f, 0.f, 0.f, 0.f}, 0, 0, 0); acc[rt][et] = __builtin_amdgcn_mfma_f32_16x16x32_bf16(a1, bw[et][1], acc[rt][et], 0, 0, 0); } }
#pragma unroll
        for (int rt = 0; rt < 2; ++rt)
#pragma unroll
            for (int reg = 0; reg < 4; ++reg) { const int tl = rt * 16 + lq * 4 + reg; float s = 0.f;
#pragma unroll
                for (int et = 0; et < 4; ++et) { const float y = acc[rt][et][reg] * psc[et]; s += y * y; Uw[tl * 64 + et * 16 + lr] = f2bf(y); }
                s += __shfl_xor(s, 1); s += __shfl_xor(s, 2); s += __shfl_xor(s, 4); s += __shfl_xor(s, 8);
                if (lr == 0) SSQPOOL[(size_t)(t0 + tl) * 4 + g] = s; }
        LDS_WAIT(); asm volatile("" ::: "memory");
#pragma unroll
        for (int j = 0; j < 4; ++j) { const int id = lane + 64 * j, row = id >> 3, c8 = (id & 7) * 8;
            *(u32x4*)(YP + (size_t)(t0 + row) * 256 + g * 64 + c8) = *(const LAS u32x4*)(Uw + row * 64 + c8); }
        LDS_WAIT(); asm volatile("" ::: "memory");
    }
}

__device__ __forceinline__ void phase_lru_a(ArgsRef a, LAS unsigned char* lds, int layer, int wv) {
    const int tid = tid_from(wv), lane = tid & 63, wave = __builtin_amdgcn_readfirstlane(tid >> 6);
    const bf16* proj = (const bf16*)(a.ws + WS_PROJ);
    bf16* HL = (bf16*)(a.ws + WS_HL); bf16* PL = (bf16*)(a.ws + WS_PL);
    float* AGGH = (float*)(a.ws + WS_AGGH); float* AGGP = (float*)(a.ws + WS_AGGP);
    const int n = wave & 3, lr = lane & 15, lq = lane >> 4;
    constexpr int US = 72;
    LAS bf16* Uw = (LAS bf16*)(lds + wave * 13824);
    LAS bf16* Xw = (LAS bf16*)(lds + wave * 13824 + 5120);
    LAS bf16* Pw = (LAS bf16*)(lds + wave * 13824 + 9728);
    const int chl = n * 64 + lane;
    const float cw0 = a.in[I_CONVW][(layer * 4 + 0) * 256 + chl], cw1 = a.in[I_CONVW][(layer * 4 + 1) * 256 + chl], cw2 = a.in[I_CONVW][(layer * 4 + 2) * 256 + chl], cw3 = a.in[I_CONVW][(layer * 4 + 3) * 256 + chl];
    const float cb = a.in[I_CONVB][layer * 256 + chl];
    const bf16* wa = (const bf16*)(a.ws + WS_SMALL) + SM_WA + (size_t)(layer * 4 + n) * 4096;
    const bf16* wx = (const bf16*)(a.ws + WS_SMALL) + SM_WX + (size_t)(layer * 4 + n) * 4096;
    bf16x8 ba[4][2], bx[4][2]; float bav[4], bxv[4], sp[4];
#pragma unroll
    for (int et = 0; et < 4; ++et) {
#pragma unroll
        for (int ks = 0; ks < 2; ++ks) { const int wo = (et * 16 + lr) * 64 + ks * 32 + lq * 8; ba[et][ks] = *(const bf16x8*)(wa + wo); bx[et][ks] = *(const bf16x8*)(wx + wo); }
        const int chn = layer * 256 + n * 64 + et * 16 + lr; bav[et] = a.in[I_BA][chn]; bxv[et] = a.in[I_BX][chn]; sp[et] = log1pf(expf(-a.in[I_LAM][chn])); }
    __syncthreads();
    const int nstreams = gridDim.x * 2;
    for (int ck = blockIdx.x * 2 + (wave >> 2); ck < NT / LRU_CH; ck += nstreams) {
        const int t0 = ck * LRU_CH, s0 = t0 & (SEQ - 1);
#pragma unroll
        for (int j = 0; j < 5; ++j) { const int id = lane + 64 * j;
            if (id < 35 * 8) { const int row = id >> 3, c8 = (id & 7) * 8; u32x4 w = {0u, 0u, 0u, 0u};
                if (s0 - 3 + row >= 0) w = *(const u32x4*)(proj + (size_t)(t0 - 3 + row) * NIN + C_LRU + n * 64 + c8);
                *(LAS u32x4*)(Uw + row * US + c8) = w; } }
        LDS_WAIT(); asm volatile("" ::: "memory");
        { float u0 = bf2f(Uw[0 * US + lane]), u1 = bf2f(Uw[1 * US + lane]), u2 = bf2f(Uw[2 * US + lane]);
#pragma unroll 8
          for (int tl = 0; tl < LRU_CH; ++tl) { const float u3 = bf2f(Uw[(tl + 3) * US + lane]); const float xc = cb + cw0 * u0 + cw1 * u1 + cw2 * u2 + cw3 * u3;
              Xw[tl * US + lane] = f2bf(xc); u0 = u1; u1 = u2; u2 = u3; } }
        LDS_WAIT(); asm volatile("" ::: "memory");
        f32x4 ca[2][4], cx[2][4];
#pragma unroll
        for (int rt = 0; rt < 2; ++rt) { const bf16x8 a0 = *(const LAS bf16x8*)(Xw + (rt * 16 + lr) * US + lq * 8), a1 = *(const LAS bf16x8*)(Xw + (rt * 16 + lr) * US + 32 + lq * 8);
#pragma unroll
            for (int et = 0; et < 4; ++et) { ca[rt][et] = __builtin_amdgcn_mfma_f32_16x16x32_bf16(a0, ba[et][0], (f32x4){0.f, 0.f, 0.f, 0.f}, 0, 0, 0); ca[rt][et] = __builtin_amdgcn_mfma_f32_16x16x32_bf16(a1, ba[et][1], ca[rt][et], 0, 0, 0);
                                              cx[rt][et] = __builtin_amdgcn_mfma_f32_16x16x32_bf16(a0, bx[et][0], (f32x4){0.f, 0.f, 0.f, 0.f}, 0, 0, 0); cx[rt][et] = __builtin_amdgcn_mfma_f32_16x16x32_bf16(a1, bx[et][1], cx[rt][et], 0, 0, 0); } }
#pragma unroll
        for (int et = 0; et < 4; ++et) {
            float Pl[2][4], Hl[2][4], At[2], Ht[2];
#pragma unroll
            for (int rt = 0; rt < 2; ++rt) { float P = 1.f, H = 0.f;
#pragma unroll
                for (int reg = 0; reg < 4; ++reg) { const int tl = rt * 16 + lq * 4 + reg;
                    const float r = fast_sigmoid(ca[rt][et][reg] + bav[et]), ig = fast_sigmoid(cx[rt][et][reg] + bxv[et]);
                    const float log_a = -8.0f * r * sp[et]; const float av = fast_exp(log_a);
                    float mult = sqrtf(fmaxf(1.0f - fast_exp(2.0f * log_a), 0.f)); if (s0 + tl == 0) mult = 1.0f;
                    const float bv = mult * ig * bf2f(Xw[tl * US + et * 16 + lr]);
                    H = av * H + bv; P *= av; Pl[rt][reg] = P; Hl[rt][reg] = H; }
                At[rt] = P; Ht[rt] = H; }
            float Ai[2], Hi[2];
#pragma unroll
            for (int rt = 0; rt < 2; ++rt) { float A = At[rt], H = Ht[rt];
                { const float Ap = __shfl_up(A, 16), Hp = __shfl_up(H, 16); if (lq >= 1) { H = A * Hp + H; A = A * Ap; } }
                { const float Ap = __shfl_up(A, 32), Hp = __shfl_up(H, 32); if (lq >= 2) { H = A * Hp + H; A = A * Ap; } }
                Ai[rt] = A; Hi[rt] = H; }
            float Ac[2], Hc[2];
#pragma unroll
            for (int rt = 0; rt < 2; ++rt) { const float Ap = __shfl_up(Ai[rt], 16), Hp = __shfl_up(Hi[rt], 16); Ac[rt] = (lq >= 1) ? Ap : 1.f; Hc[rt] = (lq >= 1) ? Hp : 0.f; }
            const float A0t = __shfl(Ai[0], 48 + lr), H0t = __shfl(Hi[0], 48 + lr);
            Hc[1] = Ac[1] * H0t + Hc[1]; Ac[1] = Ac[1] * A0t;
#pragma unroll
            for (int rt = 0; rt < 2; ++rt)
#pragma unroll
                for (int reg = 0; reg < 4; ++reg) { const int tl = rt * 16 + lq * 4 + reg;
                    Uw[tl * 64 + et * 16 + lr] = f2bf(Hl[rt][reg] + Pl[rt][reg] * Hc[rt]); Pw[tl * 64 + et * 16 + lr] = f2bf(Pl[rt][reg] * Ac[rt]); }
            if (lq == 3) { const size_t o = (size_t)ck * 256 + n * 64 + et * 16 + lr;
                AGGP[o] = Ai[1] * A0t; AGGH[o] = Ai[1] * H0t + Hi[1]; }
        }
        LDS_WAIT(); asm volatile("" ::: "memory");
#pragma unroll
        for (int j = 0; j < 4; ++j) { const int id = lane + 64 * j, row = id >> 3, c8 = (id & 7) * 8;
            *(u32x4*)(HL + (size_t)(t0 + row) * 256 + n * 64 + c8) = *(const LAS u32x4*)(Uw + row * 64 + c8);
            *(u32x4*)(PL + (size_t)(t0 + row) * 256 + n * 64 + c8) = *(const LAS u32x4*)(Pw + row * 64 + c8); }
        LDS_WAIT(); asm volatile("" ::: "memory");
    }
}
__device__ __forceinline__ void phase_lru_b(ArgsRef a, int wv) {
    const float* __restrict__ AGGH = (const float*)(a.ws + WS_AGGH); const float* __restrict__ AGGP = (const float*)(a.ws + WS_AGGP); float* __restrict__ CARRY = (float*)(a.ws + WS_CARRY);
    const int tid_ = tid_from(wv);
    for (int idx = blockIdx.x * NTHR + tid_; idx < NB * 256; idx += gridDim.x * NTHR) { const int b = idx >> 8, c = idx & 255; float carry = 0.f;
        for (int k0 = 0; k0 < LRU_NCH; k0 += 16) { float pp[16], hh[16];
#pragma unroll
            for (int k = 0; k < 16; ++k) { const size_t o = (size_t)(b * LRU_NCH + k0 + k) * 256 + c; pp[k] = AGGP[o]; hh[k] = AGGH[o]; }
#pragma unroll
            for (int k = 0; k < 16; ++k) { const size_t o = (size_t)(b * LRU_NCH + k0 + k) * 256 + c; CARRY[o] = carry; carry = pp[k] * carry + hh[k]; } } }
}
typedef short v4i16_t __attribute__((ext_vector_type(4)));
struct AttnUnit { int h, n, r, dl, g, first; size_t rowb; };
__device__ __forceinline__ AttnUnit attn_unit(int bh, int hf, int i) {
    AttnUnit u; u.h = bh & 7; u.rowb = (size_t)(bh >> 3) * SEQ;
    if (i < 16) { u.g = 0; u.dl = 1; u.r = 0; u.n = 16 * hf + i; u.first = (i == 0); }
    else if (i < 32) { const int j = i - 16; u.g = 1; u.dl = 4; u.r = 2 * hf + (j >> 3); u.n = j & 7; u.first = (u.n == 0); }
    else { const int j = i - 32; u.g = 2; u.dl = 16; u.r = 8 * hf + (j >> 1); u.n = j & 1; u.first = (u.n == 0); }
    return u;
}
__device__ __forceinline__ void attn_dma_chunk(const __amdgpu_buffer_rsrc_t rs, LAS unsigned char* lds, const AttnUnit& u, int chunk, int slot, int wave, int lane) {
    const int csc = (lane & 7) ^ ((lane >> 3) & 7);
#pragma unroll
    for (int q = 0; q < 2; ++q) { const int pc = wave + 8 * q, l = 128 * chunk + 8 * pc + (lane >> 3);
        const unsigned rowoff = (unsigned)((u.rowb + (size_t)l * u.dl + u.r) * NIN * 2);
        const unsigned srcK = rowoff + (unsigned)((C_K + (u.h >> 2) * 256 + (u.h & 3) * 32) * 2) + (unsigned)((csc >> 2) * 256 + (csc & 3) * 16);
        const unsigned srcV = rowoff + (unsigned)((C_V + u.h * 64) * 2) + (unsigned)(csc * 16);
        LAS unsigned char* dst = lds + slot * 32768 + pc * 1024;
        __builtin_amdgcn_raw_ptr_buffer_load_lds(rs, (LAS void*)dst, 16, srcK, 0, 0, 0);
        __builtin_amdgcn_raw_ptr_buffer_load_lds(rs, (LAS void*)(dst + 16384), 16, srcV, 0, 0, 0); }
}
__device__ __forceinline__ void phase_attn(ArgsRef a, LAS unsigned char* lds, int wv) {
    const int tid = tid_from(wv), lane = tid & 63, wave = __builtin_amdgcn_readfirstlane(tid >> 6);
    const bf16* proj = (const bf16*)(a.ws + WS_PROJ);
    bf16* PNUM = (bf16*)(a.ws + WS_PNUM); float* PDEN = (float*)(a.ws + WS_PDEN); float* PMAX = (float*)(a.ws + WS_PMAX);
    const __amdgpu_buffer_rsrc_t rs = __builtin_amdgcn_make_buffer_rsrc((void*)proj, 0, 0x7fffffff, 0x00020000);
    const int lr = lane & 15, lq = lane >> 4, qi0 = 16 * wave, G = gridDim.x;
    const int kc0 = ((0 + lq) ^ (lr & 7)) * 16, kc1 = ((4 + lq) ^ (lr & 7)) * 16;
    const int q4 = (lane & 15) >> 2, p4 = lane & 3, vsw = (4 * lq + q4) & 7;
    unsigned chv[4];
#pragma unroll
    for (int dt = 0; dt < 4; ++dt) chv[dt] = (unsigned)(((2 * dt + (p4 >> 1)) ^ vsw) * 16 + (p4 & 1) * 8);
    const bool xo = (G == 256);
    const int pair = xo ? ((int)(blockIdx.x & 7) * 16 + (int)(blockIdx.x >> 4)) : (int)(blockIdx.x >> 1), hf = xo ? (int)((blockIdx.x >> 3) & 1) : (int)(blockIdx.x & 1), npairs = G >> 1;
    __syncthreads();
    { unsigned z0 = 0u; asm volatile("" : "+v"(z0));
      for (int z = tid; z < RING_BYTES / 16; z += NTHR) ((LAS u32x4*)lds)[z] = (u32x4){z0, z0, z0, z0}; }
    __syncthreads();
    const int total = (pair < 128 && (int)blockIdx.x < 2 * npairs) ? ((128 - pair + npairs - 1) / npairs) * 48 : 0;
    AttnUnit cu = attn_unit(pair < 128 ? pair : 0, hf, 0);
    const int off = (total > 0 && cu.n > 0) ? 1 : 0;
#define ATT_UNIT_AT(k) attn_unit(pair + ((k) / 48) * npairs, hf, (k) % 48)
#define ATT_QLOAD(U, Q0, Q1) do { const size_t qrow_ = (U).rowb + (size_t)(128 * (U).n + qi0 + lr) * (U).dl + (U).r; const int qc_ = C_Q + ((U).h >> 2) * 256 + ((U).h & 3) * 32 + lq * 8; \
        Q0 = *(const bf16x8*)(proj + qrow_ * NIN + qc_); Q1 = *(const bf16x8*)(proj + qrow_ * NIN + qc_ + 128); } while (0)
    bf16x8 qf0, qf1, nq0, nq1;
    if (total > 0) { if (off) attn_dma_chunk(rs, lds, cu, cu.n - 1, 0, wave, lane);
        attn_dma_chunk(rs, lds, cu, cu.n, off & 3, wave, lane); ATT_QLOAD(cu, qf0, qf1);
        if (total > 1) { const AttnUnit u1 = ATT_UNIT_AT(1); attn_dma_chunk(rs, lds, u1, u1.n, (1 + off) & 3, wave, lane); } }
    nq0 = qf0; nq1 = qf1;
    asm volatile("s_waitcnt vmcnt(0)" ::: "memory");
    int idx = 0;
    while (idx < total) {
        asm volatile("s_waitcnt vmcnt(8)" ::: "memory"); __builtin_amdgcn_s_barrier(); asm volatile("" ::: "memory");
        const int csc = (idx + off) & 3, csp = cu.first ? ((cu.n > 0) ? 0 : csc) : ((idx + off + 3) & 3);
        AttnUnit nu = cu;
        if (idx + 1 < total) { nu = ATT_UNIT_AT(idx + 1); ATT_QLOAD(nu, nq0, nq1); }
        if (idx + 2 < total) { const AttnUnit u2 = ATT_UNIT_AT(idx + 2); attn_dma_chunk(rs, lds, u2, u2.n, (idx + 2 + off) & 3, wave, lane); }
        ++idx;
        f32x4 scv[9];
#pragma unroll
        for (int t = 0; t < 9; ++t) { const int wt = wave + t; const LAS unsigned char* Kt = lds + ((wt >= 8) ? csc : csp) * 32768 + ((16 * wt) & 127) * 128 + lr * 128;
            const bf16x8 k0 = *(const LAS bf16x8*)(Kt + kc0), k1 = *(const LAS bf16x8*)(Kt + kc1);
            scv[t] = __builtin_amdgcn_mfma_f32_16x16x32_bf16(k0, qf0, (f32x4){0.f, 0.f, 0.f, 0.f}, 0, 0, 0);
            scv[t] = __builtin_amdgcn_mfma_f32_16x16x32_bf16(k1, qf1, scv[t], 0, 0, 0); }
#pragma unroll
        for (int reg = 0; reg < 4; ++reg) { if (4 * lq + reg < lr) scv[0][reg] = -1e30f; if (4 * lq + reg > lr) scv[8][reg] = -1e30f; }
        if (cu.n == 0) {
#pragma unroll
            for (int t = 0; t < 8; ++t)
#pragma unroll
                for (int reg = 0; reg < 4; ++reg) { if (qi0 + 16 * t + 4 * lq + reg < 128) scv[t][reg] = -1e30f; } }
        float mx = -1e30f;
#pragma unroll
        for (int t = 0; t < 9; ++t)
#pragma unroll
            for (int reg = 0; reg < 4; ++reg) mx = fmaxf(mx, scv[t][reg]);
        mx = fmaxf(mx, __shfl_xor(mx, 16)); mx = fmaxf(mx, __shfl_xor(mx, 32));
        float sm = 0.f;
#pragma unroll
        for (int t = 0; t < 9; ++t)
#pragma unroll
            for (int reg = 0; reg < 4; ++reg) { const float pe = __builtin_amdgcn_exp2f(scv[t][reg] - mx); sm += pe; scv[t][reg] = pe; }
        sm += __shfl_xor(sm, 16); sm += __shfl_xor(sm, 32);
        f32x4 oc[4];
#pragma unroll
        for (int dt = 0; dt < 4; ++dt) oc[dt] = (f32x4){0.f, 0.f, 0.f, 0.f};
#pragma unroll
        for (int pi = 0; pi < 5; ++pi) { const int t0 = 2 * pi, t1 = (2 * pi + 1 < 9) ? 2 * pi + 1 : 8;
            u32x4 pw; pw.x = cvt_pk_bf16(scv[t0][0], scv[t0][1]); pw.y = cvt_pk_bf16(scv[t0][2], scv[t0][3]);
            if (2 * pi + 1 < 9) { pw.z = cvt_pk_bf16(scv[t1][0], scv[t1][1]); pw.w = cvt_pk_bf16(scv[t1][2], scv[t1][3]); } else { pw.z = 0u; pw.w = 0u; }
            const bf16x8 pf = __builtin_bit_cast(bf16x8, pw);
            const int w0 = wave + t0, w1 = wave + t1;
            const LAS unsigned char* V0 = lds + ((w0 >= 8) ? csc : csp) * 32768 + 16384 + (((16 * w0) & 127) + 4 * lq + q4) * 128;
            const LAS unsigned char* V1 = lds + ((w1 >= 8) ? csc : csp) * 32768 + 16384 + (((16 * w1) & 127) + 4 * lq + q4) * 128;
            const unsigned va0 = (unsigned)(unsigned long)V0, va1 = (unsigned)(unsigned long)V1;
            v4i16_t r0[4], r1[4];
#pragma unroll
            for (int dt = 0; dt < 4; ++dt) { asm volatile("ds_read_b64_tr_b16 %0, %1" : "=&v"(r0[dt]) : "v"(va0 + chv[dt]) : "memory"); asm volatile("ds_read_b64_tr_b16 %0, %1" : "=&v"(r1[dt]) : "v"(va1 + chv[dt]) : "memory"); }
            asm volatile("s_waitcnt lgkmcnt(0)" : "+v"(r0[0]), "+v"(r0[1]), "+v"(r0[2]), "+v"(r0[3]), "+v"(r1[0]), "+v"(r1[1]), "+v"(r1[2]), "+v"(r1[3]) :: "memory");
#pragma unroll
            for (int dt = 0; dt < 4; ++dt) { const bf16x8 vf = (bf16x8){r0[dt][0], r0[dt][1], r0[dt][2], r0[dt][3], r1[dt][0], r1[dt][1], r1[dt][2], r1[dt][3]};
                oc[dt] = __builtin_amdgcn_mfma_f32_16x16x32_bf16(pf, vf, oc[dt], 0, 0, 0); } }
        { LAS bf16* stg = (LAS bf16*)(lds + OST_OFF + wave * 2048);
#pragma unroll
          for (int reg = 0; reg < 4; ++reg)
#pragma unroll
              for (int dt = 0; dt < 4; ++dt) stg[(4 * lq + reg) * 64 + dt * 16 + lr] = f2bf(oc[dt][reg]);
          LDS_WAIT(); asm volatile("" ::: "memory");
#pragma unroll
          for (int i = 0; i < 2; ++i) { const int qq = i * 8 + (lane >> 3), c8 = (lane & 7) * 8; const u32x4 w = *(const LAS u32x4*)(stg + qq * 64 + c8);
              const size_t tok = cu.rowb + (size_t)(128 * cu.n + qi0 + qq) * cu.dl + cu.r;
              *(u32x4*)(PNUM + ((size_t)cu.g * NT + tok) * 512 + cu.h * 64 + c8) = w; }
          LDS_WAIT(); asm volatile("" ::: "memory"); }
        if (lq == 0) { const size_t tok = cu.rowb + (size_t)(128 * cu.n + qi0 + lr) * cu.dl + cu.r; PDEN[((size_t)cu.g * NT + tok) * 8 + cu.h] = sm; PMAX[((size_t)cu.g * NT + tok) * 8 + cu.h] = mx; }
        cu = nu; qf0 = nq0; qf1 = nq1;
    }
#undef ATT_UNIT_AT
#undef ATT_QLOAD
}
__device__ __forceinline__ void phase_finalize(ArgsRef a, int wv) {
    const int tid = tid_from(wv), lane = tid & 63, wave = tid >> 6;
    const int gw = blockIdx.x * NWAVES + wave, NGW = gridDim.x * NWAVES;
    const bf16* __restrict__ proj = (const bf16*)(a.ws + WS_PROJ); bf16* __restrict__ mix = (bf16*)(a.ws + WS_MIX);
    const bf16* __restrict__ YP = (const bf16*)(a.ws + WS_YP); const float* __restrict__ SSQPOOL = (const float*)(a.ws + WS_SSQPOOL);
    const bf16* __restrict__ HL = (const bf16*)(a.ws + WS_HL); const bf16* __restrict__ PL = (const bf16*)(a.ws + WS_PL); const float* __restrict__ CARRY = (const float*)(a.ws + WS_CARRY);
    const bf16* __restrict__ PNUM = (const bf16*)(a.ws + WS_PNUM); const float* __restrict__ PDEN = (const float*)(a.ws + WS_PDEN); const float* __restrict__ PMAX = (const float*)(a.ws + WS_PMAX);
    const int hd = lane >> 3;
    for (int t = gw; t < NT; t += NGW) {
        const u32x2 ypw = *(const u32x2*)(YP + (size_t)t * 256 + lane * 4); const f32x4 sq = *(const f32x4*)(SSQPOOL + (size_t)t * 4);
        const u32x2 hw = *(const u32x2*)(HL + (size_t)t * 256 + lane * 4), pw = *(const u32x2*)(PL + (size_t)t * 256 + lane * 4), gwd = *(const u32x2*)(proj + (size_t)t * NIN + C_GATE + lane * 4);
        const f32x4 cr = *(const f32x4*)(CARRY + (size_t)(t / LRU_CH) * 256 + lane * 4);
        float m[3], dn[3]; u32x4 nw[3];
#pragma unroll
        for (int g = 0; g < 3; ++g) { m[g] = PMAX[((size_t)g * NT + t) * 8 + hd]; dn[g] = PDEN[((size_t)g * NT + t) * 8 + hd]; nw[g] = *(const u32x4*)(PNUM + ((size_t)g * NT + t) * 512 + lane * 8); }
        { const float rs = __builtin_amdgcn_rsqf(((sq[0] + sq[1]) + (sq[2] + sq[3])) * (1.0f / 256.0f) + EPS);
          u32x2 o; o.x = cvt_pk_bf16(bflo(ypw.x) * rs, bfhi(ypw.x) * rs); o.y = cvt_pk_bf16(bflo(ypw.y) * rs, bfhi(ypw.y) * rs);
          *(u32x2*)(mix + (size_t)t * DM + lane * 4) = o; }
        { float h[4] = {bflo(hw.x) + bflo(pw.x) * cr[0], bfhi(hw.x) + bfhi(pw.x) * cr[1], bflo(hw.y) + bflo(pw.y) * cr[2], bfhi(hw.y) + bfhi(pw.y) * cr[3]};
          const float gt[4] = {bflo(gwd.x), bfhi(gwd.x), bflo(gwd.y), bfhi(gwd.y)};
          float s = 0.f;
#pragma unroll
          for (int j = 0; j < 4; ++j) { h[j] *= gelu_tanh(gt[j]); s += h[j] * h[j]; }
          s = wave_sum(s); const float rs = __builtin_amdgcn_rsqf(s * (1.0f / 256.0f) + EPS);
          u32x2 o; o.x = cvt_pk_bf16(h[0] * rs, h[1] * rs); o.y = cvt_pk_bf16(h[2] * rs, h[3] * rs);
          *(u32x2*)(mix + (size_t)t * DM + 256 + lane * 4) = o; }
        { const float mr = fmaxf(fmaxf(m[0], m[1]), m[2]);
          float o[8] = {0.f, 0.f, 0.f, 0.f, 0.f, 0.f, 0.f, 0.f}; float den = 0.f;
#pragma unroll
          for (int g = 0; g < 3; ++g) { const float wg = __builtin_amdgcn_exp2f(m[g] - mr); den += wg * dn[g];
              o[0] += wg * bflo(nw[g].x); o[1] += wg * bfhi(nw[g].x); o[2] += wg * bflo(nw[g].y); o[3] += wg * bfhi(nw[g].y); o[4] += wg * bflo(nw[g].z); o[5] += wg * bfhi(nw[g].z); o[6] += wg * bflo(nw[g].w); o[7] += wg * bfhi(nw[g].w); }
          const float inv = 1.0f / den; float s = 0.f;
#pragma unroll
          for (int j = 0; j < 8; ++j) { o[j] *= inv; s += o[j] * o[j]; }
          s = wave_sum(s); const float rs = __builtin_amdgcn_rsqf(s * (1.0f / 512.0f) + EPS);
          u32x4 wv4; wv4.x = cvt_pk_bf16(o[0] * rs, o[1] * rs); wv4.y = cvt_pk_bf16(o[2] * rs, o[3] * rs); wv4.z = cvt_pk_bf16(o[4] * rs, o[5] * rs); wv4.w = cvt_pk_bf16(o[6] * rs, o[7] * rs);
          *(u32x4*)(mix + (size_t)t * DM + 512 + lane * 8) = wv4; }
    }
}

__device__ __forceinline__ void phase_router(ArgsRef a, LAS unsigned char* lds, int layer, int wv, bool alloc) {
    const int tid = tid_from(wv), lane = tid & 63, wave = __builtin_amdgcn_readfirstlane(tid >> 6);
    const bf16* xb = (const bf16*)(a.ws + WS_XB); const bf16* wr = (const bf16*)(a.ws + WS_SMALL) + SM_WR + (size_t)layer * NEXP * DM;
    const float* ssqp = (const float*)(a.ws + WS_SSQP); const float* rbias = a.in[I_BR] + layer * NEXP;
    int* LIST = (int*)(a.ws + WS_LIST); float* LRSTD = (float*)(a.ws + WS_LRSTD); float* LGATE = (float*)(a.ws + WS_LGATE2);
    unsigned* cnt = (unsigned*)(a.ws + WS_CTL) + CW_CNT + layer * NEXP;
    LAS float* LG = (LAS float*)lds + wave * 32 * 33;
    LAS int* hist = (LAS int*)(lds + 65536);
    LAS int* base = (LAS int*)(lds + 65536 + 128);
    const int lr = lane & 15, lq = lane >> 4;
    for (int unit = blockIdx.x; unit < NT / 256; unit += gridDim.x) {
        const int tok0 = unit * 256 + wave * 32;
        __syncthreads();
        if (tid < 32) hist[tid] = 0;
        f32x4 acc[2][2];
#pragma unroll
        for (int rt = 0; rt < 2; ++rt)
#pragma unroll
            for (int et = 0; et < 2; ++et) acc[rt][et] = (f32x4){0.f, 0.f, 0.f, 0.f};
#pragma unroll 4
        for (int ks = 0; ks < 32; ++ks) { bf16x8 af[2], bfr[2];
#pragma unroll
            for (int rt = 0; rt < 2; ++rt) af[rt] = *(const bf16x8*)(xb + (size_t)(tok0 + rt * 16 + lr) * DM + ks * 32 + lq * 8);
#pragma unroll
            for (int et = 0; et < 2; ++et) bfr[et] = *(const bf16x8*)(wr + (size_t)(et * 16 + lr) * DM + ks * 32 + lq * 8);
#pragma unroll
            for (int rt = 0; rt < 2; ++rt)
#pragma unroll
                for (int et = 0; et < 2; ++et) acc[rt][et] = __builtin_amdgcn_mfma_f32_16x16x32_bf16(af[rt], bfr[et], acc[rt][et], 0, 0, 0); }
#pragma unroll
        for (int rt = 0; rt < 2; ++rt)
#pragma unroll
            for (int et = 0; et < 2; ++et)
#pragma unroll
                for (int reg = 0; reg < 4; ++reg) LG[(rt * 16 + lq * 4 + reg) * 33 + et * 16 + lr] = acc[rt][et][reg];
        __syncthreads();
        int te[4] = {0, 0, 0, 0}; float tg[4] = {0.f, 0.f, 0.f, 0.f}; int rk[4] = {0, 0, 0, 0}; float rstd = 0.f; const int tok = tok0 + lane;
        if (lane < 32) {
            const float* sp = ssqp + (size_t)tok * 16; float ss = 0.f;
#pragma unroll
            for (int j = 0; j < 16; ++j) ss += sp[j];
            rstd = __builtin_amdgcn_rsqf(ss * (1.0f / DM) + EPS);
            float tv[4] = {-3e38f, -3e38f, -3e38f, -3e38f};
            for (int e = 0; e < NEXP; ++e) { float v = LG[lane * 33 + e] * rstd + rbias[e]; int ve = e;
#pragma unroll
                for (int k = 0; k < 4; ++k) { if (v > tv[k]) { const float tvv = tv[k]; const int tee = te[k]; tv[k] = v; te[k] = ve; v = tvv; ve = tee; } } }
            float z = 0.f;
#pragma unroll
            for (int k = 0; k < 4; ++k) { tg[k] = fast_exp(tv[k] - tv[0]); z += tg[k]; }
            const float iz = 1.0f / z;
#pragma unroll
            for (int k = 0; k < 4; ++k) { tg[k] *= iz; rk[k] = __hip_atomic_fetch_add(&hist[te[k]], 1, __ATOMIC_RELAXED, __HIP_MEMORY_SCOPE_WORKGROUP); }
        }
        __syncthreads();
        if (tid < 32) base[tid] = alloc ? (int)__hip_atomic_fetch_add(cnt + tid, (unsigned)hist[tid], RLX_AGENT) : 0;
        __syncthreads();
        if (lane < 32 && alloc) {
#pragma unroll
            for (int k = 0; k < 4; ++k) { const size_t p = (size_t)te[k] * NT + base[te[k]] + rk[k]; LIST[p] = tok * 4 + k; LRSTD[p] = rstd; LGATE[p] = tg[k]; }
        }
    }
}

__device__ __forceinline__ void phase_combine(ArgsRef a, bool last_layer, int wv, bool dry) {
    const int tid = tid_from(wv), lane = tid & 63, wave = tid >> 6;
    const int gw = blockIdx.x * NWAVES + wave, NGW = gridDim.x * NWAVES;
    const unsigned char* __restrict__ Y = (const unsigned char*)(a.ws + WS_Y); float* __restrict__ out = a.out; bf16* xb = (bf16*)(a.ws + WS_XB); float* __restrict__ ssq = (float*)(a.ws + WS_SSQ);
    typedef float f2v __attribute__((ext_vector_type(2)));
    for (int t = gw; t < NT; t += NGW) {
        const u32x4 x0 = *((const u32x4*)(xb + (size_t)t * DM) + 2 * lane), x1 = *((const u32x4*)(xb + (size_t)t * DM) + 2 * lane + 1);
        u32x4 y[4];
#pragma unroll
        for (int k = 0; k < 4; ++k) y[k] = *((const u32x4*)(Y + ((size_t)t * 4 + k) * DM) + lane);
        float v[16];
        v[0] = bflo(x0.x); v[1] = bfhi(x0.x); v[2] = bflo(x0.y); v[3] = bfhi(x0.y); v[4] = bflo(x0.z); v[5] = bfhi(x0.z); v[6] = bflo(x0.w); v[7] = bfhi(x0.w);
        v[8] = bflo(x1.x); v[9] = bfhi(x1.x); v[10] = bflo(x1.y); v[11] = bfhi(x1.y); v[12] = bflo(x1.z); v[13] = bfhi(x1.z); v[14] = bflo(x1.w); v[15] = bfhi(x1.w);
#pragma unroll
        for (int k = 0; k < 4; ++k)
#pragma unroll
            for (int d = 0; d < 4; ++d) { const int w = (int)y[k][d]; const f2v lo = __builtin_amdgcn_cvt_pk_f32_fp8(w, false), hi = __builtin_amdgcn_cvt_pk_f32_fp8(w, true);
                v[4 * d + 0] += lo.x * (1.0f / Y8_SCALE); v[4 * d + 1] += lo.y * (1.0f / Y8_SCALE); v[4 * d + 2] += hi.x * (1.0f / Y8_SCALE); v[4 * d + 3] += hi.y * (1.0f / Y8_SCALE); }
        float s = 0.f;
#pragma unroll
        for (int j = 0; j < 16; ++j) s += v[j] * v[j];
        if (dry && s != 12345.678f) continue;
        if (last_layer) {
#pragma unroll
            for (int j = 0; j < 4; ++j) *((f32x4*)(out + (size_t)t * DM) + 4 * lane + j) = (f32x4){v[4 * j], v[4 * j + 1], v[4 * j + 2], v[4 * j + 3]};
        } else { s = wave_sum(s);
            u32x4 w0, w1; w0.x = cvt_pk_bf16(v[0], v[1]); w0.y = cvt_pk_bf16(v[2], v[3]); w0.z = cvt_pk_bf16(v[4], v[5]); w0.w = cvt_pk_bf16(v[6], v[7]);
            w1.x = cvt_pk_bf16(v[8], v[9]); w1.y = cvt_pk_bf16(v[10], v[11]); w1.z = cvt_pk_bf16(v[12], v[13]); w1.w = cvt_pk_bf16(v[14], v[15]);
            *((u32x4*)(xb + (size_t)t * DM) + 2 * lane) = w0; *((u32x4*)(xb + (size_t)t * DM) + 2 * lane + 1) = w1;
            if (lane == 0) ssq[t] = s; }
    }
}

constexpr int NPH_LAYER = 13, NPH = 1 + 2 * NPH_LAYER;
enum { PH_GEMM_IN = 0, PH_QKPREP, PH_POOL, PH_LRU_A, PH_LRU_B, PH_ATTN, PH_LRU_C, PH_MERGE, PH_GEMM_OUT, PH_ROUTER, PH_MOE_GU, PH_MOE_DOWN, PH_COMBINE };
#ifndef MK_STOP
#define MK_STOP NPH
#endif
#ifndef MK_SPLIT
#define MK_SPLIT 0
#endif

template <int PHMASK>
__global__ void __launch_bounds__(NTHR, 2) mega_fwd(Args args_by_value) {
    extern __shared__ __attribute__((aligned(16))) unsigned char lds_raw[];
    LAS unsigned char* lds = (LAS unsigned char*)lds_raw;
    const int tid = threadIdx.x;
    int wv = __builtin_amdgcn_readfirstlane(tid >> 6); asm volatile("" : "+s"(wv));
    for (int u = tid; u < (LDS_BYTES - LDSCTL_OFF) / 4; u += NTHR) ((LAS unsigned*)(lds + LDSCTL_OFF))[u] = 0u;
    __syncthreads();
#define ARGS_HERE() const CAS Args* ap_ = (const CAS Args*)__builtin_amdgcn_kernarg_segment_ptr(); asm volatile("" : "+s"(ap_)); ArgsRef args = *ap_; unsigned char* const ws = args.ws; unsigned* const ctl = (unsigned*)(ws + WS_CTL); (void)ctl
    int lo, hi;
    { ARGS_HERE(); lo = args.ph_lo; hi = args.ph_hi; xcd_barrier_post(ctl + CW_BAR + args.li * XCD_BAR_WORDS, (volatile LAS unsigned*)(lds + MISC_OFF) + 8); }
#define EN(p) (((PHMASK) >> (p)) & 1)
#ifndef MK_DUP
#define MK_DUP 0
#endif
#define NREP(p) ((((MK_DUP) >> (p)) & 1) ? 2 : 1)
#define IN(k) (lo <= (k) && (k) < hi)
#define SEAM(k) do { if (IN(k) && IN((k) + 1)) { ARGS_HERE(); XcdBarrier bar_; bar_.bar = ctl + CW_BAR + args.li * XCD_BAR_WORDS; bar_.x = xb_xcc_id(); bar_.st = (volatile LAS unsigned*)(lds + MISC_OFF) + 8; xcd_barrier(bar_); } } while (0)

    if (EN(13) && IN(0)) { ARGS_HERE(); for (int rep_ = 0; rep_ < NREP(13); ++rep_) { phase_prologue(args, lds, wv); } }
    SEAM(0);
    for (int l = 0; l < 2; ++l) {
        const int pb = 1 + NPH_LAYER * l;
        if (EN(PH_GEMM_IN) && IN(pb + PH_GEMM_IN)) { ARGS_HERE();
            pg8::StaticOrder S; S.init(NT, NIN, DM, gridDim.x, blockIdx.x); S.dup = NREP(PH_GEMM_IN) - 1;
            EpiIn E{(bf16*)(ws + WS_PROJ), (const float*)(ws + WS_SSQ), args.in[I_QG] + l * 64, args.in[I_KG] + l * 64, (const float*)(ws + WS_ROPE), (const float*)(ws + WS_ROPE) + SEQ * 32};
            pg8::gemm_phase<EpiIn, pg8::StaticOrder, true>(lds, (const bf16*)(ws + WS_XB), (const bf16*)(ws + WS_WIN) + (size_t)l * NIN * DM, DM, S, E, wv);
        }
        SEAM(pb + PH_GEMM_IN);
        if (EN(PH_POOL) && IN(pb + PH_POOL)) { ARGS_HERE(); for (int rep_ = 0; rep_ < NREP(PH_POOL); ++rep_) { phase_pool(args, lds, l, wv); } }
        if (EN(PH_LRU_A) && IN(pb + PH_LRU_A)) { ARGS_HERE(); for (int rep_ = 0; rep_ < NREP(PH_LRU_A); ++rep_) { phase_lru_a(args, lds, l, wv); } }
        SEAM(pb + PH_LRU_A);
        if (EN(PH_LRU_B) && IN(pb + PH_LRU_B)) { ARGS_HERE(); for (int rep_ = 0; rep_ < NREP(PH_LRU_B); ++rep_) { phase_lru_b(args, wv); } }
        if (EN(PH_ATTN) && IN(pb + PH_ATTN)) { ARGS_HERE(); for (int rep_ = 0; rep_ < NREP(PH_ATTN); ++rep_) { phase_attn(args, lds, wv); } }
        SEAM(pb + PH_ATTN);
        if (EN(PH_LRU_C) && IN(pb + PH_LRU_C)) { ARGS_HERE(); for (int rep_ = 0; rep_ < NREP(PH_LRU_C); ++rep_) { phase_finalize(args, wv); } }
        SEAM(pb + PH_MERGE);
        if (EN(PH_GEMM_OUT) && IN(pb + PH_GEMM_OUT)) { ARGS_HERE();
            __syncthreads();
            pg8::StaticOrder S; S.init(NT, DM, DM, gridDim.x, blockIdx.x); S.dup = (l == 0) ? NREP(PH_GEMM_OUT) - 1 : 0;
            EpiOut E{(bf16*)(ws + WS_XB), (float*)(ws + WS_SSQP)};
            pg8::gemm_phase<EpiOut, pg8::StaticOrder, true>(lds, (const bf16*)(ws + WS_MIX), (const bf16*)(ws + WS_WOUT) + (size_t)l * DM * DM, DM, S, E, wv);
        }
        SEAM(pb + PH_GEMM_OUT);
        if (EN(PH_ROUTER) && IN(pb + PH_ROUTER)) { ARGS_HERE(); for (int rep_ = 0; rep_ < NREP(PH_ROUTER); ++rep_) { phase_router(args, lds, l, wv, rep_ == NREP(PH_ROUTER) - 1); } }
        SEAM(pb + PH_ROUTER);
        if (EN(PH_MOE_GU) && IN(pb + PH_MOE_GU)) { ARGS_HERE();
            LAS int* tab = (LAS int*)(lds + TAB_OFF);
            moe_tables(tab, ctl + CW_CNT + l * NEXP, wv);
            MoeOrder<0> S{tab, 2, (int)gridDim.x, (int)blockIdx.x, (const int*)(ws + WS_LIST), NREP(PH_MOE_GU) - 1};
            EpiGU E{(bf16*)(ws + WS_ACT), (const float*)(ws + WS_LRSTD), args.in[I_BGU] + (size_t)l * NEXP * 512};
            pg8::gemm_phase<EpiGU, MoeOrder<0>, true>(lds, (const bf16*)(ws + WS_XB), (const bf16*)(ws + WS_WGU) + (size_t)l * NEXP * 512 * DM, DM, S, E, wv);
        }
        SEAM(pb + PH_MOE_GU);
        if (EN(PH_MOE_DOWN) && IN(pb + PH_MOE_DOWN)) { ARGS_HERE();
            LAS int* tab = (LAS int*)(lds + TAB_OFF);
            moe_tables(tab, ctl + CW_CNT + l * NEXP, wv);
            MoeOrder<1> S{tab, 4, (int)gridDim.x, (int)blockIdx.x, (const int*)(ws + WS_LIST), NREP(PH_MOE_DOWN) - 1};
            EpiDown E{(unsigned char*)(ws + WS_Y), (const int*)(ws + WS_LIST), (const float*)(ws + WS_LGATE2), args.in[I_BD] + (size_t)l * NEXP * DM, tab};
            pg8::gemm_phase<EpiDown, MoeOrder<1>, true>(lds, (const bf16*)(ws + WS_ACT), (const bf16*)(ws + WS_WD) + (size_t)l * NEXP * DM * EFF, EFF, S, E, wv);
        }
        SEAM(pb + PH_MOE_DOWN);
        if (EN(PH_COMBINE) && IN(pb + PH_COMBINE)) { ARGS_HERE(); for (int rep_ = 0; rep_ < NREP(PH_COMBINE); ++rep_) { phase_combine(args, l == 1, wv, rep_ < NREP(PH_COMBINE) - 1); } }
        SEAM(pb + PH_COMBINE);
    }
#undef IN
#undef SEAM
}

typedef void (*kern_t)(Args);
template <int M> static kern_t kern_of() { return (kern_t)mega_fwd<M>; }
static kern_t phase_kernel(int p) {
    switch (p) { case 0: return kern_of<1 << 0>(); case 1: return kern_of<1 << 1>(); case 2: return kern_of<1 << 2>(); case 3: return kern_of<1 << 3>(); case 4: return kern_of<1 << 4>();
                 case 5: return kern_of<1 << 5>(); case 6: return kern_of<1 << 6>(); case 7: return kern_of<1 << 7>(); case 8: return kern_of<1 << 8>(); case 9: return kern_of<1 << 9>();
                 case 10: return kern_of<1 << 10>(); case 11: return kern_of<1 << 11>(); case 12: return kern_of<1 << 12>(); default: return kern_of<1 << 13>(); }
}
extern "C" void kernel_launch(void* const* d_in, const int* in_sizes, int n_in, void* d_out, int out_size, void* d_ws, size_t ws_size, hipStream_t stream) {
    static int grid = 0;
    if (grid == 0) {
        if (n_in != 23 || in_sizes[0] != NT * DM || out_size != NT * DM || ws_size < WS_END) {
            fprintf(stderr, "kernel_launch: built for 23 inputs, x/out of %d floats, >= %zu bytes of workspace; got n_in %d, in0 %d, out %d, ws %zu; nothing launched\n", NT * DM, (size_t)WS_END, n_in, n_in > 0 ? in_sizes[0] : -1, out_size, ws_size);
            grid = -1; return; }
        int dev = 0, cus = 0;
        if (hipGetDevice(&dev) != hipSuccess || hipDeviceGetAttribute(&cus, hipDeviceAttributeMultiprocessorCount, dev) != hipSuccess) { fprintf(stderr, "kernel_launch: device query failed\n"); grid = -1; return; }
#if MK_SPLIT
        for (int p = 0; p < 14; ++p) if (hipFuncSetAttribute((const void*)phase_kernel(p), hipFuncAttributeMaxDynamicSharedMemorySize, LDS_BYTES) != hipSuccess) { fprintf(stderr, "kernel_launch: hipFuncSetAttribute failed\n"); grid = -1; return; }
#else
        if (hipFuncSetAttribute((const void*)kern_of<0x3fff>(), hipFuncAttributeMaxDynamicSharedMemorySize, LDS_BYTES) != hipSuccess) { fprintf(stderr, "kernel_launch: hipFuncSetAttribute failed\n"); grid = -1; return; }
        int per_cu = 0;
        if (hipOccupancyMaxActiveBlocksPerMultiprocessor(&per_cu, (const void*)kern_of<0x3fff>(), NTHR, LDS_BYTES) != hipSuccess || per_cu < 1)
            fprintf(stderr, "kernel_launch: note: occupancy query reports %d workgroups per CU\n", per_cu);
#endif
        (void)hipGetLastError();
        if (cus != 256) { fprintf(stderr, "kernel_launch: this kernel's unit maps are built for a 256-CU device (one workgroup per CU); found %d CUs; nothing launched\n", cus); grid = -1; return; }
        grid = cus;
    }
    if (grid < 0) return;
    if (hipMemsetAsync((char*)d_ws + WS_CTL, 0, CTL_ZERO_BYTES, stream) != hipSuccess) { fprintf(stderr, "kernel_launch: hipMemsetAsync failed\n"); return; }
    Args a{};
    for (int i = 0; i < 23; ++i) a.in[i] = (const float*)d_in[i];
    a.out = (float*)d_out; a.ws = (unsigned char*)d_ws; a.pad = 0;
#if MK_SPLIT
#ifdef MK_SKIP
    (void)hipMemsetAsync((char*)d_ws + WS_MIX, 0, (size_t)NT * DM * 2, stream);
#endif
    for (int p = 0; p < MK_STOP; ++p) { a.ph_lo = p; a.ph_hi = p + 1; a.li = p;
#ifdef MK_SKIP
        if (p >= 1 && (((MK_SKIP) >> ((p - 1) % NPH_LAYER)) & 1)) continue;
#endif
        hipLaunchKernelGGL(phase_kernel(p == 0 ? 13 : (p - 1) % NPH_LAYER), dim3(grid), dim3(NTHR), LDS_BYTES, stream, a); }
#else
    a.ph_lo = 0; a.ph_hi = NPH; a.li = 0;
    hipLaunchKernelGGL(kern_of<0x3fff>(), dim3(grid), dim3(NTHR), LDS_BYTES, stream, a);
#endif
    const hipError_t le = hipPeekAtLastError();
    if (le != hipSuccess) fprintf(stderr, "kernel_launch: launch failed: %s\n", hipGetErrorName(le));
}
```

```cpp
#include <hip/hip_runtime.h>
#include <cstdio>
#include <cstdint>

#define LAS __attribute__((address_space(3)))
#define GAS __attribute__((address_space(1)))
typedef unsigned short bf16;
typedef short bf16x8 __attribute__((ext_vector_type(8)));
typedef float f32x4 __attribute__((ext_vector_type(4)));
typedef float f32x2 __attribute__((ext_vector_type(2)));
typedef unsigned u32x4 __attribute__((ext_vector_type(4)));
typedef unsigned u32x2 __attribute__((ext_vector_type(2)));

#ifndef MK_VAR
#define MK_VAR 0
#endif
constexpr int NB = 16, SEQ = 4096, DM = 1024, NT = NB * SEQ;
constexpr int NIN = 2304;
constexpr int C_POOL = 0, C_LRU = 256, C_GATE = 512, C_Q = 768, C_K = 1280, C_V = 1792;
constexpr int NEXP = 32, TOPK = 4, EFF = 256;
constexpr int NASSIGN = NT * TOPK;
constexpr int ACT_ROWS = NASSIGN + NEXP * 256;
constexpr float EPS = 1e-6f;
constexpr int NWAVES = 8, NTHR = 512;
constexpr int LRU_CH = 32, LRU_NCH = SEQ / LRU_CH;

constexpr size_t MiB = 1u << 20;
constexpr size_t WS_CTL = 0, CTL_ZERO_BYTES = 1 * MiB;
constexpr size_t WS_ROPE = 1 * MiB;
constexpr size_t WS_SMALL = 2 * MiB;
constexpr size_t WS_WIN = 4 * MiB;
constexpr size_t WS_WOUT = 13 * MiB;
constexpr size_t WS_WGU = 17 * MiB;
constexpr size_t WS_WD = 81 * MiB;
constexpr size_t WS_SSQ = 113 * MiB;
constexpr size_t WS_SSQP = 114 * MiB;
constexpr size_t WS_LIST = 118 * MiB;
constexpr size_t WS_XB = 128 * MiB;
constexpr size_t WS_R = 256 * MiB;
constexpr size_t WS_PROJ = WS_R;
constexpr size_t WS_MIX = WS_R + 288 * MiB;
constexpr size_t WS_PNUM = WS_R + 416 * MiB;
constexpr size_t WS_PDEN = WS_R + 608 * MiB;
constexpr size_t WS_PMAX = WS_R + 614 * MiB;
constexpr size_t WS_HL = WS_R + 620 * MiB;
constexpr size_t WS_PL = WS_R + 652 * MiB;
constexpr size_t WS_AGGH = WS_R + 684 * MiB;
constexpr size_t WS_AGGP = WS_R + 686 * MiB;
constexpr size_t WS_CARRY = WS_R + 688 * MiB;
constexpr size_t WS_YP = WS_R + 690 * MiB;
constexpr size_t WS_SSQPOOL = WS_R + 722 * MiB;
constexpr size_t WS_ACT = WS_R;
constexpr size_t WS_Y = WS_R + 132 * MiB;
constexpr size_t WS_XB8 = WS_R + 420 * MiB;
constexpr size_t WS_LRSTD = WS_R + 644 * MiB;
constexpr size_t WS_LGATE2 = WS_R + 652 * MiB;
constexpr size_t WS_END = 1024 * MiB;
static_assert(WS_CARRY + 2 * MiB <= WS_END && WS_LGATE2 + 8 * MiB <= WS_END, "d_ws map");
constexpr size_t SM_POOLW = 0;
constexpr size_t SM_WA = 32768;
constexpr size_t SM_WX = 65536;
constexpr size_t SM_WR = 98304;
constexpr int CW_BAR = 4096;
constexpr int CW_CNT = 1024;

constexpr int RING_BYTES = 131072;
constexpr int LDSCTL_OFF = RING_BYTES;
constexpr int MISC_OFF = LDSCTL_OFF + 320;
constexpr int TAB_OFF = LDSCTL_OFF + 1024;
constexpr int OST_OFF = RING_BYTES + 8192;
constexpr int LDS_BYTES = 163840;

typedef GAS unsigned gu32;
#define RLX_AGENT __ATOMIC_RELAXED, __HIP_MEMORY_SCOPE_AGENT
#define LDS_WAIT() asm volatile("s_waitcnt lgkmcnt(0)" ::: "memory")
#define VM_WAIT() asm volatile("s_waitcnt vmcnt(0)" ::: "memory")
typedef __bf16 bf16x2_t __attribute__((ext_vector_type(2)));
__device__ __forceinline__ unsigned cvt_pk_bf16(float lo, float hi) { const f32x2 v = {lo, hi}; const bf16x2_t b = __builtin_convertvector(v, bf16x2_t); return __builtin_bit_cast(unsigned, b); }
__device__ __forceinline__ float bflo(unsigned w) { return __uint_as_float(w << 16); }
__device__ __forceinline__ float bfhi(unsigned w) { return __uint_as_float(w & 0xffff0000u); }
__device__ __forceinline__ float bf2f(bf16 h) { return __uint_as_float((unsigned)h << 16); }
__device__ __forceinline__ bf16 f2bf(float f) { return (bf16)(cvt_pk_bf16(f, 0.f) & 0xffffu); }
__device__ __forceinline__ float wave_sum(float v) {
#pragma unroll
    for (int o = 1; o < 64; o <<= 1) v += __shfl_xor(v, o);
    return v;
}
__device__ __forceinline__ float fast_sigmoid(float x) { return __builtin_amdgcn_rcpf(1.0f + __builtin_amdgcn_exp2f(-1.4426950408889634f * x)); }
__device__ __forceinline__ float fast_exp(float x) { return __builtin_amdgcn_exp2f(1.4426950408889634f * x); }
__device__ __forceinline__ float gelu_tanh(float x) {
    const float u = 0.7978845608028654f * (x + 0.044715f * x * x * x);
    return x * fast_sigmoid(2.0f * u);
}
__device__ __forceinline__ int tid_from(int wv) { int ln; asm volatile("v_mbcnt_lo_u32_b32 %0, -1, 0\n\tv_mbcnt_hi_u32_b32 %0, -1, %0" : "=v"(ln)); return wv * 64 + ln; }
namespace pg8 {
constexpr int BM = 256, BK = 64, HALF = 128, HTB = HALF * BK * 2  , STAGE_BYTES = 8 * HTB, NXCD = 8, WGM = 8;

__host__ __device__ __forceinline__ int lds_byte(int r, int c) { const int st = (r >> 4) * 2 + (c >> 5), rr = r & 15, cc = c & 31, ob = rr * 64 + cc * 2; return st * 1024 + (ob ^ (((ob >> 9) & 1) << 5)); }
__host__ __device__ __forceinline__ void stage_rc(int b, int& R, int& C) { const int st = b / 1024, sb = b % 1024, swz = sb ^ (((sb >> 9) & 1) << 5); R = (st >> 1) * 16 + swz / 64; C = (st & 1) * 32 + (swz % 64) / 2; }
__host__ __device__ __forceinline__ int perm32(int rho) { const int n = rho >> 4, i = rho & 15; return 8 * (i >> 2) + 4 * n + (i & 3); }

struct Unit { int pm, pn, e, aux; };

typedef int v8i32_t __attribute__((ext_vector_type(8)));
typedef int v4i32_t __attribute__((ext_vector_type(4)));
__device__ __forceinline__ v8i32_t f8frag(bf16x8 lo, bf16x8 hi) { const u32x4 a = __builtin_bit_cast(u32x4, lo), b = __builtin_bit_cast(u32x4, hi); return (v8i32_t){(int)a.x, (int)a.y, (int)a.z, (int)a.w, (int)b.x, (int)b.y, (int)b.z, (int)b.w}; }
template <class Epi, class Sched, bool ALIGN_EPI, bool F8 = false>
__device__ __forceinline__ void gemm_phase(LAS unsigned char* lds, const bf16* Abase, const bf16* Bbase, const int K, const Sched& S, const Epi& E, const int wv) {
    const int tid = tid_from(wv), wid = __builtin_amdgcn_readfirstlane(tid >> 6), lane = tid & 63, wr = wid >> 2, wc = wid & 3, fr = lane & 15, fq = lane >> 4;
    const int nt = K / BK;
    unsigned voffB[2];
#pragma unroll
    for (int i = 0; i < 2; ++i) { int R, C; stage_rc(tid * 16 + i * 8192, R, C); const int Rb = Epi::PERM ? ((R & ~31) + perm32(R & 31)) : R;
        voffB[i] = (unsigned)(Rb * K + C) * 2u; }
#define PG8_AVOFF(u, h, i) ([&]() { int R_, C_; stage_rc(tid * 16 + (i) * 8192, R_, C_); return S.a_voff((u), (h) * HALF + R_, C_); }())
    const unsigned kstep = (unsigned)(BK * 2);
    const unsigned hstep = (unsigned)(HALF * K * 2);
    const unsigned ldsw = (unsigned)wid * 1024u;
    const int aoff = F8 ? lds_byte(wr * 64 + fr, fq * 16) : lds_byte(wr * 64 + fr, fq * 8), boff = F8 ? lds_byte(wc * 32 + fr, fq * 16) : lds_byte(wc * 32 + fr, fq * 8);
    const __amdgpu_buffer_rsrc_t rsA = __builtin_amdgcn_make_buffer_rsrc((void*)Abase, 0, 0x7fffffff, 0x00020000);
    const __amdgpu_buffer_rsrc_t rsB = __builtin_amdgcn_make_buffer_rsrc((void*)Bbase, 0, 0x7fffffff, 0x00020000);
#define PG8_SA(b, h) (((b) * 2 + (h)) * HTB)
#define PG8_SB(b, h) ((4 + (b) * 2 + (h)) * HTB)
#define PG8_STAGE_B(bufoff, soff) do { const int so_ = __builtin_amdgcn_readfirstlane((int)(soff)); _Pragma("unroll") for (int _i = 0; _i < 2; ++_i) \
        __builtin_amdgcn_raw_ptr_buffer_load_lds(rsB, (LAS void*)(lds + (bufoff) + ldsw + _i * 8192), 16, voffB[_i], so_, 0, 0); } while (0)
#define PG8_STAGE_A(bufoff, kbytes, H, NX) do { const int so_ = __builtin_amdgcn_readfirstlane((int)(kbytes)); unsigned o0_, o1_; \
        if constexpr (Sched::GATHER) { const u32x2 pk_ = *(const LAS u32x2*)((const LAS unsigned char*)park + (((ui + (NX)) & 1) * 8192 + tid * 16 + (H) * 8)); o0_ = pk_.x; o1_ = pk_.y; } else { o0_ = vc0; o1_ = vc1; } \
        __builtin_amdgcn_raw_ptr_buffer_load_lds(rsA, (LAS void*)(lds + (bufoff) + ldsw), 16, o0_, so_, 0, 0); \
        __builtin_amdgcn_raw_ptr_buffer_load_lds(rsA, (LAS void*)(lds + (bufoff) + ldsw + 8192), 16, o1_, so_, 0, 0); } while (0)
#define PG8_LD8(p_) __builtin_shufflevector(*(const LAS v4i32_t*)(p_), *(const LAS v4i32_t*)((p_) + 16), 0, 1, 2, 3, 4, 5, 6, 7)
#define PG8_LDA(dst, b, h) do { if constexpr (F8) { _Pragma("unroll") for (int m = 0; m < 4; ++m) dst##8[m] = PG8_LD8(lds + PG8_SA(b, h) + aoff + m * 2048); } \
        else { _Pragma("unroll") for (int m = 0; m < 4; ++m) _Pragma("unroll") for (int k = 0; k < 2; ++k) dst[m][k] = *(const LAS bf16x8*)(lds + PG8_SA(b, h) + aoff + m * 2048 + k * 1024); } } while (0)
#define PG8_LDB(dst, b, h) do { if constexpr (F8) { _Pragma("unroll") for (int n = 0; n < 2; ++n) dst##8[n] = PG8_LD8(lds + PG8_SB(b, h) + boff + n * 2048); } \
        else { _Pragma("unroll") for (int n = 0; n < 2; ++n) _Pragma("unroll") for (int k = 0; k < 2; ++k) dst[n][k] = *(const LAS bf16x8*)(lds + PG8_SB(b, h) + boff + n * 2048 + k * 1024); } } while (0)
#define PG8_MMA(ai, bj, At, Bt) do { __builtin_amdgcn_s_setprio(1); _Pragma("unroll") for (int m = 0; m < 4; ++m) _Pragma("unroll") for (int n = 0; n < 2; ++n) { \
        if constexpr (F8) { asm volatile("v_mfma_scale_f32_16x16x128_f8f6f4 %0, %1, %2, %0, %3, %3 op_sel_hi:[0,0,0]" : "+v"(acc[ai][bj][m][n]) : "v"(Bt##8[n]), "v"(At##8[m]), "v"(sc1_)); }   \
        else { _Pragma("unroll") for (int k = 0; k < 2; ++k) acc[ai][bj][m][n] = __builtin_amdgcn_mfma_f32_16x16x32_bf16(Bt[n][k], At[m][k], acc[ai][bj][m][n], 0, 0, 0); } } __builtin_amdgcn_s_setprio(0); } while (0)
#define PG8_WAIT_V(n) asm volatile("s_waitcnt vmcnt(" #n ")" ::: "memory")
#define PG8_WAIT_L(n) asm volatile("s_waitcnt lgkmcnt(" #n ")" ::: "memory")
#define PG8_BAR __builtin_amdgcn_s_barrier()
#define PG8_SCHED __builtin_amdgcn_sched_barrier(0)
    Unit cur, nxt; int ui = 0;
    if (!S.next(0, cur)) return;
    float zz_ = 0.f; asm volatile("" : "+v"(zz_));
    int sc1_ = 0x7f7f7f7f; asm volatile("" : "+v"(sc1_));
    LAS u32x4* const park = (LAS u32x4*)(lds + STAGE_BYTES + 8192);
    f32x4 acc[2][2][4][2];
#pragma unroll
    for (int a = 0; a < 2; ++a)
#pragma unroll
        for (int b = 0; b < 2; ++b)
#pragma unroll
            for (int m = 0; m < 4; ++m)
#pragma unroll
                for (int n = 0; n < 2; ++n) acc[a][b][m][n] = (f32x4){zz_, zz_, zz_, zz_};
    bf16x8 At[4][2], B0[2][2], B1[2][2]; v8i32_t At8[4], B08[2], B18[2];
    unsigned vc0 = 0u, vc1 = 0u;
    unsigned cA0, cA1, nA0, nA1;
    if constexpr (Sched::GATHER) { u32x4 pk; pk.x = PG8_AVOFF(cur, 0, 0); pk.y = PG8_AVOFF(cur, 0, 1); pk.z = PG8_AVOFF(cur, 1, 0); pk.w = PG8_AVOFF(cur, 1, 1); park[tid] = pk; }
    else { vc0 = PG8_AVOFF(cur, 0, 0); vc1 = PG8_AVOFF(cur, 0, 1); }
    cA0 = S.a_soff(cur, 0); cA1 = S.a_soff(cur, 1);
    unsigned cB = (unsigned)S.b_off(cur);
    PG8_STAGE_B(PG8_SB(0, 0), cB); PG8_STAGE_B(PG8_SB(0, 1), cB + hstep); PG8_STAGE_A(PG8_SA(0, 0), cA0, 0, 0); PG8_STAGE_A(PG8_SA(0, 1), cA1, 1, 0);
    if (wr == 1) PG8_BAR;
    PG8_WAIT_V(2); PG8_BAR;
    PG8_STAGE_B(PG8_SB(1, 0), cB + kstep); PG8_STAGE_A(PG8_SA(1, 0), cA0 + kstep, 0, 0); PG8_STAGE_B(PG8_SB(1, 1), cB + hstep + kstep);
    PG8_WAIT_V(6); PG8_BAR;
    for (;;) {
#define PG8_TRIP(a1k, a2k0, a2k1, a3k0, b2, b3, NX) do { \
              \
            PG8_LDB(B0, 0, 0); PG8_LDB(B1, 0, 1); PG8_SCHED; PG8_LDA(At, 0, 0); PG8_STAGE_A(PG8_SA(1, 1), a1k, 1, 0); \
            PG8_WAIT_V(8); PG8_WAIT_L(0); PG8_BAR; PG8_MMA(0, 0, At, B0); PG8_MMA(0, 1, At, B1); PG8_BAR; PG8_SCHED; \
              \
            PG8_LDA(At, 0, 1); PG8_STAGE_B(PG8_SB(0, 0), b2); PG8_STAGE_B(PG8_SB(0, 1), (b2) + hstep); PG8_STAGE_A(PG8_SA(0, 0), a2k0, 0, NX); \
            PG8_WAIT_V(8); PG8_WAIT_L(0); PG8_BAR; PG8_MMA(1, 0, At, B0); PG8_MMA(1, 1, At, B1); PG8_BAR; PG8_SCHED; \
              \
            PG8_LDB(B0, 1, 0); PG8_LDB(B1, 1, 1); PG8_SCHED; PG8_LDA(At, 1, 0); PG8_STAGE_A(PG8_SA(0, 1), a2k1, 1, NX); \
            PG8_WAIT_V(8); PG8_WAIT_L(0); PG8_BAR; PG8_MMA(0, 0, At, B0); PG8_MMA(0, 1, At, B1); PG8_BAR; PG8_SCHED; \
              \
            PG8_LDA(At, 1, 1); PG8_STAGE_B(PG8_SB(1, 0), b3); PG8_STAGE_B(PG8_SB(1, 1), (b3) + hstep); PG8_STAGE_A(PG8_SA(1, 0), a3k0, 0, NX); \
            PG8_WAIT_V(8); PG8_WAIT_L(0); PG8_BAR; PG8_MMA(1, 0, At, B0); PG8_MMA(1, 1, At, B1); PG8_BAR; PG8_SCHED; } while (0)
        const bool has_next = S.next(ui + 1, nxt);
        if constexpr (Sched::GATHER) { if (has_next) { u32x4 pk; pk.x = PG8_AVOFF(nxt, 0, 0); pk.y = PG8_AVOFF(nxt, 0, 1); pk.z = PG8_AVOFF(nxt, 1, 0); pk.w = PG8_AVOFF(nxt, 1, 1); park[((ui + 1) & 1) * 512 + tid] = pk; } }
        unsigned nB;
        if (has_next) { nA0 = S.a_soff(nxt, 0); nA1 = S.a_soff(nxt, 1); nB = (unsigned)S.b_off(nxt); }
        else { nA0 = cA0; nA1 = cA1; nB = cB; }
#pragma unroll 1
        for (int t = 0; t < nt; t += 2) {
            const bool last = (t == nt - 2);
            const unsigned k1 = (unsigned)(t + 1) * kstep, k2 = (unsigned)(t + 2) * kstep;
            const unsigned a2k0 = last ? nA0 : cA0 + k2, a2k1 = last ? nA1 : cA1 + k2, b2 = last ? nB : cB + k2;
            const int nx = (last && has_next) ? 1 : 0;
            PG8_TRIP(cA1 + k1, a2k0, a2k1, a2k0 + kstep, b2, b2 + kstep, nx);
        }
#undef PG8_TRIP
        if constexpr (ALIGN_EPI) { if (wr == 0) PG8_BAR; }
        { int tq_ = tid; asm volatile("" : "+v"(tq_));
          const int wq_ = __builtin_amdgcn_readfirstlane(tq_ >> 6); E(acc, cur, wq_ >> 2, wq_ & 3, tq_ & 15, (tq_ & 63) >> 4); }
        if (!has_next) break;
#pragma unroll
        for (int a = 0; a < 2; ++a)
#pragma unroll
            for (int b = 0; b < 2; ++b)
#pragma unroll
                for (int m = 0; m < 4; ++m)
#pragma unroll
                    for (int n = 0; n < 2; ++n) acc[a][b][m][n] = (f32x4){zz_, zz_, zz_, zz_};
        cur = nxt; cB = nB; cA0 = nA0; cA1 = nA1; ++ui;
        if constexpr (ALIGN_EPI) { if (wr == 1) PG8_BAR; }
    }
    PG8_WAIT_V(0);
    if constexpr (!ALIGN_EPI) { if (wr == 0) PG8_BAR; }
    PG8_BAR;
#undef PG8_SA
#undef PG8_AVOFF
#undef PG8_SB
#undef PG8_STAGE_A
#undef PG8_STAGE_B
#undef PG8_LDA
#undef PG8_LDB
#undef PG8_LD8
#undef PG8_MMA
#undef PG8_WAIT_V
#undef PG8_WAIT_L
#undef PG8_BAR
#undef PG8_SCHED
}

struct StaticOrder {
    int nM, nN, nwg, G, c, lda, dup;
    __device__ __forceinline__ void init(int M, int N, int lda_, int G_, int c_) { nM = M / BM; nN = N / BM; nwg = nM * nN; G = G_; c = c_; lda = lda_; dup = 0; }
    __device__ __forceinline__ bool next(int i, Unit& u) const {
        const long L = (long)(i >> dup) * G + c; if (L >= nwg) return false;
        int wgid = (int)L; { const int q = nwg / NXCD, r = nwg % NXCD, xcd = wgid % NXCD, off = wgid / NXCD; wgid = (xcd < r ? xcd * (q + 1) : r * (q + 1) + (xcd - r) * q) + off; }
        const int nig = WGM * nN, gid = wgid / nig, fm = gid * WGM, gsz = (nM - fm) < WGM ? (nM - fm) : WGM;
        u.pm = fm + ((wgid % nig) % gsz); u.pn = (wgid % nig) / gsz; u.e = 0; u.aux = 0; return true;
    }
    static constexpr bool GATHER = false;
    __device__ __forceinline__ unsigned a_voff(const Unit&, int R, int C) const { return (unsigned)((R & (HALF - 1)) * lda + C) * 2u; }
    __device__ __forceinline__ unsigned a_soff(const Unit& u, int h) const { return (unsigned)((u.pm * BM + h * HALF) * lda) * 2u; }
    __device__ __forceinline__ size_t b_off(const Unit& u) const { return (size_t)u.pn * BM * lda * 2; }
};
}

#define XB_TMO      128
#define XB_XCNT(j)  (256  + 64 * (j))
#define XB_XSUB(j)  (1280 + 64 * (j))
#define XB_XGEN(j)  (2304 + 64 * (j))
#define XB_TOP      3328
#define XB_TOPGEN   3392
#define XCD_BAR_WORDS 3456
#define XB_SPIN_CAP (1u << 18)

__device__ __forceinline__ unsigned xb_ld(unsigned* p)              { return __hip_atomic_load(p, __ATOMIC_RELAXED, __HIP_MEMORY_SCOPE_AGENT); }
__device__ __forceinline__ unsigned xb_add(unsigned* p, unsigned v) { return __hip_atomic_fetch_add(p, v, __ATOMIC_RELAXED, __HIP_MEMORY_SCOPE_AGENT); }
__device__ __forceinline__ unsigned xb_xcc_id() { return (unsigned)__builtin_amdgcn_s_getreg((3 << 11) | 20) & 0xFu; }
#define XB_SPIN(cond, bar) do { unsigned _sp = 0; while (cond) { __builtin_amdgcn_s_sleep(1); \
    if ((++_sp & 255u) == 0u) { if (xb_ld(&(bar)[XB_TMO])) break; if (_sp > XB_SPIN_CAP) { atomicAdd(&(bar)[XB_TMO], 1u); break; } } } } while (0)

struct XcdBarrier {
    unsigned* bar; unsigned x;
    volatile LAS unsigned* st;
};

__device__ __forceinline__ XcdBarrier xcd_barrier_post(unsigned* bar, volatile LAS unsigned* st) {
    XcdBarrier b; b.bar = bar; b.x = xb_xcc_id(); b.st = st;
    if (threadIdx.x == 0) (void)xb_add(&bar[XB_XCNT(b.x)], 1u);
    return b;
}
__device__ __forceinline__ void xcd_barrier_complete(unsigned* bar, unsigned x, unsigned& nloc, unsigned& nx) {
    const unsigned G = gridDim.x * gridDim.y * gridDim.z;
    unsigned sum, cnt, mine, sp = 0u;
    for (;;) {
        sum = 0u; cnt = 0u; mine = 0u;
#pragma unroll
        for (unsigned j = 0; j < 16; ++j) { const unsigned c = xb_ld(&bar[XB_XCNT(j)]); sum += c; cnt += (c > 0u) ? 1u : 0u; mine = (j == x) ? c : mine; }
        if (sum == G) break;
        __builtin_amdgcn_s_sleep(1);
        if ((++sp & 255u) == 0u) { if (xb_ld(&bar[XB_TMO])) break; if (sp > XB_SPIN_CAP) { atomicAdd(&bar[XB_TMO], 1u); break; } }
    }
    nloc = mine > 0u ? mine : 1u; nx = cnt > 0u ? cnt : 1u;
}

__device__ __forceinline__ void xcd_barrier(const XcdBarrier& b) {
    asm volatile("s_waitcnt vmcnt(0)" ::: "memory");
    __syncthreads();
    if (threadIdx.x == 0) {
        unsigned* bar = b.bar;
        __builtin_amdgcn_s_waitcnt(0);
        unsigned nloc = b.st[0], nx = b.st[1];
        if (nloc == 0u) { xcd_barrier_complete(bar, b.x, nloc, nx); b.st[0] = nloc; b.st[1] = nx; }
        const unsigned old = xb_add(&bar[XB_XSUB(b.x)], 1u);
        const unsigned gen = old / nloc;
        if (old + 1u == (gen + 1u) * nloc) {
            __builtin_amdgcn_fence(__ATOMIC_RELEASE, "agent");
            asm volatile("s_waitcnt vmcnt(0)" ::: "memory");
            const unsigned og = xb_add(&bar[XB_TOP], 1u);
            const unsigned tg = og / nx;
            if (og + 1u == (tg + 1u) * nx) xb_add(&bar[XB_TOPGEN], 1u);
            else XB_SPIN(xb_ld(&bar[XB_TOPGEN]) == tg, bar);
            __builtin_amdgcn_fence(__ATOMIC_ACQUIRE, "agent");
            xb_add(&bar[XB_XGEN(b.x)], 1u);
            asm volatile("s_waitcnt vmcnt(0)" ::: "memory");
        } else {
            XB_SPIN(xb_ld(&bar[XB_XGEN(b.x)]) == gen, bar);
            __builtin_amdgcn_fence(__ATOMIC_ACQUIRE, "agent");
            asm volatile("s_waitcnt vmcnt(0)" ::: "memory");
        }
    }
    __syncthreads();
}

struct Args { const float* in[23]; float* out; unsigned char* ws; int ph_lo, ph_hi, li, pad; };
#define CAS __attribute__((address_space(4)))
typedef const CAS Args& ArgsRef;
enum { I_X = 0, I_NORM1G, I_WIN, I_POOLW, I_POOLSC, I_CONVW, I_CONVB, I_WA, I_BA, I_WX, I_BX, I_LAM, I_QG, I_KG, I_OG, I_WOUT, I_NORM2G, I_WR, I_BR, I_WGU, I_BGU, I_WD, I_BD };

constexpr float WGU8_SCALE = 64.0f;
struct TrDesc { const float* W; int K, N; bf16* WT; const float* gk; int mode, item; };
__device__ __forceinline__ void tr_load(const TrDesc& d, float (&v)[32], int lane) {
    const int nblk = d.N / 32, kb = d.item / nblk, nb = d.item % nblk, k0 = 64 * kb, n0 = 32 * nb;
#pragma unroll
    for (int i = 0; i < 32; ++i) { const int kk = 2 * i + (lane >> 5); v[i] = d.W[(size_t)(k0 + kk) * d.N + n0 + (lane & 31)]; }
}
__device__ __forceinline__ void tr_finish(const TrDesc& d, float (&v)[32], LAS float* scr, int lane) {
    const int nblk = d.N / 32, kb = d.item / nblk, nb = d.item % nblk, k0 = 64 * kb, n0 = 32 * nb; const int K = d.K;
#pragma unroll
    for (int i = 0; i < 32; ++i) { const int kk = 2 * i + (lane >> 5); float x = v[i]; if (d.gk) x *= d.gk[k0 + kk]; scr[kk * 33 + (lane & 31)] = x; }
    LDS_WAIT(); asm volatile("" ::: "memory");
    const int c = lane & 7;
#pragma unroll
    for (int j = 0; j < 4; ++j) { const int n = (lane >> 3) + 8 * j; const LAS float* s = scr + (8 * c) * 33 + n;
        u32x4 o; o.x = cvt_pk_bf16(s[0 * 33], s[1 * 33]); o.y = cvt_pk_bf16(s[2 * 33], s[3 * 33]); o.z = cvt_pk_bf16(s[4 * 33], s[5 * 33]); o.w = cvt_pk_bf16(s[6 * 33], s[7 * 33]);
        int dn = n0 + n; const int mode = d.mode;
        if (mode == 4) {
            const int jj = dn & 255; dn = (jj >> 7) * 256 + (dn >> 8) * 128 + (jj & 127);
            int w0 = __builtin_amdgcn_cvt_pk_fp8_f32(s[0 * 33] * WGU8_SCALE, s[1 * 33] * WGU8_SCALE, 0, false); w0 = __builtin_amdgcn_cvt_pk_fp8_f32(s[2 * 33] * WGU8_SCALE, s[3 * 33] * WGU8_SCALE, w0, true);
            int w1 = __builtin_amdgcn_cvt_pk_fp8_f32(s[4 * 33] * WGU8_SCALE, s[5 * 33] * WGU8_SCALE, 0, false); w1 = __builtin_amdgcn_cvt_pk_fp8_f32(s[6 * 33] * WGU8_SCALE, s[7 * 33] * WGU8_SCALE, w1, true);
            *(u32x2*)((unsigned char*)d.WT + (size_t)dn * K + k0 + 8 * c) = (u32x2){(unsigned)w0, (unsigned)w1}; continue; }
        if (mode == 1) { const int jj = dn & 255; dn = (jj >> 7) * 256 + (dn >> 8) * 128 + (jj & 127); }
        if (mode == 3 || (mode == 2 && (dn < C_Q || dn >= C_V))) {
            const int L = dn & 255; dn = (dn & ~255) + 128 * ((L >> 3) & 1) + 32 * (L >> 6) + 8 * ((L >> 4) & 3) + (L & 7); }
        else if (mode == 2) {
            const int rem = (dn - C_Q) & 511, sec = (dn - C_Q) >> 9, head = rem >> 6, d2 = rem & 63;
            dn = C_Q + sec * 512 + (head >> 2) * 256 + (d2 >> 5) * 128 + (head & 3) * 32 + (d2 & 31); }
        *(u32x4*)(d.WT + (size_t)dn * K + k0 + 8 * c) = o; }
    LDS_WAIT(); asm volatile("" ::: "memory");
}
__device__ __forceinline__ void cvt_row(const float* xrow, bf16* orow, float* ssq, int lane) {
    const f32x4* xr = (const f32x4*)xrow + lane;
    f32x4 v[4]; float s = 0.f;
#pragma unroll
    for (int j = 0; j < 4; ++j) { v[j] = xr[64 * j]; s += (v[j].x * v[j].x + v[j].y * v[j].y) + (v[j].z * v[j].z + v[j].w * v[j].w); }
    s = wave_sum(s);
    u32x2* o8 = (u32x2*)orow + lane;
#pragma unroll
    for (int j = 0; j < 4; ++j) { u32x2 w; w.x = cvt_pk_bf16(v[j].x, v[j].y); w.y = cvt_pk_bf16(v[j].z, v[j].w); o8[64 * j] = w; }
    if (lane == 0) *ssq = s;
}
__device__ __forceinline__ TrDesc tr_desc(ArgsRef a, int it) {
    unsigned char* ws = a.ws;
    constexpr int I_IN = 16 * 72, I_OUT = 16 * 32, I_R = 16, I_GU = 16 * 16, I_D = 4 * 32, I_S = 2;
    constexpr int PER_LAYER = I_IN + I_OUT + I_R + NEXP * I_GU + NEXP * I_D + 12 * I_S;
    const int l = it / PER_LAYER; int r = it % PER_LAYER; TrDesc d;
    if (r < I_IN) { d = TrDesc{a.in[I_WIN] + (size_t)l * DM * NIN, DM, NIN, (bf16*)(ws + WS_WIN) + (size_t)l * NIN * DM, a.in[I_NORM1G] + l * DM, 2, r}; return d; } r -= I_IN;
    if (r < I_OUT) { d = TrDesc{a.in[I_WOUT] + (size_t)l * DM * DM, DM, DM, (bf16*)(ws + WS_WOUT) + (size_t)l * DM * DM, a.in[I_OG] + l * DM, 3, r}; return d; } r -= I_OUT;
    if (r < I_R) { d = TrDesc{a.in[I_WR] + (size_t)l * DM * NEXP, DM, NEXP, (bf16*)(ws + WS_SMALL) + SM_WR + (size_t)l * NEXP * DM, a.in[I_NORM2G] + l * DM, 0, r}; return d; } r -= I_R;
    if (r < NEXP * I_GU) { const int e = r / I_GU; d = TrDesc{a.in[I_WGU] + (size_t)(l * NEXP + e) * DM * 512, DM, 512, (bf16*)(ws + WS_WGU + (size_t)(l * NEXP + e) * 512 * DM), a.in[I_NORM2G] + l * DM, 4, r % I_GU}; return d; } r -= NEXP * I_GU;
    if (r < NEXP * I_D) { const int e = r / I_D; d = TrDesc{a.in[I_WD] + (size_t)(l * NEXP + e) * EFF * DM, EFF, DM, (bf16*)(ws + WS_WD) + (size_t)(l * NEXP + e) * DM * EFF, nullptr, 3, r % I_D}; return d; } r -= NEXP * I_D;
    { const int which = r / (4 * I_S), g = (r / I_S) % 4, sub = r % I_S;
      const float* src = a.in[which == 0 ? I_POOLW : (which == 1 ? I_WA : I_WX)] + (size_t)(l * 4 + g) * 4096;
      bf16* dst = (bf16*)(ws + WS_SMALL) + (which == 0 ? SM_POOLW : (which == 1 ? SM_WA : SM_WX)) + (size_t)(l * 4 + g) * 4096;
      d = TrDesc{src, 64, 64, dst, nullptr, 0, sub}; return d; }
}
__device__ __forceinline__ void phase_prologue(ArgsRef a, LAS unsigned char* lds, int wv) {
    const int tid = tid_from(wv), lane = tid & 63, wave = tid >> 6;
    LAS float* scr = (LAS float*)(lds + wave * 16384);
    const int gw = blockIdx.x * NWAVES + wave, NGW = gridDim.x * NWAVES;
    unsigned char* ws = a.ws;
    constexpr int PER_LAYER = 16 * 72 + 16 * 32 + 16 + NEXP * 16 * 16 + NEXP * 4 * 32 + 12 * 2;
    { int it = gw; float cur[32], nxt[32];
      TrDesc dc = tr_desc(a, it < 2 * PER_LAYER ? it : 0), dn = dc;
      if (it < 2 * PER_LAYER) tr_load(dc, cur, lane);
      while (it < 2 * PER_LAYER) { const int itn = it + NGW;
          if (itn < 2 * PER_LAYER) { dn = tr_desc(a, itn); tr_load(dn, nxt, lane); }
          tr_finish(dc, cur, scr, lane);
#pragma unroll
          for (int i = 0; i < 32; ++i) cur[i] = nxt[i];
          dc = dn; it = itn; } }
    { float* ct = (float*)(ws + WS_ROPE); float* st = ct + SEQ * 32;
      for (int idx = blockIdx.x * NTHR + tid; idx < SEQ * 32; idx += gridDim.x * NTHR) {
          const int pos = idx >> 5, i = idx & 31;
          const float inv = __builtin_amdgcn_exp2f(-(float)i * 0.41524101186092029f);
          const float ang = (float)pos * inv;
          const double rev = (double)ang * 0.15915494309189535; const double fr = rev - __builtin_rint(rev);
          const float f = (float)fr;
          ct[idx] = __builtin_amdgcn_cosf(f); st[idx] = __builtin_amdgcn_sinf(f); } }
    { const float* __restrict__ X = a.in[I_X]; bf16* __restrict__ xb = (bf16*)(ws + WS_XB); float* __restrict__ ssq = (float*)(ws + WS_SSQ);
      for (int m0 = gw * 4; m0 < NT; m0 += NGW * 4) { f32x4 v[4][4];
#pragma unroll
          for (int u = 0; u < 4; ++u)
#pragma unroll
              for (int j = 0; j < 4; ++j) v[u][j] = *((const f32x4*)(X + (size_t)(m0 + u) * DM) + lane + 64 * j);
#pragma unroll
          for (int u = 0; u < 4; ++u) { float s = 0.f;
#pragma unroll
              for (int j = 0; j < 4; ++j) s += (v[u][j].x * v[u][j].x + v[u][j].y * v[u][j].y) + (v[u][j].z * v[u][j].z + v[u][j].w * v[u][j].w);
              s = wave_sum(s);
#pragma unroll
              for (int j = 0; j < 4; ++j) { u32x2 w; w.x = cvt_pk_bf16(v[u][j].x, v[u][j].y); w.y = cvt_pk_bf16(v[u][j].z, v[u][j].w); *((u32x2*)(xb + (size_t)(m0 + u) * DM) + lane + 64 * j) = w; }
              if (lane == 0) ssq[m0 + u] = s; } } }
}

struct EpiIn {
    static constexpr bool PERM = true;
    bf16* O; const float* ssq; const float* qg; const float* kg; const float* ct; const float* st;
    __device__ __forceinline__ void operator()(const f32x4 (&acc)[2][2][4][2], const pg8::Unit& u, int wr, int wc, int fr, int fq) const {
        const int row0 = u.pm * 256 + wr * 64 + fr, col0 = u.pn * 256 + wc * 32 + 8 * fq;
        if (u.pn >= 3 && u.pn < 7) {
            const bool isq = u.pn < 5; const float* gp = (isq ? qg : kg) + 8 * fq; const float gs = isq ? (0.125f * 1.4426950408889634f) : 1.0f;
            f32x4 g[2][2];
#pragma unroll
            for (int bj = 0; bj < 2; ++bj)
#pragma unroll
                for (int n = 0; n < 2; ++n) g[bj][n] = *(const f32x4*)(gp + 32 * bj + 4 * n) * gs;
#pragma unroll
            for (int ai = 0; ai < 2; ++ai)
#pragma unroll
                for (int m = 0; m < 4; ++m) { const int row = row0 + ai * 128 + m * 16; const float rs = __builtin_amdgcn_rsqf(ssq[row] * (1.0f / DM) + EPS);
                    const int pos = row & (SEQ - 1);
                    const f32x4 c0 = *(const f32x4*)(ct + pos * 32 + 8 * fq), c1 = *(const f32x4*)(ct + pos * 32 + 8 * fq + 4), s0 = *(const f32x4*)(st + pos * 32 + 8 * fq), s1 = *(const f32x4*)(st + pos * 32 + 8 * fq + 4);
                    f32x4 v[2][2]; float ss = 0.f;
#pragma unroll
                    for (int bj = 0; bj < 2; ++bj)
#pragma unroll
                        for (int n = 0; n < 2; ++n) { v[bj][n] = acc[ai][bj][m][n] * rs; ss += (v[bj][n][0] * v[bj][n][0] + v[bj][n][1] * v[bj][n][1]) + (v[bj][n][2] * v[bj][n][2] + v[bj][n][3] * v[bj][n][3]); }
                    ss += __shfl_xor(ss, 16); ss += __shfl_xor(ss, 32);
                    const float rr = __builtin_amdgcn_rsqf(ss * (1.0f / 64.0f) + EPS);
#pragma unroll
                    for (int bj = 0; bj < 2; ++bj)
#pragma unroll
                        for (int n = 0; n < 2; ++n) v[bj][n] = v[bj][n] * rr * g[bj][n];
                    const f32x4 o00 = v[0][0] * c0 - v[1][0] * s0, o01 = v[0][1] * c1 - v[1][1] * s1, o10 = v[1][0] * c0 + v[0][0] * s0, o11 = v[1][1] * c1 + v[0][1] * s1;
                    bf16* rowp = O + (size_t)row * NIN + col0;
                    u32x4 w; w.x = cvt_pk_bf16(o00[0], o00[1]); w.y = cvt_pk_bf16(o00[2], o00[3]); w.z = cvt_pk_bf16(o01[0], o01[1]); w.w = cvt_pk_bf16(o01[2], o01[3]);
                    *(u32x4*)(rowp) = w;
                    w.x = cvt_pk_bf16(o10[0], o10[1]); w.y = cvt_pk_bf16(o10[2], o10[3]); w.z = cvt_pk_bf16(o11[0], o11[1]); w.w = cvt_pk_bf16(o11[2], o11[3]);
                    *(u32x4*)(rowp + 128) = w; }
            return;
        }
#pragma unroll
        for (int ai = 0; ai < 2; ++ai)
#pragma unroll
            for (int m = 0; m < 4; ++m) { const int row = row0 + ai * 128 + m * 16; const float rs = __builtin_amdgcn_rsqf(ssq[row] * (1.0f / DM) + EPS);
                bf16* rowp = O + (size_t)row * NIN + u.pn * 256 + wc * 64 + fq * 16;
#pragma unroll
                for (int bj = 0; bj < 2; ++bj) { const f32x4 v0 = acc[ai][bj][m][0] * rs, v1 = acc[ai][bj][m][1] * rs;
                    u32x4 w; w.x = cvt_pk_bf16(v0[0], v0[1]); w.y = cvt_pk_bf16(v0[2], v0[3]); w.z = cvt_pk_bf16(v1[0], v1[1]); w.w = cvt_pk_bf16(v1[2], v1[3]);
                    *(u32x4*)(rowp + bj * 8) = w; } }
    }
};
struct EpiOut {
    static constexpr bool PERM = true;
    bf16* xb; float* ssqp; unsigned char* xb8;
    __device__ __forceinline__ void operator()(const f32x4 (&acc)[2][2][4][2], const pg8::Unit& u, int wr, int wc, int fr, int fq) const {
        const int row0 = u.pm * 256 + wr * 64 + fr, col0 = u.pn * 256 + wc * 64 + fq * 16;
#pragma unroll
        for (int am = 0; am < 4; ++am) { u32x4 xi[2][2];
#pragma unroll
            for (int mm = 0; mm < 2; ++mm) { const int ai = am >> 1, m = (am & 1) * 2 + mm; const size_t off = (size_t)(row0 + ai * 128 + m * 16) * DM + col0; xi[mm][0] = *(const u32x4*)(xb + off); xi[mm][1] = *(const u32x4*)(xb + off + 8); }
            asm volatile("" ::: "memory");
#pragma unroll
            for (int mm = 0; mm < 2; ++mm) { const int ai = am >> 1, m = (am & 1) * 2 + mm; const int row = row0 + ai * 128 + m * 16; const size_t off = (size_t)row * DM + col0; float s = 0.f; u32x4 w8;
#pragma unroll
                for (int bj = 0; bj < 2; ++bj) { const u32x4 x = xi[mm][bj];
                    const f32x4 o0 = (f32x4){bflo(x.x), bfhi(x.x), bflo(x.y), bfhi(x.y)} + acc[ai][bj][m][0], o1 = (f32x4){bflo(x.z), bfhi(x.z), bflo(x.w), bfhi(x.w)} + acc[ai][bj][m][1];
                    s += ((o0[0] * o0[0] + o0[1] * o0[1]) + (o0[2] * o0[2] + o0[3] * o0[3])) + ((o1[0] * o1[0] + o1[1] * o1[1]) + (o1[2] * o1[2] + o1[3] * o1[3]));
                    u32x4 w; w.x = cvt_pk_bf16(o0[0], o0[1]); w.y = cvt_pk_bf16(o0[2], o0[3]); w.z = cvt_pk_bf16(o1[0], o1[1]); w.w = cvt_pk_bf16(o1[2], o1[3]);
                    *(u32x4*)(xb + off + bj * 8) = w;
                    int f0 = __builtin_amdgcn_cvt_pk_fp8_f32(o0[0], o0[1], 0, false); f0 = __builtin_amdgcn_cvt_pk_fp8_f32(o0[2], o0[3], f0, true);
                    int f1 = __builtin_amdgcn_cvt_pk_fp8_f32(o1[0], o1[1], 0, false); f1 = __builtin_amdgcn_cvt_pk_fp8_f32(o1[2], o1[3], f1, true);
                    if (bj == 0) { w8.x = (unsigned)f0; w8.y = (unsigned)f1; } else { w8.z = (unsigned)f0; w8.w = (unsigned)f1; } }
                *(u32x4*)(xb8 + off) = w8;
                s += __shfl_xor(s, 16); s += __shfl_xor(s, 32);
                if (fq == 0) ssqp[(size_t)row * 16 + u.pn * 4 + wc] = s; }
            asm volatile("" ::: "memory"); }
    }
};

template <int MODE> struct MoeOrder {
    static constexpr bool GATHER = (MODE != 1);
    const LAS int* tab; int npn, G, c; const int* list; int dup;
    __device__ __forceinline__ bool next(int i, pg8::Unit& u) const {
        const int ii = i >> dup; const int total = __builtin_amdgcn_readfirstlane(tab[64]); const int nfr = total / G, nfu = nfr * npn;
        int gb;
        if (ii < nfu) { gb = (ii / npn) * G + c; u.pn = ii % npn; }
        else { const int L = (ii - nfu) * G + c; gb = nfr * G + L / npn; u.pn = L % npn; if (gb >= total) return false; }
        const int e = __builtin_amdgcn_readfirstlane((int)((const LAS unsigned char*)(tab + 80))[gb]);
        u.e = e; u.pm = gb; u.aux = gb - __builtin_amdgcn_readfirstlane(tab[32 + e]); return true;
    }
    __device__ __forceinline__ unsigned a_voff(const pg8::Unit& u, int R, int C) const {
        if constexpr (MODE == 0) { const int pos = u.aux * 256 + R; const int ne = tab[u.e]; int tok = 0; if (pos < ne) tok = list[u.e * NT + pos] >> 2; return (unsigned)(tok * DM + C) * 2u; }
        else if constexpr (MODE == 2) { const int pos = u.aux * 256 + R; const int ne = tab[u.e]; int tok = 0; if (pos < ne) tok = list[u.e * NT + pos] >> 2; return (unsigned)(tok * (DM / 2) + C) * 2u; }
        else return (unsigned)((R & 127) * EFF + C) * 2u;
    }
    __device__ __forceinline__ unsigned a_soff(const pg8::Unit& u, int h) const { if constexpr (MODE != 1) return 0u; else return (unsigned)((u.pm * 256 + h * 128) * EFF) * 2u; }
    __device__ __forceinline__ size_t b_off(const pg8::Unit& u) const {
        if constexpr (MODE == 0) return ((size_t)u.e * 512 + (size_t)u.pn * 256) * DM * 2;
        else if constexpr (MODE == 2) return ((size_t)u.e * 512 + (size_t)u.pn * 256) * DM;
        else return ((size_t)u.e * DM + (size_t)u.pn * 256) * EFF * 2;
    }
};
struct EpiGU {
    static constexpr bool PERM = true;
    bf16* act; const float* lrstd; const float* bgu;
    __device__ __forceinline__ void operator()(const f32x4 (&acc)[2][2][4][2], const pg8::Unit& u, int wr, int wc, int fr, int fq) const {
        const int r0 = wr * 64 + fr, cl0 = wc * 32 + 8 * fq;
        const float* bg = bgu + u.e * 512 + u.pn * 128 + cl0;
        const f32x4 bg0 = *(const f32x4*)(bg), bg1 = *(const f32x4*)(bg + 4), bu0 = *(const f32x4*)(bg + 256), bu1 = *(const f32x4*)(bg + 260);
#pragma unroll
        for (int ai = 0; ai < 2; ++ai)
#pragma unroll
            for (int m = 0; m < 4; ++m) { const int r = r0 + ai * 128 + m * 16; const float rs = lrstd[(size_t)u.e * NT + u.aux * 256 + r] * (1.0f / WGU8_SCALE);
                f32x4 g0 = acc[ai][0][m][0] * rs + bg0, g1 = acc[ai][0][m][1] * rs + bg1, u0 = acc[ai][1][m][0] * rs + bu0, u1 = acc[ai][1][m][1] * rs + bu1;
                float o[8];
#pragma unroll
                for (int j = 0; j < 4; ++j) { const float ga = fminf(g0[j], 7.0f), ua = fminf(fmaxf(u0[j], -7.0f), 7.0f); o[j] = (ua + 1.0f) * ga * fast_sigmoid(1.702f * ga);
                                              const float gb = fminf(g1[j], 7.0f), ub = fminf(fmaxf(u1[j], -7.0f), 7.0f); o[4 + j] = (ub + 1.0f) * gb * fast_sigmoid(1.702f * gb); }
                u32x4 w; w.x = cvt_pk_bf16(o[0], o[1]); w.y = cvt_pk_bf16(o[2], o[3]); w.z = cvt_pk_bf16(o[4], o[5]); w.w = cvt_pk_bf16(o[6], o[7]);
                *(u32x4*)(act + (size_t)(u.pm * 256 + r) * EFF + u.pn * 128 + cl0) = w; }
    }
};
constexpr float Y8_SCALE = 32.0f;
struct EpiDown {
    static constexpr bool PERM = true;
    unsigned char* y; const int* list; const float* lgate; const float* bd; const LAS int* tab;
    __device__ __forceinline__ void operator()(const f32x4 (&acc)[2][2][4][2], const pg8::Unit& u, int wr, int wc, int fr, int fq) const {
        const int r0 = wr * 64 + fr, col0 = u.pn * 256 + wc * 64 + fq * 16; const int ne = tab[u.e];
        const float* bp = bd + u.e * DM + col0;
#pragma unroll
        for (int ai = 0; ai < 2; ++ai) { int asg[4]; float gt[4];
#pragma unroll
            for (int m = 0; m < 4; ++m) { const int pos = u.aux * 256 + r0 + ai * 128 + m * 16; const bool ok = pos < ne;
                asg[m] = ok ? list[(size_t)u.e * NT + pos] : -1; gt[m] = ok ? lgate[(size_t)u.e * NT + pos] * Y8_SCALE : 0.f; }
            asm volatile("" ::: "memory");
#pragma unroll
            for (int m = 0; m < 4; ++m) {
                if (asg[m] >= 0) { unsigned char* rowp = y + (size_t)asg[m] * DM + col0; const float g = gt[m]; u32x4 wv4;
#pragma unroll
                    for (int bj = 0; bj < 2; ++bj) { const f32x4 b0 = *(const f32x4*)(bp + bj * 8), b1 = *(const f32x4*)(bp + bj * 8 + 4);
                        const f32x4 v0 = (acc[ai][bj][m][0] + b0) * g, v1 = (acc[ai][bj][m][1] + b1) * g;
                        int w0 = __builtin_amdgcn_cvt_pk_fp8_f32(v0[0], v0[1], 0, false); w0 = __builtin_amdgcn_cvt_pk_fp8_f32(v0[2], v0[3], w0, true);
                        int w1 = __builtin_amdgcn_cvt_pk_fp8_f32(v1[0], v1[1], 0, false); w1 = __builtin_amdgcn_cvt_pk_fp8_f32(v1[2], v1[3], w1, true);
                        if (bj == 0) { wv4.x = (unsigned)w0; wv4.y = (unsigned)w1; } else { wv4.z = (unsigned)w0; wv4.w = (unsigned)w1; } }
                    *(u32x4*)rowp = wv4; }
                asm volatile("" ::: "memory"); } }
    }
};
__device__ __forceinline__ void moe_tables(LAS int* tab, const unsigned* cnt, int wv) {
    __syncthreads();
    const int tid_ = tid_from(wv);
    if (tid_ == 0) { int pre = 0;
        for (int e = 0; e < NEXP; ++e) { const int n = (int)__hip_atomic_load(cnt + e, RLX_AGENT); tab[e] = n; tab[32 + e] = pre; pre += (n + 255) >> 8; }
        tab[64] = pre; }
    __syncthreads();
    { LAS unsigned char* eb = (LAS unsigned char*)(tab + 80); const int total = tab[64];
      for (int gb = tid_; gb < total; gb += NTHR) { int e = 0;
          for (int k = 1; k < NEXP; ++k) { if (tab[32 + k] <= gb) e = k; }
          eb[gb] = (unsigned char)e; } }
    __syncthreads();
}

__device__ __forceinline__ void phase_qkprep(ArgsRef a, int layer, int wv, bool dry) {
    const int tid = tid_from(wv), lane = tid & 63, wave = tid >> 6;
    const int gw = blockIdx.x * NWAVES + wave, NGW = gridDim.x * NWAVES;
    bf16* proj = (bf16*)(a.ws + WS_PROJ);
    const float* __restrict__ ct = (const float*)(a.ws + WS_ROPE); const float* __restrict__ st = ct + SEQ * 32;
    const int d0 = (lane & 7) * 8, p0 = d0 & 31;
    float gq[8], gk[8];
#pragma unroll
    for (int j = 0; j < 8; ++j) { gq[j] = a.in[I_QG][layer * 64 + d0 + j] * (0.125f * 1.4426950408889634f); gk[j] = a.in[I_KG][layer * 64 + d0 + j]; }
    const bool second = (lane & 4) != 0;
    constexpr int TB = 4;
    for (int t0 = gw * TB; t0 < NT; t0 += NGW * TB) {
        u32x4 w[TB][2]; f32x4 cs[TB][4];
#pragma unroll
        for (int u = 0; u < TB; ++u) { const int t = t0 + u, pos = t & (SEQ - 1);
            w[u][0] = *(const u32x4*)(proj + (size_t)t * NIN + C_Q + lane * 8); w[u][1] = *(const u32x4*)(proj + (size_t)t * NIN + C_Q + 512 + lane * 8);
            cs[u][0] = *(const f32x4*)(ct + pos * 32 + p0); cs[u][1] = *(const f32x4*)(ct + pos * 32 + p0 + 4); cs[u][2] = *(const f32x4*)(st + pos * 32 + p0); cs[u][3] = *(const f32x4*)(st + pos * 32 + p0 + 4); }
#pragma unroll
        for (int u = 0; u < TB; ++u) { const int t = t0 + u;
            float c[8], s[8];
#pragma unroll
            for (int j = 0; j < 4; ++j) { c[j] = cs[u][0][j]; c[4 + j] = cs[u][1][j]; s[j] = cs[u][2][j]; s[4 + j] = cs[u][3][j]; }
#pragma unroll
            for (int i = 0; i < 2; ++i) {
                const u32x4 ww = w[u][i];
                float x[8]; x[0] = bflo(ww.x); x[1] = bfhi(ww.x); x[2] = bflo(ww.y); x[3] = bfhi(ww.y); x[4] = bflo(ww.z); x[5] = bfhi(ww.z); x[6] = bflo(ww.w); x[7] = bfhi(ww.w);
                float ss = 0.f;
#pragma unroll
                for (int j = 0; j < 8; ++j) ss += x[j] * x[j];
                ss += __shfl_xor(ss, 1); ss += __shfl_xor(ss, 2); ss += __shfl_xor(ss, 4);
                const float rs = __builtin_amdgcn_rsqf(ss * (1.0f / 64.0f) + EPS);
                float o[8];
#pragma unroll
                for (int j = 0; j < 8; ++j) { const float yv = x[j] * rs * (i == 0 ? gq[j] : gk[j]); const float pv = __shfl_xor(yv, 4);
                    o[j] = second ? (yv * c[j] + pv * s[j]) : (yv * c[j] - pv * s[j]); }
                u32x4 r; r.x = cvt_pk_bf16(o[0], o[1]); r.y = cvt_pk_bf16(o[2], o[3]); r.z = cvt_pk_bf16(o[4], o[5]); r.w = cvt_pk_bf16(o[6], o[7]);
                if (!dry || o[0] == 12345.678f) *(u32x4*)(proj + (size_t)t * NIN + C_Q + i * 512 + lane * 8) = r;
            } }
    }
}

__device__ __forceinline__ void phase_pool(ArgsRef a, LAS unsigned char* lds, int layer, int wv) {
    const int tid = tid_from(wv), lane = tid & 63, wave = __builtin_amdgcn_readfirstlane(tid >> 6);
    const bf16* proj = (const bf16*)(a.ws + WS_PROJ); bf16* YP = (bf16*)(a.ws + WS_YP); float* SSQPOOL = (float*)(a.ws + WS_SSQPOOL);
    const int g = wave & 3, w = 2 << g, lr = lane & 15, lq = lane >> 4;
    constexpr int US = 72;
    LAS bf16* Uw = (LAS bf16*)(lds + wave * 11520);
    LAS bf16* Xw = (LAS bf16*)(lds + wave * 11520 + 6784);
    const bf16* pw = (const bf16*)(a.ws + WS_SMALL) + SM_POOLW + (size_t)(layer * 4 + g) * 4096;
    bf16x8 bw[4][2]; float psc[4];
#pragma unroll
    for (int et = 0; et < 4; ++et) {
#pragma unroll
        for (int ks = 0; ks < 2; ++ks) bw[et][ks] = *(const bf16x8*)(pw + (et * 16 + lr) * 64 + ks * 32 + lq * 8);
        psc[et] = a.in[I_POOLSC][layer * 256 + g * 64 + et * 16 + lr]; }
    __syncthreads();
    const int nstreams = gridDim.x * 2;
    for (int tk = blockIdx.x * 2 + (wave >> 2); tk < NT / 32; tk += nstreams) {
        const int t0 = tk * 32, s0 = t0 & (SEQ - 1);
#pragma unroll
        for (int j = 0; j < 6; ++j) { const int id = lane + 64 * j;
            if (id < 47 * 8) { const int row = id >> 3, c8 = (id & 7) * 8; u32x4 v = {0u, 0u, 0u, 0u};
                if (s0 - 15 + row >= 0) v = *(const u32x4*)(proj + (size_t)(t0 - 15 + row) * NIN + C_POOL + g * 64 + c8);
                *(LAS u32x4*)(Uw + row * US + c8) = v; } }
        LDS_WAIT(); asm volatile("" ::: "memory");
        { float sum = 0.f;
          for (int j = 1; j < w; ++j) sum += bf2f(Uw[(15 - j) * US + lane]);
#pragma unroll 8
          for (int tl = 0; tl < 32; ++tl) { const float cur = bf2f(Uw[(15 + tl) * US + lane]); sum += cur;
              const int cnt = min(w, s0 + tl + 1); const float pooled = sum * __builtin_amdgcn_rcpf((float)cnt) - cur;
              Xw[tl * US + lane] = f2bf(pooled); sum -= bf2f(Uw[(15 + tl - w + 1) * US + lane]); } }
        LDS_WAIT(); asm volatile("" ::: "memory");
        f32x4 acc[2][4];
#pragma unroll
        for (int rt = 0; rt < 2; ++rt) { const bf16x8 a0 = *(const LAS bf16x8*)(Xw + (rt * 16 + lr) * US + lq * 8), a1 = *(const LAS bf16x8*)(Xw + (rt * 16 + lr) * US + 32 + lq * 8);
#pragma unroll
            for (int et = 0; et < 4; ++et) { acc[rt][et] = __builtin_amdgcn_mfma_f32_16x16x32_bf16(a0, bw[et][0], (f32x4){0.f, 0.f, 0.f, 0.f}, 0, 0, 0); acc[rt][et] = __builtin_amdgcn_mfma_f32_16x16x32_bf16(a1, bw[et][1], acc[rt][et], 0, 0, 0); } }
#pragma unroll
        for (int rt = 0; rt < 2; ++rt)
#pragma unroll
            for (int reg = 0; reg < 4; ++reg) { const int tl = rt * 16 + lq * 4 + reg; float s = 0.f;
#pragma unroll
                for (int et = 0; et < 4; ++et) { const float y = acc[rt][et][reg] * psc[et]; s += y * y; Uw[tl * 64 + et * 16 + lr] = f2bf(y); }
                s += __shfl_xor(s, 1); s += __shfl_xor(s, 2); s += __shfl_xor(s, 4); s += __shfl_xor(s, 8);
                if (lr == 0) SSQPOOL[(size_t)(t0 + tl) * 4 + g] = s; }
        LDS_WAIT(); asm volatile("" ::: "memory");
#pragma unroll
        for (int j = 0; j < 4; ++j) { const int id = lane + 64 * j, row = id >> 3, c8 = (id & 7) * 8;
            *(u32x4*)(YP + (size_t)(t0 + row) * 256 + g * 64 + c8) = *(const LAS u32x4*)(Uw + row * 64 + c8); }
        LDS_WAIT(); asm volatile("" ::: "memory");
    }
}

__device__ __forceinline__ void phase_lru_a(ArgsRef a, LAS unsigned char* lds, int layer, int wv) {
    const int tid = tid_from(wv), lane = tid & 63, wave = __builtin_amdgcn_readfirstlane(tid >> 6);
    const bf16* proj = (const bf16*)(a.ws + WS_PROJ);
    bf16* HL = (bf16*)(a.ws + WS_HL); bf16* PL = (bf16*)(a.ws + WS_PL);
    float* AGGH = (float*)(a.ws + WS_AGGH); float* AGGP = (float*)(a.ws + WS_AGGP);
    const int n = wave & 3, lr = lane & 15, lq = lane >> 4;
    constexpr int US = 72;
    LAS bf16* Uw = (LAS bf16*)(lds + wave * 13824);
    LAS bf16* Xw = (LAS bf16*)(lds + wave * 13824 + 5120);
    LAS bf16* Pw = (LAS bf16*)(lds + wave * 13824 + 9728);
    const int chl = n * 64 + lane;
    const float cw0 = a.in[I_CONVW][(layer * 4 + 0) * 256 + chl], cw1 = a.in[I_CONVW][(layer * 4 + 1) * 256 + chl], cw2 = a.in[I_CONVW][(layer * 4 + 2) * 256 + chl], cw3 = a.in[I_CONVW][(layer * 4 + 3) * 256 + chl];
    const float cb = a.in[I_CONVB][layer * 256 + chl];
    const bf16* wa = (const bf16*)(a.ws + WS_SMALL) + SM_WA + (size_t)(layer * 4 + n) * 4096;
    const bf16* wx = (const bf16*)(a.ws + WS_SMALL) + SM_WX + (size_t)(layer * 4 + n) * 4096;
    bf16x8 ba[4][2], bx[4][2]; float bav[4], bxv[4], sp[4];
#pragma unroll
    for (int et = 0; et < 4; ++et) {
#pragma unroll
        for (int ks = 0; ks < 2; ++ks) { const int wo = (et * 16 + lr) * 64 + ks * 32 + lq * 8; ba[et][ks] = *(const bf16x8*)(wa + wo); bx[et][ks] = *(const bf16x8*)(wx + wo); }
        const int chn = layer * 256 + n * 64 + et * 16 + lr; bav[et] = a.in[I_BA][chn]; bxv[et] = a.in[I_BX][chn]; sp[et] = log1pf(expf(-a.in[I_LAM][chn])); }
    __syncthreads();
    const int nstreams = gridDim.x * 2;
    for (int ck = blockIdx.x * 2 + (wave >> 2); ck < NT / LRU_CH; ck += nstreams) {
        const int t0 = ck * LRU_CH, s0 = t0 & (SEQ - 1);
#pragma unroll
        for (int j = 0; j < 5; ++j) { const int id = lane + 64 * j;
            if (id < 35 * 8) { const int row = id >> 3, c8 = (id & 7) * 8; u32x4 w = {0u, 0u, 0u, 0u};
                if (s0 - 3 + row >= 0) w = *(const u32x4*)(proj + (size_t)(t0 - 3 + row) * NIN + C_LRU + n * 64 + c8);
                *(LAS u32x4*)(Uw + row * US + c8) = w; } }
        LDS_WAIT(); asm volatile("" ::: "memory");
        { float u0 = bf2f(Uw[0 * US + lane]), u1 = bf2f(Uw[1 * US + lane]), u2 = bf2f(Uw[2 * US + lane]);
#pragma unroll 8
          for (int tl = 0; tl < LRU_CH; ++tl) { const float u3 = bf2f(Uw[(tl + 3) * US + lane]); const float xc = cb + cw0 * u0 + cw1 * u1 + cw2 * u2 + cw3 * u3;
              Xw[tl * US + lane] = f2bf(xc); u0 = u1; u1 = u2; u2 = u3; } }
        LDS_WAIT(); asm volatile("" ::: "memory");
        f32x4 ca[2][4], cx[2][4];
#pragma unroll
        for (int rt = 0; rt < 2; ++rt) { const bf16x8 a0 = *(const LAS bf16x8*)(Xw + (rt * 16 + lr) * US + lq * 8), a1 = *(const LAS bf16x8*)(Xw + (rt * 16 + lr) * US + 32 + lq * 8);
#pragma unroll
            for (int et = 0; et < 4; ++et) { ca[rt][et] = __builtin_amdgcn_mfma_f32_16x16x32_bf16(a0, ba[et][0], (f32x4){0.f, 0.f, 0.f, 0.f}, 0, 0, 0); ca[rt][et] = __builtin_amdgcn_mfma_f32_16x16x32_bf16(a1, ba[et][1], ca[rt][et], 0, 0, 0);
                                              cx[rt][et] = __builtin_amdgcn_mfma_f32_16x16x32_bf16(a0, bx[et][0], (f32x4){0.f, 0.f, 0.f, 0.f}, 0, 0, 0); cx[rt][et] = __builtin_amdgcn_mfma_f32_16x16x32_bf16(a1, bx[et][1], cx[rt][et], 0, 0, 0); } }
#pragma unroll
        for (int et = 0; et < 4; ++et) {
            float Pl[2][4], Hl[2][4], At[2], Ht[2];
#pragma unroll
            for (int rt = 0; rt < 2; ++rt) { float P = 1.f, H = 0.f;
#pragma unroll
                for (int reg = 0; reg < 4; ++reg) { const int tl = rt * 16 + lq * 4 + reg;
                    const float r = fast_sigmoid(ca[rt][et][reg] + bav[et]), ig = fast_sigmoid(cx[rt][et][reg] + bxv[et]);
                    const float log_a = -8.0f * r * sp[et]; const float av = fast_exp(log_a);
                    float mult = sqrtf(fmaxf(1.0f - fast_exp(2.0f * log_a), 0.f)); if (s0 + tl == 0) mult = 1.0f;
                    const float bv = mult * ig * bf2f(Xw[tl * US + et * 16 + lr]);
                    H = av * H + bv; P *= av; Pl[rt][reg] = P; Hl[rt][reg] = H; }
                At[rt] = P; Ht[rt] = H; }
            float Ai[2], Hi[2];
#pragma unroll
            for (int rt = 0; rt < 2; ++rt) { float A = At[rt], H = Ht[rt];
                { const float Ap = __shfl_up(A, 16), Hp = __shfl_up(H, 16); if (lq >= 1) { H = A * Hp + H; A = A * Ap; } }
                { const float Ap = __shfl_up(A, 32), Hp = __shfl_up(H, 32); if (lq >= 2) { H = A * Hp + H; A = A * Ap; } }
                Ai[rt] = A; Hi[rt] = H; }
            float Ac[2], Hc[2];
#pragma unroll
            for (int rt = 0; rt < 2; ++rt) { const float Ap = __shfl_up(Ai[rt], 16), Hp = __shfl_up(Hi[rt], 16); Ac[rt] = (lq >= 1) ? Ap : 1.f; Hc[rt] = (lq >= 1) ? Hp : 0.f; }
            const float A0t = __shfl(Ai[0], 48 + lr), H0t = __shfl(Hi[0], 48 + lr);
            Hc[1] = Ac[1] * H0t + Hc[1]; Ac[1] = Ac[1] * A0t;
#pragma unroll
            for (int rt = 0; rt < 2; ++rt)
#pragma unroll
                for (int reg = 0; reg < 4; ++reg) { const int tl = rt * 16 + lq * 4 + reg;
                    Uw[tl * 64 + et * 16 + lr] = f2bf(Hl[rt][reg] + Pl[rt][reg] * Hc[rt]); Pw[tl * 64 + et * 16 + lr] = f2bf(Pl[rt][reg] * Ac[rt]); }
            if (lq == 3) { const size_t o = (size_t)ck * 256 + n * 64 + et * 16 + lr;
                AGGP[o] = Ai[1] * A0t; AGGH[o] = Ai[1] * H0t + Hi[1]; }
        }
        LDS_WAIT(); asm volatile("" ::: "memory");
#pragma unroll
        for (int j = 0; j < 4; ++j) { const int id = lane + 64 * j, row = id >> 3, c8 = (id & 7) * 8;
            *(u32x4*)(HL + (size_t)(t0 + row) * 256 + n * 64 + c8) = *(const LAS u32x4*)(Uw + row * 64 + c8);
            *(u32x4*)(PL + (size_t)(t0 + row) * 256 + n * 64 + c8) = *(const LAS u32x4*)(Pw + row * 64 + c8); }
        LDS_WAIT(); asm volatile("" ::: "memory");
    }
}
__device__ __forceinline__ void phase_lru_b(ArgsRef a, int wv) {
    const float* __restrict__ AGGH = (const float*)(a.ws + WS_AGGH); const float* __restrict__ AGGP = (const float*)(a.ws + WS_AGGP); float* __restrict__ CARRY = (float*)(a.ws + WS_CARRY);
    const int tid_ = tid_from(wv);
    for (int idx = blockIdx.x * NTHR + tid_; idx < NB * 256; idx += gridDim.x * NTHR) { const int b = idx >> 8, c = idx & 255; float carry = 0.f;
        for (int k0 = 0; k0 < LRU_NCH; k0 += 16) { float pp[16], hh[16];
#pragma unroll
            for (int k = 0; k < 16; ++k) { const size_t o = (size_t)(b * LRU_NCH + k0 + k) * 256 + c; pp[k] = AGGP[o]; hh[k] = AGGH[o]; }
#pragma unroll
            for (int k = 0; k < 16; ++k) { const size_t o = (size_t)(b * LRU_NCH + k0 + k) * 256 + c; CARRY[o] = carry; carry = pp[k] * carry + hh[k]; } } }
}
typedef short v4i16_t __attribute__((ext_vector_type(4)));
struct AttnUnit { int h, n, r, dl, g, first; size_t rowb; };
__device__ __forceinline__ AttnUnit attn_unit(int bh, int hf, int i) {
    AttnUnit u; u.h = bh & 7; u.rowb = (size_t)(bh >> 3) * SEQ;
    if (i < 16) { u.g = 0; u.dl = 1; u.r = 0; u.n = 16 * hf + i; u.first = (i == 0); }
    else if (i < 32) { const int j = i - 16; u.g = 1; u.dl = 4; u.r = 2 * hf + (j >> 3); u.n = j & 7; u.first = (u.n == 0); }
    else { const int j = i - 32; u.g = 2; u.dl = 16; u.r = 8 * hf + (j >> 1); u.n = j & 1; u.first = (u.n == 0); }
    return u;
}
__device__ __forceinline__ void attn_dma_chunk(const __amdgpu_buffer_rsrc_t rs, LAS unsigned char* lds, const AttnUnit& u, int chunk, int slot, int wave, int lane) {
    const int csc = (lane & 7) ^ ((lane >> 3) & 7);
#pragma unroll
    for (int q = 0; q < 2; ++q) { const int pc = wave + 8 * q, l = 128 * chunk + 8 * pc + (lane >> 3);
        const unsigned rowoff = (unsigned)((u.rowb + (size_t)l * u.dl + u.r) * NIN * 2);
        const unsigned srcK = rowoff + (unsigned)((C_K + (u.h >> 2) * 256 + (u.h & 3) * 32) * 2) + (unsigned)((csc >> 2) * 256 + (csc & 3) * 16);
        const unsigned srcV = rowoff + (unsigned)((C_V + u.h * 64) * 2) + (unsigned)(csc * 16);
        LAS unsigned char* dst = lds + slot * 32768 + pc * 1024;
        __builtin_amdgcn_raw_ptr_buffer_load_lds(rs, (LAS void*)dst, 16, srcK, 0, 0, 0);
        __builtin_amdgcn_raw_ptr_buffer_load_lds(rs, (LAS void*)(dst + 16384), 16, srcV, 0, 0, 0); }
}
__device__ __forceinline__ void phase_attn(ArgsRef a, LAS unsigned char* lds, int wv) {
    const int tid = tid_from(wv), lane = tid & 63, wave = __builtin_amdgcn_readfirstlane(tid >> 6);
    const bf16* proj = (const bf16*)(a.ws + WS_PROJ);
    bf16* PNUM = (bf16*)(a.ws + WS_PNUM); float* PDEN = (float*)(a.ws + WS_PDEN); float* PMAX = (float*)(a.ws + WS_PMAX);
    const __amdgpu_buffer_rsrc_t rs = __builtin_amdgcn_make_buffer_rsrc((void*)proj, 0, 0x7fffffff, 0x00020000);
    const int lr = lane & 15, lq = lane >> 4, qi0 = 16 * wave, G = gridDim.x;
    float zz_ = 0.f; asm volatile("" : "+v"(zz_));
    const int kc0 = ((0 + lq) ^ (lr & 7)) * 16, kc1 = ((4 + lq) ^ (lr & 7)) * 16;
    const int q4 = (lane & 15) >> 2, p4 = lane & 3, vsw = (4 * lq + q4) & 7;
    unsigned chv[4];
#pragma unroll
    for (int dt = 0; dt < 4; ++dt) chv[dt] = (unsigned)(((2 * dt + (p4 >> 1)) ^ vsw) * 16 + (p4 & 1) * 8);
    const bool xo = (G == 256);
    const int pair = xo ? ((int)(blockIdx.x & 7) * 16 + (int)(blockIdx.x >> 4)) : (int)(blockIdx.x >> 1), hf = xo ? (int)((blockIdx.x >> 3) & 1) : (int)(blockIdx.x & 1), npairs = G >> 1;
    __syncthreads();
    { unsigned z0 = 0u; asm volatile("" : "+v"(z0));
      for (int z = tid; z < RING_BYTES / 16; z += NTHR) ((LAS u32x4*)lds)[z] = (u32x4){z0, z0, z0, z0}; }
    __syncthreads();
    const int total = (pair < 128 && (int)blockIdx.x < 2 * npairs) ? ((128 - pair + npairs - 1) / npairs) * 48 : 0;
    AttnUnit cu = attn_unit(pair < 128 ? pair : 0, hf, 0);
    const int off = (total > 0 && cu.n > 0) ? 1 : 0;
#define ATT_UNIT_AT(k) attn_unit(pair + ((k) / 48) * npairs, hf, (k) % 48)
#define ATT_QLOAD(U, Q0, Q1) do { const size_t qrow_ = (U).rowb + (size_t)(128 * (U).n + qi0 + lr) * (U).dl + (U).r; const int qc_ = C_Q + ((U).h >> 2) * 256 + ((U).h & 3) * 32 + lq * 8; \
        Q0 = *(const bf16x8*)(proj + qrow_ * NIN + qc_); Q1 = *(const bf16x8*)(proj + qrow_ * NIN + qc_ + 128); } while (0)
    bf16x8 qf0, qf1, nq0, nq1;
    if (total > 0) { if (off) attn_dma_chunk(rs, lds, cu, cu.n - 1, 0, wave, lane);
        attn_dma_chunk(rs, lds, cu, cu.n, off & 3, wave, lane); ATT_QLOAD(cu, qf0, qf1);
        if (total > 1) { const AttnUnit u1 = ATT_UNIT_AT(1); attn_dma_chunk(rs, lds, u1, u1.n, (1 + off) & 3, wave, lane); } }
    nq0 = qf0; nq1 = qf1;
    asm volatile("s_waitcnt vmcnt(0)" ::: "memory");
    int idx = 0;
    while (idx < total) {
        asm volatile("s_waitcnt vmcnt(8)" ::: "memory"); __builtin_amdgcn_s_barrier(); asm volatile("" ::: "memory");
        const int csc = (idx + off) & 3, csp = cu.first ? ((cu.n > 0) ? 0 : csc) : ((idx + off + 3) & 3);
        AttnUnit nu = cu;
        if (idx + 1 < total) { nu = ATT_UNIT_AT(idx + 1); ATT_QLOAD(nu, nq0, nq1); }
        if (idx + 2 < total) { const AttnUnit u2 = ATT_UNIT_AT(idx + 2); attn_dma_chunk(rs, lds, u2, u2.n, (idx + 2 + off) & 3, wave, lane); }
        ++idx;
        f32x4 scv[9];
#pragma unroll
        for (int t = 0; t < 9; ++t) { const int wt = wave + t; const LAS unsigned char* Kt = lds + ((wt >= 8) ? csc : csp) * 32768 + ((16 * wt) & 127) * 128 + lr * 128;
            const bf16x8 k0 = *(const LAS bf16x8*)(Kt + kc0), k1 = *(const LAS bf16x8*)(Kt + kc1);
            scv[t] = __builtin_amdgcn_mfma_f32_16x16x32_bf16(k0, qf0, (f32x4){0.f, 0.f, 0.f, 0.f}, 0, 0, 0);
            scv[t] = __builtin_amdgcn_mfma_f32_16x16x32_bf16(k1, qf1, scv[t], 0, 0, 0); }
#pragma unroll
        for (int reg = 0; reg < 4; ++reg) { if (4 * lq + reg < lr) scv[0][reg] = -1e30f; if (4 * lq + reg > lr) scv[8][reg] = -1e30f; }
        if (cu.n == 0) {
#pragma unroll
            for (int t = 0; t < 8; ++t)
#pragma unroll
                for (int reg = 0; reg < 4; ++reg) { if (qi0 + 16 * t + 4 * lq + reg < 128) scv[t][reg] = -1e30f; } }
        float mx = -1e30f;
#pragma unroll
        for (int t = 0; t < 9; ++t)
#pragma unroll
            for (int reg = 0; reg < 4; ++reg) mx = fmaxf(mx, scv[t][reg]);
        mx = fmaxf(mx, __shfl_xor(mx, 16)); mx = fmaxf(mx, __shfl_xor(mx, 32));
        float sm = 0.f;
#pragma unroll
        for (int t = 0; t < 9; ++t)
#pragma unroll
            for (int reg = 0; reg < 4; ++reg) { const float pe = __builtin_amdgcn_exp2f(scv[t][reg] - mx); sm += pe; scv[t][reg] = pe; }
        sm += __shfl_xor(sm, 16); sm += __shfl_xor(sm, 32);
        f32x4 oc[4];
#pragma unroll
        for (int dt = 0; dt < 4; ++dt) oc[dt] = (f32x4){zz_, zz_, zz_, zz_};
#pragma unroll
        for (int pi = 0; pi < 5; ++pi) { const int t0 = 2 * pi, t1 = (2 * pi + 1 < 9) ? 2 * pi + 1 : 8;
            u32x4 pw; pw.x = cvt_pk_bf16(scv[t0][0], scv[t0][1]); pw.y = cvt_pk_bf16(scv[t0][2], scv[t0][3]);
            if (2 * pi + 1 < 9) { pw.z = cvt_pk_bf16(scv[t1][0], scv[t1][1]); pw.w = cvt_pk_bf16(scv[t1][2], scv[t1][3]); } else { pw.z = 0u; pw.w = 0u; }
            const bf16x8 pf = __builtin_bit_cast(bf16x8, pw);
            const int w0 = wave + t0, w1 = wave + t1;
            const LAS unsigned char* V0 = lds + ((w0 >= 8) ? csc : csp) * 32768 + 16384 + (((16 * w0) & 127) + 4 * lq + q4) * 128;
            const LAS unsigned char* V1 = lds + ((w1 >= 8) ? csc : csp) * 32768 + 16384 + (((16 * w1) & 127) + 4 * lq + q4) * 128;
            const unsigned va0 = (unsigned)(unsigned long)V0, va1 = (unsigned)(unsigned long)V1;
            v4i16_t r0[4], r1[4];
#pragma unroll
            for (int dt = 0; dt < 4; ++dt) { asm volatile("ds_read_b64_tr_b16 %0, %1" : "=&v"(r0[dt]) : "v"(va0 + chv[dt]) : "memory"); asm volatile("ds_read_b64_tr_b16 %0, %1" : "=&v"(r1[dt]) : "v"(va1 + chv[dt]) : "memory"); }
            asm volatile("s_waitcnt lgkmcnt(0)" : "+v"(r0[0]), "+v"(r0[1]), "+v"(r0[2]), "+v"(r0[3]), "+v"(r1[0]), "+v"(r1[1]), "+v"(r1[2]), "+v"(r1[3]) :: "memory");
#pragma unroll
            for (int dt = 0; dt < 4; ++dt) { const bf16x8 vf = (bf16x8){r0[dt][0], r0[dt][1], r0[dt][2], r0[dt][3], r1[dt][0], r1[dt][1], r1[dt][2], r1[dt][3]};
                oc[dt] = __builtin_amdgcn_mfma_f32_16x16x32_bf16(pf, vf, oc[dt], 0, 0, 0); } }
        { LAS bf16* stg = (LAS bf16*)(lds + OST_OFF + wave * 2048);
#pragma unroll
          for (int reg = 0; reg < 4; ++reg)
#pragma unroll
              for (int dt = 0; dt < 4; ++dt) stg[(4 * lq + reg) * 64 + dt * 16 + lr] = f2bf(oc[dt][reg]);
          LDS_WAIT(); asm volatile("" ::: "memory");
#pragma unroll
          for (int i = 0; i < 2; ++i) { const int qq = i * 8 + (lane >> 3), c8 = (lane & 7) * 8; const u32x4 w = *(const LAS u32x4*)(stg + qq * 64 + c8);
              const size_t tok = cu.rowb + (size_t)(128 * cu.n + qi0 + qq) * cu.dl + cu.r;
              *(u32x4*)(PNUM + ((size_t)cu.g * NT + tok) * 512 + cu.h * 64 + c8) = w; }
          LDS_WAIT(); asm volatile("" ::: "memory"); }
        if (lq == 0) { const size_t tok = cu.rowb + (size_t)(128 * cu.n + qi0 + lr) * cu.dl + cu.r; PDEN[((size_t)cu.g * NT + tok) * 8 + cu.h] = sm; PMAX[((size_t)cu.g * NT + tok) * 8 + cu.h] = mx; }
        cu = nu; qf0 = nq0; qf1 = nq1;
    }
#undef ATT_UNIT_AT
#undef ATT_QLOAD
}
__device__ __forceinline__ void phase_finalize(ArgsRef a, int wv) {
    const int tid = tid_from(wv), lane = tid & 63, wave = tid >> 6;
    const int gw = blockIdx.x * NWAVES + wave, NGW = gridDim.x * NWAVES;
    const bf16* __restrict__ proj = (const bf16*)(a.ws + WS_PROJ); bf16* __restrict__ mix = (bf16*)(a.ws + WS_MIX);
    const bf16* __restrict__ YP = (const bf16*)(a.ws + WS_YP); const float* __restrict__ SSQPOOL = (const float*)(a.ws + WS_SSQPOOL);
    const bf16* __restrict__ HL = (const bf16*)(a.ws + WS_HL); const bf16* __restrict__ PL = (const bf16*)(a.ws + WS_PL); const float* __restrict__ CARRY = (const float*)(a.ws + WS_CARRY);
    const bf16* __restrict__ PNUM = (const bf16*)(a.ws + WS_PNUM); const float* __restrict__ PDEN = (const float*)(a.ws + WS_PDEN); const float* __restrict__ PMAX = (const float*)(a.ws + WS_PMAX);
    const int hd = lane >> 3;
    for (int t = gw; t < NT; t += NGW) {
        const u32x2 ypw = *(const u32x2*)(YP + (size_t)t * 256 + lane * 4); const f32x4 sq = *(const f32x4*)(SSQPOOL + (size_t)t * 4);
        const u32x2 hw = *(const u32x2*)(HL + (size_t)t * 256 + lane * 4), pw = *(const u32x2*)(PL + (size_t)t * 256 + lane * 4), gwd = *(const u32x2*)(proj + (size_t)t * NIN + C_GATE + lane * 4);
        const f32x4 cr = *(const f32x4*)(CARRY + (size_t)(t / LRU_CH) * 256 + lane * 4);
        float m[3], dn[3]; u32x4 nw[3];
#pragma unroll
        for (int g = 0; g < 3; ++g) { m[g] = PMAX[((size_t)g * NT + t) * 8 + hd]; dn[g] = PDEN[((size_t)g * NT + t) * 8 + hd]; nw[g] = *(const u32x4*)(PNUM + ((size_t)g * NT + t) * 512 + lane * 8); }
        { const float rs = __builtin_amdgcn_rsqf(((sq[0] + sq[1]) + (sq[2] + sq[3])) * (1.0f / 256.0f) + EPS);
          u32x2 o; o.x = cvt_pk_bf16(bflo(ypw.x) * rs, bfhi(ypw.x) * rs); o.y = cvt_pk_bf16(bflo(ypw.y) * rs, bfhi(ypw.y) * rs);
          *(u32x2*)(mix + (size_t)t * DM + lane * 4) = o; }
        { float h[4] = {bflo(hw.x) + bflo(pw.x) * cr[0], bfhi(hw.x) + bfhi(pw.x) * cr[1], bflo(hw.y) + bflo(pw.y) * cr[2], bfhi(hw.y) + bfhi(pw.y) * cr[3]};
          const float gt[4] = {bflo(gwd.x), bfhi(gwd.x), bflo(gwd.y), bfhi(gwd.y)};
          float s = 0.f;
#pragma unroll
          for (int j = 0; j < 4; ++j) { h[j] *= gelu_tanh(gt[j]); s += h[j] * h[j]; }
          s = wave_sum(s); const float rs = __builtin_amdgcn_rsqf(s * (1.0f / 256.0f) + EPS);
          u32x2 o; o.x = cvt_pk_bf16(h[0] * rs, h[1] * rs); o.y = cvt_pk_bf16(h[2] * rs, h[3] * rs);
          *(u32x2*)(mix + (size_t)t * DM + 256 + lane * 4) = o; }
        { const float mr = fmaxf(fmaxf(m[0], m[1]), m[2]);
          float o[8] = {0.f, 0.f, 0.f, 0.f, 0.f, 0.f, 0.f, 0.f}; float den = 0.f;
#pragma unroll
          for (int g = 0; g < 3; ++g) { const float wg = __builtin_amdgcn_exp2f(m[g] - mr); den += wg * dn[g];
              o[0] += wg * bflo(nw[g].x); o[1] += wg * bfhi(nw[g].x); o[2] += wg * bflo(nw[g].y); o[3] += wg * bfhi(nw[g].y); o[4] += wg * bflo(nw[g].z); o[5] += wg * bfhi(nw[g].z); o[6] += wg * bflo(nw[g].w); o[7] += wg * bfhi(nw[g].w); }
          const float inv = 1.0f / den; float s = 0.f;
#pragma unroll
          for (int j = 0; j < 8; ++j) { o[j] *= inv; s += o[j] * o[j]; }
          s = wave_sum(s); const float rs = __builtin_amdgcn_rsqf(s * (1.0f / 512.0f) + EPS);
          u32x4 wv4; wv4.x = cvt_pk_bf16(o[0] * rs, o[1] * rs); wv4.y = cvt_pk_bf16(o[2] * rs, o[3] * rs); wv4.z = cvt_pk_bf16(o[4] * rs, o[5] * rs); wv4.w = cvt_pk_bf16(o[6] * rs, o[7] * rs);
          *(u32x4*)(mix + (size_t)t * DM + 512 + lane * 8) = wv4; }
    }
}

__device__ __forceinline__ void phase_router(ArgsRef a, LAS unsigned char* lds, int layer, int wv, bool alloc) {
    const int tid = tid_from(wv), lane = tid & 63, wave = __builtin_amdgcn_readfirstlane(tid >> 6);
    const bf16* xb = (const bf16*)(a.ws + WS_XB); const bf16* wr = (const bf16*)(a.ws + WS_SMALL) + SM_WR + (size_t)layer * NEXP * DM;
    const float* ssqp = (const float*)(a.ws + WS_SSQP); const float* rbias = a.in[I_BR] + layer * NEXP;
    int* LIST = (int*)(a.ws + WS_LIST); float* LRSTD = (float*)(a.ws + WS_LRSTD); float* LGATE = (float*)(a.ws + WS_LGATE2);
    unsigned* cnt = (unsigned*)(a.ws + WS_CTL) + CW_CNT + layer * NEXP;
    float zr_ = 0.f; asm volatile("" : "+v"(zr_));
    LAS float* LG = (LAS float*)lds + wave * 32 * 33;
    LAS int* hist = (LAS int*)(lds + 65536);
    LAS int* base = (LAS int*)(lds + 65536 + 128);
    const int lr = lane & 15, lq = lane >> 4;
    for (int unit = blockIdx.x; unit < NT / 256; unit += gridDim.x) {
        const int tok0 = unit * 256 + wave * 32;
        __syncthreads();
        if (tid < 32) hist[tid] = 0;
        f32x4 acc[2][2];
#pragma unroll
        for (int rt = 0; rt < 2; ++rt)
#pragma unroll
            for (int et = 0; et < 2; ++et) acc[rt][et] = (f32x4){zr_, zr_, zr_, zr_};
#pragma unroll 4
        for (int ks = 0; ks < 32; ++ks) { bf16x8 af[2], bfr[2];
#pragma unroll
            for (int rt = 0; rt < 2; ++rt) af[rt] = *(const bf16x8*)(xb + (size_t)(tok0 + rt * 16 + lr) * DM + ks * 32 + lq * 8);
#pragma unroll
            for (int et = 0; et < 2; ++et) bfr[et] = *(const bf16x8*)(wr + (size_t)(et * 16 + lr) * DM + ks * 32 + lq * 8);
#pragma unroll
            for (int rt = 0; rt < 2; ++rt)
#pragma unroll
                for (int et = 0; et < 2; ++et) acc[rt][et] = __builtin_amdgcn_mfma_f32_16x16x32_bf16(af[rt], bfr[et], acc[rt][et], 0, 0, 0); }
#pragma unroll
        for (int rt = 0; rt < 2; ++rt)
#pragma unroll
            for (int et = 0; et < 2; ++et)
#pragma unroll
                for (int reg = 0; reg < 4; ++reg) LG[(rt * 16 + lq * 4 + reg) * 33 + et * 16 + lr] = acc[rt][et][reg];
        __syncthreads();
        int te[4] = {0, 0, 0, 0}; float tg[4] = {0.f, 0.f, 0.f, 0.f}; int rk[4] = {0, 0, 0, 0}; float rstd = 0.f; const int tok = tok0 + lane;
        if (lane < 32) {
            const float* sp = ssqp + (size_t)tok * 16; float ss = 0.f;
#pragma unroll
            for (int j = 0; j < 16; ++j) ss += sp[j];
            rstd = __builtin_amdgcn_rsqf(ss * (1.0f / DM) + EPS);
            float tv[4] = {-3e38f, -3e38f, -3e38f, -3e38f};
            for (int e = 0; e < NEXP; ++e) { float v = LG[lane * 33 + e] * rstd + rbias[e]; int ve = e;
#pragma unroll
                for (int k = 0; k < 4; ++k) { if (v > tv[k]) { const float tvv = tv[k]; const int tee = te[k]; tv[k] = v; te[k] = ve; v = tvv; ve = tee; } } }
            float z = 0.f;
#pragma unroll
            for (int k = 0; k < 4; ++k) { tg[k] = fast_exp(tv[k] - tv[0]); z += tg[k]; }
            const float iz = 1.0f / z;
#pragma unroll
            for (int k = 0; k < 4; ++k) { tg[k] *= iz; rk[k] = __hip_atomic_fetch_add(&hist[te[k]], 1, __ATOMIC_RELAXED, __HIP_MEMORY_SCOPE_WORKGROUP); }
        }
        __syncthreads();
        if (tid < 32) base[tid] = alloc ? (int)__hip_atomic_fetch_add(cnt + tid, (unsigned)hist[tid], RLX_AGENT) : 0;
        __syncthreads();
        if (lane < 32 && alloc) {
#pragma unroll
            for (int k = 0; k < 4; ++k) { const size_t p = (size_t)te[k] * NT + base[te[k]] + rk[k]; LIST[p] = tok * 4 + k; LRSTD[p] = rstd; LGATE[p] = tg[k]; }
        }
    }
}

__device__ __forceinline__ void phase_combine(ArgsRef a, bool last_layer, int wv, bool dry) {
    const int tid = tid_from(wv), lane = tid & 63, wave = tid >> 6;
    const int gw = blockIdx.x * NWAVES + wave, NGW = gridDim.x * NWAVES;
    const unsigned char* __restrict__ Y = (const unsigned char*)(a.ws + WS_Y); float* __restrict__ out = a.out; bf16* xb = (bf16*)(a.ws + WS_XB); float* __restrict__ ssq = (float*)(a.ws + WS_SSQ);
    typedef float f2v __attribute__((ext_vector_type(2)));
    for (int t = gw; t < NT; t += NGW) {
        const u32x4 x0 = *((const u32x4*)(xb + (size_t)t * DM) + 2 * lane), x1 = *((const u32x4*)(xb + (size_t)t * DM) + 2 * lane + 1);
        u32x4 y[4];
#pragma unroll
        for (int k = 0; k < 4; ++k) y[k] = *((const u32x4*)(Y + ((size_t)t * 4 + k) * DM) + lane);
        float v[16];
        v[0] = bflo(x0.x); v[1] = bfhi(x0.x); v[2] = bflo(x0.y); v[3] = bfhi(x0.y); v[4] = bflo(x0.z); v[5] = bfhi(x0.z); v[6] = bflo(x0.w); v[7] = bfhi(x0.w);
        v[8] = bflo(x1.x); v[9] = bfhi(x1.x); v[10] = bflo(x1.y); v[11] = bfhi(x1.y); v[12] = bflo(x1.z); v[13] = bfhi(x1.z); v[14] = bflo(x1.w); v[15] = bfhi(x1.w);
#pragma unroll
        for (int k = 0; k < 4; ++k)
#pragma unroll
            for (int d = 0; d < 4; ++d) { const int w = (int)y[k][d]; const f2v lo = __builtin_amdgcn_cvt_pk_f32_fp8(w, false), hi = __builtin_amdgcn_cvt_pk_f32_fp8(w, true);
                v[4 * d + 0] += lo.x * (1.0f / Y8_SCALE); v[4 * d + 1] += lo.y * (1.0f / Y8_SCALE); v[4 * d + 2] += hi.x * (1.0f / Y8_SCALE); v[4 * d + 3] += hi.y * (1.0f / Y8_SCALE); }
        float s = 0.f;
#pragma unroll
        for (int j = 0; j < 16; ++j) s += v[j] * v[j];
        if (dry && s != 12345.678f) continue;
        if (last_layer) {
#pragma unroll
            for (int j = 0; j < 4; ++j) *((f32x4*)(out + (size_t)t * DM) + 4 * lane + j) = (f32x4){v[4 * j], v[4 * j + 1], v[4 * j + 2], v[4 * j + 3]};
        } else { s = wave_sum(s);
            u32x4 w0, w1; w0.x = cvt_pk_bf16(v[0], v[1]); w0.y = cvt_pk_bf16(v[2], v[3]); w0.z = cvt_pk_bf16(v[4], v[5]); w0.w = cvt_pk_bf16(v[6], v[7]);
            w1.x = cvt_pk_bf16(v[8], v[9]); w1.y = cvt_pk_bf16(v[10], v[11]); w1.z = cvt_pk_bf16(v[12], v[13]); w1.w = cvt_pk_bf16(v[14], v[15]);
            *((u32x4*)(xb + (size_t)t * DM) + 2 * lane) = w0; *((u32x4*)(xb + (size_t)t * DM) + 2 * lane + 1) = w1;
            if (lane == 0) ssq[t] = s; }
    }
}

constexpr int NPH_LAYER = 13, NPH = 1 + 2 * NPH_LAYER;
enum { PH_GEMM_IN = 0, PH_QKPREP, PH_POOL, PH_LRU_A, PH_LRU_B, PH_ATTN, PH_LRU_C, PH_MERGE, PH_GEMM_OUT, PH_ROUTER, PH_MOE_GU, PH_MOE_DOWN, PH_COMBINE };
#ifndef MK_STOP
#define MK_STOP NPH
#endif
#ifndef MK_SPLIT
#define MK_SPLIT 0
#endif

template <int PHMASK>
__global__ void __launch_bounds__(NTHR, 2) mega_fwd(Args args_by_value) {
    extern __shared__ __attribute__((aligned(16))) unsigned char lds_raw[];
    LAS unsigned char* lds = (LAS unsigned char*)lds_raw;
    const int tid = threadIdx.x;
    int wv = __builtin_amdgcn_readfirstlane(tid >> 6); asm volatile("" : "+s"(wv));
    for (int u = tid; u < (LDS_BYTES - LDSCTL_OFF) / 4; u += NTHR) ((LAS unsigned*)(lds + LDSCTL_OFF))[u] = 0u;
    __syncthreads();
#define ARGS_HERE() const CAS Args* ap_ = (const CAS Args*)__builtin_amdgcn_kernarg_segment_ptr(); asm volatile("" : "+s"(ap_)); ArgsRef args = *ap_; unsigned char* const ws = args.ws; unsigned* const ctl = (unsigned*)(ws + WS_CTL); (void)ctl
    int lo, hi;
    { ARGS_HERE(); lo = args.ph_lo; hi = args.ph_hi; xcd_barrier_post(ctl + CW_BAR + args.li * XCD_BAR_WORDS, (volatile LAS unsigned*)(lds + MISC_OFF) + 8); }
#define EN(p) (((PHMASK) >> (p)) & 1)
#ifndef MK_DUP
#define MK_DUP 0
#endif
#define NREP(p) ((((MK_DUP) >> (p)) & 1) ? 2 : 1)
#define IN(k) (lo <= (k) && (k) < hi)
#define SEAM(k) do { if (IN(k) && IN((k) + 1)) { ARGS_HERE(); XcdBarrier bar_; bar_.bar = ctl + CW_BAR + args.li * XCD_BAR_WORDS; bar_.x = xb_xcc_id(); bar_.st = (volatile LAS unsigned*)(lds + MISC_OFF) + 8; xcd_barrier(bar_); } } while (0)

    if (EN(13) && IN(0)) { ARGS_HERE(); for (int rep_ = 0; rep_ < NREP(13); ++rep_) { phase_prologue(args, lds, wv); } }
    SEAM(0);
    for (int l = 0; l < 2; ++l) {
        const int pb = 1 + NPH_LAYER * l;
        if (EN(PH_GEMM_IN) && IN(pb + PH_GEMM_IN)) { ARGS_HERE();
            pg8::StaticOrder S; S.init(NT, NIN, DM, gridDim.x, blockIdx.x); S.dup = NREP(PH_GEMM_IN) - 1;
            EpiIn E{(bf16*)(ws + WS_PROJ), (const float*)(ws + WS_SSQ), args.in[I_QG] + l * 64, args.in[I_KG] + l * 64, (const float*)(ws + WS_ROPE), (const float*)(ws + WS_ROPE) + SEQ * 32};
            pg8::gemm_phase<EpiIn, pg8::StaticOrder, true>(lds, (const bf16*)(ws + WS_XB), (const bf16*)(ws + WS_WIN) + (size_t)l * NIN * DM, DM, S, E, wv);
        }
        SEAM(pb + PH_GEMM_IN);
        if (EN(PH_POOL) && IN(pb + PH_POOL)) { ARGS_HERE(); for (int rep_ = 0; rep_ < NREP(PH_POOL); ++rep_) { phase_pool(args, lds, l, wv); } }
        if (EN(PH_LRU_A) && IN(pb + PH_LRU_A)) { ARGS_HERE(); for (int rep_ = 0; rep_ < NREP(PH_LRU_A); ++rep_) { phase_lru_a(args, lds, l, wv); } }
        SEAM(pb + PH_LRU_A);
        if (EN(PH_LRU_B) && IN(pb + PH_LRU_B)) { ARGS_HERE(); for (int rep_ = 0; rep_ < NREP(PH_LRU_B); ++rep_) { phase_lru_b(args, wv); } }
        if (EN(PH_ATTN) && IN(pb + PH_ATTN)) { ARGS_HERE(); for (int rep_ = 0; rep_ < NREP(PH_ATTN); ++rep_) { phase_attn(args, lds, wv); } }
        SEAM(pb + PH_ATTN);
        if (EN(PH_LRU_C) && IN(pb + PH_LRU_C)) { ARGS_HERE(); for (int rep_ = 0; rep_ < NREP(PH_LRU_C); ++rep_) { phase_finalize(args, wv); } }
        SEAM(pb + PH_MERGE);
        if (EN(PH_GEMM_OUT) && IN(pb + PH_GEMM_OUT)) { ARGS_HERE();
            __syncthreads();
            pg8::StaticOrder S; S.init(NT, DM, DM, gridDim.x, blockIdx.x); S.dup = (l == 0) ? NREP(PH_GEMM_OUT) - 1 : 0;
            EpiOut E{(bf16*)(ws + WS_XB), (float*)(ws + WS_SSQP), (unsigned char*)(ws + WS_XB8)};
            pg8::gemm_phase<EpiOut, pg8::StaticOrder, true>(lds, (const bf16*)(ws + WS_MIX), (const bf16*)(ws + WS_WOUT) + (size_t)l * DM * DM, DM, S, E, wv);
        }
        SEAM(pb + PH_GEMM_OUT);
        if (EN(PH_ROUTER) && IN(pb + PH_ROUTER)) { ARGS_HERE(); for (int rep_ = 0; rep_ < NREP(PH_ROUTER); ++rep_) { phase_router(args, lds, l, wv, rep_ == NREP(PH_ROUTER) - 1); } }
        SEAM(pb + PH_ROUTER);
        if (EN(PH_MOE_GU) && IN(pb + PH_MOE_GU)) { ARGS_HERE();
            LAS int* tab = (LAS int*)(lds + TAB_OFF);
            moe_tables(tab, ctl + CW_CNT + l * NEXP, wv);
            MoeOrder<2> S{tab, 2, (int)gridDim.x, (int)blockIdx.x, (const int*)(ws + WS_LIST), NREP(PH_MOE_GU) - 1};
            EpiGU E{(bf16*)(ws + WS_ACT), (const float*)(ws + WS_LRSTD), args.in[I_BGU] + (size_t)l * NEXP * 512};
            pg8::gemm_phase<EpiGU, MoeOrder<2>, true, true>(lds, (const bf16*)(ws + WS_XB8), (const bf16*)(ws + WS_WGU + (size_t)l * NEXP * 512 * DM), DM / 2, S, E, wv);
        }
        SEAM(pb + PH_MOE_GU);
        if (EN(PH_MOE_DOWN) && IN(pb + PH_MOE_DOWN)) { ARGS_HERE();
            LAS int* tab = (LAS int*)(lds + TAB_OFF);
            moe_tables(tab, ctl + CW_CNT + l * NEXP, wv);
            MoeOrder<1> S{tab, 4, (int)gridDim.x, (int)blockIdx.x, (const int*)(ws + WS_LIST), NREP(PH_MOE_DOWN) - 1};
            EpiDown E{(unsigned char*)(ws + WS_Y), (const int*)(ws + WS_LIST), (const float*)(ws + WS_LGATE2), args.in[I_BD] + (size_t)l * NEXP * DM, tab};
            pg8::gemm_phase<EpiDown, MoeOrder<1>, true>(lds, (const bf16*)(ws + WS_ACT), (const bf16*)(ws + WS_WD) + (size_t)l * NEXP * DM * EFF, EFF, S, E, wv);
        }
        SEAM(pb + PH_MOE_DOWN);
        if (EN(PH_COMBINE) && IN(pb + PH_COMBINE)) { ARGS_HERE(); for (int rep_ = 0; rep_ < NREP(PH_COMBINE); ++rep_) { phase_combine(args, l == 1, wv, rep_ < NREP(PH_COMBINE) - 1); } }
        SEAM(pb + PH_COMBINE);
    }
#undef IN
#undef SEAM
}

typedef void (*kern_t)(Args);
template <int M> static kern_t kern_of() { return (kern_t)mega_fwd<M>; }
static kern_t phase_kernel(int p) {
    switch (p) { case 0: return kern_of<1 << 0>(); case 1: return kern_of<1 << 1>(); case 2: return kern_of<1 << 2>(); case 3: return kern_of<1 << 3>(); case 4: return kern_of<1 << 4>();
                 case 5: return kern_of<1 << 5>(); case 6: return kern_of<1 << 6>(); case 7: return kern_of<1 << 7>(); case 8: return kern_of<1 << 8>(); case 9: return kern_of<1 << 9>();
                 case 10: return kern_of<1 << 10>(); case 11: return kern_of<1 << 11>(); case 12: return kern_of<1 << 12>(); default: return kern_of<1 << 13>(); }
}
extern "C" void kernel_launch(void* const* d_in, const int* in_sizes, int n_in, void* d_out, int out_size, void* d_ws, size_t ws_size, hipStream_t stream) {
    static int grid = 0;
    if (grid == 0) {
        if (n_in != 23 || in_sizes[0] != NT * DM || out_size != NT * DM || ws_size < WS_END) {
            fprintf(stderr, "kernel_launch: built for 23 inputs, x/out of %d floats, >= %zu bytes of workspace; got n_in %d, in0 %d, out %d, ws %zu; nothing launched\n", NT * DM, (size_t)WS_END, n_in, n_in > 0 ? in_sizes[0] : -1, out_size, ws_size);
            grid = -1; return; }
        int dev = 0, cus = 0;
        if (hipGetDevice(&dev) != hipSuccess || hipDeviceGetAttribute(&cus, hipDeviceAttributeMultiprocessorCount, dev) != hipSuccess) { fprintf(stderr, "kernel_launch: device query failed\n"); grid = -1; return; }
#if MK_SPLIT
        for (int p = 0; p < 14; ++p) if (hipFuncSetAttribute((const void*)phase_kernel(p), hipFuncAttributeMaxDynamicSharedMemorySize, LDS_BYTES) != hipSuccess) { fprintf(stderr, "kernel_launch: hipFuncSetAttribute failed\n"); grid = -1; return; }
#else
        if (hipFuncSetAttribute((const void*)kern_of<0x3fff>(), hipFuncAttributeMaxDynamicSharedMemorySize, LDS_BYTES) != hipSuccess) { fprintf(stderr, "kernel_launch: hipFuncSetAttribute failed\n"); grid = -1; return; }
        int per_cu = 0;
        if (hipOccupancyMaxActiveBlocksPerMultiprocessor(&per_cu, (const void*)kern_of<0x3fff>(), NTHR, LDS_BYTES) != hipSuccess || per_cu < 1)
            fprintf(stderr, "kernel_launch: note: occupancy query reports %d workgroups per CU\n", per_cu);
#endif
        (void)hipGetLastError();
        if (cus != 256) { fprintf(stderr, "kernel_launch: this kernel's unit maps are built for a 256-CU device (one workgroup per CU); found %d CUs; nothing launched\n", cus); grid = -1; return; }
        grid = cus;
    }
    if (grid < 0) return;
    if (hipMemsetAsync((char*)d_ws + WS_CTL, 0, CTL_ZERO_BYTES, stream) != hipSuccess) { fprintf(stderr, "kernel_launch: hipMemsetAsync failed\n"); return; }
    Args a{};
    for (int i = 0; i < 23; ++i) a.in[i] = (const float*)d_in[i];
    a.out = (float*)d_out; a.ws = (unsigned char*)d_ws; a.pad = 0;
#if MK_SPLIT
#ifdef MK_SKIP
    (void)hipMemsetAsync((char*)d_ws + WS_MIX, 0, (size_t)NT * DM * 2, stream);
#endif
    for (int p = 0; p < MK_STOP; ++p) { a.ph_lo = p; a.ph_hi = p + 1; a.li = p;
#ifdef MK_SKIP
        if (p >= 1 && (((MK_SKIP) >> ((p - 1) % NPH_LAYER)) & 1)) continue;
#endif
        hipLaunchKernelGGL(phase_kernel(p == 0 ? 13 : (p - 1) % NPH_LAYER), dim3(grid), dim3(NTHR), LDS_BYTES, stream, a); }
#else
    a.ph_lo = 0; a.ph_hi = NPH; a.li = 0;
    hipLaunchKernelGGL(kern_of<0x3fff>(), dim3(grid), dim3(NTHR), LDS_BYTES, stream, a);
#endif
    const hipError_t le = hipPeekAtLastError();
    if (le != hipSuccess) fprintf(stderr, "kernel_launch: launch failed: %s\n", hipGetErrorName(le));
}
```

```cpp
#include <hip/hip_runtime.h>
#include <cstdio>
#include <cstdint>

#define LAS __attribute__((address_space(3)))
#define GAS __attribute__((address_space(1)))
typedef unsigned short bf16;
typedef short bf16x8 __attribute__((ext_vector_type(8)));
typedef float f32x4 __attribute__((ext_vector_type(4)));
typedef float f32x2 __attribute__((ext_vector_type(2)));
typedef unsigned u32x4 __attribute__((ext_vector_type(4)));
typedef unsigned u32x2 __attribute__((ext_vector_type(2)));

#ifndef MK_VAR
#define MK_VAR 0
#endif
constexpr int NB = 16, SEQ = 4096, DM = 1024, NT = NB * SEQ;
constexpr int NIN = 2304;
constexpr int C_POOL = 0, C_LRU = 256, C_GATE = 512, C_Q = 768, C_K = 1280, C_V = 1792;
constexpr int NEXP = 32, TOPK = 4, EFF = 256;
constexpr int NASSIGN = NT * TOPK;
constexpr int ACT_ROWS = NASSIGN + NEXP * 256;
constexpr float EPS = 1e-6f;
constexpr int NWAVES = 8, NTHR = 512;
constexpr int LRU_CH = 32, LRU_NCH = SEQ / LRU_CH;

constexpr size_t MiB = 1u << 20;
constexpr size_t WS_CTL = 0, CTL_ZERO_BYTES = 1 * MiB;
constexpr size_t WS_ROPE = 1 * MiB;
constexpr size_t WS_SMALL = 2 * MiB;
constexpr size_t WS_WIN = 4 * MiB;
constexpr size_t WS_WOUT = 13 * MiB;
constexpr size_t WS_WGU = 17 * MiB;
constexpr size_t WS_WD = 81 * MiB;
constexpr size_t WS_SSQ = 113 * MiB;
constexpr size_t WS_SSQP = 114 * MiB;
constexpr size_t WS_LIST = 118 * MiB;
constexpr size_t WS_XB = 128 * MiB;
constexpr size_t WS_R = 256 * MiB;
constexpr size_t WS_PROJ = WS_R;
constexpr size_t WS_MIX = WS_R + 288 * MiB;
constexpr size_t WS_PNUM = WS_R + 416 * MiB;
constexpr size_t WS_PDEN = WS_R + 608 * MiB;
constexpr size_t WS_PMAX = WS_R + 614 * MiB;
constexpr size_t WS_HL = WS_R + 620 * MiB;
constexpr size_t WS_PL = WS_R + 652 * MiB;
constexpr size_t WS_AGGH = WS_R + 684 * MiB;
constexpr size_t WS_AGGP = WS_R + 686 * MiB;
constexpr size_t WS_CARRY = WS_R + 688 * MiB;
constexpr size_t WS_YP = WS_R + 690 * MiB;
constexpr size_t WS_SSQPOOL = WS_R + 722 * MiB;
constexpr size_t WS_ACT = WS_R;
constexpr size_t WS_Y = WS_R + 132 * MiB;
constexpr size_t WS_XB8 = WS_R + 420 * MiB;
constexpr size_t WS_LRSTD = WS_R + 644 * MiB;
constexpr size_t WS_LGATE2 = WS_R + 652 * MiB;
constexpr size_t WS_END = 1024 * MiB;
static_assert(WS_CARRY + 2 * MiB <= WS_END && WS_LGATE2 + 8 * MiB <= WS_END, "d_ws map");
constexpr size_t SM_POOLW = 0;
constexpr size_t SM_WA = 32768;
constexpr size_t SM_WX = 65536;
constexpr size_t SM_WR = 98304;
constexpr int CW_BAR = 4096;
constexpr int CW_CNT = 1024;

constexpr int RING_BYTES = 131072;
constexpr int LDSCTL_OFF = RING_BYTES;
constexpr int MISC_OFF = LDSCTL_OFF + 320;
constexpr int TAB_OFF = LDSCTL_OFF + 1024;
constexpr int OST_OFF = RING_BYTES + 8192;
constexpr int LDS_BYTES = 163840;

typedef GAS unsigned gu32;
#define RLX_AGENT __ATOMIC_RELAXED, __HIP_MEMORY_SCOPE_AGENT
#define LDS_WAIT() asm volatile("s_waitcnt lgkmcnt(0)" ::: "memory")
#define VM_WAIT() asm volatile("s_waitcnt vmcnt(0)" ::: "memory")
typedef __bf16 bf16x2_t __attribute__((ext_vector_type(2)));
__device__ __forceinline__ unsigned cvt_pk_bf16(float lo, float hi) { const f32x2 v = {lo, hi}; const bf16x2_t b = __builtin_convertvector(v, bf16x2_t); return __builtin_bit_cast(unsigned, b); }
__device__ __forceinline__ float bflo(unsigned w) { return __uint_as_float(w << 16); }
__device__ __forceinline__ float bfhi(unsigned w) { return __uint_as_float(w & 0xffff0000u); }
__device__ __forceinline__ float bf2f(bf16 h) { return __uint_as_float((unsigned)h << 16); }
__device__ __forceinline__ bf16 f2bf(float f) { return (bf16)(cvt_pk_bf16(f, 0.f) & 0xffffu); }
__device__ __forceinline__ float wave_sum(float v) {
#pragma unroll
    for (int o = 1; o < 64; o <<= 1) v += __shfl_xor(v, o);
    return v;
}
__device__ __forceinline__ float fast_sigmoid(float x) { return __builtin_amdgcn_rcpf(1.0f + __builtin_amdgcn_exp2f(-1.4426950408889634f * x)); }
__device__ __forceinline__ float fast_exp(float x) { return __builtin_amdgcn_exp2f(1.4426950408889634f * x); }
__device__ __forceinline__ float gelu_tanh(float x) {
    const float u = 0.7978845608028654f * (x + 0.044715f * x * x * x);
    return x * fast_sigmoid(2.0f * u);
}
__device__ __forceinline__ int tid_from(int wv) { int ln; asm volatile("v_mbcnt_lo_u32_b32 %0, -1, 0\n\tv_mbcnt_hi_u32_b32 %0, -1, %0" : "=v"(ln)); return wv * 64 + ln; }
namespace pg8 {
constexpr int BM = 256, BK = 64, HALF = 128, HTB = HALF * BK * 2  , STAGE_BYTES = 8 * HTB, NXCD = 8, WGM = 8;

__host__ __device__ __forceinline__ int lds_byte(int r, int c) { const int st = (r >> 4) * 2 + (c >> 5), rr = r & 15, cc = c & 31, ob = rr * 64 + cc * 2; return st * 1024 + (ob ^ (((ob >> 9) & 1) << 5)); }
__host__ __device__ __forceinline__ void stage_rc(int b, int& R, int& C) { const int st = b / 1024, sb = b % 1024, swz = sb ^ (((sb >> 9) & 1) << 5); R = (st >> 1) * 16 + swz / 64; C = (st & 1) * 32 + (swz % 64) / 2; }
__host__ __device__ __forceinline__ int perm32(int rho) { const int n = rho >> 4, i = rho & 15; return 8 * (i >> 2) + 4 * n + (i & 3); }

struct Unit { int pm, pn, e, aux; };

typedef int v8i32_t __attribute__((ext_vector_type(8)));
typedef int v4i32_t __attribute__((ext_vector_type(4)));
__device__ __forceinline__ v8i32_t f8frag(bf16x8 lo, bf16x8 hi) { const u32x4 a = __builtin_bit_cast(u32x4, lo), b = __builtin_bit_cast(u32x4, hi); return (v8i32_t){(int)a.x, (int)a.y, (int)a.z, (int)a.w, (int)b.x, (int)b.y, (int)b.z, (int)b.w}; }
template <class Epi, class Sched, bool ALIGN_EPI, bool F8 = false>
__device__ __forceinline__ void gemm_phase(LAS unsigned char* lds, const bf16* Abase, const bf16* Bbase, const int K, const Sched& S, const Epi& E, const int wv) {
    const int tid = tid_from(wv), wid = __builtin_amdgcn_readfirstlane(tid >> 6), lane = tid & 63, wr = wid >> 2, wc = wid & 3, fr = lane & 15, fq = lane >> 4;
    const int nt = K / BK;
    unsigned voffB[2];
#pragma unroll
    for (int i = 0; i < 2; ++i) { int R, C; stage_rc(tid * 16 + i * 8192, R, C); const int Rb = Epi::PERM ? ((R & ~31) + perm32(R & 31)) : R;
        voffB[i] = (unsigned)(Rb * K + C) * 2u; }
#define PG8_AVOFF(u, h, i) ([&]() { int R_, C_; stage_rc(tid * 16 + (i) * 8192, R_, C_); return S.a_voff((u), (h) * HALF + R_, C_); }())
    const unsigned kstep = (unsigned)(BK * 2);
    const unsigned hstep = (unsigned)(HALF * K * 2);
    const unsigned ldsw = (unsigned)wid * 1024u;
    const int aoff = F8 ? lds_byte(wr * 64 + fr, fq * 16) : lds_byte(wr * 64 + fr, fq * 8), boff = F8 ? lds_byte(wc * 32 + fr, fq * 16) : lds_byte(wc * 32 + fr, fq * 8);
    const __amdgpu_buffer_rsrc_t rsA = __builtin_amdgcn_make_buffer_rsrc((void*)Abase, 0, 0x7fffffff, 0x00020000);
    const __amdgpu_buffer_rsrc_t rsB = __builtin_amdgcn_make_buffer_rsrc((void*)Bbase, 0, 0x7fffffff, 0x00020000);
#define PG8_SA(b, h) (((b) * 2 + (h)) * HTB)
#define PG8_SB(b, h) ((4 + (b) * 2 + (h)) * HTB)
#define PG8_STAGE_B(bufoff, soff) do { const int so_ = __builtin_amdgcn_readfirstlane((int)(soff)); _Pragma("unroll") for (int _i = 0; _i < 2; ++_i) \
        __builtin_amdgcn_raw_ptr_buffer_load_lds(rsB, (LAS void*)(lds + (bufoff) + ldsw + _i * 8192), 16, voffB[_i], so_, 0, 0); } while (0)
#define PG8_STAGE_A(bufoff, kbytes, H, NX) do { const int so_ = __builtin_amdgcn_readfirstlane((int)(kbytes)); unsigned o0_, o1_; \
        if constexpr (Sched::GATHER) { const u32x2 pk_ = *(const LAS u32x2*)((const LAS unsigned char*)park + (((ui + (NX)) & 1) * 8192 + tid * 16 + (H) * 8)); o0_ = pk_.x; o1_ = pk_.y; } else { o0_ = vc0; o1_ = vc1; } \
        __builtin_amdgcn_raw_ptr_buffer_load_lds(rsA, (LAS void*)(lds + (bufoff) + ldsw), 16, o0_, so_, 0, 0); \
        __builtin_amdgcn_raw_ptr_buffer_load_lds(rsA, (LAS void*)(lds + (bufoff) + ldsw + 8192), 16, o1_, so_, 0, 0); } while (0)
#define PG8_LD8(p_) __builtin_shufflevector(*(const LAS v4i32_t*)(p_), *(const LAS v4i32_t*)((p_) + 16), 0, 1, 2, 3, 4, 5, 6, 7)
#define PG8_LDA(dst, b, h) do { if constexpr (F8) { _Pragma("unroll") for (int m = 0; m < 4; ++m) dst##8[m] = PG8_LD8(lds + PG8_SA(b, h) + aoff + m * 2048); } \
        else { _Pragma("unroll") for (int m = 0; m < 4; ++m) _Pragma("unroll") for (int k = 0; k < 2; ++k) dst[m][k] = *(const LAS bf16x8*)(lds + PG8_SA(b, h) + aoff + m * 2048 + k * 1024); } } while (0)
#define PG8_LDB(dst, b, h) do { if constexpr (F8) { _Pragma("unroll") for (int n = 0; n < 2; ++n) dst##8[n] = PG8_LD8(lds + PG8_SB(b, h) + boff + n * 2048); } \
        else { _Pragma("unroll") for (int n = 0; n < 2; ++n) _Pragma("unroll") for (int k = 0; k < 2; ++k) dst[n][k] = *(const LAS bf16x8*)(lds + PG8_SB(b, h) + boff + n * 2048 + k * 1024); } } while (0)
#define PG8_MMA(ai, bj, At, Bt) do { __builtin_amdgcn_s_setprio(1); _Pragma("unroll") for (int m = 0; m < 4; ++m) _Pragma("unroll") for (int n = 0; n < 2; ++n) { \
        if constexpr (F8) { asm volatile("v_mfma_scale_f32_16x16x128_f8f6f4 %0, %1, %2, %0, %3, %3 op_sel_hi:[0,0,0]" : "+v"(acc[ai][bj][m][n]) : "v"(Bt##8[n]), "v"(At##8[m]), "v"(sc1_)); }   \
        else { _Pragma("unroll") for (int k = 0; k < 2; ++k) acc[ai][bj][m][n] = __builtin_amdgcn_mfma_f32_16x16x32_bf16(Bt[n][k], At[m][k], acc[ai][bj][m][n], 0, 0, 0); } } __builtin_amdgcn_s_setprio(0); } while (0)
#define PG8_WAIT_V(n) asm volatile("s_waitcnt vmcnt(" #n ")" ::: "memory")
#define PG8_WAIT_L(n) asm volatile("s_waitcnt lgkmcnt(" #n ")" ::: "memory")
#define PG8_BAR __builtin_amdgcn_s_barrier()
#define PG8_SCHED __builtin_amdgcn_sched_barrier(0)
    Unit cur, nxt; int ui = 0;
    if (!S.next(0, cur)) return;
    float zz_ = 0.f; asm volatile("" : "+v"(zz_));
    int sc1_ = 0x7f7f7f7f; asm volatile("" : "+v"(sc1_));
    LAS u32x4* const park = (LAS u32x4*)(lds + STAGE_BYTES + 8192);
    f32x4 acc[2][2][4][2];
#pragma unroll
    for (int a = 0; a < 2; ++a)
#pragma unroll
        for (int b = 0; b < 2; ++b)
#pragma unroll
            for (int m = 0; m < 4; ++m)
#pragma unroll
                for (int n = 0; n < 2; ++n) acc[a][b][m][n] = (f32x4){zz_, zz_, zz_, zz_};
    bf16x8 At[4][2], B0[2][2], B1[2][2]; v8i32_t At8[4], B08[2], B18[2];
    unsigned vc0 = 0u, vc1 = 0u;
    unsigned cA0, cA1, nA0, nA1;
    if constexpr (Sched::GATHER) { u32x4 pk; pk.x = PG8_AVOFF(cur, 0, 0); pk.y = PG8_AVOFF(cur, 0, 1); pk.z = PG8_AVOFF(cur, 1, 0); pk.w = PG8_AVOFF(cur, 1, 1); park[tid] = pk; }
    else { vc0 = PG8_AVOFF(cur, 0, 0); vc1 = PG8_AVOFF(cur, 0, 1); }
    cA0 = S.a_soff(cur, 0); cA1 = S.a_soff(cur, 1);
    unsigned cB = (unsigned)S.b_off(cur);
    PG8_STAGE_B(PG8_SB(0, 0), cB); PG8_STAGE_B(PG8_SB(0, 1), cB + hstep); PG8_STAGE_A(PG8_SA(0, 0), cA0, 0, 0); PG8_STAGE_A(PG8_SA(0, 1), cA1, 1, 0);
    if (wr == 1) PG8_BAR;
    PG8_WAIT_V(2); PG8_BAR;
    PG8_STAGE_B(PG8_SB(1, 0), cB + kstep); PG8_STAGE_A(PG8_SA(1, 0), cA0 + kstep, 0, 0); PG8_STAGE_B(PG8_SB(1, 1), cB + hstep + kstep);
    PG8_WAIT_V(6); PG8_BAR;
    for (;;) {
#define PG8_TRIP(a1k, a2k0, a2k1, a3k0, b2, b3, NX) do { \
              \
            PG8_LDB(B0, 0, 0); PG8_LDB(B1, 0, 1); PG8_SCHED; PG8_LDA(At, 0, 0); PG8_STAGE_A(PG8_SA(1, 1), a1k, 1, 0); \
            PG8_WAIT_V(8); PG8_WAIT_L(0); PG8_BAR; PG8_MMA(0, 0, At, B0); PG8_MMA(0, 1, At, B1); PG8_BAR; PG8_SCHED; \
              \
            PG8_LDA(At, 0, 1); PG8_STAGE_B(PG8_SB(0, 0), b2); PG8_STAGE_B(PG8_SB(0, 1), (b2) + hstep); PG8_STAGE_A(PG8_SA(0, 0), a2k0, 0, NX); \
            PG8_WAIT_V(8); PG8_WAIT_L(0); PG8_BAR; PG8_MMA(1, 0, At, B0); PG8_MMA(1, 1, At, B1); PG8_BAR; PG8_SCHED; \
              \
            PG8_LDB(B0, 1, 0); PG8_LDB(B1, 1, 1); PG8_SCHED; PG8_LDA(At, 1, 0); PG8_STAGE_A(PG8_SA(0, 1), a2k1, 1, NX); \
            PG8_WAIT_V(8); PG8_WAIT_L(0); PG8_BAR; PG8_MMA(0, 0, At, B0); PG8_MMA(0, 1, At, B1); PG8_BAR; PG8_SCHED; \
              \
            PG8_LDA(At, 1, 1); PG8_STAGE_B(PG8_SB(1, 0), b3); PG8_STAGE_B(PG8_SB(1, 1), (b3) + hstep); PG8_STAGE_A(PG8_SA(1, 0), a3k0, 0, NX); \
            PG8_WAIT_V(8); PG8_WAIT_L(0); PG8_BAR; PG8_MMA(1, 0, At, B0); PG8_MMA(1, 1, At, B1); PG8_BAR; PG8_SCHED; } while (0)
        const bool has_next = S.next(ui + 1, nxt);
        if constexpr (Sched::GATHER) { if (has_next) { u32x4 pk; pk.x = PG8_AVOFF(nxt, 0, 0); pk.y = PG8_AVOFF(nxt, 0, 1); pk.z = PG8_AVOFF(nxt, 1, 0); pk.w = PG8_AVOFF(nxt, 1, 1); park[((ui + 1) & 1) * 512 + tid] = pk; } }
        unsigned nB;
        if (has_next) { nA0 = S.a_soff(nxt, 0); nA1 = S.a_soff(nxt, 1); nB = (unsigned)S.b_off(nxt); }
        else { nA0 = cA0; nA1 = cA1; nB = cB; }
#pragma unroll 1
        for (int t = 0; t < nt; t += 2) {
            const bool last = (t == nt - 2);
            const unsigned k1 = (unsigned)(t + 1) * kstep, k2 = (unsigned)(t + 2) * kstep;
            const unsigned a2k0 = last ? nA0 : cA0 + k2, a2k1 = last ? nA1 : cA1 + k2, b2 = last ? nB : cB + k2;
            const int nx = (last && has_next) ? 1 : 0;
            PG8_TRIP(cA1 + k1, a2k0, a2k1, a2k0 + kstep, b2, b2 + kstep, nx);
        }
#undef PG8_TRIP
        if constexpr (ALIGN_EPI) { if (wr == 0) PG8_BAR; }
        { int tq_ = tid; asm volatile("" : "+v"(tq_));
          const int wq_ = __builtin_amdgcn_readfirstlane(tq_ >> 6); E(acc, cur, wq_ >> 2, wq_ & 3, tq_ & 15, (tq_ & 63) >> 4); }
        if (!has_next) break;
#pragma unroll
        for (int a = 0; a < 2; ++a)
#pragma unroll
            for (int b = 0; b < 2; ++b)
#pragma unroll
                for (int m = 0; m < 4; ++m)
#pragma unroll
                    for (int n = 0; n < 2; ++n) acc[a][b][m][n] = (f32x4){zz_, zz_, zz_, zz_};
        cur = nxt; cB = nB; cA0 = nA0; cA1 = nA1; ++ui;
        if constexpr (ALIGN_EPI) { if (wr == 1) PG8_BAR; }
    }
    PG8_WAIT_V(0);
    if constexpr (!ALIGN_EPI) { if (wr == 0) PG8_BAR; }
    PG8_BAR;
#undef PG8_SA
#undef PG8_AVOFF
#undef PG8_SB
#undef PG8_STAGE_A
#undef PG8_STAGE_B
#undef PG8_LDA
#undef PG8_LDB
#undef PG8_LD8
#undef PG8_MMA
#undef PG8_WAIT_V
#undef PG8_WAIT_L
#undef PG8_BAR
#undef PG8_SCHED
}

struct StaticOrder {
    int nM, nN, nwg, G, c, lda, dup;
    __device__ __forceinline__ void init(int M, int N, int lda_, int G_, int c_) { nM = M / BM; nN = N / BM; nwg = nM * nN; G = G_; c = c_; lda = lda_; dup = 0; }
    __device__ __forceinline__ bool next(int i, Unit& u) const {
        const long L = (long)(i >> dup) * G + c; if (L >= nwg) return false;
        int wgid = (int)L; { const int q = nwg / NXCD, r = nwg % NXCD, xcd = wgid % NXCD, off = wgid / NXCD; wgid = (xcd < r ? xcd * (q + 1) : r * (q + 1) + (xcd - r) * q) + off; }
        const int nig = WGM * nN, gid = wgid / nig, fm = gid * WGM, gsz = (nM - fm) < WGM ? (nM - fm) : WGM;
        u.pm = fm + ((wgid % nig) % gsz); u.pn = (wgid % nig) / gsz; u.e = 0; u.aux = 0; return true;
    }
    static constexpr bool GATHER = false;
    __device__ __forceinline__ unsigned a_voff(const Unit&, int R, int C) const { return (unsigned)((R & (HALF - 1)) * lda + C) * 2u; }
    __device__ __forceinline__ unsigned a_soff(const Unit& u, int h) const { return (unsigned)((u.pm * BM + h * HALF) * lda) * 2u; }
    __device__ __forceinline__ size_t b_off(const Unit& u) const { return (size_t)u.pn * BM * lda * 2; }
};
}

#define XB_TMO      128
#define XB_XCNT(j)  (256  + 64 * (j))
#define XB_XSUB(j)  (1280 + 64 * (j))
#define XB_XGEN(j)  (2304 + 64 * (j))
#define XB_TOP      3328
#define XB_TOPGEN   3392
#define XCD_BAR_WORDS 3456
#define XB_SPIN_CAP (1u << 18)

__device__ __forceinline__ unsigned xb_ld(unsigned* p)              { return __hip_atomic_load(p, __ATOMIC_RELAXED, __HIP_MEMORY_SCOPE_AGENT); }
__device__ __forceinline__ unsigned xb_add(unsigned* p, unsigned v) { return __hip_atomic_fetch_add(p, v, __ATOMIC_RELAXED, __HIP_MEMORY_SCOPE_AGENT); }
__device__ __forceinline__ unsigned xb_xcc_id() { return (unsigned)__builtin_amdgcn_s_getreg((3 << 11) | 20) & 0xFu; }
#define XB_SPIN(cond, bar) do { unsigned _sp = 0; while (cond) { __builtin_amdgcn_s_sleep(1); \
    if ((++_sp & 255u) == 0u) { if (xb_ld(&(bar)[XB_TMO])) break; if (_sp > XB_SPIN_CAP) { atomicAdd(&(bar)[XB_TMO], 1u); break; } } } } while (0)

struct XcdBarrier {
    unsigned* bar; unsigned x;
    volatile LAS unsigned* st;
};

__device__ __forceinline__ XcdBarrier xcd_barrier_post(unsigned* bar, volatile LAS unsigned* st) {
    XcdBarrier b; b.bar = bar; b.x = xb_xcc_id(); b.st = st;
    if (threadIdx.x == 0) (void)xb_add(&bar[XB_XCNT(b.x)], 1u);
    return b;
}
__device__ __forceinline__ void xcd_barrier_complete(unsigned* bar, unsigned x, unsigned& nloc, unsigned& nx) {
    const unsigned G = gridDim.x * gridDim.y * gridDim.z;
    unsigned sum, cnt, mine, sp = 0u;
    for (;;) {
        sum = 0u; cnt = 0u; mine = 0u;
#pragma unroll
        for (unsigned j = 0; j < 16; ++j) { const unsigned c = xb_ld(&bar[XB_XCNT(j)]); sum += c; cnt += (c > 0u) ? 1u : 0u; mine = (j == x) ? c : mine; }
        if (sum == G) break;
        __builtin_amdgcn_s_sleep(1);
        if ((++sp & 255u) == 0u) { if (xb_ld(&bar[XB_TMO])) break; if (sp > XB_SPIN_CAP) { atomicAdd(&bar[XB_TMO], 1u); break; } }
    }
    nloc = mine > 0u ? mine : 1u; nx = cnt > 0u ? cnt : 1u;
}

__device__ __forceinline__ void xcd_barrier(const XcdBarrier& b) {
    asm volatile("s_waitcnt vmcnt(0)" ::: "memory");
    __syncthreads();
    if (threadIdx.x == 0) {
        unsigned* bar = b.bar;
        __builtin_amdgcn_s_waitcnt(0);
        unsigned nloc = b.st[0], nx = b.st[1];
        if (nloc == 0u) { xcd_barrier_complete(bar, b.x, nloc, nx); b.st[0] = nloc; b.st[1] = nx; }
        const unsigned old = xb_add(&bar[XB_XSUB(b.x)], 1u);
        const unsigned gen = old / nloc;
        if (old + 1u == (gen + 1u) * nloc) {
            __builtin_amdgcn_fence(__ATOMIC_RELEASE, "agent");
            asm volatile("s_waitcnt vmcnt(0)" ::: "memory");
            const unsigned og = xb_add(&bar[XB_TOP], 1u);
            const unsigned tg = og / nx;
            if (og + 1u == (tg + 1u) * nx) xb_add(&bar[XB_TOPGEN], 1u);
            else XB_SPIN(xb_ld(&bar[XB_TOPGEN]) == tg, bar);
            __builtin_amdgcn_fence(__ATOMIC_ACQUIRE, "agent");
            xb_add(&bar[XB_XGEN(b.x)], 1u);
            asm volatile("s_waitcnt vmcnt(0)" ::: "memory");
        } else {
            XB_SPIN(xb_ld(&bar[XB_XGEN(b.x)]) == gen, bar);
            __builtin_amdgcn_fence(__ATOMIC_ACQUIRE, "agent");
            asm volatile("s_waitcnt vmcnt(0)" ::: "memory");
        }
    }
    __syncthreads();
}

struct Args { const float* in[23]; float* out; unsigned char* ws; int ph_lo, ph_hi, li, pad; };
#define CAS __attribute__((address_space(4)))
typedef const CAS Args& ArgsRef;
enum { I_X = 0, I_NORM1G, I_WIN, I_POOLW, I_POOLSC, I_CONVW, I_CONVB, I_WA, I_BA, I_WX, I_BX, I_LAM, I_QG, I_KG, I_OG, I_WOUT, I_NORM2G, I_WR, I_BR, I_WGU, I_BGU, I_WD, I_BD };

constexpr float WGU8_SCALE = 64.0f, WD8_SCALE = 64.0f, ACT8_SCALE = 4.0f;
struct TrDesc { const float* W; int K, N; bf16* WT; const float* gk; int mode, item; };
__device__ __forceinline__ void tr_load(const TrDesc& d, float (&v)[32], int lane) {
    const int nblk = d.N / 32, kb = d.item / nblk, nb = d.item % nblk, k0 = 64 * kb, n0 = 32 * nb;
#pragma unroll
    for (int i = 0; i < 32; ++i) { const int kk = 2 * i + (lane >> 5); v[i] = d.W[(size_t)(k0 + kk) * d.N + n0 + (lane & 31)]; }
}
__device__ __forceinline__ void tr_finish(const TrDesc& d, float (&v)[32], LAS float* scr, int lane) {
    const int nblk = d.N / 32, kb = d.item / nblk, nb = d.item % nblk, k0 = 64 * kb, n0 = 32 * nb; const int K = d.K;
#pragma unroll
    for (int i = 0; i < 32; ++i) { const int kk = 2 * i + (lane >> 5); float x = v[i]; if (d.gk) x *= d.gk[k0 + kk]; scr[kk * 33 + (lane & 31)] = x; }
    LDS_WAIT(); asm volatile("" ::: "memory");
    const int c = lane & 7;
#pragma unroll
    for (int j = 0; j < 4; ++j) { const int n = (lane >> 3) + 8 * j; const LAS float* s = scr + (8 * c) * 33 + n;
        u32x4 o; o.x = cvt_pk_bf16(s[0 * 33], s[1 * 33]); o.y = cvt_pk_bf16(s[2 * 33], s[3 * 33]); o.z = cvt_pk_bf16(s[4 * 33], s[5 * 33]); o.w = cvt_pk_bf16(s[6 * 33], s[7 * 33]);
        int dn = n0 + n; const int mode = d.mode;
        if (mode == 5) {
            const int L = dn & 255; dn = (dn & ~255) + 128 * ((L >> 3) & 1) + 32 * (L >> 6) + 8 * ((L >> 4) & 3) + (L & 7);
            int w0 = __builtin_amdgcn_cvt_pk_fp8_f32(s[0 * 33] * WD8_SCALE, s[1 * 33] * WD8_SCALE, 0, false); w0 = __builtin_amdgcn_cvt_pk_fp8_f32(s[2 * 33] * WD8_SCALE, s[3 * 33] * WD8_SCALE, w0, true);
            int w1 = __builtin_amdgcn_cvt_pk_fp8_f32(s[4 * 33] * WD8_SCALE, s[5 * 33] * WD8_SCALE, 0, false); w1 = __builtin_amdgcn_cvt_pk_fp8_f32(s[6 * 33] * WD8_SCALE, s[7 * 33] * WD8_SCALE, w1, true);
            *(u32x2*)((unsigned char*)d.WT + (size_t)dn * K + k0 + 8 * c) = (u32x2){(unsigned)w0, (unsigned)w1}; continue; }
        if (mode == 4) {
            const int jj = dn & 255; dn = (jj >> 7) * 256 + (dn >> 8) * 128 + (jj & 127);
            int w0 = __builtin_amdgcn_cvt_pk_fp8_f32(s[0 * 33] * WGU8_SCALE, s[1 * 33] * WGU8_SCALE, 0, false); w0 = __builtin_amdgcn_cvt_pk_fp8_f32(s[2 * 33] * WGU8_SCALE, s[3 * 33] * WGU8_SCALE, w0, true);
            int w1 = __builtin_amdgcn_cvt_pk_fp8_f32(s[4 * 33] * WGU8_SCALE, s[5 * 33] * WGU8_SCALE, 0, false); w1 = __builtin_amdgcn_cvt_pk_fp8_f32(s[6 * 33] * WGU8_SCALE, s[7 * 33] * WGU8_SCALE, w1, true);
            *(u32x2*)((unsigned char*)d.WT + (size_t)dn * K + k0 + 8 * c) = (u32x2){(unsigned)w0, (unsigned)w1}; continue; }
        if (mode == 1) { const int jj = dn & 255; dn = (jj >> 7) * 256 + (dn >> 8) * 128 + (jj & 127); }
        if (mode == 3 || (mode == 2 && (dn < C_Q || dn >= C_V))) {
            const int L = dn & 255; dn = (dn & ~255) + 128 * ((L >> 3) & 1) + 32 * (L >> 6) + 8 * ((L >> 4) & 3) + (L & 7); }
        else if (mode == 2) {
            const int rem = (dn - C_Q) & 511, sec = (dn - C_Q) >> 9, head = rem >> 6, d2 = rem & 63;
            dn = C_Q + sec * 512 + (head >> 2) * 256 + (d2 >> 5) * 128 + (head & 3) * 32 + (d2 & 31); }
        *(u32x4*)(d.WT + (size_t)dn * K + k0 + 8 * c) = o; }
    LDS_WAIT(); asm volatile("" ::: "memory");
}
__device__ __forceinline__ void cvt_row(const float* xrow, bf16* orow, float* ssq, int lane) {
    const f32x4* xr = (const f32x4*)xrow + lane;
    f32x4 v[4]; float s = 0.f;
#pragma unroll
    for (int j = 0; j < 4; ++j) { v[j] = xr[64 * j]; s += (v[j].x * v[j].x + v[j].y * v[j].y) + (v[j].z * v[j].z + v[j].w * v[j].w); }
    s = wave_sum(s);
    u32x2* o8 = (u32x2*)orow + lane;
#pragma unroll
    for (int j = 0; j < 4; ++j) { u32x2 w; w.x = cvt_pk_bf16(v[j].x, v[j].y); w.y = cvt_pk_bf16(v[j].z, v[j].w); o8[64 * j] = w; }
    if (lane == 0) *ssq = s;
}
__device__ __forceinline__ TrDesc tr_desc(ArgsRef a, int it) {
    unsigned char* ws = a.ws;
    constexpr int I_IN = 16 * 72, I_OUT = 16 * 32, I_R = 16, I_GU = 16 * 16, I_D = 4 * 32, I_S = 2;
    constexpr int PER_LAYER = I_IN + I_OUT + I_R + NEXP * I_GU + NEXP * I_D + 12 * I_S;
    const int l = it / PER_LAYER; int r = it % PER_LAYER; TrDesc d;
    if (r < I_IN) { d = TrDesc{a.in[I_WIN] + (size_t)l * DM * NIN, DM, NIN, (bf16*)(ws + WS_WIN) + (size_t)l * NIN * DM, a.in[I_NORM1G] + l * DM, 2, r}; return d; } r -= I_IN;
    if (r < I_OUT) { d = TrDesc{a.in[I_WOUT] + (size_t)l * DM * DM, DM, DM, (bf16*)(ws + WS_WOUT) + (size_t)l * DM * DM, a.in[I_OG] + l * DM, 3, r}; return d; } r -= I_OUT;
    if (r < I_R) { d = TrDesc{a.in[I_WR] + (size_t)l * DM * NEXP, DM, NEXP, (bf16*)(ws + WS_SMALL) + SM_WR + (size_t)l * NEXP * DM, a.in[I_NORM2G] + l * DM, 0, r}; return d; } r -= I_R;
    if (r < NEXP * I_GU) { const int e = r / I_GU; d = TrDesc{a.in[I_WGU] + (size_t)(l * NEXP + e) * DM * 512, DM, 512, (bf16*)(ws + WS_WGU + (size_t)(l * NEXP + e) * 512 * DM), a.in[I_NORM2G] + l * DM, 4, r % I_GU}; return d; } r -= NEXP * I_GU;
    if (r < NEXP * I_D) { const int e = r / I_D; d = TrDesc{a.in[I_WD] + (size_t)(l * NEXP + e) * EFF * DM, EFF, DM, (bf16*)(ws + WS_WD + (size_t)(l * NEXP + e) * DM * EFF), nullptr, 5, r % I_D}; return d; } r -= NEXP * I_D;
    { const int which = r / (4 * I_S), g = (r / I_S) % 4, sub = r % I_S;
      const float* src = a.in[which == 0 ? I_POOLW : (which == 1 ? I_WA : I_WX)] + (size_t)(l * 4 + g) * 4096;
      bf16* dst = (bf16*)(ws + WS_SMALL) + (which == 0 ? SM_POOLW : (which == 1 ? SM_WA : SM_WX)) + (size_t)(l * 4 + g) * 4096;
      d = TrDesc{src, 64, 64, dst, nullptr, 0, sub}; return d; }
}
__device__ __forceinline__ void phase_prologue(ArgsRef a, LAS unsigned char* lds, int wv) {
    const int tid = tid_from(wv), lane = tid & 63, wave = tid >> 6;
    LAS float* scr = (LAS float*)(lds + wave * 16384);
    const int gw = blockIdx.x * NWAVES + wave, NGW = gridDim.x * NWAVES;
    unsigned char* ws = a.ws;
    constexpr int PER_LAYER = 16 * 72 + 16 * 32 + 16 + NEXP * 16 * 16 + NEXP * 4 * 32 + 12 * 2;
    { int it = gw; float cur[32], nxt[32];
      TrDesc dc = tr_desc(a, it < 2 * PER_LAYER ? it : 0), dn = dc;
      if (it < 2 * PER_LAYER) tr_load(dc, cur, lane);
      while (it < 2 * PER_LAYER) { const int itn = it + NGW;
          if (itn < 2 * PER_LAYER) { dn = tr_desc(a, itn); tr_load(dn, nxt, lane); }
          tr_finish(dc, cur, scr, lane);
#pragma unroll
          for (int i = 0; i < 32; ++i) cur[i] = nxt[i];
          dc = dn; it = itn; } }
    { float* ct = (float*)(ws + WS_ROPE); float* st = ct + SEQ * 32;
      for (int idx = blockIdx.x * NTHR + tid; idx < SEQ * 32; idx += gridDim.x * NTHR) {
          const int pos = idx >> 5, i = idx & 31;
          const float inv = __builtin_amdgcn_exp2f(-(float)i * 0.41524101186092029f);
          const float ang = (float)pos * inv;
          const double rev = (double)ang * 0.15915494309189535; const double fr = rev - __builtin_rint(rev);
          const float f = (float)fr;
          ct[idx] = __builtin_amdgcn_cosf(f); st[idx] = __builtin_amdgcn_sinf(f); } }
    { const float* __restrict__ X = a.in[I_X]; bf16* __restrict__ xb = (bf16*)(ws + WS_XB); float* __restrict__ ssq = (float*)(ws + WS_SSQ);
      for (int m0 = gw * 4; m0 < NT; m0 += NGW * 4) { f32x4 v[4][4];
#pragma unroll
          for (int u = 0; u < 4; ++u)
#pragma unroll
              for (int j = 0; j < 4; ++j) v[u][j] = *((const f32x4*)(X + (size_t)(m0 + u) * DM) + lane + 64 * j);
#pragma unroll
          for (int u = 0; u < 4; ++u) { float s = 0.f;
#pragma unroll
              for (int j = 0; j < 4; ++j) s += (v[u][j].x * v[u][j].x + v[u][j].y * v[u][j].y) + (v[u][j].z * v[u][j].z + v[u][j].w * v[u][j].w);
              s = wave_sum(s);
#pragma unroll
              for (int j = 0; j < 4; ++j) { u32x2 w; w.x = cvt_pk_bf16(v[u][j].x, v[u][j].y); w.y = cvt_pk_bf16(v[u][j].z, v[u][j].w); *((u32x2*)(xb + (size_t)(m0 + u) * DM) + lane + 64 * j) = w; }
              if (lane == 0) ssq[m0 + u] = s; } } }
}

struct EpiIn {
    static constexpr bool PERM = true;
    bf16* O; const float* ssq; const float* qg; const float* kg; const float* ct; const float* st;
    __device__ __forceinline__ void operator()(const f32x4 (&acc)[2][2][4][2], const pg8::Unit& u, int wr, int wc, int fr, int fq) const {
        const int row0 = u.pm * 256 + wr * 64 + fr, col0 = u.pn * 256 + wc * 32 + 8 * fq;
        if (u.pn >= 3 && u.pn < 7) {
            const bool isq = u.pn < 5; const float* gp = (isq ? qg : kg) + 8 * fq; const float gs = isq ? (0.125f * 1.4426950408889634f) : 1.0f;
            f32x4 g[2][2];
#pragma unroll
            for (int bj = 0; bj < 2; ++bj)
#pragma unroll
                for (int n = 0; n < 2; ++n) g[bj][n] = *(const f32x4*)(gp + 32 * bj + 4 * n) * gs;
#pragma unroll
            for (int ai = 0; ai < 2; ++ai)
#pragma unroll
                for (int m = 0; m < 4; ++m) { const int row = row0 + ai * 128 + m * 16; const float rs = __builtin_amdgcn_rsqf(ssq[row] * (1.0f / DM) + EPS);
                    const int pos = row & (SEQ - 1);
                    const f32x4 c0 = *(const f32x4*)(ct + pos * 32 + 8 * fq), c1 = *(const f32x4*)(ct + pos * 32 + 8 * fq + 4), s0 = *(const f32x4*)(st + pos * 32 + 8 * fq), s1 = *(const f32x4*)(st + pos * 32 + 8 * fq + 4);
                    f32x4 v[2][2]; float ss = 0.f;
#pragma unroll
                    for (int bj = 0; bj < 2; ++bj)
#pragma unroll
                        for (int n = 0; n < 2; ++n) { v[bj][n] = acc[ai][bj][m][n] * rs; ss += (v[bj][n][0] * v[bj][n][0] + v[bj][n][1] * v[bj][n][1]) + (v[bj][n][2] * v[bj][n][2] + v[bj][n][3] * v[bj][n][3]); }
                    ss += __shfl_xor(ss, 16); ss += __shfl_xor(ss, 32);
                    const float rr = __builtin_amdgcn_rsqf(ss * (1.0f / 64.0f) + EPS);
#pragma unroll
                    for (int bj = 0; bj < 2; ++bj)
#pragma unroll
                        for (int n = 0; n < 2; ++n) v[bj][n] = v[bj][n] * rr * g[bj][n];
                    const f32x4 o00 = v[0][0] * c0 - v[1][0] * s0, o01 = v[0][1] * c1 - v[1][1] * s1, o10 = v[1][0] * c0 + v[0][0] * s0, o11 = v[1][1] * c1 + v[0][1] * s1;
                    bf16* rowp = O + (size_t)row * NIN + col0;
                    u32x4 w; w.x = cvt_pk_bf16(o00[0], o00[1]); w.y = cvt_pk_bf16(o00[2], o00[3]); w.z = cvt_pk_bf16(o01[0], o01[1]); w.w = cvt_pk_bf16(o01[2], o01[3]);
                    *(u32x4*)(rowp) = w;
                    w.x = cvt_pk_bf16(o10[0], o10[1]); w.y = cvt_pk_bf16(o10[2], o10[3]); w.z = cvt_pk_bf16(o11[0], o11[1]); w.w = cvt_pk_bf16(o11[2], o11[3]);
                    *(u32x4*)(rowp + 128) = w; }
            return;
        }
#pragma unroll
        for (int ai = 0; ai < 2; ++ai)
#pragma unroll
            for (int m = 0; m < 4; ++m) { const int row = row0 + ai * 128 + m * 16; const float rs = __builtin_amdgcn_rsqf(ssq[row] * (1.0f / DM) + EPS);
                bf16* rowp = O + (size_t)row * NIN + u.pn * 256 + wc * 64 + fq * 16;
#pragma unroll
                for (int bj = 0; bj < 2; ++bj) { const f32x4 v0 = acc[ai][bj][m][0] * rs, v1 = acc[ai][bj][m][1] * rs;
                    u32x4 w; w.x = cvt_pk_bf16(v0[0], v0[1]); w.y = cvt_pk_bf16(v0[2], v0[3]); w.z = cvt_pk_bf16(v1[0], v1[1]); w.w = cvt_pk_bf16(v1[2], v1[3]);
                    *(u32x4*)(rowp + bj * 8) = w; } }
    }
};
struct EpiOut {
    static constexpr bool PERM = true;
    bf16* xb; float* ssqp; unsigned char* xb8;
    __device__ __forceinline__ void operator()(const f32x4 (&acc)[2][2][4][2], const pg8::Unit& u, int wr, int wc, int fr, int fq) const {
        const int row0 = u.pm * 256 + wr * 64 + fr, col0 = u.pn * 256 + wc * 64 + fq * 16;
#pragma unroll
        for (int am = 0; am < 4; ++am) { u32x4 xi[2][2];
#pragma unroll
            for (int mm = 0; mm < 2; ++mm) { const int ai = am >> 1, m = (am & 1) * 2 + mm; const size_t off = (size_t)(row0 + ai * 128 + m * 16) * DM + col0; xi[mm][0] = *(const u32x4*)(xb + off); xi[mm][1] = *(const u32x4*)(xb + off + 8); }
            asm volatile("" ::: "memory");
#pragma unroll
            for (int mm = 0; mm < 2; ++mm) { const int ai = am >> 1, m = (am & 1) * 2 + mm; const int row = row0 + ai * 128 + m * 16; const size_t off = (size_t)row * DM + col0; float s = 0.f; u32x4 w8;
#pragma unroll
                for (int bj = 0; bj < 2; ++bj) { const u32x4 x = xi[mm][bj];
                    const f32x4 o0 = (f32x4){bflo(x.x), bfhi(x.x), bflo(x.y), bfhi(x.y)} + acc[ai][bj][m][0], o1 = (f32x4){bflo(x.z), bfhi(x.z), bflo(x.w), bfhi(x.w)} + acc[ai][bj][m][1];
                    s += ((o0[0] * o0[0] + o0[1] * o0[1]) + (o0[2] * o0[2] + o0[3] * o0[3])) + ((o1[0] * o1[0] + o1[1] * o1[1]) + (o1[2] * o1[2] + o1[3] * o1[3]));
                    u32x4 w; w.x = cvt_pk_bf16(o0[0], o0[1]); w.y = cvt_pk_bf16(o0[2], o0[3]); w.z = cvt_pk_bf16(o1[0], o1[1]); w.w = cvt_pk_bf16(o1[2], o1[3]);
                    *(u32x4*)(xb + off + bj * 8) = w;
                    int f0 = __builtin_amdgcn_cvt_pk_fp8_f32(o0[0], o0[1], 0, false); f0 = __builtin_amdgcn_cvt_pk_fp8_f32(o0[2], o0[3], f0, true);
                    int f1 = __builtin_amdgcn_cvt_pk_fp8_f32(o1[0], o1[1], 0, false); f1 = __builtin_amdgcn_cvt_pk_fp8_f32(o1[2], o1[3], f1, true);
                    if (bj == 0) { w8.x = (unsigned)f0; w8.y = (unsigned)f1; } else { w8.z = (unsigned)f0; w8.w = (unsigned)f1; } }
                *(u32x4*)(xb8 + off) = w8;
                s += __shfl_xor(s, 16); s += __shfl_xor(s, 32);
                if (fq == 0) ssqp[(size_t)row * 16 + u.pn * 4 + wc] = s; }
            asm volatile("" ::: "memory"); }
    }
};

template <int MODE> struct MoeOrder {
    static constexpr bool GATHER = (MODE == 0 || MODE == 2);
    const LAS int* tab; int npn, G, c; const int* list; int dup;
    __device__ __forceinline__ bool next(int i, pg8::Unit& u) const {
        const int ii = i >> dup; const int total = __builtin_amdgcn_readfirstlane(tab[64]); const int nfr = total / G, nfu = nfr * npn;
        int gb;
        if (ii < nfu) { gb = (ii / npn) * G + c; u.pn = ii % npn; }
        else { const int L = (ii - nfu) * G + c; gb = nfr * G + L / npn; u.pn = L % npn; if (gb >= total) return false; }
        const int e = __builtin_amdgcn_readfirstlane((int)((const LAS unsigned char*)(tab + 80))[gb]);
        u.e = e; u.pm = gb; u.aux = gb - __builtin_amdgcn_readfirstlane(tab[32 + e]); return true;
    }
    __device__ __forceinline__ unsigned a_voff(const pg8::Unit& u, int R, int C) const {
        if constexpr (MODE == 0) { const int pos = u.aux * 256 + R; const int ne = tab[u.e]; int tok = 0; if (pos < ne) tok = list[u.e * NT + pos] >> 2; return (unsigned)(tok * DM + C) * 2u; }
        else if constexpr (MODE == 2) { const int pos = u.aux * 256 + R; const int ne = tab[u.e]; int tok = 0; if (pos < ne) tok = list[u.e * NT + pos] >> 2; return (unsigned)(tok * (DM / 2) + C) * 2u; }
        else if constexpr (MODE == 3) return (unsigned)((R & 127) * (EFF / 2) + C) * 2u;
        else return (unsigned)((R & 127) * EFF + C) * 2u;
    }
    __device__ __forceinline__ unsigned a_soff(const pg8::Unit& u, int h) const { if constexpr (MODE == 1) return (unsigned)((u.pm * 256 + h * 128) * EFF) * 2u; else if constexpr (MODE == 3) return (unsigned)((u.pm * 256 + h * 128) * EFF); else return 0u; }
    __device__ __forceinline__ size_t b_off(const pg8::Unit& u) const {
        if constexpr (MODE == 0) return ((size_t)u.e * 512 + (size_t)u.pn * 256) * DM * 2;
        else if constexpr (MODE == 2) return ((size_t)u.e * 512 + (size_t)u.pn * 256) * DM;
        else if constexpr (MODE == 3) return ((size_t)u.e * DM + (size_t)u.pn * 256) * EFF;
        else return ((size_t)u.e * DM + (size_t)u.pn * 256) * EFF * 2;
    }
};
struct EpiGU {
    static constexpr bool PERM = true;
    unsigned char* act; const float* lrstd; const float* bgu;
    __device__ __forceinline__ void operator()(const f32x4 (&acc)[2][2][4][2], const pg8::Unit& u, int wr, int wc, int fr, int fq) const {
        const int r0 = wr * 64 + fr, cl0 = wc * 32 + 8 * fq;
        const float* bg = bgu + u.e * 512 + u.pn * 128 + cl0;
        const f32x4 bg0 = *(const f32x4*)(bg), bg1 = *(const f32x4*)(bg + 4), bu0 = *(const f32x4*)(bg + 256), bu1 = *(const f32x4*)(bg + 260);
#pragma unroll
        for (int ai = 0; ai < 2; ++ai)
#pragma unroll
            for (int m = 0; m < 4; ++m) { const int r = r0 + ai * 128 + m * 16; const float rs = lrstd[(size_t)u.e * NT + u.aux * 256 + r] * (1.0f / WGU8_SCALE);
                f32x4 g0 = acc[ai][0][m][0] * rs + bg0, g1 = acc[ai][0][m][1] * rs + bg1, u0 = acc[ai][1][m][0] * rs + bu0, u1 = acc[ai][1][m][1] * rs + bu1;
                float o[8];
#pragma unroll
                for (int j = 0; j < 4; ++j) { const float ga = fminf(g0[j], 7.0f), ua = fminf(fmaxf(u0[j], -7.0f), 7.0f); o[j] = (ua + 1.0f) * ga * fast_sigmoid(1.702f * ga);
                                              const float gb = fminf(g1[j], 7.0f), ub = fminf(fmaxf(u1[j], -7.0f), 7.0f); o[4 + j] = (ub + 1.0f) * gb * fast_sigmoid(1.702f * gb); }
                int w0 = __builtin_amdgcn_cvt_pk_fp8_f32(o[0] * ACT8_SCALE, o[1] * ACT8_SCALE, 0, false); w0 = __builtin_amdgcn_cvt_pk_fp8_f32(o[2] * ACT8_SCALE, o[3] * ACT8_SCALE, w0, true);
                int w1 = __builtin_amdgcn_cvt_pk_fp8_f32(o[4] * ACT8_SCALE, o[5] * ACT8_SCALE, 0, false); w1 = __builtin_amdgcn_cvt_pk_fp8_f32(o[6] * ACT8_SCALE, o[7] * ACT8_SCALE, w1, true);
                *(u32x2*)(act + (size_t)(u.pm * 256 + r) * EFF + u.pn * 128 + cl0) = (u32x2){(unsigned)w0, (unsigned)w1}; }
    }
};
constexpr float Y8_SCALE = 32.0f;
struct EpiDown {
    static constexpr bool PERM = true;
    unsigned char* y; const int* list; const float* lgate; const float* bd; const LAS int* tab;
    __device__ __forceinline__ void operator()(const f32x4 (&acc)[2][2][4][2], const pg8::Unit& u, int wr, int wc, int fr, int fq) const {
        const int r0 = wr * 64 + fr, col0 = u.pn * 256 + wc * 64 + fq * 16; const int ne = tab[u.e];
        const float* bp = bd + u.e * DM + col0;
#pragma unroll
        for (int ai = 0; ai < 2; ++ai) { int asg[4]; float gt[4];
#pragma unroll
            for (int m = 0; m < 4; ++m) { const int pos = u.aux * 256 + r0 + ai * 128 + m * 16; const bool ok = pos < ne;
                asg[m] = ok ? list[(size_t)u.e * NT + pos] : -1; gt[m] = ok ? lgate[(size_t)u.e * NT + pos] * Y8_SCALE : 0.f; }
            asm volatile("" ::: "memory");
#pragma unroll
            for (int m = 0; m < 4; ++m) {
                if (asg[m] >= 0) { unsigned char* rowp = y + (size_t)asg[m] * DM + col0; const float g = gt[m]; u32x4 wv4;
#pragma unroll
                    for (int bj = 0; bj < 2; ++bj) { const f32x4 b0 = *(const f32x4*)(bp + bj * 8), b1 = *(const f32x4*)(bp + bj * 8 + 4);
                        const f32x4 v0 = (acc[ai][bj][m][0] * (1.0f / (WD8_SCALE * ACT8_SCALE)) + b0) * g, v1 = (acc[ai][bj][m][1] * (1.0f / (WD8_SCALE * ACT8_SCALE)) + b1) * g;
                        int w0 = __builtin_amdgcn_cvt_pk_fp8_f32(v0[0], v0[1], 0, false); w0 = __builtin_amdgcn_cvt_pk_fp8_f32(v0[2], v0[3], w0, true);
                        int w1 = __builtin_amdgcn_cvt_pk_fp8_f32(v1[0], v1[1], 0, false); w1 = __builtin_amdgcn_cvt_pk_fp8_f32(v1[2], v1[3], w1, true);
                        if (bj == 0) { wv4.x = (unsigned)w0; wv4.y = (unsigned)w1; } else { wv4.z = (unsigned)w0; wv4.w = (unsigned)w1; } }
                    *(u32x4*)rowp = wv4; }
                asm volatile("" ::: "memory"); } }
    }
};
__device__ __forceinline__ void moe_tables(LAS int* tab, const unsigned* cnt, int wv) {
    __syncthreads();
    const int tid_ = tid_from(wv);
    if (tid_ == 0) { int pre = 0;
        for (int e = 0; e < NEXP; ++e) { const int n = (int)__hip_atomic_load(cnt + e, RLX_AGENT); tab[e] = n; tab[32 + e] = pre; pre += (n + 255) >> 8; }
        tab[64] = pre; }
    __syncthreads();
    { LAS unsigned char* eb = (LAS unsigned char*)(tab + 80); const int total = tab[64];
      for (int gb = tid_; gb < total; gb += NTHR) { int e = 0;
          for (int k = 1; k < NEXP; ++k) { if (tab[32 + k] <= gb) e = k; }
          eb[gb] = (unsigned char)e; } }
    __syncthreads();
}

__device__ __forceinline__ void phase_qkprep(ArgsRef a, int layer, int wv, bool dry) {
    const int tid = tid_from(wv), lane = tid & 63, wave = tid >> 6;
    const int gw = blockIdx.x * NWAVES + wave, NGW = gridDim.x * NWAVES;
    bf16* proj = (bf16*)(a.ws + WS_PROJ);
    const float* __restrict__ ct = (const float*)(a.ws + WS_ROPE); const float* __restrict__ st = ct + SEQ * 32;
    const int d0 = (lane & 7) * 8, p0 = d0 & 31;
    float gq[8], gk[8];
#pragma unroll
    for (int j = 0; j < 8; ++j) { gq[j] = a.in[I_QG][layer * 64 + d0 + j] * (0.125f * 1.4426950408889634f); gk[j] = a.in[I_KG][layer * 64 + d0 + j]; }
    const bool second = (lane & 4) != 0;
    constexpr int TB = 4;
    for (int t0 = gw * TB; t0 < NT; t0 += NGW * TB) {
        u32x4 w[TB][2]; f32x4 cs[TB][4];
#pragma unroll
        for (int u = 0; u < TB; ++u) { const int t = t0 + u, pos = t & (SEQ - 1);
            w[u][0] = *(const u32x4*)(proj + (size_t)t * NIN + C_Q + lane * 8); w[u][1] = *(const u32x4*)(proj + (size_t)t * NIN + C_Q + 512 + lane * 8);
            cs[u][0] = *(const f32x4*)(ct + pos * 32 + p0); cs[u][1] = *(const f32x4*)(ct + pos * 32 + p0 + 4); cs[u][2] = *(const f32x4*)(st + pos * 32 + p0); cs[u][3] = *(const f32x4*)(st + pos * 32 + p0 + 4); }
#pragma unroll
        for (int u = 0; u < TB; ++u) { const int t = t0 + u;
            float c[8], s[8];
#pragma unroll
            for (int j = 0; j < 4; ++j) { c[j] = cs[u][0][j]; c[4 + j] = cs[u][1][j]; s[j] = cs[u][2][j]; s[4 + j] = cs[u][3][j]; }
#pragma unroll
            for (int i = 0; i < 2; ++i) {
                const u32x4 ww = w[u][i];
                float x[8]; x[0] = bflo(ww.x); x[1] = bfhi(ww.x); x[2] = bflo(ww.y); x[3] = bfhi(ww.y); x[4] = bflo(ww.z); x[5] = bfhi(ww.z); x[6] = bflo(ww.w); x[7] = bfhi(ww.w);
                float ss = 0.f;
#pragma unroll
                for (int j = 0; j < 8; ++j) ss += x[j] * x[j];
                ss += __shfl_xor(ss, 1); ss += __shfl_xor(ss, 2); ss += __shfl_xor(ss, 4);
                const float rs = __builtin_amdgcn_rsqf(ss * (1.0f / 64.0f) + EPS);
                float o[8];
#pragma unroll
                for (int j = 0; j < 8; ++j) { const float yv = x[j] * rs * (i == 0 ? gq[j] : gk[j]); const float pv = __shfl_xor(yv, 4);
                    o[j] = second ? (yv * c[j] + pv * s[j]) : (yv * c[j] - pv * s[j]); }
                u32x4 r; r.x = cvt_pk_bf16(o[0], o[1]); r.y = cvt_pk_bf16(o[2], o[3]); r.z = cvt_pk_bf16(o[4], o[5]); r.w = cvt_pk_bf16(o[6], o[7]);
                if (!dry || o[0] == 12345.678f) *(u32x4*)(proj + (size_t)t * NIN + C_Q + i * 512 + lane * 8) = r;
            } }
    }
}

__device__ __forceinline__ void phase_pool(ArgsRef a, LAS unsigned char* lds, int layer, int wv) {
    const int tid = tid_from(wv), lane = tid & 63, wave = __builtin_amdgcn_readfirstlane(tid >> 6);
    const bf16* proj = (const bf16*)(a.ws + WS_PROJ); bf16* YP = (bf16*)(a.ws + WS_YP); float* SSQPOOL = (float*)(a.ws + WS_SSQPOOL);
    const int g = wave & 3, w = 2 << g, lr = lane & 15, lq = lane >> 4;
    constexpr int US = 72;
    LAS bf16* Uw = (LAS bf16*)(lds + wave * 11520);
    LAS bf16* Xw = (LAS bf16*)(lds + wave * 11520 + 6784);
    const bf16* pw = (const bf16*)(a.ws + WS_SMALL) + SM_POOLW + (size_t)(layer * 4 + g) * 4096;
    bf16x8 bw[4][2]; float psc[4];
#pragma unroll
    for (int et = 0; et < 4; ++et) {
#pragma unroll
        for (int ks = 0; ks < 2; ++ks) bw[et][ks] = *(const bf16x8*)(pw + (et * 16 + lr) * 64 + ks * 32 + lq * 8);
        psc[et] = a.in[I_POOLSC][layer * 256 + g * 64 + et * 16 + lr]; }
    __syncthreads();
    const int nstreams = gridDim.x * 2;
    for (int tk = blockIdx.x * 2 + (wave >> 2); tk < NT / 32; tk += nstreams) {
        const int t0 = tk * 32, s0 = t0 & (SEQ - 1);
#pragma unroll
        for (int j = 0; j < 6; ++j) { const int id = lane + 64 * j;
            if (id < 47 * 8) { const int row = id >> 3, c8 = (id & 7) * 8; u32x4 v = {0u, 0u, 0u, 0u};
                if (s0 - 15 + row >= 0) v = *(const u32x4*)(proj + (size_t)(t0 - 15 + row) * NIN + C_POOL + g * 64 + c8);
                *(LAS u32x4*)(Uw + row * US + c8) = v; } }
        LDS_WAIT(); asm volatile("" ::: "memory");
        { float sum = 0.f;
          for (int j = 1; j < w; ++j) sum += bf2f(Uw[(15 - j) * US + lane]);
#pragma unroll 8
          for (int tl = 0; tl < 32; ++tl) { const float cur = bf2f(Uw[(15 + tl) * US + lane]); sum += cur;
              const int cnt = min(w, s0 + tl + 1); const float pooled = sum * __builtin_amdgcn_rcpf((float)cnt) - cur;
              Xw[tl * US + lane] = f2bf(pooled); sum -= bf2f(Uw[(15 + tl - w + 1) * US + lane]); } }
        LDS_WAIT(); asm volatile("" ::: "memory");
        f32x4 acc[2][4];
#pragma unroll
        for (int rt = 0; rt < 2; ++rt) { const bf16x8 a0 = *(const LAS bf16x8*)(Xw + (rt * 16 + lr) * US + lq * 8), a1 = *(const LAS bf16x8*)(Xw + (rt * 16 + lr) * US + 32 + lq * 8);
#pragma unroll
            for (int et = 0; et < 4; ++et) { acc[rt][et] = __builtin_amdgcn_mfma_f32_16x16x32_bf16(a0, bw[et][0], (f32x4){0.f, 0.f, 0.f, 0.f}, 0, 0, 0); acc[rt][et] = __builtin_amdgcn_mfma_f32_16x16x32_bf16(a1, bw[et][1], acc[rt][et], 0, 0, 0); } }
#pragma unroll
        for (int rt = 0; rt < 2; ++rt)
#pragma unroll
            for (int reg = 0; reg < 4; ++reg) { const int tl = rt * 16 + lq * 4 + reg; float s = 0.f;
#pragma unroll
                for (int et = 0; et < 4; ++et) { const float y = acc[rt][et][reg] * psc[et]; s += y * y; Uw[tl * 64 + et * 16 + lr] = f2bf(y); }
                s += __shfl_xor(s, 1); s += __shfl_xor(s, 2); s += __shfl_xor(s, 4); s += __shfl_xor(s, 8);
                if (lr == 0) SSQPOOL[(size_t)(t0 + tl) * 4 + g] = s; }
        LDS_WAIT(); asm volatile("" ::: "memory");
#pragma unroll
        for (int j = 0; j < 4; ++j) { const int id = lane + 64 * j, row = id >> 3, c8 = (id & 7) * 8;
            *(u32x4*)(YP + (size_t)(t0 + row) * 256 + g * 64 + c8) = *(const LAS u32x4*)(Uw + row * 64 + c8); }
        LDS_WAIT(); asm volatile("" ::: "memory");
    }
}

__device__ __forceinline__ void phase_lru_a(ArgsRef a, LAS unsigned char* lds, int layer, int wv) {
    const int tid = tid_from(wv), lane = tid & 63, wave = __builtin_amdgcn_readfirstlane(tid >> 6);
    const bf16* proj = (const bf16*)(a.ws + WS_PROJ);
    bf16* HL = (bf16*)(a.ws + WS_HL); bf16* PL = (bf16*)(a.ws + WS_PL);
    float* AGGH = (float*)(a.ws + WS_AGGH); float* AGGP = (float*)(a.ws + WS_AGGP);
    const int n = wave & 3, lr = lane & 15, lq = lane >> 4;
    constexpr int US = 72;
    LAS bf16* Uw = (LAS bf16*)(lds + wave * 13824);
    LAS bf16* Xw = (LAS bf16*)(lds + wave * 13824 + 5120);
    LAS bf16* Pw = (LAS bf16*)(lds + wave * 13824 + 9728);
    const int chl = n * 64 + lane;
    const float cw0 = a.in[I_CONVW][(layer * 4 + 0) * 256 + chl], cw1 = a.in[I_CONVW][(layer * 4 + 1) * 256 + chl], cw2 = a.in[I_CONVW][(layer * 4 + 2) * 256 + chl], cw3 = a.in[I_CONVW][(layer * 4 + 3) * 256 + chl];
    const float cb = a.in[I_CONVB][layer * 256 + chl];
    const bf16* wa = (const bf16*)(a.ws + WS_SMALL) + SM_WA + (size_t)(layer * 4 + n) * 4096;
    const bf16* wx = (const bf16*)(a.ws + WS_SMALL) + SM_WX + (size_t)(layer * 4 + n) * 4096;
    bf16x8 ba[4][2], bx[4][2]; float bav[4], bxv[4], sp[4];
#pragma unroll
    for (int et = 0; et < 4; ++et) {
#pragma unroll
        for (int ks = 0; ks < 2; ++ks) { const int wo = (et * 16 + lr) * 64 + ks * 32 + lq * 8; ba[et][ks] = *(const bf16x8*)(wa + wo); bx[et][ks] = *(const bf16x8*)(wx + wo); }
        const int chn = layer * 256 + n * 64 + et * 16 + lr; bav[et] = a.in[I_BA][chn]; bxv[et] = a.in[I_BX][chn]; sp[et] = log1pf(expf(-a.in[I_LAM][chn])); }
    __syncthreads();
    const int nstreams = gridDim.x * 2;
    for (int ck = blockIdx.x * 2 + (wave >> 2); ck < NT / LRU_CH; ck += nstreams) {
        const int t0 = ck * LRU_CH, s0 = t0 & (SEQ - 1);
#pragma unroll
        for (int j = 0; j < 5; ++j) { const int id = lane + 64 * j;
            if (id < 35 * 8) { const int row = id >> 3, c8 = (id & 7) * 8; u32x4 w = {0u, 0u, 0u, 0u};
                if (s0 - 3 + row >= 0) w = *(const u32x4*)(proj + (size_t)(t0 - 3 + row) * NIN + C_LRU + n * 64 + c8);
                *(LAS u32x4*)(Uw + row * US + c8) = w; } }
        LDS_WAIT(); asm volatile("" ::: "memory");
        { float u0 = bf2f(Uw[0 * US + lane]), u1 = bf2f(Uw[1 * US + lane]), u2 = bf2f(Uw[2 * US + lane]);
#pragma unroll 8
          for (int tl = 0; tl < LRU_CH; ++tl) { const float u3 = bf2f(Uw[(tl + 3) * US + lane]); const float xc = cb + cw0 * u0 + cw1 * u1 + cw2 * u2 + cw3 * u3;
              Xw[tl * US + lane] = f2bf(xc); u0 = u1; u1 = u2; u2 = u3; } }
        LDS_WAIT(); asm volatile("" ::: "memory");
        f32x4 ca[2][4], cx[2][4];
#pragma unroll
        for (int rt = 0; rt < 2; ++rt) { const bf16x8 a0 = *(const LAS bf16x8*)(Xw + (rt * 16 + lr) * US + lq * 8), a1 = *(const LAS bf16x8*)(Xw + (rt * 16 + lr) * US + 32 + lq * 8);
#pragma unroll
            for (int et = 0; et < 4; ++et) { ca[rt][et] = __builtin_amdgcn_mfma_f32_16x16x32_bf16(a0, ba[et][0], (f32x4){0.f, 0.f, 0.f, 0.f}, 0, 0, 0); ca[rt][et] = __builtin_amdgcn_mfma_f32_16x16x32_bf16(a1, ba[et][1], ca[rt][et], 0, 0, 0);
                                              cx[rt][et] = __builtin_amdgcn_mfma_f32_16x16x32_bf16(a0, bx[et][0], (f32x4){0.f, 0.f, 0.f, 0.f}, 0, 0, 0); cx[rt][et] = __builtin_amdgcn_mfma_f32_16x16x32_bf16(a1, bx[et][1], cx[rt][et], 0, 0, 0); } }
#pragma unroll
        for (int et = 0; et < 4; ++et) {
            float Pl[2][4], Hl[2][4], At[2], Ht[2];
#pragma unroll
            for (int rt = 0; rt < 2; ++rt) { float P = 1.f, H = 0.f;
#pragma unroll
                for (int reg = 0; reg < 4; ++reg) { const int tl = rt * 16 + lq * 4 + reg;
                    const float r = fast_sigmoid(ca[rt][et][reg] + bav[et]), ig = fast_sigmoid(cx[rt][et][reg] + bxv[et]);
                    const float log_a = -8.0f * r * sp[et]; const float av = fast_exp(log_a);
                    float mult = sqrtf(fmaxf(1.0f - fast_exp(2.0f * log_a), 0.f)); if (s0 + tl == 0) mult = 1.0f;
                    const float bv = mult * ig * bf2f(Xw[tl * US + et * 16 + lr]);
                    H = av * H + bv; P *= av; Pl[rt][reg] = P; Hl[rt][reg] = H; }
                At[rt] = P; Ht[rt] = H; }
            float Ai[2], Hi[2];
#pragma unroll
            for (int rt = 0; rt < 2; ++rt) { float A = At[rt], H = Ht[rt];
                { const float Ap = __shfl_up(A, 16), Hp = __shfl_up(H, 16); if (lq >= 1) { H = A * Hp + H; A = A * Ap; } }
                { const float Ap = __shfl_up(A, 32), Hp = __shfl_up(H, 32); if (lq >= 2) { H = A * Hp + H; A = A * Ap; } }
                Ai[rt] = A; Hi[rt] = H; }
            float Ac[2], Hc[2];
#pragma unroll
            for (int rt = 0; rt < 2; ++rt) { const float Ap = __shfl_up(Ai[rt], 16), Hp = __shfl_up(Hi[rt], 16); Ac[rt] = (lq >= 1) ? Ap : 1.f; Hc[rt] = (lq >= 1) ? Hp : 0.f; }
            const float A0t = __shfl(Ai[0], 48 + lr), H0t = __shfl(Hi[0], 48 + lr);
            Hc[1] = Ac[1] * H0t + Hc[1]; Ac[1] = Ac[1] * A0t;
#pragma unroll
            for (int rt = 0; rt < 2; ++rt)
#pragma unroll
                for (int reg = 0; reg < 4; ++reg) { const int tl = rt * 16 + lq * 4 + reg;
                    Uw[tl * 64 + et * 16 + lr] = f2bf(Hl[rt][reg] + Pl[rt][reg] * Hc[rt]); Pw[tl * 64 + et * 16 + lr] = f2bf(Pl[rt][reg] * Ac[rt]); }
            if (lq == 3) { const size_t o = (size_t)ck * 256 + n * 64 + et * 16 + lr;
                AGGP[o] = Ai[1] * A0t; AGGH[o] = Ai[1] * H0t + Hi[1]; }
        }
        LDS_WAIT(); asm volatile("" ::: "memory");
#pragma unroll
        for (int j = 0; j < 4; ++j) { const int id = lane + 64 * j, row = id >> 3, c8 = (id & 7) * 8;
            *(u32x4*)(HL + (size_t)(t0 + row) * 256 + n * 64 + c8) = *(const LAS u32x4*)(Uw + row * 64 + c8);
            *(u32x4*)(PL + (size_t)(t0 + row) * 256 + n * 64 + c8) = *(const LAS u32x4*)(Pw + row * 64 + c8); }
        LDS_WAIT(); asm volatile("" ::: "memory");
    }
}
__device__ __forceinline__ void phase_lru_b(ArgsRef a, int wv) {
    const float* __restrict__ AGGH = (const float*)(a.ws + WS_AGGH); const float* __restrict__ AGGP = (const float*)(a.ws + WS_AGGP); float* __restrict__ CARRY = (float*)(a.ws + WS_CARRY);
    const int tid_ = tid_from(wv);
    for (int idx = blockIdx.x * NTHR + tid_; idx < NB * 256; idx += gridDim.x * NTHR) { const int b = idx >> 8, c = idx & 255; float carry = 0.f;
        for (int k0 = 0; k0 < LRU_NCH; k0 += 16) { float pp[16], hh[16];
#pragma unroll
            for (int k = 0; k < 16; ++k) { const size_t o = (size_t)(b * LRU_NCH + k0 + k) * 256 + c; pp[k] = AGGP[o]; hh[k] = AGGH[o]; }
#pragma unroll
            for (int k = 0; k < 16; ++k) { const size_t o = (size_t)(b * LRU_NCH + k0 + k) * 256 + c; CARRY[o] = carry; carry = pp[k] * carry + hh[k]; } } }
}
typedef short v4i16_t __attribute__((ext_vector_type(4)));
struct AttnUnit { int h, n, r, dl, g, first; size_t rowb; };
__device__ __forceinline__ AttnUnit attn_unit(int bh, int hf, int i) {
    AttnUnit u; u.h = bh & 7; u.rowb = (size_t)(bh >> 3) * SEQ;
    if (i < 16) { u.g = 0; u.dl = 1; u.r = 0; u.n = 16 * hf + i; u.first = (i == 0); }
    else if (i < 32) { const int j = i - 16; u.g = 1; u.dl = 4; u.r = 2 * hf + (j >> 3); u.n = j & 7; u.first = (u.n == 0); }
    else { const int j = i - 32; u.g = 2; u.dl = 16; u.r = 8 * hf + (j >> 1); u.n = j & 1; u.first = (u.n == 0); }
    return u;
}
__device__ __forceinline__ void attn_dma_chunk(const __amdgpu_buffer_rsrc_t rs, LAS unsigned char* lds, const AttnUnit& u, int chunk, int slot, int wave, int lane) {
    const int csc = (lane & 7) ^ ((lane >> 3) & 7);
#pragma unroll
    for (int q = 0; q < 2; ++q) { const int pc = wave + 8 * q, l = 128 * chunk + 8 * pc + (lane >> 3);
        const unsigned rowoff = (unsigned)((u.rowb + (size_t)l * u.dl + u.r) * NIN * 2);
        const unsigned srcK = rowoff + (unsigned)((C_K + (u.h >> 2) * 256 + (u.h & 3) * 32) * 2) + (unsigned)((csc >> 2) * 256 + (csc & 3) * 16);
        const unsigned srcV = rowoff + (unsigned)((C_V + u.h * 64) * 2) + (unsigned)(csc * 16);
        LAS unsigned char* dst = lds + slot * 32768 + pc * 1024;
        __builtin_amdgcn_raw_ptr_buffer_load_lds(rs, (LAS void*)dst, 16, srcK, 0, 0, 0);
        __builtin_amdgcn_raw_ptr_buffer_load_lds(rs, (LAS void*)(dst + 16384), 16, srcV, 0, 0, 0); }
}
__device__ __forceinline__ void phase_attn(ArgsRef a, LAS unsigned char* lds, int wv) {
    const int tid = tid_from(wv), lane = tid & 63, wave = __builtin_amdgcn_readfirstlane(tid >> 6);
    const bf16* proj = (const bf16*)(a.ws + WS_PROJ);
    bf16* PNUM = (bf16*)(a.ws + WS_PNUM); float* PDEN = (float*)(a.ws + WS_PDEN); float* PMAX = (float*)(a.ws + WS_PMAX);
    const __amdgpu_buffer_rsrc_t rs = __builtin_amdgcn_make_buffer_rsrc((void*)proj, 0, 0x7fffffff, 0x00020000);
    const int lr = lane & 15, lq = lane >> 4, qi0 = 16 * wave, G = gridDim.x;
    float zz_ = 0.f; asm volatile("" : "+v"(zz_));
    const int kc0 = ((0 + lq) ^ (lr & 7)) * 16, kc1 = ((4 + lq) ^ (lr & 7)) * 16;
    const int q4 = (lane & 15) >> 2, p4 = lane & 3, vsw = (4 * lq + q4) & 7;
    unsigned chv[4];
#pragma unroll
    for (int dt = 0; dt < 4; ++dt) chv[dt] = (unsigned)(((2 * dt + (p4 >> 1)) ^ vsw) * 16 + (p4 & 1) * 8);
    const bool xo = (G == 256);
    const int pair = xo ? ((int)(blockIdx.x & 7) * 16 + (int)(blockIdx.x >> 4)) : (int)(blockIdx.x >> 1), hf = xo ? (int)((blockIdx.x >> 3) & 1) : (int)(blockIdx.x & 1), npairs = G >> 1;
    __syncthreads();
    { unsigned z0 = 0u; asm volatile("" : "+v"(z0));
      for (int z = tid; z < RING_BYTES / 16; z += NTHR) ((LAS u32x4*)lds)[z] = (u32x4){z0, z0, z0, z0}; }
    __syncthreads();
    const int total = (pair < 128 && (int)blockIdx.x < 2 * npairs) ? ((128 - pair + npairs - 1) / npairs) * 48 : 0;
    AttnUnit cu = attn_unit(pair < 128 ? pair : 0, hf, 0);
    const int off = (total > 0 && cu.n > 0) ? 1 : 0;
#define ATT_UNIT_AT(k) attn_unit(pair + ((k) / 48) * npairs, hf, (k) % 48)
#define ATT_QLOAD(U, Q0, Q1) do { const size_t qrow_ = (U).rowb + (size_t)(128 * (U).n + qi0 + lr) * (U).dl + (U).r; const int qc_ = C_Q + ((U).h >> 2) * 256 + ((U).h & 3) * 32 + lq * 8; \
        Q0 = *(const bf16x8*)(proj + qrow_ * NIN + qc_); Q1 = *(const bf16x8*)(proj + qrow_ * NIN + qc_ + 128); } while (0)
    bf16x8 qf0, qf1, nq0, nq1;
    if (total > 0) { if (off) attn_dma_chunk(rs, lds, cu, cu.n - 1, 0, wave, lane);
        attn_dma_chunk(rs, lds, cu, cu.n, off & 3, wave, lane); ATT_QLOAD(cu, qf0, qf1);
        if (total > 1) { const AttnUnit u1 = ATT_UNIT_AT(1); attn_dma_chunk(rs, lds, u1, u1.n, (1 + off) & 3, wave, lane); } }
    nq0 = qf0; nq1 = qf1;
    asm volatile("s_waitcnt vmcnt(0)" ::: "memory");
    int idx = 0;
    while (idx < total) {
        asm volatile("s_waitcnt vmcnt(8)" ::: "memory"); __builtin_amdgcn_s_barrier(); asm volatile("" ::: "memory");
        const int csc = (idx + off) & 3, csp = cu.first ? ((cu.n > 0) ? 0 : csc) : ((idx + off + 3) & 3);
        AttnUnit nu = cu;
        if (idx + 1 < total) { nu = ATT_UNIT_AT(idx + 1); ATT_QLOAD(nu, nq0, nq1); }
        if (idx + 2 < total) { const AttnUnit u2 = ATT_UNIT_AT(idx + 2); attn_dma_chunk(rs, lds, u2, u2.n, (idx + 2 + off) & 3, wave, lane); }
        ++idx;
        f32x4 scv[9];
#pragma unroll
        for (int t = 0; t < 9; ++t) { const int wt = wave + t; const LAS unsigned char* Kt = lds + ((wt >= 8) ? csc : csp) * 32768 + ((16 * wt) & 127) * 128 + lr * 128;
            const bf16x8 k0 = *(const LAS bf16x8*)(Kt + kc0), k1 = *(const LAS bf16x8*)(Kt + kc1);
            scv[t] = __builtin_amdgcn_mfma_f32_16x16x32_bf16(k0, qf0, (f32x4){0.f, 0.f, 0.f, 0.f}, 0, 0, 0);
            scv[t] = __builtin_amdgcn_mfma_f32_16x16x32_bf16(k1, qf1, scv[t], 0, 0, 0); }
#pragma unroll
        for (int reg = 0; reg < 4; ++reg) { if (4 * lq + reg < lr) scv[0][reg] = -1e30f; if (4 * lq + reg > lr) scv[8][reg] = -1e30f; }
        if (cu.n == 0) {
#pragma unroll
            for (int t = 0; t < 8; ++t)
#pragma unroll
                for (int reg = 0; reg < 4; ++reg) { if (qi0 + 16 * t + 4 * lq + reg < 128) scv[t][reg] = -1e30f; } }
        float mx = -1e30f;
#pragma unroll
        for (int t = 0; t < 9; ++t)
#pragma unroll
            for (int reg = 0; reg < 4; ++reg) mx = fmaxf(mx, scv[t][reg]);
        mx = fmaxf(mx, __shfl_xor(mx, 16)); mx = fmaxf(mx, __shfl_xor(mx, 32));
        float sm = 0.f;
#pragma unroll
        for (int t = 0; t < 9; ++t)
#pragma unroll
            for (int reg = 0; reg < 4; ++reg) { const float pe = __builtin_amdgcn_exp2f(scv[t][reg] - mx); sm += pe; scv[t][reg] = pe; }
        sm += __shfl_xor(sm, 16); sm += __shfl_xor(sm, 32);
        f32x4 oc[4];
#pragma unroll
        for (int dt = 0; dt < 4; ++dt) oc[dt] = (f32x4){zz_, zz_, zz_, zz_};
#pragma unroll
        for (int pi = 0; pi < 5; ++pi) { const int t0 = 2 * pi, t1 = (2 * pi + 1 < 9) ? 2 * pi + 1 : 8;
            u32x4 pw; pw.x = cvt_pk_bf16(scv[t0][0], scv[t0][1]); pw.y = cvt_pk_bf16(scv[t0][2], scv[t0][3]);
            if (2 * pi + 1 < 9) { pw.z = cvt_pk_bf16(scv[t1][0], scv[t1][1]); pw.w = cvt_pk_bf16(scv[t1][2], scv[t1][3]); } else { pw.z = 0u; pw.w = 0u; }
            const bf16x8 pf = __builtin_bit_cast(bf16x8, pw);
            const int w0 = wave + t0, w1 = wave + t1;
            const LAS unsigned char* V0 = lds + ((w0 >= 8) ? csc : csp) * 32768 + 16384 + (((16 * w0) & 127) + 4 * lq + q4) * 128;
            const LAS unsigned char* V1 = lds + ((w1 >= 8) ? csc : csp) * 32768 + 16384 + (((16 * w1) & 127) + 4 * lq + q4) * 128;
            const unsigned va0 = (unsigned)(unsigned long)V0, va1 = (unsigned)(unsigned long)V1;
            v4i16_t r0[4], r1[4];
#pragma unroll
            for (int dt = 0; dt < 4; ++dt) { asm volatile("ds_read_b64_tr_b16 %0, %1" : "=&v"(r0[dt]) : "v"(va0 + chv[dt]) : "memory"); asm volatile("ds_read_b64_tr_b16 %0, %1" : "=&v"(r1[dt]) : "v"(va1 + chv[dt]) : "memory"); }
            asm volatile("s_waitcnt lgkmcnt(0)" : "+v"(r0[0]), "+v"(r0[1]), "+v"(r0[2]), "+v"(r0[3]), "+v"(r1[0]), "+v"(r1[1]), "+v"(r1[2]), "+v"(r1[3]) :: "memory");
#pragma unroll
            for (int dt = 0; dt < 4; ++dt) { const bf16x8 vf = (bf16x8){r0[dt][0], r0[dt][1], r0[dt][2], r0[dt][3], r1[dt][0], r1[dt][1], r1[dt][2], r1[dt][3]};
                oc[dt] = __builtin_amdgcn_mfma_f32_16x16x32_bf16(pf, vf, oc[dt], 0, 0, 0); } }
        { LAS bf16* stg = (LAS bf16*)(lds + OST_OFF + wave * 2048);
#pragma unroll
          for (int reg = 0; reg < 4; ++reg)
#pragma unroll
              for (int dt = 0; dt < 4; ++dt) stg[(4 * lq + reg) * 64 + dt * 16 + lr] = f2bf(oc[dt][reg]);
          LDS_WAIT(); asm volatile("" ::: "memory");
#pragma unroll
          for (int i = 0; i < 2; ++i) { const int qq = i * 8 + (lane >> 3), c8 = (lane & 7) * 8; const u32x4 w = *(const LAS u32x4*)(stg + qq * 64 + c8);
              const size_t tok = cu.rowb + (size_t)(128 * cu.n + qi0 + qq) * cu.dl + cu.r;
              *(u32x4*)(PNUM + ((size_t)cu.g * NT + tok) * 512 + cu.h * 64 + c8) = w; }
          LDS_WAIT(); asm volatile("" ::: "memory"); }
        if (lq == 0) { const size_t tok = cu.rowb + (size_t)(128 * cu.n + qi0 + lr) * cu.dl + cu.r; PDEN[((size_t)cu.g * NT + tok) * 8 + cu.h] = sm; PMAX[((size_t)cu.g * NT + tok) * 8 + cu.h] = mx; }
        cu = nu; qf0 = nq0; qf1 = nq1;
    }
#undef ATT_UNIT_AT
#undef ATT_QLOAD
}
__device__ __forceinline__ void phase_finalize(ArgsRef a, int wv) {
    const int tid = tid_from(wv), lane = tid & 63, wave = tid >> 6;
    const int gw = blockIdx.x * NWAVES + wave, NGW = gridDim.x * NWAVES;
    const bf16* __restrict__ proj = (const bf16*)(a.ws + WS_PROJ); bf16* __restrict__ mix = (bf16*)(a.ws + WS_MIX);
    const bf16* __restrict__ YP = (const bf16*)(a.ws + WS_YP); const float* __restrict__ SSQPOOL = (const float*)(a.ws + WS_SSQPOOL);
    const bf16* __restrict__ HL = (const bf16*)(a.ws + WS_HL); const bf16* __restrict__ PL = (const bf16*)(a.ws + WS_PL); const float* __restrict__ CARRY = (const float*)(a.ws + WS_CARRY);
    const bf16* __restrict__ PNUM = (const bf16*)(a.ws + WS_PNUM); const float* __restrict__ PDEN = (const float*)(a.ws + WS_PDEN); const float* __restrict__ PMAX = (const float*)(a.ws + WS_PMAX);
    const int hd = lane >> 3;
    for (int t = gw; t < NT; t += NGW) {
        const u32x2 ypw = *(const u32x2*)(YP + (size_t)t * 256 + lane * 4); const f32x4 sq = *(const f32x4*)(SSQPOOL + (size_t)t * 4);
        const u32x2 hw = *(const u32x2*)(HL + (size_t)t * 256 + lane * 4), pw = *(const u32x2*)(PL + (size_t)t * 256 + lane * 4), gwd = *(const u32x2*)(proj + (size_t)t * NIN + C_GATE + lane * 4);
        const f32x4 cr = *(const f32x4*)(CARRY + (size_t)(t / LRU_CH) * 256 + lane * 4);
        float m[3], dn[3]; u32x4 nw[3];
#pragma unroll
        for (int g = 0; g < 3; ++g) { m[g] = PMAX[((size_t)g * NT + t) * 8 + hd]; dn[g] = PDEN[((size_t)g * NT + t) * 8 + hd]; nw[g] = *(const u32x4*)(PNUM + ((size_t)g * NT + t) * 512 + lane * 8); }
        { const float rs = __builtin_amdgcn_rsqf(((sq[0] + sq[1]) + (sq[2] + sq[3])) * (1.0f / 256.0f) + EPS);
          u32x2 o; o.x = cvt_pk_bf16(bflo(ypw.x) * rs, bfhi(ypw.x) * rs); o.y = cvt_pk_bf16(bflo(ypw.y) * rs, bfhi(ypw.y) * rs);
          *(u32x2*)(mix + (size_t)t * DM + lane * 4) = o; }
        { float h[4] = {bflo(hw.x) + bflo(pw.x) * cr[0], bfhi(hw.x) + bfhi(pw.x) * cr[1], bflo(hw.y) + bflo(pw.y) * cr[2], bfhi(hw.y) + bfhi(pw.y) * cr[3]};
          const float gt[4] = {bflo(gwd.x), bfhi(gwd.x), bflo(gwd.y), bfhi(gwd.y)};
          float s = 0.f;
#pragma unroll
          for (int j = 0; j < 4; ++j) { h[j] *= gelu_tanh(gt[j]); s += h[j] * h[j]; }
          s = wave_sum(s); const float rs = __builtin_amdgcn_rsqf(s * (1.0f / 256.0f) + EPS);
          u32x2 o; o.x = cvt_pk_bf16(h[0] * rs, h[1] * rs); o.y = cvt_pk_bf16(h[2] * rs, h[3] * rs);
          *(u32x2*)(mix + (size_t)t * DM + 256 + lane * 4) = o; }
        { const float mr = fmaxf(fmaxf(m[0], m[1]), m[2]);
          float o[8] = {0.f, 0.f, 0.f, 0.f, 0.f, 0.f, 0.f, 0.f}; float den = 0.f;
#pragma unroll
          for (int g = 0; g < 3; ++g) { const float wg = __builtin_amdgcn_exp2f(m[g] - mr); den += wg * dn[g];
              o[0] += wg * bflo(nw[g].x); o[1] += wg * bfhi(nw[g].x); o[2] += wg * bflo(nw[g].y); o[3] += wg * bfhi(nw[g].y); o[4] += wg * bflo(nw[g].z); o[5] += wg * bfhi(nw[g].z); o[6] += wg * bflo(nw[g].w); o[7] += wg * bfhi(nw[g].w); }
          const float inv = 1.0f / den; float s = 0.f;
#pragma unroll
          for (int j = 0; j < 8; ++j) { o[j] *= inv; s += o[j] * o[j]; }
          s = wave_sum(s); const float rs = __builtin_amdgcn_rsqf(s * (1.0f / 512.0f) + EPS);
          u32x4 wv4; wv4.x = cvt_pk_bf16(o[0] * rs, o[1] * rs); wv4.y = cvt_pk_bf16(o[2] * rs, o[3] * rs); wv4.z = cvt_pk_bf16(o[4] * rs, o[5] * rs); wv4.w = cvt_pk_bf16(o[6] * rs, o[7] * rs);
          *(u32x4*)(mix + (size_t)t * DM + 512 + lane * 8) = wv4; }
    }
}

__device__ __forceinline__ void phase_router(ArgsRef a, LAS unsigned char* lds, int layer, int wv, bool alloc) {
    const int tid = tid_from(wv), lane = tid & 63, wave = __builtin_amdgcn_readfirstlane(tid >> 6);
    const bf16* xb = (const bf16*)(a.ws + WS_XB); const bf16* wr = (const bf16*)(a.ws + WS_SMALL) + SM_WR + (size_t)layer * NEXP * DM;
    const float* ssqp = (const float*)(a.ws + WS_SSQP); const float* rbias = a.in[I_BR] + layer * NEXP;
    int* LIST = (int*)(a.ws + WS_LIST); float* LRSTD = (float*)(a.ws + WS_LRSTD); float* LGATE = (float*)(a.ws + WS_LGATE2);
    unsigned* cnt = (unsigned*)(a.ws + WS_CTL) + CW_CNT + layer * NEXP;
    float zr_ = 0.f; asm volatile("" : "+v"(zr_));
    LAS float* LG = (LAS float*)lds + wave * 32 * 33;
    LAS int* hist = (LAS int*)(lds + 65536);
    LAS int* base = (LAS int*)(lds + 65536 + 128);
    const int lr = lane & 15, lq = lane >> 4;
    for (int unit = blockIdx.x; unit < NT / 256; unit += gridDim.x) {
        const int tok0 = unit * 256 + wave * 32;
        __syncthreads();
        if (tid < 32) hist[tid] = 0;
        f32x4 acc[2][2];
#pragma unroll
        for (int rt = 0; rt < 2; ++rt)
#pragma unroll
            for (int et = 0; et < 2; ++et) acc[rt][et] = (f32x4){zr_, zr_, zr_, zr_};
#pragma unroll 4
        for (int ks = 0; ks < 32; ++ks) { bf16x8 af[2], bfr[2];
#pragma unroll
            for (int rt = 0; rt < 2; ++rt) af[rt] = *(const bf16x8*)(xb + (size_t)(tok0 + rt * 16 + lr) * DM + ks * 32 + lq * 8);
#pragma unroll
            for (int et = 0; et < 2; ++et) bfr[et] = *(const bf16x8*)(wr + (size_t)(et * 16 + lr) * DM + ks * 32 + lq * 8);
#pragma unroll
            for (int rt = 0; rt < 2; ++rt)
#pragma unroll
                for (int et = 0; et < 2; ++et) acc[rt][et] = __builtin_amdgcn_mfma_f32_16x16x32_bf16(af[rt], bfr[et], acc[rt][et], 0, 0, 0); }
#pragma unroll
        for (int rt = 0; rt < 2; ++rt)
#pragma unroll
            for (int et = 0; et < 2; ++et)
#pragma unroll
                for (int reg = 0; reg < 4; ++reg) LG[(rt * 16 + lq * 4 + reg) * 33 + et * 16 + lr] = acc[rt][et][reg];
        __syncthreads();
        int te[4] = {0, 0, 0, 0}; float tg[4] = {0.f, 0.f, 0.f, 0.f}; int rk[4] = {0, 0, 0, 0}; float rstd = 0.f; const int tok = tok0 + lane;
        if (lane < 32) {
            const float* sp = ssqp + (size_t)tok * 16; float ss = 0.f;
#pragma unroll
            for (int j = 0; j < 16; ++j) ss += sp[j];
            rstd = __builtin_amdgcn_rsqf(ss * (1.0f / DM) + EPS);
            float tv[4] = {-3e38f, -3e38f, -3e38f, -3e38f};
            for (int e = 0; e < NEXP; ++e) { float v = LG[lane * 33 + e] * rstd + rbias[e]; int ve = e;
#pragma unroll
                for (int k = 0; k < 4; ++k) { if (v > tv[k]) { const float tvv = tv[k]; const int tee = te[k]; tv[k] = v; te[k] = ve; v = tvv; ve = tee; } } }
            float z = 0.f;
#pragma unroll
            for (int k = 0; k < 4; ++k) { tg[k] = fast_exp(tv[k] - tv[0]); z += tg[k]; }
            const float iz = 1.0f / z;
#pragma unroll
            for (int k = 0; k < 4; ++k) { tg[k] *= iz; rk[k] = __hip_atomic_fetch_add(&hist[te[k]], 1, __ATOMIC_RELAXED, __HIP_MEMORY_SCOPE_WORKGROUP); }
        }
        __syncthreads();
        if (tid < 32) base[tid] = alloc ? (int)__hip_atomic_fetch_add(cnt + tid, (unsigned)hist[tid], RLX_AGENT) : 0;
        __syncthreads();
        if (lane < 32 && alloc) {
#pragma unroll
            for (int k = 0; k < 4; ++k) { const size_t p = (size_t)te[k] * NT + base[te[k]] + rk[k]; LIST[p] = tok * 4 + k; LRSTD[p] = rstd; LGATE[p] = tg[k]; }
        }
    }
}

__device__ __forceinline__ void phase_combine(ArgsRef a, bool last_layer, int wv, bool dry) {
    const int tid = tid_from(wv), lane = tid & 63, wave = tid >> 6;
    const int gw = blockIdx.x * NWAVES + wave, NGW = gridDim.x * NWAVES;
    const unsigned char* __restrict__ Y = (const unsigned char*)(a.ws + WS_Y); float* __restrict__ out = a.out; bf16* xb = (bf16*)(a.ws + WS_XB); float* __restrict__ ssq = (float*)(a.ws + WS_SSQ);
    typedef float f2v __attribute__((ext_vector_type(2)));
    for (int t = gw; t < NT; t += NGW) {
        const u32x4 x0 = *((const u32x4*)(xb + (size_t)t * DM) + 2 * lane), x1 = *((const u32x4*)(xb + (size_t)t * DM) + 2 * lane + 1);
        u32x4 y[4];
#pragma unroll
        for (int k = 0; k < 4; ++k) y[k] = *((const u32x4*)(Y + ((size_t)t * 4 + k) * DM) + lane);
        float v[16];
        v[0] = bflo(x0.x); v[1] = bfhi(x0.x); v[2] = bflo(x0.y); v[3] = bfhi(x0.y); v[4] = bflo(x0.z); v[5] = bfhi(x0.z); v[6] = bflo(x0.w); v[7] = bfhi(x0.w);
        v[8] = bflo(x1.x); v[9] = bfhi(x1.x); v[10] = bflo(x1.y); v[11] = bfhi(x1.y); v[12] = bflo(x1.z); v[13] = bfhi(x1.z); v[14] = bflo(x1.w); v[15] = bfhi(x1.w);
#pragma unroll
        for (int k = 0; k < 4; ++k)
#pragma unroll
            for (int d = 0; d < 4; ++d) { const int w = (int)y[k][d]; const f2v lo = __builtin_amdgcn_cvt_pk_f32_fp8(w, false), hi = __builtin_amdgcn_cvt_pk_f32_fp8(w, true);
                v[4 * d + 0] += lo.x * (1.0f / Y8_SCALE); v[4 * d + 1] += lo.y * (1.0f / Y8_SCALE); v[4 * d + 2] += hi.x * (1.0f / Y8_SCALE); v[4 * d + 3] += hi.y * (1.0f / Y8_SCALE); }
        float s = 0.f;
#pragma unroll
        for (int j = 0; j < 16; ++j) s += v[j] * v[j];
        if (dry && s != 12345.678f) continue;
        if (last_layer) {
#pragma unroll
            for (int j = 0; j < 4; ++j) *((f32x4*)(out + (size_t)t * DM) + 4 * lane + j) = (f32x4){v[4 * j], v[4 * j + 1], v[4 * j + 2], v[4 * j + 3]};
        } else { s = wave_sum(s);
            u32x4 w0, w1; w0.x = cvt_pk_bf16(v[0], v[1]); w0.y = cvt_pk_bf16(v[2], v[3]); w0.z = cvt_pk_bf16(v[4], v[5]); w0.w = cvt_pk_bf16(v[6], v[7]);
            w1.x = cvt_pk_bf16(v[8], v[9]); w1.y = cvt_pk_bf16(v[10], v[11]); w1.z = cvt_pk_bf16(v[12], v[13]); w1.w = cvt_pk_bf16(v[14], v[15]);
            *((u32x4*)(xb + (size_t)t * DM) + 2 * lane) = w0; *((u32x4*)(xb + (size_t)t * DM) + 2 * lane + 1) = w1;
            if (lane == 0) ssq[t] = s; }
    }
}

constexpr int NPH_LAYER = 13, NPH = 1 + 2 * NPH_LAYER;
enum { PH_GEMM_IN = 0, PH_QKPREP, PH_POOL, PH_LRU_A, PH_LRU_B, PH_ATTN, PH_LRU_C, PH_MERGE, PH_GEMM_OUT, PH_ROUTER, PH_MOE_GU, PH_MOE_DOWN, PH_COMBINE };
#ifndef MK_STOP
#define MK_STOP NPH
#endif
#ifndef MK_SPLIT
#define MK_SPLIT 0
#endif

template <int PHMASK>
__global__ void __launch_bounds__(NTHR, 2) mega_fwd(Args args_by_value) {
    extern __shared__ __attribute__((aligned(16))) unsigned char lds_raw[];
    LAS unsigned char* lds = (LAS unsigned char*)lds_raw;
    const int tid = threadIdx.x;
    int wv = __builtin_amdgcn_readfirstlane(tid >> 6); asm volatile("" : "+s"(wv));
    for (int u = tid; u < (LDS_BYTES - LDSCTL_OFF) / 4; u += NTHR) ((LAS unsigned*)(lds + LDSCTL_OFF))[u] = 0u;
    __syncthreads();
#define ARGS_HERE() const CAS Args* ap_ = (const CAS Args*)__builtin_amdgcn_kernarg_segment_ptr(); asm volatile("" : "+s"(ap_)); ArgsRef args = *ap_; unsigned char* const ws = args.ws; unsigned* const ctl = (unsigned*)(ws + WS_CTL); (void)ctl
    int lo, hi;
    { ARGS_HERE(); lo = args.ph_lo; hi = args.ph_hi; xcd_barrier_post(ctl + CW_BAR + args.li * XCD_BAR_WORDS, (volatile LAS unsigned*)(lds + MISC_OFF) + 8); }
#define EN(p) (((PHMASK) >> (p)) & 1)
#ifndef MK_DUP
#define MK_DUP 0
#endif
#define NREP(p) ((((MK_DUP) >> (p)) & 1) ? 2 : 1)
#define IN(k) (lo <= (k) && (k) < hi)
#define SEAM(k) do { if (IN(k) && IN((k) + 1)) { ARGS_HERE(); XcdBarrier bar_; bar_.bar = ctl + CW_BAR + args.li * XCD_BAR_WORDS; bar_.x = xb_xcc_id(); bar_.st = (volatile LAS unsigned*)(lds + MISC_OFF) + 8; xcd_barrier(bar_); } } while (0)

    if (EN(13) && IN(0)) { ARGS_HERE(); for (int rep_ = 0; rep_ < NREP(13); ++rep_) { phase_prologue(args, lds, wv); } }
    SEAM(0);
    for (int l = 0; l < 2; ++l) {
        const int pb = 1 + NPH_LAYER * l;
        if (EN(PH_GEMM_IN) && IN(pb + PH_GEMM_IN)) { ARGS_HERE();
            pg8::StaticOrder S; S.init(NT, NIN, DM, gridDim.x, blockIdx.x); S.dup = NREP(PH_GEMM_IN) - 1;
            EpiIn E{(bf16*)(ws + WS_PROJ), (const float*)(ws + WS_SSQ), args.in[I_QG] + l * 64, args.in[I_KG] + l * 64, (const float*)(ws + WS_ROPE), (const float*)(ws + WS_ROPE) + SEQ * 32};
            pg8::gemm_phase<EpiIn, pg8::StaticOrder, true>(lds, (const bf16*)(ws + WS_XB), (const bf16*)(ws + WS_WIN) + (size_t)l * NIN * DM, DM, S, E, wv);
        }
        SEAM(pb + PH_GEMM_IN);
        if (EN(PH_POOL) && IN(pb + PH_POOL)) { ARGS_HERE(); for (int rep_ = 0; rep_ < NREP(PH_POOL); ++rep_) { phase_pool(args, lds, l, wv); } }
        if (EN(PH_LRU_A) && IN(pb + PH_LRU_A)) { ARGS_HERE(); for (int rep_ = 0; rep_ < NREP(PH_LRU_A); ++rep_) { phase_lru_a(args, lds, l, wv); } }
        SEAM(pb + PH_LRU_A);
        if (EN(PH_LRU_B) && IN(pb + PH_LRU_B)) { ARGS_HERE(); for (int rep_ = 0; rep_ < NREP(PH_LRU_B); ++rep_) { phase_lru_b(args, wv); } }
        if (EN(PH_ATTN) && IN(pb + PH_ATTN)) { ARGS_HERE(); for (int rep_ = 0; rep_ < NREP(PH_ATTN); ++rep_) { phase_attn(args, lds, wv); } }
        SEAM(pb + PH_ATTN);
        if (EN(PH_LRU_C) && IN(pb + PH_LRU_C)) { ARGS_HERE(); for (int rep_ = 0; rep_ < NREP(PH_LRU_C); ++rep_) { phase_finalize(args, wv); } }
        SEAM(pb + PH_MERGE);
        if (EN(PH_GEMM_OUT) && IN(pb + PH_GEMM_OUT)) { ARGS_HERE();
            __syncthreads();
            pg8::StaticOrder S; S.init(NT, DM, DM, gridDim.x, blockIdx.x); S.dup = (l == 0) ? NREP(PH_GEMM_OUT) - 1 : 0;
            EpiOut E{(bf16*)(ws + WS_XB), (float*)(ws + WS_SSQP), (unsigned char*)(ws + WS_XB8)};
            pg8::gemm_phase<EpiOut, pg8::StaticOrder, true>(lds, (const bf16*)(ws + WS_MIX), (const bf16*)(ws + WS_WOUT) + (size_t)l * DM * DM, DM, S, E, wv);
        }
        SEAM(pb + PH_GEMM_OUT);
        if (EN(PH_ROUTER) && IN(pb + PH_ROUTER)) { ARGS_HERE(); for (int rep_ = 0; rep_ < NREP(PH_ROUTER); ++rep_) { phase_router(args, lds, l, wv, rep_ == NREP(PH_ROUTER) - 1); } }
        SEAM(pb + PH_ROUTER);
        if (EN(PH_MOE_GU) && IN(pb + PH_MOE_GU)) { ARGS_HERE();
            LAS int* tab = (LAS int*)(lds + TAB_OFF);
            moe_tables(tab, ctl + CW_CNT + l * NEXP, wv);
            MoeOrder<2> S{tab, 2, (int)gridDim.x, (int)blockIdx.x, (const int*)(ws + WS_LIST), NREP(PH_MOE_GU) - 1};
            EpiGU E{(unsigned char*)(ws + WS_ACT), (const float*)(ws + WS_LRSTD), args.in[I_BGU] + (size_t)l * NEXP * 512};
            pg8::gemm_phase<EpiGU, MoeOrder<2>, true, true>(lds, (const bf16*)(ws + WS_XB8), (const bf16*)(ws + WS_WGU + (size_t)l * NEXP * 512 * DM), DM / 2, S, E, wv);
        }
        SEAM(pb + PH_MOE_GU);
        if (EN(PH_MOE_DOWN) && IN(pb + PH_MOE_DOWN)) { ARGS_HERE();
            LAS int* tab = (LAS int*)(lds + TAB_OFF);
            moe_tables(tab, ctl + CW_CNT + l * NEXP, wv);
            MoeOrder<3> S{tab, 4, (int)gridDim.x, (int)blockIdx.x, (const int*)(ws + WS_LIST), NREP(PH_MOE_DOWN) - 1};
            EpiDown E{(unsigned char*)(ws + WS_Y), (const int*)(ws + WS_LIST), (const float*)(ws + WS_LGATE2), args.in[I_BD] + (size_t)l * NEXP * DM, tab};
            pg8::gemm_phase<EpiDown, MoeOrder<3>, true, true>(lds, (const bf16*)(ws + WS_ACT), (const bf16*)(ws + WS_WD + (size_t)l * NEXP * DM * EFF), EFF / 2, S, E, wv);
        }
        SEAM(pb + PH_MOE_DOWN);
        if (EN(PH_COMBINE) && IN(pb + PH_COMBINE)) { ARGS_HERE(); for (int rep_ = 0; rep_ < NREP(PH_COMBINE); ++rep_) { phase_combine(args, l == 1, wv, rep_ < NREP(PH_COMBINE) - 1); } }
        SEAM(pb + PH_COMBINE);
    }
#undef IN
#undef SEAM
}

typedef void (*kern_t)(Args);
template <int M> static kern_t kern_of() { return (kern_t)mega_fwd<M>; }
static kern_t phase_kernel(int p) {
    switch (p) { case 0: return kern_of<1 << 0>(); case 1: return kern_of<1 << 1>(); case 2: return kern_of<1 << 2>(); case 3: return kern_of<1 << 3>(); case 4: return kern_of<1 << 4>();
                 case 5: return kern_of<1 << 5>(); case 6: return kern_of<1 << 6>(); case 7: return kern_of<1 << 7>(); case 8: return kern_of<1 << 8>(); case 9: return kern_of<1 << 9>();
                 case 10: return kern_of<1 << 10>(); case 11: return kern_of<1 << 11>(); case 12: return kern_of<1 << 12>(); default: return kern_of<1 << 13>(); }
}
extern "C" void kernel_launch(void* const* d_in, const int* in_sizes, int n_in, void* d_out, int out_size, void* d_ws, size_t ws_size, hipStream_t stream) {
    static int grid = 0;
    if (grid == 0) {
        if (n_in != 23 || in_sizes[0] != NT * DM || out_size != NT * DM || ws_size < WS_END) {
            fprintf(stderr, "kernel_launch: built for 23 inputs, x/out of %d floats, >= %zu bytes of workspace; got n_in %d, in0 %d, out %d, ws %zu; nothing launched\n", NT * DM, (size_t)WS_END, n_in, n_in > 0 ? in_sizes[0] : -1, out_size, ws_size);
            grid = -1; return; }
        int dev = 0, cus = 0;
        if (hipGetDevice(&dev) != hipSuccess || hipDeviceGetAttribute(&cus, hipDeviceAttributeMultiprocessorCount, dev) != hipSuccess) { fprintf(stderr, "kernel_launch: device query failed\n"); grid = -1; return; }
#if MK_SPLIT
        for (int p = 0; p < 14; ++p) if (hipFuncSetAttribute((const void*)phase_kernel(p), hipFuncAttributeMaxDynamicSharedMemorySize, LDS_BYTES) != hipSuccess) { fprintf(stderr, "kernel_launch: hipFuncSetAttribute failed\n"); grid = -1; return; }
#else
        if (hipFuncSetAttribute((const void*)kern_of<0x3fff>(), hipFuncAttributeMaxDynamicSharedMemorySize, LDS_BYTES) != hipSuccess) { fprintf(stderr, "kernel_launch: hipFuncSetAttribute failed\n"); grid = -1; return; }
        int per_cu = 0;
        if (hipOccupancyMaxActiveBlocksPerMultiprocessor(&per_cu, (const void*)kern_of<0x3fff>(), NTHR, LDS_BYTES) != hipSuccess || per_cu < 1)
            fprintf(stderr, "kernel_launch: note: occupancy query reports %d workgroups per CU\n", per_cu);
#endif
        (void)hipGetLastError();
        if (cus != 256) { fprintf(stderr, "kernel_launch: this kernel's unit maps are built for a 256-CU device (one workgroup per CU); found %d CUs; nothing launched\n", cus); grid = -1; return; }
        grid = cus;
    }
    if (grid < 0) return;
    if (hipMemsetAsync((char*)d_ws + WS_CTL, 0, CTL_ZERO_BYTES, stream) != hipSuccess) { fprintf(stderr, "kernel_launch: hipMemsetAsync failed\n"); return; }
    Args a{};
    for (int i = 0; i < 23; ++i) a.in[i] = (const float*)d_in[i];
    a.out = (float*)d_out; a.ws = (unsigned char*)d_ws; a.pad = 0;
#if MK_SPLIT
#ifdef MK_SKIP
    (void)hipMemsetAsync((char*)d_ws + WS_MIX, 0, (size_t)NT * DM * 2, stream);
#endif
    for (int p = 0; p < MK_STOP; ++p) { a.ph_lo = p; a.ph_hi = p + 1; a.li = p;
#ifdef MK_SKIP
        if (p >= 1 && (((MK_SKIP) >> ((p - 1) % NPH_LAYER)) & 1)) continue;
#endif
        hipLaunchKernelGGL(phase_kernel(p == 0 ? 13 : (p - 1) % NPH_LAYER), dim3(grid), dim3(NTHR), LDS_BYTES, stream, a); }
#else
    a.ph_lo = 0; a.ph_hi = NPH; a.li = 0;
    hipLaunchKernelGGL(kern_of<0x3fff>(), dim3(grid), dim3(NTHR), LDS_BYTES, stream, a);
#endif
    const hipError_t le = hipPeekAtLastError();
    if (le != hipSuccess) fprintf(stderr, "kernel_launch: launch failed: %s\n", hipGetErrorName(le));
}
```

```cpp
#include <hip/hip_runtime.h>
#include <cstdio>
#include <cstdint>

#define LAS __attribute__((address_space(3)))
#define GAS __attribute__((address_space(1)))
typedef unsigned short bf16;
typedef short bf16x8 __attribute__((ext_vector_type(8)));
typedef float f32x4 __attribute__((ext_vector_type(4)));
typedef float f32x2 __attribute__((ext_vector_type(2)));
typedef unsigned u32x4 __attribute__((ext_vector_type(4)));
typedef unsigned u32x2 __attribute__((ext_vector_type(2)));

#ifndef MK_VAR
#define MK_VAR 0
#endif
constexpr int NB = 16, SEQ = 4096, DM = 1024, NT = NB * SEQ;
constexpr int NIN = 2304;
constexpr int C_POOL = 0, C_LRU = 256, C_GATE = 512, C_Q = 768, C_K = 1280, C_V = 1792;
constexpr int NEXP = 32, TOPK = 4, EFF = 256;
constexpr int NASSIGN = NT * TOPK;
constexpr int ACT_ROWS = NASSIGN + NEXP * 256;
constexpr float EPS = 1e-6f;
constexpr int NWAVES = 8, NTHR = 512;
constexpr int LRU_CH = 32, LRU_NCH = SEQ / LRU_CH;

constexpr size_t MiB = 1u << 20;
constexpr size_t WS_CTL = 0, CTL_ZERO_BYTES = 1 * MiB;
constexpr size_t WS_ROPE = 1 * MiB;
constexpr size_t WS_SMALL = 2 * MiB;
constexpr size_t WS_WIN = 4 * MiB;
constexpr size_t WS_WOUT = 13 * MiB;
constexpr size_t WS_WGU = 17 * MiB;
constexpr size_t WS_WD = 81 * MiB;
constexpr size_t WS_SSQ = 113 * MiB;
constexpr size_t WS_SSQP = 114 * MiB;
constexpr size_t WS_LIST = 118 * MiB;
constexpr size_t WS_XB = 128 * MiB;
constexpr size_t WS_R = 256 * MiB;
constexpr size_t WS_PROJ = WS_R;
constexpr size_t WS_MIX = WS_R + 288 * MiB;
constexpr size_t WS_PNUM = WS_R + 416 * MiB;
constexpr size_t WS_PDEN = WS_R + 608 * MiB;
constexpr size_t WS_PMAX = WS_R + 614 * MiB;
constexpr size_t WS_HL = WS_R + 620 * MiB;
constexpr size_t WS_PL = WS_R + 652 * MiB;
constexpr size_t WS_AGGH = WS_R + 684 * MiB;
constexpr size_t WS_AGGP = WS_R + 686 * MiB;
constexpr size_t WS_CARRY = WS_R + 688 * MiB;
constexpr size_t WS_YP = WS_R + 690 * MiB;
constexpr size_t WS_SSQPOOL = WS_R + 722 * MiB;
constexpr size_t WS_ACT = WS_R;
constexpr size_t WS_Y = WS_R + 132 * MiB;
constexpr size_t WS_XB8 = WS_R + 420 * MiB;
constexpr size_t WS_LRSTD = WS_R + 644 * MiB;
constexpr size_t WS_LGATE2 = WS_R + 652 * MiB;
constexpr size_t WS_END = 1024 * MiB;
static_assert(WS_CARRY + 2 * MiB <= WS_END && WS_LGATE2 + 8 * MiB <= WS_END, "d_ws map");
constexpr size_t SM_POOLW = 0;
constexpr size_t SM_WA = 32768;
constexpr size_t SM_WX = 65536;
constexpr size_t SM_WR = 98304;
constexpr int CW_BAR = 4096;
constexpr int CW_CNT = 1024;

constexpr int RING_BYTES = 131072;
constexpr int LDSCTL_OFF = RING_BYTES;
constexpr int MISC_OFF = LDSCTL_OFF + 320;
constexpr int TAB_OFF = LDSCTL_OFF + 1024;
constexpr int OST_OFF = RING_BYTES + 8192;
constexpr int LDS_BYTES = 163840;

typedef GAS unsigned gu32;
#define RLX_AGENT __ATOMIC_RELAXED, __HIP_MEMORY_SCOPE_AGENT
#define LDS_WAIT() asm volatile("s_waitcnt lgkmcnt(0)" ::: "memory")
#define VM_WAIT() asm volatile("s_waitcnt vmcnt(0)" ::: "memory")
typedef __bf16 bf16x2_t __attribute__((ext_vector_type(2)));
__device__ __forceinline__ unsigned cvt_pk_bf16(float lo, float hi) { const f32x2 v = {lo, hi}; const bf16x2_t b = __builtin_convertvector(v, bf16x2_t); return __builtin_bit_cast(unsigned, b); }
__device__ __forceinline__ float bflo(unsigned w) { return __uint_as_float(w << 16); }
__device__ __forceinline__ float bfhi(unsigned w) { return __uint_as_float(w & 0xffff0000u); }
__device__ __forceinline__ float bf2f(bf16 h) { return __uint_as_float((unsigned)h << 16); }
__device__ __forceinline__ bf16 f2bf(float f) { return (bf16)(cvt_pk_bf16(f, 0.f) & 0xffffu); }
__device__ __forceinline__ float wave_sum(float v) {
#pragma unroll
    for (int o = 1; o < 64; o <<= 1) v += __shfl_xor(v, o);
    return v;
}
__device__ __forceinline__ float fast_sigmoid(float x) { return __builtin_amdgcn_rcpf(1.0f + __builtin_amdgcn_exp2f(-1.4426950408889634f * x)); }
__device__ __forceinline__ float fast_exp(float x) { return __builtin_amdgcn_exp2f(1.4426950408889634f * x); }
__device__ __forceinline__ float gelu_tanh(float x) {
    const float u = 0.7978845608028654f * (x + 0.044715f * x * x * x);
    return x * fast_sigmoid(2.0f * u);
}
__device__ __forceinline__ int tid_from(int wv) { int ln; asm volatile("v_mbcnt_lo_u32_b32 %0, -1, 0\n\tv_mbcnt_hi_u32_b32 %0, -1, %0" : "=v"(ln)); return wv * 64 + ln; }
namespace pg8 {
constexpr int BM = 256, BK = 64, HALF = 128, HTB = HALF * BK * 2  , STAGE_BYTES = 8 * HTB, NXCD = 8, WGM = 8;

__host__ __device__ __forceinline__ int lds_byte(int r, int c) { const int st = (r >> 4) * 2 + (c >> 5), rr = r & 15, cc = c & 31, ob = rr * 64 + cc * 2; return st * 1024 + (ob ^ (((ob >> 9) & 1) << 5)); }
__host__ __device__ __forceinline__ void stage_rc(int b, int& R, int& C) { const int st = b / 1024, sb = b % 1024, swz = sb ^ (((sb >> 9) & 1) << 5); R = (st >> 1) * 16 + swz / 64; C = (st & 1) * 32 + (swz % 64) / 2; }
__host__ __device__ __forceinline__ int perm32(int rho) { const int n = rho >> 4, i = rho & 15; return 8 * (i >> 2) + 4 * n + (i & 3); }

struct Unit { int pm, pn, e, aux; };

typedef int v8i32_t __attribute__((ext_vector_type(8)));
typedef int v4i32_t __attribute__((ext_vector_type(4)));
__device__ __forceinline__ v8i32_t f8frag(bf16x8 lo, bf16x8 hi) { const u32x4 a = __builtin_bit_cast(u32x4, lo), b = __builtin_bit_cast(u32x4, hi); return (v8i32_t){(int)a.x, (int)a.y, (int)a.z, (int)a.w, (int)b.x, (int)b.y, (int)b.z, (int)b.w}; }
template <class Epi, class Sched, bool ALIGN_EPI, bool F8 = false>
__device__ __forceinline__ void gemm_phase(LAS unsigned char* lds, const bf16* Abase, const bf16* Bbase, const int K, const Sched& S, const Epi& E, const int wv) {
    const int tid = tid_from(wv), wid = __builtin_amdgcn_readfirstlane(tid >> 6), lane = tid & 63, wr = wid >> 2, wc = wid & 3, fr = lane & 15, fq = lane >> 4;
    const int nt = K / BK;
    unsigned voffB[2];
#pragma unroll
    for (int i = 0; i < 2; ++i) { int R, C; stage_rc(tid * 16 + i * 8192, R, C); const int Rb = Epi::PERM ? ((R & ~31) + perm32(R & 31)) : R;
        voffB[i] = (unsigned)(Rb * K + C) * 2u; }
#define PG8_AVOFF(u, h, i) ([&]() { int R_, C_; stage_rc(tid * 16 + (i) * 8192, R_, C_); return S.a_voff((u), (h) * HALF + R_, C_); }())
    const unsigned kstep = (unsigned)(BK * 2);
    const unsigned hstep = (unsigned)(HALF * K * 2);
    const unsigned ldsw = (unsigned)wid * 1024u;
    const int aoff = F8 ? lds_byte(wr * 64 + fr, fq * 16) : lds_byte(wr * 64 + fr, fq * 8), boff = F8 ? lds_byte(wc * 32 + fr, fq * 16) : lds_byte(wc * 32 + fr, fq * 8);
    const __amdgpu_buffer_rsrc_t rsA = __builtin_amdgcn_make_buffer_rsrc((void*)Abase, 0, 0x7fffffff, 0x00020000);
    const __amdgpu_buffer_rsrc_t rsB = __builtin_amdgcn_make_buffer_rsrc((void*)Bbase, 0, 0x7fffffff, 0x00020000);
#define PG8_SA(b, h) (((b) * 2 + (h)) * HTB)
#define PG8_SB(b, h) ((4 + (b) * 2 + (h)) * HTB)
#define PG8_STAGE_B(bufoff, soff) do { const int so_ = __builtin_amdgcn_readfirstlane((int)(soff)); _Pragma("unroll") for (int _i = 0; _i < 2; ++_i) \
        __builtin_amdgcn_raw_ptr_buffer_load_lds(rsB, (LAS void*)(lds + (bufoff) + ldsw + _i * 8192), 16, voffB[_i], so_, 0, 0); } while (0)
#define PG8_STAGE_A(bufoff, kbytes, H, NX) do { const int so_ = __builtin_amdgcn_readfirstlane((int)(kbytes)); unsigned o0_, o1_; \
        if constexpr (Sched::GATHER) { const u32x2 pk_ = *(const LAS u32x2*)((const LAS unsigned char*)park + (((ui + (NX)) & 1) * 8192 + tid * 16 + (H) * 8)); o0_ = pk_.x; o1_ = pk_.y; } else { o0_ = vc0; o1_ = vc1; } \
        __builtin_amdgcn_raw_ptr_buffer_load_lds(rsA, (LAS void*)(lds + (bufoff) + ldsw), 16, o0_, so_, 0, 0); \
        __builtin_amdgcn_raw_ptr_buffer_load_lds(rsA, (LAS void*)(lds + (bufoff) + ldsw + 8192), 16, o1_, so_, 0, 0); } while (0)
#define PG8_LD8(p_) __builtin_shufflevector(*(const LAS v4i32_t*)(p_), *(const LAS v4i32_t*)((p_) + 16), 0, 1, 2, 3, 4, 5, 6, 7)
#define PG8_LDA(dst, b, h) do { if constexpr (F8) { _Pragma("unroll") for (int m = 0; m < 4; ++m) dst##8[m] = PG8_LD8(lds + PG8_SA(b, h) + aoff + m * 2048); } \
        else { _Pragma("unroll") for (int m = 0; m < 4; ++m) _Pragma("unroll") for (int k = 0; k < 2; ++k) dst[m][k] = *(const LAS bf16x8*)(lds + PG8_SA(b, h) + aoff + m * 2048 + k * 1024); } } while (0)
#define PG8_LDB(dst, b, h) do { if constexpr (F8) { _Pragma("unroll") for (int n = 0; n < 2; ++n) dst##8[n] = PG8_LD8(lds + PG8_SB(b, h) + boff + n * 2048); } \
        else { _Pragma("unroll") for (int n = 0; n < 2; ++n) _Pragma("unroll") for (int k = 0; k < 2; ++k) dst[n][k] = *(const LAS bf16x8*)(lds + PG8_SB(b, h) + boff + n * 2048 + k * 1024); } } while (0)
#define PG8_MMA(ai, bj, At, Bt) do { __builtin_amdgcn_s_setprio(1); _Pragma("unroll") for (int m = 0; m < 4; ++m) _Pragma("unroll") for (int n = 0; n < 2; ++n) { \
        if constexpr (F8) { asm volatile("v_mfma_scale_f32_16x16x128_f8f6f4 %0, %1, %2, %0, %3, %3 op_sel_hi:[0,0,0]" : "+v"(acc[ai][bj][m][n]) : "v"(Bt##8[n]), "v"(At##8[m]), "v"(sc1_)); }   \
        else { _Pragma("unroll") for (int k = 0; k < 2; ++k) acc[ai][bj][m][n] = __builtin_amdgcn_mfma_f32_16x16x32_bf16(Bt[n][k], At[m][k], acc[ai][bj][m][n], 0, 0, 0); } } __builtin_amdgcn_s_setprio(0); } while (0)
#define PG8_WAIT_V(n) asm volatile("s_waitcnt vmcnt(" #n ")" ::: "memory")
#define PG8_WAIT_L(n) asm volatile("s_waitcnt lgkmcnt(" #n ")" ::: "memory")
#define PG8_BAR __builtin_amdgcn_s_barrier()
#define PG8_SCHED __builtin_amdgcn_sched_barrier(0)
    Unit cur, nxt; int ui = 0;
    if (!S.next(0, cur)) return;
    float zz_ = 0.f; asm volatile("" : "+v"(zz_));
    int sc1_ = 0x7f7f7f7f; asm volatile("" : "+v"(sc1_));
    LAS u32x4* const park = (LAS u32x4*)(lds + STAGE_BYTES + 8192);
    f32x4 acc[2][2][4][2];
#pragma unroll
    for (int a = 0; a < 2; ++a)
#pragma unroll
        for (int b = 0; b < 2; ++b)
#pragma unroll
            for (int m = 0; m < 4; ++m)
#pragma unroll
                for (int n = 0; n < 2; ++n) acc[a][b][m][n] = (f32x4){zz_, zz_, zz_, zz_};
    bf16x8 At[4][2], B0[2][2], B1[2][2]; v8i32_t At8[4], B08[2], B18[2];
    unsigned vc0 = 0u, vc1 = 0u;
    unsigned cA0, cA1, nA0, nA1;
    if constexpr (Sched::GATHER) { u32x4 pk; pk.x = PG8_AVOFF(cur, 0, 0); pk.y = PG8_AVOFF(cur, 0, 1); pk.z = PG8_AVOFF(cur, 1, 0); pk.w = PG8_AVOFF(cur, 1, 1); park[tid] = pk; }
    else { vc0 = PG8_AVOFF(cur, 0, 0); vc1 = PG8_AVOFF(cur, 0, 1); }
    cA0 = S.a_soff(cur, 0); cA1 = S.a_soff(cur, 1);
    unsigned cB = (unsigned)S.b_off(cur);
    PG8_STAGE_B(PG8_SB(0, 0), cB); PG8_STAGE_B(PG8_SB(0, 1), cB + hstep); PG8_STAGE_A(PG8_SA(0, 0), cA0, 0, 0); PG8_STAGE_A(PG8_SA(0, 1), cA1, 1, 0);
    if (wr == 1) PG8_BAR;
    PG8_WAIT_V(2); PG8_BAR;
    PG8_STAGE_B(PG8_SB(1, 0), cB + kstep); PG8_STAGE_A(PG8_SA(1, 0), cA0 + kstep, 0, 0); PG8_STAGE_B(PG8_SB(1, 1), cB + hstep + kstep);
    PG8_WAIT_V(6); PG8_BAR;
    for (;;) {
#define PG8_TRIP(a1k, a2k0, a2k1, a3k0, b2, b3, NX) do { \
              \
            PG8_LDB(B0, 0, 0); PG8_LDB(B1, 0, 1); PG8_SCHED; PG8_LDA(At, 0, 0); PG8_STAGE_A(PG8_SA(1, 1), a1k, 1, 0); \
            PG8_WAIT_V(8); PG8_WAIT_L(0); PG8_BAR; PG8_MMA(0, 0, At, B0); PG8_MMA(0, 1, At, B1); PG8_BAR; PG8_SCHED; \
              \
            PG8_LDA(At, 0, 1); PG8_STAGE_B(PG8_SB(0, 0), b2); PG8_STAGE_B(PG8_SB(0, 1), (b2) + hstep); PG8_STAGE_A(PG8_SA(0, 0), a2k0, 0, NX); \
            PG8_WAIT_V(8); PG8_WAIT_L(0); PG8_BAR; PG8_MMA(1, 0, At, B0); PG8_MMA(1, 1, At, B1); PG8_BAR; PG8_SCHED; \
              \
            PG8_LDB(B0, 1, 0); PG8_LDB(B1, 1, 1); PG8_SCHED; PG8_LDA(At, 1, 0); PG8_STAGE_A(PG8_SA(0, 1), a2k1, 1, NX); \
            PG8_WAIT_V(8); PG8_WAIT_L(0); PG8_BAR; PG8_MMA(0, 0, At, B0); PG8_MMA(0, 1, At, B1); PG8_BAR; PG8_SCHED; \
              \
            PG8_LDA(At, 1, 1); PG8_STAGE_B(PG8_SB(1, 0), b3); PG8_STAGE_B(PG8_SB(1, 1), (b3) + hstep); PG8_STAGE_A(PG8_SA(1, 0), a3k0, 0, NX); \
            PG8_WAIT_V(8); PG8_WAIT_L(0); PG8_BAR; PG8_MMA(1, 0, At, B0); PG8_MMA(1, 1, At, B1); PG8_BAR; PG8_SCHED; } while (0)
        const bool has_next = S.next(ui + 1, nxt);
        if constexpr (Sched::GATHER) { if (has_next) { u32x4 pk; pk.x = PG8_AVOFF(nxt, 0, 0); pk.y = PG8_AVOFF(nxt, 0, 1); pk.z = PG8_AVOFF(nxt, 1, 0); pk.w = PG8_AVOFF(nxt, 1, 1); park[((ui + 1) & 1) * 512 + tid] = pk; } }
        unsigned nB;
        if (has_next) { nA0 = S.a_soff(nxt, 0); nA1 = S.a_soff(nxt, 1); nB = (unsigned)S.b_off(nxt); }
        else { nA0 = cA0; nA1 = cA1; nB = cB; }
#pragma unroll 1
        for (int t = 0; t < nt; t += 2) {
            const bool last = (t == nt - 2);
            const unsigned k1 = (unsigned)(t + 1) * kstep, k2 = (unsigned)(t + 2) * kstep;
            const unsigned a2k0 = last ? nA0 : cA0 + k2, a2k1 = last ? nA1 : cA1 + k2, b2 = last ? nB : cB + k2;
            const int nx = (last && has_next) ? 1 : 0;
            PG8_TRIP(cA1 + k1, a2k0, a2k1, a2k0 + kstep, b2, b2 + kstep, nx);
        }
#undef PG8_TRIP
        if constexpr (ALIGN_EPI) { if (wr == 0) PG8_BAR; }
        { int tq_ = tid; asm volatile("" : "+v"(tq_));
          const int wq_ = __builtin_amdgcn_readfirstlane(tq_ >> 6); E(acc, cur, wq_ >> 2, wq_ & 3, tq_ & 15, (tq_ & 63) >> 4); }
        if (!has_next) break;
#pragma unroll
        for (int a = 0; a < 2; ++a)
#pragma unroll
            for (int b = 0; b < 2; ++b)
#pragma unroll
                for (int m = 0; m < 4; ++m)
#pragma unroll
                    for (int n = 0; n < 2; ++n) acc[a][b][m][n] = (f32x4){zz_, zz_, zz_, zz_};
        cur = nxt; cB = nB; cA0 = nA0; cA1 = nA1; ++ui;
        if constexpr (ALIGN_EPI) { if (wr == 1) PG8_BAR; }
    }
    PG8_WAIT_V(0);
    if constexpr (!ALIGN_EPI) { if (wr == 0) PG8_BAR; }
    PG8_BAR;
#undef PG8_SA
#undef PG8_AVOFF
#undef PG8_SB
#undef PG8_STAGE_A
#undef PG8_STAGE_B
#undef PG8_LDA
#undef PG8_LDB
#undef PG8_LD8
#undef PG8_MMA
#undef PG8_WAIT_V
#undef PG8_WAIT_L
#undef PG8_BAR
#undef PG8_SCHED
}

struct StaticOrder {
    int nM, nN, nwg, G, c, lda, dup;
    __device__ __forceinline__ void init(int M, int N, int lda_, int G_, int c_) { nM = M / BM; nN = N / BM; nwg = nM * nN; G = G_; c = c_; lda = lda_; dup = 0; }
    __device__ __forceinline__ bool next(int i, Unit& u) const {
        const long L = (long)(i >> dup) * G + c; if (L >= nwg) return false;
        int wgid = (int)L; { const int q = nwg / NXCD, r = nwg % NXCD, xcd = wgid % NXCD, off = wgid / NXCD; wgid = (xcd < r ? xcd * (q + 1) : r * (q + 1) + (xcd - r) * q) + off; }
        const int nig = WGM * nN, gid = wgid / nig, fm = gid * WGM, gsz = (nM - fm) < WGM ? (nM - fm) : WGM;
        u.pm = fm + ((wgid % nig) % gsz); u.pn = (wgid % nig) / gsz; u.e = 0; u.aux = 0; return true;
    }
    static constexpr bool GATHER = false;
    __device__ __forceinline__ unsigned a_voff(const Unit&, int R, int C) const { return (unsigned)((R & (HALF - 1)) * lda + C) * 2u; }
    __device__ __forceinline__ unsigned a_soff(const Unit& u, int h) const { return (unsigned)((u.pm * BM + h * HALF) * lda) * 2u; }
    __device__ __forceinline__ size_t b_off(const Unit& u) const { return (size_t)u.pn * BM * lda * 2; }
};
}

#define XB_TMO      128
#define XB_XCNT(j)  (256  + 64 * (j))
#define XB_XSUB(j)  (1280 + 64 * (j))
#define XB_XGEN(j)  (2304 + 64 * (j))
#define XB_TOP      3328
#define XB_TOPGEN   3392
#define XCD_BAR_WORDS 3456
#define XB_SPIN_CAP (1u << 18)

__device__ __forceinline__ unsigned xb_ld(unsigned* p)              { return __hip_atomic_load(p, __ATOMIC_RELAXED, __HIP_MEMORY_SCOPE_AGENT); }
__device__ __forceinline__ unsigned xb_add(unsigned* p, unsigned v) { return __hip_atomic_fetch_add(p, v, __ATOMIC_RELAXED, __HIP_MEMORY_SCOPE_AGENT); }
__device__ __forceinline__ unsigned xb_xcc_id() { return (unsigned)__builtin_amdgcn_s_getreg((3 << 11) | 20) & 0xFu; }
#define XB_SPIN(cond, bar) do { unsigned _sp = 0; while (cond) { __builtin_amdgcn_s_sleep(1); \
    if ((++_sp & 255u) == 0u) { if (xb_ld(&(bar)[XB_TMO])) break; if (_sp > XB_SPIN_CAP) { atomicAdd(&(bar)[XB_TMO], 1u); break; } } } } while (0)

struct XcdBarrier {
    unsigned* bar; unsigned x;
    volatile LAS unsigned* st;
};

__device__ __forceinline__ XcdBarrier xcd_barrier_post(unsigned* bar, volatile LAS unsigned* st) {
    XcdBarrier b; b.bar = bar; b.x = xb_xcc_id(); b.st = st;
    if (threadIdx.x == 0) (void)xb_add(&bar[XB_XCNT(b.x)], 1u);
    return b;
}
__device__ __forceinline__ void xcd_barrier_complete(unsigned* bar, unsigned x, unsigned& nloc, unsigned& nx) {
    const unsigned G = gridDim.x * gridDim.y * gridDim.z;
    unsigned sum, cnt, mine, sp = 0u;
    for (;;) {
        sum = 0u; cnt = 0u; mine = 0u;
#pragma unroll
        for (unsigned j = 0; j < 16; ++j) { const unsigned c = xb_ld(&bar[XB_XCNT(j)]); sum += c; cnt += (c > 0u) ? 1u : 0u; mine = (j == x) ? c : mine; }
        if (sum == G) break;
        __builtin_amdgcn_s_sleep(1);
        if ((++sp & 255u) == 0u) { if (xb_ld(&bar[XB_TMO])) break; if (sp > XB_SPIN_CAP) { atomicAdd(&bar[XB_TMO], 1u); break; } }
    }
    nloc = mine > 0u ? mine : 1u; nx = cnt > 0u ? cnt : 1u;
}

__device__ __forceinline__ void xcd_barrier(const XcdBarrier& b) {
    asm volatile("s_waitcnt vmcnt(0)" ::: "memory");
    __syncthreads();
    if (threadIdx.x == 0) {
        unsigned* bar = b.bar;
        __builtin_amdgcn_s_waitcnt(0);
        unsigned nloc = b.st[0], nx = b.st[1];
        if (nloc == 0u) { xcd_barrier_complete(bar, b.x, nloc, nx); b.st[0] = nloc; b.st[1] = nx; }
        const unsigned old = xb_add(&bar[XB_XSUB(b.x)], 1u);
        const unsigned gen = old / nloc;
        if (old + 1u == (gen + 1u) * nloc) {
            __builtin_amdgcn_fence(__ATOMIC_RELEASE, "agent");
            asm volatile("s_waitcnt vmcnt(0)" ::: "memory");
            const unsigned og = xb_add(&bar[XB_TOP], 1u);
            const unsigned tg = og / nx;
            if (og + 1u == (tg + 1u) * nx) xb_add(&bar[XB_TOPGEN], 1u);
            else XB_SPIN(xb_ld(&bar[XB_TOPGEN]) == tg, bar);
            __builtin_amdgcn_fence(__ATOMIC_ACQUIRE, "agent");
            xb_add(&bar[XB_XGEN(b.x)], 1u);
            asm volatile("s_waitcnt vmcnt(0)" ::: "memory");
        } else {
            XB_SPIN(xb_ld(&bar[XB_XGEN(b.x)]) == gen, bar);
            __builtin_amdgcn_fence(__ATOMIC_ACQUIRE, "agent");
            asm volatile("s_waitcnt vmcnt(0)" ::: "memory");
        }
    }
    __syncthreads();
}

struct Args { const float* in[23]; float* out; unsigned char* ws; int ph_lo, ph_hi, li, pad; };
#define CAS __attribute__((address_space(4)))
typedef const CAS Args& ArgsRef;
enum { I_X = 0, I_NORM1G, I_WIN, I_POOLW, I_POOLSC, I_CONVW, I_CONVB, I_WA, I_BA, I_WX, I_BX, I_LAM, I_QG, I_KG, I_OG, I_WOUT, I_NORM2G, I_WR, I_BR, I_WGU, I_BGU, I_WD, I_BD };

constexpr float WGU8_SCALE = 64.0f, WD8_SCALE = 64.0f, ACT8_SCALE = 4.0f;
struct TrDesc { const float* W; int K, N; bf16* WT; const float* gk; int mode, item; };
__device__ __forceinline__ void tr_load(const TrDesc& d, float (&v)[32], int lane) {
    const int nblk = d.N / 32, kb = d.item / nblk, nb = d.item % nblk, k0 = 64 * kb, n0 = 32 * nb;
#pragma unroll
    for (int i = 0; i < 32; ++i) { const int kk = 2 * i + (lane >> 5); v[i] = d.W[(size_t)(k0 + kk) * d.N + n0 + (lane & 31)]; }
}
__device__ __forceinline__ void tr_finish(const TrDesc& d, float (&v)[32], LAS float* scr, int lane) {
    const int nblk = d.N / 32, kb = d.item / nblk, nb = d.item % nblk, k0 = 64 * kb, n0 = 32 * nb; const int K = d.K;
#pragma unroll
    for (int i = 0; i < 32; ++i) { const int kk = 2 * i + (lane >> 5); float x = v[i]; if (d.gk) x *= d.gk[k0 + kk]; scr[kk * 33 + (lane & 31)] = x; }
    LDS_WAIT(); asm volatile("" ::: "memory");
    const int c = lane & 7;
#pragma unroll
    for (int j = 0; j < 4; ++j) { const int n = (lane >> 3) + 8 * j; const LAS float* s = scr + (8 * c) * 33 + n;
        u32x4 o; o.x = cvt_pk_bf16(s[0 * 33], s[1 * 33]); o.y = cvt_pk_bf16(s[2 * 33], s[3 * 33]); o.z = cvt_pk_bf16(s[4 * 33], s[5 * 33]); o.w = cvt_pk_bf16(s[6 * 33], s[7 * 33]);
        int dn = n0 + n; const int mode = d.mode;
        if (mode == 5) {
            const int L = dn & 255; dn = (dn & ~255) + 128 * ((L >> 3) & 1) + 32 * (L >> 6) + 8 * ((L >> 4) & 3) + (L & 7);
            int w0 = __builtin_amdgcn_cvt_pk_fp8_f32(s[0 * 33] * WD8_SCALE, s[1 * 33] * WD8_SCALE, 0, false); w0 = __builtin_amdgcn_cvt_pk_fp8_f32(s[2 * 33] * WD8_SCALE, s[3 * 33] * WD8_SCALE, w0, true);
            int w1 = __builtin_amdgcn_cvt_pk_fp8_f32(s[4 * 33] * WD8_SCALE, s[5 * 33] * WD8_SCALE, 0, false); w1 = __builtin_amdgcn_cvt_pk_fp8_f32(s[6 * 33] * WD8_SCALE, s[7 * 33] * WD8_SCALE, w1, true);
            *(u32x2*)((unsigned char*)d.WT + (size_t)dn * K + k0 + 8 * c) = (u32x2){(unsigned)w0, (unsigned)w1}; continue; }
        if (mode == 4) {
            const int jj = dn & 255; dn = (jj >> 7) * 256 + (dn >> 8) * 128 + (jj & 127);
            int w0 = __builtin_amdgcn_cvt_pk_fp8_f32(s[0 * 33] * WGU8_SCALE, s[1 * 33] * WGU8_SCALE, 0, false); w0 = __builtin_amdgcn_cvt_pk_fp8_f32(s[2 * 33] * WGU8_SCALE, s[3 * 33] * WGU8_SCALE, w0, true);
            int w1 = __builtin_amdgcn_cvt_pk_fp8_f32(s[4 * 33] * WGU8_SCALE, s[5 * 33] * WGU8_SCALE, 0, false); w1 = __builtin_amdgcn_cvt_pk_fp8_f32(s[6 * 33] * WGU8_SCALE, s[7 * 33] * WGU8_SCALE, w1, true);
            *(u32x2*)((unsigned char*)d.WT + (size_t)dn * K + k0 + 8 * c) = (u32x2){(unsigned)w0, (unsigned)w1}; continue; }
        if (mode == 1) { const int jj = dn & 255; dn = (jj >> 7) * 256 + (dn >> 8) * 128 + (jj & 127); }
        if (mode == 3 || (mode == 2 && (dn < C_Q || dn >= C_V))) {
            const int L = dn & 255; dn = (dn & ~255) + 128 * ((L >> 3) & 1) + 32 * (L >> 6) + 8 * ((L >> 4) & 3) + (L & 7); }
        else if (mode == 2) {
            const int rem = (dn - C_Q) & 511, sec = (dn - C_Q) >> 9, head = rem >> 6, d2 = rem & 63;
            dn = C_Q + sec * 512 + (head >> 2) * 256 + (d2 >> 5) * 128 + (head & 3) * 32 + (d2 & 31); }
        *(u32x4*)(d.WT + (size_t)dn * K + k0 + 8 * c) = o; }
    LDS_WAIT(); asm volatile("" ::: "memory");
}
__device__ __forceinline__ void cvt_row(const float* xrow, bf16* orow, float* ssq, int lane) {
    const f32x4* xr = (const f32x4*)xrow + lane;
    f32x4 v[4]; float s = 0.f;
#pragma unroll
    for (int j = 0; j < 4; ++j) { v[j] = xr[64 * j]; s += (v[j].x * v[j].x + v[j].y * v[j].y) + (v[j].z * v[j].z + v[j].w * v[j].w); }
    s = wave_sum(s);
    u32x2* o8 = (u32x2*)orow + lane;
#pragma unroll
    for (int j = 0; j < 4; ++j) { u32x2 w; w.x = cvt_pk_bf16(v[j].x, v[j].y); w.y = cvt_pk_bf16(v[j].z, v[j].w); o8[64 * j] = w; }
    if (lane == 0) *ssq = s;
}
__device__ __forceinline__ TrDesc tr_desc(ArgsRef a, int it) {
    unsigned char* ws = a.ws;
    constexpr int I_IN = 16 * 72, I_OUT = 16 * 32, I_R = 16, I_GU = 16 * 16, I_D = 4 * 32, I_S = 2;
    constexpr int PER_LAYER = I_IN + I_OUT + I_R + NEXP * I_GU + NEXP * I_D + 12 * I_S;
    const int l = it / PER_LAYER; int r = it % PER_LAYER; TrDesc d;
    if (r < I_IN) { d = TrDesc{a.in[I_WIN] + (size_t)l * DM * NIN, DM, NIN, (bf16*)(ws + WS_WIN) + (size_t)l * NIN * DM, a.in[I_NORM1G] + l * DM, 2, r}; return d; } r -= I_IN;
    if (r < I_OUT) { d = TrDesc{a.in[I_WOUT] + (size_t)l * DM * DM, DM, DM, (bf16*)(ws + WS_WOUT) + (size_t)l * DM * DM, a.in[I_OG] + l * DM, 3, r}; return d; } r -= I_OUT;
    if (r < I_R) { d = TrDesc{a.in[I_WR] + (size_t)l * DM * NEXP, DM, NEXP, (bf16*)(ws + WS_SMALL) + SM_WR + (size_t)l * NEXP * DM, a.in[I_NORM2G] + l * DM, 0, r}; return d; } r -= I_R;
    if (r < NEXP * I_GU) { const int e = r / I_GU; d = TrDesc{a.in[I_WGU] + (size_t)(l * NEXP + e) * DM * 512, DM, 512, (bf16*)(ws + WS_WGU + (size_t)(l * NEXP + e) * 512 * DM), a.in[I_NORM2G] + l * DM, 4, r % I_GU}; return d; } r -= NEXP * I_GU;
    if (r < NEXP * I_D) { const int e = r / I_D; d = TrDesc{a.in[I_WD] + (size_t)(l * NEXP + e) * EFF * DM, EFF, DM, (bf16*)(ws + WS_WD + (size_t)(l * NEXP + e) * DM * EFF), nullptr, 5, r % I_D}; return d; } r -= NEXP * I_D;
    { const int which = r / (4 * I_S), g = (r / I_S) % 4, sub = r % I_S;
      const float* src = a.in[which == 0 ? I_POOLW : (which == 1 ? I_WA : I_WX)] + (size_t)(l * 4 + g) * 4096;
      bf16* dst = (bf16*)(ws + WS_SMALL) + (which == 0 ? SM_POOLW : (which == 1 ? SM_WA : SM_WX)) + (size_t)(l * 4 + g) * 4096;
      d = TrDesc{src, 64, 64, dst, nullptr, 0, sub}; return d; }
}
__device__ __forceinline__ void phase_prologue(ArgsRef a, LAS unsigned char* lds, int wv) {
    const int tid = tid_from(wv), lane = tid & 63, wave = tid >> 6;
    LAS float* scr = (LAS float*)(lds + wave * 16384);
    const int gw = blockIdx.x * NWAVES + wave, NGW = gridDim.x * NWAVES;
    unsigned char* ws = a.ws;
    constexpr int PER_LAYER = 16 * 72 + 16 * 32 + 16 + NEXP * 16 * 16 + NEXP * 4 * 32 + 12 * 2;
    { int it = gw; float cur[32], nxt[32];
      TrDesc dc = tr_desc(a, it < 2 * PER_LAYER ? it : 0), dn = dc;
      if (it < 2 * PER_LAYER) tr_load(dc, cur, lane);
      while (it < 2 * PER_LAYER) { const int itn = it + NGW;
          if (itn < 2 * PER_LAYER) { dn = tr_desc(a, itn); tr_load(dn, nxt, lane); }
          tr_finish(dc, cur, scr, lane);
#pragma unroll
          for (int i = 0; i < 32; ++i) cur[i] = nxt[i];
          dc = dn; it = itn; } }
    { float* ct = (float*)(ws + WS_ROPE); float* st = ct + SEQ * 32;
      for (int idx = blockIdx.x * NTHR + tid; idx < SEQ * 32; idx += gridDim.x * NTHR) {
          const int pos = idx >> 5, i = idx & 31;
          const float inv = __builtin_amdgcn_exp2f(-(float)i * 0.41524101186092029f);
          const float ang = (float)pos * inv;
          const double rev = (double)ang * 0.15915494309189535; const double fr = rev - __builtin_rint(rev);
          const float f = (float)fr;
          ct[idx] = __builtin_amdgcn_cosf(f); st[idx] = __builtin_amdgcn_sinf(f); } }
    { const float* __restrict__ X = a.in[I_X]; bf16* __restrict__ xb = (bf16*)(ws + WS_XB); float* __restrict__ ssq = (float*)(ws + WS_SSQ);
      for (int m0 = gw * 4; m0 < NT; m0 += NGW * 4) { f32x4 v[4][4];
#pragma unroll
          for (int u = 0; u < 4; ++u)
#pragma unroll
              for (int j = 0; j < 4; ++j) v[u][j] = *((const f32x4*)(X + (size_t)(m0 + u) * DM) + lane + 64 * j);
#pragma unroll
          for (int u = 0; u < 4; ++u) { float s = 0.f;
#pragma unroll
              for (int j = 0; j < 4; ++j) s += (v[u][j].x * v[u][j].x + v[u][j].y * v[u][j].y) + (v[u][j].z * v[u][j].z + v[u][j].w * v[u][j].w);
              s = wave_sum(s);
#pragma unroll
              for (int j = 0; j < 4; ++j) { u32x2 w; w.x = cvt_pk_bf16(v[u][j].x, v[u][j].y); w.y = cvt_pk_bf16(v[u][j].z, v[u][j].w); *((u32x2*)(xb + (size_t)(m0 + u) * DM) + lane + 64 * j) = w; }
              if (lane == 0) ssq[m0 + u] = s; } } }
}

struct EpiIn {
    static constexpr bool PERM = true;
    bf16* O; const float* ssq; const float* qg; const float* kg; const float* ct; const float* st;
    __device__ __forceinline__ void operator()(const f32x4 (&acc)[2][2][4][2], const pg8::Unit& u, int wr, int wc, int fr, int fq) const {
        const int row0 = u.pm * 256 + wr * 64 + fr, col0 = u.pn * 256 + wc * 32 + 8 * fq;
        if (u.pn >= 3 && u.pn < 7) {
            const bool isq = u.pn < 5; const float* gp = (isq ? qg : kg) + 8 * fq; const float gs = isq ? (0.125f * 1.4426950408889634f) : 1.0f;
            f32x4 g[2][2];
#pragma unroll
            for (int bj = 0; bj < 2; ++bj)
#pragma unroll
                for (int n = 0; n < 2; ++n) g[bj][n] = *(const f32x4*)(gp + 32 * bj + 4 * n) * gs;
#pragma unroll
            for (int ai = 0; ai < 2; ++ai)
#pragma unroll
                for (int m = 0; m < 4; ++m) { const int row = row0 + ai * 128 + m * 16; const float rs = __builtin_amdgcn_rsqf(ssq[row] * (1.0f / DM) + EPS);
                    const int pos = row & (SEQ - 1);
                    const f32x4 c0 = *(const f32x4*)(ct + pos * 32 + 8 * fq), c1 = *(const f32x4*)(ct + pos * 32 + 8 * fq + 4), s0 = *(const f32x4*)(st + pos * 32 + 8 * fq), s1 = *(const f32x4*)(st + pos * 32 + 8 * fq + 4);
                    f32x4 v[2][2]; float ss = 0.f;
#pragma unroll
                    for (int bj = 0; bj < 2; ++bj)
#pragma unroll
                        for (int n = 0; n < 2; ++n) { v[bj][n] = acc[ai][bj][m][n] * rs; ss += (v[bj][n][0] * v[bj][n][0] + v[bj][n][1] * v[bj][n][1]) + (v[bj][n][2] * v[bj][n][2] + v[bj][n][3] * v[bj][n][3]); }
                    ss += __shfl_xor(ss, 16); ss += __shfl_xor(ss, 32);
                    const float rr = __builtin_amdgcn_rsqf(ss * (1.0f / 64.0f) + EPS);
#pragma unroll
                    for (int bj = 0; bj < 2; ++bj)
#pragma unroll
                        for (int n = 0; n < 2; ++n) v[bj][n] = v[bj][n] * rr * g[bj][n];
                    const f32x4 o00 = v[0][0] * c0 - v[1][0] * s0, o01 = v[0][1] * c1 - v[1][1] * s1, o10 = v[1][0] * c0 + v[0][0] * s0, o11 = v[1][1] * c1 + v[0][1] * s1;
                    bf16* rowp = O + (size_t)row * NIN + col0;
                    u32x4 w; w.x = cvt_pk_bf16(o00[0], o00[1]); w.y = cvt_pk_bf16(o00[2], o00[3]); w.z = cvt_pk_bf16(o01[0], o01[1]); w.w = cvt_pk_bf16(o01[2], o01[3]);
                    *(u32x4*)(rowp) = w;
                    w.x = cvt_pk_bf16(o10[0], o10[1]); w.y = cvt_pk_bf16(o10[2], o10[3]); w.z = cvt_pk_bf16(o11[0], o11[1]); w.w = cvt_pk_bf16(o11[2], o11[3]);
                    *(u32x4*)(rowp + 128) = w; }
            return;
        }
#pragma unroll
        for (int ai = 0; ai < 2; ++ai)
#pragma unroll
            for (int m = 0; m < 4; ++m) { const int row = row0 + ai * 128 + m * 16; const float rs = __builtin_amdgcn_rsqf(ssq[row] * (1.0f / DM) + EPS);
                bf16* rowp = O + (size_t)row * NIN + u.pn * 256 + wc * 64 + fq * 16;
#pragma unroll
                for (int bj = 0; bj < 2; ++bj) { const f32x4 v0 = acc[ai][bj][m][0] * rs, v1 = acc[ai][bj][m][1] * rs;
                    u32x4 w; w.x = cvt_pk_bf16(v0[0], v0[1]); w.y = cvt_pk_bf16(v0[2], v0[3]); w.z = cvt_pk_bf16(v1[0], v1[1]); w.w = cvt_pk_bf16(v1[2], v1[3]);
                    *(u32x4*)(rowp + bj * 8) = w; } }
    }
};
struct EpiOut {
    static constexpr bool PERM = true;
    bf16* xb; float* ssqp; unsigned char* xb8;
    __device__ __forceinline__ void operator()(const f32x4 (&acc)[2][2][4][2], const pg8::Unit& u, int wr, int wc, int fr, int fq) const {
        const int row0 = u.pm * 256 + wr * 64 + fr, col0 = u.pn * 256 + wc * 64 + fq * 16;
#pragma unroll
        for (int am = 0; am < 2; ++am) { u32x4 xi[4][2];
#pragma unroll
            for (int mm = 0; mm < 4; ++mm) { const int ai = am, m = mm; const size_t off = (size_t)(row0 + ai * 128 + m * 16) * DM + col0; xi[mm][0] = *(const u32x4*)(xb + off); xi[mm][1] = *(const u32x4*)(xb + off + 8); }
            asm volatile("" ::: "memory");
#pragma unroll
            for (int mm = 0; mm < 4; ++mm) { const int ai = am, m = mm; const int row = row0 + ai * 128 + m * 16; const size_t off = (size_t)row * DM + col0; float s = 0.f; u32x4 w8;
#pragma unroll
                for (int bj = 0; bj < 2; ++bj) { const u32x4 x = xi[mm][bj];
                    const f32x4 o0 = (f32x4){bflo(x.x), bfhi(x.x), bflo(x.y), bfhi(x.y)} + acc[ai][bj][m][0], o1 = (f32x4){bflo(x.z), bfhi(x.z), bflo(x.w), bfhi(x.w)} + acc[ai][bj][m][1];
                    s += ((o0[0] * o0[0] + o0[1] * o0[1]) + (o0[2] * o0[2] + o0[3] * o0[3])) + ((o1[0] * o1[0] + o1[1] * o1[1]) + (o1[2] * o1[2] + o1[3] * o1[3]));
                    u32x4 w; w.x = cvt_pk_bf16(o0[0], o0[1]); w.y = cvt_pk_bf16(o0[2], o0[3]); w.z = cvt_pk_bf16(o1[0], o1[1]); w.w = cvt_pk_bf16(o1[2], o1[3]);
                    *(u32x4*)(xb + off + bj * 8) = w;
                    int f0 = __builtin_amdgcn_cvt_pk_fp8_f32(o0[0], o0[1], 0, false); f0 = __builtin_amdgcn_cvt_pk_fp8_f32(o0[2], o0[3], f0, true);
                    int f1 = __builtin_amdgcn_cvt_pk_fp8_f32(o1[0], o1[1], 0, false); f1 = __builtin_amdgcn_cvt_pk_fp8_f32(o1[2], o1[3], f1, true);
                    if (bj == 0) { w8.x = (unsigned)f0; w8.y = (unsigned)f1; } else { w8.z = (unsigned)f0; w8.w = (unsigned)f1; } }
                *(u32x4*)(xb8 + off) = w8;
                s += __shfl_xor(s, 16); s += __shfl_xor(s, 32);
                if (fq == 0) ssqp[(size_t)row * 16 + u.pn * 4 + wc] = s; }
            asm volatile("" ::: "memory"); }
    }
};

template <int MODE> struct MoeOrder {
    static constexpr bool GATHER = (MODE == 0 || MODE == 2);
    const LAS int* tab; int npn, G, c; const int* list; int dup;
    __device__ __forceinline__ bool next(int i, pg8::Unit& u) const {
        const int ii = i >> dup; const int total = __builtin_amdgcn_readfirstlane(tab[64]); const int nfr = total / G, nfu = nfr * npn;
        int gb;
        if (ii < nfu) { gb = (ii / npn) * G + c; u.pn = ii % npn; }
        else { const int L = (ii - nfu) * G + c; gb = nfr * G + L / npn; u.pn = L % npn; if (gb >= total) return false; }
        const int e = __builtin_amdgcn_readfirstlane((int)((const LAS unsigned char*)(tab + 80))[gb]);
        u.e = e; u.pm = gb; u.aux = gb - __builtin_amdgcn_readfirstlane(tab[32 + e]); return true;
    }
    __device__ __forceinline__ unsigned a_voff(const pg8::Unit& u, int R, int C) const {
        if constexpr (MODE == 0) { const int pos = u.aux * 256 + R; const int ne = tab[u.e]; int tok = 0; if (pos < ne) tok = list[u.e * NT + pos] >> 2; return (unsigned)(tok * DM + C) * 2u; }
        else if constexpr (MODE == 2) { const int pos = u.aux * 256 + R; const int ne = tab[u.e]; int tok = 0; if (pos < ne) tok = list[u.e * NT + pos] >> 2; return (unsigned)(tok * (DM / 2) + C) * 2u; }
        else if constexpr (MODE == 3) return (unsigned)((R & 127) * (EFF / 2) + C) * 2u;
        else return (unsigned)((R & 127) * EFF + C) * 2u;
    }
    __device__ __forceinline__ unsigned a_soff(const pg8::Unit& u, int h) const { if constexpr (MODE == 1) return (unsigned)((u.pm * 256 + h * 128) * EFF) * 2u; else if constexpr (MODE == 3) return (unsigned)((u.pm * 256 + h * 128) * EFF); else return 0u; }
    __device__ __forceinline__ size_t b_off(const pg8::Unit& u) const {
        if constexpr (MODE == 0) return ((size_t)u.e * 512 + (size_t)u.pn * 256) * DM * 2;
        else if constexpr (MODE == 2) return ((size_t)u.e * 512 + (size_t)u.pn * 256) * DM;
        else if constexpr (MODE == 3) return ((size_t)u.e * DM + (size_t)u.pn * 256) * EFF;
        else return ((size_t)u.e * DM + (size_t)u.pn * 256) * EFF * 2;
    }
};
struct EpiGU {
    static constexpr bool PERM = true;
    unsigned char* act; const float* lrstd; const float* bgu;
    __device__ __forceinline__ void operator()(const f32x4 (&acc)[2][2][4][2], const pg8::Unit& u, int wr, int wc, int fr, int fq) const {
        const int r0 = wr * 64 + fr, cl0 = wc * 32 + 8 * fq;
        const float* bg = bgu + u.e * 512 + u.pn * 128 + cl0;
        const f32x4 bg0 = *(const f32x4*)(bg), bg1 = *(const f32x4*)(bg + 4), bu0 = *(const f32x4*)(bg + 256), bu1 = *(const f32x4*)(bg + 260);
#pragma unroll
        for (int ai = 0; ai < 2; ++ai)
#pragma unroll
            for (int m = 0; m < 4; ++m) { const int r = r0 + ai * 128 + m * 16; const float rs = lrstd[(size_t)u.e * NT + u.aux * 256 + r] * (1.0f / WGU8_SCALE);
                f32x4 g0 = acc[ai][0][m][0] * rs + bg0, g1 = acc[ai][0][m][1] * rs + bg1, u0 = acc[ai][1][m][0] * rs + bu0, u1 = acc[ai][1][m][1] * rs + bu1;
                float o[8];
#pragma unroll
                for (int j = 0; j < 4; ++j) { const float ga = fminf(g0[j], 7.0f), ua = fminf(fmaxf(u0[j], -7.0f), 7.0f); o[j] = (ua + 1.0f) * ga * fast_sigmoid(1.702f * ga);
                                              const float gb = fminf(g1[j], 7.0f), ub = fminf(fmaxf(u1[j], -7.0f), 7.0f); o[4 + j] = (ub + 1.0f) * gb * fast_sigmoid(1.702f * gb); }
                int w0 = __builtin_amdgcn_cvt_pk_fp8_f32(o[0] * ACT8_SCALE, o[1] * ACT8_SCALE, 0, false); w0 = __builtin_amdgcn_cvt_pk_fp8_f32(o[2] * ACT8_SCALE, o[3] * ACT8_SCALE, w0, true);
                int w1 = __builtin_amdgcn_cvt_pk_fp8_f32(o[4] * ACT8_SCALE, o[5] * ACT8_SCALE, 0, false); w1 = __builtin_amdgcn_cvt_pk_fp8_f32(o[6] * ACT8_SCALE, o[7] * ACT8_SCALE, w1, true);
                *(u32x2*)(act + (size_t)(u.pm * 256 + r) * EFF + u.pn * 128 + cl0) = (u32x2){(unsigned)w0, (unsigned)w1}; }
    }
};
constexpr float Y8_SCALE = 32.0f;
struct EpiDown {
    static constexpr bool PERM = true;
    unsigned char* y; const int* list; const float* lgate; const float* bd; const LAS int* tab;
    __device__ __forceinline__ void operator()(const f32x4 (&acc)[2][2][4][2], const pg8::Unit& u, int wr, int wc, int fr, int fq) const {
        const int r0 = wr * 64 + fr, col0 = u.pn * 256 + wc * 64 + fq * 16; const int ne = tab[u.e];
        const float* bp = bd + u.e * DM + col0;
#pragma unroll
        for (int ai = 0; ai < 2; ++ai) { int asg[4]; float gt[4];
#pragma unroll
            for (int m = 0; m < 4; ++m) { const int pos = u.aux * 256 + r0 + ai * 128 + m * 16; const bool ok = pos < ne;
                asg[m] = ok ? list[(size_t)u.e * NT + pos] : -1; gt[m] = ok ? lgate[(size_t)u.e * NT + pos] * Y8_SCALE : 0.f; }
            asm volatile("" ::: "memory");
#pragma unroll
            for (int m = 0; m < 4; ++m) {
                if (asg[m] >= 0) { unsigned char* rowp = y + (size_t)asg[m] * DM + col0; const float g = gt[m]; u32x4 wv4;
#pragma unroll
                    for (int bj = 0; bj < 2; ++bj) { const f32x4 b0 = *(const f32x4*)(bp + bj * 8), b1 = *(const f32x4*)(bp + bj * 8 + 4);
                        const f32x4 v0 = (acc[ai][bj][m][0] * (1.0f / (WD8_SCALE * ACT8_SCALE)) + b0) * g, v1 = (acc[ai][bj][m][1] * (1.0f / (WD8_SCALE * ACT8_SCALE)) + b1) * g;
                        int w0 = __builtin_amdgcn_cvt_pk_fp8_f32(v0[0], v0[1], 0, false); w0 = __builtin_amdgcn_cvt_pk_fp8_f32(v0[2], v0[3], w0, true);
                        int w1 = __builtin_amdgcn_cvt_pk_fp8_f32(v1[0], v1[1], 0, false); w1 = __builtin_amdgcn_cvt_pk_fp8_f32(v1[2], v1[3], w1, true);
                        if (bj == 0) { wv4.x = (unsigned)w0; wv4.y = (unsigned)w1; } else { wv4.z = (unsigned)w0; wv4.w = (unsigned)w1; } }
                    *(u32x4*)rowp = wv4; }
                asm volatile("" ::: "memory"); } }
    }
};
__device__ __forceinline__ void moe_tables(LAS int* tab, const unsigned* cnt, int wv) {
    __syncthreads();
    const int tid_ = tid_from(wv);
    if (tid_ == 0) { int pre = 0;
        for (int e = 0; e < NEXP; ++e) { const int n = (int)__hip_atomic_load(cnt + e, RLX_AGENT); tab[e] = n; tab[32 + e] = pre; pre += (n + 255) >> 8; }
        tab[64] = pre; }
    __syncthreads();
    { LAS unsigned char* eb = (LAS unsigned char*)(tab + 80); const int total = tab[64];
      for (int gb = tid_; gb < total; gb += NTHR) { int e = 0;
          for (int k = 1; k < NEXP; ++k) { if (tab[32 + k] <= gb) e = k; }
          eb[gb] = (unsigned char)e; } }
    __syncthreads();
}

__device__ __forceinline__ void phase_qkprep(ArgsRef a, int layer, int wv, bool dry) {
    const int tid = tid_from(wv), lane = tid & 63, wave = tid >> 6;
    const int gw = blockIdx.x * NWAVES + wave, NGW = gridDim.x * NWAVES;
    bf16* proj = (bf16*)(a.ws + WS_PROJ);
    const float* __restrict__ ct = (const float*)(a.ws + WS_ROPE); const float* __restrict__ st = ct + SEQ * 32;
    const int d0 = (lane & 7) * 8, p0 = d0 & 31;
    float gq[8], gk[8];
#pragma unroll
    for (int j = 0; j < 8; ++j) { gq[j] = a.in[I_QG][layer * 64 + d0 + j] * (0.125f * 1.4426950408889634f); gk[j] = a.in[I_KG][layer * 64 + d0 + j]; }
    const bool second = (lane & 4) != 0;
    constexpr int TB = 4;
    for (int t0 = gw * TB; t0 < NT; t0 += NGW * TB) {
        u32x4 w[TB][2]; f32x4 cs[TB][4];
#pragma unroll
        for (int u = 0; u < TB; ++u) { const int t = t0 + u, pos = t & (SEQ - 1);
            w[u][0] = *(const u32x4*)(proj + (size_t)t * NIN + C_Q + lane * 8); w[u][1] = *(const u32x4*)(proj + (size_t)t * NIN + C_Q + 512 + lane * 8);
            cs[u][0] = *(const f32x4*)(ct + pos * 32 + p0); cs[u][1] = *(const f32x4*)(ct + pos * 32 + p0 + 4); cs[u][2] = *(const f32x4*)(st + pos * 32 + p0); cs[u][3] = *(const f32x4*)(st + pos * 32 + p0 + 4); }
#pragma unroll
        for (int u = 0; u < TB; ++u) { const int t = t0 + u;
            float c[8], s[8];
#pragma unroll
            for (int j = 0; j < 4; ++j) { c[j] = cs[u][0][j]; c[4 + j] = cs[u][1][j]; s[j] = cs[u][2][j]; s[4 + j] = cs[u][3][j]; }
#pragma unroll
            for (int i = 0; i < 2; ++i) {
                const u32x4 ww = w[u][i];
                float x[8]; x[0] = bflo(ww.x); x[1] = bfhi(ww.x); x[2] = bflo(ww.y); x[3] = bfhi(ww.y); x[4] = bflo(ww.z); x[5] = bfhi(ww.z); x[6] = bflo(ww.w); x[7] = bfhi(ww.w);
                float ss = 0.f;
#pragma unroll
                for (int j = 0; j < 8; ++j) ss += x[j] * x[j];
                ss += __shfl_xor(ss, 1); ss += __shfl_xor(ss, 2); ss += __shfl_xor(ss, 4);
                const float rs = __builtin_amdgcn_rsqf(ss * (1.0f / 64.0f) + EPS);
                float o[8];
#pragma unroll
                for (int j = 0; j < 8; ++j) { const float yv = x[j] * rs * (i == 0 ? gq[j] : gk[j]); const float pv = __shfl_xor(yv, 4);
                    o[j] = second ? (yv * c[j] + pv * s[j]) : (yv * c[j] - pv * s[j]); }
                u32x4 r; r.x = cvt_pk_bf16(o[0], o[1]); r.y = cvt_pk_bf16(o[2], o[3]); r.z = cvt_pk_bf16(o[4], o[5]); r.w = cvt_pk_bf16(o[6], o[7]);
                if (!dry || o[0] == 12345.678f) *(u32x4*)(proj + (size_t)t * NIN + C_Q + i * 512 + lane * 8) = r;
            } }
    }
}

__device__ __forceinline__ void phase_pool(ArgsRef a, LAS unsigned char* lds, int layer, int wv) {
    const int tid = tid_from(wv), lane = tid & 63, wave = __builtin_amdgcn_readfirstlane(tid >> 6);
    const bf16* proj = (const bf16*)(a.ws + WS_PROJ); bf16* YP = (bf16*)(a.ws + WS_YP); float* SSQPOOL = (float*)(a.ws + WS_SSQPOOL);
    const int g = wave & 3, w = 2 << g, lr = lane & 15, lq = lane >> 4;
    constexpr int US = 72;
    LAS bf16* Uw = (LAS bf16*)(lds + wave * 11520);
    LAS bf16* Xw = (LAS bf16*)(lds + wave * 11520 + 6784);
    const bf16* pw = (const bf16*)(a.ws + WS_SMALL) + SM_POOLW + (size_t)(layer * 4 + g) * 4096;
    bf16x8 bw[4][2]; float psc[4];
#pragma unroll
    for (int et = 0; et < 4; ++et) {
#pragma unroll
        for (int ks = 0; ks < 2; ++ks) bw[et][ks] = *(const bf16x8*)(pw + (et * 16 + lr) * 64 + ks * 32 + lq * 8);
        psc[et] = a.in[I_POOLSC][layer * 256 + g * 64 + et * 16 + lr]; }
    __syncthreads();
    const int nstreams = gridDim.x * 2;
    for (int tk = blockIdx.x * 2 + (wave >> 2); tk < NT / 32; tk += nstreams) {
        const int t0 = tk * 32, s0 = t0 & (SEQ - 1);
#pragma unroll
        for (int j = 0; j < 6; ++j) { const int id = lane + 64 * j;
            if (id < 47 * 8) { const int row = id >> 3, c8 = (id & 7) * 8; u32x4 v = {0u, 0u, 0u, 0u};
                if (s0 - 15 + row >= 0) v = *(const u32x4*)(proj + (size_t)(t0 - 15 + row) * NIN + C_POOL + g * 64 + c8);
                *(LAS u32x4*)(Uw + row * US + c8) = v; } }
        LDS_WAIT(); asm volatile("" ::: "memory");
        { float sum = 0.f;
          for (int j = 1; j < w; ++j) sum += bf2f(Uw[(15 - j) * US + lane]);
#pragma unroll 8
          for (int tl = 0; tl < 32; ++tl) { const float cur = bf2f(Uw[(15 + tl) * US + lane]); sum += cur;
              const int cnt = min(w, s0 + tl + 1); const float pooled = sum * __builtin_amdgcn_rcpf((float)cnt) - cur;
              Xw[tl * US + lane] = f2bf(pooled); sum -= bf2f(Uw[(15 + tl - w + 1) * US + lane]); } }
        LDS_WAIT(); asm volatile("" ::: "memory");
        f32x4 acc[2][4];
#pragma unroll
        for (int rt = 0; rt < 2; ++rt) { const bf16x8 a0 = *(const LAS bf16x8*)(Xw + (rt * 16 + lr) * US + lq * 8), a1 = *(const LAS bf16x8*)(Xw + (rt * 16 + lr) * US + 32 + lq * 8);
#pragma unroll
            for (int et = 0; et < 4; ++et) { acc[rt][et] = __builtin_amdgcn_mfma_f32_16x16x32_bf16(a0, bw[et][0], (f32x4){0.f, 0.f, 0.f, 0.f}, 0, 0, 0); acc[rt][et] = __builtin_amdgcn_mfma_f32_16x16x32_bf16(a1, bw[et][1], acc[rt][et], 0, 0, 0); } }
#pragma unroll
        for (int rt = 0; rt < 2; ++rt)
#pragma unroll
            for (int reg = 0; reg < 4; ++reg) { const int tl = rt * 16 + lq * 4 + reg; float s = 0.f;
#pragma unroll
                for (int et = 0; et < 4; ++et) { const float y = acc[rt][et][reg] * psc[et]; s += y * y; Uw[tl * 64 + et * 16 + lr] = f2bf(y); }
                s += __shfl_xor(s, 1); s += __shfl_xor(s, 2); s += __shfl_xor(s, 4); s += __shfl_xor(s, 8);
                if (lr == 0) SSQPOOL[(size_t)(t0 + tl) * 4 + g] = s; }
        LDS_WAIT(); asm volatile("" ::: "memory");
#pragma unroll
        for (int j = 0; j < 4; ++j) { const int id = lane + 64 * j, row = id >> 3, c8 = (id & 7) * 8;
            *(u32x4*)(YP + (size_t)(t0 + row) * 256 + g * 64 + c8) = *(const LAS u32x4*)(Uw + row * 64 + c8); }
        LDS_WAIT(); asm volatile("" ::: "memory");
    }
}

__device__ __forceinline__ void phase_lru_a(ArgsRef a, LAS unsigned char* lds, int layer, int wv) {
    const int tid = tid_from(wv), lane = tid & 63, wave = __builtin_amdgcn_readfirstlane(tid >> 6);
    const bf16* proj = (const bf16*)(a.ws + WS_PROJ);
    bf16* HL = (bf16*)(a.ws + WS_HL); bf16* PL = (bf16*)(a.ws + WS_PL);
    float* AGGH = (float*)(a.ws + WS_AGGH); float* AGGP = (float*)(a.ws + WS_AGGP);
    const int n = wave & 3, lr = lane & 15, lq = lane >> 4;
    constexpr int US = 72;
    LAS bf16* Uw = (LAS bf16*)(lds + wave * 13824);
    LAS bf16* Xw = (LAS bf16*)(lds + wave * 13824 + 5120);
    LAS bf16* Pw = (LAS bf16*)(lds + wave * 13824 + 9728);
    const int chl = n * 64 + lane;
    const float cw0 = a.in[I_CONVW][(layer * 4 + 0) * 256 + chl], cw1 = a.in[I_CONVW][(layer * 4 + 1) * 256 + chl], cw2 = a.in[I_CONVW][(layer * 4 + 2) * 256 + chl], cw3 = a.in[I_CONVW][(layer * 4 + 3) * 256 + chl];
    const float cb = a.in[I_CONVB][layer * 256 + chl];
    const bf16* wa = (const bf16*)(a.ws + WS_SMALL) + SM_WA + (size_t)(layer * 4 + n) * 4096;
    const bf16* wx = (const bf16*)(a.ws + WS_SMALL) + SM_WX + (size_t)(layer * 4 + n) * 4096;
    bf16x8 ba[4][2], bx[4][2]; float bav[4], bxv[4], sp[4];
#pragma unroll
    for (int et = 0; et < 4; ++et) {
#pragma unroll
        for (int ks = 0; ks < 2; ++ks) { const int wo = (et * 16 + lr) * 64 + ks * 32 + lq * 8; ba[et][ks] = *(const bf16x8*)(wa + wo); bx[et][ks] = *(const bf16x8*)(wx + wo); }
        const int chn = layer * 256 + n * 64 + et * 16 + lr; bav[et] = a.in[I_BA][chn]; bxv[et] = a.in[I_BX][chn]; sp[et] = log1pf(expf(-a.in[I_LAM][chn])); }
    __syncthreads();
    const int nstreams = gridDim.x * 2;
    for (int ck = blockIdx.x * 2 + (wave >> 2); ck < NT / LRU_CH; ck += nstreams) {
        const int t0 = ck * LRU_CH, s0 = t0 & (SEQ - 1);
#pragma unroll
        for (int j = 0; j < 5; ++j) { const int id = lane + 64 * j;
            if (id < 35 * 8) { const int row = id >> 3, c8 = (id & 7) * 8; u32x4 w = {0u, 0u, 0u, 0u};
                if (s0 - 3 + row >= 0) w = *(const u32x4*)(proj + (size_t)(t0 - 3 + row) * NIN + C_LRU + n * 64 + c8);
                *(LAS u32x4*)(Uw + row * US + c8) = w; } }
        LDS_WAIT(); asm volatile("" ::: "memory");
        { float u0 = bf2f(Uw[0 * US + lane]), u1 = bf2f(Uw[1 * US + lane]), u2 = bf2f(Uw[2 * US + lane]);
#pragma unroll 8
          for (int tl = 0; tl < LRU_CH; ++tl) { const float u3 = bf2f(Uw[(tl + 3) * US + lane]); const float xc = cb + cw0 * u0 + cw1 * u1 + cw2 * u2 + cw3 * u3;
              Xw[tl * US + lane] = f2bf(xc); u0 = u1; u1 = u2; u2 = u3; } }
        LDS_WAIT(); asm volatile("" ::: "memory");
        f32x4 ca[2][4], cx[2][4];
#pragma unroll
        for (int rt = 0; rt < 2; ++rt) { const bf16x8 a0 = *(const LAS bf16x8*)(Xw + (rt * 16 + lr) * US + lq * 8), a1 = *(const LAS bf16x8*)(Xw + (rt * 16 + lr) * US + 32 + lq * 8);
#pragma unroll
            for (int et = 0; et < 4; ++et) { ca[rt][et] = __builtin_amdgcn_mfma_f32_16x16x32_bf16(a0, ba[et][0], (f32x4){0.f, 0.f, 0.f, 0.f}, 0, 0, 0); ca[rt][et] = __builtin_amdgcn_mfma_f32_16x16x32_bf16(a1, ba[et][1], ca[rt][et], 0, 0, 0);
                                              cx[rt][et] = __builtin_amdgcn_mfma_f32_16x16x32_bf16(a0, bx[et][0], (f32x4){0.f, 0.f, 0.f, 0.f}, 0, 0, 0); cx[rt][et] = __builtin_amdgcn_mfma_f32_16x16x32_bf16(a1, bx[et][1], cx[rt][et], 0, 0, 0); } }
#pragma unroll
        for (int et = 0; et < 4; ++et) {
            float Pl[2][4], Hl[2][4], At[2], Ht[2];
#pragma unroll
            for (int rt = 0; rt < 2; ++rt) { float P = 1.f, H = 0.f;
#pragma unroll
                for (int reg = 0; reg < 4; ++reg) { const int tl = rt * 16 + lq * 4 + reg;
                    const float r = fast_sigmoid(ca[rt][et][reg] + bav[et]), ig = fast_sigmoid(cx[rt][et][reg] + bxv[et]);
                    const float log_a = -8.0f * r * sp[et]; const float av = fast_exp(log_a);
                    float mult = sqrtf(fmaxf(1.0f - fast_exp(2.0f * log_a), 0.f)); if (s0 + tl == 0) mult = 1.0f;
                    const float bv = mult * ig * bf2f(Xw[tl * US + et * 16 + lr]);
                    H = av * H + bv; P *= av; Pl[rt][reg] = P; Hl[rt][reg] = H; }
                At[rt] = P; Ht[rt] = H; }
            float Ai[2], Hi[2];
#pragma unroll
            for (int rt = 0; rt < 2; ++rt) { float A = At[rt], H = Ht[rt];
                { const float Ap = __shfl_up(A, 16), Hp = __shfl_up(H, 16); if (lq >= 1) { H = A * Hp + H; A = A * Ap; } }
                { const float Ap = __shfl_up(A, 32), Hp = __shfl_up(H, 32); if (lq >= 2) { H = A * Hp + H; A = A * Ap; } }
                Ai[rt] = A; Hi[rt] = H; }
            float Ac[2], Hc[2];
#pragma unroll
            for (int rt = 0; rt < 2; ++rt) { const float Ap = __shfl_up(Ai[rt], 16), Hp = __shfl_up(Hi[rt], 16); Ac[rt] = (lq >= 1) ? Ap : 1.f; Hc[rt] = (lq >= 1) ? Hp : 0.f; }
            const float A0t = __shfl(Ai[0], 48 + lr), H0t = __shfl(Hi[0], 48 + lr);
            Hc[1] = Ac[1] * H0t + Hc[1]; Ac[1] = Ac[1] * A0t;
#pragma unroll
            for (int rt = 0; rt < 2; ++rt)
#pragma unroll
                for (int reg = 0; reg < 4; ++reg) { const int tl = rt * 16 + lq * 4 + reg;
                    Uw[tl * 64 + et * 16 + lr] = f2bf(Hl[rt][reg] + Pl[rt][reg] * Hc[rt]); Pw[tl * 64 + et * 16 + lr] = f2bf(Pl[rt][reg] * Ac[rt]); }
            if (lq == 3) { const size_t o = (size_t)ck * 256 + n * 64 + et * 16 + lr;
                AGGP[o] = Ai[1] * A0t; AGGH[o] = Ai[1] * H0t + Hi[1]; }
        }
        LDS_WAIT(); asm volatile("" ::: "memory");
#pragma unroll
        for (int j = 0; j < 4; ++j) { const int id = lane + 64 * j, row = id >> 3, c8 = (id & 7) * 8;
            *(u32x4*)(HL + (size_t)(t0 + row) * 256 + n * 64 + c8) = *(const LAS u32x4*)(Uw + row * 64 + c8);
            *(u32x4*)(PL + (size_t)(t0 + row) * 256 + n * 64 + c8) = *(const LAS u32x4*)(Pw + row * 64 + c8); }
        LDS_WAIT(); asm volatile("" ::: "memory");
    }
}
__device__ __forceinline__ void phase_lru_b(ArgsRef a, int wv) {
    const float* __restrict__ AGGH = (const float*)(a.ws + WS_AGGH); const float* __restrict__ AGGP = (const float*)(a.ws + WS_AGGP); float* __restrict__ CARRY = (float*)(a.ws + WS_CARRY);
    const int tid_ = tid_from(wv);
    for (int idx = blockIdx.x * NTHR + tid_; idx < NB * 256; idx += gridDim.x * NTHR) { const int b = idx >> 8, c = idx & 255; float carry = 0.f;
        for (int k0 = 0; k0 < LRU_NCH; k0 += 16) { float pp[16], hh[16];
#pragma unroll
            for (int k = 0; k < 16; ++k) { const size_t o = (size_t)(b * LRU_NCH + k0 + k) * 256 + c; pp[k] = AGGP[o]; hh[k] = AGGH[o]; }
#pragma unroll
            for (int k = 0; k < 16; ++k) { const size_t o = (size_t)(b * LRU_NCH + k0 + k) * 256 + c; CARRY[o] = carry; carry = pp[k] * carry + hh[k]; } } }
}
typedef short v4i16_t __attribute__((ext_vector_type(4)));
struct AttnUnit { int h, n, r, dl, g, first; size_t rowb; };
__device__ __forceinline__ AttnUnit attn_unit(int bh, int hf, int i) {
    AttnUnit u; u.h = bh & 7; u.rowb = (size_t)(bh >> 3) * SEQ;
    if (i < 16) { u.g = 0; u.dl = 1; u.r = 0; u.n = 16 * hf + i; u.first = (i == 0); }
    else if (i < 32) { const int j = i - 16; u.g = 1; u.dl = 4; u.r = 2 * hf + (j >> 3); u.n = j & 7; u.first = (u.n == 0); }
    else { const int j = i - 32; u.g = 2; u.dl = 16; u.r = 8 * hf + (j >> 1); u.n = j & 1; u.first = (u.n == 0); }
    return u;
}
__device__ __forceinline__ void attn_dma_chunk(const __amdgpu_buffer_rsrc_t rs, LAS unsigned char* lds, const AttnUnit& u, int chunk, int slot, int wave, int lane) {
    const int csc = (lane & 7) ^ ((lane >> 3) & 7);
#pragma unroll
    for (int q = 0; q < 2; ++q) { const int pc = wave + 8 * q, l = 128 * chunk + 8 * pc + (lane >> 3);
        const unsigned rowoff = (unsigned)((u.rowb + (size_t)l * u.dl + u.r) * NIN * 2);
        const unsigned srcK = rowoff + (unsigned)((C_K + (u.h >> 2) * 256 + (u.h & 3) * 32) * 2) + (unsigned)((csc >> 2) * 256 + (csc & 3) * 16);
        const unsigned srcV = rowoff + (unsigned)((C_V + u.h * 64) * 2) + (unsigned)(csc * 16);
        LAS unsigned char* dst = lds + slot * 32768 + pc * 1024;
        __builtin_amdgcn_raw_ptr_buffer_load_lds(rs, (LAS void*)dst, 16, srcK, 0, 0, 0);
        __builtin_amdgcn_raw_ptr_buffer_load_lds(rs, (LAS void*)(dst + 16384), 16, srcV, 0, 0, 0); }
}
__device__ __forceinline__ void phase_attn(ArgsRef a, LAS unsigned char* lds, int wv) {
    const int tid = tid_from(wv), lane = tid & 63, wave = __builtin_amdgcn_readfirstlane(tid >> 6);
    const bf16* proj = (const bf16*)(a.ws + WS_PROJ);
    bf16* PNUM = (bf16*)(a.ws + WS_PNUM); float* PDEN = (float*)(a.ws + WS_PDEN); float* PMAX = (float*)(a.ws + WS_PMAX);
    const __amdgpu_buffer_rsrc_t rs = __builtin_amdgcn_make_buffer_rsrc((void*)proj, 0, 0x7fffffff, 0x00020000);
    const int lr = lane & 15, lq = lane >> 4, qi0 = 16 * wave, G = gridDim.x;
    float zz_ = 0.f; asm volatile("" : "+v"(zz_));
    const int kc0 = ((0 + lq) ^ (lr & 7)) * 16, kc1 = ((4 + lq) ^ (lr & 7)) * 16;
    const int q4 = (lane & 15) >> 2, p4 = lane & 3, vsw = (4 * lq + q4) & 7;
    unsigned chv[4];
#pragma unroll
    for (int dt = 0; dt < 4; ++dt) chv[dt] = (unsigned)(((2 * dt + (p4 >> 1)) ^ vsw) * 16 + (p4 & 1) * 8);
    const bool xo = (G == 256);
    const int pair = xo ? ((int)(blockIdx.x & 7) * 16 + (int)(blockIdx.x >> 4)) : (int)(blockIdx.x >> 1), hf = xo ? (int)((blockIdx.x >> 3) & 1) : (int)(blockIdx.x & 1), npairs = G >> 1;
    __syncthreads();
    { unsigned z0 = 0u; asm volatile("" : "+v"(z0));
      for (int z = tid; z < RING_BYTES / 16; z += NTHR) ((LAS u32x4*)lds)[z] = (u32x4){z0, z0, z0, z0}; }
    __syncthreads();
    const int total = (pair < 128 && (int)blockIdx.x < 2 * npairs) ? ((128 - pair + npairs - 1) / npairs) * 48 : 0;
    AttnUnit cu = attn_unit(pair < 128 ? pair : 0, hf, 0);
    const int off = (total > 0 && cu.n > 0) ? 1 : 0;
#define ATT_UNIT_AT(k) attn_unit(pair + ((k) / 48) * npairs, hf, (k) % 48)
#define ATT_QLOAD(U, Q0, Q1) do { const size_t qrow_ = (U).rowb + (size_t)(128 * (U).n + qi0 + lr) * (U).dl + (U).r; const int qc_ = C_Q + ((U).h >> 2) * 256 + ((U).h & 3) * 32 + lq * 8; \
        Q0 = *(const bf16x8*)(proj + qrow_ * NIN + qc_); Q1 = *(const bf16x8*)(proj + qrow_ * NIN + qc_ + 128); } while (0)
    bf16x8 qf0, qf1, nq0, nq1;
    if (total > 0) { if (off) attn_dma_chunk(rs, lds, cu, cu.n - 1, 0, wave, lane);
        attn_dma_chunk(rs, lds, cu, cu.n, off & 3, wave, lane); ATT_QLOAD(cu, qf0, qf1);
        if (total > 1) { const AttnUnit u1 = ATT_UNIT_AT(1); attn_dma_chunk(rs, lds, u1, u1.n, (1 + off) & 3, wave, lane); } }
    nq0 = qf0; nq1 = qf1;
    asm volatile("s_waitcnt vmcnt(0)" ::: "memory");
    int idx = 0;
    while (idx < total) {
        asm volatile("s_waitcnt vmcnt(8)" ::: "memory"); __builtin_amdgcn_s_barrier(); asm volatile("" ::: "memory");
        const int csc = (idx + off) & 3, csp = cu.first ? ((cu.n > 0) ? 0 : csc) : ((idx + off + 3) & 3);
        AttnUnit nu = cu;
        if (idx + 1 < total) { nu = ATT_UNIT_AT(idx + 1); ATT_QLOAD(nu, nq0, nq1); }
        if (idx + 2 < total) { const AttnUnit u2 = ATT_UNIT_AT(idx + 2); attn_dma_chunk(rs, lds, u2, u2.n, (idx + 2 + off) & 3, wave, lane); }
        ++idx;
        f32x4 scv[9];
#pragma unroll
        for (int t = 0; t < 9; ++t) { const int wt = wave + t; const LAS unsigned char* Kt = lds + ((wt >= 8) ? csc : csp) * 32768 + ((16 * wt) & 127) * 128 + lr * 128;
            const bf16x8 k0 = *(const LAS bf16x8*)(Kt + kc0), k1 = *(const LAS bf16x8*)(Kt + kc1);
            scv[t] = __builtin_amdgcn_mfma_f32_16x16x32_bf16(k0, qf0, (f32x4){0.f, 0.f, 0.f, 0.f}, 0, 0, 0);
            scv[t] = __builtin_amdgcn_mfma_f32_16x16x32_bf16(k1, qf1, scv[t], 0, 0, 0); }
#pragma unroll
        for (int reg = 0; reg < 4; ++reg) { if (4 * lq + reg < lr) scv[0][reg] = -1e30f; if (4 * lq + reg > lr) scv[8][reg] = -1e30f; }
        if (cu.n == 0) {
#pragma unroll
            for (int t = 0; t < 8; ++t)
#pragma unroll
                for (int reg = 0; reg < 4; ++reg) { if (qi0 + 16 * t + 4 * lq + reg < 128) scv[t][reg] = -1e30f; } }
        float mx = -1e30f;
#pragma unroll
        for (int t = 0; t < 9; ++t)
#pragma unroll
            for (int reg = 0; reg < 4; ++reg) mx = fmaxf(mx, scv[t][reg]);
        mx = fmaxf(mx, __shfl_xor(mx, 16)); mx = fmaxf(mx, __shfl_xor(mx, 32));
        float sm = 0.f;
#pragma unroll
        for (int t = 0; t < 9; ++t)
#pragma unroll
            for (int reg = 0; reg < 4; ++reg) { const float pe = __builtin_amdgcn_exp2f(scv[t][reg] - mx); sm += pe; scv[t][reg] = pe; }
        sm += __shfl_xor(sm, 16); sm += __shfl_xor(sm, 32);
        f32x4 oc[4];
#pragma unroll
        for (int dt = 0; dt < 4; ++dt) oc[dt] = (f32x4){zz_, zz_, zz_, zz_};
#pragma unroll
        for (int pi = 0; pi < 5; ++pi) { const int t0 = 2 * pi, t1 = (2 * pi + 1 < 9) ? 2 * pi + 1 : 8;
            u32x4 pw; pw.x = cvt_pk_bf16(scv[t0][0], scv[t0][1]); pw.y = cvt_pk_bf16(scv[t0][2], scv[t0][3]);
            if (2 * pi + 1 < 9) { pw.z = cvt_pk_bf16(scv[t1][0], scv[t1][1]); pw.w = cvt_pk_bf16(scv[t1][2], scv[t1][3]); } else { pw.z = 0u; pw.w = 0u; }
            const bf16x8 pf = __builtin_bit_cast(bf16x8, pw);
            const int w0 = wave + t0, w1 = wave + t1;
            const LAS unsigned char* V0 = lds + ((w0 >= 8) ? csc : csp) * 32768 + 16384 + (((16 * w0) & 127) + 4 * lq + q4) * 128;
            const LAS unsigned char* V1 = lds + ((w1 >= 8) ? csc : csp) * 32768 + 16384 + (((16 * w1) & 127) + 4 * lq + q4) * 128;
            const unsigned va0 = (unsigned)(unsigned long)V0, va1 = (unsigned)(unsigned long)V1;
            v4i16_t r0[4], r1[4];
#pragma unroll
            for (int dt = 0; dt < 4; ++dt) { asm volatile("ds_read_b64_tr_b16 %0, %1" : "=&v"(r0[dt]) : "v"(va0 + chv[dt]) : "memory"); asm volatile("ds_read_b64_tr_b16 %0, %1" : "=&v"(r1[dt]) : "v"(va1 + chv[dt]) : "memory"); }
            asm volatile("s_waitcnt lgkmcnt(0)" : "+v"(r0[0]), "+v"(r0[1]), "+v"(r0[2]), "+v"(r0[3]), "+v"(r1[0]), "+v"(r1[1]), "+v"(r1[2]), "+v"(r1[3]) :: "memory");
#pragma unroll
            for (int dt = 0; dt < 4; ++dt) { const bf16x8 vf = (bf16x8){r0[dt][0], r0[dt][1], r0[dt][2], r0[dt][3], r1[dt][0], r1[dt][1], r1[dt][2], r1[dt][3]};
                oc[dt] = __builtin_amdgcn_mfma_f32_16x16x32_bf16(pf, vf, oc[dt], 0, 0, 0); } }
        { LAS bf16* stg = (LAS bf16*)(lds + OST_OFF + wave * 2048);
#pragma unroll
          for (int reg = 0; reg < 4; ++reg)
#pragma unroll
              for (int dt = 0; dt < 4; ++dt) stg[(4 * lq + reg) * 64 + dt * 16 + lr] = f2bf(oc[dt][reg]);
          LDS_WAIT(); asm volatile("" ::: "memory");
#pragma unroll
          for (int i = 0; i < 2; ++i) { const int qq = i * 8 + (lane >> 3), c8 = (lane & 7) * 8; const u32x4 w = *(const LAS u32x4*)(stg + qq * 64 + c8);
              const size_t tok = cu.rowb + (size_t)(128 * cu.n + qi0 + qq) * cu.dl + cu.r;
              *(u32x4*)(PNUM + ((size_t)cu.g * NT + tok) * 512 + cu.h * 64 + c8) = w; }
          LDS_WAIT(); asm volatile("" ::: "memory"); }
        if (lq == 0) { const size_t tok = cu.rowb + (size_t)(128 * cu.n + qi0 + lr) * cu.dl + cu.r; PDEN[((size_t)cu.g * NT + tok) * 8 + cu.h] = sm; PMAX[((size_t)cu.g * NT + tok) * 8 + cu.h] = mx; }
        cu = nu; qf0 = nq0; qf1 = nq1;
    }
#undef ATT_UNIT_AT
#undef ATT_QLOAD
}
__device__ __forceinline__ void phase_finalize(ArgsRef a, int wv) {
    const int tid = tid_from(wv), lane = tid & 63, wave = tid >> 6;
    const int gw = blockIdx.x * NWAVES + wave, NGW = gridDim.x * NWAVES;
    const bf16* __restrict__ proj = (const bf16*)(a.ws + WS_PROJ); bf16* __restrict__ mix = (bf16*)(a.ws + WS_MIX);
    const bf16* __restrict__ YP = (const bf16*)(a.ws + WS_YP); const float* __restrict__ SSQPOOL = (const float*)(a.ws + WS_SSQPOOL);
    const bf16* __restrict__ HL = (const bf16*)(a.ws + WS_HL); const bf16* __restrict__ PL = (const bf16*)(a.ws + WS_PL); const float* __restrict__ CARRY = (const float*)(a.ws + WS_CARRY);
    const bf16* __restrict__ PNUM = (const bf16*)(a.ws + WS_PNUM); const float* __restrict__ PDEN = (const float*)(a.ws + WS_PDEN); const float* __restrict__ PMAX = (const float*)(a.ws + WS_PMAX);
    const int hd = lane >> 3;
    for (int t = gw; t < NT; t += NGW) {
        const u32x2 ypw = *(const u32x2*)(YP + (size_t)t * 256 + lane * 4); const f32x4 sq = *(const f32x4*)(SSQPOOL + (size_t)t * 4);
        const u32x2 hw = *(const u32x2*)(HL + (size_t)t * 256 + lane * 4), pw = *(const u32x2*)(PL + (size_t)t * 256 + lane * 4), gwd = *(const u32x2*)(proj + (size_t)t * NIN + C_GATE + lane * 4);
        const f32x4 cr = *(const f32x4*)(CARRY + (size_t)(t / LRU_CH) * 256 + lane * 4);
        float m[3], dn[3]; u32x4 nw[3];
#pragma unroll
        for (int g = 0; g < 3; ++g) { m[g] = PMAX[((size_t)g * NT + t) * 8 + hd]; dn[g] = PDEN[((size_t)g * NT + t) * 8 + hd]; nw[g] = *(const u32x4*)(PNUM + ((size_t)g * NT + t) * 512 + lane * 8); }
        { const float rs = __builtin_amdgcn_rsqf(((sq[0] + sq[1]) + (sq[2] + sq[3])) * (1.0f / 256.0f) + EPS);
          u32x2 o; o.x = cvt_pk_bf16(bflo(ypw.x) * rs, bfhi(ypw.x) * rs); o.y = cvt_pk_bf16(bflo(ypw.y) * rs, bfhi(ypw.y) * rs);
          *(u32x2*)(mix + (size_t)t * DM + lane * 4) = o; }
        { float h[4] = {bflo(hw.x) + bflo(pw.x) * cr[0], bfhi(hw.x) + bfhi(pw.x) * cr[1], bflo(hw.y) + bflo(pw.y) * cr[2], bfhi(hw.y) + bfhi(pw.y) * cr[3]};
          const float gt[4] = {bflo(gwd.x), bfhi(gwd.x), bflo(gwd.y), bfhi(gwd.y)};
          float s = 0.f;
#pragma unroll
          for (int j = 0; j < 4; ++j) { h[j] *= gelu_tanh(gt[j]); s += h[j] * h[j]; }
          s = wave_sum(s); const float rs = __builtin_amdgcn_rsqf(s * (1.0f / 256.0f) + EPS);
          u32x2 o; o.x = cvt_pk_bf16(h[0] * rs, h[1] * rs); o.y = cvt_pk_bf16(h[2] * rs, h[3] * rs);
          *(u32x2*)(mix + (size_t)t * DM + 256 + lane * 4) = o; }
        { const float mr = fmaxf(fmaxf(m[0], m[1]), m[2]);
          float o[8] = {0.f, 0.f, 0.f, 0.f, 0.f, 0.f, 0.f, 0.f}; float den = 0.f;
#pragma unroll
          for (int g = 0; g < 3; ++g) { const float wg = __builtin_amdgcn_exp2f(m[g] - mr); den += wg * dn[g];
              o[0] += wg * bflo(nw[g].x); o[1] += wg * bfhi(nw[g].x); o[2] += wg * bflo(nw[g].y); o[3] += wg * bfhi(nw[g].y); o[4] += wg * bflo(nw[g].z); o[5] += wg * bfhi(nw[g].z); o[6] += wg * bflo(nw[g].w); o[7] += wg * bfhi(nw[g].w); }
          const float inv = 1.0f / den; float s = 0.f;
#pragma unroll
          for (int j = 0; j < 8; ++j) { o[j] *= inv; s += o[j] * o[j]; }
          s = wave_sum(s); const float rs = __builtin_amdgcn_rsqf(s * (1.0f / 512.0f) + EPS);
          u32x4 wv4; wv4.x = cvt_pk_bf16(o[0] * rs, o[1] * rs); wv4.y = cvt_pk_bf16(o[2] * rs, o[3] * rs); wv4.z = cvt_pk_bf16(o[4] * rs, o[5] * rs); wv4.w = cvt_pk_bf16(o[6] * rs, o[7] * rs);
          *(u32x4*)(mix + (size_t)t * DM + 512 + lane * 8) = wv4; }
    }
}

__device__ __forceinline__ void phase_router(ArgsRef a, LAS unsigned char* lds, int layer, int wv, bool alloc) {
    const int tid = tid_from(wv), lane = tid & 63, wave = __builtin_amdgcn_readfirstlane(tid >> 6);
    const bf16* xb = (const bf16*)(a.ws + WS_XB); const bf16* wr = (const bf16*)(a.ws + WS_SMALL) + SM_WR + (size_t)layer * NEXP * DM;
    const float* ssqp = (const float*)(a.ws + WS_SSQP); const float* rbias = a.in[I_BR] + layer * NEXP;
    int* LIST = (int*)(a.ws + WS_LIST); float* LRSTD = (float*)(a.ws + WS_LRSTD); float* LGATE = (float*)(a.ws + WS_LGATE2);
    unsigned* cnt = (unsigned*)(a.ws + WS_CTL) + CW_CNT + layer * NEXP;
    float zr_ = 0.f; asm volatile("" : "+v"(zr_));
    LAS float* LG = (LAS float*)lds + wave * 32 * 33;
    LAS int* hist = (LAS int*)(lds + 65536);
    LAS int* base = (LAS int*)(lds + 65536 + 128);
    const int lr = lane & 15, lq = lane >> 4;
    for (int unit = blockIdx.x; unit < NT / 256; unit += gridDim.x) {
        const int tok0 = unit * 256 + wave * 32;
        __syncthreads();
        if (tid < 32) hist[tid] = 0;
        f32x4 acc[2][2];
#pragma unroll
        for (int rt = 0; rt < 2; ++rt)
#pragma unroll
            for (int et = 0; et < 2; ++et) acc[rt][et] = (f32x4){zr_, zr_, zr_, zr_};
#pragma unroll 4
        for (int ks = 0; ks < 32; ++ks) { bf16x8 af[2], bfr[2];
#pragma unroll
            for (int rt = 0; rt < 2; ++rt) af[rt] = *(const bf16x8*)(xb + (size_t)(tok0 + rt * 16 + lr) * DM + ks * 32 + lq * 8);
#pragma unroll
            for (int et = 0; et < 2; ++et) bfr[et] = *(const bf16x8*)(wr + (size_t)(et * 16 + lr) * DM + ks * 32 + lq * 8);
#pragma unroll
            for (int rt = 0; rt < 2; ++rt)
#pragma unroll
                for (int et = 0; et < 2; ++et) acc[rt][et] = __builtin_amdgcn_mfma_f32_16x16x32_bf16(af[rt], bfr[et], acc[rt][et], 0, 0, 0); }
#pragma unroll
        for (int rt = 0; rt < 2; ++rt)
#pragma unroll
            for (int et = 0; et < 2; ++et)
#pragma unroll
                for (int reg = 0; reg < 4; ++reg) LG[(rt * 16 + lq * 4 + reg) * 33 + et * 16 + lr] = acc[rt][et][reg];
        __syncthreads();
        int te[4] = {0, 0, 0, 0}; float tg[4] = {0.f, 0.f, 0.f, 0.f}; int rk[4] = {0, 0, 0, 0}; float rstd = 0.f; const int tok = tok0 + lane;
        if (lane < 32) {
            const float* sp = ssqp + (size_t)tok * 16; float ss = 0.f;
#pragma unroll
            for (int j = 0; j < 16; ++j) ss += sp[j];
            rstd = __builtin_amdgcn_rsqf(ss * (1.0f / DM) + EPS);
            float tv[4] = {-3e38f, -3e38f, -3e38f, -3e38f};
            for (int e = 0; e < NEXP; ++e) { float v = LG[lane * 33 + e] * rstd + rbias[e]; int ve = e;
#pragma unroll
                for (int k = 0; k < 4; ++k) { if (v > tv[k]) { const float tvv = tv[k]; const int tee = te[k]; tv[k] = v; te[k] = ve; v = tvv; ve = tee; } } }
            float z = 0.f;
#pragma unroll
            for (int k = 0; k < 4; ++k) { tg[k] = fast_exp(tv[k] - tv[0]); z += tg[k]; }
            const float iz = 1.0f / z;
#pragma unroll
            for (int k = 0; k < 4; ++k) { tg[k] *= iz; rk[k] = __hip_atomic_fetch_add(&hist[te[k]], 1, __ATOMIC_RELAXED, __HIP_MEMORY_SCOPE_WORKGROUP); }
        }
        __syncthreads();
        if (tid < 32) base[tid] = alloc ? (int)__hip_atomic_fetch_add(cnt + tid, (unsigned)hist[tid], RLX_AGENT) : 0;
        __syncthreads();
        if (lane < 32 && alloc) {
#pragma unroll
            for (int k = 0; k < 4; ++k) { const size_t p = (size_t)te[k] * NT + base[te[k]] + rk[k]; LIST[p] = tok * 4 + k; LRSTD[p] = rstd; LGATE[p] = tg[k]; }
        }
    }
}

__device__ __forceinline__ void phase_combine(ArgsRef a, bool last_layer, int wv, bool dry) {
    const int tid = tid_from(wv), lane = tid & 63, wave = tid >> 6;
    const int gw = blockIdx.x * NWAVES + wave, NGW = gridDim.x * NWAVES;
    const unsigned char* __restrict__ Y = (const unsigned char*)(a.ws + WS_Y); float* __restrict__ out = a.out; bf16* xb = (bf16*)(a.ws + WS_XB); float* __restrict__ ssq = (float*)(a.ws + WS_SSQ);
    typedef float f2v __attribute__((ext_vector_type(2)));
    for (int t = gw; t < NT; t += NGW) {
        const u32x4 x0 = *((const u32x4*)(xb + (size_t)t * DM) + 2 * lane), x1 = *((const u32x4*)(xb + (size_t)t * DM) + 2 * lane + 1);
        u32x4 y[4];
#pragma unroll
        for (int k = 0; k < 4; ++k) y[k] = *((const u32x4*)(Y + ((size_t)t * 4 + k) * DM) + lane);
        float v[16];
        v[0] = bflo(x0.x); v[1] = bfhi(x0.x); v[2] = bflo(x0.y); v[3] = bfhi(x0.y); v[4] = bflo(x0.z); v[5] = bfhi(x0.z); v[6] = bflo(x0.w); v[7] = bfhi(x0.w);
        v[8] = bflo(x1.x); v[9] = bfhi(x1.x); v[10] = bflo(x1.y); v[11] = bfhi(x1.y); v[12] = bflo(x1.z); v[13] = bfhi(x1.z); v[14] = bflo(x1.w); v[15] = bfhi(x1.w);
#pragma unroll
        for (int k = 0; k < 4; ++k)
#pragma unroll
            for (int d = 0; d < 4; ++d) { const int w = (int)y[k][d]; const f2v lo = __builtin_amdgcn_cvt_pk_f32_fp8(w, false), hi = __builtin_amdgcn_cvt_pk_f32_fp8(w, true);
                v[4 * d + 0] += lo.x * (1.0f / Y8_SCALE); v[4 * d + 1] += lo.y * (1.0f / Y8_SCALE); v[4 * d + 2] += hi.x * (1.0f / Y8_SCALE); v[4 * d + 3] += hi.y * (1.0f / Y8_SCALE); }
        float s = 0.f;
#pragma unroll
        for (int j = 0; j < 16; ++j) s += v[j] * v[j];
        if (dry && s != 12345.678f) continue;
        if (last_layer) {
#pragma unroll
            for (int j = 0; j < 4; ++j) *((f32x4*)(out + (size_t)t * DM) + 4 * lane + j) = (f32x4){v[4 * j], v[4 * j + 1], v[4 * j + 2], v[4 * j + 3]};
        } else { s = wave_sum(s);
            u32x4 w0, w1; w0.x = cvt_pk_bf16(v[0], v[1]); w0.y = cvt_pk_bf16(v[2], v[3]); w0.z = cvt_pk_bf16(v[4], v[5]); w0.w = cvt_pk_bf16(v[6], v[7]);
            w1.x = cvt_pk_bf16(v[8], v[9]); w1.y = cvt_pk_bf16(v[10], v[11]); w1.z = cvt_pk_bf16(v[12], v[13]); w1.w = cvt_pk_bf16(v[14], v[15]);
            *((u32x4*)(xb + (size_t)t * DM) + 2 * lane) = w0; *((u32x4*)(xb + (size_t)t * DM) + 2 * lane + 1) = w1;
            if (lane == 0) ssq[t] = s; }
    }
}

constexpr int NPH_LAYER = 13, NPH = 1 + 2 * NPH_LAYER;
enum { PH_GEMM_IN = 0, PH_QKPREP, PH_POOL, PH_LRU_A, PH_LRU_B, PH_ATTN, PH_LRU_C, PH_MERGE, PH_GEMM_OUT, PH_ROUTER, PH_MOE_GU, PH_MOE_DOWN, PH_COMBINE };
#ifndef MK_STOP
#define MK_STOP NPH
#endif
#ifndef MK_SPLIT
#define MK_SPLIT 0
#endif

template <int PHMASK>
__global__ void __launch_bounds__(NTHR, 2) mega_fwd(Args args_by_value) {
    extern __shared__ __attribute__((aligned(16))) unsigned char lds_raw[];
    LAS unsigned char* lds = (LAS unsigned char*)lds_raw;
    const int tid = threadIdx.x;
    int wv = __builtin_amdgcn_readfirstlane(tid >> 6); asm volatile("" : "+s"(wv));
    for (int u = tid; u < (LDS_BYTES - LDSCTL_OFF) / 4; u += NTHR) ((LAS unsigned*)(lds + LDSCTL_OFF))[u] = 0u;
    __syncthreads();
#define ARGS_HERE() const CAS Args* ap_ = (const CAS Args*)__builtin_amdgcn_kernarg_segment_ptr(); asm volatile("" : "+s"(ap_)); ArgsRef args = *ap_; unsigned char* const ws = args.ws; unsigned* const ctl = (unsigned*)(ws + WS_CTL); (void)ctl
    int lo, hi;
    { ARGS_HERE(); lo = args.ph_lo; hi = args.ph_hi; xcd_barrier_post(ctl + CW_BAR + args.li * XCD_BAR_WORDS, (volatile LAS unsigned*)(lds + MISC_OFF) + 8); }
#define EN(p) (((PHMASK) >> (p)) & 1)
#ifndef MK_DUP
#define MK_DUP 0
#endif
#define NREP(p) ((((MK_DUP) >> (p)) & 1) ? 2 : 1)
#define IN(k) (lo <= (k) && (k) < hi)
#define SEAM(k) do { if (IN(k) && IN((k) + 1)) { ARGS_HERE(); XcdBarrier bar_; bar_.bar = ctl + CW_BAR + args.li * XCD_BAR_WORDS; bar_.x = xb_xcc_id(); bar_.st = (volatile LAS unsigned*)(lds + MISC_OFF) + 8; xcd_barrier(bar_); } } while (0)

    if (EN(13) && IN(0)) { ARGS_HERE(); for (int rep_ = 0; rep_ < NREP(13); ++rep_) { phase_prologue(args, lds, wv); } }
    SEAM(0);
    for (int l = 0; l < 2; ++l) {
        const int pb = 1 + NPH_LAYER * l;
        if (EN(PH_GEMM_IN) && IN(pb + PH_GEMM_IN)) { ARGS_HERE();
            pg8::StaticOrder S; S.init(NT, NIN, DM, gridDim.x, blockIdx.x); S.dup = NREP(PH_GEMM_IN) - 1;
            EpiIn E{(bf16*)(ws + WS_PROJ), (const float*)(ws + WS_SSQ), args.in[I_QG] + l * 64, args.in[I_KG] + l * 64, (const float*)(ws + WS_ROPE), (const float*)(ws + WS_ROPE) + SEQ * 32};
            pg8::gemm_phase<EpiIn, pg8::StaticOrder, true>(lds, (const bf16*)(ws + WS_XB), (const bf16*)(ws + WS_WIN) + (size_t)l * NIN * DM, DM, S, E, wv);
        }
        SEAM(pb + PH_GEMM_IN);
        if (EN(PH_POOL) && IN(pb + PH_POOL)) { ARGS_HERE(); for (int rep_ = 0; rep_ < NREP(PH_POOL); ++rep_) { phase_pool(args, lds, l, wv); } }
        if (EN(PH_LRU_A) && IN(pb + PH_LRU_A)) { ARGS_HERE(); for (int rep_ = 0; rep_ < NREP(PH_LRU_A); ++rep_) { phase_lru_a(args, lds, l, wv); } }
        SEAM(pb + PH_LRU_A);
        if (EN(PH_LRU_B) && IN(pb + PH_LRU_B)) { ARGS_HERE(); for (int rep_ = 0; rep_ < NREP(PH_LRU_B); ++rep_) { phase_lru_b(args, wv); } }
        if (EN(PH_ATTN) && IN(pb + PH_ATTN)) { ARGS_HERE(); for (int rep_ = 0; rep_ < NREP(PH_ATTN); ++rep_) { phase_attn(args, lds, wv); } }
        SEAM(pb + PH_ATTN);
        if (EN(PH_LRU_C) && IN(pb + PH_LRU_C)) { ARGS_HERE(); for (int rep_ = 0; rep_ < NREP(PH_LRU_C); ++rep_) { phase_finalize(args, wv); } }
        SEAM(pb + PH_MERGE);
        if (EN(PH_GEMM_OUT) && IN(pb + PH_GEMM_OUT)) { ARGS_HERE();
            __syncthreads();
            pg8::StaticOrder S; S.init(NT, DM, DM, gridDim.x, blockIdx.x); S.dup = (l == 0) ? NREP(PH_GEMM_OUT) - 1 : 0;
            EpiOut E{(bf16*)(ws + WS_XB), (float*)(ws + WS_SSQP), (unsigned char*)(ws + WS_XB8)};
            pg8::gemm_phase<EpiOut, pg8::StaticOrder, true>(lds, (const bf16*)(ws + WS_MIX), (const bf16*)(ws + WS_WOUT) + (size_t)l * DM * DM, DM, S, E, wv);
        }
        SEAM(pb + PH_GEMM_OUT);
        if (EN(PH_ROUTER) && IN(pb + PH_ROUTER)) { ARGS_HERE(); for (int rep_ = 0; rep_ < NREP(PH_ROUTER); ++rep_) { phase_router(args, lds, l, wv, rep_ == NREP(PH_ROUTER) - 1); } }
        SEAM(pb + PH_ROUTER);
        if (EN(PH_MOE_GU) && IN(pb + PH_MOE_GU)) { ARGS_HERE();
            LAS int* tab = (LAS int*)(lds + TAB_OFF);
            moe_tables(tab, ctl + CW_CNT + l * NEXP, wv);
            MoeOrder<2> S{tab, 2, (int)gridDim.x, (int)blockIdx.x, (const int*)(ws + WS_LIST), NREP(PH_MOE_GU) - 1};
            EpiGU E{(unsigned char*)(ws + WS_ACT), (const float*)(ws + WS_LRSTD), args.in[I_BGU] + (size_t)l * NEXP * 512};
            pg8::gemm_phase<EpiGU, MoeOrder<2>, true, true>(lds, (const bf16*)(ws + WS_XB8), (const bf16*)(ws + WS_WGU + (size_t)l * NEXP * 512 * DM), DM / 2, S, E, wv);
        }
        SEAM(pb + PH_MOE_GU);
        if (EN(PH_MOE_DOWN) && IN(pb + PH_MOE_DOWN)) { ARGS_HERE();
            LAS int* tab = (LAS int*)(lds + TAB_OFF);
            moe_tables(tab, ctl + CW_CNT + l * NEXP, wv);
            MoeOrder<3> S{tab, 4, (int)gridDim.x, (int)blockIdx.x, (const int*)(ws + WS_LIST), NREP(PH_MOE_DOWN) - 1};
            EpiDown E{(unsigned char*)(ws + WS_Y), (const int*)(ws + WS_LIST), (const float*)(ws + WS_LGATE2), args.in[I_BD] + (size_t)l * NEXP * DM, tab};
            pg8::gemm_phase<EpiDown, MoeOrder<3>, true, true>(lds, (const bf16*)(ws + WS_ACT), (const bf16*)(ws + WS_WD + (size_t)l * NEXP * DM * EFF), EFF / 2, S, E, wv);
        }
        SEAM(pb + PH_MOE_DOWN);
        if (EN(PH_COMBINE) && IN(pb + PH_COMBINE)) { ARGS_HERE(); for (int rep_ = 0; rep_ < NREP(PH_COMBINE); ++rep_) { phase_combine(args, l == 1, wv, rep_ < NREP(PH_COMBINE) - 1); } }
        SEAM(pb + PH_COMBINE);
    }
#undef IN
#undef SEAM
}

typedef void (*kern_t)(Args);
template <int M> static kern_t kern_of() { return (kern_t)mega_fwd<M>; }
static kern_t phase_kernel(int p) {
    switch (p) { case 0: return kern_of<1 << 0>(); case 1: return kern_of<1 << 1>(); case 2: return kern_of<1 << 2>(); case 3: return kern_of<1 << 3>(); case 4: return kern_of<1 << 4>();
                 case 5: return kern_of<1 << 5>(); case 6: return kern_of<1 << 6>(); case 7: return kern_of<1 << 7>(); case 8: return kern_of<1 << 8>(); case 9: return kern_of<1 << 9>();
                 case 10: return kern_of<1 << 10>(); case 11: return kern_of<1 << 11>(); case 12: return kern_of<1 << 12>(); default: return kern_of<1 << 13>(); }
}
extern "C" void kernel_launch(void* const* d_in, const int* in_sizes, int n_in, void* d_out, int out_size, void* d_ws, size_t ws_size, hipStream_t stream) {
    static int grid = 0;
    if (grid == 0) {
        if (n_in != 23 || in_sizes[0] != NT * DM || out_size != NT * DM || ws_size < WS_END) {
            fprintf(stderr, "kernel_launch: built for 23 inputs, x/out of %d floats, >= %zu bytes of workspace; got n_in %d, in0 %d, out %d, ws %zu; nothing launched\n", NT * DM, (size_t)WS_END, n_in, n_in > 0 ? in_sizes[0] : -1, out_size, ws_size);
            grid = -1; return; }
        int dev = 0, cus = 0;
        if (hipGetDevice(&dev) != hipSuccess || hipDeviceGetAttribute(&cus, hipDeviceAttributeMultiprocessorCount, dev) != hipSuccess) { fprintf(stderr, "kernel_launch: device query failed\n"); grid = -1; return; }
#if MK_SPLIT
        for (int p = 0; p < 14; ++p) if (hipFuncSetAttribute((const void*)phase_kernel(p), hipFuncAttributeMaxDynamicSharedMemorySize, LDS_BYTES) != hipSuccess) { fprintf(stderr, "kernel_launch: hipFuncSetAttribute failed\n"); grid = -1; return; }
#else
        if (hipFuncSetAttribute((const void*)kern_of<0x3fff>(), hipFuncAttributeMaxDynamicSharedMemorySize, LDS_BYTES) != hipSuccess) { fprintf(stderr, "kernel_launch: hipFuncSetAttribute failed\n"); grid = -1; return; }
        int per_cu = 0;
        if (hipOccupancyMaxActiveBlocksPerMultiprocessor(&per_cu, (const void*)kern_of<0x3fff>(), NTHR, LDS_BYTES) != hipSuccess || per_cu < 1)
            fprintf(stderr, "kernel_launch: note: occupancy query reports %d workgroups per CU\n", per_cu);
#endif
        (void)hipGetLastError();
        if (cus != 256) { fprintf(stderr, "kernel_launch: this kernel's unit maps are built for a 256-CU device (one workgroup per CU); found %d CUs; nothing launched\n", cus); grid = -1; return; }
        grid = cus;
    }
    if (grid < 0) return;
    if (hipMemsetAsync((char*)d_ws + WS_CTL, 0, CTL_ZERO_BYTES, stream) != hipSuccess) { fprintf(stderr, "kernel_launch: hipMemsetAsync failed\n"); return; }
    Args a{};
    for (int i = 0; i < 23; ++i) a.in[i] = (const float*)d_in[i];
    a.out = (float*)d_out; a.ws = (unsigned char*)d_ws; a.pad = 0;
#if MK_SPLIT
#ifdef MK_SKIP
    (void)hipMemsetAsync((char*)d_ws + WS_MIX, 0, (size_t)NT * DM * 2, stream);
#endif
    for (int p = 0; p < MK_STOP; ++p) { a.ph_lo = p; a.ph_hi = p + 1; a.li = p;
#ifdef MK_SKIP
        if (p >= 1 && (((MK_SKIP) >> ((p - 1) % NPH_LAYER)) & 1)) continue;
#endif
        hipLaunchKernelGGL(phase_kernel(p == 0 ? 13 : (p - 1) % NPH_LAYER), dim3(grid), dim3(NTHR), LDS_BYTES, stream, a); }
#else
    a.ph_lo = 0; a.ph_hi = NPH; a.li = 0;
    hipLaunchKernelGGL(kern_of<0x3fff>(), dim3(grid), dim3(NTHR), LDS_BYTES, stream, a);
#endif
    const hipError_t le = hipPeekAtLastError();
    if (le != hipSuccess) fprintf(stderr, "kernel_launch: launch failed: %s\n", hipGetErrorName(le));
}
```

```cpp
#include <hip/hip_runtime.h>
#include <cstdio>
#include <cstdint>

#define LAS __attribute__((address_space(3)))
#define GAS __attribute__((address_space(1)))
typedef unsigned short bf16;
typedef short bf16x8 __attribute__((ext_vector_type(8)));
typedef float f32x4 __attribute__((ext_vector_type(4)));
typedef float f32x2 __attribute__((ext_vector_type(2)));
typedef unsigned u32x4 __attribute__((ext_vector_type(4)));
typedef unsigned u32x2 __attribute__((ext_vector_type(2)));

#ifndef MK_VAR
#define MK_VAR 0
#endif
constexpr int NB = 16, SEQ = 4096, DM = 1024, NT = NB * SEQ;
constexpr int NIN = 2304;
constexpr int NPJ = 768;
constexpr int C_POOL = 0, C_LRU = 256, C_GATE = 512, C_Q = 768, C_K = 1280, C_V = 1792;
constexpr int NEXP = 32, TOPK = 4, EFF = 256;
constexpr int NASSIGN = NT * TOPK;
constexpr int ACT_ROWS = NASSIGN + NEXP * 256;
constexpr float EPS = 1e-6f;
constexpr int NWAVES = 8, NTHR = 512;
constexpr int LRU_CH = 32, LRU_NCH = SEQ / LRU_CH;

constexpr size_t MiB = 1u << 20;
constexpr size_t WS_CTL = 0, CTL_ZERO_BYTES = 1 * MiB;
constexpr size_t WS_ROPE = 1 * MiB;
constexpr size_t WS_SMALL = 2 * MiB;
constexpr size_t WS_WIN = 4 * MiB;
constexpr size_t WS_WOUT = 13 * MiB;
constexpr size_t WS_WGU = 17 * MiB;
constexpr size_t WS_WD = 81 * MiB;
constexpr size_t WS_SSQ = 113 * MiB;
constexpr size_t WS_SSQP = 114 * MiB;
constexpr size_t WS_LIST = 118 * MiB;
constexpr size_t WS_XB = 128 * MiB;
constexpr size_t WS_R = 256 * MiB;
constexpr size_t WS_PROJ = WS_R;
constexpr size_t WS_HM = WS_R + 96 * MiB;
constexpr size_t WS_MIX = WS_R + 288 * MiB;
constexpr size_t WS_PNUM = WS_R + 416 * MiB;
constexpr size_t WS_PDEN = WS_R + 608 * MiB;
constexpr size_t WS_PMAX = WS_R + 614 * MiB;
constexpr size_t WS_HL = WS_R + 620 * MiB;
constexpr size_t WS_PL = WS_R + 652 * MiB;
constexpr size_t WS_AGGH = WS_R + 684 * MiB;
constexpr size_t WS_AGGP = WS_R + 686 * MiB;
constexpr size_t WS_CARRY = WS_R + 688 * MiB;
constexpr size_t WS_YP = WS_R + 690 * MiB;
constexpr size_t WS_SSQPOOL = WS_R + 722 * MiB;
constexpr size_t WS_ACT = WS_R;
constexpr size_t WS_Y = WS_R + 132 * MiB;
constexpr size_t WS_XB8 = WS_R + 420 * MiB;
constexpr size_t WS_LRSTD = WS_R + 644 * MiB;
constexpr size_t WS_LGATE2 = WS_R + 652 * MiB;
constexpr size_t WS_TSEL = WS_R + 660 * MiB;
constexpr size_t WS_END = 1024 * MiB;
static_assert(WS_CARRY + 2 * MiB <= WS_END && WS_LGATE2 + 8 * MiB <= WS_END, "d_ws map");
constexpr size_t SM_POOLW = 0;
constexpr size_t SM_WA = 32768;
constexpr size_t SM_WX = 65536;
constexpr size_t SM_WR = 98304;
constexpr int CW_BAR = 4096;
constexpr int CW_CNT = 1024;

constexpr int RING_BYTES = 131072;
constexpr int LDSCTL_OFF = RING_BYTES;
constexpr int MISC_OFF = LDSCTL_OFF + 320;
constexpr int TAB_OFF = LDSCTL_OFF + 1024;
constexpr int OST_OFF = RING_BYTES + 8192;
constexpr int LDS_BYTES = 163840;

typedef GAS unsigned gu32;
#define RLX_AGENT __ATOMIC_RELAXED, __HIP_MEMORY_SCOPE_AGENT
#define LDS_WAIT() asm volatile("s_waitcnt lgkmcnt(0)" ::: "memory")
#define VM_WAIT() asm volatile("s_waitcnt vmcnt(0)" ::: "memory")
typedef __bf16 bf16x2_t __attribute__((ext_vector_type(2)));
__device__ __forceinline__ unsigned cvt_pk_bf16(float lo, float hi) { const f32x2 v = {lo, hi}; const bf16x2_t b = __builtin_convertvector(v, bf16x2_t); return __builtin_bit_cast(unsigned, b); }
__device__ __forceinline__ float bflo(unsigned w) { return __uint_as_float(w << 16); }
__device__ __forceinline__ float bfhi(unsigned w) { return __uint_as_float(w & 0xffff0000u); }
__device__ __forceinline__ float bf2f(bf16 h) { return __uint_as_float((unsigned)h << 16); }
__device__ __forceinline__ bf16 f2bf(float f) { return (bf16)(cvt_pk_bf16(f, 0.f) & 0xffffu); }
__device__ __forceinline__ float xsum16(float x) { const u32x2 r = __builtin_amdgcn_permlane16_swap(__float_as_uint(x), __float_as_uint(x), false, false); return __uint_as_float(r.x) + __uint_as_float(r.y); }
__device__ __forceinline__ float xsum32(float x) { const u32x2 r = __builtin_amdgcn_permlane32_swap(__float_as_uint(x), __float_as_uint(x), false, false); return __uint_as_float(r.x) + __uint_as_float(r.y); }
__device__ __forceinline__ float xmax16(float x) { const u32x2 r = __builtin_amdgcn_permlane16_swap(__float_as_uint(x), __float_as_uint(x), false, false); return fmaxf(__uint_as_float(r.x), __uint_as_float(r.y)); }
__device__ __forceinline__ float xmax32(float x) { const u32x2 r = __builtin_amdgcn_permlane32_swap(__float_as_uint(x), __float_as_uint(x), false, false); return fmaxf(__uint_as_float(r.x), __uint_as_float(r.y)); }
#define DPP_ROR_F(x, n) __int_as_float(__builtin_amdgcn_update_dpp(0, __float_as_int(x), 0x120 + (n), 0xf, 0xf, true))
__device__ __forceinline__ float row16_sum(float v) { v += DPP_ROR_F(v, 8); v += DPP_ROR_F(v, 4); v += DPP_ROR_F(v, 2); v += DPP_ROR_F(v, 1); return v; }
__device__ __forceinline__ float wave_sum(float v) { return xsum32(xsum16(row16_sum(v))); }
__device__ __forceinline__ float rows_up16(float x, int row) { const unsigned u = __float_as_uint(x); const u32x2 p = __builtin_amdgcn_permlane16_swap(u, u, false, false);
    const u32x2 q = __builtin_amdgcn_permlane32_swap(p.y, p.y, false, false); return __uint_as_float(row == 2 ? q.x : p.x); }
__device__ __forceinline__ float rows_up32(float x) { const unsigned u = __float_as_uint(x); const u32x2 p = __builtin_amdgcn_permlane32_swap(u, u, false, false); return __uint_as_float(p.x); }
__device__ __forceinline__ float row3_bcast(float x) { const unsigned u = __float_as_uint(x); const u32x2 p = __builtin_amdgcn_permlane16_swap(u, u, false, false);
    const u32x2 q = __builtin_amdgcn_permlane32_swap(p.y, p.y, false, false); return __uint_as_float(q.y); }
__device__ __forceinline__ float fast_sigmoid(float x) { return __builtin_amdgcn_rcpf(1.0f + __builtin_amdgcn_exp2f(-1.4426950408889634f * x)); }
__device__ __forceinline__ float fast_exp(float x) { return __builtin_amdgcn_exp2f(1.4426950408889634f * x); }
__device__ __forceinline__ float gelu_tanh(float x) {
    const float u = 0.7978845608028654f * (x + 0.044715f * x * x * x);
    return x * fast_sigmoid(2.0f * u);
}
__device__ __forceinline__ int bid_here() { int b = (int)blockIdx.x; asm volatile("" : "+s"(b)); return b; }
__device__ __forceinline__ int gdim_here() { int g = (int)gridDim.x; asm volatile("" : "+s"(g)); return g; }
__device__ __forceinline__ int tid_from(int wv) { int ln; asm volatile("v_mbcnt_lo_u32_b32 %0, -1, 0\n\tv_mbcnt_hi_u32_b32 %0, -1, %0" : "=v"(ln)); return wv * 64 + ln; }
namespace pg8 {
constexpr int BM = 256, BK = 64, HALF = 128, HTB = HALF * BK * 2  , STAGE_BYTES = 8 * HTB, NXCD = 8, WGM = 8;

__host__ __device__ __forceinline__ int lds_byte(int r, int c) { const int st = (r >> 4) * 2 + (c >> 5), rr = r & 15, cc = c & 31, ob = rr * 64 + cc * 2; return st * 1024 + (ob ^ (((ob >> 9) & 1) << 5)); }
__host__ __device__ __forceinline__ void stage_rc(int b, int& R, int& C) { const int st = b / 1024, sb = b % 1024, swz = sb ^ (((sb >> 9) & 1) << 5); R = (st >> 1) * 16 + swz / 64; C = (st & 1) * 32 + (swz % 64) / 2; }
__host__ __device__ __forceinline__ int perm32(int rho) { const int n = rho >> 4, i = rho & 15; return 8 * (i >> 2) + 4 * n + (i & 3); }

struct Unit { int pm, pn, e, aux; };

typedef int v8i32_t __attribute__((ext_vector_type(8)));
typedef int v4i32_t __attribute__((ext_vector_type(4)));
__device__ __forceinline__ v8i32_t f8frag(bf16x8 lo, bf16x8 hi) { const u32x4 a = __builtin_bit_cast(u32x4, lo), b = __builtin_bit_cast(u32x4, hi); return (v8i32_t){(int)a.x, (int)a.y, (int)a.z, (int)a.w, (int)b.x, (int)b.y, (int)b.z, (int)b.w}; }
template <class Epi, class Sched, bool ALIGN_EPI, bool F8 = false>
__device__ __forceinline__ void gemm_phase(LAS unsigned char* lds, const bf16* Abase, const bf16* Bbase, const int K, const Sched& S, const Epi& E, const int wv, const int stag = 0) {
    const int tid = tid_from(wv), wid = __builtin_amdgcn_readfirstlane(tid >> 6), lane = tid & 63, wr = wid >> 2, wc = wid & 3, fr = lane & 15, fq = lane >> 4;
    const int nt = K / BK;
    unsigned voffB[2];
#pragma unroll
    for (int i = 0; i < 2; ++i) { int R, C; stage_rc(tid * 16 + i * 8192, R, C); const int Rb = Epi::PERM ? ((R & ~31) + perm32(R & 31)) : R;
        voffB[i] = (unsigned)(Rb * K + C) * 2u; }
#define PG8_AVOFF(u, h, i) ([&]() { int R_, C_; stage_rc(tid * 16 + (i) * 8192, R_, C_); return S.a_voff((u), (h) * HALF + R_, C_); }())
#define PG8_GATHER4(u, pk) do { int R0_, C0_, R1_, C1_; stage_rc(tid * 16, R0_, C0_); stage_rc(tid * 16 + 8192, R1_, C1_); \
        const int q0_ = S.a_raw((u), R0_), q1_ = S.a_raw((u), R1_), q2_ = S.a_raw((u), HALF + R0_), q3_ = S.a_raw((u), HALF + R1_); \
        pk.x = S.a_voff_raw((u), R0_, C0_, q0_); pk.y = S.a_voff_raw((u), R1_, C1_, q1_); pk.z = S.a_voff_raw((u), HALF + R0_, C0_, q2_); pk.w = S.a_voff_raw((u), HALF + R1_, C1_, q3_); } while (0)
    const unsigned kstep = (unsigned)(BK * 2);
    const unsigned hstep = (unsigned)(HALF * K * 2);
    const unsigned ldsw = (unsigned)wid * 1024u;
    const int aoff = F8 ? lds_byte(wr * 64 + fr, fq * 16) : lds_byte(wr * 64 + fr, fq * 8), boff = F8 ? lds_byte(wc * 32 + fr, fq * 16) : lds_byte(wc * 32 + fr, fq * 8);
    const __amdgpu_buffer_rsrc_t rsA = __builtin_amdgcn_make_buffer_rsrc((void*)Abase, 0, 0x7fffffff, 0x00020000);
    const __amdgpu_buffer_rsrc_t rsB = __builtin_amdgcn_make_buffer_rsrc((void*)Bbase, 0, 0x7fffffff, 0x00020000);
#define PG8_SA(b, h) (((b) * 2 + (h)) * HTB)
#define PG8_SB(b, h) ((4 + (b) * 2 + (h)) * HTB)
#define PG8_STAGE_B(bufoff, soff) do { const int so_ = __builtin_amdgcn_readfirstlane((int)(soff)); _Pragma("unroll") for (int _i = 0; _i < 2; ++_i) \
        __builtin_amdgcn_raw_ptr_buffer_load_lds(rsB, (LAS void*)(lds + (bufoff) + ldsw + _i * 8192), 16, voffB[_i], so_, 0, 0); } while (0)
#define PG8_STAGE_A(bufoff, kbytes, H, NX) do { const int so_ = __builtin_amdgcn_readfirstlane((int)(kbytes)); unsigned o0_, o1_; \
        if constexpr (Sched::GATHER) { const u32x2 pk_ = *(const LAS u32x2*)((const LAS unsigned char*)park + (((ui + (NX)) & 1) * 8192 + tid * 16 + (H) * 8)); o0_ = pk_.x; o1_ = pk_.y; } else { o0_ = vc0; o1_ = vc1; } \
        __builtin_amdgcn_raw_ptr_buffer_load_lds(rsA, (LAS void*)(lds + (bufoff) + ldsw), 16, o0_, so_, 0, 0); \
        __builtin_amdgcn_raw_ptr_buffer_load_lds(rsA, (LAS void*)(lds + (bufoff) + ldsw + 8192), 16, o1_, so_, 0, 0); } while (0)
#define PG8_LD8(p_) __builtin_shufflevector(*(const LAS v4i32_t*)(p_), *(const LAS v4i32_t*)((p_) + 16), 0, 1, 2, 3, 4, 5, 6, 7)
#define PG8_LDA(dst, b, h) do { if constexpr (F8) { _Pragma("unroll") for (int m = 0; m < 4; ++m) dst##8[m] = PG8_LD8(lds + PG8_SA(b, h) + aoff + m * 2048); } \
        else { _Pragma("unroll") for (int m = 0; m < 4; ++m) _Pragma("unroll") for (int k = 0; k < 2; ++k) dst[m][k] = *(const LAS bf16x8*)(lds + PG8_SA(b, h) + aoff + m * 2048 + k * 1024); } } while (0)
#define PG8_LDB(dst, b, h) do { if constexpr (F8) { _Pragma("unroll") for (int n = 0; n < 2; ++n) dst##8[n] = PG8_LD8(lds + PG8_SB(b, h) + boff + n * 2048); } \
        else { _Pragma("unroll") for (int n = 0; n < 2; ++n) _Pragma("unroll") for (int k = 0; k < 2; ++k) dst[n][k] = *(const LAS bf16x8*)(lds + PG8_SB(b, h) + boff + n * 2048 + k * 1024); } } while (0)
#define PG8_MMA(ai, bj, At, Bt) do { __builtin_amdgcn_s_setprio(1); _Pragma("unroll") for (int m = 0; m < 4; ++m) _Pragma("unroll") for (int n = 0; n < 2; ++n) { \
        if constexpr (F8) { asm volatile("v_mfma_scale_f32_16x16x128_f8f6f4 %0, %1, %2, %0, %3, %3 op_sel_hi:[0,0,0]" : "+v"(acc[ai][bj][m][n]) : "v"(Bt##8[n]), "v"(At##8[m]), "v"(sc1_)); }   \
        else { _Pragma("unroll") for (int k = 0; k < 2; ++k) acc[ai][bj][m][n] = __builtin_amdgcn_mfma_f32_16x16x32_bf16(Bt[n][k], At[m][k], acc[ai][bj][m][n], 0, 0, 0); } } __builtin_amdgcn_s_setprio(0); } while (0)
#define PG8_WAIT_V(n) asm volatile("s_waitcnt vmcnt(" #n ")" ::: "memory")
#define PG8_WAIT_VN(n) asm volatile("s_waitcnt vmcnt(%0)" :: "n"(n) : "memory")
#define PG8_WAIT_L(n) asm volatile("s_waitcnt lgkmcnt(" #n ")" ::: "memory")
#define PG8_BAR __builtin_amdgcn_s_barrier()
#define PG8_SCHED __builtin_amdgcn_sched_barrier(0)
    if (stag > 0) { const unsigned long long t0_ = __builtin_amdgcn_s_memrealtime(), dl_ = (unsigned long long)(((bid_here() >> 3) & 3) * stag);
        while (__builtin_amdgcn_s_memrealtime() - t0_ < dl_) __builtin_amdgcn_s_sleep(8); }
    Unit cur, nxt; int ui = 0;
    if (!S.next(0, cur)) return;
    float zz_ = 0.f; asm volatile("" : "+v"(zz_));
    int sc1_ = 0x7f7f7f7f; asm volatile("" : "+v"(sc1_));
    LAS int* const rawx = (LAS int*)(lds + STAGE_BYTES + 8192 + 16384); int rawpm = -1; (void)rawx; (void)rawpm;
    LAS u32x4* const park = (LAS u32x4*)(lds + STAGE_BYTES + 8192);
    f32x4 acc[2][2][4][2];
#pragma unroll
    for (int a = 0; a < 2; ++a)
#pragma unroll
        for (int b = 0; b < 2; ++b)
#pragma unroll
            for (int m = 0; m < 4; ++m)
#pragma unroll
                for (int n = 0; n < 2; ++n) acc[a][b][m][n] = (f32x4){zz_, zz_, zz_, zz_};
    bf16x8 At[4][2], B0[2][2], B1[2][2]; v8i32_t At8[4], B08[2], B18[2];
    unsigned vc0 = 0u, vc1 = 0u;
    unsigned cA0, cA1, nA0, nA1;
    if constexpr (Sched::GATHER) { u32x4 pk; PG8_GATHER4(cur, pk); park[tid] = pk; }
    else { vc0 = PG8_AVOFF(cur, 0, 0); vc1 = PG8_AVOFF(cur, 0, 1); }
    cA0 = S.a_soff(cur, 0); cA1 = S.a_soff(cur, 1);
    unsigned cB = (unsigned)S.b_off(cur);
    PG8_STAGE_B(PG8_SB(0, 0), cB); PG8_STAGE_B(PG8_SB(0, 1), cB + hstep); PG8_STAGE_A(PG8_SA(0, 0), cA0, 0, 0); PG8_STAGE_A(PG8_SA(0, 1), cA1, 1, 0);
    if (wr == 1) PG8_BAR;
    PG8_WAIT_V(2); PG8_BAR;
    PG8_STAGE_B(PG8_SB(1, 0), cB + kstep); PG8_STAGE_A(PG8_SA(1, 0), cA0 + kstep, 0, 0); PG8_STAGE_B(PG8_SB(1, 1), cB + hstep + kstep);
    if constexpr (Epi::PEEL) PG8_WAIT_V(0); else PG8_WAIT_V(6);
    PG8_BAR;
    for (;;) {
#define PG8_TRIP(a1k, a2k0, a2k1, a3k0, b2, b3, NX, W1, W2) do { \
              \
            PG8_LDB(B0, 0, 0); PG8_LDB(B1, 0, 1); PG8_SCHED; PG8_LDA(At, 0, 0); PG8_STAGE_A(PG8_SA(1, 1), a1k, 1, 0); \
            W1; PG8_WAIT_L(0); PG8_BAR; PG8_MMA(0, 0, At, B0); PG8_MMA(0, 1, At, B1); PG8_BAR; PG8_SCHED; \
              \
            PG8_LDA(At, 0, 1); PG8_STAGE_B(PG8_SB(0, 0), b2); PG8_STAGE_B(PG8_SB(0, 1), (b2) + hstep); PG8_STAGE_A(PG8_SA(0, 0), a2k0, 0, NX); \
            W2; PG8_WAIT_L(0); PG8_BAR; PG8_MMA(1, 0, At, B0); PG8_MMA(1, 1, At, B1); PG8_BAR; PG8_SCHED; \
              \
            PG8_LDB(B0, 1, 0); PG8_LDB(B1, 1, 1); PG8_SCHED; PG8_LDA(At, 1, 0); PG8_STAGE_A(PG8_SA(0, 1), a2k1, 1, NX); \
            PG8_WAIT_V(8); PG8_WAIT_L(0); PG8_BAR; PG8_MMA(0, 0, At, B0); PG8_MMA(0, 1, At, B1); PG8_BAR; PG8_SCHED; \
              \
            PG8_LDA(At, 1, 1); PG8_STAGE_B(PG8_SB(1, 0), b3); PG8_STAGE_B(PG8_SB(1, 1), (b3) + hstep); PG8_STAGE_A(PG8_SA(1, 0), a3k0, 0, NX); \
            PG8_WAIT_V(8); PG8_WAIT_L(0); PG8_BAR; PG8_MMA(1, 0, At, B0); PG8_MMA(1, 1, At, B1); PG8_BAR; PG8_SCHED; } while (0)
        const bool has_next = S.next(ui + 1, nxt);
        if constexpr (Sched::GATHER) { if (has_next) { u32x4 pk;
            if (nxt.pm == cur.pm) pk = park[(ui & 1) * 512 + tid];
            else if (nxt.pm == rawpm) { int R0_, C0_, R1_, C1_; stage_rc(tid * 16, R0_, C0_); stage_rc(tid * 16 + 8192, R1_, C1_);
                pk.x = S.a_voff_raw(nxt, R0_, C0_, rawx[tid]); pk.y = S.a_voff_raw(nxt, R1_, C1_, rawx[512 + tid]); pk.z = S.a_voff_raw(nxt, HALF + R0_, C0_, rawx[1024 + tid]); pk.w = S.a_voff_raw(nxt, HALF + R1_, C1_, rawx[1536 + tid]); }
            else PG8_GATHER4(nxt, pk);
            park[((ui + 1) & 1) * 512 + tid] = pk;
            if (nxt.pm == cur.pm) { Unit nn; if (S.next(ui + 2, nn) && nn.pm != cur.pm) { int R0_, C0_, R1_, C1_; stage_rc(tid * 16, R0_, C0_); stage_rc(tid * 16 + 8192, R1_, C1_);
                S.a_raw_dma(nn, R0_, (LAS void*)((LAS unsigned char*)rawx + wid * 256)); S.a_raw_dma(nn, R1_, (LAS void*)((LAS unsigned char*)rawx + 2048 + wid * 256));
                S.a_raw_dma(nn, HALF + R0_, (LAS void*)((LAS unsigned char*)rawx + 4096 + wid * 256)); S.a_raw_dma(nn, HALF + R1_, (LAS void*)((LAS unsigned char*)rawx + 6144 + wid * 256)); rawpm = nn.pm; } } } }
        unsigned nB;
        if (has_next) { nA0 = S.a_soff(nxt, 0); nA1 = S.a_soff(nxt, 1); nB = (unsigned)S.b_off(nxt); }
        else { nA0 = cA0; nA1 = cA1; nB = cB; }
        if constexpr (Epi::PEEL) { const int t = 0; const bool last = (t == nt - 2);
            const unsigned k1 = (unsigned)(t + 1) * kstep, k2 = (unsigned)(t + 2) * kstep;
            const unsigned a2k0 = last ? nA0 : cA0 + k2, a2k1 = last ? nA1 : cA1 + k2, b2 = last ? nB : cB + k2;
            const int nx = (last && has_next) ? 1 : 0;
            PG8_TRIP(cA1 + k1, a2k0, a2k1, a2k0 + kstep, b2, b2 + kstep, nx, PG8_WAIT_VN(2 + Epi::NSTORE), PG8_WAIT_VN(8 + Epi::NSTORE)); }
#pragma unroll 1
        for (int t = Epi::PEEL ? 2 : 0; t < nt; t += 2) {
            const bool last = (t == nt - 2);
            const unsigned k1 = (unsigned)(t + 1) * kstep, k2 = (unsigned)(t + 2) * kstep;
            const unsigned a2k0 = last ? nA0 : cA0 + k2, a2k1 = last ? nA1 : cA1 + k2, b2 = last ? nB : cB + k2;
            const int nx = (last && has_next) ? 1 : 0;
            PG8_TRIP(cA1 + k1, a2k0, a2k1, a2k0 + kstep, b2, b2 + kstep, nx, PG8_WAIT_V(8), PG8_WAIT_V(8));
        }
#undef PG8_TRIP
        if constexpr (ALIGN_EPI) { if (wr == 0) PG8_BAR; }
        { int tq_ = tid; asm volatile("" : "+v"(tq_));
          const int wq_ = __builtin_amdgcn_readfirstlane(tq_ >> 6); E(acc, cur, wq_ >> 2, wq_ & 3, tq_ & 15, (tq_ & 63) >> 4); }
        if (!has_next) break;
#pragma unroll
        for (int a = 0; a < 2; ++a)
#pragma unroll
            for (int b = 0; b < 2; ++b)
#pragma unroll
                for (int m = 0; m < 4; ++m)
#pragma unroll
                    for (int n = 0; n < 2; ++n) acc[a][b][m][n] = (f32x4){zz_, zz_, zz_, zz_};
        cur = nxt; cB = nB; cA0 = nA0; cA1 = nA1; ++ui;
        if constexpr (ALIGN_EPI) { if (wr == 1) PG8_BAR; }
    }
    PG8_WAIT_V(0);
    if constexpr (!ALIGN_EPI) { if (wr == 0) PG8_BAR; }
    PG8_BAR;
#undef PG8_SA
#undef PG8_AVOFF
#undef PG8_GATHER4
#undef PG8_SB
#undef PG8_STAGE_A
#undef PG8_STAGE_B
#undef PG8_LDA
#undef PG8_LDB
#undef PG8_LD8
#undef PG8_MMA
#undef PG8_WAIT_V
#undef PG8_WAIT_VN
#undef PG8_WAIT_L
#undef PG8_BAR
#undef PG8_SCHED
}

struct StaticOrder {
    int nM, nN, nwg, G, c, lda, dup;
    __device__ __forceinline__ void init(int M, int N, int lda_, int G_, int c_) { nM = M / BM; nN = N / BM; nwg = nM * nN; G = G_; c = c_; lda = lda_; dup = 0; }
    __device__ __forceinline__ bool next(int i, Unit& u) const {
        const long L = (long)(i >> dup) * G + c; if (L >= nwg) return false;
        int wgid = (int)L; { const int q = nwg / NXCD, r = nwg % NXCD, xcd = wgid % NXCD, off = wgid / NXCD; wgid = (xcd < r ? xcd * (q + 1) : r * (q + 1) + (xcd - r) * q) + off; }
        const int nig = WGM * nN, gid = wgid / nig, fm = gid * WGM, gsz = (nM - fm) < WGM ? (nM - fm) : WGM;
        u.pm = fm + ((wgid % nig) % gsz); u.pn = (wgid % nig) / gsz; u.e = 0; u.aux = 0; return true;
    }
    static constexpr bool GATHER = false;
    __device__ __forceinline__ unsigned a_voff(const Unit&, int R, int C) const { return (unsigned)((R & (HALF - 1)) * lda + C) * 2u; }
    __device__ __forceinline__ unsigned a_soff(const Unit& u, int h) const { return (unsigned)((u.pm * BM + h * HALF) * lda) * 2u; }
    __device__ __forceinline__ size_t b_off(const Unit& u) const { return (size_t)u.pn * BM * lda * 2; }
};
}

#define XB_TMO      128
#define XB_XCNT(j)  (256  + 64 * (j))
#define XB_XSUB(j)  (1280 + 64 * (j))
#define XB_XGEN(j)  (2304 + 64 * (j))
#define XB_TOP      3328
#define XB_TOPGEN   3392
#define XCD_BAR_WORDS 3456
#define XB_SPIN_CAP (1u << 18)

__device__ __forceinline__ unsigned xb_ld(unsigned* p)              { return __hip_atomic_load(p, __ATOMIC_RELAXED, __HIP_MEMORY_SCOPE_AGENT); }
__device__ __forceinline__ unsigned xb_add(unsigned* p, unsigned v) { return __hip_atomic_fetch_add(p, v, __ATOMIC_RELAXED, __HIP_MEMORY_SCOPE_AGENT); }
__device__ __forceinline__ unsigned xb_xcc_id() { return (unsigned)__builtin_amdgcn_s_getreg((3 << 11) | 20) & 0xFu; }
#define XB_SPIN(cond, bar) do { unsigned _sp = 0; while (cond) { __builtin_amdgcn_s_sleep(1); \
    if ((++_sp & 255u) == 0u) { if (xb_ld(&(bar)[XB_TMO])) break; if (_sp > XB_SPIN_CAP) { atomicAdd(&(bar)[XB_TMO], 1u); break; } } } } while (0)

struct XcdBarrier {
    unsigned* bar; unsigned x;
    volatile LAS unsigned* st;
};

__device__ __forceinline__ XcdBarrier xcd_barrier_post(unsigned* bar, volatile LAS unsigned* st) {
    XcdBarrier b; b.bar = bar; b.x = xb_xcc_id(); b.st = st;
    if (threadIdx.x == 0) (void)xb_add(&bar[XB_XCNT(b.x)], 1u);
    return b;
}
__device__ __forceinline__ void xcd_barrier_complete(unsigned* bar, unsigned x, unsigned& nloc, unsigned& nx) {
    const unsigned G = gridDim.x * gridDim.y * gridDim.z;
    unsigned sum, cnt, mine, sp = 0u;
    for (;;) {
        sum = 0u; cnt = 0u; mine = 0u;
#pragma unroll
        for (unsigned j = 0; j < 16; ++j) { const unsigned c = xb_ld(&bar[XB_XCNT(j)]); sum += c; cnt += (c > 0u) ? 1u : 0u; mine = (j == x) ? c : mine; }
        if (sum == G) break;
        __builtin_amdgcn_s_sleep(1);
        if ((++sp & 255u) == 0u) { if (xb_ld(&bar[XB_TMO])) break; if (sp > XB_SPIN_CAP) { atomicAdd(&bar[XB_TMO], 1u); break; } }
    }
    nloc = mine > 0u ? mine : 1u; nx = cnt > 0u ? cnt : 1u;
}

__device__ __forceinline__ void xcd_barrier(const XcdBarrier& b) {
    asm volatile("s_waitcnt vmcnt(0)" ::: "memory");
    __syncthreads();
    if (threadIdx.x == 0) {
        unsigned* bar = b.bar;
        __builtin_amdgcn_s_waitcnt(0);
        unsigned nloc = b.st[0], nx = b.st[1];
        if (nloc == 0u) { xcd_barrier_complete(bar, b.x, nloc, nx); b.st[0] = nloc; b.st[1] = nx; }
        const unsigned old = xb_add(&bar[XB_XSUB(b.x)], 1u);
        const unsigned gen = old / nloc;
        if (old + 1u == (gen + 1u) * nloc) {
            __builtin_amdgcn_fence(__ATOMIC_RELEASE, "agent");
            asm volatile("s_waitcnt vmcnt(0)" ::: "memory");
            const unsigned og = xb_add(&bar[XB_TOP], 1u);
            const unsigned tg = og / nx;
            if (og + 1u == (tg + 1u) * nx) xb_add(&bar[XB_TOPGEN], 1u);
            else XB_SPIN(xb_ld(&bar[XB_TOPGEN]) == tg, bar);
            __builtin_amdgcn_fence(__ATOMIC_ACQUIRE, "agent");
            xb_add(&bar[XB_XGEN(b.x)], 1u);
            asm volatile("s_waitcnt vmcnt(0)" ::: "memory");
        } else {
            XB_SPIN(xb_ld(&bar[XB_XGEN(b.x)]) == gen, bar);
            __builtin_amdgcn_fence(__ATOMIC_ACQUIRE, "agent");
            asm volatile("s_waitcnt vmcnt(0)" ::: "memory");
        }
    }
    __syncthreads();
}

struct Args { const float* in[23]; float* out; unsigned char* ws; int ph_lo, ph_hi, li, pad; };
#define CAS __attribute__((address_space(4)))
typedef const CAS Args& ArgsRef;
enum { I_X = 0, I_NORM1G, I_WIN, I_POOLW, I_POOLSC, I_CONVW, I_CONVB, I_WA, I_BA, I_WX, I_BX, I_LAM, I_QG, I_KG, I_OG, I_WOUT, I_NORM2G, I_WR, I_BR, I_WGU, I_BGU, I_WD, I_BD };

constexpr float WGU8_SCALE = 64.0f, WD8_SCALE = 64.0f, ACT8_SCALE = 4.0f, WOUT8_SCALE = 64.0f, WIN8_SCALE = 64.0f;
struct TrDesc { const float* W; int K, N; bf16* WT; const float* gk; int mode, item; };
__device__ __forceinline__ void tr_load(const TrDesc& d, float (&v)[32], float (&g)[8], int lane) {
    const int nblk = d.N / 32, kb = d.item / nblk, nb = d.item % nblk, k0 = 64 * kb, n0 = 32 * nb;
#pragma unroll
    for (int i = 0; i < 32; ++i) { const int kk = 2 * i + (lane >> 5); v[i] = __builtin_nontemporal_load(d.W + (size_t)(k0 + kk) * d.N + n0 + (lane & 31)); }
    const float* gp = (d.gk ? d.gk + k0 : d.W) + 8 * (lane & 7);
    const f32x4 g0 = *(const f32x4*)gp, g1 = *(const f32x4*)(gp + 4); const bool hg = d.gk != nullptr;
    g[0] = hg ? g0[0] : 1.f; g[1] = hg ? g0[1] : 1.f; g[2] = hg ? g0[2] : 1.f; g[3] = hg ? g0[3] : 1.f; g[4] = hg ? g1[0] : 1.f; g[5] = hg ? g1[1] : 1.f; g[6] = hg ? g1[2] : 1.f; g[7] = hg ? g1[3] : 1.f;
}
__device__ __forceinline__ void tr_finish(const TrDesc& d, float (&v)[32], const float (&g)[8], LAS float* scr, int lane) {
    const int nblk = d.N / 32, kb = d.item / nblk, nb = d.item % nblk, k0 = 64 * kb, n0 = 32 * nb; const int K = d.K;
#pragma unroll
    for (int i = 0; i < 32; ++i) { const int kk = 2 * i + (lane >> 5); scr[kk * 33 + (lane & 31)] = v[i]; }
    LDS_WAIT(); asm volatile("" ::: "memory");
    const int c = lane & 7;
#pragma unroll
    for (int j = 0; j < 4; ++j) { const int n = (lane >> 3) + 8 * j; const LAS float* s = scr + (8 * c) * 33 + n;
        float x[8];
#pragma unroll
        for (int q = 0; q < 8; ++q) x[q] = s[q * 33] * g[q];
        u32x4 o; o.x = cvt_pk_bf16(x[0], x[1]); o.y = cvt_pk_bf16(x[2], x[3]); o.z = cvt_pk_bf16(x[4], x[5]); o.w = cvt_pk_bf16(x[6], x[7]);
        int dn = n0 + n; const int mode = d.mode;
        if (mode == 5) {
            const int L = dn & 255; dn = (dn & ~255) + 128 * ((L >> 3) & 1) + 32 * (L >> 6) + 8 * ((L >> 4) & 3) + (L & 7);
            int w0 = __builtin_amdgcn_cvt_pk_fp8_f32(x[0] * WD8_SCALE, x[1] * WD8_SCALE, 0, false); w0 = __builtin_amdgcn_cvt_pk_fp8_f32(x[2] * WD8_SCALE, x[3] * WD8_SCALE, w0, true);
            int w1 = __builtin_amdgcn_cvt_pk_fp8_f32(x[4] * WD8_SCALE, x[5] * WD8_SCALE, 0, false); w1 = __builtin_amdgcn_cvt_pk_fp8_f32(x[6] * WD8_SCALE, x[7] * WD8_SCALE, w1, true);
            *(u32x2*)((unsigned char*)d.WT + (size_t)dn * K + k0 + 8 * c) = (u32x2){(unsigned)w0, (unsigned)w1}; continue; }
        if (mode == 4) {
            const int jj = dn & 255; dn = (jj >> 7) * 256 + (dn >> 8) * 128 + (jj & 127);
            int w0 = __builtin_amdgcn_cvt_pk_fp8_f32(x[0] * WGU8_SCALE, x[1] * WGU8_SCALE, 0, false); w0 = __builtin_amdgcn_cvt_pk_fp8_f32(x[2] * WGU8_SCALE, x[3] * WGU8_SCALE, w0, true);
            int w1 = __builtin_amdgcn_cvt_pk_fp8_f32(x[4] * WGU8_SCALE, x[5] * WGU8_SCALE, 0, false); w1 = __builtin_amdgcn_cvt_pk_fp8_f32(x[6] * WGU8_SCALE, x[7] * WGU8_SCALE, w1, true);
            *(u32x2*)((unsigned char*)d.WT + (size_t)dn * K + k0 + 8 * c) = (u32x2){(unsigned)w0, (unsigned)w1}; continue; }
        if (mode == 1) { const int jj = dn & 255; dn = (jj >> 7) * 256 + (dn >> 8) * 128 + (jj & 127); }
        if (mode == 3 || mode == 6 || ((mode == 2 || mode == 7) && (dn < C_Q || dn >= C_V))) {
            const int L = dn & 255; dn = (dn & ~255) + 128 * ((L >> 3) & 1) + 32 * (L >> 6) + 8 * ((L >> 4) & 3) + (L & 7); }
        else if (mode == 2 || mode == 7) {
            const int rem = (dn - C_Q) & 511, sec = (dn - C_Q) >> 9, head = rem >> 6, d2 = rem & 63;
            dn = C_Q + sec * 512 + (head >> 2) * 256 + (d2 >> 5) * 128 + (head & 3) * 32 + (d2 & 31); }
        if (mode == 6 || mode == 7) {
            int w0 = __builtin_amdgcn_cvt_pk_fp8_f32(x[0] * WOUT8_SCALE, x[1] * WOUT8_SCALE, 0, false); w0 = __builtin_amdgcn_cvt_pk_fp8_f32(x[2] * WOUT8_SCALE, x[3] * WOUT8_SCALE, w0, true);
            int w1 = __builtin_amdgcn_cvt_pk_fp8_f32(x[4] * WOUT8_SCALE, x[5] * WOUT8_SCALE, 0, false); w1 = __builtin_amdgcn_cvt_pk_fp8_f32(x[6] * WOUT8_SCALE, x[7] * WOUT8_SCALE, w1, true);
            *(u32x2*)((unsigned char*)d.WT + (size_t)dn * K + k0 + 8 * c) = (u32x2){(unsigned)w0, (unsigned)w1}; continue; }
        *(u32x4*)(d.WT + (size_t)dn * K + k0 + 8 * c) = o; }
    LDS_WAIT(); asm volatile("" ::: "memory");
}
__device__ __forceinline__ void cvt_row(const float* xrow, bf16* orow, float* ssq, int lane) {
    const f32x4* xr = (const f32x4*)xrow + lane;
    f32x4 v[4]; float s = 0.f;
#pragma unroll
    for (int j = 0; j < 4; ++j) { v[j] = xr[64 * j]; s += (v[j].x * v[j].x + v[j].y * v[j].y) + (v[j].z * v[j].z + v[j].w * v[j].w); }
    s = wave_sum(s);
    u32x2* o8 = (u32x2*)orow + lane;
#pragma unroll
    for (int j = 0; j < 4; ++j) { u32x2 w; w.x = cvt_pk_bf16(v[j].x, v[j].y); w.y = cvt_pk_bf16(v[j].z, v[j].w); o8[64 * j] = w; }
    if (lane == 0) *ssq = s;
}
__device__ __forceinline__ TrDesc tr_desc(ArgsRef a, int it) {
    unsigned char* ws = a.ws;
    constexpr int I_IN = 16 * 72, I_OUT = 16 * 32, I_R = 16, I_GU = 16 * 16, I_D = 4 * 32, I_S = 2;
    constexpr int PER_LAYER = I_IN + I_OUT + I_R + NEXP * I_GU + NEXP * I_D + 12 * I_S;
    const int l = it / PER_LAYER; int r = it % PER_LAYER; TrDesc d;
    if (r < I_IN) { d = TrDesc{a.in[I_WIN] + (size_t)l * DM * NIN, DM, NIN, (bf16*)(ws + WS_WIN) + (size_t)l * NIN * DM, a.in[I_NORM1G] + l * DM, l == 1 ? 7 : 2, r}; return d; } r -= I_IN;
    if (r < I_OUT) { d = TrDesc{a.in[I_WOUT] + (size_t)l * DM * DM, DM, DM, (bf16*)(ws + WS_WOUT) + (size_t)l * DM * DM, a.in[I_OG] + l * DM, l == 1 ? 6 : 3, r}; return d; } r -= I_OUT;
    if (r < I_R) { d = TrDesc{a.in[I_WR] + (size_t)l * DM * NEXP, DM, NEXP, (bf16*)(ws + WS_SMALL) + SM_WR + (size_t)l * NEXP * DM, a.in[I_NORM2G] + l * DM, 0, r}; return d; } r -= I_R;
    if (r < NEXP * I_GU) { const int e = r / I_GU; d = TrDesc{a.in[I_WGU] + (size_t)(l * NEXP + e) * DM * 512, DM, 512, (bf16*)(ws + WS_WGU + (size_t)(l * NEXP + e) * 512 * DM), a.in[I_NORM2G] + l * DM, 4, r % I_GU}; return d; } r -= NEXP * I_GU;
    if (r < NEXP * I_D) { const int e = r / I_D; d = TrDesc{a.in[I_WD] + (size_t)(l * NEXP + e) * EFF * DM, EFF, DM, (bf16*)(ws + WS_WD + (size_t)(l * NEXP + e) * DM * EFF), nullptr, 5, r % I_D}; return d; } r -= NEXP * I_D;
    { const int which = r / (4 * I_S), g = (r / I_S) % 4, sub = r % I_S;
      const float* src = a.in[which == 0 ? I_POOLW : (which == 1 ? I_WA : I_WX)] + (size_t)(l * 4 + g) * 4096;
      bf16* dst = (bf16*)(ws + WS_SMALL) + (which == 0 ? SM_POOLW : (which == 1 ? SM_WA : SM_WX)) + (size_t)(l * 4 + g) * 4096;
      d = TrDesc{src, 64, 64, dst, nullptr, 0, sub}; return d; }
}
__device__ __forceinline__ void phase_prologue(ArgsRef a, LAS unsigned char* lds, int wv) {
    const int tid = tid_from(wv), lane = tid & 63, wave = tid >> 6;
    LAS float* scr = (LAS float*)(lds + wave * 16384);
    const int gw = bid_here() * NWAVES + wave, NGW = gdim_here() * NWAVES;
    unsigned char* ws = a.ws;
    constexpr int PER_LAYER = 16 * 72 + 16 * 32 + 16 + NEXP * 16 * 16 + NEXP * 4 * 32 + 12 * 2;
    { int it = gw; float cur[32], nxt[32], gc[8], gn[8];
      TrDesc dc = tr_desc(a, it < 2 * PER_LAYER ? it : 0), dn = dc;
      if (it < 2 * PER_LAYER) tr_load(dc, cur, gc, lane);
#pragma unroll
      for (int i = 0; i < 8; ++i) gn[i] = gc[i];
      while (it < 2 * PER_LAYER) { const int itn = it + NGW;
          if (itn < 2 * PER_LAYER) { dn = tr_desc(a, itn); tr_load(dn, nxt, gn, lane); }
          tr_finish(dc, cur, gc, scr, lane);
#pragma unroll
          for (int i = 0; i < 32; ++i) cur[i] = nxt[i];
#pragma unroll
          for (int i = 0; i < 8; ++i) gc[i] = gn[i];
          dc = dn; it = itn; } }
    { float* ct = (float*)(ws + WS_ROPE); float* st = ct + SEQ * 32;
      for (int idx = bid_here() * NTHR + tid; idx < SEQ * 32; idx += gdim_here() * NTHR) {
          const int pos = idx >> 5, i = idx & 31;
          const float inv = __builtin_amdgcn_exp2f(-(float)i * 0.41524101186092029f);
          const float ang = (float)pos * inv;
          const double rev = (double)ang * 0.15915494309189535; const double fr = rev - __builtin_rint(rev);
          const float f = (float)fr;
          ct[idx] = __builtin_amdgcn_cosf(f); st[idx] = __builtin_amdgcn_sinf(f); } }
    { const float* __restrict__ X = a.in[I_X]; bf16* __restrict__ xb = (bf16*)(ws + WS_XB); float* __restrict__ ssq = (float*)(ws + WS_SSQ);
      for (int m0 = gw * 4; m0 < NT; m0 += NGW * 4) { f32x4 v[4][4];
#pragma unroll
          for (int u = 0; u < 4; ++u)
#pragma unroll
              for (int j = 0; j < 4; ++j) v[u][j] = __builtin_nontemporal_load((const f32x4*)(X + (size_t)(m0 + u) * DM) + lane + 64 * j);
#pragma unroll
          for (int u = 0; u < 4; ++u) { float s = 0.f;
#pragma unroll
              for (int j = 0; j < 4; ++j) s += (v[u][j].x * v[u][j].x + v[u][j].y * v[u][j].y) + (v[u][j].z * v[u][j].z + v[u][j].w * v[u][j].w);
              s = wave_sum(s);
#pragma unroll
              for (int j = 0; j < 4; ++j) { u32x2 w; w.x = cvt_pk_bf16(v[u][j].x, v[u][j].y); w.y = cvt_pk_bf16(v[u][j].z, v[u][j].w); *((u32x2*)(xb + (size_t)(m0 + u) * DM) + lane + 64 * j) = w; }
              if (lane == 0) ssq[m0 + u] = s; } } }
}

struct EpiIn {
    static constexpr bool PERM = true; static constexpr int NSTORE = 16; static constexpr bool PEEL = false;
    bf16* O; bf16* HM; const float* ssq; const float* qg; const float* kg; const float* ct; const float* st; LAS unsigned char* stage; float oscale;
    __device__ __forceinline__ void rows16(LAS unsigned char* stg, int fr, int fq, int c0, int c1, const u32x4& w0, const u32x4& w1, bf16* gbase, int stride) const {
        *(LAS u32x4*)(stg + fr * 128 + ((c0 ^ (fr & 7)) << 4)) = w0;
        *(LAS u32x4*)(stg + fr * 128 + ((c1 ^ (fr & 7)) << 4)) = w1;
        const int l = fr + 16 * fq, rr = l >> 3, cc = l & 7;
        const u32x4 a = *(const LAS u32x4*)(stg + rr * 128 + ((cc ^ rr) << 4)), b = *(const LAS u32x4*)(stg + (rr + 8) * 128 + ((cc ^ rr) << 4));
        *(u32x4*)(gbase + (size_t)rr * stride + cc * 8) = a;
        *(u32x4*)(gbase + (size_t)(rr + 8) * stride + cc * 8) = b;
    }
    __device__ __forceinline__ void operator()(const f32x4 (&acc)[2][2][4][2], const pg8::Unit& u, int wr, int wc, int fr, int fq) const {
        const int rbase0 = u.pm * 256 + wr * 64;
        LAS unsigned char* stg = stage + (wr * 4 + wc) * 2048;
        float rsv[2][4];
#pragma unroll
        for (int ai = 0; ai < 2; ++ai)
#pragma unroll
            for (int m = 0; m < 4; ++m) rsv[ai][m] = ssq[rbase0 + ai * 128 + m * 16 + fr];
        const float osc = oscale;
        if (u.pn >= 3 && u.pn < 7) {
            const bool isq = u.pn < 5; const float* gp = (isq ? qg : kg) + 8 * fq; const float gs = isq ? (0.125f * 1.4426950408889634f) : 1.0f;
            f32x4 g[2][2];
#pragma unroll
            for (int bj = 0; bj < 2; ++bj)
#pragma unroll
                for (int n = 0; n < 2; ++n) g[bj][n] = *(const f32x4*)(gp + 32 * bj + 4 * n);
            const int pos0 = (rbase0 + fr) & (SEQ - 1);
            f32x4 cb[2], sb[2], cd[2], sd[2], ce[2], se[2];
#pragma unroll
            for (int n = 0; n < 2; ++n) { cb[n] = *(const f32x4*)(ct + pos0 * 32 + 8 * fq + 4 * n); sb[n] = *(const f32x4*)(st + pos0 * 32 + 8 * fq + 4 * n);
                cd[n] = *(const f32x4*)(ct + 16 * 32 + 8 * fq + 4 * n); sd[n] = *(const f32x4*)(st + 16 * 32 + 8 * fq + 4 * n);
                ce[n] = *(const f32x4*)(ct + 128 * 32 + 8 * fq + 4 * n); se[n] = *(const f32x4*)(st + 128 * 32 + 8 * fq + 4 * n); }
            bf16* hb = HM + (size_t)(u.pn >= 5 ? 1 : 0) * NT * 512 + ((size_t)((rbase0 >> 12) * 8 + 4 * ((u.pn - 3) & 1) + wc) * SEQ + (rbase0 & (SEQ - 1))) * 64;
#pragma unroll
            for (int ai = 0; ai < 2; ++ai) { f32x4 cc[2], sc[2];
#pragma unroll
                for (int n = 0; n < 2; ++n) { if (ai == 0) { cc[n] = cb[n]; sc[n] = sb[n]; } else { cc[n] = cb[n] * ce[n] - sb[n] * se[n]; sc[n] = sb[n] * ce[n] + cb[n] * se[n]; } }
#pragma unroll
                for (int m = 0; m < 4; ++m) { const float rs = __builtin_amdgcn_rsqf(rsv[ai][m] * (1.0f / DM) + EPS) * osc;
                    f32x4 v[2][2]; float ss = 0.f;
#pragma unroll
                    for (int bj = 0; bj < 2; ++bj)
#pragma unroll
                        for (int n = 0; n < 2; ++n) { v[bj][n] = acc[ai][bj][m][n] * rs; ss += (v[bj][n][0] * v[bj][n][0] + v[bj][n][1] * v[bj][n][1]) + (v[bj][n][2] * v[bj][n][2] + v[bj][n][3] * v[bj][n][3]); }
                    ss = xsum32(xsum16(ss));
                    const float rr = __builtin_amdgcn_rsqf(ss * (1.0f / 64.0f) + EPS) * gs;
#pragma unroll
                    for (int bj = 0; bj < 2; ++bj)
#pragma unroll
                        for (int n = 0; n < 2; ++n) v[bj][n] = v[bj][n] * rr * g[bj][n];
                    const f32x4 o00 = v[0][0] * cc[0] - v[1][0] * sc[0], o01 = v[0][1] * cc[1] - v[1][1] * sc[1], o10 = v[1][0] * cc[0] + v[0][0] * sc[0], o11 = v[1][1] * cc[1] + v[0][1] * sc[1];
                    u32x4 w0, w1; w0.x = cvt_pk_bf16(o00[0], o00[1]); w0.y = cvt_pk_bf16(o00[2], o00[3]); w0.z = cvt_pk_bf16(o01[0], o01[1]); w0.w = cvt_pk_bf16(o01[2], o01[3]);
                    w1.x = cvt_pk_bf16(o10[0], o10[1]); w1.y = cvt_pk_bf16(o10[2], o10[3]); w1.z = cvt_pk_bf16(o11[0], o11[1]); w1.w = cvt_pk_bf16(o11[2], o11[3]);
                    rows16(stg, fr, fq, fq, 4 + fq, w0, w1, hb + (size_t)(ai * 128 + m * 16) * 64, 64);
                    if (m < 3) {
#pragma unroll
                        for (int n = 0; n < 2; ++n) { const f32x4 c2 = cc[n] * cd[n] - sc[n] * sd[n]; sc[n] = sc[n] * cd[n] + cc[n] * sd[n]; cc[n] = c2; } } } }
            return;
        }
        const bool isv = u.pn >= 7; const int stride = isv ? 64 : NPJ;
        bf16* ob = isv ? HM + (size_t)2 * NT * 512 + ((size_t)((rbase0 >> 12) * 8 + 4 * (u.pn - 7) + wc) * SEQ + (rbase0 & (SEQ - 1))) * 64
                       : O + (size_t)rbase0 * NPJ + u.pn * 256 + wc * 64;
#pragma unroll
        for (int ai = 0; ai < 2; ++ai)
#pragma unroll
            for (int m = 0; m < 4; ++m) { const float rs = __builtin_amdgcn_rsqf(rsv[ai][m] * (1.0f / DM) + EPS) * osc;
                u32x4 w[2];
#pragma unroll
                for (int bj = 0; bj < 2; ++bj) { const f32x4 v0 = acc[ai][bj][m][0] * rs, v1 = acc[ai][bj][m][1] * rs;
                    w[bj].x = cvt_pk_bf16(v0[0], v0[1]); w[bj].y = cvt_pk_bf16(v0[2], v0[3]); w[bj].z = cvt_pk_bf16(v1[0], v1[1]); w[bj].w = cvt_pk_bf16(v1[2], v1[3]); }
                rows16(stg, fr, fq, 2 * fq, 2 * fq + 1, w[0], w[1], ob + (size_t)(ai * 128 + m * 16) * stride, stride); }
    }
};
struct EpiOut {
    static constexpr bool PERM = true; static constexpr int NSTORE = 32; static constexpr bool PEEL = false;
    bf16* xb; float* ssqp; unsigned char* xb8; float oscale;
    __device__ __forceinline__ void operator()(const f32x4 (&acc)[2][2][4][2], const pg8::Unit& u, int wr, int wc, int fr, int fq) const {
        const int row0 = u.pm * 256 + wr * 64 + fr, col0 = u.pn * 256 + wc * 64 + fq * 16;
        u32x4 xi[2][4][2];
#pragma unroll
        for (int am = 0; am < 2; ++am)
#pragma unroll
            for (int mm = 0; mm < 4; ++mm) { const size_t off = (size_t)(row0 + am * 128 + mm * 16) * DM + col0; xi[am][mm][0] = *(const u32x4*)(xb + off); xi[am][mm][1] = *(const u32x4*)(xb + off + 8); }
        asm volatile("" ::: "memory");
#pragma unroll
        for (int am = 0; am < 2; ++am) {
#pragma unroll
            for (int mm = 0; mm < 4; ++mm) { const int ai = am, m = mm; const int row = row0 + ai * 128 + m * 16; const size_t off = (size_t)row * DM + col0; float s = 0.f; u32x4 w8;
#pragma unroll
                for (int bj = 0; bj < 2; ++bj) { const u32x4 x = xi[am][mm][bj];
                    const f32x4 o0 = (f32x4){bflo(x.x), bfhi(x.x), bflo(x.y), bfhi(x.y)} + acc[ai][bj][m][0] * oscale, o1 = (f32x4){bflo(x.z), bfhi(x.z), bflo(x.w), bfhi(x.w)} + acc[ai][bj][m][1] * oscale;
                    s += ((o0[0] * o0[0] + o0[1] * o0[1]) + (o0[2] * o0[2] + o0[3] * o0[3])) + ((o1[0] * o1[0] + o1[1] * o1[1]) + (o1[2] * o1[2] + o1[3] * o1[3]));
                    u32x4 w; w.x = cvt_pk_bf16(o0[0], o0[1]); w.y = cvt_pk_bf16(o0[2], o0[3]); w.z = cvt_pk_bf16(o1[0], o1[1]); w.w = cvt_pk_bf16(o1[2], o1[3]);
                    *(u32x4*)(xb + off + bj * 8) = w;
                    int f0 = __builtin_amdgcn_cvt_pk_fp8_f32(o0[0], o0[1], 0, false); f0 = __builtin_amdgcn_cvt_pk_fp8_f32(o0[2], o0[3], f0, true);
                    int f1 = __builtin_amdgcn_cvt_pk_fp8_f32(o1[0], o1[1], 0, false); f1 = __builtin_amdgcn_cvt_pk_fp8_f32(o1[2], o1[3], f1, true);
                    if (bj == 0) { w8.x = (unsigned)f0; w8.y = (unsigned)f1; } else { w8.z = (unsigned)f0; w8.w = (unsigned)f1; } }
                *(u32x4*)(xb8 + off) = w8;
                s = xsum32(xsum16(s));
                if (fq == 0) ssqp[(size_t)row * 16 + u.pn * 4 + wc] = s; }
            asm volatile("" ::: "memory"); }
    }
};

template <int MODE> struct MoeOrder {
    static constexpr bool GATHER = (MODE == 0 || MODE == 2);
    const LAS int* tab; int npn, G, c; const int* list; int dup;
    __device__ __forceinline__ bool next(int i, pg8::Unit& u) const {
        const int ii = i >> dup; const int total = __builtin_amdgcn_readfirstlane(tab[64]); const int nfr = total / G, nfu = nfr * npn;
        int gb;
        if (ii < nfu) { gb = (ii / npn) * G + c; u.pn = ii % npn; }
        else { const int L = (ii - nfu) * G + c; gb = nfr * G + L / npn; u.pn = L % npn; if (gb >= total) return false; }
        const int e = __builtin_amdgcn_readfirstlane((int)((const LAS unsigned char*)(tab + 80))[gb]);
        u.e = e; u.pm = gb; u.aux = gb - __builtin_amdgcn_readfirstlane(tab[32 + e]); return true;
    }
    __device__ __forceinline__ unsigned a_voff(const pg8::Unit& u, int R, int C) const {
        if constexpr (MODE == 0) { const int pos = u.aux * 256 + R; const int ne = tab[u.e]; int tok = 0; if (pos < ne) tok = list[u.e * NT + pos] >> 2; return (unsigned)(tok * DM + C) * 2u; }
        else if constexpr (MODE == 2) { const int pos = u.aux * 256 + R; const int ne = tab[u.e]; int tok = list[u.e * NT + (pos < ne ? pos : 0)] >> 2; if (pos >= ne) tok = 0; return (unsigned)(tok * (DM / 2) + C) * 2u; }
        else if constexpr (MODE == 3) return (unsigned)((R & 127) * (EFF / 2) + C) * 2u;
        else return (unsigned)((R & 127) * EFF + C) * 2u;
    }
    __device__ __forceinline__ int a_raw(const pg8::Unit& u, int R) const { const int pos = u.aux * 256 + R; const int ne = tab[u.e]; return list[u.e * NT + (pos < ne ? pos : 0)]; }
    __device__ __forceinline__ void a_raw_dma(const pg8::Unit& u, int R, LAS void* dst) const { const int pos = u.aux * 256 + R; const int ne = tab[u.e];
        const __amdgpu_buffer_rsrc_t rs = __builtin_amdgcn_make_buffer_rsrc((void*)list, 0, 0x7fffffff, 0x00020000);
        __builtin_amdgcn_raw_ptr_buffer_load_lds(rs, dst, 4, (unsigned)(u.e * NT + (pos < ne ? pos : 0)) * 4u, 0, 0, 0); }
    __device__ __forceinline__ unsigned a_voff_raw(const pg8::Unit& u, int R, int C, int raw) const { const int pos = u.aux * 256 + R; const int ne = tab[u.e]; int tok = raw >> 2; if (pos >= ne) tok = 0;
        return (unsigned)(tok * (MODE == 2 ? DM / 2 : DM) + C) * 2u; }
    __device__ __forceinline__ unsigned a_soff(const pg8::Unit& u, int h) const { if constexpr (MODE == 1) return (unsigned)((u.pm * 256 + h * 128) * EFF) * 2u; else if constexpr (MODE == 3) return (unsigned)((u.pm * 256 + h * 128) * EFF); else return 0u; }
    __device__ __forceinline__ size_t b_off(const pg8::Unit& u) const {
        if constexpr (MODE == 0) return ((size_t)u.e * 512 + (size_t)u.pn * 256) * DM * 2;
        else if constexpr (MODE == 2) return ((size_t)u.e * 512 + (size_t)u.pn * 256) * DM;
        else if constexpr (MODE == 3) return ((size_t)u.e * DM + (size_t)u.pn * 256) * EFF;
        else return ((size_t)u.e * DM + (size_t)u.pn * 256) * EFF * 2;
    }
};
struct EpiGU {
    static constexpr bool PERM = true; static constexpr int NSTORE = 8; static constexpr bool PEEL = true;
    unsigned char* act; const float* lrstd; const float* bgu;
    __device__ __forceinline__ void operator()(const f32x4 (&acc)[2][2][4][2], const pg8::Unit& u, int wr, int wc, int fr, int fq) const {
        const int r0 = wr * 64 + fr, cl0 = wc * 32 + 8 * fq;
        const float* bg = bgu + u.e * 512 + u.pn * 128 + cl0;
        const f32x4 bg0 = *(const f32x4*)(bg), bg1 = *(const f32x4*)(bg + 4), bu0 = *(const f32x4*)(bg + 256), bu1 = *(const f32x4*)(bg + 260);
        float rsv[2][4];
#pragma unroll
        for (int ai = 0; ai < 2; ++ai)
#pragma unroll
            for (int m = 0; m < 4; ++m) rsv[ai][m] = lrstd[(size_t)u.e * NT + u.aux * 256 + r0 + ai * 128 + m * 16];
#pragma unroll
        for (int ai = 0; ai < 2; ++ai)
#pragma unroll
            for (int m = 0; m < 4; ++m) { const int r = r0 + ai * 128 + m * 16; const float rs = rsv[ai][m] * (1.0f / WGU8_SCALE);
                f32x4 g0 = acc[ai][0][m][0] * rs + bg0, g1 = acc[ai][0][m][1] * rs + bg1, u0 = acc[ai][1][m][0] * rs + bu0, u1 = acc[ai][1][m][1] * rs + bu1;
                float o[8];
#pragma unroll
                for (int j = 0; j < 4; ++j) { const float ga = fminf(g0[j], 7.0f), ua = fminf(fmaxf(u0[j], -7.0f), 7.0f); o[j] = (ua + 1.0f) * ga * fast_sigmoid(1.702f * ga);
                                              const float gb = fminf(g1[j], 7.0f), ub = fminf(fmaxf(u1[j], -7.0f), 7.0f); o[4 + j] = (ub + 1.0f) * gb * fast_sigmoid(1.702f * gb); }
                int w0 = __builtin_amdgcn_cvt_pk_fp8_f32(o[0] * ACT8_SCALE, o[1] * ACT8_SCALE, 0, false); w0 = __builtin_amdgcn_cvt_pk_fp8_f32(o[2] * ACT8_SCALE, o[3] * ACT8_SCALE, w0, true);
                int w1 = __builtin_amdgcn_cvt_pk_fp8_f32(o[4] * ACT8_SCALE, o[5] * ACT8_SCALE, 0, false); w1 = __builtin_amdgcn_cvt_pk_fp8_f32(o[6] * ACT8_SCALE, o[7] * ACT8_SCALE, w1, true);
                *(u32x2*)(act + (size_t)(u.pm * 256 + r) * EFF + u.pn * 128 + cl0) = (u32x2){(unsigned)w0, (unsigned)w1}; }
    }
};
constexpr float Y8_SCALE = 32.0f;
struct EpiDown {
    static constexpr bool PERM = true; static constexpr int NSTORE = 8; static constexpr bool PEEL = true;
    unsigned char* y; const int* list; const float* lgate; const float* bd; const LAS int* tab;
    __device__ __forceinline__ void operator()(const f32x4 (&acc)[2][2][4][2], const pg8::Unit& u, int wr, int wc, int fr, int fq) const {
        const int r0 = wr * 64 + fr, col0 = u.pn * 256 + wc * 64 + fq * 16; const int ne = tab[u.e];
        const float* bp = bd + u.e * DM + col0;
        float gt[2][4]; f32x4 bb[2][2];
#pragma unroll
        for (int ai = 0; ai < 2; ++ai)
#pragma unroll
            for (int m = 0; m < 4; ++m) { const int pos = u.aux * 256 + r0 + ai * 128 + m * 16; gt[ai][m] = lgate[(size_t)u.e * NT + (pos < ne ? pos : 0)]; if (pos >= ne) gt[ai][m] = 0.f; }
#pragma unroll
        for (int bj = 0; bj < 2; ++bj) { bb[bj][0] = *(const f32x4*)(bp + bj * 8); bb[bj][1] = *(const f32x4*)(bp + bj * 8 + 4); }
#pragma unroll
        for (int ai = 0; ai < 2; ++ai) {
#pragma unroll
            for (int m = 0; m < 4; ++m) { unsigned char* rowp = y + (size_t)(u.pm * 256 + r0 + ai * 128 + m * 16) * DM + col0; const float g = gt[ai][m] * Y8_SCALE; u32x4 wv4;
#pragma unroll
                for (int bj = 0; bj < 2; ++bj) { const f32x4 b0 = bb[bj][0], b1 = bb[bj][1];
                    const f32x4 v0 = (acc[ai][bj][m][0] * (1.0f / (WD8_SCALE * ACT8_SCALE)) + b0) * g, v1 = (acc[ai][bj][m][1] * (1.0f / (WD8_SCALE * ACT8_SCALE)) + b1) * g;
                    int w0 = __builtin_amdgcn_cvt_pk_fp8_f32(v0[0], v0[1], 0, false); w0 = __builtin_amdgcn_cvt_pk_fp8_f32(v0[2], v0[3], w0, true);
                    int w1 = __builtin_amdgcn_cvt_pk_fp8_f32(v1[0], v1[1], 0, false); w1 = __builtin_amdgcn_cvt_pk_fp8_f32(v1[2], v1[3], w1, true);
                    if (bj == 0) { wv4.x = (unsigned)w0; wv4.y = (unsigned)w1; } else { wv4.z = (unsigned)w0; wv4.w = (unsigned)w1; } }
                *(u32x4*)rowp = wv4; } }
    }
};
__device__ __forceinline__ void moe_tables(LAS int* tab, const unsigned* cnt, int wv) {
    __syncthreads();
    const int tid_ = tid_from(wv);
    if (tid_ < 64) {
        const int ln = tid_ & 63; const int n = (ln < NEXP) ? (int)__hip_atomic_load(cnt + (ln & 31), RLX_AGENT) : 0; const int nb = (n + 255) >> 8; int incl = nb;
#pragma unroll
        for (int d = 1; d < 32; d <<= 1) { const int v = __shfl_up(incl, d, 64); if (ln >= d) incl += v; }
        if (ln < NEXP) { tab[ln] = n; tab[32 + ln] = incl - nb; }
        if (ln == NEXP - 1) tab[64] = incl; }
    __syncthreads();
    { LAS unsigned char* eb = (LAS unsigned char*)(tab + 80);
      if (tid_ < NEXP) { const int b0 = tab[32 + tid_], b1 = b0 + ((tab[tid_] + 255) >> 8);
          for (int gb = b0; gb < b1; ++gb) eb[gb] = (unsigned char)tid_; } }
    __syncthreads();
}

__device__ __forceinline__ void phase_qkprep(ArgsRef a, int layer, int wv, bool dry) {
    const int tid = tid_from(wv), lane = tid & 63, wave = tid >> 6;
    const int gw = bid_here() * NWAVES + wave, NGW = gdim_here() * NWAVES;
    bf16* proj = (bf16*)(a.ws + WS_PROJ);
    const float* __restrict__ ct = (const float*)(a.ws + WS_ROPE); const float* __restrict__ st = ct + SEQ * 32;
    const int d0 = (lane & 7) * 8, p0 = d0 & 31;
    float gq[8], gk[8];
#pragma unroll
    for (int j = 0; j < 8; ++j) { gq[j] = a.in[I_QG][layer * 64 + d0 + j] * (0.125f * 1.4426950408889634f); gk[j] = a.in[I_KG][layer * 64 + d0 + j]; }
    const bool second = (lane & 4) != 0;
    constexpr int TB = 4;
    for (int t0 = gw * TB; t0 < NT; t0 += NGW * TB) {
        u32x4 w[TB][2]; f32x4 cs[TB][4];
#pragma unroll
        for (int u = 0; u < TB; ++u) { const int t = t0 + u, pos = t & (SEQ - 1);
            w[u][0] = *(const u32x4*)(proj + (size_t)t * NIN + C_Q + lane * 8); w[u][1] = *(const u32x4*)(proj + (size_t)t * NIN + C_Q + 512 + lane * 8);
            cs[u][0] = *(const f32x4*)(ct + pos * 32 + p0); cs[u][1] = *(const f32x4*)(ct + pos * 32 + p0 + 4); cs[u][2] = *(const f32x4*)(st + pos * 32 + p0); cs[u][3] = *(const f32x4*)(st + pos * 32 + p0 + 4); }
#pragma unroll
        for (int u = 0; u < TB; ++u) { const int t = t0 + u;
            float c[8], s[8];
#pragma unroll
            for (int j = 0; j < 4; ++j) { c[j] = cs[u][0][j]; c[4 + j] = cs[u][1][j]; s[j] = cs[u][2][j]; s[4 + j] = cs[u][3][j]; }
#pragma unroll
            for (int i = 0; i < 2; ++i) {
                const u32x4 ww = w[u][i];
                float x[8]; x[0] = bflo(ww.x); x[1] = bfhi(ww.x); x[2] = bflo(ww.y); x[3] = bfhi(ww.y); x[4] = bflo(ww.z); x[5] = bfhi(ww.z); x[6] = bflo(ww.w); x[7] = bfhi(ww.w);
                float ss = 0.f;
#pragma unroll
                for (int j = 0; j < 8; ++j) ss += x[j] * x[j];
                ss += __shfl_xor(ss, 1); ss += __shfl_xor(ss, 2); ss += __shfl_xor(ss, 4);
                const float rs = __builtin_amdgcn_rsqf(ss * (1.0f / 64.0f) + EPS);
                float o[8];
#pragma unroll
                for (int j = 0; j < 8; ++j) { const float yv = x[j] * rs * (i == 0 ? gq[j] : gk[j]); const float pv = __shfl_xor(yv, 4);
                    o[j] = second ? (yv * c[j] + pv * s[j]) : (yv * c[j] - pv * s[j]); }
                u32x4 r; r.x = cvt_pk_bf16(o[0], o[1]); r.y = cvt_pk_bf16(o[2], o[3]); r.z = cvt_pk_bf16(o[4], o[5]); r.w = cvt_pk_bf16(o[6], o[7]);
                if (!dry || o[0] == 12345.678f) *(u32x4*)(proj + (size_t)t * NIN + C_Q + i * 512 + lane * 8) = r;
            } }
    }
}

__device__ __forceinline__ void phase_pool(ArgsRef a, LAS unsigned char* lds, int layer, int wv) {
    const int tid = tid_from(wv), lane = tid & 63, wave = __builtin_amdgcn_readfirstlane(tid >> 6);
    const bf16* proj = (const bf16*)(a.ws + WS_PROJ); bf16* YP = (bf16*)(a.ws + WS_YP); float* SSQPOOL = (float*)(a.ws + WS_SSQPOOL);
    const int g = wave & 3, w = 2 << g, lr = lane & 15, lq = lane >> 4;
    constexpr int US = 72;
    LAS bf16* Uw = (LAS bf16*)(lds + wave * 11520);
    LAS bf16* Xw = (LAS bf16*)(lds + wave * 11520 + 6784);
    const bf16* pw = (const bf16*)(a.ws + WS_SMALL) + SM_POOLW + (size_t)(layer * 4 + g) * 4096;
    bf16x8 bw[4][2]; float psc[4];
#pragma unroll
    for (int et = 0; et < 4; ++et) {
#pragma unroll
        for (int ks = 0; ks < 2; ++ks) bw[et][ks] = *(const bf16x8*)(pw + (et * 16 + lr) * 64 + ks * 32 + lq * 8);
        psc[et] = a.in[I_POOLSC][layer * 256 + g * 64 + et * 16 + lr]; }
    __syncthreads();
    const int nstreams = gdim_here() * 2;
    u32x4 pre[6];
#define POOL_FETCH(TK) do { const int t0_ = (TK) * 32, s0_ = t0_ & (SEQ - 1); _Pragma("unroll") for (int j = 0; j < 6; ++j) { const int id = lane + 64 * j; const int row = id >> 3, c8 = (id & 7) * 8; \
            pre[j] = (u32x4){0u, 0u, 0u, 0u}; if (id < 47 * 8 && s0_ - 15 + row >= 0) pre[j] = __builtin_nontemporal_load((const u32x4*)(proj + (size_t)(t0_ - 15 + row) * NPJ + C_POOL + g * 64 + c8)); } } while (0)
    { const int tk0 = bid_here() * 2 + (wave >> 2); if (tk0 < NT / 32) POOL_FETCH(tk0); }
    for (int tk = bid_here() * 2 + (wave >> 2); tk < NT / 32; tk += nstreams) {
        const int t0 = tk * 32, s0 = t0 & (SEQ - 1);
#pragma unroll
        for (int j = 0; j < 6; ++j) { const int id = lane + 64 * j;
            if (id < 47 * 8) { const int row = id >> 3, c8 = (id & 7) * 8; *(LAS u32x4*)(Uw + row * US + c8) = pre[j]; } }
        if (tk + nstreams < NT / 32) POOL_FETCH(tk + nstreams);
        LDS_WAIT(); asm volatile("" ::: "memory");
        { float u[47], pl[32];
#pragma unroll
          for (int r = 0; r < 47; ++r) u[r] = bf2f(Uw[r * US + lane]);
#define POOL_RUN(W) do { float sum = 0.f; _Pragma("unroll") for (int j = 1; j < (W); ++j) sum += u[15 - j]; \
              _Pragma("unroll") for (int tl = 0; tl < 32; ++tl) { const float cur = u[15 + tl]; sum += cur; const int cnt = min((W), s0 + tl + 1); \
                  pl[tl] = sum * __builtin_amdgcn_rcpf((float)cnt) - cur; sum -= u[15 + tl - (W) + 1]; } } while (0)
          if (g == 0) POOL_RUN(2); else if (g == 1) POOL_RUN(4); else if (g == 2) POOL_RUN(8); else POOL_RUN(16);
#undef POOL_RUN
#pragma unroll
          for (int tl = 0; tl < 32; ++tl) Xw[tl * US + lane] = f2bf(pl[tl]); }
        LDS_WAIT(); asm volatile("" ::: "memory");
        f32x4 acc[2][4];
#pragma unroll
        for (int rt = 0; rt < 2; ++rt) { const bf16x8 a0 = *(const LAS bf16x8*)(Xw + (rt * 16 + lr) * US + lq * 8), a1 = *(const LAS bf16x8*)(Xw + (rt * 16 + lr) * US + 32 + lq * 8);
#pragma unroll
            for (int et = 0; et < 4; ++et) { acc[rt][et] = __builtin_amdgcn_mfma_f32_16x16x32_bf16(a0, bw[et][0], (f32x4){0.f, 0.f, 0.f, 0.f}, 0, 0, 0); acc[rt][et] = __builtin_amdgcn_mfma_f32_16x16x32_bf16(a1, bw[et][1], acc[rt][et], 0, 0, 0); } }
#pragma unroll
        for (int rt = 0; rt < 2; ++rt)
#pragma unroll
            for (int reg = 0; reg < 4; ++reg) { const int tl = rt * 16 + lq * 4 + reg; float s = 0.f;
#pragma unroll
                for (int et = 0; et < 4; ++et) { const float y = acc[rt][et][reg] * psc[et]; s += y * y; Uw[tl * 64 + et * 16 + lr] = f2bf(y); }
                s = row16_sum(s);
                if (lr == 0) SSQPOOL[(size_t)(t0 + tl) * 4 + g] = s; }
        LDS_WAIT(); asm volatile("" ::: "memory");
#pragma unroll
        for (int j = 0; j < 4; ++j) { const int id = lane + 64 * j, row = id >> 3, c8 = (id & 7) * 8;
            *(u32x4*)(YP + (size_t)(t0 + row) * 256 + g * 64 + c8) = *(const LAS u32x4*)(Uw + row * 64 + c8); }
        LDS_WAIT(); asm volatile("" ::: "memory");
    }
}

__device__ __forceinline__ void phase_lru_a(ArgsRef a, LAS unsigned char* lds, int layer, int wv) {
    const int tid = tid_from(wv), lane = tid & 63, wave = __builtin_amdgcn_readfirstlane(tid >> 6);
    const bf16* proj = (const bf16*)(a.ws + WS_PROJ);
    bf16* HL = (bf16*)(a.ws + WS_HL); bf16* PL = (bf16*)(a.ws + WS_PL);
    float* AGGH = (float*)(a.ws + WS_AGGH); float* AGGP = (float*)(a.ws + WS_AGGP);
    const int n = wave & 3, lr = lane & 15, lq = lane >> 4;
    constexpr int US = 72;
    LAS bf16* Uw = (LAS bf16*)(lds + wave * 13824);
    LAS bf16* Xw = (LAS bf16*)(lds + wave * 13824 + 5120);
    LAS bf16* Pw = (LAS bf16*)(lds + wave * 13824 + 9728);
    const int chl = n * 64 + lane;
    const float cw0 = a.in[I_CONVW][(layer * 4 + 0) * 256 + chl], cw1 = a.in[I_CONVW][(layer * 4 + 1) * 256 + chl], cw2 = a.in[I_CONVW][(layer * 4 + 2) * 256 + chl], cw3 = a.in[I_CONVW][(layer * 4 + 3) * 256 + chl];
    const float cb = a.in[I_CONVB][layer * 256 + chl];
    const bf16* wa = (const bf16*)(a.ws + WS_SMALL) + SM_WA + (size_t)(layer * 4 + n) * 4096;
    const bf16* wx = (const bf16*)(a.ws + WS_SMALL) + SM_WX + (size_t)(layer * 4 + n) * 4096;
    bf16x8 ba[4][2], bx[4][2]; float bav[4], bxv[4], sp[4];
#pragma unroll
    for (int et = 0; et < 4; ++et) {
#pragma unroll
        for (int ks = 0; ks < 2; ++ks) { const int wo = (et * 16 + lr) * 64 + ks * 32 + lq * 8; ba[et][ks] = *(const bf16x8*)(wa + wo); bx[et][ks] = *(const bf16x8*)(wx + wo); }
        const int chn = layer * 256 + n * 64 + et * 16 + lr; bav[et] = a.in[I_BA][chn]; bxv[et] = a.in[I_BX][chn]; sp[et] = log1pf(expf(-a.in[I_LAM][chn])); }
    __syncthreads();
    const int nstreams = gdim_here() * 2;
    u32x4 pre[5];
#define LRU_FETCH(CK) do { const int t0_ = (CK) * LRU_CH, s0_ = t0_ & (SEQ - 1); _Pragma("unroll") for (int j = 0; j < 5; ++j) { const int id = lane + 64 * j; const int row = id >> 3, c8 = (id & 7) * 8; \
            pre[j] = (u32x4){0u, 0u, 0u, 0u}; if (id < 35 * 8 && s0_ - 3 + row >= 0) pre[j] = __builtin_nontemporal_load((const u32x4*)(proj + (size_t)(t0_ - 3 + row) * NPJ + C_LRU + n * 64 + c8)); } } while (0)
    { const int ck0 = bid_here() * 2 + (wave >> 2); if (ck0 < NT / LRU_CH) LRU_FETCH(ck0); }
    for (int ck = bid_here() * 2 + (wave >> 2); ck < NT / LRU_CH; ck += nstreams) {
        const int t0 = ck * LRU_CH, s0 = t0 & (SEQ - 1);
#pragma unroll
        for (int j = 0; j < 5; ++j) { const int id = lane + 64 * j;
            if (id < 35 * 8) { const int row = id >> 3, c8 = (id & 7) * 8; *(LAS u32x4*)(Uw + row * US + c8) = pre[j]; } }
        if (ck + nstreams < NT / LRU_CH) LRU_FETCH(ck + nstreams);
        LDS_WAIT(); asm volatile("" ::: "memory");
        { float u[LRU_CH + 3];
#pragma unroll
          for (int r = 0; r < LRU_CH + 3; ++r) u[r] = bf2f(Uw[r * US + lane]);
#pragma unroll
          for (int tl = 0; tl < LRU_CH; ++tl) { const float xc = cb + cw0 * u[tl] + cw1 * u[tl + 1] + cw2 * u[tl + 2] + cw3 * u[tl + 3]; Xw[tl * US + lane] = f2bf(xc); } }
        LDS_WAIT(); asm volatile("" ::: "memory");
        f32x4 ca[2][4], cx[2][4];
#pragma unroll
        for (int rt = 0; rt < 2; ++rt) { const bf16x8 a0 = *(const LAS bf16x8*)(Xw + (rt * 16 + lr) * US + lq * 8), a1 = *(const LAS bf16x8*)(Xw + (rt * 16 + lr) * US + 32 + lq * 8);
#pragma unroll
            for (int et = 0; et < 4; ++et) { ca[rt][et] = __builtin_amdgcn_mfma_f32_16x16x32_bf16(a0, ba[et][0], (f32x4){0.f, 0.f, 0.f, 0.f}, 0, 0, 0); ca[rt][et] = __builtin_amdgcn_mfma_f32_16x16x32_bf16(a1, ba[et][1], ca[rt][et], 0, 0, 0);
                                              cx[rt][et] = __builtin_amdgcn_mfma_f32_16x16x32_bf16(a0, bx[et][0], (f32x4){0.f, 0.f, 0.f, 0.f}, 0, 0, 0); cx[rt][et] = __builtin_amdgcn_mfma_f32_16x16x32_bf16(a1, bx[et][1], cx[rt][et], 0, 0, 0); } }
        float xv[4][2][4];
#pragma unroll
        for (int et = 0; et < 4; ++et)
#pragma unroll
            for (int rt = 0; rt < 2; ++rt)
#pragma unroll
                for (int reg = 0; reg < 4; ++reg) xv[et][rt][reg] = bf2f(Xw[(rt * 16 + lq * 4 + reg) * US + et * 16 + lr]);
#pragma unroll
        for (int et = 0; et < 4; ++et) {
            float Pl[2][4], Hl[2][4], At[2], Ht[2];
#pragma unroll
            for (int rt = 0; rt < 2; ++rt) { float P = 1.f, H = 0.f;
#pragma unroll
                for (int reg = 0; reg < 4; ++reg) { const int tl = rt * 16 + lq * 4 + reg;
                    const float r = fast_sigmoid(ca[rt][et][reg] + bav[et]), ig = fast_sigmoid(cx[rt][et][reg] + bxv[et]);
                    const float log_a = -8.0f * r * sp[et]; const float av = fast_exp(log_a);
                    float mult = __builtin_amdgcn_sqrtf(fmaxf(1.0f - av * av, 0.f)); if (s0 + tl == 0) mult = 1.0f;
                    const float bv = mult * ig * xv[et][rt][reg];
                    H = av * H + bv; P *= av; Pl[rt][reg] = P; Hl[rt][reg] = H; }
                At[rt] = P; Ht[rt] = H; }
            float Ai[2], Hi[2];
#pragma unroll
            for (int rt = 0; rt < 2; ++rt) { float A = At[rt], H = Ht[rt];
                { const float Ap = rows_up16(A, lq), Hp = rows_up16(H, lq); if (lq >= 1) { H = A * Hp + H; A = A * Ap; } }
                { const float Ap = rows_up32(A), Hp = rows_up32(H); if (lq >= 2) { H = A * Hp + H; A = A * Ap; } }
                Ai[rt] = A; Hi[rt] = H; }
            float Ac[2], Hc[2];
#pragma unroll
            for (int rt = 0; rt < 2; ++rt) { const float Ap = rows_up16(Ai[rt], lq), Hp = rows_up16(Hi[rt], lq); Ac[rt] = (lq >= 1) ? Ap : 1.f; Hc[rt] = (lq >= 1) ? Hp : 0.f; }
            const float A0t = row3_bcast(Ai[0]), H0t = row3_bcast(Hi[0]);
            Hc[1] = Ac[1] * H0t + Hc[1]; Ac[1] = Ac[1] * A0t;
#pragma unroll
            for (int rt = 0; rt < 2; ++rt)
#pragma unroll
                for (int reg = 0; reg < 4; ++reg) { const int tl = rt * 16 + lq * 4 + reg;
                    Uw[tl * 64 + et * 16 + lr] = f2bf(Hl[rt][reg] + Pl[rt][reg] * Hc[rt]); Pw[tl * 64 + et * 16 + lr] = f2bf(Pl[rt][reg] * Ac[rt]); }
            if (lq == 3) { const size_t o = (size_t)ck * 256 + n * 64 + et * 16 + lr;
                AGGP[o] = Ai[1] * A0t; AGGH[o] = Ai[1] * H0t + Hi[1]; }
        }
        LDS_WAIT(); asm volatile("" ::: "memory");
#pragma unroll
        for (int j = 0; j < 4; ++j) { const int id = lane + 64 * j, row = id >> 3, c8 = (id & 7) * 8;
            *(u32x4*)(HL + (size_t)(t0 + row) * 256 + n * 64 + c8) = *(const LAS u32x4*)(Uw + row * 64 + c8);
            *(u32x4*)(PL + (size_t)(t0 + row) * 256 + n * 64 + c8) = *(const LAS u32x4*)(Pw + row * 64 + c8); }
        LDS_WAIT(); asm volatile("" ::: "memory");
    }
}
__device__ __forceinline__ void phase_lru_b(ArgsRef a, int wv) {
    const float* __restrict__ AGGH = (const float*)(a.ws + WS_AGGH); const float* __restrict__ AGGP = (const float*)(a.ws + WS_AGGP); float* __restrict__ CARRY = (float*)(a.ws + WS_CARRY);
    const int tid_ = tid_from(wv), seg = tid_ & 31;
    for (int ch = bid_here() * 16 + (tid_ >> 5); ch < NB * 256; ch += gdim_here() * 16) { const int b = ch >> 8, c = ch & 255;
        float pp[4], hh[4];
#pragma unroll
        for (int k = 0; k < 4; ++k) { const size_t o = (size_t)(b * LRU_NCH + seg * 4 + k) * 256 + c; pp[k] = AGGP[o]; hh[k] = AGGH[o]; }
        float A = 1.f, H = 0.f;
#pragma unroll
        for (int k = 0; k < 4; ++k) { H = pp[k] * H + hh[k]; A *= pp[k]; }
#pragma unroll
        for (int d = 1; d < 32; d <<= 1) { const float Ap = __shfl_up(A, d, 32), Hp = __shfl_up(H, d, 32); if (seg >= d) { H = A * Hp + H; A = A * Ap; } }
        float carry = __shfl_up(H, 1, 32); if (seg == 0) carry = 0.f;
#pragma unroll
        for (int k = 0; k < 4; ++k) { const size_t o = (size_t)(b * LRU_NCH + seg * 4 + k) * 256 + c; CARRY[o] = carry; carry = pp[k] * carry + hh[k]; } }
}
typedef short v4i16_t __attribute__((ext_vector_type(4)));
struct AttnUnit { int h, n, r, dl, g, first; size_t rowb; };
__device__ __forceinline__ AttnUnit attn_unit(int bh, int hf, int i) {
    AttnUnit u; u.h = bh & 7; u.rowb = (size_t)(bh >> 3) * SEQ;
    if (i < 16) { u.g = 0; u.dl = 1; u.r = 0; u.n = 16 * hf + i; u.first = (i == 0); }
    else if (i < 32) { const int j = i - 16; u.g = 1; u.dl = 4; u.r = 2 * hf + (j >> 3); u.n = j & 7; u.first = (u.n == 0); }
    else { const int j = i - 32; u.g = 2; u.dl = 16; u.r = 8 * hf + (j >> 1); u.n = j & 1; u.first = (u.n == 0); }
    return u;
}
__device__ __forceinline__ void attn_dma_chunk(const __amdgpu_buffer_rsrc_t rs, LAS unsigned char* lds, const AttnUnit& u, int chunk, int slot, int wave, int lane) {
    const int csc = (lane & 7) ^ ((lane >> 3) & 7);
#pragma unroll
    for (int q = 0; q < 2; ++q) { const int pc = wave + 8 * q, l = 128 * chunk + 8 * pc + (lane >> 3);
        const unsigned rowoff = ((unsigned)(u.rowb * 8 + u.h * SEQ) + (unsigned)(l * u.dl + u.r)) * 128u + (unsigned)(csc * 16);
        const unsigned srcK = rowoff + (unsigned)(NT * 512 * 2), srcV = rowoff + (unsigned)(NT * 512 * 4);
        LAS unsigned char* dst = lds + slot * 32768 + pc * 1024;
        __builtin_amdgcn_raw_ptr_buffer_load_lds(rs, (LAS void*)dst, 16, srcK, 0, 0, 0);
        __builtin_amdgcn_raw_ptr_buffer_load_lds(rs, (LAS void*)(dst + 16384), 16, srcV, 0, 0, 0); }
}
__device__ __forceinline__ void phase_attn(ArgsRef a, LAS unsigned char* lds, int wv) {
    const int tid = tid_from(wv), lane = tid & 63, wave = __builtin_amdgcn_readfirstlane(tid >> 6);
    const bf16* proj = (const bf16*)(a.ws + WS_HM);
    bf16* PNUM = (bf16*)(a.ws + WS_PNUM); float* PDEN = (float*)(a.ws + WS_PDEN); float* PMAX = (float*)(a.ws + WS_PMAX);
    const __amdgpu_buffer_rsrc_t rs = __builtin_amdgcn_make_buffer_rsrc((void*)proj, 0, 0x7fffffff, 0x00020000);
    const int lr = lane & 15, lq = lane >> 4, qi0 = 16 * wave, G = gdim_here();
    float zz_ = 0.f; asm volatile("" : "+v"(zz_));
    const int kc0 = ((0 + lq) ^ (lr & 7)) * 16, kc1 = ((4 + lq) ^ (lr & 7)) * 16;
    const int q4 = (lane & 15) >> 2, p4 = lane & 3, vsw = (4 * lq + q4) & 7;
    unsigned chv[4];
#pragma unroll
    for (int dt = 0; dt < 4; ++dt) chv[dt] = (unsigned)(((2 * dt + (p4 >> 1)) ^ vsw) * 16 + (p4 & 1) * 8);
    const bool xo = (G == 256);
    const int pair = xo ? ((int)(bid_here() & 7) * 16 + (int)(bid_here() >> 4)) : (int)(bid_here() >> 1), hf = xo ? (int)((bid_here() >> 3) & 1) : (int)(bid_here() & 1), npairs = G >> 1;
    __syncthreads();
    { unsigned z0 = 0u; asm volatile("" : "+v"(z0));
      for (int z = tid; z < RING_BYTES / 16; z += NTHR) ((LAS u32x4*)lds)[z] = (u32x4){z0, z0, z0, z0}; }
    __syncthreads();
    const int total = (pair < 128 && bid_here() < 2 * npairs) ? ((128 - pair + npairs - 1) / npairs) * 48 : 0;
    AttnUnit cu = attn_unit(pair < 128 ? pair : 0, hf, 0);
    const int off = (total > 0 && cu.n > 0) ? 1 : 0;
#define ATT_UNIT_AT(k) attn_unit(pair + ((k) / 48) * npairs, hf, (k) % 48)
#define ATT_QLOAD(U, Q0, Q1) do { const size_t qrow_ = (U).rowb * 8 + (size_t)(U).h * SEQ + (size_t)(128 * (U).n + qi0 + lr) * (U).dl + (U).r; \
        Q0 = *(const bf16x8*)(proj + qrow_ * 64 + lq * 8); Q1 = *(const bf16x8*)(proj + qrow_ * 64 + 32 + lq * 8); } while (0)
    bf16x8 qf0, qf1, nq0, nq1;
    if (total > 0) { if (off) attn_dma_chunk(rs, lds, cu, cu.n - 1, 0, wave, lane);
        attn_dma_chunk(rs, lds, cu, cu.n, off & 3, wave, lane); ATT_QLOAD(cu, qf0, qf1);
        if (total > 1) { const AttnUnit u1 = ATT_UNIT_AT(1); attn_dma_chunk(rs, lds, u1, u1.n, (1 + off) & 3, wave, lane); } }
    nq0 = qf0; nq1 = qf1;
    asm volatile("s_waitcnt vmcnt(0)" ::: "memory");
    int idx = 0;
    while (idx < total) {
        __builtin_amdgcn_s_barrier(); asm volatile("" ::: "memory");
        const int csc = (idx + off) & 3, csp = cu.first ? ((cu.n > 0) ? 0 : csc) : ((idx + off + 3) & 3);
        AttnUnit nu = cu;
        if (idx + 1 < total) { nu = ATT_UNIT_AT(idx + 1); ATT_QLOAD(nu, nq0, nq1); }
        if (idx + 2 < total) { const AttnUnit u2 = ATT_UNIT_AT(idx + 2); attn_dma_chunk(rs, lds, u2, u2.n, (idx + 2 + off) & 3, wave, lane); }
        ++idx;
        f32x4 scv[9];
        { bf16x8 kf[9][2];
#pragma unroll
          for (int t = 0; t < 9; ++t) { const int wt = wave + t; const LAS unsigned char* Kt = lds + ((wt >= 8) ? csc : csp) * 32768 + ((16 * wt) & 127) * 128 + lr * 128;
              kf[t][0] = *(const LAS bf16x8*)(Kt + kc0); kf[t][1] = *(const LAS bf16x8*)(Kt + kc1); }
          __builtin_amdgcn_sched_barrier(0);
#pragma unroll
          for (int t = 0; t < 9; ++t) scv[t] = __builtin_amdgcn_mfma_f32_16x16x32_bf16(kf[t][0], qf0, (f32x4){0.f, 0.f, 0.f, 0.f}, 0, 0, 0);
#pragma unroll
          for (int t = 0; t < 9; ++t) scv[t] = __builtin_amdgcn_mfma_f32_16x16x32_bf16(kf[t][1], qf1, scv[t], 0, 0, 0); }
#pragma unroll
        for (int reg = 0; reg < 4; ++reg) { if (4 * lq + reg < lr) scv[0][reg] = -1e30f; if (4 * lq + reg > lr) scv[8][reg] = -1e30f; }
        if (cu.n == 0) {
#pragma unroll
            for (int t = 0; t < 8; ++t)
#pragma unroll
                for (int reg = 0; reg < 4; ++reg) { if (qi0 + 16 * t + 4 * lq + reg < 128) scv[t][reg] = -1e30f; } }
        float mx = -1e30f;
#pragma unroll
        for (int t = 0; t < 9; ++t)
#pragma unroll
            for (int reg = 0; reg < 4; ++reg) mx = fmaxf(mx, scv[t][reg]);
        mx = xmax32(xmax16(mx));
#define ATT_EXP_PAIR(PI) do { _Pragma("unroll") for (int tt_ = 2 * (PI); tt_ < 2 * (PI) + 2 && tt_ < 9; ++tt_) _Pragma("unroll") for (int reg = 0; reg < 4; ++reg) scv[tt_][reg] = __builtin_amdgcn_exp2f(scv[tt_][reg] - mx); } while (0)
        ATT_EXP_PAIR(0);
        f32x4 oc[4], den = (f32x4){zz_, zz_, zz_, zz_};
        const bf16x8 ones = __builtin_bit_cast(bf16x8, (u32x4){0x3f803f80u, 0x3f803f80u, 0x3f803f80u, 0x3f803f80u});
#pragma unroll
        for (int dt = 0; dt < 4; ++dt) oc[dt] = (f32x4){zz_, zz_, zz_, zz_};
        v4i16_t rv[2][2][4];
#define ATT_VISSUE(PI, B) do { const int t0_ = 2 * (PI), t1_ = (2 * (PI) + 1 < 9) ? 2 * (PI) + 1 : 8; const int w0_ = wave + t0_, w1_ = wave + t1_; \
            const LAS unsigned char* V0_ = lds + ((w0_ >= 8) ? csc : csp) * 32768 + 16384 + (((16 * w0_) & 127) + 4 * lq + q4) * 128; \
            const LAS unsigned char* V1_ = lds + ((w1_ >= 8) ? csc : csp) * 32768 + 16384 + (((16 * w1_) & 127) + 4 * lq + q4) * 128; \
            const unsigned va0_ = (unsigned)(unsigned long)V0_, va1_ = (unsigned)(unsigned long)V1_; \
            _Pragma("unroll") for (int dt = 0; dt < 4; ++dt) { asm volatile("ds_read_b64_tr_b16 %0, %1" : "=&v"(rv[B][0][dt]) : "v"(va0_ + chv[dt]) : "memory"); asm volatile("ds_read_b64_tr_b16 %0, %1" : "=&v"(rv[B][1][dt]) : "v"(va1_ + chv[dt]) : "memory"); } } while (0)
        ATT_VISSUE(0, 0);
#pragma unroll
        for (int pi = 0; pi < 5; ++pi) { const int t0 = 2 * pi, t1 = (2 * pi + 1 < 9) ? 2 * pi + 1 : 8; const int B = pi & 1;
            u32x4 pw; pw.x = cvt_pk_bf16(scv[t0][0], scv[t0][1]); pw.y = cvt_pk_bf16(scv[t0][2], scv[t0][3]);
            if (2 * pi + 1 < 9) { pw.z = cvt_pk_bf16(scv[t1][0], scv[t1][1]); pw.w = cvt_pk_bf16(scv[t1][2], scv[t1][3]); } else { pw.z = 0u; pw.w = 0u; }
            const bf16x8 pf = __builtin_bit_cast(bf16x8, pw);
            if (pi < 4) { ATT_VISSUE(pi + 1, (pi + 1) & 1);
                asm volatile("s_waitcnt lgkmcnt(8)" : "+v"(rv[B][0][0]), "+v"(rv[B][0][1]), "+v"(rv[B][0][2]), "+v"(rv[B][0][3]), "+v"(rv[B][1][0]), "+v"(rv[B][1][1]), "+v"(rv[B][1][2]), "+v"(rv[B][1][3]) :: "memory"); }
            else asm volatile("s_waitcnt lgkmcnt(0)" : "+v"(rv[B][0][0]), "+v"(rv[B][0][1]), "+v"(rv[B][0][2]), "+v"(rv[B][0][3]), "+v"(rv[B][1][0]), "+v"(rv[B][1][1]), "+v"(rv[B][1][2]), "+v"(rv[B][1][3]) :: "memory");
#pragma unroll
            for (int dt = 0; dt < 4; ++dt) { const bf16x8 vf = (bf16x8){rv[B][0][dt][0], rv[B][0][dt][1], rv[B][0][dt][2], rv[B][0][dt][3], rv[B][1][dt][0], rv[B][1][dt][1], rv[B][1][dt][2], rv[B][1][dt][3]};
                oc[dt] = __builtin_amdgcn_mfma_f32_16x16x32_bf16(vf, pf, oc[dt], 0, 0, 0); }
            den = __builtin_amdgcn_mfma_f32_16x16x32_bf16(ones, pf, den, 0, 0, 0);
            if (pi < 4) { ATT_EXP_PAIR(pi + 1);
#pragma unroll
                for (int q = 0; q < 4; ++q) { __builtin_amdgcn_sched_group_barrier(0x8, 1, 0); __builtin_amdgcn_sched_group_barrier(0x2, 4, 0); }
                __builtin_amdgcn_sched_group_barrier(0x8, 1, 0); } }
#undef ATT_VISSUE
#undef ATT_EXP_PAIR
        asm volatile("s_waitcnt vmcnt(4)" ::: "memory");
        { LAS unsigned char* stg = lds + OST_OFF + wave * 2048;
#pragma unroll
          for (int dt = 0; dt < 4; ++dt) { u32x2 w; w.x = cvt_pk_bf16(oc[dt][0], oc[dt][1]); w.y = cvt_pk_bf16(oc[dt][2], oc[dt][3]);
              *(LAS u32x2*)(stg + lr * 128 + (((2 * dt + (lq >> 1)) ^ (lr & 7)) << 4) + (lq & 1) * 8) = w; }
          LDS_WAIT(); asm volatile("" ::: "memory");
#pragma unroll
          for (int i = 0; i < 2; ++i) { const int qq = i * 8 + (lane >> 3), c8 = lane & 7; const u32x4 w = *(const LAS u32x4*)(stg + qq * 128 + ((c8 ^ (qq & 7)) << 4));
              const size_t tok = cu.rowb + (size_t)(128 * cu.n + qi0 + qq) * cu.dl + cu.r;
              *(u32x4*)(PNUM + ((size_t)cu.g * NT + tok) * 512 + cu.h * 64 + c8 * 8) = w; }
          LDS_WAIT(); asm volatile("" ::: "memory"); }
        if (lq == 0) { const size_t tok = cu.rowb + (size_t)(128 * cu.n + qi0 + lr) * cu.dl + cu.r; PDEN[((size_t)cu.g * NT + tok) * 8 + cu.h] = den[0]; PMAX[((size_t)cu.g * NT + tok) * 8 + cu.h] = mx; }
        cu = nu; qf0 = nq0; qf1 = nq1;
    }
#undef ATT_UNIT_AT
#undef ATT_QLOAD
}
__device__ __forceinline__ void phase_finalize(ArgsRef a, int wv, const bool f8) {
    const int tid = tid_from(wv), lane = tid & 63, wave = tid >> 6;
    const int gw = bid_here() * NWAVES + wave, NGW = gdim_here() * NWAVES;
    const bf16* __restrict__ proj = (const bf16*)(a.ws + WS_PROJ); unsigned char* __restrict__ mix = a.ws + WS_MIX;
    bf16* __restrict__ mixb = (bf16*)(a.ws + WS_MIX);
    const bf16* __restrict__ YP = (const bf16*)(a.ws + WS_YP); const float* __restrict__ SSQPOOL = (const float*)(a.ws + WS_SSQPOOL);
    const bf16* __restrict__ HL = (const bf16*)(a.ws + WS_HL); const bf16* __restrict__ PL = (const bf16*)(a.ws + WS_PL); const float* __restrict__ CARRY = (const float*)(a.ws + WS_CARRY);
    const bf16* __restrict__ PNUM = (const bf16*)(a.ws + WS_PNUM); const float* __restrict__ PDEN = (const float*)(a.ws + WS_PDEN); const float* __restrict__ PMAX = (const float*)(a.ws + WS_PMAX);
    const int hd = lane >> 3;
    for (int t = gw; t < NT; t += NGW) {
        const u32x2 ypw = __builtin_nontemporal_load((const u32x2*)(YP + (size_t)t * 256 + lane * 4)); const f32x4 sq = *(const f32x4*)(SSQPOOL + (size_t)t * 4);
        const u32x2 hw = __builtin_nontemporal_load((const u32x2*)(HL + (size_t)t * 256 + lane * 4)), pw = __builtin_nontemporal_load((const u32x2*)(PL + (size_t)t * 256 + lane * 4)), gwd = __builtin_nontemporal_load((const u32x2*)(proj + (size_t)t * NPJ + C_GATE + lane * 4));
        const f32x4 cr = *(const f32x4*)(CARRY + (size_t)(t / LRU_CH) * 256 + lane * 4);
        float m[3], dn[3]; u32x4 nw[3];
#pragma unroll
        for (int g = 0; g < 3; ++g) { m[g] = PMAX[((size_t)g * NT + t) * 8 + hd]; dn[g] = PDEN[((size_t)g * NT + t) * 8 + hd]; nw[g] = __builtin_nontemporal_load((const u32x4*)(PNUM + ((size_t)g * NT + t) * 512 + lane * 8)); }
        { const float rs = __builtin_amdgcn_rsqf(((sq[0] + sq[1]) + (sq[2] + sq[3])) * (1.0f / 256.0f) + EPS);
          if (f8) { int o = __builtin_amdgcn_cvt_pk_fp8_f32(bflo(ypw.x) * rs, bfhi(ypw.x) * rs, 0, false); o = __builtin_amdgcn_cvt_pk_fp8_f32(bflo(ypw.y) * rs, bfhi(ypw.y) * rs, o, true);
              *(unsigned*)(mix + (size_t)t * DM + lane * 4) = (unsigned)o; }
          else { u32x2 o; o.x = cvt_pk_bf16(bflo(ypw.x) * rs, bfhi(ypw.x) * rs); o.y = cvt_pk_bf16(bflo(ypw.y) * rs, bfhi(ypw.y) * rs); *(u32x2*)(mixb + (size_t)t * DM + lane * 4) = o; } }
        { float h[4] = {bflo(hw.x) + bflo(pw.x) * cr[0], bfhi(hw.x) + bfhi(pw.x) * cr[1], bflo(hw.y) + bflo(pw.y) * cr[2], bfhi(hw.y) + bfhi(pw.y) * cr[3]};
          const float gt[4] = {bflo(gwd.x), bfhi(gwd.x), bflo(gwd.y), bfhi(gwd.y)};
          float s = 0.f;
#pragma unroll
          for (int j = 0; j < 4; ++j) { h[j] *= gelu_tanh(gt[j]); s += h[j] * h[j]; }
          s = wave_sum(s); const float rs = __builtin_amdgcn_rsqf(s * (1.0f / 256.0f) + EPS);
          if (f8) { int o = __builtin_amdgcn_cvt_pk_fp8_f32(h[0] * rs, h[1] * rs, 0, false); o = __builtin_amdgcn_cvt_pk_fp8_f32(h[2] * rs, h[3] * rs, o, true);
              *(unsigned*)(mix + (size_t)t * DM + 256 + lane * 4) = (unsigned)o; }
          else { u32x2 o; o.x = cvt_pk_bf16(h[0] * rs, h[1] * rs); o.y = cvt_pk_bf16(h[2] * rs, h[3] * rs); *(u32x2*)(mixb + (size_t)t * DM + 256 + lane * 4) = o; } }
        { const float mr = fmaxf(fmaxf(m[0], m[1]), m[2]);
          float o[8] = {0.f, 0.f, 0.f, 0.f, 0.f, 0.f, 0.f, 0.f}; float den = 0.f;
#pragma unroll
          for (int g = 0; g < 3; ++g) { const float wg = __builtin_amdgcn_exp2f(m[g] - mr); den += wg * dn[g];
              o[0] += wg * bflo(nw[g].x); o[1] += wg * bfhi(nw[g].x); o[2] += wg * bflo(nw[g].y); o[3] += wg * bfhi(nw[g].y); o[4] += wg * bflo(nw[g].z); o[5] += wg * bfhi(nw[g].z); o[6] += wg * bflo(nw[g].w); o[7] += wg * bfhi(nw[g].w); }
          const float inv = 1.0f / den; float s = 0.f;
#pragma unroll
          for (int j = 0; j < 8; ++j) { o[j] *= inv; s += o[j] * o[j]; }
          s = wave_sum(s); const float rs = __builtin_amdgcn_rsqf(s * (1.0f / 512.0f) + EPS);
          if (f8) { int w0 = __builtin_amdgcn_cvt_pk_fp8_f32(o[0] * rs, o[1] * rs, 0, false); w0 = __builtin_amdgcn_cvt_pk_fp8_f32(o[2] * rs, o[3] * rs, w0, true);
              int w1 = __builtin_amdgcn_cvt_pk_fp8_f32(o[4] * rs, o[5] * rs, 0, false); w1 = __builtin_amdgcn_cvt_pk_fp8_f32(o[6] * rs, o[7] * rs, w1, true);
              *(u32x2*)(mix + (size_t)t * DM + 512 + lane * 8) = (u32x2){(unsigned)w0, (unsigned)w1}; }
          else { u32x4 wv4; wv4.x = cvt_pk_bf16(o[0] * rs, o[1] * rs); wv4.y = cvt_pk_bf16(o[2] * rs, o[3] * rs); wv4.z = cvt_pk_bf16(o[4] * rs, o[5] * rs); wv4.w = cvt_pk_bf16(o[6] * rs, o[7] * rs);
              *(u32x4*)(mixb + (size_t)t * DM + 512 + lane * 8) = wv4; } }
    }
}

__device__ __forceinline__ void phase_router(ArgsRef a, LAS unsigned char* lds, int layer, int wv, bool alloc) {
    const int tid = tid_from(wv), lane = tid & 63, wave = __builtin_amdgcn_readfirstlane(tid >> 6);
    const bf16* xb = (const bf16*)(a.ws + WS_XB); const bf16* wr = (const bf16*)(a.ws + WS_SMALL) + SM_WR + (size_t)layer * NEXP * DM;
    const float* ssqp = (const float*)(a.ws + WS_SSQP); const float* rbias = a.in[I_BR] + layer * NEXP;
    int* LIST = (int*)(a.ws + WS_LIST); float* LRSTD = (float*)(a.ws + WS_LRSTD); float* LGATE = (float*)(a.ws + WS_LGATE2); int* TSEL = (int*)(a.ws + WS_TSEL);
    unsigned* cnt = (unsigned*)(a.ws + WS_CTL) + CW_CNT + layer * NEXP;
    float zr_ = 0.f; asm volatile("" : "+v"(zr_));
    LAS float* LG = (LAS float*)lds + wave * 32 * 33;
    LAS int* hist = (LAS int*)(lds + 65536);
    LAS int* base = (LAS int*)(lds + 65536 + 128);
    LAS float* rbl = (LAS float*)(lds + 65536 + 256);
    const int lr = lane & 15, lq = lane >> 4;
    for (int unit = bid_here(); unit < NT / 256; unit += gdim_here()) {
        const int tok0 = unit * 256 + wave * 32;
        __syncthreads();
        if (tid < 32) { hist[tid] = 0; rbl[tid] = rbias[tid]; }
        f32x4 acc[2][2];
#pragma unroll
        for (int rt = 0; rt < 2; ++rt)
#pragma unroll
            for (int et = 0; et < 2; ++et) acc[rt][et] = (f32x4){zr_, zr_, zr_, zr_};
#pragma unroll 1
        for (int k0 = 0; k0 < 32; k0 += 8) { bf16x8 af[8][2], bfr[8][2];
#pragma unroll
            for (int j = 0; j < 8; ++j) { const int ks = k0 + j;
#pragma unroll
                for (int rt = 0; rt < 2; ++rt) af[j][rt] = *(const bf16x8*)(xb + (size_t)(tok0 + rt * 16 + lr) * DM + ks * 32 + lq * 8);
#pragma unroll
                for (int et = 0; et < 2; ++et) bfr[j][et] = *(const bf16x8*)(wr + (size_t)(et * 16 + lr) * DM + ks * 32 + lq * 8); }
            __builtin_amdgcn_sched_barrier(0);
#pragma unroll
            for (int j = 0; j < 8; ++j)
#pragma unroll
                for (int rt = 0; rt < 2; ++rt)
#pragma unroll
                    for (int et = 0; et < 2; ++et) acc[rt][et] = __builtin_amdgcn_mfma_f32_16x16x32_bf16(af[j][rt], bfr[j][et], acc[rt][et], 0, 0, 0); }
#pragma unroll
        for (int rt = 0; rt < 2; ++rt)
#pragma unroll
            for (int et = 0; et < 2; ++et)
#pragma unroll
                for (int reg = 0; reg < 4; ++reg) LG[(rt * 16 + lq * 4 + reg) * 33 + et * 16 + lr] = acc[rt][et][reg];
        __syncthreads();
        int te[4] = {0, 0, 0, 0}; float tg[4] = {0.f, 0.f, 0.f, 0.f}; int rk[4] = {0, 0, 0, 0}; float rstd = 0.f; const int tok = tok0 + lane;
        if (lane < 32) {
            const float* sp = ssqp + (size_t)tok * 16; float ss = 0.f;
#pragma unroll
            for (int j = 0; j < 16; ++j) ss += sp[j];
            rstd = __builtin_amdgcn_rsqf(ss * (1.0f / DM) + EPS);
            float tv[4] = {-3e38f, -3e38f, -3e38f, -3e38f};
            for (int e = 0; e < NEXP; ++e) { float v = LG[lane * 33 + e] * rstd + rbl[e]; int ve = e;
#pragma unroll
                for (int k = 0; k < 4; ++k) { if (v > tv[k]) { const float tvv = tv[k]; const int tee = te[k]; tv[k] = v; te[k] = ve; v = tvv; ve = tee; } } }
            float z = 0.f;
#pragma unroll
            for (int k = 0; k < 4; ++k) { tg[k] = fast_exp(tv[k] - tv[0]); z += tg[k]; }
            const float iz = 1.0f / z;
#pragma unroll
            for (int k = 0; k < 4; ++k) { tg[k] *= iz; rk[k] = __hip_atomic_fetch_add(&hist[te[k]], 1, __ATOMIC_RELAXED, __HIP_MEMORY_SCOPE_WORKGROUP); }
        }
        __syncthreads();
        if (tid < 32) base[tid] = alloc ? (int)__hip_atomic_fetch_add(cnt + tid, (unsigned)hist[tid], RLX_AGENT) : 0;
        __syncthreads();
        if (lane < 32 && alloc) {
#pragma unroll
            for (int k = 0; k < 4; ++k) { const size_t p = (size_t)te[k] * NT + base[te[k]] + rk[k]; LIST[p] = tok * 4 + k; LRSTD[p] = rstd; LGATE[p] = tg[k]; TSEL[tok * 4 + k] = (te[k] << 16) | (base[te[k]] + rk[k]); }
        }
    }
}

__device__ __forceinline__ void phase_combine(ArgsRef a, bool last_layer, int wv, bool dry, const unsigned* cnt) {
    const int tid = tid_from(wv), lane = tid & 63, wave = tid >> 6;
    const int gw = bid_here() * NWAVES + wave, NGW = gdim_here() * NWAVES;
    const unsigned char* __restrict__ Y = (const unsigned char*)(a.ws + WS_Y); float* __restrict__ out = a.out; bf16* xb = (bf16*)(a.ws + WS_XB); float* __restrict__ ssq = (float*)(a.ws + WS_SSQ);
    const u32x4* __restrict__ TSEL = (const u32x4*)(a.ws + WS_TSEL); unsigned char* __restrict__ xa8 = a.ws + WS_XB8;
    typedef float f2v __attribute__((ext_vector_type(2)));
    int bpl; { int nb = (lane < NEXP) ? (int)((__hip_atomic_load(cnt + (lane & 31), RLX_AGENT) + 255u) >> 8) : 0; int incl = nb;
#pragma unroll
        for (int d = 1; d < 32; d <<= 1) { const int v = __shfl_up(incl, d, 64); if (lane >= d) incl += v; }
        bpl = (incl - nb) * 256; }
    u32x4 sel = TSEL[gw < NT ? gw : 0];
    for (int t = gw; t < NT; t += NGW) {
        const u32x4 x0 = __builtin_nontemporal_load((const u32x4*)(xb + (size_t)t * DM) + 2 * lane), x1 = __builtin_nontemporal_load((const u32x4*)(xb + (size_t)t * DM) + 2 * lane + 1);
        u32x4 y[4];
#pragma unroll
        for (int k = 0; k < 4; ++k) { const int e = (int)(sel[k] >> 16), pos = (int)(sel[k] & 0xffffu); const int slot = __builtin_amdgcn_readlane(bpl, __builtin_amdgcn_readfirstlane(e)) + pos;
            y[k] = __builtin_nontemporal_load((const u32x4*)(Y + (size_t)slot * DM) + lane); }
        if (t + NGW < NT) sel = TSEL[t + NGW];
        float v[16];
        v[0] = bflo(x0.x); v[1] = bfhi(x0.x); v[2] = bflo(x0.y); v[3] = bfhi(x0.y); v[4] = bflo(x0.z); v[5] = bfhi(x0.z); v[6] = bflo(x0.w); v[7] = bfhi(x0.w);
        v[8] = bflo(x1.x); v[9] = bfhi(x1.x); v[10] = bflo(x1.y); v[11] = bfhi(x1.y); v[12] = bflo(x1.z); v[13] = bfhi(x1.z); v[14] = bflo(x1.w); v[15] = bfhi(x1.w);
#pragma unroll
        for (int k = 0; k < 4; ++k)
#pragma unroll
            for (int d = 0; d < 4; ++d) { const int w = (int)y[k][d]; const f2v lo = __builtin_amdgcn_cvt_pk_f32_fp8(w, false), hi = __builtin_amdgcn_cvt_pk_f32_fp8(w, true);
                v[4 * d + 0] += lo.x * (1.0f / Y8_SCALE); v[4 * d + 1] += lo.y * (1.0f / Y8_SCALE); v[4 * d + 2] += hi.x * (1.0f / Y8_SCALE); v[4 * d + 3] += hi.y * (1.0f / Y8_SCALE); }
        float s = 0.f;
#pragma unroll
        for (int j = 0; j < 16; ++j) s += v[j] * v[j];
        if (dry && s != 12345.678f) continue;
        if (last_layer) {
#pragma unroll
            for (int j = 0; j < 4; ++j) *((f32x4*)(out + (size_t)t * DM) + 4 * lane + j) = (f32x4){v[4 * j], v[4 * j + 1], v[4 * j + 2], v[4 * j + 3]};
        } else { s = wave_sum(s);
            u32x4 w0, w1; w0.x = cvt_pk_bf16(v[0], v[1]); w0.y = cvt_pk_bf16(v[2], v[3]); w0.z = cvt_pk_bf16(v[4], v[5]); w0.w = cvt_pk_bf16(v[6], v[7]);
            w1.x = cvt_pk_bf16(v[8], v[9]); w1.y = cvt_pk_bf16(v[10], v[11]); w1.z = cvt_pk_bf16(v[12], v[13]); w1.w = cvt_pk_bf16(v[14], v[15]);
            *((u32x4*)(xb + (size_t)t * DM) + 2 * lane) = w0; *((u32x4*)(xb + (size_t)t * DM) + 2 * lane + 1) = w1;
            u32x4 w8;
#pragma unroll
            for (int d = 0; d < 4; ++d) { int f = __builtin_amdgcn_cvt_pk_fp8_f32(v[4 * d], v[4 * d + 1], 0, false); f = __builtin_amdgcn_cvt_pk_fp8_f32(v[4 * d + 2], v[4 * d + 3], f, true); w8[d] = (unsigned)f; }
            *((u32x4*)(xa8 + (size_t)t * DM) + lane) = w8;
            if (lane == 0) ssq[t] = s; }
    }
}

constexpr int NPH_LAYER = 13, NPH = 1 + 2 * NPH_LAYER;
enum { PH_GEMM_IN = 0, PH_QKPREP, PH_POOL, PH_LRU_A, PH_LRU_B, PH_ATTN, PH_LRU_C, PH_MERGE, PH_GEMM_OUT, PH_ROUTER, PH_MOE_GU, PH_MOE_DOWN, PH_COMBINE };
#ifndef MK_STOP
#define MK_STOP NPH
#endif
#ifndef MK_STAG_OUT
#define MK_STAG_OUT 0
#endif
#ifndef MK_SPLIT
#define MK_SPLIT 0
#endif

template <int PHMASK>
__global__ void __launch_bounds__(NTHR, 2) mega_fwd(Args args_by_value) {
    extern __shared__ __attribute__((aligned(16))) unsigned char lds_raw[];
    LAS unsigned char* lds = (LAS unsigned char*)lds_raw;
    const int tid = threadIdx.x;
    int wv = __builtin_amdgcn_readfirstlane(tid >> 6); asm volatile("" : "+s"(wv));
    for (int u = tid; u < (LDS_BYTES - LDSCTL_OFF) / 4; u += NTHR) ((LAS unsigned*)(lds + LDSCTL_OFF))[u] = 0u;
    __syncthreads();
#define ARGS_HERE() const CAS Args* ap_ = (const CAS Args*)__builtin_amdgcn_kernarg_segment_ptr(); asm volatile("" : "+s"(ap_)); ArgsRef args = *ap_; unsigned char* const ws = args.ws; unsigned* const ctl = (unsigned*)(ws + WS_CTL); (void)ctl
    int lo, hi;
    { ARGS_HERE(); lo = args.ph_lo; hi = args.ph_hi; xcd_barrier_post(ctl + CW_BAR + args.li * XCD_BAR_WORDS, (volatile LAS unsigned*)(lds + MISC_OFF) + 8); }
#define EN(p) (((PHMASK) >> (p)) & 1)
#ifndef MK_DUP
#define MK_DUP 0
#endif
#define NREP(p) ((((MK_DUP) >> (p)) & 1) ? 2 : 1)
#define IN(k) (lo <= (k) && (k) < hi)
#define SEAM(k) do { if (IN(k) && IN((k) + 1)) { ARGS_HERE(); XcdBarrier bar_; bar_.bar = ctl + CW_BAR + args.li * XCD_BAR_WORDS; bar_.x = xb_xcc_id(); bar_.st = (volatile LAS unsigned*)(lds + MISC_OFF) + 8; xcd_barrier(bar_); } } while (0)

    if (EN(13) && IN(0)) { ARGS_HERE(); for (int rep_ = 0; rep_ < NREP(13); ++rep_) { phase_prologue(args, lds, wv); } }
    SEAM(0);
    for (int l = 0; l < 2; ++l) {
        const int pb = 1 + NPH_LAYER * l;
        if (EN(PH_GEMM_IN) && IN(pb + PH_GEMM_IN)) { ARGS_HERE();
            if (l == 0) { pg8::StaticOrder S; S.init(NT, NIN, DM, gdim_here(), bid_here()); S.dup = NREP(PH_GEMM_IN) - 1;
                EpiIn E{(bf16*)(ws + WS_PROJ), (bf16*)(ws + WS_HM), (const float*)(ws + WS_SSQ), args.in[I_QG], args.in[I_KG], (const float*)(ws + WS_ROPE), (const float*)(ws + WS_ROPE) + SEQ * 32, lds + OST_OFF, 1.0f};
                pg8::gemm_phase<EpiIn, pg8::StaticOrder, true>(lds, (const bf16*)(ws + WS_XB), (const bf16*)(ws + WS_WIN), DM, S, E, wv); }
            else { pg8::StaticOrder S; S.init(NT, NIN, DM / 2, gdim_here(), bid_here()); S.dup = 0;
                EpiIn E{(bf16*)(ws + WS_PROJ), (bf16*)(ws + WS_HM), (const float*)(ws + WS_SSQ), args.in[I_QG] + 64, args.in[I_KG] + 64, (const float*)(ws + WS_ROPE), (const float*)(ws + WS_ROPE) + SEQ * 32, lds + OST_OFF, 1.0f / WIN8_SCALE};
                pg8::gemm_phase<EpiIn, pg8::StaticOrder, true, true>(lds, (const bf16*)(ws + WS_XB8), (const bf16*)(ws + WS_WIN) + (size_t)NIN * DM, DM / 2, S, E, wv); }
        }
        SEAM(pb + PH_GEMM_IN);
        if (EN(PH_POOL) && IN(pb + PH_POOL)) { ARGS_HERE(); for (int rep_ = 0; rep_ < NREP(PH_POOL); ++rep_) { phase_pool(args, lds, l, wv); } }
        if (EN(PH_LRU_A) && IN(pb + PH_LRU_A)) { ARGS_HERE(); for (int rep_ = 0; rep_ < NREP(PH_LRU_A); ++rep_) { phase_lru_a(args, lds, l, wv); } }
        SEAM(pb + PH_LRU_A);
        if (EN(PH_LRU_B) && IN(pb + PH_LRU_B)) { ARGS_HERE(); for (int rep_ = 0; rep_ < NREP(PH_LRU_B); ++rep_) { phase_lru_b(args, wv); } }
        if (EN(PH_ATTN) && IN(pb + PH_ATTN)) { ARGS_HERE(); for (int rep_ = 0; rep_ < NREP(PH_ATTN); ++rep_) { phase_attn(args, lds, wv); } }
        SEAM(pb + PH_ATTN);
        if (EN(PH_LRU_C) && IN(pb + PH_LRU_C)) { ARGS_HERE(); for (int rep_ = 0; rep_ < NREP(PH_LRU_C); ++rep_) { phase_finalize(args, wv, l == 1); } }
        SEAM(pb + PH_MERGE);
        if (EN(PH_GEMM_OUT) && IN(pb + PH_GEMM_OUT)) { ARGS_HERE();
            __syncthreads();
            if (l == 0) { pg8::StaticOrder S; S.init(NT, DM, DM, gdim_here(), bid_here()); S.dup = NREP(PH_GEMM_OUT) - 1;
                EpiOut E{(bf16*)(ws + WS_XB), (float*)(ws + WS_SSQP), (unsigned char*)(ws + WS_XB8), 1.0f};
                pg8::gemm_phase<EpiOut, pg8::StaticOrder, true>(lds, (const bf16*)(ws + WS_MIX), (const bf16*)(ws + WS_WOUT), DM, S, E, wv, MK_STAG_OUT); }
            else { pg8::StaticOrder S; S.init(NT, DM, DM / 2, gdim_here(), bid_here()); S.dup = 0;
                EpiOut E{(bf16*)(ws + WS_XB), (float*)(ws + WS_SSQP), (unsigned char*)(ws + WS_XB8), 1.0f / WOUT8_SCALE};
                pg8::gemm_phase<EpiOut, pg8::StaticOrder, true, true>(lds, (const bf16*)(ws + WS_MIX), (const bf16*)(ws + WS_WOUT) + (size_t)DM * DM, DM / 2, S, E, wv, MK_STAG_OUT); }
        }
        SEAM(pb + PH_GEMM_OUT);
        if (EN(PH_ROUTER) && IN(pb + PH_ROUTER)) { ARGS_HERE(); for (int rep_ = 0; rep_ < NREP(PH_ROUTER); ++rep_) { phase_router(args, lds, l, wv, rep_ == NREP(PH_ROUTER) - 1); } }
        SEAM(pb + PH_ROUTER);
        if (EN(PH_MOE_GU) && IN(pb + PH_MOE_GU)) { ARGS_HERE();
            LAS int* tab = (LAS int*)(lds + TAB_OFF);
            moe_tables(tab, ctl + CW_CNT + l * NEXP, wv);
            MoeOrder<2> S{tab, 2, gdim_here(), bid_here(), (const int*)(ws + WS_LIST), NREP(PH_MOE_GU) - 1};
            EpiGU E{(unsigned char*)(ws + WS_ACT), (const float*)(ws + WS_LRSTD), args.in[I_BGU] + (size_t)l * NEXP * 512};
            pg8::gemm_phase<EpiGU, MoeOrder<2>, true, true>(lds, (const bf16*)(ws + WS_XB8), (const bf16*)(ws + WS_WGU + (size_t)l * NEXP * 512 * DM), DM / 2, S, E, wv);
        }
        SEAM(pb + PH_MOE_GU);
        if (EN(PH_MOE_DOWN) && IN(pb + PH_MOE_DOWN)) { ARGS_HERE();
            LAS int* tab = (LAS int*)(lds + TAB_OFF);
            moe_tables(tab, ctl + CW_CNT + l * NEXP, wv);
            MoeOrder<3> S{tab, 4, gdim_here(), bid_here(), (const int*)(ws + WS_LIST), NREP(PH_MOE_DOWN) - 1};
            EpiDown E{(unsigned char*)(ws + WS_Y), (const int*)(ws + WS_LIST), (const float*)(ws + WS_LGATE2), args.in[I_BD] + (size_t)l * NEXP * DM, tab};
            pg8::gemm_phase<EpiDown, MoeOrder<3>, true, true>(lds, (const bf16*)(ws + WS_ACT), (const bf16*)(ws + WS_WD + (size_t)l * NEXP * DM * EFF), EFF / 2, S, E, wv);
        }
        SEAM(pb + PH_MOE_DOWN);
        if (EN(PH_COMBINE) && IN(pb + PH_COMBINE)) { ARGS_HERE(); for (int rep_ = 0; rep_ < NREP(PH_COMBINE); ++rep_) { phase_combine(args, l == 1, wv, rep_ < NREP(PH_COMBINE) - 1, ctl + CW_CNT + l * NEXP); } }
        SEAM(pb + PH_COMBINE);
    }
#undef IN
#undef SEAM
}

typedef void (*kern_t)(Args);
template <int M> static kern_t kern_of() { return (kern_t)mega_fwd<M>; }
static kern_t phase_kernel(int p) {
    switch (p) { case 0: return kern_of<1 << 0>(); case 1: return kern_of<1 << 1>(); case 2: return kern_of<1 << 2>(); case 3: return kern_of<1 << 3>(); case 4: return kern_of<1 << 4>();
                 case 5: return kern_of<1 << 5>(); case 6: return kern_of<1 << 6>(); case 7: return kern_of<1 << 7>(); case 8: return kern_of<1 << 8>(); case 9: return kern_of<1 << 9>();
                 case 10: return kern_of<1 << 10>(); case 11: return kern_of<1 << 11>(); case 12: return kern_of<1 << 12>(); default: return kern_of<1 << 13>(); }
}
extern "C" void kernel_launch(void* const* d_in, const int* in_sizes, int n_in, void* d_out, int out_size, void* d_ws, size_t ws_size, hipStream_t stream) {
    static int grid = 0;
    if (grid == 0) {
        if (n_in != 23 || in_sizes[0] != NT * DM || out_size != NT * DM || ws_size < WS_END) {
            fprintf(stderr, "kernel_launch: built for 23 inputs, x/out of %d floats, >= %zu bytes of workspace; got n_in %d, in0 %d, out %d, ws %zu; nothing launched\n", NT * DM, (size_t)WS_END, n_in, n_in > 0 ? in_sizes[0] : -1, out_size, ws_size);
            grid = -1; return; }
        int dev = 0, cus = 0;
        if (hipGetDevice(&dev) != hipSuccess || hipDeviceGetAttribute(&cus, hipDeviceAttributeMultiprocessorCount, dev) != hipSuccess) { fprintf(stderr, "kernel_launch: device query failed\n"); grid = -1; return; }
#if MK_SPLIT
        for (int p = 0; p < 14; ++p) if (hipFuncSetAttribute((const void*)phase_kernel(p), hipFuncAttributeMaxDynamicSharedMemorySize, LDS_BYTES) != hipSuccess) { fprintf(stderr, "kernel_launch: hipFuncSetAttribute failed\n"); grid = -1; return; }
#else
        if (hipFuncSetAttribute((const void*)kern_of<0x3fff>(), hipFuncAttributeMaxDynamicSharedMemorySize, LDS_BYTES) != hipSuccess) { fprintf(stderr, "kernel_launch: hipFuncSetAttribute failed\n"); grid = -1; return; }
        int per_cu = 0;
        if (hipOccupancyMaxActiveBlocksPerMultiprocessor(&per_cu, (const void*)kern_of<0x3fff>(), NTHR, LDS_BYTES) != hipSuccess || per_cu < 1)
            fprintf(stderr, "kernel_launch: note: occupancy query reports %d workgroups per CU\n", per_cu);
#endif
        (void)hipGetLastError();
        if (cus != 256) { fprintf(stderr, "kernel_launch: this kernel's unit maps are built for a 256-CU device (one workgroup per CU); found %d CUs; nothing launched\n", cus); grid = -1; return; }
        grid = cus;
    }
    if (grid < 0) return;
    if (hipMemsetAsync((char*)d_ws + WS_CTL, 0, CTL_ZERO_BYTES, stream) != hipSuccess) { fprintf(stderr, "kernel_launch: hipMemsetAsync failed\n"); return; }
    Args a{};
    for (int i = 0; i < 23; ++i) a.in[i] = (const float*)d_in[i];
    a.out = (float*)d_out; a.ws = (unsigned char*)d_ws; a.pad = 0;
#if MK_SPLIT
#ifdef MK_SKIP
    (void)hipMemsetAsync((char*)d_ws + WS_MIX, 0, (size_t)NT * DM * 2, stream);
#endif
    for (int p = 0; p < MK_STOP; ++p) { a.ph_lo = p; a.ph_hi = p + 1; a.li = p;
#ifdef MK_SKIP
        if (p >= 1 && (((MK_SKIP) >> ((p - 1) % NPH_LAYER)) & 1)) continue;
#endif
        hipLaunchKernelGGL(phase_kernel(p == 0 ? 13 : (p - 1) % NPH_LAYER), dim3(grid), dim3(NTHR), LDS_BYTES, stream, a); }
#else
    a.ph_lo = 0; a.ph_hi = NPH; a.li = 0;
    hipLaunchKernelGGL(kern_of<0x3fff>(), dim3(grid), dim3(NTHR), LDS_BYTES, stream, a);
#endif
    const hipError_t le = hipPeekAtLastError();
    if (le != hipSuccess) fprintf(stderr, "kernel_launch: launch failed: %s\n", hipGetErrorName(le));
}
```

```cpp
#include <hip/hip_runtime.h>
#include <cstdio>
#include <cstdint>

#define LAS __attribute__((address_space(3)))
#define GAS __attribute__((address_space(1)))
typedef unsigned short bf16;
typedef short bf16x8 __attribute__((ext_vector_type(8)));
typedef float f32x4 __attribute__((ext_vector_type(4)));
typedef float f32x2 __attribute__((ext_vector_type(2)));
typedef unsigned u32x4 __attribute__((ext_vector_type(4)));
typedef unsigned u32x2 __attribute__((ext_vector_type(2)));

#ifndef MK_VAR
#define MK_VAR 0
#endif
constexpr int NB = 16, SEQ = 4096, DM = 1024, NT = NB * SEQ;
constexpr int NIN = 2304;
constexpr int NPJ = 768;
constexpr int C_POOL = 0, C_LRU = 256, C_GATE = 512, C_Q = 768, C_K = 1280, C_V = 1792;
constexpr int NEXP = 32, TOPK = 4, EFF = 256;
constexpr int NASSIGN = NT * TOPK;
constexpr int ACT_ROWS = NASSIGN + NEXP * 256;
constexpr float EPS = 1e-6f;
constexpr int NWAVES = 8, NTHR = 512;
constexpr int LRU_CH = 32, LRU_NCH = SEQ / LRU_CH;

constexpr size_t MiB = 1u << 20;
constexpr size_t WS_CTL = 0, CTL_ZERO_BYTES = 1 * MiB;
constexpr size_t WS_ROPE = 1 * MiB;
constexpr size_t WS_SMALL = 2 * MiB;
constexpr size_t WS_WIN = 4 * MiB;
constexpr size_t WS_WOUT = 13 * MiB;
constexpr size_t WS_WGU = 17 * MiB;
constexpr size_t WS_WD = 81 * MiB;
constexpr size_t WS_SSQ = 113 * MiB;
constexpr size_t WS_SSQP = 114 * MiB;
constexpr size_t WS_LIST = 118 * MiB;
constexpr size_t WS_XB = 128 * MiB;
constexpr size_t WS_R = 256 * MiB;
constexpr size_t WS_PROJ = WS_R;
constexpr size_t WS_HM = WS_R + 96 * MiB;
constexpr size_t WS_MIX = WS_R + 288 * MiB;
constexpr size_t WS_PNUM = WS_R + 416 * MiB;
constexpr size_t WS_PDEN = WS_R + 608 * MiB;
constexpr size_t WS_PMAX = WS_R + 614 * MiB;
constexpr size_t WS_HL = WS_R + 620 * MiB;
constexpr size_t WS_PL = WS_R + 652 * MiB;
constexpr size_t WS_AGGH = WS_R + 684 * MiB;
constexpr size_t WS_AGGP = WS_R + 686 * MiB;
constexpr size_t WS_CARRY = WS_R + 688 * MiB;
constexpr size_t WS_YP = WS_R + 690 * MiB;
constexpr size_t WS_SSQPOOL = WS_R + 722 * MiB;
constexpr size_t WS_ACT = WS_R;
constexpr size_t WS_Y = WS_R + 132 * MiB;
constexpr size_t WS_XB8 = WS_R + 420 * MiB;
constexpr size_t WS_LRSTD = WS_R + 644 * MiB;
constexpr size_t WS_LGATE2 = WS_R + 652 * MiB;
constexpr size_t WS_TSEL = WS_R + 660 * MiB;
constexpr size_t WS_END = 1024 * MiB;
static_assert(WS_CARRY + 2 * MiB <= WS_END && WS_LGATE2 + 8 * MiB <= WS_END, "d_ws map");
constexpr size_t SM_POOLW = 0;
constexpr size_t SM_WA = 32768;
constexpr size_t SM_WX = 65536;
constexpr size_t SM_WR = 98304;
constexpr int CW_BAR = 4096;
constexpr int CW_CNT = 1024;

constexpr int RING_BYTES = 131072;
constexpr int LDSCTL_OFF = RING_BYTES;
constexpr int MISC_OFF = LDSCTL_OFF + 320;
constexpr int TAB_OFF = LDSCTL_OFF + 1024;
constexpr int OST_OFF = RING_BYTES + 8192;
constexpr int LDS_BYTES = 163840;

typedef GAS unsigned gu32;
#define RLX_AGENT __ATOMIC_RELAXED, __HIP_MEMORY_SCOPE_AGENT
#define LDS_WAIT() asm volatile("s_waitcnt lgkmcnt(0)" ::: "memory")
#define VM_WAIT() asm volatile("s_waitcnt vmcnt(0)" ::: "memory")
typedef __bf16 bf16x2_t __attribute__((ext_vector_type(2)));
__device__ __forceinline__ unsigned cvt_pk_bf16(float lo, float hi) { const f32x2 v = {lo, hi}; const bf16x2_t b = __builtin_convertvector(v, bf16x2_t); return __builtin_bit_cast(unsigned, b); }
__device__ __forceinline__ float bflo(unsigned w) { return __uint_as_float(w << 16); }
__device__ __forceinline__ float bfhi(unsigned w) { return __uint_as_float(w & 0xffff0000u); }
__device__ __forceinline__ float bf2f(bf16 h) { return __uint_as_float((unsigned)h << 16); }
__device__ __forceinline__ bf16 f2bf(float f) { return (bf16)(cvt_pk_bf16(f, 0.f) & 0xffffu); }
__device__ __forceinline__ float xsum16(float x) { const u32x2 r = __builtin_amdgcn_permlane16_swap(__float_as_uint(x), __float_as_uint(x), false, false); return __uint_as_float(r.x) + __uint_as_float(r.y); }
__device__ __forceinline__ float xsum32(float x) { const u32x2 r = __builtin_amdgcn_permlane32_swap(__float_as_uint(x), __float_as_uint(x), false, false); return __uint_as_float(r.x) + __uint_as_float(r.y); }
__device__ __forceinline__ float xmax16(float x) { const u32x2 r = __builtin_amdgcn_permlane16_swap(__float_as_uint(x), __float_as_uint(x), false, false); return fmaxf(__uint_as_float(r.x), __uint_as_float(r.y)); }
__device__ __forceinline__ float xmax32(float x) { const u32x2 r = __builtin_amdgcn_permlane32_swap(__float_as_uint(x), __float_as_uint(x), false, false); return fmaxf(__uint_as_float(r.x), __uint_as_float(r.y)); }
#define DPP_ROR_F(x, n) __int_as_float(__builtin_amdgcn_update_dpp(0, __float_as_int(x), 0x120 + (n), 0xf, 0xf, true))
__device__ __forceinline__ float row16_sum(float v) { v += DPP_ROR_F(v, 8); v += DPP_ROR_F(v, 4); v += DPP_ROR_F(v, 2); v += DPP_ROR_F(v, 1); return v; }
__device__ __forceinline__ float wave_sum(float v) { return xsum32(xsum16(row16_sum(v))); }
__device__ __forceinline__ float rows_up16(float x, int row) { const unsigned u = __float_as_uint(x); const u32x2 p = __builtin_amdgcn_permlane16_swap(u, u, false, false);
    const u32x2 q = __builtin_amdgcn_permlane32_swap(p.y, p.y, false, false); return __uint_as_float(row == 2 ? q.x : p.x); }
__device__ __forceinline__ float rows_up32(float x) { const unsigned u = __float_as_uint(x); const u32x2 p = __builtin_amdgcn_permlane32_swap(u, u, false, false); return __uint_as_float(p.x); }
__device__ __forceinline__ float row3_bcast(float x) { const unsigned u = __float_as_uint(x); const u32x2 p = __builtin_amdgcn_permlane16_swap(u, u, false, false);
    const u32x2 q = __builtin_amdgcn_permlane32_swap(p.y, p.y, false, false); return __uint_as_float(q.y); }
__device__ __forceinline__ float fast_sigmoid(float x) { return __builtin_amdgcn_rcpf(1.0f + __builtin_amdgcn_exp2f(-1.4426950408889634f * x)); }
__device__ __forceinline__ float fast_exp(float x) { return __builtin_amdgcn_exp2f(1.4426950408889634f * x); }
__device__ __forceinline__ float gelu_tanh(float x) {
    const float u = 0.7978845608028654f * (x + 0.044715f * x * x * x);
    return x * fast_sigmoid(2.0f * u);
}
__device__ __forceinline__ int bid_here() { int b = (int)blockIdx.x; asm volatile("" : "+s"(b)); return b; }
__device__ __forceinline__ int gdim_here() { int g = (int)gridDim.x; asm volatile("" : "+s"(g)); return g; }
__device__ __forceinline__ int tid_from(int wv) { int ln; asm volatile("v_mbcnt_lo_u32_b32 %0, -1, 0\n\tv_mbcnt_hi_u32_b32 %0, -1, %0" : "=v"(ln)); return wv * 64 + ln; }
namespace pg8 {
constexpr int BM = 256, BK = 64, HALF = 128, HTB = HALF * BK * 2  , STAGE_BYTES = 8 * HTB, NXCD = 8, WGM = 8;

__host__ __device__ __forceinline__ int lds_byte(int r, int c) { const int st = (r >> 4) * 2 + (c >> 5), rr = r & 15, cc = c & 31, ob = rr * 64 + cc * 2; return st * 1024 + (ob ^ (((ob >> 9) & 1) << 5)); }
__host__ __device__ __forceinline__ void stage_rc(int b, int& R, int& C) { const int st = b / 1024, sb = b % 1024, swz = sb ^ (((sb >> 9) & 1) << 5); R = (st >> 1) * 16 + swz / 64; C = (st & 1) * 32 + (swz % 64) / 2; }
__host__ __device__ __forceinline__ int perm32(int rho) { const int n = rho >> 4, i = rho & 15; return 8 * (i >> 2) + 4 * n + (i & 3); }

struct Unit { int pm, pn, e, aux; };

typedef int v8i32_t __attribute__((ext_vector_type(8)));
typedef int v4i32_t __attribute__((ext_vector_type(4)));
__device__ __forceinline__ v8i32_t f8frag(bf16x8 lo, bf16x8 hi) { const u32x4 a = __builtin_bit_cast(u32x4, lo), b = __builtin_bit_cast(u32x4, hi); return (v8i32_t){(int)a.x, (int)a.y, (int)a.z, (int)a.w, (int)b.x, (int)b.y, (int)b.z, (int)b.w}; }
template <class Epi, class Sched, bool ALIGN_EPI, bool F8 = false>
__device__ __forceinline__ void gemm_phase(LAS unsigned char* lds, const bf16* Abase, const bf16* Bbase, const int K, const Sched& S, const Epi& E, const int wv, const int stag = 0) {
    const int tid = tid_from(wv), wid = __builtin_amdgcn_readfirstlane(tid >> 6), lane = tid & 63, wr = wid >> 2, wc = wid & 3, fr = lane & 15, fq = lane >> 4;
    const int nt = K / BK;
    unsigned voffB[2];
#pragma unroll
    for (int i = 0; i < 2; ++i) { int R, C; stage_rc(tid * 16 + i * 8192, R, C); const int Rb = Epi::PERM ? ((R & ~31) + perm32(R & 31)) : R;
        voffB[i] = (unsigned)(Rb * K + C) * 2u; }
#define PG8_AVOFF(u, h, i) ([&]() { int R_, C_; stage_rc(tid * 16 + (i) * 8192, R_, C_); return S.a_voff((u), (h) * HALF + R_, C_); }())
#define PG8_GATHER4(u, pk) do { int R0_, C0_, R1_, C1_; stage_rc(tid * 16, R0_, C0_); stage_rc(tid * 16 + 8192, R1_, C1_); \
        const int q0_ = S.a_raw((u), R0_), q1_ = S.a_raw((u), R1_), q2_ = S.a_raw((u), HALF + R0_), q3_ = S.a_raw((u), HALF + R1_); \
        pk.x = S.a_voff_raw((u), R0_, C0_, q0_); pk.y = S.a_voff_raw((u), R1_, C1_, q1_); pk.z = S.a_voff_raw((u), HALF + R0_, C0_, q2_); pk.w = S.a_voff_raw((u), HALF + R1_, C1_, q3_); } while (0)
    const unsigned kstep = (unsigned)(BK * 2);
    const unsigned hstep = (unsigned)(HALF * K * 2);
    const unsigned ldsw = (unsigned)wid * 1024u;
    const int aoff = F8 ? lds_byte(wr * 64 + fr, fq * 16) : lds_byte(wr * 64 + fr, fq * 8), boff = F8 ? lds_byte(wc * 32 + fr, fq * 16) : lds_byte(wc * 32 + fr, fq * 8);
    const __amdgpu_buffer_rsrc_t rsA = __builtin_amdgcn_make_buffer_rsrc((void*)Abase, 0, 0x7fffffff, 0x00020000);
    const __amdgpu_buffer_rsrc_t rsB = __builtin_amdgcn_make_buffer_rsrc((void*)Bbase, 0, 0x7fffffff, 0x00020000);
#define PG8_SA(b, h) (((b) * 2 + (h)) * HTB)
#define PG8_SB(b, h) ((4 + (b) * 2 + (h)) * HTB)
#define PG8_STAGE_B(bufoff, soff) do { const int so_ = __builtin_amdgcn_readfirstlane((int)(soff)); _Pragma("unroll") for (int _i = 0; _i < 2; ++_i) \
        __builtin_amdgcn_raw_ptr_buffer_load_lds(rsB, (LAS void*)(lds + (bufoff) + ldsw + _i * 8192), 16, voffB[_i], so_, 0, 0); } while (0)
#define PG8_STAGE_A(bufoff, kbytes, H, NX) do { const int so_ = __builtin_amdgcn_readfirstlane((int)(kbytes)); unsigned o0_, o1_; \
        if constexpr (Sched::GATHER) { const u32x2 pk_ = *(const LAS u32x2*)((const LAS unsigned char*)park + (((ui + (NX)) & 1) * 8192 + tid * 16 + (H) * 8)); o0_ = pk_.x; o1_ = pk_.y; } else { o0_ = vc0; o1_ = vc1; } \
        __builtin_amdgcn_raw_ptr_buffer_load_lds(rsA, (LAS void*)(lds + (bufoff) + ldsw), 16, o0_, so_, 0, 0); \
        __builtin_amdgcn_raw_ptr_buffer_load_lds(rsA, (LAS void*)(lds + (bufoff) + ldsw + 8192), 16, o1_, so_, 0, 0); } while (0)
#define PG8_LD8(p_) __builtin_shufflevector(*(const LAS v4i32_t*)(p_), *(const LAS v4i32_t*)((p_) + 16), 0, 1, 2, 3, 4, 5, 6, 7)
#define PG8_LDA(dst, b, h) do { if constexpr (F8) { _Pragma("unroll") for (int m = 0; m < 4; ++m) dst##8[m] = PG8_LD8(lds + PG8_SA(b, h) + aoff + m * 2048); } \
        else { _Pragma("unroll") for (int m = 0; m < 4; ++m) _Pragma("unroll") for (int k = 0; k < 2; ++k) dst[m][k] = *(const LAS bf16x8*)(lds + PG8_SA(b, h) + aoff + m * 2048 + k * 1024); } } while (0)
#define PG8_LDB(dst, b, h) do { if constexpr (F8) { _Pragma("unroll") for (int n = 0; n < 2; ++n) dst##8[n] = PG8_LD8(lds + PG8_SB(b, h) + boff + n * 2048); } \
        else { _Pragma("unroll") for (int n = 0; n < 2; ++n) _Pragma("unroll") for (int k = 0; k < 2; ++k) dst[n][k] = *(const LAS bf16x8*)(lds + PG8_SB(b, h) + boff + n * 2048 + k * 1024); } } while (0)
#define PG8_MMA(ai, bj, At, Bt) do { __builtin_amdgcn_s_setprio(1); _Pragma("unroll") for (int m = 0; m < 4; ++m) _Pragma("unroll") for (int n = 0; n < 2; ++n) { \
        if constexpr (F8) { asm volatile("v_mfma_scale_f32_16x16x128_f8f6f4 %0, %1, %2, %0, %3, %3 op_sel_hi:[0,0,0]" : "+v"(acc[ai][bj][m][n]) : "v"(Bt##8[n]), "v"(At##8[m]), "v"(sc1_)); }   \
        else { _Pragma("unroll") for (int k = 0; k < 2; ++k) acc[ai][bj][m][n] = __builtin_amdgcn_mfma_f32_16x16x32_bf16(Bt[n][k], At[m][k], acc[ai][bj][m][n], 0, 0, 0); } } __builtin_amdgcn_s_setprio(0); } while (0)
#define PG8_WAIT_V(n) asm volatile("s_waitcnt vmcnt(" #n ")" ::: "memory")
#define PG8_WAIT_VN(n) asm volatile("s_waitcnt vmcnt(%0)" :: "n"(n) : "memory")
#define PG8_WAIT_L(n) asm volatile("s_waitcnt lgkmcnt(" #n ")" ::: "memory")
#define PG8_BAR __builtin_amdgcn_s_barrier()
#define PG8_SCHED __builtin_amdgcn_sched_barrier(0)
    if (stag > 0) { const unsigned long long t0_ = __builtin_amdgcn_s_memrealtime(), dl_ = (unsigned long long)(((bid_here() >> 3) & 3) * stag);
        while (__builtin_amdgcn_s_memrealtime() - t0_ < dl_) __builtin_amdgcn_s_sleep(8); }
    Unit cur, nxt; int ui = 0;
    if (!S.next(0, cur)) return;
    float zz_ = 0.f; asm volatile("" : "+v"(zz_));
    int sc1_ = 0x7f7f7f7f; asm volatile("" : "+v"(sc1_));
    LAS u32x4* const park = (LAS u32x4*)(lds + STAGE_BYTES + 8192);
    f32x4 acc[2][2][4][2];
#pragma unroll
    for (int a = 0; a < 2; ++a)
#pragma unroll
        for (int b = 0; b < 2; ++b)
#pragma unroll
            for (int m = 0; m < 4; ++m)
#pragma unroll
                for (int n = 0; n < 2; ++n) acc[a][b][m][n] = (f32x4){zz_, zz_, zz_, zz_};
    bf16x8 At[4][2], B0[2][2], B1[2][2]; v8i32_t At8[4], B08[2], B18[2];
    unsigned vc0 = 0u, vc1 = 0u;
    unsigned cA0, cA1, nA0, nA1;
    if constexpr (Sched::GATHER) { u32x4 pk; PG8_GATHER4(cur, pk); park[tid] = pk; }
    else { vc0 = PG8_AVOFF(cur, 0, 0); vc1 = PG8_AVOFF(cur, 0, 1); }
    cA0 = S.a_soff(cur, 0); cA1 = S.a_soff(cur, 1);
    unsigned cB = (unsigned)S.b_off(cur);
    PG8_STAGE_B(PG8_SB(0, 0), cB); PG8_STAGE_B(PG8_SB(0, 1), cB + hstep); PG8_STAGE_A(PG8_SA(0, 0), cA0, 0, 0); PG8_STAGE_A(PG8_SA(0, 1), cA1, 1, 0);
    if (wr == 1) PG8_BAR;
    PG8_WAIT_V(2); PG8_BAR;
    PG8_STAGE_B(PG8_SB(1, 0), cB + kstep); PG8_STAGE_A(PG8_SA(1, 0), cA0 + kstep, 0, 0); PG8_STAGE_B(PG8_SB(1, 1), cB + hstep + kstep);
    if constexpr (Epi::PEEL) PG8_WAIT_V(0); else PG8_WAIT_V(6);
    PG8_BAR;
    for (;;) {
#define PG8_TRIP(a1k, a2k0, a2k1, a3k0, b2, b3, NX, W1, W2) do { \
              \
            PG8_LDB(B0, 0, 0); PG8_LDB(B1, 0, 1); PG8_SCHED; PG8_LDA(At, 0, 0); PG8_STAGE_A(PG8_SA(1, 1), a1k, 1, 0); \
            W1; PG8_WAIT_L(0); PG8_BAR; PG8_MMA(0, 0, At, B0); PG8_MMA(0, 1, At, B1); PG8_BAR; PG8_SCHED; \
              \
            PG8_LDA(At, 0, 1); PG8_STAGE_B(PG8_SB(0, 0), b2); PG8_STAGE_B(PG8_SB(0, 1), (b2) + hstep); PG8_STAGE_A(PG8_SA(0, 0), a2k0, 0, NX); \
            W2; PG8_WAIT_L(0); PG8_BAR; PG8_MMA(1, 0, At, B0); PG8_MMA(1, 1, At, B1); PG8_BAR; PG8_SCHED; \
              \
            PG8_LDB(B0, 1, 0); PG8_LDB(B1, 1, 1); PG8_SCHED; PG8_LDA(At, 1, 0); PG8_STAGE_A(PG8_SA(0, 1), a2k1, 1, NX); \
            PG8_WAIT_V(8); PG8_WAIT_L(0); PG8_BAR; PG8_MMA(0, 0, At, B0); PG8_MMA(0, 1, At, B1); PG8_BAR; PG8_SCHED; \
              \
            PG8_LDA(At, 1, 1); PG8_STAGE_B(PG8_SB(1, 0), b3); PG8_STAGE_B(PG8_SB(1, 1), (b3) + hstep); PG8_STAGE_A(PG8_SA(1, 0), a3k0, 0, NX); \
            PG8_WAIT_V(8); PG8_WAIT_L(0); PG8_BAR; PG8_MMA(1, 0, At, B0); PG8_MMA(1, 1, At, B1); PG8_BAR; PG8_SCHED; } while (0)
        const bool has_next = S.next(ui + 1, nxt);
        if constexpr (Sched::GATHER) { if (has_next) { u32x4 pk;
            if (nxt.pm == cur.pm) pk = park[(ui & 1) * 512 + tid];
            else PG8_GATHER4(nxt, pk);
            park[((ui + 1) & 1) * 512 + tid] = pk; } }
        unsigned nB;
        if (has_next) { nA0 = S.a_soff(nxt, 0); nA1 = S.a_soff(nxt, 1); nB = (unsigned)S.b_off(nxt); }
        else { nA0 = cA0; nA1 = cA1; nB = cB; }
        if constexpr (Epi::PEEL) { const int t = 0; const bool last = (t == nt - 2);
            const unsigned k1 = (unsigned)(t + 1) * kstep, k2 = (unsigned)(t + 2) * kstep;
            const unsigned a2k0 = last ? nA0 : cA0 + k2, a2k1 = last ? nA1 : cA1 + k2, b2 = last ? nB : cB + k2;
            const int nx = (last && has_next) ? 1 : 0;
            PG8_TRIP(cA1 + k1, a2k0, a2k1, a2k0 + kstep, b2, b2 + kstep, nx, PG8_WAIT_VN(2 + Epi::NSTORE), PG8_WAIT_VN(8 + Epi::NSTORE)); }
#pragma unroll 1
        for (int t = Epi::PEEL ? 2 : 0; t < nt; t += 2) {
            const bool last = (t == nt - 2);
            const unsigned k1 = (unsigned)(t + 1) * kstep, k2 = (unsigned)(t + 2) * kstep;
            const unsigned a2k0 = last ? nA0 : cA0 + k2, a2k1 = last ? nA1 : cA1 + k2, b2 = last ? nB : cB + k2;
            const int nx = (last && has_next) ? 1 : 0;
            PG8_TRIP(cA1 + k1, a2k0, a2k1, a2k0 + kstep, b2, b2 + kstep, nx, PG8_WAIT_V(8), PG8_WAIT_V(8));
        }
#undef PG8_TRIP
        if constexpr (ALIGN_EPI) { if (wr == 0) PG8_BAR; }
        { int tq_ = tid; asm volatile("" : "+v"(tq_));
          const int wq_ = __builtin_amdgcn_readfirstlane(tq_ >> 6); E(acc, cur, wq_ >> 2, wq_ & 3, tq_ & 15, (tq_ & 63) >> 4); }
        if (!has_next) break;
#pragma unroll
        for (int a = 0; a < 2; ++a)
#pragma unroll
            for (int b = 0; b < 2; ++b)
#pragma unroll
                for (int m = 0; m < 4; ++m)
#pragma unroll
                    for (int n = 0; n < 2; ++n) acc[a][b][m][n] = (f32x4){zz_, zz_, zz_, zz_};
        cur = nxt; cB = nB; cA0 = nA0; cA1 = nA1; ++ui;
        if constexpr (ALIGN_EPI) { if (wr == 1) PG8_BAR; }
    }
    PG8_WAIT_V(0);
    if constexpr (!ALIGN_EPI) { if (wr == 0) PG8_BAR; }
    PG8_BAR;
#undef PG8_SA
#undef PG8_AVOFF
#undef PG8_GATHER4
#undef PG8_SB
#undef PG8_STAGE_A
#undef PG8_STAGE_B
#undef PG8_LDA
#undef PG8_LDB
#undef PG8_LD8
#undef PG8_MMA
#undef PG8_WAIT_V
#undef PG8_WAIT_VN
#undef PG8_WAIT_L
#undef PG8_BAR
#undef PG8_SCHED
}

struct StaticOrder {
    int nM, nN, nwg, G, c, lda, dup;
    __device__ __forceinline__ void init(int M, int N, int lda_, int G_, int c_) { nM = M / BM; nN = N / BM; nwg = nM * nN; G = G_; c = c_; lda = lda_; dup = 0; }
    __device__ __forceinline__ bool next(int i, Unit& u) const {
        const long L = (long)(i >> dup) * G + c; if (L >= nwg) return false;
        int wgid = (int)L; { const int q = nwg / NXCD, r = nwg % NXCD, xcd = wgid % NXCD, off = wgid / NXCD; wgid = (xcd < r ? xcd * (q + 1) : r * (q + 1) + (xcd - r) * q) + off; }
        const int nig = WGM * nN, gid = wgid / nig, fm = gid * WGM, gsz = (nM - fm) < WGM ? (nM - fm) : WGM;
        u.pm = fm + ((wgid % nig) % gsz); u.pn = (wgid % nig) / gsz; u.e = 0; u.aux = 0; return true;
    }
    static constexpr bool GATHER = false;
    __device__ __forceinline__ unsigned a_voff(const Unit&, int R, int C) const { return (unsigned)((R & (HALF - 1)) * lda + C) * 2u; }
    __device__ __forceinline__ unsigned a_soff(const Unit& u, int h) const { return (unsigned)((u.pm * BM + h * HALF) * lda) * 2u; }
    __device__ __forceinline__ size_t b_off(const Unit& u) const { return (size_t)u.pn * BM * lda * 2; }
};
}

#define XB_TMO      128
#define XB_XCNT(j)  (256  + 64 * (j))
#define XB_XSUB(j)  (1280 + 64 * (j))
#define XB_XGEN(j)  (2304 + 64 * (j))
#define XB_TOP      3328
#define XB_TOPGEN   3392
#define XCD_BAR_WORDS 3456
#define XB_SPIN_CAP (1u << 18)

__device__ __forceinline__ unsigned xb_ld(unsigned* p)              { return __hip_atomic_load(p, __ATOMIC_RELAXED, __HIP_MEMORY_SCOPE_AGENT); }
__device__ __forceinline__ unsigned xb_add(unsigned* p, unsigned v) { return __hip_atomic_fetch_add(p, v, __ATOMIC_RELAXED, __HIP_MEMORY_SCOPE_AGENT); }
__device__ __forceinline__ unsigned xb_xcc_id() { return (unsigned)__builtin_amdgcn_s_getreg((3 << 11) | 20) & 0xFu; }
#define XB_SPIN(cond, bar) do { unsigned _sp = 0; while (cond) { __builtin_amdgcn_s_sleep(1); \
    if ((++_sp & 255u) == 0u) { if (xb_ld(&(bar)[XB_TMO])) break; if (_sp > XB_SPIN_CAP) { atomicAdd(&(bar)[XB_TMO], 1u); break; } } } } while (0)

struct XcdBarrier {
    unsigned* bar; unsigned x;
    volatile LAS unsigned* st;
};

__device__ __forceinline__ XcdBarrier xcd_barrier_post(unsigned* bar, volatile LAS unsigned* st) {
    XcdBarrier b; b.bar = bar; b.x = xb_xcc_id(); b.st = st;
    if (threadIdx.x == 0) (void)xb_add(&bar[XB_XCNT(b.x)], 1u);
    return b;
}
__device__ __forceinline__ void xcd_barrier_complete(unsigned* bar, unsigned x, unsigned& nloc, unsigned& nx) {
    const unsigned G = gridDim.x * gridDim.y * gridDim.z;
    unsigned sum, cnt, mine, sp = 0u;
    for (;;) {
        sum = 0u; cnt = 0u; mine = 0u;
#pragma unroll
        for (unsigned j = 0; j < 16; ++j) { const unsigned c = xb_ld(&bar[XB_XCNT(j)]); sum += c; cnt += (c > 0u) ? 1u : 0u; mine = (j == x) ? c : mine; }
        if (sum == G) break;
        __builtin_amdgcn_s_sleep(1);
        if ((++sp & 255u) == 0u) { if (xb_ld(&bar[XB_TMO])) break; if (sp > XB_SPIN_CAP) { atomicAdd(&bar[XB_TMO], 1u); break; } }
    }
    nloc = mine > 0u ? mine : 1u; nx = cnt > 0u ? cnt : 1u;
}

__device__ __forceinline__ void xcd_barrier(const XcdBarrier& b) {
    asm volatile("s_waitcnt vmcnt(0)" ::: "memory");
    __syncthreads();
    if (threadIdx.x == 0) {
        unsigned* bar = b.bar;
        __builtin_amdgcn_s_waitcnt(0);
        unsigned nloc = b.st[0], nx = b.st[1];
        if (nloc == 0u) { xcd_barrier_complete(bar, b.x, nloc, nx); b.st[0] = nloc; b.st[1] = nx; }
        const unsigned old = xb_add(&bar[XB_XSUB(b.x)], 1u);
        const unsigned gen = old / nloc;
        if (old + 1u == (gen + 1u) * nloc) {
            __builtin_amdgcn_fence(__ATOMIC_RELEASE, "agent");
            asm volatile("s_waitcnt vmcnt(0)" ::: "memory");
            const unsigned og = xb_add(&bar[XB_TOP], 1u);
            const unsigned tg = og / nx;
            if (og + 1u == (tg + 1u) * nx) xb_add(&bar[XB_TOPGEN], 1u);
            else XB_SPIN(xb_ld(&bar[XB_TOPGEN]) == tg, bar);
            __builtin_amdgcn_fence(__ATOMIC_ACQUIRE, "agent");
            xb_add(&bar[XB_XGEN(b.x)], 1u);
            asm volatile("s_waitcnt vmcnt(0)" ::: "memory");
        } else {
            XB_SPIN(xb_ld(&bar[XB_XGEN(b.x)]) == gen, bar);
            __builtin_amdgcn_fence(__ATOMIC_ACQUIRE, "agent");
            asm volatile("s_waitcnt vmcnt(0)" ::: "memory");
        }
    }
    __syncthreads();
}

struct Args { const float* in[23]; float* out; unsigned char* ws; int ph_lo, ph_hi, li, pad; };
#define CAS __attribute__((address_space(4)))
typedef const CAS Args& ArgsRef;
enum { I_X = 0, I_NORM1G, I_WIN, I_POOLW, I_POOLSC, I_CONVW, I_CONVB, I_WA, I_BA, I_WX, I_BX, I_LAM, I_QG, I_KG, I_OG, I_WOUT, I_NORM2G, I_WR, I_BR, I_WGU, I_BGU, I_WD, I_BD };

constexpr float WGU8_SCALE = 64.0f, WD8_SCALE = 64.0f, ACT8_SCALE = 4.0f, WOUT8_SCALE = 64.0f, WIN8_SCALE = 64.0f;
struct TrDesc { const float* W; int K, N; bf16* WT; const float* gk; int mode, item; };
__device__ __forceinline__ void tr_load(const TrDesc& d, float (&v)[32], float (&g)[8], int lane) {
    const int nblk = d.N / 32, kb = d.item / nblk, nb = d.item % nblk, k0 = 64 * kb, n0 = 32 * nb;
#pragma unroll
    for (int i = 0; i < 32; ++i) { const int kk = 2 * i + (lane >> 5); v[i] = __builtin_nontemporal_load(d.W + (size_t)(k0 + kk) * d.N + n0 + (lane & 31)); }
    const float* gp = (d.gk ? d.gk + k0 : d.W) + 8 * (lane & 7);
    const f32x4 g0 = *(const f32x4*)gp, g1 = *(const f32x4*)(gp + 4); const bool hg = d.gk != nullptr;
    g[0] = hg ? g0[0] : 1.f; g[1] = hg ? g0[1] : 1.f; g[2] = hg ? g0[2] : 1.f; g[3] = hg ? g0[3] : 1.f; g[4] = hg ? g1[0] : 1.f; g[5] = hg ? g1[1] : 1.f; g[6] = hg ? g1[2] : 1.f; g[7] = hg ? g1[3] : 1.f;
}
__device__ __forceinline__ void tr_finish(const TrDesc& d, float (&v)[32], const float (&g)[8], LAS float* scr, int lane) {
    const int nblk = d.N / 32, kb = d.item / nblk, nb = d.item % nblk, k0 = 64 * kb, n0 = 32 * nb; const int K = d.K;
#pragma unroll
    for (int i = 0; i < 32; ++i) { const int kk = 2 * i + (lane >> 5); scr[kk * 33 + (lane & 31)] = v[i]; }
    LDS_WAIT(); asm volatile("" ::: "memory");
    const int c = lane & 7;
#pragma unroll
    for (int j = 0; j < 4; ++j) { const int n = (lane >> 3) + 8 * j; const LAS float* s = scr + (8 * c) * 33 + n;
        float x[8];
#pragma unroll
        for (int q = 0; q < 8; ++q) x[q] = s[q * 33] * g[q];
        u32x4 o; o.x = cvt_pk_bf16(x[0], x[1]); o.y = cvt_pk_bf16(x[2], x[3]); o.z = cvt_pk_bf16(x[4], x[5]); o.w = cvt_pk_bf16(x[6], x[7]);
        int dn = n0 + n; const int mode = d.mode;
        if (mode == 5) {
            const int L = dn & 255; dn = (dn & ~255) + 128 * ((L >> 3) & 1) + 32 * (L >> 6) + 8 * ((L >> 4) & 3) + (L & 7);
            int w0 = __builtin_amdgcn_cvt_pk_fp8_f32(x[0] * WD8_SCALE, x[1] * WD8_SCALE, 0, false); w0 = __builtin_amdgcn_cvt_pk_fp8_f32(x[2] * WD8_SCALE, x[3] * WD8_SCALE, w0, true);
            int w1 = __builtin_amdgcn_cvt_pk_fp8_f32(x[4] * WD8_SCALE, x[5] * WD8_SCALE, 0, false); w1 = __builtin_amdgcn_cvt_pk_fp8_f32(x[6] * WD8_SCALE, x[7] * WD8_SCALE, w1, true);
            *(u32x2*)((unsigned char*)d.WT + (size_t)dn * K + k0 + 8 * c) = (u32x2){(unsigned)w0, (unsigned)w1}; continue; }
        if (mode == 4) {
            const int jj = dn & 255; dn = (jj >> 7) * 256 + (dn >> 8) * 128 + (jj & 127);
            int w0 = __builtin_amdgcn_cvt_pk_fp8_f32(x[0] * WGU8_SCALE, x[1] * WGU8_SCALE, 0, false); w0 = __builtin_amdgcn_cvt_pk_fp8_f32(x[2] * WGU8_SCALE, x[3] * WGU8_SCALE, w0, true);
            int w1 = __builtin_amdgcn_cvt_pk_fp8_f32(x[4] * WGU8_SCALE, x[5] * WGU8_SCALE, 0, false); w1 = __builtin_amdgcn_cvt_pk_fp8_f32(x[6] * WGU8_SCALE, x[7] * WGU8_SCALE, w1, true);
            *(u32x2*)((unsigned char*)d.WT + (size_t)dn * K + k0 + 8 * c) = (u32x2){(unsigned)w0, (unsigned)w1}; continue; }
        if (mode == 1) { const int jj = dn & 255; dn = (jj >> 7) * 256 + (dn >> 8) * 128 + (jj & 127); }
        if (mode == 3 || mode == 6 || ((mode == 2 || mode == 7) && (dn < C_Q || dn >= C_V))) {
            const int L = dn & 255; dn = (dn & ~255) + 128 * ((L >> 3) & 1) + 32 * (L >> 6) + 8 * ((L >> 4) & 3) + (L & 7); }
        else if (mode == 2 || mode == 7) {
            const int rem = (dn - C_Q) & 511, sec = (dn - C_Q) >> 9, head = rem >> 6, d2 = rem & 63;
            dn = C_Q + sec * 512 + (head >> 2) * 256 + (d2 >> 5) * 128 + (head & 3) * 32 + (d2 & 31); }
        if (mode == 6 || mode == 7) {
            int w0 = __builtin_amdgcn_cvt_pk_fp8_f32(x[0] * WOUT8_SCALE, x[1] * WOUT8_SCALE, 0, false); w0 = __builtin_amdgcn_cvt_pk_fp8_f32(x[2] * WOUT8_SCALE, x[3] * WOUT8_SCALE, w0, true);
            int w1 = __builtin_amdgcn_cvt_pk_fp8_f32(x[4] * WOUT8_SCALE, x[5] * WOUT8_SCALE, 0, false); w1 = __builtin_amdgcn_cvt_pk_fp8_f32(x[6] * WOUT8_SCALE, x[7] * WOUT8_SCALE, w1, true);
            *(u32x2*)((unsigned char*)d.WT + (size_t)dn * K + k0 + 8 * c) = (u32x2){(unsigned)w0, (unsigned)w1}; continue; }
        *(u32x4*)(d.WT + (size_t)dn * K + k0 + 8 * c) = o; }
    LDS_WAIT(); asm volatile("" ::: "memory");
}
__device__ __forceinline__ void cvt_row(const float* xrow, bf16* orow, float* ssq, int lane) {
    const f32x4* xr = (const f32x4*)xrow + lane;
    f32x4 v[4]; float s = 0.f;
#pragma unroll
    for (int j = 0; j < 4; ++j) { v[j] = xr[64 * j]; s += (v[j].x * v[j].x + v[j].y * v[j].y) + (v[j].z * v[j].z + v[j].w * v[j].w); }
    s = wave_sum(s);
    u32x2* o8 = (u32x2*)orow + lane;
#pragma unroll
    for (int j = 0; j < 4; ++j) { u32x2 w; w.x = cvt_pk_bf16(v[j].x, v[j].y); w.y = cvt_pk_bf16(v[j].z, v[j].w); o8[64 * j] = w; }
    if (lane == 0) *ssq = s;
}
__device__ __forceinline__ TrDesc tr_desc(ArgsRef a, int it) {
    unsigned char* ws = a.ws;
    constexpr int I_IN = 16 * 72, I_OUT = 16 * 32, I_R = 16, I_GU = 16 * 16, I_D = 4 * 32, I_S = 2;
    constexpr int PER_LAYER = I_IN + I_OUT + I_R + NEXP * I_GU + NEXP * I_D + 12 * I_S;
    const int l = it / PER_LAYER; int r = it % PER_LAYER; TrDesc d;
    if (r < I_IN) { d = TrDesc{a.in[I_WIN] + (size_t)l * DM * NIN, DM, NIN, (bf16*)(ws + WS_WIN) + (size_t)l * NIN * DM, a.in[I_NORM1G] + l * DM, l == 1 ? 7 : 2, r}; return d; } r -= I_IN;
    if (r < I_OUT) { d = TrDesc{a.in[I_WOUT] + (size_t)l * DM * DM, DM, DM, (bf16*)(ws + WS_WOUT) + (size_t)l * DM * DM, a.in[I_OG] + l * DM, l == 1 ? 6 : 3, r}; return d; } r -= I_OUT;
    if (r < I_R) { d = TrDesc{a.in[I_WR] + (size_t)l * DM * NEXP, DM, NEXP, (bf16*)(ws + WS_SMALL) + SM_WR + (size_t)l * NEXP * DM, a.in[I_NORM2G] + l * DM, 0, r}; return d; } r -= I_R;
    if (r < NEXP * I_GU) { const int e = r / I_GU; d = TrDesc{a.in[I_WGU] + (size_t)(l * NEXP + e) * DM * 512, DM, 512, (bf16*)(ws + WS_WGU + (size_t)(l * NEXP + e) * 512 * DM), a.in[I_NORM2G] + l * DM, 4, r % I_GU}; return d; } r -= NEXP * I_GU;
    if (r < NEXP * I_D) { const int e = r / I_D; d = TrDesc{a.in[I_WD] + (size_t)(l * NEXP + e) * EFF * DM, EFF, DM, (bf16*)(ws + WS_WD + (size_t)(l * NEXP + e) * DM * EFF), nullptr, 5, r % I_D}; return d; } r -= NEXP * I_D;
    { const int which = r / (4 * I_S), g = (r / I_S) % 4, sub = r % I_S;
      const float* src = a.in[which == 0 ? I_POOLW : (which == 1 ? I_WA : I_WX)] + (size_t)(l * 4 + g) * 4096;
      bf16* dst = (bf16*)(ws + WS_SMALL) + (which == 0 ? SM_POOLW : (which == 1 ? SM_WA : SM_WX)) + (size_t)(l * 4 + g) * 4096;
      d = TrDesc{src, 64, 64, dst, nullptr, 0, sub}; return d; }
}
__device__ __forceinline__ void phase_prologue(ArgsRef a, LAS unsigned char* lds, int wv) {
    const int tid = tid_from(wv), lane = tid & 63, wave = tid >> 6;
    LAS float* scr = (LAS float*)(lds + wave * 16384);
    const int gw = bid_here() * NWAVES + wave, NGW = gdim_here() * NWAVES;
    unsigned char* ws = a.ws;
    constexpr int PER_LAYER = 16 * 72 + 16 * 32 + 16 + NEXP * 16 * 16 + NEXP * 4 * 32 + 12 * 2;
    { int it = gw; float cur[32], nxt[32], gc[8], gn[8];
      TrDesc dc = tr_desc(a, it < 2 * PER_LAYER ? it : 0), dn = dc;
      if (it < 2 * PER_LAYER) tr_load(dc, cur, gc, lane);
#pragma unroll
      for (int i = 0; i < 8; ++i) gn[i] = gc[i];
      while (it < 2 * PER_LAYER) { const int itn = it + NGW;
          if (itn < 2 * PER_LAYER) { dn = tr_desc(a, itn); tr_load(dn, nxt, gn, lane); }
          tr_finish(dc, cur, gc, scr, lane);
#pragma unroll
          for (int i = 0; i < 32; ++i) cur[i] = nxt[i];
#pragma unroll
          for (int i = 0; i < 8; ++i) gc[i] = gn[i];
          dc = dn; it = itn; } }
    { float* ct = (float*)(ws + WS_ROPE); float* st = ct + SEQ * 32;
      for (int idx = bid_here() * NTHR + tid; idx < SEQ * 32; idx += gdim_here() * NTHR) {
          const int pos = idx >> 5, i = idx & 31;
          const float inv = __builtin_amdgcn_exp2f(-(float)i * 0.41524101186092029f);
          const float ang = (float)pos * inv;
          const double rev = (double)ang * 0.15915494309189535; const double fr = rev - __builtin_rint(rev);
          const float f = (float)fr;
          ct[idx] = __builtin_amdgcn_cosf(f); st[idx] = __builtin_amdgcn_sinf(f); } }
    { const float* __restrict__ X = a.in[I_X]; bf16* __restrict__ xb = (bf16*)(ws + WS_XB); float* __restrict__ ssq = (float*)(ws + WS_SSQ);
      for (int m0 = gw * 4; m0 < NT; m0 += NGW * 4) { f32x4 v[4][4];
#pragma unroll
          for (int u = 0; u < 4; ++u)
#pragma unroll
              for (int j = 0; j < 4; ++j) v[u][j] = __builtin_nontemporal_load((const f32x4*)(X + (size_t)(m0 + u) * DM) + lane + 64 * j);
#pragma unroll
          for (int u = 0; u < 4; ++u) { float s = 0.f;
#pragma unroll
              for (int j = 0; j < 4; ++j) s += (v[u][j].x * v[u][j].x + v[u][j].y * v[u][j].y) + (v[u][j].z * v[u][j].z + v[u][j].w * v[u][j].w);
              s = wave_sum(s);
#pragma unroll
              for (int j = 0; j < 4; ++j) { u32x2 w; w.x = cvt_pk_bf16(v[u][j].x, v[u][j].y); w.y = cvt_pk_bf16(v[u][j].z, v[u][j].w); *((u32x2*)(xb + (size_t)(m0 + u) * DM) + lane + 64 * j) = w; }
              if (lane == 0) ssq[m0 + u] = s; } } }
}

struct EpiIn {
    static constexpr bool PERM = true; static constexpr int NSTORE = 16; static constexpr bool PEEL = false;
    bf16* O; bf16* HM; const float* ssq; const float* qg; const float* kg; const float* ct; const float* st; LAS unsigned char* stage; float oscale;
    __device__ __forceinline__ void rows16(LAS unsigned char* stg, int fr, int fq, int c0, int c1, const u32x4& w0, const u32x4& w1, bf16* gbase, int stride) const {
        *(LAS u32x4*)(stg + fr * 128 + ((c0 ^ (fr & 7)) << 4)) = w0;
        *(LAS u32x4*)(stg + fr * 128 + ((c1 ^ (fr & 7)) << 4)) = w1;
        const int l = fr + 16 * fq, rr = l >> 3, cc = l & 7;
        const u32x4 a = *(const LAS u32x4*)(stg + rr * 128 + ((cc ^ rr) << 4)), b = *(const LAS u32x4*)(stg + (rr + 8) * 128 + ((cc ^ rr) << 4));
        *(u32x4*)(gbase + (size_t)rr * stride + cc * 8) = a;
        *(u32x4*)(gbase + (size_t)(rr + 8) * stride + cc * 8) = b;
    }
    __device__ __forceinline__ void operator()(const f32x4 (&acc)[2][2][4][2], const pg8::Unit& u, int wr, int wc, int fr, int fq) const {
        const int rbase0 = u.pm * 256 + wr * 64;
        LAS unsigned char* stg = stage + (wr * 4 + wc) * 2048;
        float rsv[2][4];
#pragma unroll
        for (int ai = 0; ai < 2; ++ai)
#pragma unroll
            for (int m = 0; m < 4; ++m) rsv[ai][m] = ssq[rbase0 + ai * 128 + m * 16 + fr];
        const float osc = oscale;
        if (u.pn >= 3 && u.pn < 7) {
            const bool isq = u.pn < 5; const float* gp = (isq ? qg : kg) + 8 * fq; const float gs = isq ? (0.125f * 1.4426950408889634f) : 1.0f;
            f32x4 g[2][2];
#pragma unroll
            for (int bj = 0; bj < 2; ++bj)
#pragma unroll
                for (int n = 0; n < 2; ++n) g[bj][n] = *(const f32x4*)(gp + 32 * bj + 4 * n);
            const int pos0 = (rbase0 + fr) & (SEQ - 1);
            f32x4 cb[2], sb[2], cd[2], sd[2], ce[2], se[2];
#pragma unroll
            for (int n = 0; n < 2; ++n) { cb[n] = *(const f32x4*)(ct + pos0 * 32 + 8 * fq + 4 * n); sb[n] = *(const f32x4*)(st + pos0 * 32 + 8 * fq + 4 * n);
                cd[n] = *(const f32x4*)(ct + 16 * 32 + 8 * fq + 4 * n); sd[n] = *(const f32x4*)(st + 16 * 32 + 8 * fq + 4 * n);
                ce[n] = *(const f32x4*)(ct + 128 * 32 + 8 * fq + 4 * n); se[n] = *(const f32x4*)(st + 128 * 32 + 8 * fq + 4 * n); }
            bf16* hb = HM + (size_t)(u.pn >= 5 ? 1 : 0) * NT * 512 + ((size_t)((rbase0 >> 12) * 8 + 4 * ((u.pn - 3) & 1) + wc) * SEQ + (rbase0 & (SEQ - 1))) * 64;
#pragma unroll
            for (int ai = 0; ai < 2; ++ai) { f32x4 cc[2], sc[2];
#pragma unroll
                for (int n = 0; n < 2; ++n) { if (ai == 0) { cc[n] = cb[n]; sc[n] = sb[n]; } else { cc[n] = cb[n] * ce[n] - sb[n] * se[n]; sc[n] = sb[n] * ce[n] + cb[n] * se[n]; } }
#pragma unroll
                for (int m = 0; m < 4; ++m) { const float rs = __builtin_amdgcn_rsqf(rsv[ai][m] * (1.0f / DM) + EPS) * osc;
                    f32x4 v[2][2]; float ss = 0.f;
#pragma unroll
                    for (int bj = 0; bj < 2; ++bj)
#pragma unroll
                        for (int n = 0; n < 2; ++n) { v[bj][n] = acc[ai][bj][m][n] * rs; ss += (v[bj][n][0] * v[bj][n][0] + v[bj][n][1] * v[bj][n][1]) + (v[bj][n][2] * v[bj][n][2] + v[bj][n][3] * v[bj][n][3]); }
                    ss = xsum32(xsum16(ss));
                    const float rr = __builtin_amdgcn_rsqf(ss * (1.0f / 64.0f) + EPS) * gs;
#pragma unroll
                    for (int bj = 0; bj < 2; ++bj)
#pragma unroll
                        for (int n = 0; n < 2; ++n) v[bj][n] = v[bj][n] * rr * g[bj][n];
                    const f32x4 o00 = v[0][0] * cc[0] - v[1][0] * sc[0], o01 = v[0][1] * cc[1] - v[1][1] * sc[1], o10 = v[1][0] * cc[0] + v[0][0] * sc[0], o11 = v[1][1] * cc[1] + v[0][1] * sc[1];
                    u32x4 w0, w1; w0.x = cvt_pk_bf16(o00[0], o00[1]); w0.y = cvt_pk_bf16(o00[2], o00[3]); w0.z = cvt_pk_bf16(o01[0], o01[1]); w0.w = cvt_pk_bf16(o01[2], o01[3]);
                    w1.x = cvt_pk_bf16(o10[0], o10[1]); w1.y = cvt_pk_bf16(o10[2], o10[3]); w1.z = cvt_pk_bf16(o11[0], o11[1]); w1.w = cvt_pk_bf16(o11[2], o11[3]);
                    rows16(stg, fr, fq, fq, 4 + fq, w0, w1, hb + (size_t)(ai * 128 + m * 16) * 64, 64);
                    if (m < 3) {
#pragma unroll
                        for (int n = 0; n < 2; ++n) { const f32x4 c2 = cc[n] * cd[n] - sc[n] * sd[n]; sc[n] = sc[n] * cd[n] + cc[n] * sd[n]; cc[n] = c2; } } } }
            return;
        }
        const bool isv = u.pn >= 7; const int stride = isv ? 64 : NPJ;
        bf16* ob = isv ? HM + (size_t)2 * NT * 512 + ((size_t)((rbase0 >> 12) * 8 + 4 * (u.pn - 7) + wc) * SEQ + (rbase0 & (SEQ - 1))) * 64
                       : O + (size_t)rbase0 * NPJ + u.pn * 256 + wc * 64;
#pragma unroll
        for (int ai = 0; ai < 2; ++ai)
#pragma unroll
            for (int m = 0; m < 4; ++m) { const float rs = __builtin_amdgcn_rsqf(rsv[ai][m] * (1.0f / DM) + EPS) * osc;
                u32x4 w[2];
#pragma unroll
                for (int bj = 0; bj < 2; ++bj) { const f32x4 v0 = acc[ai][bj][m][0] * rs, v1 = acc[ai][bj][m][1] * rs;
                    w[bj].x = cvt_pk_bf16(v0[0], v0[1]); w[bj].y = cvt_pk_bf16(v0[2], v0[3]); w[bj].z = cvt_pk_bf16(v1[0], v1[1]); w[bj].w = cvt_pk_bf16(v1[2], v1[3]); }
                rows16(stg, fr, fq, 2 * fq, 2 * fq + 1, w[0], w[1], ob + (size_t)(ai * 128 + m * 16) * stride, stride); }
    }
};
struct EpiOut {
    static constexpr bool PERM = true; static constexpr int NSTORE = 32; static constexpr bool PEEL = false;
    bf16* xb; float* ssqp; unsigned char* xb8; float oscale;
    __device__ __forceinline__ void operator()(const f32x4 (&acc)[2][2][4][2], const pg8::Unit& u, int wr, int wc, int fr, int fq) const {
        const int row0 = u.pm * 256 + wr * 64 + fr, col0 = u.pn * 256 + wc * 64 + fq * 16;
        u32x4 xi[2][4][2];
#pragma unroll
        for (int am = 0; am < 2; ++am)
#pragma unroll
            for (int mm = 0; mm < 4; ++mm) { const size_t off = (size_t)(row0 + am * 128 + mm * 16) * DM + col0; xi[am][mm][0] = *(const u32x4*)(xb + off); xi[am][mm][1] = *(const u32x4*)(xb + off + 8); }
        asm volatile("" ::: "memory");
#pragma unroll
        for (int am = 0; am < 2; ++am) {
#pragma unroll
            for (int mm = 0; mm < 4; ++mm) { const int ai = am, m = mm; const int row = row0 + ai * 128 + m * 16; const size_t off = (size_t)row * DM + col0; float s = 0.f; u32x4 w8;
#pragma unroll
                for (int bj = 0; bj < 2; ++bj) { const u32x4 x = xi[am][mm][bj];
                    const f32x4 o0 = (f32x4){bflo(x.x), bfhi(x.x), bflo(x.y), bfhi(x.y)} + acc[ai][bj][m][0] * oscale, o1 = (f32x4){bflo(x.z), bfhi(x.z), bflo(x.w), bfhi(x.w)} + acc[ai][bj][m][1] * oscale;
                    s += ((o0[0] * o0[0] + o0[1] * o0[1]) + (o0[2] * o0[2] + o0[3] * o0[3])) + ((o1[0] * o1[0] + o1[1] * o1[1]) + (o1[2] * o1[2] + o1[3] * o1[3]));
                    u32x4 w; w.x = cvt_pk_bf16(o0[0], o0[1]); w.y = cvt_pk_bf16(o0[2], o0[3]); w.z = cvt_pk_bf16(o1[0], o1[1]); w.w = cvt_pk_bf16(o1[2], o1[3]);
                    *(u32x4*)(xb + off + bj * 8) = w;
                    int f0 = __builtin_amdgcn_cvt_pk_fp8_f32(o0[0], o0[1], 0, false); f0 = __builtin_amdgcn_cvt_pk_fp8_f32(o0[2], o0[3], f0, true);
                    int f1 = __builtin_amdgcn_cvt_pk_fp8_f32(o1[0], o1[1], 0, false); f1 = __builtin_amdgcn_cvt_pk_fp8_f32(o1[2], o1[3], f1, true);
                    if (bj == 0) { w8.x = (unsigned)f0; w8.y = (unsigned)f1; } else { w8.z = (unsigned)f0; w8.w = (unsigned)f1; } }
                *(u32x4*)(xb8 + off) = w8;
                s = xsum32(xsum16(s));
                if (fq == 0) ssqp[(size_t)row * 16 + u.pn * 4 + wc] = s; }
            asm volatile("" ::: "memory"); }
    }
};

template <int MODE> struct MoeOrder {
    static constexpr bool GATHER = (MODE == 0 || MODE == 2);
    const LAS int* tab; int npn, G, c; const int* list; int dup;
    __device__ __forceinline__ bool next(int i, pg8::Unit& u) const {
        const int ii = i >> dup; const int total = __builtin_amdgcn_readfirstlane(tab[64]); const int nfr = total / G, nfu = nfr * npn;
        int gb;
        if (ii < nfu) { gb = (ii / npn) * G + c; u.pn = ii % npn; }
        else { const int L = (ii - nfu) * G + c; gb = nfr * G + L / npn; u.pn = L % npn; if (gb >= total) return false; }
        const int e = __builtin_amdgcn_readfirstlane((int)((const LAS unsigned char*)(tab + 80))[gb]);
        u.e = e; u.pm = gb; u.aux = gb - __builtin_amdgcn_readfirstlane(tab[32 + e]); return true;
    }
    __device__ __forceinline__ unsigned a_voff(const pg8::Unit& u, int R, int C) const {
        if constexpr (MODE == 0) { const int pos = u.aux * 256 + R; const int ne = tab[u.e]; int tok = 0; if (pos < ne) tok = list[u.e * NT + pos] >> 2; return (unsigned)(tok * DM + C) * 2u; }
        else if constexpr (MODE == 2) { const int pos = u.aux * 256 + R; const int ne = tab[u.e]; int tok = list[u.e * NT + (pos < ne ? pos : 0)] >> 2; if (pos >= ne) tok = 0; return (unsigned)(tok * (DM / 2) + C) * 2u; }
        else if constexpr (MODE == 3) return (unsigned)((R & 127) * (EFF / 2) + C) * 2u;
        else return (unsigned)((R & 127) * EFF + C) * 2u;
    }
    __device__ __forceinline__ int a_raw(const pg8::Unit& u, int R) const { const int pos = u.aux * 256 + R; const int ne = tab[u.e]; return list[u.e * NT + (pos < ne ? pos : 0)]; }
    __device__ __forceinline__ unsigned a_voff_raw(const pg8::Unit& u, int R, int C, int raw) const { const int pos = u.aux * 256 + R; const int ne = tab[u.e]; int tok = raw >> 2; if (pos >= ne) tok = 0;
        return (unsigned)(tok * (MODE == 2 ? DM / 2 : DM) + C) * 2u; }
    __device__ __forceinline__ unsigned a_soff(const pg8::Unit& u, int h) const { if constexpr (MODE == 1) return (unsigned)((u.pm * 256 + h * 128) * EFF) * 2u; else if constexpr (MODE == 3) return (unsigned)((u.pm * 256 + h * 128) * EFF); else return 0u; }
    __device__ __forceinline__ size_t b_off(const pg8::Unit& u) const {
        if constexpr (MODE == 0) return ((size_t)u.e * 512 + (size_t)u.pn * 256) * DM * 2;
        else if constexpr (MODE == 2) return ((size_t)u.e * 512 + (size_t)u.pn * 256) * DM;
        else if constexpr (MODE == 3) return ((size_t)u.e * DM + (size_t)u.pn * 256) * EFF;
        else return ((size_t)u.e * DM + (size_t)u.pn * 256) * EFF * 2;
    }
};
struct EpiGU {
    static constexpr bool PERM = true; static constexpr int NSTORE = 8; static constexpr bool PEEL = true;
    unsigned char* act; const float* lrstd; const float* bgu;
    __device__ __forceinline__ void operator()(const f32x4 (&acc)[2][2][4][2], const pg8::Unit& u, int wr, int wc, int fr, int fq) const {
        const int r0 = wr * 64 + fr, cl0 = wc * 32 + 8 * fq;
        const float* bg = bgu + u.e * 512 + u.pn * 128 + cl0;
        const f32x4 bg0 = *(const f32x4*)(bg), bg1 = *(const f32x4*)(bg + 4), bu0 = *(const f32x4*)(bg + 256), bu1 = *(const f32x4*)(bg + 260);
        float rsv[2][4];
#pragma unroll
        for (int ai = 0; ai < 2; ++ai)
#pragma unroll
            for (int m = 0; m < 4; ++m) rsv[ai][m] = lrstd[(size_t)u.e * NT + u.aux * 256 + r0 + ai * 128 + m * 16];
#pragma unroll
        for (int ai = 0; ai < 2; ++ai)
#pragma unroll
            for (int m = 0; m < 4; ++m) { const int r = r0 + ai * 128 + m * 16; const float rs = rsv[ai][m] * (1.0f / WGU8_SCALE);
                f32x4 g0 = acc[ai][0][m][0] * rs + bg0, g1 = acc[ai][0][m][1] * rs + bg1, u0 = acc[ai][1][m][0] * rs + bu0, u1 = acc[ai][1][m][1] * rs + bu1;
                float o[8];
#pragma unroll
                for (int j = 0; j < 4; ++j) { const float ga = fminf(g0[j], 7.0f), ua = fminf(fmaxf(u0[j], -7.0f), 7.0f); o[j] = (ua + 1.0f) * ga * fast_sigmoid(1.702f * ga);
                                              const float gb = fminf(g1[j], 7.0f), ub = fminf(fmaxf(u1[j], -7.0f), 7.0f); o[4 + j] = (ub + 1.0f) * gb * fast_sigmoid(1.702f * gb); }
                int w0 = __builtin_amdgcn_cvt_pk_fp8_f32(o[0] * ACT8_SCALE, o[1] * ACT8_SCALE, 0, false); w0 = __builtin_amdgcn_cvt_pk_fp8_f32(o[2] * ACT8_SCALE, o[3] * ACT8_SCALE, w0, true);
                int w1 = __builtin_amdgcn_cvt_pk_fp8_f32(o[4] * ACT8_SCALE, o[5] * ACT8_SCALE, 0, false); w1 = __builtin_amdgcn_cvt_pk_fp8_f32(o[6] * ACT8_SCALE, o[7] * ACT8_SCALE, w1, true);
                *(u32x2*)(act + (size_t)(u.pm * 256 + r) * EFF + u.pn * 128 + cl0) = (u32x2){(unsigned)w0, (unsigned)w1}; }
    }
};
constexpr float Y8_SCALE = 32.0f;
struct EpiDown {
    static constexpr bool PERM = true; static constexpr int NSTORE = 8; static constexpr bool PEEL = true;
    unsigned char* y; const int* list; const float* lgate; const float* bd; const LAS int* tab;
    __device__ __forceinline__ void operator()(const f32x4 (&acc)[2][2][4][2], const pg8::Unit& u, int wr, int wc, int fr, int fq) const {
        const int r0 = wr * 64 + fr, col0 = u.pn * 256 + wc * 64 + fq * 16; const int ne = tab[u.e];
        const float* bp = bd + u.e * DM + col0;
        float gt[2][4]; f32x4 bb[2][2];
#pragma unroll
        for (int ai = 0; ai < 2; ++ai)
#pragma unroll
            for (int m = 0; m < 4; ++m) { const int pos = u.aux * 256 + r0 + ai * 128 + m * 16; gt[ai][m] = lgate[(size_t)u.e * NT + (pos < ne ? pos : 0)]; if (pos >= ne) gt[ai][m] = 0.f; }
#pragma unroll
        for (int bj = 0; bj < 2; ++bj) { bb[bj][0] = *(const f32x4*)(bp + bj * 8); bb[bj][1] = *(const f32x4*)(bp + bj * 8 + 4); }
#pragma unroll
        for (int ai = 0; ai < 2; ++ai) {
#pragma unroll
            for (int m = 0; m < 4; ++m) { unsigned char* rowp = y + (size_t)(u.pm * 256 + r0 + ai * 128 + m * 16) * DM + col0; const float g = gt[ai][m] * Y8_SCALE; u32x4 wv4;
#pragma unroll
                for (int bj = 0; bj < 2; ++bj) { const f32x4 b0 = bb[bj][0], b1 = bb[bj][1];
                    const f32x4 v0 = (acc[ai][bj][m][0] * (1.0f / (WD8_SCALE * ACT8_SCALE)) + b0) * g, v1 = (acc[ai][bj][m][1] * (1.0f / (WD8_SCALE * ACT8_SCALE)) + b1) * g;
                    int w0 = __builtin_amdgcn_cvt_pk_fp8_f32(v0[0], v0[1], 0, false); w0 = __builtin_amdgcn_cvt_pk_fp8_f32(v0[2], v0[3], w0, true);
                    int w1 = __builtin_amdgcn_cvt_pk_fp8_f32(v1[0], v1[1], 0, false); w1 = __builtin_amdgcn_cvt_pk_fp8_f32(v1[2], v1[3], w1, true);
                    if (bj == 0) { wv4.x = (unsigned)w0; wv4.y = (unsigned)w1; } else { wv4.z = (unsigned)w0; wv4.w = (unsigned)w1; } }
                *(u32x4*)rowp = wv4; } }
    }
};
__device__ __forceinline__ void moe_tables(LAS int* tab, const unsigned* cnt, int wv) {
    __syncthreads();
    const int tid_ = tid_from(wv);
    if (tid_ < 64) {
        const int ln = tid_ & 63; const int n = (ln < NEXP) ? (int)__hip_atomic_load(cnt + (ln & 31), RLX_AGENT) : 0; const int nb = (n + 255) >> 8; int incl = nb;
#pragma unroll
        for (int d = 1; d < 32; d <<= 1) { const int v = __shfl_up(incl, d, 64); if (ln >= d) incl += v; }
        if (ln < NEXP) { tab[ln] = n; tab[32 + ln] = incl - nb; }
        if (ln == NEXP - 1) tab[64] = incl; }
    __syncthreads();
    { LAS unsigned char* eb = (LAS unsigned char*)(tab + 80);
      if (tid_ < NEXP) { const int b0 = tab[32 + tid_], b1 = b0 + ((tab[tid_] + 255) >> 8);
          for (int gb = b0; gb < b1; ++gb) eb[gb] = (unsigned char)tid_; } }
    __syncthreads();
}

__device__ __forceinline__ void phase_qkprep(ArgsRef a, int layer, int wv, bool dry) {
    const int tid = tid_from(wv), lane = tid & 63, wave = tid >> 6;
    const int gw = bid_here() * NWAVES + wave, NGW = gdim_here() * NWAVES;
    bf16* proj = (bf16*)(a.ws + WS_PROJ);
    const float* __restrict__ ct = (const float*)(a.ws + WS_ROPE); const float* __restrict__ st = ct + SEQ * 32;
    const int d0 = (lane & 7) * 8, p0 = d0 & 31;
    float gq[8], gk[8];
#pragma unroll
    for (int j = 0; j < 8; ++j) { gq[j] = a.in[I_QG][layer * 64 + d0 + j] * (0.125f * 1.4426950408889634f); gk[j] = a.in[I_KG][layer * 64 + d0 + j]; }
    const bool second = (lane & 4) != 0;
    constexpr int TB = 4;
    for (int t0 = gw * TB; t0 < NT; t0 += NGW * TB) {
        u32x4 w[TB][2]; f32x4 cs[TB][4];
#pragma unroll
        for (int u = 0; u < TB; ++u) { const int t = t0 + u, pos = t & (SEQ - 1);
            w[u][0] = *(const u32x4*)(proj + (size_t)t * NIN + C_Q + lane * 8); w[u][1] = *(const u32x4*)(proj + (size_t)t * NIN + C_Q + 512 + lane * 8);
            cs[u][0] = *(const f32x4*)(ct + pos * 32 + p0); cs[u][1] = *(const f32x4*)(ct + pos * 32 + p0 + 4); cs[u][2] = *(const f32x4*)(st + pos * 32 + p0); cs[u][3] = *(const f32x4*)(st + pos * 32 + p0 + 4); }
#pragma unroll
        for (int u = 0; u < TB; ++u) { const int t = t0 + u;
            float c[8], s[8];
#pragma unroll
            for (int j = 0; j < 4; ++j) { c[j] = cs[u][0][j]; c[4 + j] = cs[u][1][j]; s[j] = cs[u][2][j]; s[4 + j] = cs[u][3][j]; }
#pragma unroll
            for (int i = 0; i < 2; ++i) {
                const u32x4 ww = w[u][i];
                float x[8]; x[0] = bflo(ww.x); x[1] = bfhi(ww.x); x[2] = bflo(ww.y); x[3] = bfhi(ww.y); x[4] = bflo(ww.z); x[5] = bfhi(ww.z); x[6] = bflo(ww.w); x[7] = bfhi(ww.w);
                float ss = 0.f;
#pragma unroll
                for (int j = 0; j < 8; ++j) ss += x[j] * x[j];
                ss += __shfl_xor(ss, 1); ss += __shfl_xor(ss, 2); ss += __shfl_xor(ss, 4);
                const float rs = __builtin_amdgcn_rsqf(ss * (1.0f / 64.0f) + EPS);
                float o[8];
#pragma unroll
                for (int j = 0; j < 8; ++j) { const float yv = x[j] * rs * (i == 0 ? gq[j] : gk[j]); const float pv = __shfl_xor(yv, 4);
                    o[j] = second ? (yv * c[j] + pv * s[j]) : (yv * c[j] - pv * s[j]); }
                u32x4 r; r.x = cvt_pk_bf16(o[0], o[1]); r.y = cvt_pk_bf16(o[2], o[3]); r.z = cvt_pk_bf16(o[4], o[5]); r.w = cvt_pk_bf16(o[6], o[7]);
                if (!dry || o[0] == 12345.678f) *(u32x4*)(proj + (size_t)t * NIN + C_Q + i * 512 + lane * 8) = r;
            } }
    }
}

__device__ __forceinline__ void phase_pool(ArgsRef a, LAS unsigned char* lds, int layer, int wv) {
    const int tid = tid_from(wv), lane = tid & 63, wave = __builtin_amdgcn_readfirstlane(tid >> 6);
    const bf16* proj = (const bf16*)(a.ws + WS_PROJ); bf16* YP = (bf16*)(a.ws + WS_YP); float* SSQPOOL = (float*)(a.ws + WS_SSQPOOL);
    const int g = wave & 3, w = 2 << g, lr = lane & 15, lq = lane >> 4;
    constexpr int US = 72;
    LAS bf16* Uw = (LAS bf16*)(lds + wave * 11520);
    LAS bf16* Xw = (LAS bf16*)(lds + wave * 11520 + 6784);
    const bf16* pw = (const bf16*)(a.ws + WS_SMALL) + SM_POOLW + (size_t)(layer * 4 + g) * 4096;
    bf16x8 bw[4][2]; float psc[4];
#pragma unroll
    for (int et = 0; et < 4; ++et) {
#pragma unroll
        for (int ks = 0; ks < 2; ++ks) bw[et][ks] = *(const bf16x8*)(pw + (et * 16 + lr) * 64 + ks * 32 + lq * 8);
        psc[et] = a.in[I_POOLSC][layer * 256 + g * 64 + et * 16 + lr]; }
    __syncthreads();
    const int nstreams = gdim_here() * 2;
    u32x4 pre[6];
#define POOL_FETCH(TK) do { const int t0_ = (TK) * 32, s0_ = t0_ & (SEQ - 1); _Pragma("unroll") for (int j = 0; j < 6; ++j) { const int id = lane + 64 * j; const int row = id >> 3, c8 = (id & 7) * 8; \
            pre[j] = (u32x4){0u, 0u, 0u, 0u}; if (id < 47 * 8 && s0_ - 15 + row >= 0) pre[j] = __builtin_nontemporal_load((const u32x4*)(proj + (size_t)(t0_ - 15 + row) * NPJ + C_POOL + g * 64 + c8)); } } while (0)
    { const int tk0 = bid_here() * 2 + (wave >> 2); if (tk0 < NT / 32) POOL_FETCH(tk0); }
    for (int tk = bid_here() * 2 + (wave >> 2); tk < NT / 32; tk += nstreams) {
        const int t0 = tk * 32, s0 = t0 & (SEQ - 1);
#pragma unroll
        for (int j = 0; j < 6; ++j) { const int id = lane + 64 * j;
            if (id < 47 * 8) { const int row = id >> 3, c8 = (id & 7) * 8; *(LAS u32x4*)(Uw + row * US + c8) = pre[j]; } }
        if (tk + nstreams < NT / 32) POOL_FETCH(tk + nstreams);
        LDS_WAIT(); asm volatile("" ::: "memory");
        { float u[47], pl[32];
#pragma unroll
          for (int r = 0; r < 47; ++r) u[r] = bf2f(Uw[r * US + lane]);
#define POOL_RUN(W) do { float sum = 0.f; _Pragma("unroll") for (int j = 1; j < (W); ++j) sum += u[15 - j]; \
              _Pragma("unroll") for (int tl = 0; tl < 32; ++tl) { const float cur = u[15 + tl]; sum += cur; const int cnt = min((W), s0 + tl + 1); \
                  pl[tl] = sum * __builtin_amdgcn_rcpf((float)cnt) - cur; sum -= u[15 + tl - (W) + 1]; } } while (0)
          if (g == 0) POOL_RUN(2); else if (g == 1) POOL_RUN(4); else if (g == 2) POOL_RUN(8); else POOL_RUN(16);
#undef POOL_RUN
#pragma unroll
          for (int tl = 0; tl < 32; ++tl) Xw[tl * US + lane] = f2bf(pl[tl]); }
        LDS_WAIT(); asm volatile("" ::: "memory");
        f32x4 acc[2][4];
#pragma unroll
        for (int rt = 0; rt < 2; ++rt) { const bf16x8 a0 = *(const LAS bf16x8*)(Xw + (rt * 16 + lr) * US + lq * 8), a1 = *(const LAS bf16x8*)(Xw + (rt * 16 + lr) * US + 32 + lq * 8);
#pragma unroll
            for (int et = 0; et < 4; ++et) { acc[rt][et] = __builtin_amdgcn_mfma_f32_16x16x32_bf16(a0, bw[et][0], (f32x4){0.f, 0.f, 0.f, 0.f}, 0, 0, 0); acc[rt][et] = __builtin_amdgcn_mfma_f32_16x16x32_bf16(a1, bw[et][1], acc[rt][et], 0, 0, 0); } }
#pragma unroll
        for (int rt = 0; rt < 2; ++rt)
#pragma unroll
            for (int reg = 0; reg < 4; ++reg) { const int tl = rt * 16 + lq * 4 + reg; float s = 0.f;
#pragma unroll
                for (int et = 0; et < 4; ++et) { const float y = acc[rt][et][reg] * psc[et]; s += y * y; Uw[tl * 64 + et * 16 + lr] = f2bf(y); }
                s = row16_sum(s);
                if (lr == 0) SSQPOOL[(size_t)(t0 + tl) * 4 + g] = s; }
        LDS_WAIT(); asm volatile("" ::: "memory");
#pragma unroll
        for (int j = 0; j < 4; ++j) { const int id = lane + 64 * j, row = id >> 3, c8 = (id & 7) * 8;
            *(u32x4*)(YP + (size_t)(t0 + row) * 256 + g * 64 + c8) = *(const LAS u32x4*)(Uw + row * 64 + c8); }
        LDS_WAIT(); asm volatile("" ::: "memory");
    }
}

__device__ __forceinline__ void phase_lru_a(ArgsRef a, LAS unsigned char* lds, int layer, int wv) {
    const int tid = tid_from(wv), lane = tid & 63, wave = __builtin_amdgcn_readfirstlane(tid >> 6);
    const bf16* proj = (const bf16*)(a.ws + WS_PROJ);
    bf16* HL = (bf16*)(a.ws + WS_HL); bf16* PL = (bf16*)(a.ws + WS_PL);
    float* AGGH = (float*)(a.ws + WS_AGGH); float* AGGP = (float*)(a.ws + WS_AGGP);
    const int n = wave & 3, lr = lane & 15, lq = lane >> 4;
    constexpr int US = 72;
    LAS bf16* Uw = (LAS bf16*)(lds + wave * 13824);
    LAS bf16* Xw = (LAS bf16*)(lds + wave * 13824 + 5120);
    LAS bf16* Pw = (LAS bf16*)(lds + wave * 13824 + 9728);
    const int chl = n * 64 + lane;
    const float cw0 = a.in[I_CONVW][(layer * 4 + 0) * 256 + chl], cw1 = a.in[I_CONVW][(layer * 4 + 1) * 256 + chl], cw2 = a.in[I_CONVW][(layer * 4 + 2) * 256 + chl], cw3 = a.in[I_CONVW][(layer * 4 + 3) * 256 + chl];
    const float cb = a.in[I_CONVB][layer * 256 + chl];
    const bf16* wa = (const bf16*)(a.ws + WS_SMALL) + SM_WA + (size_t)(layer * 4 + n) * 4096;
    const bf16* wx = (const bf16*)(a.ws + WS_SMALL) + SM_WX + (size_t)(layer * 4 + n) * 4096;
    bf16x8 ba[4][2], bx[4][2]; float bav[4], bxv[4], sp[4];
#pragma unroll
    for (int et = 0; et < 4; ++et) {
#pragma unroll
        for (int ks = 0; ks < 2; ++ks) { const int wo = (et * 16 + lr) * 64 + ks * 32 + lq * 8; ba[et][ks] = *(const bf16x8*)(wa + wo); bx[et][ks] = *(const bf16x8*)(wx + wo); }
        const int chn = layer * 256 + n * 64 + et * 16 + lr; bav[et] = a.in[I_BA][chn]; bxv[et] = a.in[I_BX][chn]; sp[et] = log1pf(expf(-a.in[I_LAM][chn])); }
    __syncthreads();
    const int nstreams = gdim_here() * 2;
    u32x4 pre[5];
#define LRU_FETCH(CK) do { const int t0_ = (CK) * LRU_CH, s0_ = t0_ & (SEQ - 1); _Pragma("unroll") for (int j = 0; j < 5; ++j) { const int id = lane + 64 * j; const int row = id >> 3, c8 = (id & 7) * 8; \
            pre[j] = (u32x4){0u, 0u, 0u, 0u}; if (id < 35 * 8 && s0_ - 3 + row >= 0) pre[j] = __builtin_nontemporal_load((const u32x4*)(proj + (size_t)(t0_ - 3 + row) * NPJ + C_LRU + n * 64 + c8)); } } while (0)
    { const int ck0 = bid_here() * 2 + (wave >> 2); if (ck0 < NT / LRU_CH) LRU_FETCH(ck0); }
    for (int ck = bid_here() * 2 + (wave >> 2); ck < NT / LRU_CH; ck += nstreams) {
        const int t0 = ck * LRU_CH, s0 = t0 & (SEQ - 1);
#pragma unroll
        for (int j = 0; j < 5; ++j) { const int id = lane + 64 * j;
            if (id < 35 * 8) { const int row = id >> 3, c8 = (id & 7) * 8; *(LAS u32x4*)(Uw + row * US + c8) = pre[j]; } }
        if (ck + nstreams < NT / LRU_CH) LRU_FETCH(ck + nstreams);
        LDS_WAIT(); asm volatile("" ::: "memory");
        { float u[LRU_CH + 3];
#pragma unroll
          for (int r = 0; r < LRU_CH + 3; ++r) u[r] = bf2f(Uw[r * US + lane]);
#pragma unroll
          for (int tl = 0; tl < LRU_CH; ++tl) { const float xc = cb + cw0 * u[tl] + cw1 * u[tl + 1] + cw2 * u[tl + 2] + cw3 * u[tl + 3]; Xw[tl * US + lane] = f2bf(xc); } }
        LDS_WAIT(); asm volatile("" ::: "memory");
        f32x4 ca[2][4], cx[2][4];
#pragma unroll
        for (int rt = 0; rt < 2; ++rt) { const bf16x8 a0 = *(const LAS bf16x8*)(Xw + (rt * 16 + lr) * US + lq * 8), a1 = *(const LAS bf16x8*)(Xw + (rt * 16 + lr) * US + 32 + lq * 8);
#pragma unroll
            for (int et = 0; et < 4; ++et) { ca[rt][et] = __builtin_amdgcn_mfma_f32_16x16x32_bf16(a0, ba[et][0], (f32x4){0.f, 0.f, 0.f, 0.f}, 0, 0, 0); ca[rt][et] = __builtin_amdgcn_mfma_f32_16x16x32_bf16(a1, ba[et][1], ca[rt][et], 0, 0, 0);
                                              cx[rt][et] = __builtin_amdgcn_mfma_f32_16x16x32_bf16(a0, bx[et][0], (f32x4){0.f, 0.f, 0.f, 0.f}, 0, 0, 0); cx[rt][et] = __builtin_amdgcn_mfma_f32_16x16x32_bf16(a1, bx[et][1], cx[rt][et], 0, 0, 0); } }
        float xv[4][2][4];
#pragma unroll
        for (int et = 0; et < 4; ++et)
#pragma unroll
            for (int rt = 0; rt < 2; ++rt)
#pragma unroll
                for (int reg = 0; reg < 4; ++reg) xv[et][rt][reg] = bf2f(Xw[(rt * 16 + lq * 4 + reg) * US + et * 16 + lr]);
#pragma unroll
        for (int et = 0; et < 4; ++et) {
            float Pl[2][4], Hl[2][4], At[2], Ht[2];
#pragma unroll
            for (int rt = 0; rt < 2; ++rt) { float P = 1.f, H = 0.f;
#pragma unroll
                for (int reg = 0; reg < 4; ++reg) { const int tl = rt * 16 + lq * 4 + reg;
                    const float r = fast_sigmoid(ca[rt][et][reg] + bav[et]), ig = fast_sigmoid(cx[rt][et][reg] + bxv[et]);
                    const float log_a = -8.0f * r * sp[et]; const float av = fast_exp(log_a);
                    float mult = __builtin_amdgcn_sqrtf(fmaxf(1.0f - av * av, 0.f)); if (s0 + tl == 0) mult = 1.0f;
                    const float bv = mult * ig * xv[et][rt][reg];
                    H = av * H + bv; P *= av; Pl[rt][reg] = P; Hl[rt][reg] = H; }
                At[rt] = P; Ht[rt] = H; }
            float Ai[2], Hi[2];
#pragma unroll
            for (int rt = 0; rt < 2; ++rt) { float A = At[rt], H = Ht[rt];
                { const float Ap = rows_up16(A, lq), Hp = rows_up16(H, lq); if (lq >= 1) { H = A * Hp + H; A = A * Ap; } }
                { const float Ap = rows_up32(A), Hp = rows_up32(H); if (lq >= 2) { H = A * Hp + H; A = A * Ap; } }
                Ai[rt] = A; Hi[rt] = H; }
            float Ac[2], Hc[2];
#pragma unroll
            for (int rt = 0; rt < 2; ++rt) { const float Ap = rows_up16(Ai[rt], lq), Hp = rows_up16(Hi[rt], lq); Ac[rt] = (lq >= 1) ? Ap : 1.f; Hc[rt] = (lq >= 1) ? Hp : 0.f; }
            const float A0t = row3_bcast(Ai[0]), H0t = row3_bcast(Hi[0]);
            Hc[1] = Ac[1] * H0t + Hc[1]; Ac[1] = Ac[1] * A0t;
#pragma unroll
            for (int rt = 0; rt < 2; ++rt)
#pragma unroll
                for (int reg = 0; reg < 4; ++reg) { const int tl = rt * 16 + lq * 4 + reg;
                    Uw[tl * 64 + et * 16 + lr] = f2bf(Hl[rt][reg] + Pl[rt][reg] * Hc[rt]); Pw[tl * 64 + et * 16 + lr] = f2bf(Pl[rt][reg] * Ac[rt]); }
            if (lq == 3) { const size_t o = (size_t)ck * 256 + n * 64 + et * 16 + lr;
                AGGP[o] = Ai[1] * A0t; AGGH[o] = Ai[1] * H0t + Hi[1]; }
        }
        LDS_WAIT(); asm volatile("" ::: "memory");
#pragma unroll
        for (int j = 0; j < 4; ++j) { const int id = lane + 64 * j, row = id >> 3, c8 = (id & 7) * 8;
            *(u32x4*)(HL + (size_t)(t0 + row) * 256 + n * 64 + c8) = *(const LAS u32x4*)(Uw + row * 64 + c8);
            *(u32x4*)(PL + (size_t)(t0 + row) * 256 + n * 64 + c8) = *(const LAS u32x4*)(Pw + row * 64 + c8); }
        LDS_WAIT(); asm volatile("" ::: "memory");
    }
}
__device__ __forceinline__ void phase_lru_b(ArgsRef a, int wv) {
    const float* __restrict__ AGGH = (const float*)(a.ws + WS_AGGH); const float* __restrict__ AGGP = (const float*)(a.ws + WS_AGGP); float* __restrict__ CARRY = (float*)(a.ws + WS_CARRY);
    const int tid_ = tid_from(wv), seg = tid_ & 31;
    for (int ch = bid_here() * 16 + (tid_ >> 5); ch < NB * 256; ch += gdim_here() * 16) { const int b = ch >> 8, c = ch & 255;
        float pp[4], hh[4];
#pragma unroll
        for (int k = 0; k < 4; ++k) { const size_t o = (size_t)(b * LRU_NCH + seg * 4 + k) * 256 + c; pp[k] = AGGP[o]; hh[k] = AGGH[o]; }
        float A = 1.f, H = 0.f;
#pragma unroll
        for (int k = 0; k < 4; ++k) { H = pp[k] * H + hh[k]; A *= pp[k]; }
#pragma unroll
        for (int d = 1; d < 32; d <<= 1) { const float Ap = __shfl_up(A, d, 32), Hp = __shfl_up(H, d, 32); if (seg >= d) { H = A * Hp + H; A = A * Ap; } }
        float carry = __shfl_up(H, 1, 32); if (seg == 0) carry = 0.f;
#pragma unroll
        for (int k = 0; k < 4; ++k) { const size_t o = (size_t)(b * LRU_NCH + seg * 4 + k) * 256 + c; CARRY[o] = carry; carry = pp[k] * carry + hh[k]; } }
}
typedef short v4i16_t __attribute__((ext_vector_type(4)));
struct AttnUnit { int h, n, r, dl, g, first; size_t rowb; };
__device__ __forceinline__ AttnUnit attn_unit(int bh, int hf, int i) {
    AttnUnit u; u.h = bh & 7; u.rowb = (size_t)(bh >> 3) * SEQ;
    if (i < 16) { u.g = 0; u.dl = 1; u.r = 0; u.n = 16 * hf + i; u.first = (i == 0); }
    else if (i < 32) { const int j = i - 16; u.g = 1; u.dl = 4; u.r = 2 * hf + (j >> 3); u.n = j & 7; u.first = (u.n == 0); }
    else { const int j = i - 32; u.g = 2; u.dl = 16; u.r = 8 * hf + (j >> 1); u.n = j & 1; u.first = (u.n == 0); }
    return u;
}
__device__ __forceinline__ void attn_dma_chunk(const __amdgpu_buffer_rsrc_t rs, LAS unsigned char* lds, const AttnUnit& u, int chunk, int slot, int wave, int lane) {
    const int csc = (lane & 7) ^ ((lane >> 3) & 7);
#pragma unroll
    for (int q = 0; q < 2; ++q) { const int pc = wave + 8 * q, l = 128 * chunk + 8 * pc + (lane >> 3);
        const unsigned rowoff = ((unsigned)(u.rowb * 8 + u.h * SEQ) + (unsigned)(l * u.dl + u.r)) * 128u + (unsigned)(csc * 16);
        const unsigned srcK = rowoff + (unsigned)(NT * 512 * 2), srcV = rowoff + (unsigned)(NT * 512 * 4);
        LAS unsigned char* dst = lds + slot * 32768 + pc * 1024;
        __builtin_amdgcn_raw_ptr_buffer_load_lds(rs, (LAS void*)dst, 16, srcK, 0, 0, 0);
        __builtin_amdgcn_raw_ptr_buffer_load_lds(rs, (LAS void*)(dst + 16384), 16, srcV, 0, 0, 0); }
}
__device__ __forceinline__ void phase_attn(ArgsRef a, LAS unsigned char* lds, int wv) {
    const int tid = tid_from(wv), lane = tid & 63, wave = __builtin_amdgcn_readfirstlane(tid >> 6);
    const bf16* proj = (const bf16*)(a.ws + WS_HM);
    bf16* PNUM = (bf16*)(a.ws + WS_PNUM); float* PDEN = (float*)(a.ws + WS_PDEN); float* PMAX = (float*)(a.ws + WS_PMAX);
    const __amdgpu_buffer_rsrc_t rs = __builtin_amdgcn_make_buffer_rsrc((void*)proj, 0, 0x7fffffff, 0x00020000);
    const int lr = lane & 15, lq = lane >> 4, qi0 = 16 * wave, G = gdim_here();
    float zz_ = 0.f; asm volatile("" : "+v"(zz_));
    const int kc0 = ((0 + lq) ^ (lr & 7)) * 16, kc1 = ((4 + lq) ^ (lr & 7)) * 16;
    const int q4 = (lane & 15) >> 2, p4 = lane & 3, vsw = (4 * lq + q4) & 7;
    unsigned chv[4];
#pragma unroll
    for (int dt = 0; dt < 4; ++dt) chv[dt] = (unsigned)(((2 * dt + (p4 >> 1)) ^ vsw) * 16 + (p4 & 1) * 8);
    const bool xo = (G == 256);
    const int pair = xo ? ((int)(bid_here() & 7) * 16 + (int)(bid_here() >> 4)) : (int)(bid_here() >> 1), hf = xo ? (int)((bid_here() >> 3) & 1) : (int)(bid_here() & 1), npairs = G >> 1;
    __syncthreads();
    { unsigned z0 = 0u; asm volatile("" : "+v"(z0));
      for (int z = tid; z < RING_BYTES / 16; z += NTHR) ((LAS u32x4*)lds)[z] = (u32x4){z0, z0, z0, z0}; }
    __syncthreads();
    const int total = (pair < 128 && bid_here() < 2 * npairs) ? ((128 - pair + npairs - 1) / npairs) * 48 : 0;
    AttnUnit cu = attn_unit(pair < 128 ? pair : 0, hf, 0);
    const int off = (total > 0 && cu.n > 0) ? 1 : 0;
#define ATT_UNIT_AT(k) attn_unit(pair + ((k) / 48) * npairs, hf, (k) % 48)
#define ATT_QLOAD(U, Q0, Q1) do { const size_t qrow_ = (U).rowb * 8 + (size_t)(U).h * SEQ + (size_t)(128 * (U).n + qi0 + lr) * (U).dl + (U).r; \
        Q0 = *(const bf16x8*)(proj + qrow_ * 64 + lq * 8); Q1 = *(const bf16x8*)(proj + qrow_ * 64 + 32 + lq * 8); } while (0)
    bf16x8 qf0, qf1, nq0, nq1;
    if (total > 0) { if (off) attn_dma_chunk(rs, lds, cu, cu.n - 1, 0, wave, lane);
        attn_dma_chunk(rs, lds, cu, cu.n, off & 3, wave, lane); ATT_QLOAD(cu, qf0, qf1);
        if (total > 1) { const AttnUnit u1 = ATT_UNIT_AT(1); attn_dma_chunk(rs, lds, u1, u1.n, (1 + off) & 3, wave, lane); } }
    nq0 = qf0; nq1 = qf1;
    asm volatile("s_waitcnt vmcnt(0)" ::: "memory");
    int idx = 0;
    while (idx < total) {
        __builtin_amdgcn_s_barrier(); asm volatile("" ::: "memory");
        const int csc = (idx + off) & 3, csp = cu.first ? ((cu.n > 0) ? 0 : csc) : ((idx + off + 3) & 3);
        AttnUnit nu = cu;
        if (idx + 1 < total) { nu = ATT_UNIT_AT(idx + 1); ATT_QLOAD(nu, nq0, nq1); }
        if (idx + 2 < total) { const AttnUnit u2 = ATT_UNIT_AT(idx + 2); attn_dma_chunk(rs, lds, u2, u2.n, (idx + 2 + off) & 3, wave, lane); }
        ++idx;
        f32x4 scv[9];
        { bf16x8 kf[9][2];
#pragma unroll
          for (int t = 0; t < 9; ++t) { const int wt = wave + t; const LAS unsigned char* Kt = lds + ((wt >= 8) ? csc : csp) * 32768 + ((16 * wt) & 127) * 128 + lr * 128;
              kf[t][0] = *(const LAS bf16x8*)(Kt + kc0); kf[t][1] = *(const LAS bf16x8*)(Kt + kc1); }
          __builtin_amdgcn_sched_barrier(0);
#pragma unroll
          for (int t = 0; t < 9; ++t) scv[t] = __builtin_amdgcn_mfma_f32_16x16x32_bf16(kf[t][0], qf0, (f32x4){0.f, 0.f, 0.f, 0.f}, 0, 0, 0);
#pragma unroll
          for (int t = 0; t < 9; ++t) scv[t] = __builtin_amdgcn_mfma_f32_16x16x32_bf16(kf[t][1], qf1, scv[t], 0, 0, 0); }
#pragma unroll
        for (int reg = 0; reg < 4; ++reg) { if (4 * lq + reg < lr) scv[0][reg] = -1e30f; if (4 * lq + reg > lr) scv[8][reg] = -1e30f; }
        if (cu.n == 0) {
#pragma unroll
            for (int t = 0; t < 8; ++t)
#pragma unroll
                for (int reg = 0; reg < 4; ++reg) { if (qi0 + 16 * t + 4 * lq + reg < 128) scv[t][reg] = -1e30f; } }
        float mx = -1e30f;
#pragma unroll
        for (int t = 0; t < 9; ++t)
#pragma unroll
            for (int reg = 0; reg < 4; ++reg) mx = fmaxf(mx, scv[t][reg]);
        mx = xmax32(xmax16(mx));
#define ATT_EXP_PAIR(PI) do { _Pragma("unroll") for (int tt_ = 2 * (PI); tt_ < 2 * (PI) + 2 && tt_ < 9; ++tt_) _Pragma("unroll") for (int reg = 0; reg < 4; ++reg) scv[tt_][reg] = __builtin_amdgcn_exp2f(scv[tt_][reg] - mx); } while (0)
        ATT_EXP_PAIR(0);
        f32x4 oc[4], den = (f32x4){zz_, zz_, zz_, zz_};
        const bf16x8 ones = __builtin_bit_cast(bf16x8, (u32x4){0x3f803f80u, 0x3f803f80u, 0x3f803f80u, 0x3f803f80u});
#pragma unroll
        for (int dt = 0; dt < 4; ++dt) oc[dt] = (f32x4){zz_, zz_, zz_, zz_};
        v4i16_t rv[2][2][4];
#define ATT_VISSUE(PI, B) do { const int t0_ = 2 * (PI), t1_ = (2 * (PI) + 1 < 9) ? 2 * (PI) + 1 : 8; const int w0_ = wave + t0_, w1_ = wave + t1_; \
            const LAS unsigned char* V0_ = lds + ((w0_ >= 8) ? csc : csp) * 32768 + 16384 + (((16 * w0_) & 127) + 4 * lq + q4) * 128; \
            const LAS unsigned char* V1_ = lds + ((w1_ >= 8) ? csc : csp) * 32768 + 16384 + (((16 * w1_) & 127) + 4 * lq + q4) * 128; \
            const unsigned va0_ = (unsigned)(unsigned long)V0_, va1_ = (unsigned)(unsigned long)V1_; \
            _Pragma("unroll") for (int dt = 0; dt < 4; ++dt) { asm volatile("ds_read_b64_tr_b16 %0, %1" : "=&v"(rv[B][0][dt]) : "v"(va0_ + chv[dt]) : "memory"); asm volatile("ds_read_b64_tr_b16 %0, %1" : "=&v"(rv[B][1][dt]) : "v"(va1_ + chv[dt]) : "memory"); } } while (0)
        ATT_VISSUE(0, 0);
#pragma unroll
        for (int pi = 0; pi < 5; ++pi) { const int t0 = 2 * pi, t1 = (2 * pi + 1 < 9) ? 2 * pi + 1 : 8; const int B = pi & 1;
            u32x4 pw; pw.x = cvt_pk_bf16(scv[t0][0], scv[t0][1]); pw.y = cvt_pk_bf16(scv[t0][2], scv[t0][3]);
            if (2 * pi + 1 < 9) { pw.z = cvt_pk_bf16(scv[t1][0], scv[t1][1]); pw.w = cvt_pk_bf16(scv[t1][2], scv[t1][3]); } else { pw.z = 0u; pw.w = 0u; }
            const bf16x8 pf = __builtin_bit_cast(bf16x8, pw);
            if (pi < 4) { ATT_VISSUE(pi + 1, (pi + 1) & 1);
                asm volatile("s_waitcnt lgkmcnt(8)" : "+v"(rv[B][0][0]), "+v"(rv[B][0][1]), "+v"(rv[B][0][2]), "+v"(rv[B][0][3]), "+v"(rv[B][1][0]), "+v"(rv[B][1][1]), "+v"(rv[B][1][2]), "+v"(rv[B][1][3]) :: "memory"); }
            else asm volatile("s_waitcnt lgkmcnt(0)" : "+v"(rv[B][0][0]), "+v"(rv[B][0][1]), "+v"(rv[B][0][2]), "+v"(rv[B][0][3]), "+v"(rv[B][1][0]), "+v"(rv[B][1][1]), "+v"(rv[B][1][2]), "+v"(rv[B][1][3]) :: "memory");
#pragma unroll
            for (int dt = 0; dt < 4; ++dt) { const bf16x8 vf = (bf16x8){rv[B][0][dt][0], rv[B][0][dt][1], rv[B][0][dt][2], rv[B][0][dt][3], rv[B][1][dt][0], rv[B][1][dt][1], rv[B][1][dt][2], rv[B][1][dt][3]};
                oc[dt] = __builtin_amdgcn_mfma_f32_16x16x32_bf16(vf, pf, oc[dt], 0, 0, 0); }
            den = __builtin_amdgcn_mfma_f32_16x16x32_bf16(ones, pf, den, 0, 0, 0);
            if (pi < 4) { ATT_EXP_PAIR(pi + 1);
#pragma unroll
                for (int q = 0; q < 4; ++q) { __builtin_amdgcn_sched_group_barrier(0x8, 1, 0); __builtin_amdgcn_sched_group_barrier(0x2, 4, 0); }
                __builtin_amdgcn_sched_group_barrier(0x8, 1, 0); } }
#undef ATT_VISSUE
#undef ATT_EXP_PAIR
        asm volatile("s_waitcnt vmcnt(4)" ::: "memory");
        { LAS unsigned char* stg = lds + OST_OFF + wave * 2048;
#pragma unroll
          for (int dt = 0; dt < 4; ++dt) { u32x2 w; w.x = cvt_pk_bf16(oc[dt][0], oc[dt][1]); w.y = cvt_pk_bf16(oc[dt][2], oc[dt][3]);
              *(LAS u32x2*)(stg + lr * 128 + (((2 * dt + (lq >> 1)) ^ (lr & 7)) << 4) + (lq & 1) * 8) = w; }
          LDS_WAIT(); asm volatile("" ::: "memory");
#pragma unroll
          for (int i = 0; i < 2; ++i) { const int qq = i * 8 + (lane >> 3), c8 = lane & 7; const u32x4 w = *(const LAS u32x4*)(stg + qq * 128 + ((c8 ^ (qq & 7)) << 4));
              const size_t tok = cu.rowb + (size_t)(128 * cu.n + qi0 + qq) * cu.dl + cu.r;
              *(u32x4*)(PNUM + ((size_t)cu.g * NT + tok) * 512 + cu.h * 64 + c8 * 8) = w; }
          LDS_WAIT(); asm volatile("" ::: "memory"); }
        if (lq == 0) { const size_t tok = cu.rowb + (size_t)(128 * cu.n + qi0 + lr) * cu.dl + cu.r; PDEN[((size_t)cu.g * NT + tok) * 8 + cu.h] = den[0]; PMAX[((size_t)cu.g * NT + tok) * 8 + cu.h] = mx; }
        cu = nu; qf0 = nq0; qf1 = nq1;
    }
#undef ATT_UNIT_AT
#undef ATT_QLOAD
}
__device__ __forceinline__ void phase_finalize(ArgsRef a, int wv, const bool f8) {
    const int tid = tid_from(wv), lane = tid & 63, wave = tid >> 6;
    const int gw = bid_here() * NWAVES + wave, NGW = gdim_here() * NWAVES;
    const bf16* __restrict__ proj = (const bf16*)(a.ws + WS_PROJ); unsigned char* __restrict__ mix = a.ws + WS_MIX;
    bf16* __restrict__ mixb = (bf16*)(a.ws + WS_MIX);
    const bf16* __restrict__ YP = (const bf16*)(a.ws + WS_YP); const float* __restrict__ SSQPOOL = (const float*)(a.ws + WS_SSQPOOL);
    const bf16* __restrict__ HL = (const bf16*)(a.ws + WS_HL); const bf16* __restrict__ PL = (const bf16*)(a.ws + WS_PL); const float* __restrict__ CARRY = (const float*)(a.ws + WS_CARRY);
    const bf16* __restrict__ PNUM = (const bf16*)(a.ws + WS_PNUM); const float* __restrict__ PDEN = (const float*)(a.ws + WS_PDEN); const float* __restrict__ PMAX = (const float*)(a.ws + WS_PMAX);
    const int hd = lane >> 3;
    for (int t = gw; t < NT; t += NGW) {
        const u32x2 ypw = __builtin_nontemporal_load((const u32x2*)(YP + (size_t)t * 256 + lane * 4)); const f32x4 sq = *(const f32x4*)(SSQPOOL + (size_t)t * 4);
        const u32x2 hw = __builtin_nontemporal_load((const u32x2*)(HL + (size_t)t * 256 + lane * 4)), pw = __builtin_nontemporal_load((const u32x2*)(PL + (size_t)t * 256 + lane * 4)), gwd = __builtin_nontemporal_load((const u32x2*)(proj + (size_t)t * NPJ + C_GATE + lane * 4));
        const f32x4 cr = *(const f32x4*)(CARRY + (size_t)(t / LRU_CH) * 256 + lane * 4);
        float m[3], dn[3]; u32x4 nw[3];
#pragma unroll
        for (int g = 0; g < 3; ++g) { m[g] = PMAX[((size_t)g * NT + t) * 8 + hd]; dn[g] = PDEN[((size_t)g * NT + t) * 8 + hd]; nw[g] = __builtin_nontemporal_load((const u32x4*)(PNUM + ((size_t)g * NT + t) * 512 + lane * 8)); }
        { const float rs = __builtin_amdgcn_rsqf(((sq[0] + sq[1]) + (sq[2] + sq[3])) * (1.0f / 256.0f) + EPS);
          if (f8) { int o = __builtin_amdgcn_cvt_pk_fp8_f32(bflo(ypw.x) * rs, bfhi(ypw.x) * rs, 0, false); o = __builtin_amdgcn_cvt_pk_fp8_f32(bflo(ypw.y) * rs, bfhi(ypw.y) * rs, o, true);
              *(unsigned*)(mix + (size_t)t * DM + lane * 4) = (unsigned)o; }
          else { u32x2 o; o.x = cvt_pk_bf16(bflo(ypw.x) * rs, bfhi(ypw.x) * rs); o.y = cvt_pk_bf16(bflo(ypw.y) * rs, bfhi(ypw.y) * rs); *(u32x2*)(mixb + (size_t)t * DM + lane * 4) = o; } }
        { float h[4] = {bflo(hw.x) + bflo(pw.x) * cr[0], bfhi(hw.x) + bfhi(pw.x) * cr[1], bflo(hw.y) + bflo(pw.y) * cr[2], bfhi(hw.y) + bfhi(pw.y) * cr[3]};
          const float gt[4] = {bflo(gwd.x), bfhi(gwd.x), bflo(gwd.y), bfhi(gwd.y)};
          float s = 0.f;
#pragma unroll
          for (int j = 0; j < 4; ++j) { h[j] *= gelu_tanh(gt[j]); s += h[j] * h[j]; }
          s = wave_sum(s); const float rs = __builtin_amdgcn_rsqf(s * (1.0f / 256.0f) + EPS);
          if (f8) { int o = __builtin_amdgcn_cvt_pk_fp8_f32(h[0] * rs, h[1] * rs, 0, false); o = __builtin_amdgcn_cvt_pk_fp8_f32(h[2] * rs, h[3] * rs, o, true);
              *(unsigned*)(mix + (size_t)t * DM + 256 + lane * 4) = (unsigned)o; }
          else { u32x2 o; o.x = cvt_pk_bf16(h[0] * rs, h[1] * rs); o.y = cvt_pk_bf16(h[2] * rs, h[3] * rs); *(u32x2*)(mixb + (size_t)t * DM + 256 + lane * 4) = o; } }
        { const float mr = fmaxf(fmaxf(m[0], m[1]), m[2]);
          float o[8] = {0.f, 0.f, 0.f, 0.f, 0.f, 0.f, 0.f, 0.f}; float den = 0.f;
#pragma unroll
          for (int g = 0; g < 3; ++g) { const float wg = __builtin_amdgcn_exp2f(m[g] - mr); den += wg * dn[g];
              o[0] += wg * bflo(nw[g].x); o[1] += wg * bfhi(nw[g].x); o[2] += wg * bflo(nw[g].y); o[3] += wg * bfhi(nw[g].y); o[4] += wg * bflo(nw[g].z); o[5] += wg * bfhi(nw[g].z); o[6] += wg * bflo(nw[g].w); o[7] += wg * bfhi(nw[g].w); }
          const float inv = 1.0f / den; float s = 0.f;
#pragma unroll
          for (int j = 0; j < 8; ++j) { o[j] *= inv; s += o[j] * o[j]; }
          s = wave_sum(s); const float rs = __builtin_amdgcn_rsqf(s * (1.0f / 512.0f) + EPS);
          if (f8) { int w0 = __builtin_amdgcn_cvt_pk_fp8_f32(o[0] * rs, o[1] * rs, 0, false); w0 = __builtin_amdgcn_cvt_pk_fp8_f32(o[2] * rs, o[3] * rs, w0, true);
              int w1 = __builtin_amdgcn_cvt_pk_fp8_f32(o[4] * rs, o[5] * rs, 0, false); w1 = __builtin_amdgcn_cvt_pk_fp8_f32(o[6] * rs, o[7] * rs, w1, true);
              *(u32x2*)(mix + (size_t)t * DM + 512 + lane * 8) = (u32x2){(unsigned)w0, (unsigned)w1}; }
          else { u32x4 wv4; wv4.x = cvt_pk_bf16(o[0] * rs, o[1] * rs); wv4.y = cvt_pk_bf16(o[2] * rs, o[3] * rs); wv4.z = cvt_pk_bf16(o[4] * rs, o[5] * rs); wv4.w = cvt_pk_bf16(o[6] * rs, o[7] * rs);
              *(u32x4*)(mixb + (size_t)t * DM + 512 + lane * 8) = wv4; } }
    }
}

__device__ __forceinline__ void phase_router(ArgsRef a, LAS unsigned char* lds, int layer, int wv, bool alloc) {
    const int tid = tid_from(wv), lane = tid & 63, wave = __builtin_amdgcn_readfirstlane(tid >> 6);
    const bf16* xb = (const bf16*)(a.ws + WS_XB); const bf16* wr = (const bf16*)(a.ws + WS_SMALL) + SM_WR + (size_t)layer * NEXP * DM;
    const float* ssqp = (const float*)(a.ws + WS_SSQP); const float* rbias = a.in[I_BR] + layer * NEXP;
    int* LIST = (int*)(a.ws + WS_LIST); float* LRSTD = (float*)(a.ws + WS_LRSTD); float* LGATE = (float*)(a.ws + WS_LGATE2); int* TSEL = (int*)(a.ws + WS_TSEL);
    unsigned* cnt = (unsigned*)(a.ws + WS_CTL) + CW_CNT + layer * NEXP;
    float zr_ = 0.f; asm volatile("" : "+v"(zr_));
    LAS float* LG = (LAS float*)lds + wave * 32 * 33;
    LAS int* hist = (LAS int*)(lds + 65536);
    LAS int* base = (LAS int*)(lds + 65536 + 128);
    LAS float* rbl = (LAS float*)(lds + 65536 + 256);
    const int lr = lane & 15, lq = lane >> 4;
    for (int unit = bid_here(); unit < NT / 256; unit += gdim_here()) {
        const int tok0 = unit * 256 + wave * 32;
        __syncthreads();
        if (tid < 32) { hist[tid] = 0; rbl[tid] = rbias[tid]; }
        f32x4 acc[2][2];
#pragma unroll
        for (int rt = 0; rt < 2; ++rt)
#pragma unroll
            for (int et = 0; et < 2; ++et) acc[rt][et] = (f32x4){zr_, zr_, zr_, zr_};
#pragma unroll 1
        for (int k0 = 0; k0 < 32; k0 += 8) { bf16x8 af[8][2], bfr[8][2];
#pragma unroll
            for (int j = 0; j < 8; ++j) { const int ks = k0 + j;
#pragma unroll
                for (int rt = 0; rt < 2; ++rt) af[j][rt] = *(const bf16x8*)(xb + (size_t)(tok0 + rt * 16 + lr) * DM + ks * 32 + lq * 8);
#pragma unroll
                for (int et = 0; et < 2; ++et) bfr[j][et] = *(const bf16x8*)(wr + (size_t)(et * 16 + lr) * DM + ks * 32 + lq * 8); }
            __builtin_amdgcn_sched_barrier(0);
#pragma unroll
            for (int j = 0; j < 8; ++j)
#pragma unroll
                for (int rt = 0; rt < 2; ++rt)
#pragma unroll
                    for (int et = 0; et < 2; ++et) acc[rt][et] = __builtin_amdgcn_mfma_f32_16x16x32_bf16(af[j][rt], bfr[j][et], acc[rt][et], 0, 0, 0); }
#pragma unroll
        for (int rt = 0; rt < 2; ++rt)
#pragma unroll
            for (int et = 0; et < 2; ++et)
#pragma unroll
                for (int reg = 0; reg < 4; ++reg) LG[(rt * 16 + lq * 4 + reg) * 33 + et * 16 + lr] = acc[rt][et][reg];
        __syncthreads();
        int te[4] = {0, 0, 0, 0}; float tg[4] = {0.f, 0.f, 0.f, 0.f}; int rk[4] = {0, 0, 0, 0}; float rstd = 0.f; const int tok = tok0 + lane;
        if (lane < 32) {
            const float* sp = ssqp + (size_t)tok * 16; float ss = 0.f;
#pragma unroll
            for (int j = 0; j < 16; ++j) ss += sp[j];
            rstd = __builtin_amdgcn_rsqf(ss * (1.0f / DM) + EPS);
            float tv[4] = {-3e38f, -3e38f, -3e38f, -3e38f};
            for (int e = 0; e < NEXP; ++e) { float v = LG[lane * 33 + e] * rstd + rbl[e]; int ve = e;
#pragma unroll
                for (int k = 0; k < 4; ++k) { if (v > tv[k]) { const float tvv = tv[k]; const int tee = te[k]; tv[k] = v; te[k] = ve; v = tvv; ve = tee; } } }
            float z = 0.f;
#pragma unroll
            for (int k = 0; k < 4; ++k) { tg[k] = fast_exp(tv[k] - tv[0]); z += tg[k]; }
            const float iz = 1.0f / z;
#pragma unroll
            for (int k = 0; k < 4; ++k) { tg[k] *= iz; rk[k] = __hip_atomic_fetch_add(&hist[te[k]], 1, __ATOMIC_RELAXED, __HIP_MEMORY_SCOPE_WORKGROUP); }
        }
        __syncthreads();
        if (tid < 32) base[tid] = alloc ? (int)__hip_atomic_fetch_add(cnt + tid, (unsigned)hist[tid], RLX_AGENT) : 0;
        __syncthreads();
        if (lane < 32 && alloc) {
#pragma unroll
            for (int k = 0; k < 4; ++k) { const size_t p = (size_t)te[k] * NT + base[te[k]] + rk[k]; LIST[p] = tok * 4 + k; LRSTD[p] = rstd; LGATE[p] = tg[k]; TSEL[tok * 4 + k] = (te[k] << 16) | (base[te[k]] + rk[k]); }
        }
    }
}

__device__ __forceinline__ void phase_combine(ArgsRef a, bool last_layer, int wv, bool dry, const unsigned* cnt) {
    const int tid = tid_from(wv), lane = tid & 63, wave = tid >> 6;
    const int gw = bid_here() * NWAVES + wave, NGW = gdim_here() * NWAVES;
    const unsigned char* __restrict__ Y = (const unsigned char*)(a.ws + WS_Y); float* __restrict__ out = a.out; bf16* xb = (bf16*)(a.ws + WS_XB); float* __restrict__ ssq = (float*)(a.ws + WS_SSQ);
    const u32x4* __restrict__ TSEL = (const u32x4*)(a.ws + WS_TSEL); unsigned char* __restrict__ xa8 = a.ws + WS_XB8;
    typedef float f2v __attribute__((ext_vector_type(2)));
    int bpl; { int nb = (lane < NEXP) ? (int)((__hip_atomic_load(cnt + (lane & 31), RLX_AGENT) + 255u) >> 8) : 0; int incl = nb;
#pragma unroll
        for (int d = 1; d < 32; d <<= 1) { const int v = __shfl_up(incl, d, 64); if (lane >= d) incl += v; }
        bpl = (incl - nb) * 256; }
    u32x4 sel = TSEL[gw < NT ? gw : 0];
    for (int t = gw; t < NT; t += NGW) {
        const u32x4 x0 = __builtin_nontemporal_load((const u32x4*)(xb + (size_t)t * DM) + 2 * lane), x1 = __builtin_nontemporal_load((const u32x4*)(xb + (size_t)t * DM) + 2 * lane + 1);
        u32x4 y[4];
#pragma unroll
        for (int k = 0; k < 4; ++k) { const int e = (int)(sel[k] >> 16), pos = (int)(sel[k] & 0xffffu); const int slot = __builtin_amdgcn_readlane(bpl, __builtin_amdgcn_readfirstlane(e)) + pos;
            y[k] = __builtin_nontemporal_load((const u32x4*)(Y + (size_t)slot * DM) + lane); }
        if (t + NGW < NT) sel = TSEL[t + NGW];
        float v[16];
        v[0] = bflo(x0.x); v[1] = bfhi(x0.x); v[2] = bflo(x0.y); v[3] = bfhi(x0.y); v[4] = bflo(x0.z); v[5] = bfhi(x0.z); v[6] = bflo(x0.w); v[7] = bfhi(x0.w);
        v[8] = bflo(x1.x); v[9] = bfhi(x1.x); v[10] = bflo(x1.y); v[11] = bfhi(x1.y); v[12] = bflo(x1.z); v[13] = bfhi(x1.z); v[14] = bflo(x1.w); v[15] = bfhi(x1.w);
#pragma unroll
        for (int k = 0; k < 4; ++k)
#pragma unroll
            for (int d = 0; d < 4; ++d) { const int w = (int)y[k][d]; const f2v lo = __builtin_amdgcn_cvt_pk_f32_fp8(w, false), hi = __builtin_amdgcn_cvt_pk_f32_fp8(w, true);
                v[4 * d + 0] += lo.x * (1.0f / Y8_SCALE); v[4 * d + 1] += lo.y * (1.0f / Y8_SCALE); v[4 * d + 2] += hi.x * (1.0f / Y8_SCALE); v[4 * d + 3] += hi.y * (1.0f / Y8_SCALE); }
        float s = 0.f;
#pragma unroll
        for (int j = 0; j < 16; ++j) s += v[j] * v[j];
        if (dry && s != 12345.678f) continue;
        if (last_layer) {
#pragma unroll
            for (int j = 0; j < 4; ++j) *((f32x4*)(out + (size_t)t * DM) + 4 * lane + j) = (f32x4){v[4 * j], v[4 * j + 1], v[4 * j + 2], v[4 * j + 3]};
        } else { s = wave_sum(s);
            u32x4 w0, w1; w0.x = cvt_pk_bf16(v[0], v[1]); w0.y = cvt_pk_bf16(v[2], v[3]); w0.z = cvt_pk_bf16(v[4], v[5]); w0.w = cvt_pk_bf16(v[6], v[7]);
            w1.x = cvt_pk_bf16(v[8], v[9]); w1.y = cvt_pk_bf16(v[10], v[11]); w1.z = cvt_pk_bf16(v[12], v[13]); w1.w = cvt_pk_bf16(v[14], v[15]);
            *((u32x4*)(xb + (size_t)t * DM) + 2 * lane) = w0; *((u32x4*)(xb + (size_t)t * DM) + 2 * lane + 1) = w1;
            u32x4 w8;
#pragma unroll
            for (int d = 0; d < 4; ++d) { int f = __builtin_amdgcn_cvt_pk_fp8_f32(v[4 * d], v[4 * d + 1], 0, false); f = __builtin_amdgcn_cvt_pk_fp8_f32(v[4 * d + 2], v[4 * d + 3], f, true); w8[d] = (unsigned)f; }
            *((u32x4*)(xa8 + (size_t)t * DM) + lane) = w8;
            if (lane == 0) ssq[t] = s; }
    }
}

constexpr int NPH_LAYER = 13, NPH = 1 + 2 * NPH_LAYER;
enum { PH_GEMM_IN = 0, PH_QKPREP, PH_POOL, PH_LRU_A, PH_LRU_B, PH_ATTN, PH_LRU_C, PH_MERGE, PH_GEMM_OUT, PH_ROUTER, PH_MOE_GU, PH_MOE_DOWN, PH_COMBINE };
#ifndef MK_STOP
#define MK_STOP NPH
#endif
#ifndef MK_STAG_OUT
#define MK_STAG_OUT 0
#endif
#ifndef MK_SPLIT
#define MK_SPLIT 0
#endif

template <int PHMASK>
__global__ void __launch_bounds__(NTHR, 2) mega_fwd(Args args_by_value) {
    extern __shared__ __attribute__((aligned(16))) unsigned char lds_raw[];
    LAS unsigned char* lds = (LAS unsigned char*)lds_raw;
    const int tid = threadIdx.x;
    int wv = __builtin_amdgcn_readfirstlane(tid >> 6); asm volatile("" : "+s"(wv));
    for (int u = tid; u < (LDS_BYTES - LDSCTL_OFF) / 4; u += NTHR) ((LAS unsigned*)(lds + LDSCTL_OFF))[u] = 0u;
    __syncthreads();
#define ARGS_HERE() const CAS Args* ap_ = (const CAS Args*)__builtin_amdgcn_kernarg_segment_ptr(); asm volatile("" : "+s"(ap_)); ArgsRef args = *ap_; unsigned char* const ws = args.ws; unsigned* const ctl = (unsigned*)(ws + WS_CTL); (void)ctl
    int lo, hi;
    { ARGS_HERE(); lo = args.ph_lo; hi = args.ph_hi; xcd_barrier_post(ctl + CW_BAR + args.li * XCD_BAR_WORDS, (volatile LAS unsigned*)(lds + MISC_OFF) + 8); }
#define EN(p) (((PHMASK) >> (p)) & 1)
#ifndef MK_DUP
#define MK_DUP 0
#endif
#define NREP(p) ((((MK_DUP) >> (p)) & 1) ? 2 : 1)
#define IN(k) (lo <= (k) && (k) < hi)
#define SEAM(k) do { if (IN(k) && IN((k) + 1)) { ARGS_HERE(); XcdBarrier bar_; bar_.bar = ctl + CW_BAR + args.li * XCD_BAR_WORDS; bar_.x = xb_xcc_id(); bar_.st = (volatile LAS unsigned*)(lds + MISC_OFF) + 8; xcd_barrier(bar_); } } while (0)

    if (EN(13) && IN(0)) { ARGS_HERE(); for (int rep_ = 0; rep_ < NREP(13); ++rep_) { phase_prologue(args, lds, wv); } }
    SEAM(0);
    for (int l = 0; l < 2; ++l) {
        const int pb = 1 + NPH_LAYER * l;
        if (EN(PH_GEMM_IN) && IN(pb + PH_GEMM_IN)) { ARGS_HERE();
            if (l == 0) { pg8::StaticOrder S; S.init(NT, NIN, DM, gdim_here(), bid_here()); S.dup = NREP(PH_GEMM_IN) - 1;
                EpiIn E{(bf16*)(ws + WS_PROJ), (bf16*)(ws + WS_HM), (const float*)(ws + WS_SSQ), args.in[I_QG], args.in[I_KG], (const float*)(ws + WS_ROPE), (const float*)(ws + WS_ROPE) + SEQ * 32, lds + OST_OFF, 1.0f};
                pg8::gemm_phase<EpiIn, pg8::StaticOrder, true>(lds, (const bf16*)(ws + WS_XB), (const bf16*)(ws + WS_WIN), DM, S, E, wv); }
            else { pg8::StaticOrder S; S.init(NT, NIN, DM / 2, gdim_here(), bid_here()); S.dup = 0;
                EpiIn E{(bf16*)(ws + WS_PROJ), (bf16*)(ws + WS_HM), (const float*)(ws + WS_SSQ), args.in[I_QG] + 64, args.in[I_KG] + 64, (const float*)(ws + WS_ROPE), (const float*)(ws + WS_ROPE) + SEQ * 32, lds + OST_OFF, 1.0f / WIN8_SCALE};
                pg8::gemm_phase<EpiIn, pg8::StaticOrder, true, true>(lds, (const bf16*)(ws + WS_XB8), (const bf16*)(ws + WS_WIN) + (size_t)NIN * DM, DM / 2, S, E, wv); }
        }
        SEAM(pb + PH_GEMM_IN);
        if (EN(PH_POOL) && IN(pb + PH_POOL)) { ARGS_HERE(); for (int rep_ = 0; rep_ < NREP(PH_POOL); ++rep_) { phase_pool(args, lds, l, wv); } }
        if (EN(PH_LRU_A) && IN(pb + PH_LRU_A)) { ARGS_HERE(); for (int rep_ = 0; rep_ < NREP(PH_LRU_A); ++rep_) { phase_lru_a(args, lds, l, wv); } }
        SEAM(pb + PH_LRU_A);
        if (EN(PH_LRU_B) && IN(pb + PH_LRU_B)) { ARGS_HERE(); for (int rep_ = 0; rep_ < NREP(PH_LRU_B); ++rep_) { phase_lru_b(args, wv); } }
        if (EN(PH_ATTN) && IN(pb + PH_ATTN)) { ARGS_HERE(); for (int rep_ = 0; rep_ < NREP(PH_ATTN); ++rep_) { phase_attn(args, lds, wv); } }
        SEAM(pb + PH_ATTN);
        if (EN(PH_LRU_C) && IN(pb + PH_LRU_C)) { ARGS_HERE(); for (int rep_ = 0; rep_ < NREP(PH_LRU_C); ++rep_) { phase_finalize(args, wv, l == 1); } }
        SEAM(pb + PH_MERGE);
        if (EN(PH_GEMM_OUT) && IN(pb + PH_GEMM_OUT)) { ARGS_HERE();
            __syncthreads();
            if (l == 0) { pg8::StaticOrder S; S.init(NT, DM, DM, gdim_here(), bid_here()); S.dup = NREP(PH_GEMM_OUT) - 1;
                EpiOut E{(bf16*)(ws + WS_XB), (float*)(ws + WS_SSQP), (unsigned char*)(ws + WS_XB8), 1.0f};
                pg8::gemm_phase<EpiOut, pg8::StaticOrder, true>(lds, (const bf16*)(ws + WS_MIX), (const bf16*)(ws + WS_WOUT), DM, S, E, wv, MK_STAG_OUT); }
            else { pg8::StaticOrder S; S.init(NT, DM, DM / 2, gdim_here(), bid_here()); S.dup = 0;
                EpiOut E{(bf16*)(ws + WS_XB), (float*)(ws + WS_SSQP), (unsigned char*)(ws + WS_XB8), 1.0f / WOUT8_SCALE};
                pg8::gemm_phase<EpiOut, pg8::StaticOrder, true, true>(lds, (const bf16*)(ws + WS_MIX), (const bf16*)(ws + WS_WOUT) + (size_t)DM * DM, DM / 2, S, E, wv, MK_STAG_OUT); }
        }
        SEAM(pb + PH_GEMM_OUT);
        if (EN(PH_ROUTER) && IN(pb + PH_ROUTER)) { ARGS_HERE(); for (int rep_ = 0; rep_ < NREP(PH_ROUTER); ++rep_) { phase_router(args, lds, l, wv, rep_ == NREP(PH_ROUTER) - 1); } }
        SEAM(pb + PH_ROUTER);
        if (EN(PH_MOE_GU) && IN(pb + PH_MOE_GU)) { ARGS_HERE();
            LAS int* tab = (LAS int*)(lds + TAB_OFF);
            moe_tables(tab, ctl + CW_CNT + l * NEXP, wv);
            MoeOrder<2> S{tab, 2, gdim_here(), bid_here(), (const int*)(ws + WS_LIST), NREP(PH_MOE_GU) - 1};
            EpiGU E{(unsigned char*)(ws + WS_ACT), (const float*)(ws + WS_LRSTD), args.in[I_BGU] + (size_t)l * NEXP * 512};
            pg8::gemm_phase<EpiGU, MoeOrder<2>, true, true>(lds, (const bf16*)(ws + WS_XB8), (const bf16*)(ws + WS_WGU + (size_t)l * NEXP * 512 * DM), DM / 2, S, E, wv);
        }
        SEAM(pb + PH_MOE_GU);
        if (EN(PH_MOE_DOWN) && IN(pb + PH_MOE_DOWN)) { ARGS_HERE();
            LAS int* tab = (LAS int*)(lds + TAB_OFF);
            if (!(EN(PH_MOE_GU) && IN(pb + PH_MOE_GU))) moe_tables(tab, ctl + CW_CNT + l * NEXP, wv);
            else __syncthreads();
            MoeOrder<3> S{tab, 4, gdim_here(), bid_here(), (const int*)(ws + WS_LIST), NREP(PH_MOE_DOWN) - 1};
            EpiDown E{(unsigned char*)(ws + WS_Y), (const int*)(ws + WS_LIST), (const float*)(ws + WS_LGATE2), args.in[I_BD] + (size_t)l * NEXP * DM, tab};
            pg8::gemm_phase<EpiDown, MoeOrder<3>, true, true>(lds, (const bf16*)(ws + WS_ACT), (const bf16*)(ws + WS_WD + (size_t)l * NEXP * DM * EFF), EFF / 2, S, E, wv);
        }
        SEAM(pb + PH_MOE_DOWN);
        if (EN(PH_COMBINE) && IN(pb + PH_COMBINE)) { ARGS_HERE(); for (int rep_ = 0; rep_ < NREP(PH_COMBINE); ++rep_) { phase_combine(args, l == 1, wv, rep_ < NREP(PH_COMBINE) - 1, ctl + CW_CNT + l * NEXP); } }
        SEAM(pb + PH_COMBINE);
    }
#undef IN
#undef SEAM
}

typedef void (*kern_t)(Args);
template <int M> static kern_t kern_of() { return (kern_t)mega_fwd<M>; }
static kern_t phase_kernel(int p) {
    switch (p) { case 0: return kern_of<1 << 0>(); case 1: return kern_of<1 << 1>(); case 2: return kern_of<1 << 2>(); case 3: return kern_of<1 << 3>(); case 4: return kern_of<1 << 4>();
                 case 5: return kern_of<1 << 5>(); case 6: return kern_of<1 << 6>(); case 7: return kern_of<1 << 7>(); case 8: return kern_of<1 << 8>(); case 9: return kern_of<1 << 9>();
                 case 10: return kern_of<1 << 10>(); case 11: return kern_of<1 << 11>(); case 12: return kern_of<1 << 12>(); default: return kern_of<1 << 13>(); }
}
extern "C" void kernel_launch(void* const* d_in, const int* in_sizes, int n_in, void* d_out, int out_size, void* d_ws, size_t ws_size, hipStream_t stream) {
    static int grid = 0;
    if (grid == 0) {
        if (n_in != 23 || in_sizes[0] != NT * DM || out_size != NT * DM || ws_size < WS_END) {
            fprintf(stderr, "kernel_launch: built for 23 inputs, x/out of %d floats, >= %zu bytes of workspace; got n_in %d, in0 %d, out %d, ws %zu; nothing launched\n", NT * DM, (size_t)WS_END, n_in, n_in > 0 ? in_sizes[0] : -1, out_size, ws_size);
            grid = -1; return; }
        int dev = 0, cus = 0;
        if (hipGetDevice(&dev) != hipSuccess || hipDeviceGetAttribute(&cus, hipDeviceAttributeMultiprocessorCount, dev) != hipSuccess) { fprintf(stderr, "kernel_launch: device query failed\n"); grid = -1; return; }
#if MK_SPLIT
        for (int p = 0; p < 14; ++p) if (hipFuncSetAttribute((const void*)phase_kernel(p), hipFuncAttributeMaxDynamicSharedMemorySize, LDS_BYTES) != hipSuccess) { fprintf(stderr, "kernel_launch: hipFuncSetAttribute failed\n"); grid = -1; return; }
#else
        if (hipFuncSetAttribute((const void*)kern_of<0x3fff>(), hipFuncAttributeMaxDynamicSharedMemorySize, LDS_BYTES) != hipSuccess) { fprintf(stderr, "kernel_launch: hipFuncSetAttribute failed\n"); grid = -1; return; }
        int per_cu = 0;
        if (hipOccupancyMaxActiveBlocksPerMultiprocessor(&per_cu, (const void*)kern_of<0x3fff>(), NTHR, LDS_BYTES) != hipSuccess || per_cu < 1)
            fprintf(stderr, "kernel_launch: note: occupancy query reports %d workgroups per CU\n", per_cu);
#endif
        (void)hipGetLastError();
        if (cus != 256) { fprintf(stderr, "kernel_launch: this kernel's unit maps are built for a 256-CU device (one workgroup per CU); found %d CUs; nothing launched\n", cus); grid = -1; return; }
        grid = cus;
    }
    if (grid < 0) return;
    if (hipMemsetAsync((char*)d_ws + WS_CTL, 0, MK_SPLIT ? CTL_ZERO_BYTES : (size_t)65536, stream) != hipSuccess)
 { fprintf(stderr, "kernel_launch: hipMemsetAsync failed\n"); return; }
    Args a{};
    for (int i = 0; i < 23; ++i) a.in[i] = (const float*)d_in[i];
    a.out = (float*)d_out; a.ws = (unsigned char*)d_ws; a.pad = 0;
#if MK_SPLIT
#ifdef MK_SKIP
    (void)hipMemsetAsync((char*)d_ws + WS_MIX, 0, (size_t)NT * DM * 2, stream);
#endif
    for (int p = 0; p < MK_STOP; ++p) { a.ph_lo = p; a.ph_hi = p + 1; a.li = p;
#ifdef MK_SKIP
        if (p >= 1 && (((MK_SKIP) >> ((p - 1) % NPH_LAYER)) & 1)) continue;
#endif
        hipLaunchKernelGGL(phase_kernel(p == 0 ? 13 : (p - 1) % NPH_LAYER), dim3(grid), dim3(NTHR), LDS_BYTES, stream, a); }
#else
    a.ph_lo = 0; a.ph_hi = NPH; a.li = 0;
    hipLaunchKernelGGL(kern_of<0x3fff>(), dim3(grid), dim3(NTHR), LDS_BYTES, stream, a);
#endif
    const hipError_t le = hipPeekAtLastError();
    if (le != hipSuccess) fprintf(stderr, "kernel_launch: launch failed: %s\n", hipGetErrorName(le));
}
```

```cpp
#include <hip/hip_runtime.h>
#include <cstdio>
#include <cstdint>

#define LAS __attribute__((address_space(3)))
#define GAS __attribute__((address_space(1)))
typedef unsigned short bf16;
typedef short bf16x8 __attribute__((ext_vector_type(8)));
typedef float f32x4 __attribute__((ext_vector_type(4)));
typedef float f32x2 __attribute__((ext_vector_type(2)));
typedef unsigned u32x4 __attribute__((ext_vector_type(4)));
typedef unsigned u32x2 __attribute__((ext_vector_type(2)));

#ifndef MK_VAR
#define MK_VAR 0
#endif
constexpr int NB = 16, SEQ = 4096, DM = 1024, NT = NB * SEQ;
constexpr int NIN = 2304;
constexpr int NPJ = 768;
constexpr int C_POOL = 0, C_LRU = 256, C_GATE = 512, C_Q = 768, C_K = 1280, C_V = 1792;
constexpr int NEXP = 32, TOPK = 4, EFF = 256;
constexpr int NASSIGN = NT * TOPK;
constexpr int ACT_ROWS = NASSIGN + NEXP * 256;
constexpr float EPS = 1e-6f;
constexpr int NWAVES = 8, NTHR = 512;
constexpr int LRU_CH = 32, LRU_NCH = SEQ / LRU_CH;

constexpr size_t MiB = 1u << 20;
constexpr size_t WS_CTL = 0, CTL_ZERO_BYTES = 1 * MiB;
constexpr size_t WS_ROPE = 1 * MiB;
constexpr size_t WS_SMALL = 2 * MiB;
constexpr size_t WS_WIN = 4 * MiB;
constexpr size_t WS_WOUT = 13 * MiB;
constexpr size_t WS_WGU = 17 * MiB;
constexpr size_t WS_WD = 81 * MiB;
constexpr size_t WS_SSQ = 113 * MiB;
constexpr size_t WS_SSQP = 114 * MiB;
constexpr size_t WS_LIST = 118 * MiB;
constexpr size_t WS_XB = 128 * MiB;
constexpr size_t WS_R = 256 * MiB;
constexpr size_t WS_PROJ = WS_R;
constexpr size_t WS_HM = WS_R + 96 * MiB;
constexpr size_t WS_MIX = WS_R + 288 * MiB;
constexpr size_t WS_PNUM = WS_R + 416 * MiB;
constexpr size_t WS_PDEN = WS_R + 608 * MiB;
constexpr size_t WS_PMAX = WS_R + 614 * MiB;
constexpr size_t WS_HL = WS_R + 620 * MiB;
constexpr size_t WS_PL = WS_R + 652 * MiB;
constexpr size_t WS_AGGH = WS_R + 684 * MiB;
constexpr size_t WS_AGGP = WS_R + 686 * MiB;
constexpr size_t WS_CARRY = WS_R + 688 * MiB;
constexpr size_t WS_YP = WS_R + 690 * MiB;
constexpr size_t WS_SSQPOOL = WS_R + 722 * MiB;
constexpr size_t WS_ACT = WS_R;
constexpr size_t WS_Y = WS_R + 132 * MiB;
constexpr size_t WS_XB8 = WS_R + 420 * MiB;
constexpr size_t WS_LRSTD = WS_R + 644 * MiB;
constexpr size_t WS_LGATE2 = WS_R + 652 * MiB;
constexpr size_t WS_TSEL = WS_R + 660 * MiB;
constexpr size_t WS_END = 1024 * MiB;
static_assert(WS_CARRY + 2 * MiB <= WS_END && WS_LGATE2 + 8 * MiB <= WS_END, "d_ws map");
constexpr size_t SM_POOLW = 0;
constexpr size_t SM_WA = 32768;
constexpr size_t SM_WX = 65536;
constexpr size_t SM_WR = 98304;
constexpr int CW_BAR = 4096;
constexpr int CW_CNT = 1024;

constexpr int RING_BYTES = 131072;
constexpr int LDSCTL_OFF = RING_BYTES;
constexpr int MISC_OFF = LDSCTL_OFF + 320;
constexpr int TAB_OFF = LDSCTL_OFF + 1024;
constexpr int OST_OFF = RING_BYTES + 8192;
constexpr int LDS_BYTES = 163840;

typedef GAS unsigned gu32;
#define RLX_AGENT __ATOMIC_RELAXED, __HIP_MEMORY_SCOPE_AGENT
#define LDS_WAIT() asm volatile("s_waitcnt lgkmcnt(0)" ::: "memory")
#define VM_WAIT() asm volatile("s_waitcnt vmcnt(0)" ::: "memory")
typedef __bf16 bf16x2_t __attribute__((ext_vector_type(2)));
__device__ __forceinline__ unsigned cvt_pk_bf16(float lo, float hi) { const f32x2 v = {lo, hi}; const bf16x2_t b = __builtin_convertvector(v, bf16x2_t); return __builtin_bit_cast(unsigned, b); }
__device__ __forceinline__ float bflo(unsigned w) { return __uint_as_float(w << 16); }
__device__ __forceinline__ float bfhi(unsigned w) { return __uint_as_float(w & 0xffff0000u); }
__device__ __forceinline__ float bf2f(bf16 h) { return __uint_as_float((unsigned)h << 16); }
__device__ __forceinline__ bf16 f2bf(float f) { return (bf16)(cvt_pk_bf16(f, 0.f) & 0xffffu); }
__device__ __forceinline__ float xsum16(float x) { const u32x2 r = __builtin_amdgcn_permlane16_swap(__float_as_uint(x), __float_as_uint(x), false, false); return __uint_as_float(r.x) + __uint_as_float(r.y); }
__device__ __forceinline__ float xsum32(float x) { const u32x2 r = __builtin_amdgcn_permlane32_swap(__float_as_uint(x), __float_as_uint(x), false, false); return __uint_as_float(r.x) + __uint_as_float(r.y); }
__device__ __forceinline__ float xmax16(float x) { const u32x2 r = __builtin_amdgcn_permlane16_swap(__float_as_uint(x), __float_as_uint(x), false, false); return fmaxf(__uint_as_float(r.x), __uint_as_float(r.y)); }
__device__ __forceinline__ float xmax32(float x) { const u32x2 r = __builtin_amdgcn_permlane32_swap(__float_as_uint(x), __float_as_uint(x), false, false); return fmaxf(__uint_as_float(r.x), __uint_as_float(r.y)); }
#define DPP_ROR_F(x, n) __int_as_float(__builtin_amdgcn_update_dpp(0, __float_as_int(x), 0x120 + (n), 0xf, 0xf, true))
__device__ __forceinline__ float row16_sum(float v) { v += DPP_ROR_F(v, 8); v += DPP_ROR_F(v, 4); v += DPP_ROR_F(v, 2); v += DPP_ROR_F(v, 1); return v; }
__device__ __forceinline__ float wave_sum(float v) { return xsum32(xsum16(row16_sum(v))); }
__device__ __forceinline__ float rows_up16(float x, int row) { const unsigned u = __float_as_uint(x); const u32x2 p = __builtin_amdgcn_permlane16_swap(u, u, false, false);
    const u32x2 q = __builtin_amdgcn_permlane32_swap(p.y, p.y, false, false); return __uint_as_float(row == 2 ? q.x : p.x); }
__device__ __forceinline__ float rows_up32(float x) { const unsigned u = __float_as_uint(x); const u32x2 p = __builtin_amdgcn_permlane32_swap(u, u, false, false); return __uint_as_float(p.x); }
__device__ __forceinline__ float row3_bcast(float x) { const unsigned u = __float_as_uint(x); const u32x2 p = __builtin_amdgcn_permlane16_swap(u, u, false, false);
    const u32x2 q = __builtin_amdgcn_permlane32_swap(p.y, p.y, false, false); return __uint_as_float(q.y); }
__device__ __forceinline__ float fast_sigmoid(float x) { return __builtin_amdgcn_rcpf(1.0f + __builtin_amdgcn_exp2f(-1.4426950408889634f * x)); }
__device__ __forceinline__ float fast_exp(float x) { return __builtin_amdgcn_exp2f(1.4426950408889634f * x); }
__device__ __forceinline__ float gelu_tanh(float x) {
    const float u = 0.7978845608028654f * (x + 0.044715f * x * x * x);
    return x * fast_sigmoid(2.0f * u);
}
__device__ __forceinline__ int bid_here() { int b = (int)blockIdx.x; asm volatile("" : "+s"(b)); return b; }
__device__ __forceinline__ int gdim_here() { int g = (int)gridDim.x; asm volatile("" : "+s"(g)); return g; }
__device__ __forceinline__ int tid_from(int wv) { int ln; asm volatile("v_mbcnt_lo_u32_b32 %0, -1, 0\n\tv_mbcnt_hi_u32_b32 %0, -1, %0" : "=v"(ln)); return wv * 64 + ln; }
namespace pg8 {
constexpr int BM = 256, BK = 64, HALF = 128, HTB = HALF * BK * 2  , STAGE_BYTES = 8 * HTB, NXCD = 8, WGM = 8;

__host__ __device__ __forceinline__ int lds_byte(int r, int c) { const int st = (r >> 4) * 2 + (c >> 5), rr = r & 15, cc = c & 31, ob = rr * 64 + cc * 2; return st * 1024 + (ob ^ (((ob >> 9) & 1) << 5)); }
__host__ __device__ __forceinline__ void stage_rc(int b, int& R, int& C) { const int st = b / 1024, sb = b % 1024, swz = sb ^ (((sb >> 9) & 1) << 5); R = (st >> 1) * 16 + swz / 64; C = (st & 1) * 32 + (swz % 64) / 2; }
__host__ __device__ __forceinline__ int perm32(int rho) { const int n = rho >> 4, i = rho & 15; return 8 * (i >> 2) + 4 * n + (i & 3); }

struct Unit { int pm, pn, e, aux; };

typedef int v8i32_t __attribute__((ext_vector_type(8)));
typedef int v4i32_t __attribute__((ext_vector_type(4)));
__device__ __forceinline__ v8i32_t f8frag(bf16x8 lo, bf16x8 hi) { const u32x4 a = __builtin_bit_cast(u32x4, lo), b = __builtin_bit_cast(u32x4, hi); return (v8i32_t){(int)a.x, (int)a.y, (int)a.z, (int)a.w, (int)b.x, (int)b.y, (int)b.z, (int)b.w}; }
template <class Epi, class Sched, bool ALIGN_EPI, bool F8 = false>
__device__ __forceinline__ void gemm_phase(LAS unsigned char* lds, const bf16* Abase, const bf16* Bbase, const int K, const Sched& S, const Epi& E, const int wv, const int stag = 0) {
    const int tid = tid_from(wv), wid = __builtin_amdgcn_readfirstlane(tid >> 6), lane = tid & 63, wr = wid >> 2, wc = wid & 3, fr = lane & 15, fq = lane >> 4;
    const int nt = K / BK;
    unsigned voffB[2];
#pragma unroll
    for (int i = 0; i < 2; ++i) { int R, C; stage_rc(tid * 16 + i * 8192, R, C); const int Rb = Epi::PERM ? ((R & ~31) + perm32(R & 31)) : R;
        voffB[i] = (unsigned)(Rb * K + C) * 2u; }
#define PG8_AVOFF(u, h, i) ([&]() { int R_, C_; stage_rc(tid * 16 + (i) * 8192, R_, C_); return S.a_voff((u), (h) * HALF + R_, C_); }())
#define PG8_GATHER4(u, pk) do { int R0_, C0_, R1_, C1_; stage_rc(tid * 16, R0_, C0_); stage_rc(tid * 16 + 8192, R1_, C1_); \
        const int q0_ = S.a_raw((u), R0_), q1_ = S.a_raw((u), R1_), q2_ = S.a_raw((u), HALF + R0_), q3_ = S.a_raw((u), HALF + R1_); \
        pk.x = S.a_voff_raw((u), R0_, C0_, q0_); pk.y = S.a_voff_raw((u), R1_, C1_, q1_); pk.z = S.a_voff_raw((u), HALF + R0_, C0_, q2_); pk.w = S.a_voff_raw((u), HALF + R1_, C1_, q3_); } while (0)
    const unsigned kstep = (unsigned)(BK * 2);
    const unsigned hstep = (unsigned)(HALF * K * 2);
    const unsigned ldsw = (unsigned)wid * 1024u;
    const int aoff = F8 ? lds_byte(wr * 64 + fr, fq * 16) : lds_byte(wr * 64 + fr, fq * 8), boff = F8 ? lds_byte(wc * 32 + fr, fq * 16) : lds_byte(wc * 32 + fr, fq * 8);
    const __amdgpu_buffer_rsrc_t rsA = __builtin_amdgcn_make_buffer_rsrc((void*)Abase, 0, 0x7fffffff, 0x00020000);
    const __amdgpu_buffer_rsrc_t rsB = __builtin_amdgcn_make_buffer_rsrc((void*)Bbase, 0, 0x7fffffff, 0x00020000);
#define PG8_SA(b, h) (((b) * 2 + (h)) * HTB)
#define PG8_SB(b, h) ((4 + (b) * 2 + (h)) * HTB)
#define PG8_STAGE_B(bufoff, soff) do { const int so_ = __builtin_amdgcn_readfirstlane((int)(soff)); _Pragma("unroll") for (int _i = 0; _i < 2; ++_i) \
        __builtin_amdgcn_raw_ptr_buffer_load_lds(rsB, (LAS void*)(lds + (bufoff) + ldsw + _i * 8192), 16, voffB[_i], so_, 0, 0); } while (0)
#define PG8_STAGE_A(bufoff, kbytes, H, NX) do { const int so_ = __builtin_amdgcn_readfirstlane((int)(kbytes)); unsigned o0_, o1_; \
        if constexpr (Sched::GATHER) { const u32x2 pk_ = *(const LAS u32x2*)((const LAS unsigned char*)park + (((ui + (NX)) & 1) * 8192 + tid * 16 + (H) * 8)); o0_ = pk_.x; o1_ = pk_.y; } else { o0_ = vc0; o1_ = vc1; } \
        __builtin_amdgcn_raw_ptr_buffer_load_lds(rsA, (LAS void*)(lds + (bufoff) + ldsw), 16, o0_, so_, 0, 0); \
        __builtin_amdgcn_raw_ptr_buffer_load_lds(rsA, (LAS void*)(lds + (bufoff) + ldsw + 8192), 16, o1_, so_, 0, 0); } while (0)
#define PG8_LD8(p_) __builtin_shufflevector(*(const LAS v4i32_t*)(p_), *(const LAS v4i32_t*)((p_) + 16), 0, 1, 2, 3, 4, 5, 6, 7)
#define PG8_LDA(dst, b, h) do { if constexpr (F8) { _Pragma("unroll") for (int m = 0; m < 4; ++m) dst##8[m] = PG8_LD8(lds + PG8_SA(b, h) + aoff + m * 2048); } \
        else { _Pragma("unroll") for (int m = 0; m < 4; ++m) _Pragma("unroll") for (int k = 0; k < 2; ++k) dst[m][k] = *(const LAS bf16x8*)(lds + PG8_SA(b, h) + aoff + m * 2048 + k * 1024); } } while (0)
#define PG8_LDB(dst, b, h) do { if constexpr (F8) { _Pragma("unroll") for (int n = 0; n < 2; ++n) dst##8[n] = PG8_LD8(lds + PG8_SB(b, h) + boff + n * 2048); } \
        else { _Pragma("unroll") for (int n = 0; n < 2; ++n) _Pragma("unroll") for (int k = 0; k < 2; ++k) dst[n][k] = *(const LAS bf16x8*)(lds + PG8_SB(b, h) + boff + n * 2048 + k * 1024); } } while (0)
#define PG8_MMA(ai, bj, At, Bt) do { __builtin_amdgcn_s_setprio(1); _Pragma("unroll") for (int m = 0; m < 4; ++m) _Pragma("unroll") for (int n = 0; n < 2; ++n) { \
        if constexpr (F8) { asm volatile("v_mfma_scale_f32_16x16x128_f8f6f4 %0, %1, %2, %0, %3, %3 op_sel_hi:[0,0,0]" : "+v"(acc[ai][bj][m][n]) : "v"(Bt##8[n]), "v"(At##8[m]), "v"(sc1_)); }   \
        else { _Pragma("unroll") for (int k = 0; k < 2; ++k) acc[ai][bj][m][n] = __builtin_amdgcn_mfma_f32_16x16x32_bf16(Bt[n][k], At[m][k], acc[ai][bj][m][n], 0, 0, 0); } } __builtin_amdgcn_s_setprio(0); } while (0)
#define PG8_WAIT_V(n) asm volatile("s_waitcnt vmcnt(" #n ")" ::: "memory")
#define PG8_WAIT_VN(n) asm volatile("s_waitcnt vmcnt(%0)" :: "n"(n) : "memory")
#define PG8_WAIT_L(n) asm volatile("s_waitcnt lgkmcnt(" #n ")" ::: "memory")
#define PG8_BAR __builtin_amdgcn_s_barrier()
#define PG8_SCHED __builtin_amdgcn_sched_barrier(0)
    if (stag > 0) { const unsigned long long t0_ = __builtin_amdgcn_s_memrealtime(), dl_ = (unsigned long long)(((bid_here() >> 3) & 3) * stag);
        while (__builtin_amdgcn_s_memrealtime() - t0_ < dl_) __builtin_amdgcn_s_sleep(8); }
    Unit cur, nxt; int ui = 0;
    if (!S.next(0, cur)) return;
    float zz_ = 0.f; asm volatile("" : "+v"(zz_));
    int sc1_ = 0x7f7f7f7f; asm volatile("" : "+v"(sc1_));
    LAS u32x4* const park = (LAS u32x4*)(lds + STAGE_BYTES + 8192);
    f32x4 acc[2][2][4][2];
#pragma unroll
    for (int a = 0; a < 2; ++a)
#pragma unroll
        for (int b = 0; b < 2; ++b)
#pragma unroll
            for (int m = 0; m < 4; ++m)
#pragma unroll
                for (int n = 0; n < 2; ++n) acc[a][b][m][n] = (f32x4){zz_, zz_, zz_, zz_};
    bf16x8 At[4][2], B0[2][2], B1[2][2]; v8i32_t At8[4], B08[2], B18[2];
    unsigned vc0 = 0u, vc1 = 0u;
    unsigned cA0, cA1, nA0, nA1;
    if constexpr (Sched::GATHER) { u32x4 pk; PG8_GATHER4(cur, pk); park[tid] = pk; }
    else { vc0 = PG8_AVOFF(cur, 0, 0); vc1 = PG8_AVOFF(cur, 0, 1); }
    cA0 = S.a_soff(cur, 0); cA1 = S.a_soff(cur, 1);
    unsigned cB = (unsigned)S.b_off(cur);
    PG8_STAGE_B(PG8_SB(0, 0), cB); PG8_STAGE_B(PG8_SB(0, 1), cB + hstep); PG8_STAGE_A(PG8_SA(0, 0), cA0, 0, 0); PG8_STAGE_A(PG8_SA(0, 1), cA1, 1, 0);
    if (wr == 1) PG8_BAR;
    PG8_WAIT_V(2); PG8_BAR;
    PG8_STAGE_B(PG8_SB(1, 0), cB + kstep); PG8_STAGE_A(PG8_SA(1, 0), cA0 + kstep, 0, 0); PG8_STAGE_B(PG8_SB(1, 1), cB + hstep + kstep);
    if constexpr (Epi::PEEL) PG8_WAIT_V(0); else PG8_WAIT_V(6);
    PG8_BAR;
    for (;;) {
#define PG8_TRIP(a1k, a2k0, a2k1, a3k0, b2, b3, NX, W1, W2) do { \
              \
            PG8_LDB(B0, 0, 0); PG8_LDB(B1, 0, 1); PG8_SCHED; PG8_LDA(At, 0, 0); PG8_STAGE_A(PG8_SA(1, 1), a1k, 1, 0); \
            W1; PG8_WAIT_L(0); PG8_BAR; PG8_MMA(0, 0, At, B0); PG8_MMA(0, 1, At, B1); PG8_BAR; PG8_SCHED; \
              \
            PG8_LDA(At, 0, 1); PG8_STAGE_B(PG8_SB(0, 0), b2); PG8_STAGE_B(PG8_SB(0, 1), (b2) + hstep); PG8_STAGE_A(PG8_SA(0, 0), a2k0, 0, NX); \
            W2; PG8_WAIT_L(0); PG8_BAR; PG8_MMA(1, 0, At, B0); PG8_MMA(1, 1, At, B1); PG8_BAR; PG8_SCHED; \
              \
            PG8_LDB(B0, 1, 0); PG8_LDB(B1, 1, 1); PG8_SCHED; PG8_LDA(At, 1, 0); PG8_STAGE_A(PG8_SA(0, 1), a2k1, 1, NX); \
            PG8_WAIT_V(8); PG8_WAIT_L(0); PG8_BAR; PG8_MMA(0, 0, At, B0); PG8_MMA(0, 1, At, B1); PG8_BAR; PG8_SCHED; \
              \
            PG8_LDA(At, 1, 1); PG8_STAGE_B(PG8_SB(1, 0), b3); PG8_STAGE_B(PG8_SB(1, 1), (b3) + hstep); PG8_STAGE_A(PG8_SA(1, 0), a3k0, 0, NX); \
            PG8_WAIT_V(8); PG8_WAIT_L(0); PG8_BAR; PG8_MMA(1, 0, At, B0); PG8_MMA(1, 1, At, B1); PG8_BAR; PG8_SCHED; } while (0)
        const bool has_next = S.next(ui + 1, nxt);
        if constexpr (Sched::GATHER) { if (has_next) { u32x4 pk;
            if (nxt.pm == cur.pm) pk = park[(ui & 1) * 512 + tid];
            else PG8_GATHER4(nxt, pk);
            park[((ui + 1) & 1) * 512 + tid] = pk; } }
        unsigned nB;
        if (has_next) { nA0 = S.a_soff(nxt, 0); nA1 = S.a_soff(nxt, 1); nB = (unsigned)S.b_off(nxt); }
        else { nA0 = cA0; nA1 = cA1; nB = cB; }
        if constexpr (Epi::PEEL) { const int t = 0; const bool last = (t == nt - 2);
            const unsigned k1 = (unsigned)(t + 1) * kstep, k2 = (unsigned)(t + 2) * kstep;
            const unsigned a2k0 = last ? nA0 : cA0 + k2, a2k1 = last ? nA1 : cA1 + k2, b2 = last ? nB : cB + k2;
            const int nx = (last && has_next) ? 1 : 0;
            PG8_TRIP(cA1 + k1, a2k0, a2k1, a2k0 + kstep, b2, b2 + kstep, nx, PG8_WAIT_VN(2 + Epi::NSTORE), PG8_WAIT_VN(8 + Epi::NSTORE)); }
#pragma unroll 1
        for (int t = Epi::PEEL ? 2 : 0; t < nt; t += 2) {
            const bool last = (t == nt - 2);
            const unsigned k1 = (unsigned)(t + 1) * kstep, k2 = (unsigned)(t + 2) * kstep;
            const unsigned a2k0 = last ? nA0 : cA0 + k2, a2k1 = last ? nA1 : cA1 + k2, b2 = last ? nB : cB + k2;
            const int nx = (last && has_next) ? 1 : 0;
            PG8_TRIP(cA1 + k1, a2k0, a2k1, a2k0 + kstep, b2, b2 + kstep, nx, PG8_WAIT_V(8), PG8_WAIT_V(8));
        }
#undef PG8_TRIP
        if constexpr (ALIGN_EPI) { if (wr == 0) PG8_BAR; }
        { int tq_ = tid; asm volatile("" : "+v"(tq_));
          const int wq_ = __builtin_amdgcn_readfirstlane(tq_ >> 6); E(acc, cur, wq_ >> 2, wq_ & 3, tq_ & 15, (tq_ & 63) >> 4); }
        if (!has_next) break;
#pragma unroll
        for (int a = 0; a < 2; ++a)
#pragma unroll
            for (int b = 0; b < 2; ++b)
#pragma unroll
                for (int m = 0; m < 4; ++m)
#pragma unroll
                    for (int n = 0; n < 2; ++n) acc[a][b][m][n] = (f32x4){zz_, zz_, zz_, zz_};
        cur = nxt; cB = nB; cA0 = nA0; cA1 = nA1; ++ui;
        if constexpr (ALIGN_EPI) { if (wr == 1) PG8_BAR; }
    }
    PG8_WAIT_V(0);
    if constexpr (!ALIGN_EPI) { if (wr == 0) PG8_BAR; }
    PG8_BAR;
#undef PG8_SA
#undef PG8_AVOFF
#undef PG8_GATHER4
#undef PG8_SB
#undef PG8_STAGE_A
#undef PG8_STAGE_B
#undef PG8_LDA
#undef PG8_LDB
#undef PG8_LD8
#undef PG8_MMA
#undef PG8_WAIT_V
#undef PG8_WAIT_VN
#undef PG8_WAIT_L
#undef PG8_BAR
#undef PG8_SCHED
}

struct StaticOrder {
    int nM, nN, nwg, G, c, lda, dup;
    __device__ __forceinline__ void init(int M, int N, int lda_, int G_, int c_) { nM = M / BM; nN = N / BM; nwg = nM * nN; G = G_; c = c_; lda = lda_; dup = 0; }
    __device__ __forceinline__ bool next(int i, Unit& u) const {
        const long L = (long)(i >> dup) * G + c; if (L >= nwg) return false;
        int wgid = (int)L; { const int q = nwg / NXCD, r = nwg % NXCD, xcd = wgid % NXCD, off = wgid / NXCD; wgid = (xcd < r ? xcd * (q + 1) : r * (q + 1) + (xcd - r) * q) + off; }
        const int nig = WGM * nN, gid = wgid / nig, fm = gid * WGM, gsz = (nM - fm) < WGM ? (nM - fm) : WGM;
        u.pm = fm + ((wgid % nig) % gsz); u.pn = (wgid % nig) / gsz; u.e = 0; u.aux = 0; return true;
    }
    static constexpr bool GATHER = false;
    __device__ __forceinline__ unsigned a_voff(const Unit&, int R, int C) const { return (unsigned)((R & (HALF - 1)) * lda + C) * 2u; }
    __device__ __forceinline__ unsigned a_soff(const Unit& u, int h) const { return (unsigned)((u.pm * BM + h * HALF) * lda) * 2u; }
    __device__ __forceinline__ size_t b_off(const Unit& u) const { return (size_t)u.pn * BM * lda * 2; }
};
}

#define XB_TMO      128
#define XB_XCNT(j)  (256  + 64 * (j))
#define XB_XSUB(j)  (1280 + 64 * (j))
#define XB_XGEN(j)  (2304 + 64 * (j))
#define XB_TOP      3328
#define XB_TOPGEN   3392
#define XCD_BAR_WORDS 3456
#define XB_SPIN_CAP (1u << 18)

__device__ __forceinline__ unsigned xb_ld(unsigned* p)              { return __hip_atomic_load(p, __ATOMIC_RELAXED, __HIP_MEMORY_SCOPE_AGENT); }
__device__ __forceinline__ unsigned xb_add(unsigned* p, unsigned v) { return __hip_atomic_fetch_add(p, v, __ATOMIC_RELAXED, __HIP_MEMORY_SCOPE_AGENT); }
__device__ __forceinline__ unsigned xb_xcc_id() { return (unsigned)__builtin_amdgcn_s_getreg((3 << 11) | 20) & 0xFu; }
#define XB_SPIN(cond, bar) do { unsigned _sp = 0; while (cond) { __builtin_amdgcn_s_sleep(1); \
    if ((++_sp & 255u) == 0u) { if (xb_ld(&(bar)[XB_TMO])) break; if (_sp > XB_SPIN_CAP) { atomicAdd(&(bar)[XB_TMO], 1u); break; } } } } while (0)

struct XcdBarrier {
    unsigned* bar; unsigned x;
    volatile LAS unsigned* st;
};

__device__ __forceinline__ XcdBarrier xcd_barrier_post(unsigned* bar, volatile LAS unsigned* st) {
    XcdBarrier b; b.bar = bar; b.x = xb_xcc_id(); b.st = st;
    if (threadIdx.x == 0) (void)xb_add(&bar[XB_XCNT(b.x)], 1u);
    return b;
}
__device__ __forceinline__ void xcd_barrier_complete(unsigned* bar, unsigned x, unsigned& nloc, unsigned& nx) {
    const unsigned G = gridDim.x * gridDim.y * gridDim.z;
    unsigned sum, cnt, mine, sp = 0u;
    for (;;) {
        sum = 0u; cnt = 0u; mine = 0u;
#pragma unroll
        for (unsigned j = 0; j < 16; ++j) { const unsigned c = xb_ld(&bar[XB_XCNT(j)]); sum += c; cnt += (c > 0u) ? 1u : 0u; mine = (j == x) ? c : mine; }
        if (sum == G) break;
        __builtin_amdgcn_s_sleep(1);
        if ((++sp & 255u) == 0u) { if (xb_ld(&bar[XB_TMO])) break; if (sp > XB_SPIN_CAP) { atomicAdd(&bar[XB_TMO], 1u); break; } }
    }
    nloc = mine > 0u ? mine : 1u; nx = cnt > 0u ? cnt : 1u;
}

__device__ __forceinline__ void xcd_barrier(const XcdBarrier& b) {
    asm volatile("s_waitcnt vmcnt(0)" ::: "memory");
    __syncthreads();
    if (threadIdx.x == 0) {
        unsigned* bar = b.bar;
        __builtin_amdgcn_s_waitcnt(0);
        unsigned nloc = b.st[0], nx = b.st[1];
        if (nloc == 0u) { xcd_barrier_complete(bar, b.x, nloc, nx); b.st[0] = nloc; b.st[1] = nx; }
        const unsigned old = xb_add(&bar[XB_XSUB(b.x)], 1u);
        const unsigned gen = old / nloc;
        if (old + 1u == (gen + 1u) * nloc) {
            __builtin_amdgcn_fence(__ATOMIC_RELEASE, "agent");
            asm volatile("s_waitcnt vmcnt(0)" ::: "memory");
            const unsigned og = xb_add(&bar[XB_TOP], 1u);
            const unsigned tg = og / nx;
            if (og + 1u == (tg + 1u) * nx) xb_add(&bar[XB_TOPGEN], 1u);
            else XB_SPIN(xb_ld(&bar[XB_TOPGEN]) == tg, bar);
            __builtin_amdgcn_fence(__ATOMIC_ACQUIRE, "agent");
            xb_add(&bar[XB_XGEN(b.x)], 1u);
            asm volatile("s_waitcnt vmcnt(0)" ::: "memory");
        } else {
            XB_SPIN(xb_ld(&bar[XB_XGEN(b.x)]) == gen, bar);
            __builtin_amdgcn_fence(__ATOMIC_ACQUIRE, "agent");
            asm volatile("s_waitcnt vmcnt(0)" ::: "memory");
        }
    }
    __syncthreads();
}

struct Args { const float* in[23]; float* out; unsigned char* ws; int ph_lo, ph_hi, li, pad; };
#define CAS __attribute__((address_space(4)))
typedef const CAS Args& ArgsRef;
enum { I_X = 0, I_NORM1G, I_WIN, I_POOLW, I_POOLSC, I_CONVW, I_CONVB, I_WA, I_BA, I_WX, I_BX, I_LAM, I_QG, I_KG, I_OG, I_WOUT, I_NORM2G, I_WR, I_BR, I_WGU, I_BGU, I_WD, I_BD };

constexpr float WGU8_SCALE = 64.0f, WD8_SCALE = 64.0f, ACT8_SCALE = 4.0f, WOUT8_SCALE = 64.0f, WIN8_SCALE = 64.0f;
struct TrDesc { const float* W; int K, N; bf16* WT; const float* gk; int mode, item; };
__device__ __forceinline__ void tr_load(const TrDesc& d, float (&v)[32], float (&g)[8], int lane) {
    const int nblk = d.N / 32, kb = d.item / nblk, nb = d.item % nblk, k0 = 64 * kb, n0 = 32 * nb;
#pragma unroll
    for (int i = 0; i < 32; ++i) { const int kk = 2 * i + (lane >> 5); v[i] = __builtin_nontemporal_load(d.W + (size_t)(k0 + kk) * d.N + n0 + (lane & 31)); }
    const float* gp = (d.gk ? d.gk + k0 : d.W) + 8 * (lane & 7);
    const f32x4 g0 = *(const f32x4*)gp, g1 = *(const f32x4*)(gp + 4); const bool hg = d.gk != nullptr;
    g[0] = hg ? g0[0] : 1.f; g[1] = hg ? g0[1] : 1.f; g[2] = hg ? g0[2] : 1.f; g[3] = hg ? g0[3] : 1.f; g[4] = hg ? g1[0] : 1.f; g[5] = hg ? g1[1] : 1.f; g[6] = hg ? g1[2] : 1.f; g[7] = hg ? g1[3] : 1.f;
}
__device__ __forceinline__ void tr_finish(const TrDesc& d, float (&v)[32], const float (&g)[8], LAS float* scr, int lane) {
    const int nblk = d.N / 32, kb = d.item / nblk, nb = d.item % nblk, k0 = 64 * kb, n0 = 32 * nb; const int K = d.K;
#pragma unroll
    for (int i = 0; i < 32; ++i) { const int kk = 2 * i + (lane >> 5); scr[kk * 33 + (lane & 31)] = v[i]; }
    LDS_WAIT(); asm volatile("" ::: "memory");
    const int c = lane & 7;
#pragma unroll
    for (int j = 0; j < 4; ++j) { const int n = (lane >> 3) + 8 * j; const LAS float* s = scr + (8 * c) * 33 + n;
        float x[8];
#pragma unroll
        for (int q = 0; q < 8; ++q) x[q] = s[q * 33] * g[q];
        u32x4 o; o.x = cvt_pk_bf16(x[0], x[1]); o.y = cvt_pk_bf16(x[2], x[3]); o.z = cvt_pk_bf16(x[4], x[5]); o.w = cvt_pk_bf16(x[6], x[7]);
        int dn = n0 + n; const int mode = d.mode;
        if (mode == 5) {
            const int L = dn & 255; dn = (dn & ~255) + 128 * ((L >> 3) & 1) + 32 * (L >> 6) + 8 * ((L >> 4) & 3) + (L & 7);
            int w0 = __builtin_amdgcn_cvt_pk_fp8_f32(x[0] * WD8_SCALE, x[1] * WD8_SCALE, 0, false); w0 = __builtin_amdgcn_cvt_pk_fp8_f32(x[2] * WD8_SCALE, x[3] * WD8_SCALE, w0, true);
            int w1 = __builtin_amdgcn_cvt_pk_fp8_f32(x[4] * WD8_SCALE, x[5] * WD8_SCALE, 0, false); w1 = __builtin_amdgcn_cvt_pk_fp8_f32(x[6] * WD8_SCALE, x[7] * WD8_SCALE, w1, true);
            *(u32x2*)((unsigned char*)d.WT + (size_t)dn * K + k0 + 8 * c) = (u32x2){(unsigned)w0, (unsigned)w1}; continue; }
        if (mode == 4) {
            const int jj = dn & 255; dn = (jj >> 7) * 256 + (dn >> 8) * 128 + (jj & 127);
            int w0 = __builtin_amdgcn_cvt_pk_fp8_f32(x[0] * WGU8_SCALE, x[1] * WGU8_SCALE, 0, false); w0 = __builtin_amdgcn_cvt_pk_fp8_f32(x[2] * WGU8_SCALE, x[3] * WGU8_SCALE, w0, true);
            int w1 = __builtin_amdgcn_cvt_pk_fp8_f32(x[4] * WGU8_SCALE, x[5] * WGU8_SCALE, 0, false); w1 = __builtin_amdgcn_cvt_pk_fp8_f32(x[6] * WGU8_SCALE, x[7] * WGU8_SCALE, w1, true);
            *(u32x2*)((unsigned char*)d.WT + (size_t)dn * K + k0 + 8 * c) = (u32x2){(unsigned)w0, (unsigned)w1}; continue; }
        if (mode == 1) { const int jj = dn & 255; dn = (jj >> 7) * 256 + (dn >> 8) * 128 + (jj & 127); }
        if (mode == 3 || mode == 6 || ((mode == 2 || mode == 7) && (dn < C_Q || dn >= C_V))) {
            const int L = dn & 255; dn = (dn & ~255) + 128 * ((L >> 3) & 1) + 32 * (L >> 6) + 8 * ((L >> 4) & 3) + (L & 7); }
        else if (mode == 2 || mode == 7) {
            const int rem = (dn - C_Q) & 511, sec = (dn - C_Q) >> 9, head = rem >> 6, d2 = rem & 63;
            dn = C_Q + sec * 512 + (head >> 2) * 256 + (d2 >> 5) * 128 + (head & 3) * 32 + (d2 & 31); }
        if (mode == 6 || mode == 7) {
            int w0 = __builtin_amdgcn_cvt_pk_fp8_f32(x[0] * WOUT8_SCALE, x[1] * WOUT8_SCALE, 0, false); w0 = __builtin_amdgcn_cvt_pk_fp8_f32(x[2] * WOUT8_SCALE, x[3] * WOUT8_SCALE, w0, true);
            int w1 = __builtin_amdgcn_cvt_pk_fp8_f32(x[4] * WOUT8_SCALE, x[5] * WOUT8_SCALE, 0, false); w1 = __builtin_amdgcn_cvt_pk_fp8_f32(x[6] * WOUT8_SCALE, x[7] * WOUT8_SCALE, w1, true);
            *(u32x2*)((unsigned char*)d.WT + (size_t)dn * K + k0 + 8 * c) = (u32x2){(unsigned)w0, (unsigned)w1}; continue; }
        *(u32x4*)(d.WT + (size_t)dn * K + k0 + 8 * c) = o; }
    LDS_WAIT(); asm volatile("" ::: "memory");
}
__device__ __forceinline__ void cvt_row(const float* xrow, bf16* orow, float* ssq, int lane) {
    const f32x4* xr = (const f32x4*)xrow + lane;
    f32x4 v[4]; float s = 0.f;
#pragma unroll
    for (int j = 0; j < 4; ++j) { v[j] = xr[64 * j]; s += (v[j].x * v[j].x + v[j].y * v[j].y) + (v[j].z * v[j].z + v[j].w * v[j].w); }
    s = wave_sum(s);
    u32x2* o8 = (u32x2*)orow + lane;
#pragma unroll
    for (int j = 0; j < 4; ++j) { u32x2 w; w.x = cvt_pk_bf16(v[j].x, v[j].y); w.y = cvt_pk_bf16(v[j].z, v[j].w); o8[64 * j] = w; }
    if (lane == 0) *ssq = s;
}
__device__ __forceinline__ TrDesc tr_desc(ArgsRef a, int it) {
    unsigned char* ws = a.ws;
    constexpr int I_IN = 16 * 72, I_OUT = 16 * 32, I_R = 16, I_GU = 16 * 16, I_D = 4 * 32, I_S = 2;
    constexpr int PER_LAYER = I_IN + I_OUT + I_R + NEXP * I_GU + NEXP * I_D + 12 * I_S;
    const int l = it / PER_LAYER; int r = it % PER_LAYER; TrDesc d;
    if (r < I_IN) { d = TrDesc{a.in[I_WIN] + (size_t)l * DM * NIN, DM, NIN, (bf16*)(ws + WS_WIN) + (size_t)l * NIN * DM, a.in[I_NORM1G] + l * DM, l == 1 ? 7 : 2, r}; return d; } r -= I_IN;
    if (r < I_OUT) { d = TrDesc{a.in[I_WOUT] + (size_t)l * DM * DM, DM, DM, (bf16*)(ws + WS_WOUT) + (size_t)l * DM * DM, a.in[I_OG] + l * DM, l == 1 ? 6 : 3, r}; return d; } r -= I_OUT;
    if (r < I_R) { d = TrDesc{a.in[I_WR] + (size_t)l * DM * NEXP, DM, NEXP, (bf16*)(ws + WS_SMALL) + SM_WR + (size_t)l * NEXP * DM, a.in[I_NORM2G] + l * DM, 0, r}; return d; } r -= I_R;
    if (r < NEXP * I_GU) { const int e = r / I_GU; d = TrDesc{a.in[I_WGU] + (size_t)(l * NEXP + e) * DM * 512, DM, 512, (bf16*)(ws + WS_WGU + (size_t)(l * NEXP + e) * 512 * DM), a.in[I_NORM2G] + l * DM, 4, r % I_GU}; return d; } r -= NEXP * I_GU;
    if (r < NEXP * I_D) { const int e = r / I_D; d = TrDesc{a.in[I_WD] + (size_t)(l * NEXP + e) * EFF * DM, EFF, DM, (bf16*)(ws + WS_WD + (size_t)(l * NEXP + e) * DM * EFF), nullptr, 5, r % I_D}; return d; } r -= NEXP * I_D;
    { const int which = r / (4 * I_S), g = (r / I_S) % 4, sub = r % I_S;
      const float* src = a.in[which == 0 ? I_POOLW : (which == 1 ? I_WA : I_WX)] + (size_t)(l * 4 + g) * 4096;
      bf16* dst = (bf16*)(ws + WS_SMALL) + (which == 0 ? SM_POOLW : (which == 1 ? SM_WA : SM_WX)) + (size_t)(l * 4 + g) * 4096;
      d = TrDesc{src, 64, 64, dst, nullptr, 0, sub}; return d; }
}
__device__ __forceinline__ void phase_prologue(ArgsRef a, LAS unsigned char* lds, int wv) {
    const int tid = tid_from(wv), lane = tid & 63, wave = tid >> 6;
    LAS float* scr = (LAS float*)(lds + wave * 16384);
    const int gw = bid_here() * NWAVES + wave, NGW = gdim_here() * NWAVES;
    unsigned char* ws = a.ws;
    constexpr int PER_LAYER = 16 * 72 + 16 * 32 + 16 + NEXP * 16 * 16 + NEXP * 4 * 32 + 12 * 2;
    { int it = gw; float cur[32], nxt[32], gc[8], gn[8];
      TrDesc dc = tr_desc(a, it < 2 * PER_LAYER ? it : 0), dn = dc;
      if (it < 2 * PER_LAYER) tr_load(dc, cur, gc, lane);
#pragma unroll
      for (int i = 0; i < 8; ++i) gn[i] = gc[i];
      while (it < 2 * PER_LAYER) { const int itn = it + NGW;
          if (itn < 2 * PER_LAYER) { dn = tr_desc(a, itn); tr_load(dn, nxt, gn, lane); }
          tr_finish(dc, cur, gc, scr, lane);
#pragma unroll
          for (int i = 0; i < 32; ++i) cur[i] = nxt[i];
#pragma unroll
          for (int i = 0; i < 8; ++i) gc[i] = gn[i];
          dc = dn; it = itn; } }
    { float* ct = (float*)(ws + WS_ROPE); float* st = ct + SEQ * 32;
      for (int idx = bid_here() * NTHR + tid; idx < SEQ * 32; idx += gdim_here() * NTHR) {
          const int pos = idx >> 5, i = idx & 31;
          const float inv = __builtin_amdgcn_exp2f(-(float)i * 0.41524101186092029f);
          const float ang = (float)pos * inv;
          const double rev = (double)ang * 0.15915494309189535; const double fr = rev - __builtin_rint(rev);
          const float f = (float)fr;
          ct[idx] = __builtin_amdgcn_cosf(f); st[idx] = __builtin_amdgcn_sinf(f); } }
    { const float* __restrict__ X = a.in[I_X]; bf16* __restrict__ xb = (bf16*)(ws + WS_XB); float* __restrict__ ssq = (float*)(ws + WS_SSQ);
      for (int m0 = gw * 4; m0 < NT; m0 += NGW * 4) { f32x4 v[4][4];
#pragma unroll
          for (int u = 0; u < 4; ++u)
#pragma unroll
              for (int j = 0; j < 4; ++j) v[u][j] = __builtin_nontemporal_load((const f32x4*)(X + (size_t)(m0 + u) * DM) + lane + 64 * j);
#pragma unroll
          for (int u = 0; u < 4; ++u) { float s = 0.f;
#pragma unroll
              for (int j = 0; j < 4; ++j) s += (v[u][j].x * v[u][j].x + v[u][j].y * v[u][j].y) + (v[u][j].z * v[u][j].z + v[u][j].w * v[u][j].w);
              s = wave_sum(s);
#pragma unroll
              for (int j = 0; j < 4; ++j) { u32x2 w; w.x = cvt_pk_bf16(v[u][j].x, v[u][j].y); w.y = cvt_pk_bf16(v[u][j].z, v[u][j].w); *((u32x2*)(xb + (size_t)(m0 + u) * DM) + lane + 64 * j) = w; }
              if (lane == 0) ssq[m0 + u] = s; } } }
}

struct EpiIn {
    static constexpr bool PERM = true; static constexpr int NSTORE = 16; static constexpr bool PEEL = false;
    bf16* O; bf16* HM; const float* ssq; const float* qg; const float* kg; const float* ct; const float* st; LAS unsigned char* stage; float oscale;
    __device__ __forceinline__ void rows16(LAS unsigned char* stg, int fr, int fq, int c0, int c1, const u32x4& w0, const u32x4& w1, bf16* gbase, int stride) const {
        *(LAS u32x4*)(stg + fr * 128 + ((c0 ^ (fr & 7)) << 4)) = w0;
        *(LAS u32x4*)(stg + fr * 128 + ((c1 ^ (fr & 7)) << 4)) = w1;
        const int l = fr + 16 * fq, rr = l >> 3, cc = l & 7;
        const u32x4 a = *(const LAS u32x4*)(stg + rr * 128 + ((cc ^ rr) << 4)), b = *(const LAS u32x4*)(stg + (rr + 8) * 128 + ((cc ^ rr) << 4));
        *(u32x4*)(gbase + (size_t)rr * stride + cc * 8) = a;
        *(u32x4*)(gbase + (size_t)(rr + 8) * stride + cc * 8) = b;
    }
    __device__ __forceinline__ void operator()(const f32x4 (&acc)[2][2][4][2], const pg8::Unit& u, int wr, int wc, int fr, int fq) const {
        const int rbase0 = u.pm * 256 + wr * 64;
        LAS unsigned char* stg = stage + (wr * 4 + wc) * 2048;
        float rsv[2][4];
#pragma unroll
        for (int ai = 0; ai < 2; ++ai)
#pragma unroll
            for (int m = 0; m < 4; ++m) rsv[ai][m] = ssq[rbase0 + ai * 128 + m * 16 + fr];
        const float osc = oscale;
        if (u.pn >= 3 && u.pn < 7) {
            const bool isq = u.pn < 5; const float* gp = (isq ? qg : kg) + 8 * fq; const float gs = isq ? (0.125f * 1.4426950408889634f) : 1.0f;
            f32x4 g[2][2];
#pragma unroll
            for (int bj = 0; bj < 2; ++bj)
#pragma unroll
                for (int n = 0; n < 2; ++n) g[bj][n] = *(const f32x4*)(gp + 32 * bj + 4 * n);
            const int pos0 = (rbase0 + fr) & (SEQ - 1);
            f32x4 cb[2], sb[2], cd[2], sd[2], ce[2], se[2];
#pragma unroll
            for (int n = 0; n < 2; ++n) { cb[n] = *(const f32x4*)(ct + pos0 * 32 + 8 * fq + 4 * n); sb[n] = *(const f32x4*)(st + pos0 * 32 + 8 * fq + 4 * n);
                cd[n] = *(const f32x4*)(ct + 16 * 32 + 8 * fq + 4 * n); sd[n] = *(const f32x4*)(st + 16 * 32 + 8 * fq + 4 * n);
                ce[n] = *(const f32x4*)(ct + 128 * 32 + 8 * fq + 4 * n); se[n] = *(const f32x4*)(st + 128 * 32 + 8 * fq + 4 * n); }
            bf16* hb = HM + (size_t)(u.pn >= 5 ? 1 : 0) * NT * 512 + ((size_t)((rbase0 >> 12) * 8 + 4 * ((u.pn - 3) & 1) + wc) * SEQ + (rbase0 & (SEQ - 1))) * 64;
#pragma unroll
            for (int ai = 0; ai < 2; ++ai) { f32x4 cc[2], sc[2];
#pragma unroll
                for (int n = 0; n < 2; ++n) { if (ai == 0) { cc[n] = cb[n]; sc[n] = sb[n]; } else { cc[n] = cb[n] * ce[n] - sb[n] * se[n]; sc[n] = sb[n] * ce[n] + cb[n] * se[n]; } }
#pragma unroll
                for (int m = 0; m < 4; ++m) { const float rs = __builtin_amdgcn_rsqf(rsv[ai][m] * (1.0f / DM) + EPS) * osc;
                    f32x4 v[2][2]; float ss = 0.f;
#pragma unroll
                    for (int bj = 0; bj < 2; ++bj)
#pragma unroll
                        for (int n = 0; n < 2; ++n) { v[bj][n] = acc[ai][bj][m][n] * rs; ss += (v[bj][n][0] * v[bj][n][0] + v[bj][n][1] * v[bj][n][1]) + (v[bj][n][2] * v[bj][n][2] + v[bj][n][3] * v[bj][n][3]); }
                    ss = xsum32(xsum16(ss));
                    const float rr = __builtin_amdgcn_rsqf(ss * (1.0f / 64.0f) + EPS) * gs;
#pragma unroll
                    for (int bj = 0; bj < 2; ++bj)
#pragma unroll
                        for (int n = 0; n < 2; ++n) v[bj][n] = v[bj][n] * rr * g[bj][n];
                    const f32x4 o00 = v[0][0] * cc[0] - v[1][0] * sc[0], o01 = v[0][1] * cc[1] - v[1][1] * sc[1], o10 = v[1][0] * cc[0] + v[0][0] * sc[0], o11 = v[1][1] * cc[1] + v[0][1] * sc[1];
                    u32x4 w0, w1; w0.x = cvt_pk_bf16(o00[0], o00[1]); w0.y = cvt_pk_bf16(o00[2], o00[3]); w0.z = cvt_pk_bf16(o01[0], o01[1]); w0.w = cvt_pk_bf16(o01[2], o01[3]);
                    w1.x = cvt_pk_bf16(o10[0], o10[1]); w1.y = cvt_pk_bf16(o10[2], o10[3]); w1.z = cvt_pk_bf16(o11[0], o11[1]); w1.w = cvt_pk_bf16(o11[2], o11[3]);
                    rows16(stg, fr, fq, fq, 4 + fq, w0, w1, hb + (size_t)(ai * 128 + m * 16) * 64, 64);
                    if (m < 3) {
#pragma unroll
                        for (int n = 0; n < 2; ++n) { const f32x4 c2 = cc[n] * cd[n] - sc[n] * sd[n]; sc[n] = sc[n] * cd[n] + cc[n] * sd[n]; cc[n] = c2; } } } }
            return;
        }
        const bool isv = u.pn >= 7; const int stride = isv ? 64 : NPJ;
        bf16* ob = isv ? HM + (size_t)2 * NT * 512 + ((size_t)((rbase0 >> 12) * 8 + 4 * (u.pn - 7) + wc) * SEQ + (rbase0 & (SEQ - 1))) * 64
                       : O + (size_t)rbase0 * NPJ + u.pn * 256 + wc * 64;
#pragma unroll
        for (int ai = 0; ai < 2; ++ai)
#pragma unroll
            for (int m = 0; m < 4; ++m) { const float rs = __builtin_amdgcn_rsqf(rsv[ai][m] * (1.0f / DM) + EPS) * osc;
                u32x4 w[2];
#pragma unroll
                for (int bj = 0; bj < 2; ++bj) { const f32x4 v0 = acc[ai][bj][m][0] * rs, v1 = acc[ai][bj][m][1] * rs;
                    w[bj].x = cvt_pk_bf16(v0[0], v0[1]); w[bj].y = cvt_pk_bf16(v0[2], v0[3]); w[bj].z = cvt_pk_bf16(v1[0], v1[1]); w[bj].w = cvt_pk_bf16(v1[2], v1[3]); }
                rows16(stg, fr, fq, 2 * fq, 2 * fq + 1, w[0], w[1], ob + (size_t)(ai * 128 + m * 16) * stride, stride); }
    }
};
struct EpiOut {
    static constexpr bool PERM = true; static constexpr int NSTORE = 32; static constexpr bool PEEL = false;
    bf16* xb; float* ssqp; unsigned char* xb8; float oscale;
    __device__ __forceinline__ void operator()(const f32x4 (&acc)[2][2][4][2], const pg8::Unit& u, int wr, int wc, int fr, int fq) const {
        const int row0 = u.pm * 256 + wr * 64 + fr, col0 = u.pn * 256 + wc * 64 + fq * 16;
        u32x4 xi[2][4][2];
#pragma unroll
        for (int am = 0; am < 2; ++am)
#pragma unroll
            for (int mm = 0; mm < 4; ++mm) { const size_t off = (size_t)(row0 + am * 128 + mm * 16) * DM + col0; xi[am][mm][0] = *(const u32x4*)(xb + off); xi[am][mm][1] = *(const u32x4*)(xb + off + 8); }
        asm volatile("" ::: "memory");
#pragma unroll
        for (int am = 0; am < 2; ++am) {
#pragma unroll
            for (int mm = 0; mm < 4; ++mm) { const int ai = am, m = mm; const int row = row0 + ai * 128 + m * 16; const size_t off = (size_t)row * DM + col0; float s = 0.f; u32x4 w8;
#pragma unroll
                for (int bj = 0; bj < 2; ++bj) { const u32x4 x = xi[am][mm][bj];
                    const f32x4 o0 = (f32x4){bflo(x.x), bfhi(x.x), bflo(x.y), bfhi(x.y)} + acc[ai][bj][m][0] * oscale, o1 = (f32x4){bflo(x.z), bfhi(x.z), bflo(x.w), bfhi(x.w)} + acc[ai][bj][m][1] * oscale;
                    s += ((o0[0] * o0[0] + o0[1] * o0[1]) + (o0[2] * o0[2] + o0[3] * o0[3])) + ((o1[0] * o1[0] + o1[1] * o1[1]) + (o1[2] * o1[2] + o1[3] * o1[3]));
                    u32x4 w; w.x = cvt_pk_bf16(o0[0], o0[1]); w.y = cvt_pk_bf16(o0[2], o0[3]); w.z = cvt_pk_bf16(o1[0], o1[1]); w.w = cvt_pk_bf16(o1[2], o1[3]);
                    *(u32x4*)(xb + off + bj * 8) = w;
                    int f0 = __builtin_amdgcn_cvt_pk_fp8_f32(o0[0], o0[1], 0, false); f0 = __builtin_amdgcn_cvt_pk_fp8_f32(o0[2], o0[3], f0, true);
                    int f1 = __builtin_amdgcn_cvt_pk_fp8_f32(o1[0], o1[1], 0, false); f1 = __builtin_amdgcn_cvt_pk_fp8_f32(o1[2], o1[3], f1, true);
                    if (bj == 0) { w8.x = (unsigned)f0; w8.y = (unsigned)f1; } else { w8.z = (unsigned)f0; w8.w = (unsigned)f1; } }
                *(u32x4*)(xb8 + off) = w8;
                s = xsum32(xsum16(s));
                if (fq == 0) ssqp[(size_t)row * 16 + u.pn * 4 + wc] = s; }
            asm volatile("" ::: "memory"); }
    }
};

template <int MODE> struct MoeOrder {
    static constexpr bool GATHER = (MODE == 0 || MODE == 2);
    const LAS int* tab; int npn, G, c; const int* list; int dup;
    __device__ __forceinline__ bool next(int i, pg8::Unit& u) const {
        const int ii = i >> dup; const int total = __builtin_amdgcn_readfirstlane(tab[64]); const int nfr = total / G, nfu = nfr * npn;
        int gb;
        if (ii < nfu) { gb = (ii / npn) * G + c; u.pn = ii % npn; }
        else { const int L = (ii - nfu) * G + c; gb = nfr * G + L / npn; u.pn = L % npn; if (gb >= total) return false; }
        const int e = __builtin_amdgcn_readfirstlane((int)((const LAS unsigned char*)(tab + 80))[gb]);
        u.e = e; u.pm = gb; u.aux = gb - __builtin_amdgcn_readfirstlane(tab[32 + e]); return true;
    }
    __device__ __forceinline__ unsigned a_voff(const pg8::Unit& u, int R, int C) const {
        if constexpr (MODE == 0) { const int pos = u.aux * 256 + R; const int ne = tab[u.e]; int tok = 0; if (pos < ne) tok = list[u.e * NT + pos] >> 2; return (unsigned)(tok * DM + C) * 2u; }
        else if constexpr (MODE == 2) { const int pos = u.aux * 256 + R; const int ne = tab[u.e]; int tok = list[u.e * NT + (pos < ne ? pos : 0)] >> 2; if (pos >= ne) tok = 0; return (unsigned)(tok * (DM / 2) + C) * 2u; }
        else if constexpr (MODE == 3) return (unsigned)((R & 127) * (EFF / 2) + C) * 2u;
        else return (unsigned)((R & 127) * EFF + C) * 2u;
    }
    __device__ __forceinline__ int a_raw(const pg8::Unit& u, int R) const { const int pos = u.aux * 256 + R; const int ne = tab[u.e]; return list[u.e * NT + (pos < ne ? pos : 0)]; }
    __device__ __forceinline__ unsigned a_voff_raw(const pg8::Unit& u, int R, int C, int raw) const { const int pos = u.aux * 256 + R; const int ne = tab[u.e]; int tok = raw >> 2; if (pos >= ne) tok = 0;
        return (unsigned)(tok * (MODE == 2 ? DM / 2 : DM) + C) * 2u; }
    __device__ __forceinline__ unsigned a_soff(const pg8::Unit& u, int h) const { if constexpr (MODE == 1) return (unsigned)((u.pm * 256 + h * 128) * EFF) * 2u; else if constexpr (MODE == 3) return (unsigned)((u.pm * 256 + h * 128) * EFF); else return 0u; }
    __device__ __forceinline__ size_t b_off(const pg8::Unit& u) const {
        if constexpr (MODE == 0) return ((size_t)u.e * 512 + (size_t)u.pn * 256) * DM * 2;
        else if constexpr (MODE == 2) return ((size_t)u.e * 512 + (size_t)u.pn * 256) * DM;
        else if constexpr (MODE == 3) return ((size_t)u.e * DM + (size_t)u.pn * 256) * EFF;
        else return ((size_t)u.e * DM + (size_t)u.pn * 256) * EFF * 2;
    }
};
struct EpiGU {
    static constexpr bool PERM = true; static constexpr int NSTORE = 8; static constexpr bool PEEL = true;
    unsigned char* act; const float* lrstd; const float* bgu;
    __device__ __forceinline__ void operator()(const f32x4 (&acc)[2][2][4][2], const pg8::Unit& u, int wr, int wc, int fr, int fq) const {
        const int r0 = wr * 64 + fr, cl0 = wc * 32 + 8 * fq;
        const float* bg = bgu + u.e * 512 + u.pn * 128 + cl0;
        const f32x4 bg0 = *(const f32x4*)(bg), bg1 = *(const f32x4*)(bg + 4), bu0 = *(const f32x4*)(bg + 256), bu1 = *(const f32x4*)(bg + 260);
        float rsv[2][4];
#pragma unroll
        for (int ai = 0; ai < 2; ++ai)
#pragma unroll
            for (int m = 0; m < 4; ++m) rsv[ai][m] = lrstd[(size_t)u.e * NT + u.aux * 256 + r0 + ai * 128 + m * 16];
#pragma unroll
        for (int ai = 0; ai < 2; ++ai)
#pragma unroll
            for (int m = 0; m < 4; ++m) { const int r = r0 + ai * 128 + m * 16; const float rs = rsv[ai][m] * (1.0f / WGU8_SCALE);
                const f32x4 g0 = acc[ai][0][m][0] * rs + bg0, g1 = acc[ai][0][m][1] * rs + bg1, u0 = acc[ai][1][m][0] * rs + bu0, u1 = acc[ai][1][m][1] * rs + bu1;
                f32x4 ga0, ga1, ua0, ua1;
#pragma unroll
                for (int j = 0; j < 4; ++j) { ga0[j] = fminf(g0[j], 7.0f); ga1[j] = fminf(g1[j], 7.0f); ua0[j] = __builtin_amdgcn_fmed3f(u0[j], -7.0f, 7.0f); ua1[j] = __builtin_amdgcn_fmed3f(u1[j], -7.0f, 7.0f); }
                const f32x4 t0 = ga0 * (-1.702f * 1.4426950408889634f), t1 = ga1 * (-1.702f * 1.4426950408889634f);
                f32x4 e0, e1;
#pragma unroll
                for (int j = 0; j < 4; ++j) { e0[j] = __builtin_amdgcn_exp2f(t0[j]); e1[j] = __builtin_amdgcn_exp2f(t1[j]); }
                const f32x4 d0 = e0 + 1.0f, d1 = e1 + 1.0f;
                f32x4 s0, s1;
#pragma unroll
                for (int j = 0; j < 4; ++j) { s0[j] = __builtin_amdgcn_rcpf(d0[j]); s1[j] = __builtin_amdgcn_rcpf(d1[j]); }
                const f32x4 o0 = (ua0 * ACT8_SCALE + ACT8_SCALE) * (ga0 * s0), o1 = (ua1 * ACT8_SCALE + ACT8_SCALE) * (ga1 * s1);
                int w0 = __builtin_amdgcn_cvt_pk_fp8_f32(o0[0], o0[1], 0, false); w0 = __builtin_amdgcn_cvt_pk_fp8_f32(o0[2], o0[3], w0, true);
                int w1 = __builtin_amdgcn_cvt_pk_fp8_f32(o1[0], o1[1], 0, false); w1 = __builtin_amdgcn_cvt_pk_fp8_f32(o1[2], o1[3], w1, true);
                *(u32x2*)(act + (size_t)(u.pm * 256 + r) * EFF + u.pn * 128 + cl0) = (u32x2){(unsigned)w0, (unsigned)w1}; }
    }
};
constexpr float Y8_SCALE = 32.0f;
struct EpiDown {
    static constexpr bool PERM = true; static constexpr int NSTORE = 8; static constexpr bool PEEL = true;
    unsigned char* y; const int* list; const float* lgate; const float* bd; const LAS int* tab;
    __device__ __forceinline__ void operator()(const f32x4 (&acc)[2][2][4][2], const pg8::Unit& u, int wr, int wc, int fr, int fq) const {
        const int r0 = wr * 64 + fr, col0 = u.pn * 256 + wc * 64 + fq * 16; const int ne = tab[u.e];
        const float* bp = bd + u.e * DM + col0;
        float gt[2][4]; f32x4 bb[2][2];
#pragma unroll
        for (int ai = 0; ai < 2; ++ai)
#pragma unroll
            for (int m = 0; m < 4; ++m) { const int pos = u.aux * 256 + r0 + ai * 128 + m * 16; gt[ai][m] = lgate[(size_t)u.e * NT + (pos < ne ? pos : 0)]; if (pos >= ne) gt[ai][m] = 0.f; }
#pragma unroll
        for (int bj = 0; bj < 2; ++bj) { bb[bj][0] = *(const f32x4*)(bp + bj * 8); bb[bj][1] = *(const f32x4*)(bp + bj * 8 + 4); }
#pragma unroll
        for (int ai = 0; ai < 2; ++ai) {
#pragma unroll
            for (int m = 0; m < 4; ++m) { unsigned char* rowp = y + (size_t)(u.pm * 256 + r0 + ai * 128 + m * 16) * DM + col0; const float g = gt[ai][m] * Y8_SCALE; u32x4 wv4;
#pragma unroll
                for (int bj = 0; bj < 2; ++bj) { const f32x4 b0 = bb[bj][0], b1 = bb[bj][1];
                    const f32x4 v0 = (acc[ai][bj][m][0] * (1.0f / (WD8_SCALE * ACT8_SCALE)) + b0) * g, v1 = (acc[ai][bj][m][1] * (1.0f / (WD8_SCALE * ACT8_SCALE)) + b1) * g;
                    int w0 = __builtin_amdgcn_cvt_pk_fp8_f32(v0[0], v0[1], 0, false); w0 = __builtin_amdgcn_cvt_pk_fp8_f32(v0[2], v0[3], w0, true);
                    int w1 = __builtin_amdgcn_cvt_pk_fp8_f32(v1[0], v1[1], 0, false); w1 = __builtin_amdgcn_cvt_pk_fp8_f32(v1[2], v1[3], w1, true);
                    if (bj == 0) { wv4.x = (unsigned)w0; wv4.y = (unsigned)w1; } else { wv4.z = (unsigned)w0; wv4.w = (unsigned)w1; } }
                *(u32x4*)rowp = wv4; } }
    }
};
__device__ __forceinline__ void moe_tables(LAS int* tab, const unsigned* cnt, int wv) {
    __syncthreads();
    const int tid_ = tid_from(wv);
    if (tid_ < 64) {
        const int ln = tid_ & 63; const int n = (ln < NEXP) ? (int)__hip_atomic_load(cnt + (ln & 31), RLX_AGENT) : 0; const int nb = (n + 255) >> 8; int incl = nb;
#pragma unroll
        for (int d = 1; d < 32; d <<= 1) { const int v = __shfl_up(incl, d, 64); if (ln >= d) incl += v; }
        if (ln < NEXP) { tab[ln] = n; tab[32 + ln] = incl - nb; }
        if (ln == NEXP - 1) tab[64] = incl; }
    __syncthreads();
    { LAS unsigned char* eb = (LAS unsigned char*)(tab + 80);
      if (tid_ < NEXP) { const int b0 = tab[32 + tid_], b1 = b0 + ((tab[tid_] + 255) >> 8);
          for (int gb = b0; gb < b1; ++gb) eb[gb] = (unsigned char)tid_; } }
    __syncthreads();
}

__device__ __forceinline__ void phase_qkprep(ArgsRef a, int layer, int wv, bool dry) {
    const int tid = tid_from(wv), lane = tid & 63, wave = tid >> 6;
    const int gw = bid_here() * NWAVES + wave, NGW = gdim_here() * NWAVES;
    bf16* proj = (bf16*)(a.ws + WS_PROJ);
    const float* __restrict__ ct = (const float*)(a.ws + WS_ROPE); const float* __restrict__ st = ct + SEQ * 32;
    const int d0 = (lane & 7) * 8, p0 = d0 & 31;
    float gq[8], gk[8];
#pragma unroll
    for (int j = 0; j < 8; ++j) { gq[j] = a.in[I_QG][layer * 64 + d0 + j] * (0.125f * 1.4426950408889634f); gk[j] = a.in[I_KG][layer * 64 + d0 + j]; }
    const bool second = (lane & 4) != 0;
    constexpr int TB = 4;
    for (int t0 = gw * TB; t0 < NT; t0 += NGW * TB) {
        u32x4 w[TB][2]; f32x4 cs[TB][4];
#pragma unroll
        for (int u = 0; u < TB; ++u) { const int t = t0 + u, pos = t & (SEQ - 1);
            w[u][0] = *(const u32x4*)(proj + (size_t)t * NIN + C_Q + lane * 8); w[u][1] = *(const u32x4*)(proj + (size_t)t * NIN + C_Q + 512 + lane * 8);
            cs[u][0] = *(const f32x4*)(ct + pos * 32 + p0); cs[u][1] = *(const f32x4*)(ct + pos * 32 + p0 + 4); cs[u][2] = *(const f32x4*)(st + pos * 32 + p0); cs[u][3] = *(const f32x4*)(st + pos * 32 + p0 + 4); }
#pragma unroll
        for (int u = 0; u < TB; ++u) { const int t = t0 + u;
            float c[8], s[8];
#pragma unroll
            for (int j = 0; j < 4; ++j) { c[j] = cs[u][0][j]; c[4 + j] = cs[u][1][j]; s[j] = cs[u][2][j]; s[4 + j] = cs[u][3][j]; }
#pragma unroll
            for (int i = 0; i < 2; ++i) {
                const u32x4 ww = w[u][i];
                float x[8]; x[0] = bflo(ww.x); x[1] = bfhi(ww.x); x[2] = bflo(ww.y); x[3] = bfhi(ww.y); x[4] = bflo(ww.z); x[5] = bfhi(ww.z); x[6] = bflo(ww.w); x[7] = bfhi(ww.w);
                float ss = 0.f;
#pragma unroll
                for (int j = 0; j < 8; ++j) ss += x[j] * x[j];
                ss += __shfl_xor(ss, 1); ss += __shfl_xor(ss, 2); ss += __shfl_xor(ss, 4);
                const float rs = __builtin_amdgcn_rsqf(ss * (1.0f / 64.0f) + EPS);
                float o[8];
#pragma unroll
                for (int j = 0; j < 8; ++j) { const float yv = x[j] * rs * (i == 0 ? gq[j] : gk[j]); const float pv = __shfl_xor(yv, 4);
                    o[j] = second ? (yv * c[j] + pv * s[j]) : (yv * c[j] - pv * s[j]); }
                u32x4 r; r.x = cvt_pk_bf16(o[0], o[1]); r.y = cvt_pk_bf16(o[2], o[3]); r.z = cvt_pk_bf16(o[4], o[5]); r.w = cvt_pk_bf16(o[6], o[7]);
                if (!dry || o[0] == 12345.678f) *(u32x4*)(proj + (size_t)t * NIN + C_Q + i * 512 + lane * 8) = r;
            } }
    }
}

__device__ __forceinline__ void phase_pool(ArgsRef a, LAS unsigned char* lds, int layer, int wv) {
    const int tid = tid_from(wv), lane = tid & 63, wave = __builtin_amdgcn_readfirstlane(tid >> 6);
    const bf16* proj = (const bf16*)(a.ws + WS_PROJ); bf16* YP = (bf16*)(a.ws + WS_YP); float* SSQPOOL = (float*)(a.ws + WS_SSQPOOL);
    const int g = wave & 3, w = 2 << g, lr = lane & 15, lq = lane >> 4;
    constexpr int US = 72;
    LAS bf16* Uw = (LAS bf16*)(lds + wave * 11520);
    LAS bf16* Xw = (LAS bf16*)(lds + wave * 11520 + 6784);
    const bf16* pw = (const bf16*)(a.ws + WS_SMALL) + SM_POOLW + (size_t)(layer * 4 + g) * 4096;
    bf16x8 bw[4][2]; float psc[4];
#pragma unroll
    for (int et = 0; et < 4; ++et) {
#pragma unroll
        for (int ks = 0; ks < 2; ++ks) bw[et][ks] = *(const bf16x8*)(pw + (et * 16 + lr) * 64 + ks * 32 + lq * 8);
        psc[et] = a.in[I_POOLSC][layer * 256 + g * 64 + et * 16 + lr]; }
    __syncthreads();
    const int nstreams = gdim_here() * 2;
    u32x4 pre[6];
#define POOL_FETCH(TK) do { const int t0_ = (TK) * 32, s0_ = t0_ & (SEQ - 1); _Pragma("unroll") for (int j = 0; j < 6; ++j) { const int id = lane + 64 * j; const int row = id >> 3, c8 = (id & 7) * 8; \
            pre[j] = (u32x4){0u, 0u, 0u, 0u}; if (id < 47 * 8 && s0_ - 15 + row >= 0) pre[j] = __builtin_nontemporal_load((const u32x4*)(proj + (size_t)(t0_ - 15 + row) * NPJ + C_POOL + g * 64 + c8)); } } while (0)
    { const int tk0 = bid_here() * 2 + (wave >> 2); if (tk0 < NT / 32) POOL_FETCH(tk0); }
    for (int tk = bid_here() * 2 + (wave >> 2); tk < NT / 32; tk += nstreams) {
        const int t0 = tk * 32, s0 = t0 & (SEQ - 1);
#pragma unroll
        for (int j = 0; j < 6; ++j) { const int id = lane + 64 * j;
            if (id < 47 * 8) { const int row = id >> 3, c8 = (id & 7) * 8; *(LAS u32x4*)(Uw + row * US + c8) = pre[j]; } }
        if (tk + nstreams < NT / 32) POOL_FETCH(tk + nstreams);
        LDS_WAIT(); asm volatile("" ::: "memory");
        { float u[47], pl[32];
#pragma unroll
          for (int r = 0; r < 47; ++r) u[r] = bf2f(Uw[r * US + lane]);
#define POOL_RUN(W) do { float sum = 0.f; _Pragma("unroll") for (int j = 1; j < (W); ++j) sum += u[15 - j]; \
              _Pragma("unroll") for (int tl = 0; tl < 32; ++tl) { const float cur = u[15 + tl]; sum += cur; const int cnt = min((W), s0 + tl + 1); \
                  pl[tl] = sum * __builtin_amdgcn_rcpf((float)cnt) - cur; sum -= u[15 + tl - (W) + 1]; } } while (0)
          if (g == 0) POOL_RUN(2); else if (g == 1) POOL_RUN(4); else if (g == 2) POOL_RUN(8); else POOL_RUN(16);
#undef POOL_RUN
#pragma unroll
          for (int tl = 0; tl < 32; ++tl) Xw[tl * US + lane] = f2bf(pl[tl]); }
        LDS_WAIT(); asm volatile("" ::: "memory");
        f32x4 acc[2][4];
#pragma unroll
        for (int rt = 0; rt < 2; ++rt) { const bf16x8 a0 = *(const LAS bf16x8*)(Xw + (rt * 16 + lr) * US + lq * 8), a1 = *(const LAS bf16x8*)(Xw + (rt * 16 + lr) * US + 32 + lq * 8);
#pragma unroll
            for (int et = 0; et < 4; ++et) { acc[rt][et] = __builtin_amdgcn_mfma_f32_16x16x32_bf16(a0, bw[et][0], (f32x4){0.f, 0.f, 0.f, 0.f}, 0, 0, 0); acc[rt][et] = __builtin_amdgcn_mfma_f32_16x16x32_bf16(a1, bw[et][1], acc[rt][et], 0, 0, 0); } }
#pragma unroll
        for (int rt = 0; rt < 2; ++rt)
#pragma unroll
            for (int reg = 0; reg < 4; ++reg) { const int tl = rt * 16 + lq * 4 + reg; float s = 0.f;
#pragma unroll
                for (int et = 0; et < 4; ++et) { const float y = acc[rt][et][reg] * psc[et]; s += y * y; Uw[tl * 64 + et * 16 + lr] = f2bf(y); }
                s = row16_sum(s);
                if (lr == 0) SSQPOOL[(size_t)(t0 + tl) * 4 + g] = s; }
        LDS_WAIT(); asm volatile("" ::: "memory");
#pragma unroll
        for (int j = 0; j < 4; ++j) { const int id = lane + 64 * j, row = id >> 3, c8 = (id & 7) * 8;
            *(u32x4*)(YP + (size_t)(t0 + row) * 256 + g * 64 + c8) = *(const LAS u32x4*)(Uw + row * 64 + c8); }
        LDS_WAIT(); asm volatile("" ::: "memory");
    }
}

__device__ __forceinline__ void phase_lru_a(ArgsRef a, LAS unsigned char* lds, int layer, int wv) {
    const int tid = tid_from(wv), lane = tid & 63, wave = __builtin_amdgcn_readfirstlane(tid >> 6);
    const bf16* proj = (const bf16*)(a.ws + WS_PROJ);
    bf16* HL = (bf16*)(a.ws + WS_HL); bf16* PL = (bf16*)(a.ws + WS_PL);
    float* AGGH = (float*)(a.ws + WS_AGGH); float* AGGP = (float*)(a.ws + WS_AGGP);
    const int n = wave & 3, lr = lane & 15, lq = lane >> 4;
    constexpr int US = 72;
    LAS bf16* Uw = (LAS bf16*)(lds + wave * 13824);
    LAS bf16* Xw = (LAS bf16*)(lds + wave * 13824 + 5120);
    LAS bf16* Pw = (LAS bf16*)(lds + wave * 13824 + 9728);
    const int chl = n * 64 + lane;
    const float cw0 = a.in[I_CONVW][(layer * 4 + 0) * 256 + chl], cw1 = a.in[I_CONVW][(layer * 4 + 1) * 256 + chl], cw2 = a.in[I_CONVW][(layer * 4 + 2) * 256 + chl], cw3 = a.in[I_CONVW][(layer * 4 + 3) * 256 + chl];
    const float cb = a.in[I_CONVB][layer * 256 + chl];
    const bf16* wa = (const bf16*)(a.ws + WS_SMALL) + SM_WA + (size_t)(layer * 4 + n) * 4096;
    const bf16* wx = (const bf16*)(a.ws + WS_SMALL) + SM_WX + (size_t)(layer * 4 + n) * 4096;
    bf16x8 ba[4][2], bx[4][2]; float bav[4], bxv[4], sp[4];
#pragma unroll
    for (int et = 0; et < 4; ++et) {
#pragma unroll
        for (int ks = 0; ks < 2; ++ks) { const int wo = (et * 16 + lr) * 64 + ks * 32 + lq * 8; ba[et][ks] = *(const bf16x8*)(wa + wo); bx[et][ks] = *(const bf16x8*)(wx + wo); }
        const int chn = layer * 256 + n * 64 + et * 16 + lr; bav[et] = a.in[I_BA][chn]; bxv[et] = a.in[I_BX][chn]; sp[et] = log1pf(expf(-a.in[I_LAM][chn])); }
    __syncthreads();
    const int nstreams = gdim_here() * 2;
    u32x4 pre[5];
#define LRU_FETCH(CK) do { const int t0_ = (CK) * LRU_CH, s0_ = t0_ & (SEQ - 1); _Pragma("unroll") for (int j = 0; j < 5; ++j) { const int id = lane + 64 * j; const int row = id >> 3, c8 = (id & 7) * 8; \
            pre[j] = (u32x4){0u, 0u, 0u, 0u}; if (id < 35 * 8 && s0_ - 3 + row >= 0) pre[j] = __builtin_nontemporal_load((const u32x4*)(proj + (size_t)(t0_ - 3 + row) * NPJ + C_LRU + n * 64 + c8)); } } while (0)
    { const int ck0 = bid_here() * 2 + (wave >> 2); if (ck0 < NT / LRU_CH) LRU_FETCH(ck0); }
    for (int ck = bid_here() * 2 + (wave >> 2); ck < NT / LRU_CH; ck += nstreams) {
        const int t0 = ck * LRU_CH, s0 = t0 & (SEQ - 1);
#pragma unroll
        for (int j = 0; j < 5; ++j) { const int id = lane + 64 * j;
            if (id < 35 * 8) { const int row = id >> 3, c8 = (id & 7) * 8; *(LAS u32x4*)(Uw + row * US + c8) = pre[j]; } }
        if (ck + nstreams < NT / LRU_CH) LRU_FETCH(ck + nstreams);
        LDS_WAIT(); asm volatile("" ::: "memory");
        { float u[LRU_CH + 3];
#pragma unroll
          for (int r = 0; r < LRU_CH + 3; ++r) u[r] = bf2f(Uw[r * US + lane]);
#pragma unroll
          for (int tl = 0; tl < LRU_CH; ++tl) { const float xc = cb + cw0 * u[tl] + cw1 * u[tl + 1] + cw2 * u[tl + 2] + cw3 * u[tl + 3]; Xw[tl * US + lane] = f2bf(xc); } }
        LDS_WAIT(); asm volatile("" ::: "memory");
        f32x4 ca[2][4], cx[2][4];
#pragma unroll
        for (int rt = 0; rt < 2; ++rt) { const bf16x8 a0 = *(const LAS bf16x8*)(Xw + (rt * 16 + lr) * US + lq * 8), a1 = *(const LAS bf16x8*)(Xw + (rt * 16 + lr) * US + 32 + lq * 8);
#pragma unroll
            for (int et = 0; et < 4; ++et) { ca[rt][et] = __builtin_amdgcn_mfma_f32_16x16x32_bf16(a0, ba[et][0], (f32x4){0.f, 0.f, 0.f, 0.f}, 0, 0, 0); ca[rt][et] = __builtin_amdgcn_mfma_f32_16x16x32_bf16(a1, ba[et][1], ca[rt][et], 0, 0, 0);
                                              cx[rt][et] = __builtin_amdgcn_mfma_f32_16x16x32_bf16(a0, bx[et][0], (f32x4){0.f, 0.f, 0.f, 0.f}, 0, 0, 0); cx[rt][et] = __builtin_amdgcn_mfma_f32_16x16x32_bf16(a1, bx[et][1], cx[rt][et], 0, 0, 0); } }
        float xv[4][2][4];
#pragma unroll
        for (int et = 0; et < 4; ++et)
#pragma unroll
            for (int rt = 0; rt < 2; ++rt)
#pragma unroll
                for (int reg = 0; reg < 4; ++reg) xv[et][rt][reg] = bf2f(Xw[(rt * 16 + lq * 4 + reg) * US + et * 16 + lr]);
#pragma unroll
        for (int et = 0; et < 4; ++et) {
            float Pl[2][4], Hl[2][4], At[2], Ht[2];
#pragma unroll
            for (int rt = 0; rt < 2; ++rt) { float P = 1.f, H = 0.f;
#pragma unroll
                for (int reg = 0; reg < 4; ++reg) { const int tl = rt * 16 + lq * 4 + reg;
                    const float r = fast_sigmoid(ca[rt][et][reg] + bav[et]), ig = fast_sigmoid(cx[rt][et][reg] + bxv[et]);
                    const float log_a = -8.0f * r * sp[et]; const float av = fast_exp(log_a);
                    float mult = __builtin_amdgcn_sqrtf(fmaxf(1.0f - av * av, 0.f)); if (s0 + tl == 0) mult = 1.0f;
                    const float bv = mult * ig * xv[et][rt][reg];
                    H = av * H + bv; P *= av; Pl[rt][reg] = P; Hl[rt][reg] = H; }
                At[rt] = P; Ht[rt] = H; }
            float Ai[2], Hi[2];
#pragma unroll
            for (int rt = 0; rt < 2; ++rt) { float A = At[rt], H = Ht[rt];
                { const float Ap = rows_up16(A, lq), Hp = rows_up16(H, lq); if (lq >= 1) { H = A * Hp + H; A = A * Ap; } }
                { const float Ap = rows_up32(A), Hp = rows_up32(H); if (lq >= 2) { H = A * Hp + H; A = A * Ap; } }
                Ai[rt] = A; Hi[rt] = H; }
            float Ac[2], Hc[2];
#pragma unroll
            for (int rt = 0; rt < 2; ++rt) { const float Ap = rows_up16(Ai[rt], lq), Hp = rows_up16(Hi[rt], lq); Ac[rt] = (lq >= 1) ? Ap : 1.f; Hc[rt] = (lq >= 1) ? Hp : 0.f; }
            const float A0t = row3_bcast(Ai[0]), H0t = row3_bcast(Hi[0]);
            Hc[1] = Ac[1] * H0t + Hc[1]; Ac[1] = Ac[1] * A0t;
#pragma unroll
            for (int rt = 0; rt < 2; ++rt)
#pragma unroll
                for (int reg = 0; reg < 4; ++reg) { const int tl = rt * 16 + lq * 4 + reg;
                    Uw[tl * 64 + et * 16 + lr] = f2bf(Hl[rt][reg] + Pl[rt][reg] * Hc[rt]); Pw[tl * 64 + et * 16 + lr] = f2bf(Pl[rt][reg] * Ac[rt]); }
            if (lq == 3) { const size_t o = (size_t)ck * 256 + n * 64 + et * 16 + lr;
                AGGP[o] = Ai[1] * A0t; AGGH[o] = Ai[1] * H0t + Hi[1]; }
        }
        LDS_WAIT(); asm volatile("" ::: "memory");
#pragma unroll
        for (int j = 0; j < 4; ++j) { const int id = lane + 64 * j, row = id >> 3, c8 = (id & 7) * 8;
            *(u32x4*)(HL + (size_t)(t0 + row) * 256 + n * 64 + c8) = *(const LAS u32x4*)(Uw + row * 64 + c8);
            *(u32x4*)(PL + (size_t)(t0 + row) * 256 + n * 64 + c8) = *(const LAS u32x4*)(Pw + row * 64 + c8); }
        LDS_WAIT(); asm volatile("" ::: "memory");
    }
}
__device__ __forceinline__ void phase_lru_b(ArgsRef a, int wv) {
    const float* __restrict__ AGGH = (const float*)(a.ws + WS_AGGH); const float* __restrict__ AGGP = (const float*)(a.ws + WS_AGGP); float* __restrict__ CARRY = (float*)(a.ws + WS_CARRY);
    const int tid_ = tid_from(wv), seg = tid_ & 31;
    for (int ch = bid_here() * 16 + (tid_ >> 5); ch < NB * 256; ch += gdim_here() * 16) { const int b = ch >> 8, c = ch & 255;
        float pp[4], hh[4];
#pragma unroll
        for (int k = 0; k < 4; ++k) { const size_t o = (size_t)(b * LRU_NCH + seg * 4 + k) * 256 + c; pp[k] = AGGP[o]; hh[k] = AGGH[o]; }
        float A = 1.f, H = 0.f;
#pragma unroll
        for (int k = 0; k < 4; ++k) { H = pp[k] * H + hh[k]; A *= pp[k]; }
#pragma unroll
        for (int d = 1; d < 32; d <<= 1) { const float Ap = __shfl_up(A, d, 32), Hp = __shfl_up(H, d, 32); if (seg >= d) { H = A * Hp + H; A = A * Ap; } }
        float carry = __shfl_up(H, 1, 32); if (seg == 0) carry = 0.f;
#pragma unroll
        for (int k = 0; k < 4; ++k) { const size_t o = (size_t)(b * LRU_NCH + seg * 4 + k) * 256 + c; CARRY[o] = carry; carry = pp[k] * carry + hh[k]; } }
}
typedef short v4i16_t __attribute__((ext_vector_type(4)));
struct AttnUnit { int h, n, r, dl, g, first; size_t rowb; };
__device__ __forceinline__ AttnUnit attn_unit(int bh, int hf, int i) {
    AttnUnit u; u.h = bh & 7; u.rowb = (size_t)(bh >> 3) * SEQ;
    if (i < 16) { u.g = 0; u.dl = 1; u.r = 0; u.n = 16 * hf + i; u.first = (i == 0); }
    else if (i < 32) { const int j = i - 16; u.g = 1; u.dl = 4; u.r = 2 * hf + (j >> 3); u.n = j & 7; u.first = (u.n == 0); }
    else { const int j = i - 32; u.g = 2; u.dl = 16; u.r = 8 * hf + (j >> 1); u.n = j & 1; u.first = (u.n == 0); }
    return u;
}
__device__ __forceinline__ void attn_dma_chunk(const __amdgpu_buffer_rsrc_t rs, LAS unsigned char* lds, const AttnUnit& u, int chunk, int slot, int wave, int lane) {
    const int csc = (lane & 7) ^ ((lane >> 3) & 7);
#pragma unroll
    for (int q = 0; q < 2; ++q) { const int pc = wave + 8 * q, l = 128 * chunk + 8 * pc + (lane >> 3);
        const unsigned rowoff = ((unsigned)(u.rowb * 8 + u.h * SEQ) + (unsigned)(l * u.dl + u.r)) * 128u + (unsigned)(csc * 16);
        const unsigned srcK = rowoff + (unsigned)(NT * 512 * 2), srcV = rowoff + (unsigned)(NT * 512 * 4);
        LAS unsigned char* dst = lds + slot * 32768 + pc * 1024;
        __builtin_amdgcn_raw_ptr_buffer_load_lds(rs, (LAS void*)dst, 16, srcK, 0, 0, 0);
        __builtin_amdgcn_raw_ptr_buffer_load_lds(rs, (LAS void*)(dst + 16384), 16, srcV, 0, 0, 0); }
}
__device__ __forceinline__ void phase_attn(ArgsRef a, LAS unsigned char* lds, int wv) {
    const int tid = tid_from(wv), lane = tid & 63, wave = __builtin_amdgcn_readfirstlane(tid >> 6);
    const bf16* proj = (const bf16*)(a.ws + WS_HM);
    bf16* PNUM = (bf16*)(a.ws + WS_PNUM); float* PDEN = (float*)(a.ws + WS_PDEN); float* PMAX = (float*)(a.ws + WS_PMAX);
    const __amdgpu_buffer_rsrc_t rs = __builtin_amdgcn_make_buffer_rsrc((void*)proj, 0, 0x7fffffff, 0x00020000);
    const int lr = lane & 15, lq = lane >> 4, qi0 = 16 * wave, G = gdim_here();
    float zz_ = 0.f; asm volatile("" : "+v"(zz_));
    const int kc0 = ((0 + lq) ^ (lr & 7)) * 16, kc1 = ((4 + lq) ^ (lr & 7)) * 16;
    const int q4 = (lane & 15) >> 2, p4 = lane & 3, vsw = (4 * lq + q4) & 7;
    unsigned chv[4];
#pragma unroll
    for (int dt = 0; dt < 4; ++dt) chv[dt] = (unsigned)(((2 * dt + (p4 >> 1)) ^ vsw) * 16 + (p4 & 1) * 8);
    const bool xo = (G == 256);
    const int pair = xo ? ((int)(bid_here() & 7) * 16 + (int)(bid_here() >> 4)) : (int)(bid_here() >> 1), hf = xo ? (int)((bid_here() >> 3) & 1) : (int)(bid_here() & 1), npairs = G >> 1;
    __syncthreads();
    { unsigned z0 = 0u; asm volatile("" : "+v"(z0));
      for (int z = tid; z < RING_BYTES / 16; z += NTHR) ((LAS u32x4*)lds)[z] = (u32x4){z0, z0, z0, z0}; }
    __syncthreads();
    const int total = (pair < 128 && bid_here() < 2 * npairs) ? ((128 - pair + npairs - 1) / npairs) * 48 : 0;
    AttnUnit cu = attn_unit(pair < 128 ? pair : 0, hf, 0);
    const int off = (total > 0 && cu.n > 0) ? 1 : 0;
#define ATT_UNIT_AT(k) attn_unit(pair + ((k) / 48) * npairs, hf, (k) % 48)
#define ATT_QLOAD(U, Q0, Q1) do { const size_t qrow_ = (U).rowb * 8 + (size_t)(U).h * SEQ + (size_t)(128 * (U).n + qi0 + lr) * (U).dl + (U).r; \
        Q0 = *(const bf16x8*)(proj + qrow_ * 64 + lq * 8); Q1 = *(const bf16x8*)(proj + qrow_ * 64 + 32 + lq * 8); } while (0)
    bf16x8 qf0, qf1, nq0, nq1;
    if (total > 0) { if (off) attn_dma_chunk(rs, lds, cu, cu.n - 1, 0, wave, lane);
        attn_dma_chunk(rs, lds, cu, cu.n, off & 3, wave, lane); ATT_QLOAD(cu, qf0, qf1);
        if (total > 1) { const AttnUnit u1 = ATT_UNIT_AT(1); attn_dma_chunk(rs, lds, u1, u1.n, (1 + off) & 3, wave, lane); } }
    nq0 = qf0; nq1 = qf1;
    asm volatile("s_waitcnt vmcnt(0)" ::: "memory");
    int idx = 0;
    while (idx < total) {
        __builtin_amdgcn_s_barrier(); asm volatile("" ::: "memory");
        const int csc = (idx + off) & 3, csp = cu.first ? ((cu.n > 0) ? 0 : csc) : ((idx + off + 3) & 3);
        AttnUnit nu = cu;
        if (idx + 1 < total) { nu = ATT_UNIT_AT(idx + 1); ATT_QLOAD(nu, nq0, nq1); }
        if (idx + 2 < total) { const AttnUnit u2 = ATT_UNIT_AT(idx + 2); attn_dma_chunk(rs, lds, u2, u2.n, (idx + 2 + off) & 3, wave, lane); }
        ++idx;
        f32x4 scv[9];
        { bf16x8 kf[9][2];
#pragma unroll
          for (int t = 0; t < 9; ++t) { const int wt = wave + t; const LAS unsigned char* Kt = lds + ((wt >= 8) ? csc : csp) * 32768 + ((16 * wt) & 127) * 128 + lr * 128;
              kf[t][0] = *(const LAS bf16x8*)(Kt + kc0); kf[t][1] = *(const LAS bf16x8*)(Kt + kc1); }
          __builtin_amdgcn_sched_barrier(0);
#pragma unroll
          for (int t = 0; t < 9; ++t) scv[t] = __builtin_amdgcn_mfma_f32_16x16x32_bf16(kf[t][0], qf0, (f32x4){0.f, 0.f, 0.f, 0.f}, 0, 0, 0);
#pragma unroll
          for (int t = 0; t < 9; ++t) scv[t] = __builtin_amdgcn_mfma_f32_16x16x32_bf16(kf[t][1], qf1, scv[t], 0, 0, 0); }
#pragma unroll
        for (int reg = 0; reg < 4; ++reg) { if (4 * lq + reg < lr) scv[0][reg] = -1e30f; if (4 * lq + reg > lr) scv[8][reg] = -1e30f; }
        if (cu.n == 0) {
#pragma unroll
            for (int t = 0; t < 8; ++t)
#pragma unroll
                for (int reg = 0; reg < 4; ++reg) { if (qi0 + 16 * t + 4 * lq + reg < 128) scv[t][reg] = -1e30f; } }
        float mx = -1e30f;
#pragma unroll
        for (int t = 0; t < 9; ++t)
#pragma unroll
            for (int reg = 0; reg < 4; ++reg) mx = fmaxf(mx, scv[t][reg]);
        mx = xmax32(xmax16(mx));
#define ATT_EXP_PAIR(PI) do { _Pragma("unroll") for (int tt_ = 2 * (PI); tt_ < 2 * (PI) + 2 && tt_ < 9; ++tt_) _Pragma("unroll") for (int reg = 0; reg < 4; ++reg) scv[tt_][reg] = __builtin_amdgcn_exp2f(scv[tt_][reg] - mx); } while (0)
        ATT_EXP_PAIR(0);
        f32x4 oc[4], den = (f32x4){zz_, zz_, zz_, zz_};
        const bf16x8 ones = __builtin_bit_cast(bf16x8, (u32x4){0x3f803f80u, 0x3f803f80u, 0x3f803f80u, 0x3f803f80u});
#pragma unroll
        for (int dt = 0; dt < 4; ++dt) oc[dt] = (f32x4){zz_, zz_, zz_, zz_};
        v4i16_t rv[2][2][4];
#define ATT_VISSUE(PI, B) do { const int t0_ = 2 * (PI), t1_ = (2 * (PI) + 1 < 9) ? 2 * (PI) + 1 : 8; const int w0_ = wave + t0_, w1_ = wave + t1_; \
            const LAS unsigned char* V0_ = lds + ((w0_ >= 8) ? csc : csp) * 32768 + 16384 + (((16 * w0_) & 127) + 4 * lq + q4) * 128; \
            const LAS unsigned char* V1_ = lds + ((w1_ >= 8) ? csc : csp) * 32768 + 16384 + (((16 * w1_) & 127) + 4 * lq + q4) * 128; \
            const unsigned va0_ = (unsigned)(unsigned long)V0_, va1_ = (unsigned)(unsigned long)V1_; \
            _Pragma("unroll") for (int dt = 0; dt < 4; ++dt) { asm volatile("ds_read_b64_tr_b16 %0, %1" : "=&v"(rv[B][0][dt]) : "v"(va0_ + chv[dt]) : "memory"); asm volatile("ds_read_b64_tr_b16 %0, %1" : "=&v"(rv[B][1][dt]) : "v"(va1_ + chv[dt]) : "memory"); } } while (0)
        ATT_VISSUE(0, 0);
#pragma unroll
        for (int pi = 0; pi < 5; ++pi) { const int t0 = 2 * pi, t1 = (2 * pi + 1 < 9) ? 2 * pi + 1 : 8; const int B = pi & 1;
            u32x4 pw; pw.x = cvt_pk_bf16(scv[t0][0], scv[t0][1]); pw.y = cvt_pk_bf16(scv[t0][2], scv[t0][3]);
            if (2 * pi + 1 < 9) { pw.z = cvt_pk_bf16(scv[t1][0], scv[t1][1]); pw.w = cvt_pk_bf16(scv[t1][2], scv[t1][3]); } else { pw.z = 0u; pw.w = 0u; }
            const bf16x8 pf = __builtin_bit_cast(bf16x8, pw);
            if (pi < 4) { ATT_VISSUE(pi + 1, (pi + 1) & 1);
                asm volatile("s_waitcnt lgkmcnt(8)" : "+v"(rv[B][0][0]), "+v"(rv[B][0][1]), "+v"(rv[B][0][2]), "+v"(rv[B][0][3]), "+v"(rv[B][1][0]), "+v"(rv[B][1][1]), "+v"(rv[B][1][2]), "+v"(rv[B][1][3]) :: "memory"); }
            else asm volatile("s_waitcnt lgkmcnt(0)" : "+v"(rv[B][0][0]), "+v"(rv[B][0][1]), "+v"(rv[B][0][2]), "+v"(rv[B][0][3]), "+v"(rv[B][1][0]), "+v"(rv[B][1][1]), "+v"(rv[B][1][2]), "+v"(rv[B][1][3]) :: "memory");
#pragma unroll
            for (int dt = 0; dt < 4; ++dt) { const bf16x8 vf = (bf16x8){rv[B][0][dt][0], rv[B][0][dt][1], rv[B][0][dt][2], rv[B][0][dt][3], rv[B][1][dt][0], rv[B][1][dt][1], rv[B][1][dt][2], rv[B][1][dt][3]};
                oc[dt] = __builtin_amdgcn_mfma_f32_16x16x32_bf16(vf, pf, oc[dt], 0, 0, 0); }
            den = __builtin_amdgcn_mfma_f32_16x16x32_bf16(ones, pf, den, 0, 0, 0);
            if (pi < 4) { ATT_EXP_PAIR(pi + 1);
#pragma unroll
                for (int q = 0; q < 4; ++q) { __builtin_amdgcn_sched_group_barrier(0x8, 1, 0); __builtin_amdgcn_sched_group_barrier(0x2, 4, 0); }
                __builtin_amdgcn_sched_group_barrier(0x8, 1, 0); } }
#undef ATT_VISSUE
#undef ATT_EXP_PAIR
        asm volatile("s_waitcnt vmcnt(4)" ::: "memory");
        { LAS unsigned char* stg = lds + OST_OFF + wave * 2048;
#pragma unroll
          for (int dt = 0; dt < 4; ++dt) { u32x2 w; w.x = cvt_pk_bf16(oc[dt][0], oc[dt][1]); w.y = cvt_pk_bf16(oc[dt][2], oc[dt][3]);
              *(LAS u32x2*)(stg + lr * 128 + (((2 * dt + (lq >> 1)) ^ (lr & 7)) << 4) + (lq & 1) * 8) = w; }
          LDS_WAIT(); asm volatile("" ::: "memory");
#pragma unroll
          for (int i = 0; i < 2; ++i) { const int qq = i * 8 + (lane >> 3), c8 = lane & 7; const u32x4 w = *(const LAS u32x4*)(stg + qq * 128 + ((c8 ^ (qq & 7)) << 4));
              const size_t tok = cu.rowb + (size_t)(128 * cu.n + qi0 + qq) * cu.dl + cu.r;
              *(u32x4*)(PNUM + ((size_t)cu.g * NT + tok) * 512 + cu.h * 64 + c8 * 8) = w; }
          LDS_WAIT(); asm volatile("" ::: "memory"); }
        if (lq == 0) { const size_t tok = cu.rowb + (size_t)(128 * cu.n + qi0 + lr) * cu.dl + cu.r; PDEN[((size_t)cu.g * NT + tok) * 8 + cu.h] = den[0]; PMAX[((size_t)cu.g * NT + tok) * 8 + cu.h] = mx; }
        cu = nu; qf0 = nq0; qf1 = nq1;
    }
#undef ATT_UNIT_AT
#undef ATT_QLOAD
}
__device__ __forceinline__ void phase_finalize(ArgsRef a, int wv, const bool f8) {
    const int tid = tid_from(wv), lane = tid & 63, wave = tid >> 6;
    const int gw = bid_here() * NWAVES + wave, NGW = gdim_here() * NWAVES;
    const bf16* __restrict__ proj = (const bf16*)(a.ws + WS_PROJ); unsigned char* __restrict__ mix = a.ws + WS_MIX;
    bf16* __restrict__ mixb = (bf16*)(a.ws + WS_MIX);
    const bf16* __restrict__ YP = (const bf16*)(a.ws + WS_YP); const float* __restrict__ SSQPOOL = (const float*)(a.ws + WS_SSQPOOL);
    const bf16* __restrict__ HL = (const bf16*)(a.ws + WS_HL); const bf16* __restrict__ PL = (const bf16*)(a.ws + WS_PL); const float* __restrict__ CARRY = (const float*)(a.ws + WS_CARRY);
    const bf16* __restrict__ PNUM = (const bf16*)(a.ws + WS_PNUM); const float* __restrict__ PDEN = (const float*)(a.ws + WS_PDEN); const float* __restrict__ PMAX = (const float*)(a.ws + WS_PMAX);
    const int hd = lane >> 3;
    for (int t = gw; t < NT; t += NGW) {
        const u32x2 ypw = __builtin_nontemporal_load((const u32x2*)(YP + (size_t)t * 256 + lane * 4)); const f32x4 sq = *(const f32x4*)(SSQPOOL + (size_t)t * 4);
        const u32x2 hw = __builtin_nontemporal_load((const u32x2*)(HL + (size_t)t * 256 + lane * 4)), pw = __builtin_nontemporal_load((const u32x2*)(PL + (size_t)t * 256 + lane * 4)), gwd = __builtin_nontemporal_load((const u32x2*)(proj + (size_t)t * NPJ + C_GATE + lane * 4));
        const f32x4 cr = *(const f32x4*)(CARRY + (size_t)(t / LRU_CH) * 256 + lane * 4);
        float m[3], dn[3]; u32x4 nw[3];
#pragma unroll
        for (int g = 0; g < 3; ++g) { m[g] = PMAX[((size_t)g * NT + t) * 8 + hd]; dn[g] = PDEN[((size_t)g * NT + t) * 8 + hd]; nw[g] = __builtin_nontemporal_load((const u32x4*)(PNUM + ((size_t)g * NT + t) * 512 + lane * 8)); }
        { const float rs = __builtin_amdgcn_rsqf(((sq[0] + sq[1]) + (sq[2] + sq[3])) * (1.0f / 256.0f) + EPS);
          if (f8) { int o = __builtin_amdgcn_cvt_pk_fp8_f32(bflo(ypw.x) * rs, bfhi(ypw.x) * rs, 0, false); o = __builtin_amdgcn_cvt_pk_fp8_f32(bflo(ypw.y) * rs, bfhi(ypw.y) * rs, o, true);
              *(unsigned*)(mix + (size_t)t * DM + lane * 4) = (unsigned)o; }
          else { u32x2 o; o.x = cvt_pk_bf16(bflo(ypw.x) * rs, bfhi(ypw.x) * rs); o.y = cvt_pk_bf16(bflo(ypw.y) * rs, bfhi(ypw.y) * rs); *(u32x2*)(mixb + (size_t)t * DM + lane * 4) = o; } }
        { float h[4] = {bflo(hw.x) + bflo(pw.x) * cr[0], bfhi(hw.x) + bfhi(pw.x) * cr[1], bflo(hw.y) + bflo(pw.y) * cr[2], bfhi(hw.y) + bfhi(pw.y) * cr[3]};
          const float gt[4] = {bflo(gwd.x), bfhi(gwd.x), bflo(gwd.y), bfhi(gwd.y)};
          float s = 0.f;
#pragma unroll
          for (int j = 0; j < 4; ++j) { h[j] *= gelu_tanh(gt[j]); s += h[j] * h[j]; }
          s = wave_sum(s); const float rs = __builtin_amdgcn_rsqf(s * (1.0f / 256.0f) + EPS);
          if (f8) { int o = __builtin_amdgcn_cvt_pk_fp8_f32(h[0] * rs, h[1] * rs, 0, false); o = __builtin_amdgcn_cvt_pk_fp8_f32(h[2] * rs, h[3] * rs, o, true);
              *(unsigned*)(mix + (size_t)t * DM + 256 + lane * 4) = (unsigned)o; }
          else { u32x2 o; o.x = cvt_pk_bf16(h[0] * rs, h[1] * rs); o.y = cvt_pk_bf16(h[2] * rs, h[3] * rs); *(u32x2*)(mixb + (size_t)t * DM + 256 + lane * 4) = o; } }
        { const float mr = fmaxf(fmaxf(m[0], m[1]), m[2]);
          float o[8] = {0.f, 0.f, 0.f, 0.f, 0.f, 0.f, 0.f, 0.f}; float den = 0.f;
#pragma unroll
          for (int g = 0; g < 3; ++g) { const float wg = __builtin_amdgcn_exp2f(m[g] - mr); den += wg * dn[g];
              o[0] += wg * bflo(nw[g].x); o[1] += wg * bfhi(nw[g].x); o[2] += wg * bflo(nw[g].y); o[3] += wg * bfhi(nw[g].y); o[4] += wg * bflo(nw[g].z); o[5] += wg * bfhi(nw[g].z); o[6] += wg * bflo(nw[g].w); o[7] += wg * bfhi(nw[g].w); }
          const float inv = 1.0f / den; float s = 0.f;
#pragma unroll
          for (int j = 0; j < 8; ++j) { o[j] *= inv; s += o[j] * o[j]; }
          s = wave_sum(s); const float rs = __builtin_amdgcn_rsqf(s * (1.0f / 512.0f) + EPS);
          if (f8) { int w0 = __builtin_amdgcn_cvt_pk_fp8_f32(o[0] * rs, o[1] * rs, 0, false); w0 = __builtin_amdgcn_cvt_pk_fp8_f32(o[2] * rs, o[3] * rs, w0, true);
              int w1 = __builtin_amdgcn_cvt_pk_fp8_f32(o[4] * rs, o[5] * rs, 0, false); w1 = __builtin_amdgcn_cvt_pk_fp8_f32(o[6] * rs, o[7] * rs, w1, true);
              *(u32x2*)(mix + (size_t)t * DM + 512 + lane * 8) = (u32x2){(unsigned)w0, (unsigned)w1}; }
          else { u32x4 wv4; wv4.x = cvt_pk_bf16(o[0] * rs, o[1] * rs); wv4.y = cvt_pk_bf16(o[2] * rs, o[3] * rs); wv4.z = cvt_pk_bf16(o[4] * rs, o[5] * rs); wv4.w = cvt_pk_bf16(o[6] * rs, o[7] * rs);
              *(u32x4*)(mixb + (size_t)t * DM + 512 + lane * 8) = wv4; } }
    }
}

__device__ __forceinline__ void phase_router(ArgsRef a, LAS unsigned char* lds, int layer, int wv, bool alloc) {
    const int tid = tid_from(wv), lane = tid & 63, wave = __builtin_amdgcn_readfirstlane(tid >> 6);
    const bf16* xb = (const bf16*)(a.ws + WS_XB); const bf16* wr = (const bf16*)(a.ws + WS_SMALL) + SM_WR + (size_t)layer * NEXP * DM;
    const float* ssqp = (const float*)(a.ws + WS_SSQP); const float* rbias = a.in[I_BR] + layer * NEXP;
    int* LIST = (int*)(a.ws + WS_LIST); float* LRSTD = (float*)(a.ws + WS_LRSTD); float* LGATE = (float*)(a.ws + WS_LGATE2); int* TSEL = (int*)(a.ws + WS_TSEL);
    unsigned* cnt = (unsigned*)(a.ws + WS_CTL) + CW_CNT + layer * NEXP;
    float zr_ = 0.f; asm volatile("" : "+v"(zr_));
    LAS float* LG = (LAS float*)lds + wave * 32 * 33;
    LAS int* hist = (LAS int*)(lds + 65536);
    LAS int* base = (LAS int*)(lds + 65536 + 128);
    LAS float* rbl = (LAS float*)(lds + 65536 + 256);
    const int lr = lane & 15, lq = lane >> 4;
    for (int unit = bid_here(); unit < NT / 256; unit += gdim_here()) {
        const int tok0 = unit * 256 + wave * 32;
        __syncthreads();
        if (tid < 32) { hist[tid] = 0; rbl[tid] = rbias[tid]; }
        f32x4 acc[2][2];
#pragma unroll
        for (int rt = 0; rt < 2; ++rt)
#pragma unroll
            for (int et = 0; et < 2; ++et) acc[rt][et] = (f32x4){zr_, zr_, zr_, zr_};
#pragma unroll 1
        for (int k0 = 0; k0 < 32; k0 += 8) { bf16x8 af[8][2], bfr[8][2];
#pragma unroll
            for (int j = 0; j < 8; ++j) { const int ks = k0 + j;
#pragma unroll
                for (int rt = 0; rt < 2; ++rt) af[j][rt] = *(const bf16x8*)(xb + (size_t)(tok0 + rt * 16 + lr) * DM + ks * 32 + lq * 8);
#pragma unroll
                for (int et = 0; et < 2; ++et) bfr[j][et] = *(const bf16x8*)(wr + (size_t)(et * 16 + lr) * DM + ks * 32 + lq * 8); }
            __builtin_amdgcn_sched_barrier(0);
#pragma unroll
            for (int j = 0; j < 8; ++j)
#pragma unroll
                for (int rt = 0; rt < 2; ++rt)
#pragma unroll
                    for (int et = 0; et < 2; ++et) acc[rt][et] = __builtin_amdgcn_mfma_f32_16x16x32_bf16(af[j][rt], bfr[j][et], acc[rt][et], 0, 0, 0); }
#pragma unroll
        for (int rt = 0; rt < 2; ++rt)
#pragma unroll
            for (int et = 0; et < 2; ++et)
#pragma unroll
                for (int reg = 0; reg < 4; ++reg) LG[(rt * 16 + lq * 4 + reg) * 33 + et * 16 + lr] = acc[rt][et][reg];
        __syncthreads();
        int te[4] = {0, 0, 0, 0}; float tg[4] = {0.f, 0.f, 0.f, 0.f}; int rk[4] = {0, 0, 0, 0}; float rstd = 0.f; const int tok = tok0 + lane;
        if (lane < 32) {
            const float* sp = ssqp + (size_t)tok * 16; float ss = 0.f;
#pragma unroll
            for (int j = 0; j < 16; ++j) ss += sp[j];
            rstd = __builtin_amdgcn_rsqf(ss * (1.0f / DM) + EPS);
            float tv[4] = {-3e38f, -3e38f, -3e38f, -3e38f};
            for (int e = 0; e < NEXP; ++e) { float v = LG[lane * 33 + e] * rstd + rbl[e]; int ve = e;
#pragma unroll
                for (int k = 0; k < 4; ++k) { if (v > tv[k]) { const float tvv = tv[k]; const int tee = te[k]; tv[k] = v; te[k] = ve; v = tvv; ve = tee; } } }
            float z = 0.f;
#pragma unroll
            for (int k = 0; k < 4; ++k) { tg[k] = fast_exp(tv[k] - tv[0]); z += tg[k]; }
            const float iz = 1.0f / z;
#pragma unroll
            for (int k = 0; k < 4; ++k) { tg[k] *= iz; rk[k] = __hip_atomic_fetch_add(&hist[te[k]], 1, __ATOMIC_RELAXED, __HIP_MEMORY_SCOPE_WORKGROUP); }
        }
        __syncthreads();
        if (tid < 32) base[tid] = alloc ? (int)__hip_atomic_fetch_add(cnt + tid, (unsigned)hist[tid], RLX_AGENT) : 0;
        __syncthreads();
        if (lane < 32 && alloc) {
#pragma unroll
            for (int k = 0; k < 4; ++k) { const size_t p = (size_t)te[k] * NT + base[te[k]] + rk[k]; LIST[p] = tok * 4 + k; LRSTD[p] = rstd; LGATE[p] = tg[k]; TSEL[tok * 4 + k] = (te[k] << 16) | (base[te[k]] + rk[k]); }
        }
    }
}

__device__ __forceinline__ void phase_combine(ArgsRef a, bool last_layer, int wv, bool dry, const unsigned* cnt) {
    const int tid = tid_from(wv), lane = tid & 63, wave = tid >> 6;
    const int gw = bid_here() * NWAVES + wave, NGW = gdim_here() * NWAVES;
    const unsigned char* __restrict__ Y = (const unsigned char*)(a.ws + WS_Y); float* __restrict__ out = a.out; bf16* xb = (bf16*)(a.ws + WS_XB); float* __restrict__ ssq = (float*)(a.ws + WS_SSQ);
    const u32x4* __restrict__ TSEL = (const u32x4*)(a.ws + WS_TSEL); unsigned char* __restrict__ xa8 = a.ws + WS_XB8;
    typedef float f2v __attribute__((ext_vector_type(2)));
    int bpl; { int nb = (lane < NEXP) ? (int)((__hip_atomic_load(cnt + (lane & 31), RLX_AGENT) + 255u) >> 8) : 0; int incl = nb;
#pragma unroll
        for (int d = 1; d < 32; d <<= 1) { const int v = __shfl_up(incl, d, 64); if (lane >= d) incl += v; }
        bpl = (incl - nb) * 256; }
    u32x4 sel = TSEL[gw < NT ? gw : 0];
    for (int t = gw; t < NT; t += NGW) {
        const u32x4 x0 = __builtin_nontemporal_load((const u32x4*)(xb + (size_t)t * DM) + 2 * lane), x1 = __builtin_nontemporal_load((const u32x4*)(xb + (size_t)t * DM) + 2 * lane + 1);
        u32x4 y[4];
#pragma unroll
        for (int k = 0; k < 4; ++k) { const int e = (int)(sel[k] >> 16), pos = (int)(sel[k] & 0xffffu); const int slot = __builtin_amdgcn_readlane(bpl, __builtin_amdgcn_readfirstlane(e)) + pos;
            y[k] = __builtin_nontemporal_load((const u32x4*)(Y + (size_t)slot * DM) + lane); }
        if (t + NGW < NT) sel = TSEL[t + NGW];
        float v[16];
        v[0] = bflo(x0.x); v[1] = bfhi(x0.x); v[2] = bflo(x0.y); v[3] = bfhi(x0.y); v[4] = bflo(x0.z); v[5] = bfhi(x0.z); v[6] = bflo(x0.w); v[7] = bfhi(x0.w);
        v[8] = bflo(x1.x); v[9] = bfhi(x1.x); v[10] = bflo(x1.y); v[11] = bfhi(x1.y); v[12] = bflo(x1.z); v[13] = bfhi(x1.z); v[14] = bflo(x1.w); v[15] = bfhi(x1.w);
#pragma unroll
        for (int k = 0; k < 4; ++k)
#pragma unroll
            for (int d = 0; d < 4; ++d) { const int w = (int)y[k][d]; const f2v lo = __builtin_amdgcn_cvt_pk_f32_fp8(w, false), hi = __builtin_amdgcn_cvt_pk_f32_fp8(w, true);
                v[4 * d + 0] += lo.x * (1.0f / Y8_SCALE); v[4 * d + 1] += lo.y * (1.0f / Y8_SCALE); v[4 * d + 2] += hi.x * (1.0f / Y8_SCALE); v[4 * d + 3] += hi.y * (1.0f / Y8_SCALE); }
        float s = 0.f;
#pragma unroll
        for (int j = 0; j < 16; ++j) s += v[j] * v[j];
        if (dry && s != 12345.678f) continue;
        if (last_layer) {
#pragma unroll
            for (int j = 0; j < 4; ++j) *((f32x4*)(out + (size_t)t * DM) + 4 * lane + j) = (f32x4){v[4 * j], v[4 * j + 1], v[4 * j + 2], v[4 * j + 3]};
        } else { s = wave_sum(s);
            u32x4 w0, w1; w0.x = cvt_pk_bf16(v[0], v[1]); w0.y = cvt_pk_bf16(v[2], v[3]); w0.z = cvt_pk_bf16(v[4], v[5]); w0.w = cvt_pk_bf16(v[6], v[7]);
            w1.x = cvt_pk_bf16(v[8], v[9]); w1.y = cvt_pk_bf16(v[10], v[11]); w1.z = cvt_pk_bf16(v[12], v[13]); w1.w = cvt_pk_bf16(v[14], v[15]);
            *((u32x4*)(xb + (size_t)t * DM) + 2 * lane) = w0; *((u32x4*)(xb + (size_t)t * DM) + 2 * lane + 1) = w1;
            u32x4 w8;
#pragma unroll
            for (int d = 0; d < 4; ++d) { int f = __builtin_amdgcn_cvt_pk_fp8_f32(v[4 * d], v[4 * d + 1], 0, false); f = __builtin_amdgcn_cvt_pk_fp8_f32(v[4 * d + 2], v[4 * d + 3], f, true); w8[d] = (unsigned)f; }
            *((u32x4*)(xa8 + (size_t)t * DM) + lane) = w8;
            if (lane == 0) ssq[t] = s; }
    }
}

constexpr int NPH_LAYER = 13, NPH = 1 + 2 * NPH_LAYER;
enum { PH_GEMM_IN = 0, PH_QKPREP, PH_POOL, PH_LRU_A, PH_LRU_B, PH_ATTN, PH_LRU_C, PH_MERGE, PH_GEMM_OUT, PH_ROUTER, PH_MOE_GU, PH_MOE_DOWN, PH_COMBINE };
#ifndef MK_STOP
#define MK_STOP NPH
#endif
#ifndef MK_STAG_OUT
#define MK_STAG_OUT 0
#endif
#ifndef MK_SPLIT
#define MK_SPLIT 0
#endif

template <int PHMASK>
__global__ void __launch_bounds__(NTHR, 2) mega_fwd(Args args_by_value) {
    extern __shared__ __attribute__((aligned(16))) unsigned char lds_raw[];
    LAS unsigned char* lds = (LAS unsigned char*)lds_raw;
    const int tid = threadIdx.x;
    int wv = __builtin_amdgcn_readfirstlane(tid >> 6); asm volatile("" : "+s"(wv));
    for (int u = tid; u < (LDS_BYTES - LDSCTL_OFF) / 4; u += NTHR) ((LAS unsigned*)(lds + LDSCTL_OFF))[u] = 0u;
    __syncthreads();
#define ARGS_HERE() const CAS Args* ap_ = (const CAS Args*)__builtin_amdgcn_kernarg_segment_ptr(); asm volatile("" : "+s"(ap_)); ArgsRef args = *ap_; unsigned char* const ws = args.ws; unsigned* const ctl = (unsigned*)(ws + WS_CTL); (void)ctl
    int lo, hi;
    { ARGS_HERE(); lo = args.ph_lo; hi = args.ph_hi; xcd_barrier_post(ctl + CW_BAR + args.li * XCD_BAR_WORDS, (volatile LAS unsigned*)(lds + MISC_OFF) + 8); }
#define EN(p) (((PHMASK) >> (p)) & 1)
#ifndef MK_DUP
#define MK_DUP 0
#endif
#define NREP(p) ((((MK_DUP) >> (p)) & 1) ? 2 : 1)
#define IN(k) (lo <= (k) && (k) < hi)
#define SEAM(k) do { if (IN(k) && IN((k) + 1)) { ARGS_HERE(); XcdBarrier bar_; bar_.bar = ctl + CW_BAR + args.li * XCD_BAR_WORDS; bar_.x = xb_xcc_id(); bar_.st = (volatile LAS unsigned*)(lds + MISC_OFF) + 8; xcd_barrier(bar_); } } while (0)

    if (EN(13) && IN(0)) { ARGS_HERE(); for (int rep_ = 0; rep_ < NREP(13); ++rep_) { phase_prologue(args, lds, wv); } }
    SEAM(0);
    for (int l = 0; l < 2; ++l) {
        const int pb = 1 + NPH_LAYER * l;
        if (EN(PH_GEMM_IN) && IN(pb + PH_GEMM_IN)) { ARGS_HERE();
            if (l == 0) { pg8::StaticOrder S; S.init(NT, NIN, DM, gdim_here(), bid_here()); S.dup = NREP(PH_GEMM_IN) - 1;
                EpiIn E{(bf16*)(ws + WS_PROJ), (bf16*)(ws + WS_HM), (const float*)(ws + WS_SSQ), args.in[I_QG], args.in[I_KG], (const float*)(ws + WS_ROPE), (const float*)(ws + WS_ROPE) + SEQ * 32, lds + OST_OFF, 1.0f};
                pg8::gemm_phase<EpiIn, pg8::StaticOrder, true>(lds, (const bf16*)(ws + WS_XB), (const bf16*)(ws + WS_WIN), DM, S, E, wv); }
            else { pg8::StaticOrder S; S.init(NT, NIN, DM / 2, gdim_here(), bid_here()); S.dup = 0;
                EpiIn E{(bf16*)(ws + WS_PROJ), (bf16*)(ws + WS_HM), (const float*)(ws + WS_SSQ), args.in[I_QG] + 64, args.in[I_KG] + 64, (const float*)(ws + WS_ROPE), (const float*)(ws + WS_ROPE) + SEQ * 32, lds + OST_OFF, 1.0f / WIN8_SCALE};
                pg8::gemm_phase<EpiIn, pg8::StaticOrder, true, true>(lds, (const bf16*)(ws + WS_XB8), (const bf16*)(ws + WS_WIN) + (size_t)NIN * DM, DM / 2, S, E, wv); }
        }
        SEAM(pb + PH_GEMM_IN);
        if (EN(PH_POOL) && IN(pb + PH_POOL)) { ARGS_HERE(); for (int rep_ = 0; rep_ < NREP(PH_POOL); ++rep_) { phase_pool(args, lds, l, wv); } }
        if (EN(PH_LRU_A) && IN(pb + PH_LRU_A)) { ARGS_HERE(); for (int rep_ = 0; rep_ < NREP(PH_LRU_A); ++rep_) { phase_lru_a(args, lds, l, wv); } }
        SEAM(pb + PH_LRU_A);
        if (EN(PH_LRU_B) && IN(pb + PH_LRU_B)) { ARGS_HERE(); for (int rep_ = 0; rep_ < NREP(PH_LRU_B); ++rep_) { phase_lru_b(args, wv); } }
        if (EN(PH_ATTN) && IN(pb + PH_ATTN)) { ARGS_HERE(); for (int rep_ = 0; rep_ < NREP(PH_ATTN); ++rep_) { phase_attn(args, lds, wv); } }
        SEAM(pb + PH_ATTN);
        if (EN(PH_LRU_C) && IN(pb + PH_LRU_C)) { ARGS_HERE(); for (int rep_ = 0; rep_ < NREP(PH_LRU_C); ++rep_) { phase_finalize(args, wv, l == 1); } }
        SEAM(pb + PH_MERGE);
        if (EN(PH_GEMM_OUT) && IN(pb + PH_GEMM_OUT)) { ARGS_HERE();
            __syncthreads();
            if (l == 0) { pg8::StaticOrder S; S.init(NT, DM, DM, gdim_here(), bid_here()); S.dup = NREP(PH_GEMM_OUT) - 1;
                EpiOut E{(bf16*)(ws + WS_XB), (float*)(ws + WS_SSQP), (unsigned char*)(ws + WS_XB8), 1.0f};
                pg8::gemm_phase<EpiOut, pg8::StaticOrder, true>(lds, (const bf16*)(ws + WS_MIX), (const bf16*)(ws + WS_WOUT), DM, S, E, wv, MK_STAG_OUT); }
            else { pg8::StaticOrder S; S.init(NT, DM, DM / 2, gdim_here(), bid_here()); S.dup = 0;
                EpiOut E{(bf16*)(ws + WS_XB), (float*)(ws + WS_SSQP), (unsigned char*)(ws + WS_XB8), 1.0f / WOUT8_SCALE};
                pg8::gemm_phase<EpiOut, pg8::StaticOrder, true, true>(lds, (const bf16*)(ws + WS_MIX), (const bf16*)(ws + WS_WOUT) + (size_t)DM * DM, DM / 2, S, E, wv, MK_STAG_OUT); }
        }
        SEAM(pb + PH_GEMM_OUT);
        if (EN(PH_ROUTER) && IN(pb + PH_ROUTER)) { ARGS_HERE(); for (int rep_ = 0; rep_ < NREP(PH_ROUTER); ++rep_) { phase_router(args, lds, l, wv, rep_ == NREP(PH_ROUTER) - 1); } }
        SEAM(pb + PH_ROUTER);
        if (EN(PH_MOE_GU) && IN(pb + PH_MOE_GU)) { ARGS_HERE();
            LAS int* tab = (LAS int*)(lds + TAB_OFF);
            moe_tables(tab, ctl + CW_CNT + l * NEXP, wv);
            MoeOrder<2> S{tab, 2, gdim_here(), bid_here(), (const int*)(ws + WS_LIST), NREP(PH_MOE_GU) - 1};
            EpiGU E{(unsigned char*)(ws + WS_ACT), (const float*)(ws + WS_LRSTD), args.in[I_BGU] + (size_t)l * NEXP * 512};
            pg8::gemm_phase<EpiGU, MoeOrder<2>, true, true>(lds, (const bf16*)(ws + WS_XB8), (const bf16*)(ws + WS_WGU + (size_t)l * NEXP * 512 * DM), DM / 2, S, E, wv);
        }
        SEAM(pb + PH_MOE_GU);
        if (EN(PH_MOE_DOWN) && IN(pb + PH_MOE_DOWN)) { ARGS_HERE();
            LAS int* tab = (LAS int*)(lds + TAB_OFF);
            if (!(EN(PH_MOE_GU) && IN(pb + PH_MOE_GU))) moe_tables(tab, ctl + CW_CNT + l * NEXP, wv);
            else __syncthreads();
            MoeOrder<3> S{tab, 4, gdim_here(), bid_here(), (const int*)(ws + WS_LIST), NREP(PH_MOE_DOWN) - 1};
            EpiDown E{(unsigned char*)(ws + WS_Y), (const int*)(ws + WS_LIST), (const float*)(ws + WS_LGATE2), args.in[I_BD] + (size_t)l * NEXP * DM, tab};
            pg8::gemm_phase<EpiDown, MoeOrder<3>, true, true>(lds, (const bf16*)(ws + WS_ACT), (const bf16*)(ws + WS_WD + (size_t)l * NEXP * DM * EFF), EFF / 2, S, E, wv);
        }
        SEAM(pb + PH_MOE_DOWN);
        if (EN(PH_COMBINE) && IN(pb + PH_COMBINE)) { ARGS_HERE(); for (int rep_ = 0; rep_ < NREP(PH_COMBINE); ++rep_) { phase_combine(args, l == 1, wv, rep_ < NREP(PH_COMBINE) - 1, ctl + CW_CNT + l * NEXP); } }
        SEAM(pb + PH_COMBINE);
    }
#undef IN
#undef SEAM
}

typedef void (*kern_t)(Args);
template <int M> static kern_t kern_of() { return (kern_t)mega_fwd<M>; }
static kern_t phase_kernel(int p) {
    switch (p) { case 0: return kern_of<1 << 0>(); case 1: return kern_of<1 << 1>(); case 2: return kern_of<1 << 2>(); case 3: return kern_of<1 << 3>(); case 4: return kern_of<1 << 4>();
                 case 5: return kern_of<1 << 5>(); case 6: return kern_of<1 << 6>(); case 7: return kern_of<1 << 7>(); case 8: return kern_of<1 << 8>(); case 9: return kern_of<1 << 9>();
                 case 10: return kern_of<1 << 10>(); case 11: return kern_of<1 << 11>(); case 12: return kern_of<1 << 12>(); default: return kern_of<1 << 13>(); }
}
extern "C" void kernel_launch(void* const* d_in, const int* in_sizes, int n_in, void* d_out, int out_size, void* d_ws, size_t ws_size, hipStream_t stream) {
    static int grid = 0;
    if (grid == 0) {
        if (n_in != 23 || in_sizes[0] != NT * DM || out_size != NT * DM || ws_size < WS_END) {
            fprintf(stderr, "kernel_launch: built for 23 inputs, x/out of %d floats, >= %zu bytes of workspace; got n_in %d, in0 %d, out %d, ws %zu; nothing launched\n", NT * DM, (size_t)WS_END, n_in, n_in > 0 ? in_sizes[0] : -1, out_size, ws_size);
            grid = -1; return; }
        int dev = 0, cus = 0;
        if (hipGetDevice(&dev) != hipSuccess || hipDeviceGetAttribute(&cus, hipDeviceAttributeMultiprocessorCount, dev) != hipSuccess) { fprintf(stderr, "kernel_launch: device query failed\n"); grid = -1; return; }
#if MK_SPLIT
        for (int p = 0; p < 14; ++p) if (hipFuncSetAttribute((const void*)phase_kernel(p), hipFuncAttributeMaxDynamicSharedMemorySize, LDS_BYTES) != hipSuccess) { fprintf(stderr, "kernel_launch: hipFuncSetAttribute failed\n"); grid = -1; return; }
#else
        if (hipFuncSetAttribute((const void*)kern_of<0x3fff>(), hipFuncAttributeMaxDynamicSharedMemorySize, LDS_BYTES) != hipSuccess) { fprintf(stderr, "kernel_launch: hipFuncSetAttribute failed\n"); grid = -1; return; }
        int per_cu = 0;
        if (hipOccupancyMaxActiveBlocksPerMultiprocessor(&per_cu, (const void*)kern_of<0x3fff>(), NTHR, LDS_BYTES) != hipSuccess || per_cu < 1)
            fprintf(stderr, "kernel_launch: note: occupancy query reports %d workgroups per CU\n", per_cu);
#endif
        (void)hipGetLastError();
        if (cus != 256) { fprintf(stderr, "kernel_launch: this kernel's unit maps are built for a 256-CU device (one workgroup per CU); found %d CUs; nothing launched\n", cus); grid = -1; return; }
        grid = cus;
    }
    if (grid < 0) return;
    if (hipMemsetAsync((char*)d_ws + WS_CTL, 0, MK_SPLIT ? CTL_ZERO_BYTES : (size_t)65536, stream) != hipSuccess)
 { fprintf(stderr, "kernel_launch: hipMemsetAsync failed\n"); return; }
    Args a{};
    for (int i = 0; i < 23; ++i) a.in[i] = (const float*)d_in[i];
    a.out = (float*)d_out; a.ws = (unsigned char*)d_ws; a.pad = 0;
#if MK_SPLIT
#ifdef MK_SKIP
    (void)hipMemsetAsync((char*)d_ws + WS_MIX, 0, (size_t)NT * DM * 2, stream);
#endif
    for (int p = 0; p < MK_STOP; ++p) { a.ph_lo = p; a.ph_hi = p + 1; a.li = p;
#ifdef MK_SKIP
        if (p >= 1 && (((MK_SKIP) >> ((p - 1) % NPH_LAYER)) & 1)) continue;
#endif
        hipLaunchKernelGGL(phase_kernel(p == 0 ? 13 : (p - 1) % NPH_LAYER), dim3(grid), dim3(NTHR), LDS_BYTES, stream, a); }
#else
    a.ph_lo = 0; a.ph_hi = NPH; a.li = 0;
    hipLaunchKernelGGL(kern_of<0x3fff>(), dim3(grid), dim3(NTHR), LDS_BYTES, stream, a);
#endif
    const hipError_t le = hipPeekAtLastError();
    if (le != hipSuccess) fprintf(stderr, "kernel_launch: launch failed: %s\n", hipGetErrorName(le));
}
```
